# Optimizing an MI355X kernel written in HIP

```python
import math
import jax, jax.numpy as jnp
from jax import lax
import numpy as np

D_MODEL = 2048
BATCH = 8
SEQ = 2048
DEPTH = 1

MIX_WIDTH = D_MODEL
SSD_WIDTH = MIX_WIDTH // 2
ATTN_WIDTH = MIX_WIDTH - SSD_WIDTH
SSD_HEAD_DIM = 64
SSD_HEADS = SSD_WIDTH // SSD_HEAD_DIM
SSD_GROUPS = 2
SSD_STATE = 128
SSD_CONV = 4
SSD_CHUNK = 128
SSD_CONV_DIM = SSD_WIDTH + 2 * SSD_GROUPS * SSD_STATE
ATTN_V_DIM = 128
ATTN_HEADS = ATTN_WIDTH // ATTN_V_DIM
ATTN_QK_DIM = ATTN_V_DIM // 2
ROPE_THETA = 500000.0
ROPE_DIM = ATTN_QK_DIM // 4
Q_BLOCK = 128
IN_COLS = SSD_WIDTH + SSD_CONV_DIM + SSD_HEADS + 3 * ATTN_WIDTH
N_EXPERT_GROUPS = 4
EXPERTS_PER_GROUP = 8
N_EXPERTS = N_EXPERT_GROUPS * EXPERTS_PER_GROUP
TOP_K = 2
EXPERT_HIDDEN = D_MODEL // 2
EPS = 1e-6

kernel_name = "hybrid_ssd_diffattn_hmoe_layer"


def rms_norm(x, w, eps=EPS):
    xf = x.astype(jnp.float32)
    y = xf * lax.rsqrt(jnp.mean(xf * xf, axis=-1, keepdims=True) + eps)
    return (y * w.astype(jnp.float32)).astype(x.dtype)


def lambda_init_fn(layer_idx):
    return 0.8 - 0.6 * math.exp(-0.3 * layer_idx)


def partial_rotary(t, positions):
    inv_freq = jnp.power(ROPE_THETA, -jnp.arange(0, ROPE_DIM, 2, dtype=jnp.float32) / ROPE_DIM)
    ang = positions.astype(jnp.float32)[..., None] * inv_freq
    cos = jnp.cos(ang)[:, :, None, None, :]
    sin = jnp.sin(ang)[:, :, None, None, :]
    half = ROPE_DIM // 2
    t1 = t[..., :half].astype(jnp.float32)
    t2 = t[..., half:ROPE_DIM].astype(jnp.float32)
    rot = jnp.concatenate([t1 * cos - t2 * sin, t2 * cos + t1 * sin], axis=-1).astype(t.dtype)
    return jnp.concatenate([rot, t[..., ROPE_DIM:]], axis=-1)


def causal_depthwise_conv(u, w, b):
    c = u.shape[-1]
    kern = w.reshape(SSD_CONV, 1, c).astype(u.dtype)
    y = lax.conv_general_dilated(u, kern, window_strides=(1,), padding=[(SSD_CONV - 1, 0)],
                                 dimension_numbers=('NWC', 'WIO', 'NWC'), feature_group_count=c)
    return y + b.astype(u.dtype)


def ssd_chunked(x, dt, A, Bm, Cm):
    b, s, h, p = x.shape
    g, n = Bm.shape[2], Bm.shape[3]
    hg = h // g
    c = s // SSD_CHUNK
    L = SSD_CHUNK
    xdt = (x * dt[..., None]).reshape(b, c, L, g, hg, p)
    a_cs = jnp.cumsum((dt * A).reshape(b, c, L, g, hg), axis=2)
    Bc = Bm.reshape(b, c, L, g, n)
    Cc = Cm.reshape(b, c, L, g, n)
    causal = jnp.tril(jnp.ones((L, L), dtype=bool))[None, None, :, :, None, None]
    seg = a_cs[:, :, :, None] - a_cs[:, :, None, :]
    decay = jnp.exp(jnp.where(causal, seg, -jnp.inf))
    cb = jnp.einsum('bclgn,bcsgn->bclsg', Cc, Bc)
    y_diag = jnp.einsum('bclsg,bclsgh,bcsghp->bclghp', cb, decay, xdt)
    decay_states = jnp.exp(a_cs[:, :, -1:] - a_cs)
    states = jnp.einsum('bclgn,bclgh,bclghp->bcghpn', Bc, decay_states, xdt)
    chunk_decay = jnp.exp(a_cs[:, :, -1])

    def step(carry, inp):
        st, dec = inp
        return carry * dec[..., None, None] + st, carry

    init = jnp.zeros((b, g, hg, p, n), dtype=x.dtype)
    _, prev = lax.scan(step, init, (jnp.moveaxis(states, 1, 0), jnp.moveaxis(chunk_decay, 1, 0)))
    prev = jnp.moveaxis(prev, 0, 1)
    y_off = jnp.einsum('bclgn,bcghpn,bclgh->bclghp', Cc, prev, jnp.exp(a_cs))
    return (y_diag + y_off).reshape(b, s, h, p)


def ssd_branch(z, xbc, dt_raw, conv_w, conv_b, dt_bias, a_log, d_skip, norm_w):
    bsz, s, _ = z.shape
    xbc = jax.nn.silu(causal_depthwise_conv(xbc, conv_w, conv_b))
    xs, Bm, Cm = jnp.split(xbc, [SSD_WIDTH, SSD_WIDTH + SSD_GROUPS * SSD_STATE], axis=-1)
    xs = xs.reshape(bsz, s, SSD_HEADS, SSD_HEAD_DIM).astype(jnp.float32)
    Bm = Bm.reshape(bsz, s, SSD_GROUPS, SSD_STATE).astype(jnp.float32)
    Cm = Cm.reshape(bsz, s, SSD_GROUPS, SSD_STATE).astype(jnp.float32)
    dt = jax.nn.softplus(dt_raw.astype(jnp.float32) + dt_bias.astype(jnp.float32))
    A = -jnp.exp(a_log.astype(jnp.float32))
    y = ssd_chunked(xs, dt, A, Bm, Cm) + xs * d_skip.astype(jnp.float32)[:, None]
    y = y.reshape(bsz, s, SSD_WIDTH) * jax.nn.silu(z.astype(jnp.float32))
    y = y.reshape(bsz, s, SSD_GROUPS, SSD_WIDTH // SSD_GROUPS)
    y = y * lax.rsqrt(jnp.mean(y * y, axis=-1, keepdims=True) + EPS)
    y = y.reshape(bsz, s, SSD_WIDTH) * norm_w.astype(jnp.float32)
    return y.astype(z.dtype)


def diff_attention_branch(q, k, v, positions, q_norm_w, k_norm_w, lq1, lk1, lq2, lk2, subln_w, lam_init):
    bsz, s, _ = q.shape
    q = q.reshape(bsz, s, ATTN_HEADS, 2, ATTN_QK_DIM)
    k = k.reshape(bsz, s, ATTN_HEADS, 2, ATTN_QK_DIM)
    v = v.reshape(bsz, s, ATTN_HEADS, ATTN_V_DIM)
    q = partial_rotary(rms_norm(q, q_norm_w), positions)
    k = partial_rotary(rms_norm(k, k_norm_w), positions)
    f32 = jnp.float32
    lam = (jnp.exp(jnp.sum(lq1.astype(f32) * lk1.astype(f32)))
           - jnp.exp(jnp.sum(lq2.astype(f32) * lk2.astype(f32))) + lam_init)
    scale = 1.0 / math.sqrt(ATTN_QK_DIM)
    outs = []
    for start in range(0, s, Q_BLOCK):
        end = start + Q_BLOCK
        sc = jnp.einsum('bqhcd,bkhcd->bhcqk', q[:, start:end], k[:, :end]).astype(f32) * scale
        mask = (start + jnp.arange(Q_BLOCK))[:, None] >= jnp.arange(end)[None, :]
        pr = jax.nn.softmax(jnp.where(mask, sc, -jnp.inf), axis=-1)
        att = pr[:, :, 0] - lam * pr[:, :, 1]
        outs.append(jnp.einsum('bhqk,bkhd->bqhd', att.astype(v.dtype), v[:, :end]))
    o = jnp.concatenate(outs, axis=1)
    o = rms_norm(o, subln_w) * (1.0 - lam_init)
    return o.reshape(bsz, s, ATTN_WIDTH)


def hierarchical_moe(x, w_rg, b_rg, w_re, b_re, w_gate, w_up, w_down):
    bsz, s, d = x.shape
    xt = x.reshape(-1, d)
    n = xt.shape[0]
    g_logits = (xt @ w_rg).astype(jnp.float32) + b_rg.astype(jnp.float32)
    g_prob = jax.nn.softmax(g_logits, axis=-1)
    g_sel = jnp.argmax(g_logits, axis=-1)
    g_w = jnp.take_along_axis(g_prob, g_sel[:, None], axis=-1)
    e_logits = ((xt @ w_re).astype(jnp.float32) + b_re.astype(jnp.float32)).reshape(n, N_EXPERT_GROUPS, EXPERTS_PER_GROUP)
    e_in = jnp.take_along_axis(e_logits, g_sel[:, None, None], axis=1)[:, 0]
    top_p, top_i = lax.top_k(jax.nn.softmax(e_in, axis=-1), TOP_K)
    weights = top_p / jnp.sum(top_p, axis=-1, keepdims=True) * g_w
    expert = (g_sel[:, None] * EXPERTS_PER_GROUP + top_i).reshape(-1)
    order = jnp.argsort(expert)
    tok = order // TOP_K
    sizes = jnp.bincount(expert, length=N_EXPERTS).astype(jnp.int32)
    xs = xt[tok]
    hid = jax.nn.silu(lax.ragged_dot(xs, w_gate, sizes)) * lax.ragged_dot(xs, w_up, sizes)
    ys = lax.ragged_dot(hid, w_down, sizes) * weights.reshape(-1)[order][:, None].astype(x.dtype)
    out = jnp.zeros_like(xt).at[tok].add(ys)
    return out.reshape(bsz, s, d)


def setup_inputs(seed: int = 0) -> dict:
    key = jax.random.key(seed)
    ks = jax.random.split(key, 32)
    f32 = jnp.float32
    nrm = lambda k, shape, sc: jax.random.normal(k, shape, f32) * sc
    x = jax.random.normal(ks[0], (BATCH, SEQ, D_MODEL), f32)
    offs = jax.random.randint(ks[1], (BATCH, 1), 0, 4096, dtype=jnp.int32)
    positions = (offs + jnp.arange(SEQ, dtype=jnp.int32)[None, :]).astype(jnp.int32)
    dt0 = jnp.exp(jax.random.uniform(ks[6], (DEPTH, SSD_HEADS), f32, math.log(1e-3), math.log(1e-1)))
    return {
        'x': x,
        'positions': positions,
        'ln1_w': 1.0 + nrm(ks[2], (DEPTH, D_MODEL), 0.02),
        'w_in': nrm(ks[3], (DEPTH, D_MODEL, IN_COLS), D_MODEL ** -0.5),
        'conv_w': nrm(ks[4], (DEPTH, SSD_CONV, SSD_CONV_DIM), SSD_CONV ** -0.5),
        'conv_b': nrm(ks[5], (DEPTH, SSD_CONV_DIM), 0.02),
        'dt_bias': dt0 + jnp.log(-jnp.expm1(-dt0)),
        'a_log': jnp.log(jax.random.uniform(ks[7], (DEPTH, SSD_HEADS), f32, 1.0, 16.0)),
        'd_skip': 1.0 + nrm(ks[8], (DEPTH, SSD_HEADS), 0.02),
        'ssd_norm_w': 1.0 + nrm(ks[9], (DEPTH, SSD_WIDTH), 0.02),
        'q_norm_w': 1.0 + nrm(ks[10], (DEPTH, ATTN_QK_DIM), 0.02),
        'k_norm_w': 1.0 + nrm(ks[11], (DEPTH, ATTN_QK_DIM), 0.02),
        'lambda_q1': nrm(ks[12], (DEPTH, ATTN_QK_DIM), 0.1),
        'lambda_k1': nrm(ks[13], (DEPTH, ATTN_QK_DIM), 0.1),
        'lambda_q2': nrm(ks[14], (DEPTH, ATTN_QK_DIM), 0.1),
        'lambda_k2': nrm(ks[15], (DEPTH, ATTN_QK_DIM), 0.1),
        'subln_w': 1.0 + nrm(ks[16], (DEPTH, ATTN_V_DIM), 0.02),
        'w_out': nrm(ks[17], (DEPTH, MIX_WIDTH, D_MODEL), MIX_WIDTH ** -0.5),
        'ln2_w': 1.0 + nrm(ks[18], (DEPTH, D_MODEL), 0.02),
        'w_router_group': nrm(ks[19], (DEPTH, D_MODEL, N_EXPERT_GROUPS), D_MODEL ** -0.5),
        'b_router_group': nrm(ks[20], (DEPTH, N_EXPERT_GROUPS), 0.01),
        'w_router_expert': nrm(ks[21], (DEPTH, D_MODEL, N_EXPERTS), D_MODEL ** -0.5),
        'b_router_expert': nrm(ks[22], (DEPTH, N_EXPERTS), 0.01),
        'w_gate': nrm(ks[23], (DEPTH, N_EXPERTS, D_MODEL, EXPERT_HIDDEN), D_MODEL ** -0.5),
        'w_up': nrm(ks[24], (DEPTH, N_EXPERTS, D_MODEL, EXPERT_HIDDEN), D_MODEL ** -0.5),
        'w_down': nrm(ks[25], (DEPTH, N_EXPERTS, EXPERT_HIDDEN, D_MODEL), EXPERT_HIDDEN ** -0.5),
    }


def reference(x, positions, ln1_w, w_in, conv_w, conv_b, dt_bias, a_log, d_skip, ssd_norm_w,
              q_norm_w, k_norm_w, lambda_q1, lambda_k1, lambda_q2, lambda_k2, subln_w, w_out,
              ln2_w, w_router_group, b_router_group, w_router_expert, b_router_expert,
              w_gate, w_up, w_down):
    splits = np.cumsum([SSD_WIDTH, SSD_CONV_DIM, SSD_HEADS, ATTN_WIDTH, ATTN_WIDTH]).tolist()
    for l in range(DEPTH):
        u = rms_norm(x, ln1_w[l]) @ w_in[l]
        z, xbc, dt_raw, q, k, v = jnp.split(u, splits, axis=-1)
        y_ssd = ssd_branch(z, xbc, dt_raw, conv_w[l], conv_b[l], dt_bias[l], a_log[l], d_skip[l], ssd_norm_w[l])
        y_att = diff_attention_branch(q, k, v, positions, q_norm_w[l], k_norm_w[l], lambda_q1[l], lambda_k1[l],
                                      lambda_q2[l], lambda_k2[l], subln_w[l], lambda_init_fn(l))
        h = x + jnp.concatenate([y_ssd, y_att], axis=-1) @ w_out[l]
        x = h + hierarchical_moe(rms_norm(h, ln2_w[l]), w_router_group[l], b_router_group[l],
                                 w_router_expert[l], b_router_expert[l], w_gate[l], w_up[l], w_down[l])
    return x
```

```cpp
#include <hip/hip_runtime.h>
#include <hip/hip_bf16.h>
#include <math.h>
#include <stdint.h>
#include <cstdio>
#include <cmath>
namespace pg8 {
#define PG8_LAS __attribute__((address_space(3)))
typedef unsigned short bf16_t;
typedef short bf16x8 __attribute__((ext_vector_type(8)));
typedef float f32x4 __attribute__((ext_vector_type(4)));
typedef unsigned u32x4 __attribute__((ext_vector_type(4)));
typedef int v8i_t __attribute__((ext_vector_type(8)));
constexpr int BM = 256, BK = 64, HALF = 128, HTB = HALF * BK * 2  , STAGE_BYTES = 8 * HTB, NXCD = 8, WGM = 8;

__host__ __device__ __forceinline__ int lds_byte(int r, int c) { const int st = (r >> 4) * 2 + (c >> 5), rr = r & 15, cc = c & 31, ob = rr * 64 + cc * 2; return st * 1024 + (ob ^ (((ob >> 9) & 1) << 5)); }
__host__ __device__ __forceinline__ void stage_rc(int b, int& R, int& C) { const int st = b / 1024, sb = b % 1024, swz = sb ^ (((sb >> 9) & 1) << 5); R = (st >> 1) * 16 + swz / 64; C = (st & 1) * 32 + (swz % 64) / 2; }
__host__ __device__ __forceinline__ int perm32(int rho) { const int n = rho >> 4, i = rho & 15; return 8 * (i >> 2) + 4 * n + (i & 3); }

struct Unit { int pm, pn; };
struct Gemm { const bf16_t* A; const bf16_t* Bt; int M, N, K; };

struct StaticOrder {
    int nM, nN, nwg, G, c;
    __host__ __device__ void init(int M, int N, int G_, int c_) { nM = M / BM; nN = N / BM; nwg = nM * nN; G = G_; c = c_; }
    __host__ __device__ bool next(int i, Unit& u) const {
        const long L = (long)i * G + c; if (L >= nwg) return false;
        int wgid = (int)L; { const int q = nwg / NXCD, r = nwg % NXCD, xcd = wgid % NXCD, off = wgid / NXCD; wgid = (xcd < r ? xcd * (q + 1) : r * (q + 1) + (xcd - r) * q) + off; }
        const int nig = WGM * nN, gid = wgid / nig, fm = gid * WGM, gsz = (nM - fm) < WGM ? (nM - fm) : WGM;
        u.pm = fm + ((wgid % nig) % gsz); u.pn = (wgid % nig) / gsz; return true;
    }
    __device__ __forceinline__ void a_ready(const Unit&) const {}
    __device__ __forceinline__ void done(const Unit&) const {}
};

__device__ __forceinline__ unsigned cvt_pk_bf16(float lo, float hi) { unsigned r; asm volatile("v_cvt_pk_bf16_f32 %0, %1, %2" : "=v"(r) : "v"(lo), "v"(hi)); return r; }
typedef float f32x2 __attribute__((ext_vector_type(2)));
__device__ __forceinline__ f32x2 gelu_pk(f32x2 v) {
    const f32x2 av = __builtin_elementwise_abs(v), d = av * 0.2316418882f + 1.0f;
    f32x2 t; t.x = __builtin_amdgcn_rcpf(d.x); t.y = __builtin_amdgcn_rcpf(d.y);
    f32x2 q = t * 0.5307027145f + (-0.7265760135f); q = q * t + 0.7107068705f; q = q * t + (-0.142248368f); q = q * t + 0.127414796f; q = q * t;
    const f32x2 s = (v * v) * (-0.72134752044f);
    f32x2 e; e.x = __builtin_amdgcn_exp2f(s.x); e.y = __builtin_amdgcn_exp2f(s.y);
    const f32x2 m = v * (q * e), r = v - m;
    f32x2 o; o.x = v.x < 0.f ? m.x : r.x; o.y = v.y < 0.f ? m.y : r.y; return o;
}

template <int ACT  > struct EpiBf16 {
    static constexpr bool PERM = true, AFTER_DRAIN = false; static_assert(ACT == 0 || ACT == 1, "EpiBf16: ACT is 0 (none) or 1 (gelu_pk)");
    bf16_t* O; int ldc; const float* bias; int split_cols; size_t split_stride; float scale0;
    __device__ __forceinline__ void operator()(const f32x4 (&acc)[2][2][4][2], const Unit& u, int wr, int wc, int fr, int fq) const {
        const int row0 = u.pm * BM + wr * 64 + fr; int colt = u.pn * BM; bf16_t* base = O;
        float sc = 1.f; if (split_cols) { const int t = colt / split_cols; base += (size_t)t * split_stride; colt -= t * split_cols; if (t == 0) sc = scale0; }
        const int col0 = colt + wc * 32 + 8 * fq, bcol0 = u.pn * BM + wc * 32 + 8 * fq;
        f32x4 bv[2][2];
#pragma unroll
        for (int bj = 0; bj < 2; ++bj)
#pragma unroll
            for (int n = 0; n < 2; ++n) bv[bj][n] = bias ? *(const f32x4*)(bias + bcol0 + bj * HALF + 4 * n) : (f32x4){0.f, 0.f, 0.f, 0.f};
#pragma unroll
        for (int ai = 0; ai < 2; ++ai)
#pragma unroll
            for (int m = 0; m < 4; ++m) { bf16_t* rowp = base + (size_t)(row0 + ai * HALF + m * 16) * ldc + col0;
#pragma unroll
                for (int bj = 0; bj < 2; ++bj) { f32x4 v0 = acc[ai][bj][m][0] + bv[bj][0], v1 = acc[ai][bj][m][1] + bv[bj][1];
                    if (ACT == 1) { f32x2 a = gelu_pk((f32x2){v0[0], v0[1]}), b = gelu_pk((f32x2){v0[2], v0[3]}), c = gelu_pk((f32x2){v1[0], v1[1]}), d = gelu_pk((f32x2){v1[2], v1[3]});
                        v0 = (f32x4){a.x, a.y, b.x, b.y}; v1 = (f32x4){c.x, c.y, d.x, d.y}; }
                    v0 = v0 * sc; v1 = v1 * sc; u32x4 w; w.x = cvt_pk_bf16(v0[0], v0[1]); w.y = cvt_pk_bf16(v0[2], v0[3]); w.z = cvt_pk_bf16(v1[0], v1[1]); w.w = cvt_pk_bf16(v1[2], v1[3]);
                    *(u32x4*)(rowp + bj * HALF) = w; } }
    }
};

struct ConvNone { static constexpr bool ON = false; static constexpr int LDS_OFF = 0; };
template <class Epi, class Sched, bool ALIGN_EPI = false, bool SP2 = false, bool F8 = false, class CV = ConvNone>
__device__ __forceinline__ void gemm_phase(PG8_LAS unsigned char* lds, const Gemm g, const Sched& S, const Epi& E, const CV& cv = CV{}) {
    static_assert(!CV::ON || SP2, "the side job's vmcnt arithmetic is written for the SP2 schedule");
    const int tid = threadIdx.x, wid = __builtin_amdgcn_readfirstlane(tid >> 6), lane = tid & 63, wr = wid >> 2, wc = wid & 3, fr = lane & 15, fq = lane >> 4;
    const int K = g.K, nt = K / BK;
    unsigned voffA[2], voffB[2];
#pragma unroll
    for (int i = 0; i < 2; ++i) { int R, C; stage_rc(tid * 16 + i * 8192, R, C); const int Rb = Epi::PERM ? ((R & ~31) + perm32(R & 31)) : R;
        voffA[i] = (unsigned)(R * K + C) * 2u; voffB[i] = (unsigned)(Rb * K + C) * 2u; }
    const size_t kstep = (size_t)(BK * 2);
    const size_t hstep = (size_t)HALF * K * 2;
    const size_t tstep = 2 * hstep;
    const unsigned ldsw = (unsigned)wid * 1024u;
    const int aoff = lds_byte(wr * 64 + fr, fq * 8), boff = lds_byte(wc * 32 + fr, fq * 8);
#define PG8_CAT8(x, y) __builtin_bit_cast(v8i_t, __builtin_shufflevector((x), (y), 0, 1, 2, 3, 4, 5, 6, 7, 8, 9, 10, 11, 12, 13, 14, 15))
#define PG8_SA(b, h) (((b) * 2 + (h)) * HTB)
#define PG8_SB(b, h) ((4 + (b) * 2 + (h)) * HTB)
#define PG8_STAGE(bufoff, gbase, voff) do { _Pragma("unroll") for (int _i = 0; _i < 2; ++_i) \
        __builtin_amdgcn_global_load_lds((const unsigned*)((const char*)(gbase) + (voff)[_i]), (PG8_LAS unsigned*)(lds + (bufoff) + ldsw + _i * 8192), 16, 0, 0); } while (0)
#define PG8_LDA(dst, b, h) do { if constexpr (F8) { _Pragma("unroll") for (int m = 0; m < 4; ++m) dst##8[m] = PG8_CAT8(*(const PG8_LAS bf16x8*)(lds + PG8_SA(b, h) + aoff + m * 2048), *(const PG8_LAS bf16x8*)(lds + PG8_SA(b, h) + aoff + m * 2048 + 1024)); } else _Pragma("unroll") for (int m = 0; m < 4; ++m) _Pragma("unroll") for (int k = 0; k < 2; ++k) dst[m][k] = *(const PG8_LAS bf16x8*)(lds + PG8_SA(b, h) + aoff + m * 2048 + k * 1024); } while (0)
#define PG8_LDB(dst, b, h) do { if constexpr (F8) { _Pragma("unroll") for (int n = 0; n < 2; ++n) dst##8[n] = PG8_CAT8(*(const PG8_LAS bf16x8*)(lds + PG8_SB(b, h) + boff + n * 2048), *(const PG8_LAS bf16x8*)(lds + PG8_SB(b, h) + boff + n * 2048 + 1024)); } else _Pragma("unroll") for (int n = 0; n < 2; ++n) _Pragma("unroll") for (int k = 0; k < 2; ++k) dst[n][k] = *(const PG8_LAS bf16x8*)(lds + PG8_SB(b, h) + boff + n * 2048 + k * 1024); } while (0)
#define PG8_MMA(ai, bj, At, Bt) do { __builtin_amdgcn_s_setprio(1); \
        if constexpr (F8) { _Pragma("unroll") for (int m = 0; m < 4; ++m) _Pragma("unroll") for (int n = 0; n < 2; ++n) \
            asm volatile("v_mfma_f32_16x16x128_f8f6f4 %0, %1, %2, %0" : "+v"(acc[ai][bj][m][n]) : "v"(Bt##8[n]), "v"(At##8[m])); }     \
        else { _Pragma("unroll") for (int m = 0; m < 4; ++m) _Pragma("unroll") for (int n = 0; n < 2; ++n) _Pragma("unroll") for (int k = 0; k < 2; ++k) \
            acc[ai][bj][m][n] = __builtin_amdgcn_mfma_f32_16x16x32_bf16(Bt[n][k], At[m][k], acc[ai][bj][m][n], 0, 0, 0); } \
        __builtin_amdgcn_s_setprio(0); } while (0)
#define PG8_WAIT_V(n) asm volatile("s_waitcnt vmcnt(" #n ")" ::: "memory")
#define PG8_WAIT_L(n) asm volatile("s_waitcnt lgkmcnt(" #n ")" ::: "memory")
#define PG8_BAR __builtin_amdgcn_s_barrier()
#define PG8_SCHED __builtin_amdgcn_sched_barrier(0)
    Unit cur, nxt; int ui = 0;
    if (!S.next(0, cur)) return;
    f32x4 acc[2][2][4][2];
#pragma unroll
    for (int a = 0; a < 2; ++a)
#pragma unroll
        for (int b = 0; b < 2; ++b)
#pragma unroll
            for (int m = 0; m < 4; ++m)
#pragma unroll
                for (int n = 0; n < 2; ++n) acc[a][b][m][n] = (f32x4){0.f, 0.f, 0.f, 0.f};
    bf16x8 At[4][2], B0[2][2], B1[2][2];
    v8i_t At8[4], B08[2], B18[2];
    const char* cA = (const char*)g.A + (size_t)cur.pm * tstep; const char* cB = (const char*)g.Bt + (size_t)cur.pn * tstep;
    S.a_ready(cur);
    typedef float cvf2 __attribute__((ext_vector_type(2))); typedef unsigned cvu2 __attribute__((ext_vector_type(2)));
    cvu2 cvo0 = {0u, 0u}, cvo1 = {0u, 0u};
    const char* cv_sb = nullptr; unsigned cv_sv = 0, cv_db = 0, cv_dv = 0, cv_stb = 0, cv_stv = 0; int cv_dn = 0, cv_stdn = 0;
    unsigned char* cv_ws = nullptr; unsigned cv_slot = 0;
    PG8_LAS unsigned char* const cv_lds = lds + CV::LDS_OFF + wid * 3072;
    if constexpr (CV::ON) { cv.decode(cur, wid, lane, cv_sb, cv_dn, cv_db, cv_dv, cv_sv); cv_ws = cv.wsbase(); cv_stb = CV::DUMMY_OFF; cv_stdn = 0; cv_stv = (unsigned)tid * 16u; }
#define CV_LD(slot) do { if constexpr (CV::ON) { \
        __builtin_amdgcn_global_load_lds((const unsigned*)(cv_sb + (size_t)((2 * slot) * (cv_dn ? 8192u : 4096u)) + cv_sv), (PG8_LAS unsigned*)(cv_lds + cv_slot), 16, 0, 0); \
        cv_slot = cv_slot == 2048u ? 0u : cv_slot + 1024u; } } while (0)
#define CV_CVT(slot, dw, hi) do { if constexpr (CV::ON) { \
        const cvf2 ra_ = *(const PG8_LAS cvf2*)(cv_lds + cv_slot + lane * 8), rb_ = *(const PG8_LAS cvf2*)(cv_lds + cv_slot + 512 + lane * 8); \
        cvo0[dw] = (unsigned)__builtin_amdgcn_cvt_pk_fp8_f32(ra_.x * CV::SCALE, rb_.x * CV::SCALE, (int)cvo0[dw], hi); \
        cvo1[dw] = (unsigned)__builtin_amdgcn_cvt_pk_fp8_f32(ra_.y * CV::SCALE, rb_.y * CV::SCALE, (int)cvo1[dw], hi); } } while (0)
#define CV_ST() do { if constexpr (CV::ON) { unsigned char* p_ = cv_ws + cv_stb; *(__attribute__((address_space(1))) cvu2*)(p_ + cv_stv) = cvo0; *(__attribute__((address_space(1))) cvu2*)(p_ + (cv_stdn ? 1024u : 2048u) + cv_stv) = cvo1; } } while (0)
    if constexpr (SP2) {
        PG8_STAGE(PG8_SB(0, 0), cB, voffB); PG8_STAGE(PG8_SB(0, 1), cB + hstep, voffB); PG8_STAGE(PG8_SA(0, 0), cA, voffA); PG8_STAGE(PG8_SA(0, 1), cA + hstep, voffA);
        if (wr == 1) PG8_BAR;
        PG8_WAIT_V(2); PG8_BAR;
        PG8_STAGE(PG8_SB(1, 0), cB + kstep, voffB); PG8_STAGE(PG8_SA(1, 0), cA + kstep, voffA); PG8_STAGE(PG8_SB(1, 1), cB + hstep + kstep, voffB);
        PG8_WAIT_V(6); PG8_BAR;
    } else {
        PG8_STAGE(PG8_SB(0, 0), cB, voffB); PG8_STAGE(PG8_SA(0, 0), cA, voffA); PG8_STAGE(PG8_SB(0, 1), cB + hstep, voffB); PG8_STAGE(PG8_SA(0, 1), cA + hstep, voffA);
        if (wr == 1) PG8_BAR;
        PG8_WAIT_V(4); PG8_BAR;
        PG8_STAGE(PG8_SB(1, 0), cB + kstep, voffB); PG8_STAGE(PG8_SA(1, 0), cA + kstep, voffA); PG8_STAGE(PG8_SB(1, 1), cB + hstep + kstep, voffB);
        PG8_WAIT_V(6); PG8_BAR;
    }
    for (;;) {
        const bool has_next = S.next(ui + 1, nxt);
        const char* nA = has_next ? (const char*)g.A + (size_t)nxt.pm * tstep : cA; const char* nB = has_next ? (const char*)g.Bt + (size_t)nxt.pn * tstep : cB;
#pragma clang loop unroll(disable)
        for (int t = 0; t < nt; t += 2) {
            const bool last = (t == nt - 2);
            const char* a1 = cA + (size_t)(t + 1) * kstep;
            const char* a2 = last ? nA : cA + (size_t)(t + 2) * kstep; const char* b2 = last ? nB : cB + (size_t)(t + 2) * kstep;
            const char* a3 = a2 + kstep; const char* b3 = b2 + kstep;
            if (last && has_next) S.a_ready(nxt);
            if constexpr (SP2) {
            PG8_LDB(B0, 0, 0); PG8_LDB(B1, 0, 1); PG8_SCHED; PG8_LDA(At, 0, 0); PG8_STAGE(PG8_SA(1, 1), a1 + hstep, voffA); CV_LD(0);
            if constexpr (CV::ON) PG8_WAIT_V(10); else PG8_WAIT_V(8);
            PG8_WAIT_L(0); PG8_BAR; PG8_MMA(0, 0, At, B0); PG8_MMA(0, 1, At, B1); CV_CVT(2, 1, false); PG8_BAR; PG8_SCHED;
            PG8_LDA(At, 0, 1); PG8_STAGE(PG8_SB(0, 0), b2, voffB); PG8_STAGE(PG8_SB(0, 1), b2 + hstep, voffB); PG8_STAGE(PG8_SA(0, 0), a2, voffA); CV_LD(1);
            if constexpr (CV::ON) PG8_WAIT_V(10); else PG8_WAIT_V(8);
            PG8_WAIT_L(0); PG8_BAR; PG8_MMA(1, 0, At, B0); PG8_MMA(1, 1, At, B1); CV_CVT(3, 1, true); PG8_BAR; PG8_SCHED;
            CV_ST(); if constexpr (CV::ON) { cv_stb = cv_db + 4 * t; cv_stdn = cv_dn; cv_stv = cv_dv; }
            PG8_LDB(B0, 1, 0); PG8_LDB(B1, 1, 1); PG8_SCHED; PG8_LDA(At, 1, 0); PG8_STAGE(PG8_SA(0, 1), a2 + hstep, voffA); CV_LD(2);
            if constexpr (CV::ON) PG8_WAIT_V(12); else PG8_WAIT_V(8);
            PG8_WAIT_L(0); PG8_BAR; PG8_MMA(0, 0, At, B0); PG8_MMA(0, 1, At, B1); CV_CVT(0, 0, false); PG8_BAR; PG8_SCHED;
            PG8_LDA(At, 1, 1); PG8_STAGE(PG8_SB(1, 0), b3, voffB); PG8_STAGE(PG8_SB(1, 1), b3 + hstep, voffB); PG8_STAGE(PG8_SA(1, 0), a3, voffA); CV_LD(3);
            if constexpr (CV::ON) PG8_WAIT_V(12); else PG8_WAIT_V(8);
            PG8_WAIT_L(0); PG8_BAR; PG8_MMA(1, 0, At, B0); PG8_MMA(1, 1, At, B1); CV_CVT(1, 0, true); PG8_BAR; PG8_SCHED;
            if constexpr (CV::ON) cv_sb += cv_dn ? 65536 : 32768;
            } else {
            PG8_LDB(B0, 0, 0); PG8_SCHED; PG8_LDA(At, 0, 0); PG8_STAGE(PG8_SA(1, 1), a1 + hstep, voffA);
            PG8_WAIT_L(8); PG8_BAR; PG8_WAIT_L(0); PG8_MMA(0, 0, At, B0); PG8_BAR; PG8_SCHED;
            PG8_LDB(B1, 0, 1); PG8_STAGE(PG8_SB(0, 0), b2, voffB);
            PG8_BAR; PG8_WAIT_L(0); PG8_MMA(0, 1, At, B1); PG8_BAR;
            PG8_LDA(At, 0, 1); PG8_STAGE(PG8_SA(0, 0), a2, voffA);
            PG8_BAR; PG8_WAIT_L(0); PG8_MMA(1, 0, At, B0); PG8_BAR; PG8_SCHED;
            PG8_STAGE(PG8_SB(0, 1), b2 + hstep, voffB);
            PG8_WAIT_V(6); PG8_BAR; PG8_MMA(1, 1, At, B1); PG8_BAR;
            PG8_LDB(B0, 1, 0); PG8_SCHED; PG8_LDA(At, 1, 0); PG8_STAGE(PG8_SA(0, 1), a2 + hstep, voffA);
            PG8_WAIT_L(8); PG8_BAR; PG8_WAIT_L(0); PG8_MMA(0, 0, At, B0); PG8_BAR; PG8_SCHED;
            PG8_LDB(B1, 1, 1); PG8_STAGE(PG8_SB(1, 0), b3, voffB);
            PG8_BAR; PG8_WAIT_L(0); PG8_MMA(0, 1, At, B1); PG8_BAR;
            PG8_LDA(At, 1, 1); PG8_STAGE(PG8_SA(1, 0), a3, voffA);
            PG8_BAR; PG8_WAIT_L(0); PG8_MMA(1, 0, At, B0); PG8_BAR; PG8_SCHED;
            PG8_STAGE(PG8_SB(1, 1), b3 + hstep, voffB);
            PG8_WAIT_V(6); PG8_BAR; PG8_MMA(1, 1, At, B1); PG8_BAR;
            }
        }
        if constexpr (F8) asm volatile("s_nop 15\n\ts_nop 7" ::: "memory");
        if constexpr (ALIGN_EPI) { if (wr == 0) PG8_BAR; }
        if constexpr (!Epi::AFTER_DRAIN) { int fr_ = fr, fq_ = fq; asm volatile("" : "+v"(fr_), "+v"(fq_));
            E(acc, cur, wr, wc, fr_, fq_); S.done(cur); }
        if (!has_next) break;
#pragma unroll
        for (int a = 0; a < 2; ++a)
#pragma unroll
            for (int b = 0; b < 2; ++b)
#pragma unroll
                for (int m = 0; m < 4; ++m)
#pragma unroll
                    for (int n = 0; n < 2; ++n) acc[a][b][m][n] = (f32x4){0.f, 0.f, 0.f, 0.f};
        cur = nxt; cA = nA; cB = nB; ++ui;
        if constexpr (CV::ON) cv.decode(cur, wid, lane, cv_sb, cv_dn, cv_db, cv_dv, cv_sv);
        if constexpr (ALIGN_EPI) { if (wr == 1) PG8_BAR; }
    }
    PG8_WAIT_V(0);
    if constexpr (CV::ON) { cv_slot = cv_slot == 2048u ? 0u : cv_slot + 1024u; CV_CVT(2, 1, false); cv_slot = cv_slot == 2048u ? 0u : cv_slot + 1024u; CV_CVT(3, 1, true); CV_ST(); }
    if constexpr (!ALIGN_EPI) { if (wr == 0) PG8_BAR; }
    PG8_BAR;
    if constexpr (Epi::AFTER_DRAIN) { E.fused(acc, cur, wr, wc, fr, fq, lds, wid, lane); S.done(cur); }
#undef PG8_SA
#undef PG8_SB
#undef PG8_STAGE
#undef PG8_LDA
#undef PG8_LDB
#undef PG8_MMA
#undef PG8_CAT8
#undef PG8_WAIT_V
#undef PG8_WAIT_L
#undef PG8_BAR
#undef PG8_SCHED
#undef CV_LD
#undef CV_CVT
#undef CV_ST
}
}

namespace pg8 {
__device__ __forceinline__ void store16_wt(void* p, u32x4 v) { asm volatile("global_store_dwordx4 %0, %1, off sc1\n\ts_nop 1" :: "v"(p), "v"(v) : "memory"); }
__device__ __forceinline__ float clamp_f8(float v) { return __builtin_fminf(__builtin_fmaxf(v, -448.f), 448.f); }
__device__ __forceinline__ unsigned cvt4_fp8(float a, float b, float c, float d) { int w = 0; w = __builtin_amdgcn_cvt_pk_fp8_f32(a, b, w, false); w = __builtin_amdgcn_cvt_pk_fp8_f32(c, d, w, true); return (unsigned)w; }
__device__ __forceinline__ unsigned cvt4_fp8c(float a, float b, float c, float d) { return cvt4_fp8(clamp_f8(a), clamp_f8(b), clamp_f8(c), clamp_f8(d)); }
struct EpiInProj {
    static constexpr bool PERM = true, AFTER_DRAIN = false;
    bf16_t* O; int ldc; float* DT;
    __device__ __forceinline__ void operator()(const f32x4 (&acc)[2][2][4][2], const Unit& u, int wr, int wc, int fr, int fq) const {
        const int row0 = u.pm * BM + wr * 64 + fr;
        if (u.pn == 22) {
            if (wc == 0 && fq < 2) {
#pragma unroll
                for (int ai = 0; ai < 2; ++ai)
#pragma unroll
                    for (int m = 0; m < 4; ++m) { float* dp = DT + (size_t)(row0 + ai * HALF + m * 16) * 16 + 8 * fq; *(f32x4*)dp = acc[ai][0][m][0]; *(f32x4*)(dp + 4) = acc[ai][0][m][1]; } }
            return; }
        const int col0 = u.pn * BM + wc * 32 + 8 * fq;
#pragma unroll
        for (int ai = 0; ai < 2; ++ai)
#pragma unroll
            for (int m = 0; m < 4; ++m) { bf16_t* rowp = O + (size_t)(row0 + ai * HALF + m * 16) * ldc + col0;
#pragma unroll
                for (int bj = 0; bj < 2; ++bj) { const f32x4 v0 = acc[ai][bj][m][0], v1 = acc[ai][bj][m][1];
                    u32x4 w; w.x = cvt_pk_bf16(v0[0], v0[1]); w.y = cvt_pk_bf16(v0[2], v0[3]); w.z = cvt_pk_bf16(v1[0], v1[1]); w.w = cvt_pk_bf16(v1[2], v1[3]);
                    *(u32x4*)(rowp + bj * HALF) = w; } }
    }
};
struct EpiResid {
    static constexpr bool PERM = true, AFTER_DRAIN = false;
    const float* base; bf16_t* hb; unsigned char* h8; int ldc; const float* cs;
    __device__ __forceinline__ void operator()(const f32x4 (&acc)[2][2][4][2], const Unit& u, int wr, int wc, int fr, int fq) const {
        const int row0 = u.pm * BM + wr * 64 + fr, col0 = u.pn * BM + wc * 32 + 8 * fq;
        typedef unsigned u32x2_t __attribute__((ext_vector_type(2)));
        f32x4 csv[2][2];
#pragma unroll
        for (int bj = 0; bj < 2; ++bj) { csv[bj][0] = *(const f32x4*)(cs + col0 + bj * HALF); csv[bj][1] = *(const f32x4*)(cs + col0 + bj * HALF + 4); }
#pragma unroll
        for (int ai = 0; ai < 2; ++ai) {
            f32x4 xr[4][2][2];
#pragma unroll
            for (int m = 0; m < 4; ++m) { const size_t off = (size_t)(row0 + ai * HALF + m * 16) * ldc + col0;
#pragma unroll
                for (int bj = 0; bj < 2; ++bj) { xr[m][bj][0] = __builtin_nontemporal_load((const f32x4*)(base + off + bj * HALF)); xr[m][bj][1] = __builtin_nontemporal_load((const f32x4*)(base + off + bj * HALF + 4)); } }
#pragma unroll
            for (int m = 0; m < 4; ++m) { const size_t off = (size_t)(row0 + ai * HALF + m * 16) * ldc + col0;
#pragma unroll
                for (int bj = 0; bj < 2; ++bj) {
                    const f32x4 v0 = acc[ai][bj][m][0] + xr[m][bj][0], v1 = acc[ai][bj][m][1] + xr[m][bj][1];
                    u32x4 w; w.x = cvt_pk_bf16(v0[0], v0[1]); w.y = cvt_pk_bf16(v0[2], v0[3]); w.z = cvt_pk_bf16(v1[0], v1[1]); w.w = cvt_pk_bf16(v1[2], v1[3]);
                    *(u32x4*)(hb + off + bj * HALF) = w;
                    const f32x4 s0 = v0 * csv[bj][0], s1 = v1 * csv[bj][1];
                    u32x2_t q; q.x = cvt4_fp8c(s0[0], s0[1], s0[2], s0[3]); q.y = cvt4_fp8c(s1[0], s1[1], s1[2], s1[3]);
                    *(u32x2_t*)(h8 + off + bj * HALF) = q; } }
        }
    }
};
struct ExpertScale {
    const PG8_LAS int* tab; const float* lst; int lcap;
    __device__ __forceinline__ float at(const Unit& u, int rowlocal) const { const int e = u.pn >> 3, p = (u.pm - tab[40 + e]) * BM + rowlocal; return p < tab[80 + e] ? lst[(size_t)e * lcap + p] : 0.f; }
};
struct EpiGateUp {
    static constexpr bool PERM = true, AFTER_DRAIN = false;
    unsigned char* O; int ldc; ExpertScale rs; float wsc;
    __device__ __forceinline__ void operator()(const f32x4 (&acc)[2][2][4][2], const Unit& u, int wr, int wc, int fr, int fq) const {
        const int rl0 = wr * 64 + fr, col0 = (u.pn & 7) * HALF + wc * 32 + 8 * fq;
        float rsc[2][4];
#pragma unroll
        for (int ai = 0; ai < 2; ++ai)
#pragma unroll
            for (int m = 0; m < 4; ++m) rsc[ai][m] = rs.at(u, rl0 + ai * HALF + m * 16) * wsc;
#pragma unroll
        for (int ai = 0; ai < 2; ++ai)
#pragma unroll
            for (int m = 0; m < 4; ++m) { const int rl = rl0 + ai * HALF + m * 16; const float r = rsc[ai][m];
                float hv[8];
#pragma unroll
                for (int n = 0; n < 2; ++n)
#pragma unroll
                    for (int j = 0; j < 4; ++j) { const float g = acc[ai][0][m][n][j] * r, up = acc[ai][1][m][n][j] * r; hv[n * 4 + j] = g * __builtin_amdgcn_rcpf(1.f + __builtin_amdgcn_exp2f(-1.44269504089f * g)) * up; }
                typedef unsigned u32x2_t __attribute__((ext_vector_type(2))); u32x2_t q; q.x = cvt4_fp8c(hv[0], hv[1], hv[2], hv[3]); q.y = cvt4_fp8c(hv[4], hv[5], hv[6], hv[7]);
                *(u32x2_t*)(O + (size_t)(u.pm * BM + rl) * ldc + col0) = q; }
    }
};
struct EpiRowScale {
    static constexpr bool PERM = true, AFTER_DRAIN = false;
    unsigned char* O; int ldc; ExpertScale rs; float wsc;
    __device__ __forceinline__ void operator()(const f32x4 (&acc)[2][2][4][2], const Unit& u, int wr, int wc, int fr, int fq) const {
        const int rl0 = wr * 64 + fr, col0 = (u.pn & 7) * BM + wc * 64 + 16 * fq;
        float rsc[2][4];
#pragma unroll
        for (int ai = 0; ai < 2; ++ai)
#pragma unroll
            for (int m = 0; m < 4; ++m) rsc[ai][m] = rs.at(u, rl0 + ai * HALF + m * 16) * wsc;
#pragma unroll
        for (int ai = 0; ai < 2; ++ai)
#pragma unroll
            for (int m = 0; m < 4; ++m) { const int rl = rl0 + ai * HALF + m * 16; const float r = rsc[ai][m];
                const f32x4 v0 = acc[ai][0][m][0] * r, v1 = acc[ai][0][m][1] * r, v2 = acc[ai][1][m][0] * r, v3 = acc[ai][1][m][1] * r;
                u32x4 q; q.x = cvt4_fp8c(v0[0], v0[1], v0[2], v0[3]); q.y = cvt4_fp8c(v1[0], v1[1], v1[2], v1[3]); q.z = cvt4_fp8c(v2[0], v2[1], v2[2], v2[3]); q.w = cvt4_fp8c(v3[0], v3[1], v3[2], v3[3]);
                *(u32x4*)(O + (size_t)(u.pm * BM + rl) * ldc + col0) = q; }
    }
};
struct ExpertOrder {
    const PG8_LAS int* tab; int nwg, G, c;
    __device__ __forceinline__ void init(const PG8_LAS int* t, int G_, int c_) { tab = t; nwg = t[32]; G = G_; c = c_; }
    __device__ __forceinline__ bool next(int i, Unit& u) const {
        const long L = (long)i * G + c; if (L >= nwg) return false;
        int wgid = (int)L; { const int q = nwg / NXCD, r = nwg % NXCD, xcd = wgid % NXCD, off = wgid / NXCD; wgid = (xcd < r ? xcd * (q + 1) : r * (q + 1) + (xcd - r) * q) + off; }
        const int tj = tab[threadIdx.x & 31];
        const int e = __builtin_popcountll(__ballot(wgid >= tj) & 0xffffffffull) - 1;
        const int local_i = wgid - tab[e], mt = (tab[e + 1] - tab[e]) >> 3;
        u.pm = tab[40 + e] + local_i % mt; u.pn = e * 8 + local_i / mt; return true;
    }
    __device__ __forceinline__ void a_ready(const Unit&) const {}
    __device__ __forceinline__ void done(const Unit&) const {}
};
struct TeamOrder {
    int c, i0, i1;
    __device__ __forceinline__ bool next(int i, Unit& u) const {
        i += i0; if (i >= i1) return false;
        const int xcd = c & 7, l = c >> 3; if (i * 32 + l >= 184) return false;
        int pmo, pn;
        if (i < 5) { const int t = l >> 3, j = l & 7; pmo = 4 * (t & 1) + (j & 3); pn = 4 * i + 2 * (t >> 1) + (j >> 2); }
        else { pmo = l & 7; pn = 20 + (l >> 3); }
        u.pm = 8 * xcd + pmo; u.pn = pn; return true;
    }
    __device__ __forceinline__ void a_ready(const Unit&) const {}
    __device__ __forceinline__ void done(const Unit&) const {}
};
template <class KArgs, int IN_GATE, size_t WGU_OFF, size_t WD_OFF, size_t DUMMY, int LDSOFF> struct ConvMoE {
    static constexpr bool ON = true; static constexpr float SCALE = 64.f;
    static constexpr unsigned DUMMY_OFF = (unsigned)DUMMY; static constexpr int LDS_OFF = LDSOFF; static constexpr int nN = 23;
    static_assert(WD_OFF + 64u * 1024 * 1024 < (1ull << 32) && DUMMY < (1ull << 32), "32-bit workspace offsets");
    __device__ __forceinline__ unsigned char* wsbase() const { const KArgs a = (KArgs)__builtin_amdgcn_kernarg_segment_ptr(); return a->ws; }
    __device__ __forceinline__ void decode(const Unit& u, int wid, int lane, const char*& sb, int& dn, unsigned& db, unsigned& dv, unsigned& sv) const {
        const KArgs a = (KArgs)__builtin_amdgcn_kernarg_segment_ptr();
        const int cb = (u.pm * nN + u.pn) * 8 + wid, nl = 2 * lane;
        if (cb < 8192) { const int up = cb >> 12, r = cb & 4095, e = r >> 7, kb = (r >> 3) & 15, nb = r & 7;
            sb = (const char*)((const float*)a->in[IN_GATE + up] + (size_t)e * 2048 * 1024 + (size_t)(128 * kb) * 1024 + 128 * nb); dn = 0;
            db = (unsigned)(WGU_OFF + (size_t)e * 2048 * 2048 + (size_t)(nb * 256 + up * 128) * 2048 + 128 * kb); dv = (unsigned)nl * 2048u; sv = (unsigned)(lane >> 5) * 4096u + (unsigned)(lane & 31) * 16u; }
        else { const int r = cb - 8192, e = r >> 7, kb = (r >> 4) & 7, nb = r & 15;
            sb = (const char*)((const float*)a->in[IN_GATE + 2] + (size_t)e * 1024 * 2048 + (size_t)(128 * kb) * 2048 + 128 * nb); dn = 1;
            db = (unsigned)(WD_OFF + (size_t)e * 2048 * 1024 + (size_t)(256 * (nb >> 1)) * 1024 + 128 * kb);
            dv = (unsigned)(((nl >> 3) & 1) * 128 + (2 * (nb & 1) + (nl >> 6)) * 32 + ((nl >> 4) & 3) * 8 + (nl & 7)) * 1024u; sv = (unsigned)(lane >> 5) * 8192u + (unsigned)(lane & 31) * 16u; }
    }
};
}

namespace pg8 {
template <class Epi, class Sched, class RowSrc, bool ALIGN_EPI = false, bool SP2 = false, bool F8 = false>
__device__ __forceinline__ void gemm_phase_g(PG8_LAS unsigned char* lds, const Gemm g, const Sched& S, const Epi& E, const RowSrc& RS) {
    const int tid = threadIdx.x, wid = __builtin_amdgcn_readfirstlane(tid >> 6), lane = tid & 63, wr = wid >> 2, wc = wid & 3, fr = lane & 15, fq = lane >> 4;
    const int K = g.K, nt = K / BK;
    unsigned voffB[2]; unsigned vC0[2], vC1[2], vN0[2], vN1[2]; int Rr[2], Cc[2];
#pragma unroll
    for (int i = 0; i < 2; ++i) { int R, C; stage_rc(tid * 16 + i * 8192, R, C); const int Rb = Epi::PERM ? ((R & ~31) + perm32(R & 31)) : R;
        Rr[i] = R; Cc[i] = C; voffB[i] = (unsigned)(Rb * K + C) * 2u; }
    const size_t kstep = (size_t)(BK * 2);
    const size_t hstep = (size_t)HALF * K * 2;
    const size_t tstep = 2 * hstep;
    const unsigned ldsw = (unsigned)wid * 1024u;
    const int aoff = lds_byte(wr * 64 + fr, fq * 8), boff = lds_byte(wc * 32 + fr, fq * 8);
#define PG8_CAT8(x, y) __builtin_bit_cast(v8i_t, __builtin_shufflevector((x), (y), 0, 1, 2, 3, 4, 5, 6, 7, 8, 9, 10, 11, 12, 13, 14, 15))
#define PG8_SA(b, h) (((b) * 2 + (h)) * HTB)
#define PG8_SB(b, h) ((4 + (b) * 2 + (h)) * HTB)
#define PG8_STAGE(bufoff, gbase, voff) do { _Pragma("unroll") for (int _i = 0; _i < 2; ++_i) \
        __builtin_amdgcn_global_load_lds((const unsigned*)((const char*)(gbase) + (voff)[_i]), (PG8_LAS unsigned*)(lds + (bufoff) + ldsw + _i * 8192), 16, 0, 0); } while (0)
#define PG8_LDA(dst, b, h) do { if constexpr (F8) { _Pragma("unroll") for (int m = 0; m < 4; ++m) dst##8[m] = PG8_CAT8(*(const PG8_LAS bf16x8*)(lds + PG8_SA(b, h) + aoff + m * 2048), *(const PG8_LAS bf16x8*)(lds + PG8_SA(b, h) + aoff + m * 2048 + 1024)); } else _Pragma("unroll") for (int m = 0; m < 4; ++m) _Pragma("unroll") for (int k = 0; k < 2; ++k) dst[m][k] = *(const PG8_LAS bf16x8*)(lds + PG8_SA(b, h) + aoff + m * 2048 + k * 1024); } while (0)
#define PG8_LDB(dst, b, h) do { if constexpr (F8) { _Pragma("unroll") for (int n = 0; n < 2; ++n) dst##8[n] = PG8_CAT8(*(const PG8_LAS bf16x8*)(lds + PG8_SB(b, h) + boff + n * 2048), *(const PG8_LAS bf16x8*)(lds + PG8_SB(b, h) + boff + n * 2048 + 1024)); } else _Pragma("unroll") for (int n = 0; n < 2; ++n) _Pragma("unroll") for (int k = 0; k < 2; ++k) dst[n][k] = *(const PG8_LAS bf16x8*)(lds + PG8_SB(b, h) + boff + n * 2048 + k * 1024); } while (0)
#define PG8_MMA(ai, bj, At, Bt) do { __builtin_amdgcn_s_setprio(1); \
        if constexpr (F8) { _Pragma("unroll") for (int m = 0; m < 4; ++m) _Pragma("unroll") for (int n = 0; n < 2; ++n) \
            asm volatile("v_mfma_f32_16x16x128_f8f6f4 %0, %1, %2, %0" : "+v"(acc[ai][bj][m][n]) : "v"(Bt##8[n]), "v"(At##8[m])); }     \
        else { _Pragma("unroll") for (int m = 0; m < 4; ++m) _Pragma("unroll") for (int n = 0; n < 2; ++n) _Pragma("unroll") for (int k = 0; k < 2; ++k) \
            acc[ai][bj][m][n] = __builtin_amdgcn_mfma_f32_16x16x32_bf16(Bt[n][k], At[m][k], acc[ai][bj][m][n], 0, 0, 0); } \
        __builtin_amdgcn_s_setprio(0); } while (0)
#define PG8_WAIT_V(n) asm volatile("s_waitcnt vmcnt(" #n ")" ::: "memory")
#define PG8_WAIT_L(n) asm volatile("s_waitcnt lgkmcnt(" #n ")" ::: "memory")
#define PG8_BAR __builtin_amdgcn_s_barrier()
#define PG8_SCHED __builtin_amdgcn_sched_barrier(0)
    Unit cur, nxt; int ui = 0;
    if (!S.next(0, cur)) return;
    f32x4 acc[2][2][4][2];
#pragma unroll
    for (int a = 0; a < 2; ++a)
#pragma unroll
        for (int b = 0; b < 2; ++b)
#pragma unroll
            for (int m = 0; m < 4; ++m)
#pragma unroll
                for (int n = 0; n < 2; ++n) acc[a][b][m][n] = (f32x4){0.f, 0.f, 0.f, 0.f};
    bf16x8 At[4][2], B0[2][2], B1[2][2];
    v8i_t At8[4], B08[2], B18[2];
    const char* cA = (const char*)g.A; const char* cB = (const char*)g.Bt + (size_t)cur.pn * tstep;
    RS.rows(cur, Rr, Cc, K, vC0, vC1);
    S.a_ready(cur);
    if constexpr (SP2) {
        PG8_STAGE(PG8_SB(0, 0), cB, voffB); PG8_STAGE(PG8_SB(0, 1), cB + hstep, voffB); PG8_STAGE(PG8_SA(0, 0), cA, vC0); PG8_STAGE(PG8_SA(0, 1), cA, vC1);
        if (wr == 1) PG8_BAR;
        PG8_WAIT_V(2); PG8_BAR;
        PG8_STAGE(PG8_SB(1, 0), cB + kstep, voffB); PG8_STAGE(PG8_SA(1, 0), cA + kstep, vC0); PG8_STAGE(PG8_SB(1, 1), cB + hstep + kstep, voffB);
        PG8_WAIT_V(6); PG8_BAR;
    } else {
        PG8_STAGE(PG8_SB(0, 0), cB, voffB); PG8_STAGE(PG8_SA(0, 0), cA, vC0); PG8_STAGE(PG8_SB(0, 1), cB + hstep, voffB); PG8_STAGE(PG8_SA(0, 1), cA, vC1);
        if (wr == 1) PG8_BAR;
        PG8_WAIT_V(4); PG8_BAR;
        PG8_STAGE(PG8_SB(1, 0), cB + kstep, voffB); PG8_STAGE(PG8_SA(1, 0), cA + kstep, vC0); PG8_STAGE(PG8_SB(1, 1), cB + hstep + kstep, voffB);
        PG8_WAIT_V(6); PG8_BAR;
    }
    for (;;) {
        const bool has_next = S.next(ui + 1, nxt);
        const char* nA = cA; const char* nB = has_next ? (const char*)g.Bt + (size_t)nxt.pn * tstep : cB;
        if (has_next) RS.rows(nxt, Rr, Cc, K, vN0, vN1); else { vN0[0] = vC0[0]; vN0[1] = vC0[1]; vN1[0] = vC1[0]; vN1[1] = vC1[1]; }
        for (int t = 0; t < nt; t += 2) {
            const bool last = (t == nt - 2);
            const char* a1 = cA + (size_t)(t + 1) * kstep;
            const char* a2 = last ? nA : cA + (size_t)(t + 2) * kstep; const char* b2 = last ? nB : cB + (size_t)(t + 2) * kstep;
            const char* a3 = a2 + kstep; const char* b3 = b2 + kstep;
            const unsigned v20[2] = {last ? vN0[0] : vC0[0], last ? vN0[1] : vC0[1]}, v21[2] = {last ? vN1[0] : vC1[0], last ? vN1[1] : vC1[1]};
            if (last && has_next) S.a_ready(nxt);
            if constexpr (SP2) {
            PG8_LDB(B0, 0, 0); PG8_LDB(B1, 0, 1); PG8_SCHED; PG8_LDA(At, 0, 0); PG8_STAGE(PG8_SA(1, 1), a1, vC1);
            PG8_WAIT_V(8); PG8_WAIT_L(0); PG8_BAR; PG8_MMA(0, 0, At, B0); PG8_MMA(0, 1, At, B1); PG8_BAR; PG8_SCHED;
            PG8_LDA(At, 0, 1); PG8_STAGE(PG8_SB(0, 0), b2, voffB); PG8_STAGE(PG8_SB(0, 1), b2 + hstep, voffB); PG8_STAGE(PG8_SA(0, 0), a2, v20);
            PG8_WAIT_V(8); PG8_WAIT_L(0); PG8_BAR; PG8_MMA(1, 0, At, B0); PG8_MMA(1, 1, At, B1); PG8_BAR; PG8_SCHED;
            PG8_LDB(B0, 1, 0); PG8_LDB(B1, 1, 1); PG8_SCHED; PG8_LDA(At, 1, 0); PG8_STAGE(PG8_SA(0, 1), a2, v21);
            PG8_WAIT_V(8); PG8_WAIT_L(0); PG8_BAR; PG8_MMA(0, 0, At, B0); PG8_MMA(0, 1, At, B1); PG8_BAR; PG8_SCHED;
            PG8_LDA(At, 1, 1); PG8_STAGE(PG8_SB(1, 0), b3, voffB); PG8_STAGE(PG8_SB(1, 1), b3 + hstep, voffB); PG8_STAGE(PG8_SA(1, 0), a3, v20);
            PG8_WAIT_V(8); PG8_WAIT_L(0); PG8_BAR; PG8_MMA(1, 0, At, B0); PG8_MMA(1, 1, At, B1); PG8_BAR; PG8_SCHED;
            } else {
            PG8_LDB(B0, 0, 0); PG8_SCHED; PG8_LDA(At, 0, 0); PG8_STAGE(PG8_SA(1, 1), a1, vC1);
            PG8_WAIT_L(8); PG8_BAR; PG8_WAIT_L(0); PG8_MMA(0, 0, At, B0); PG8_BAR; PG8_SCHED;
            PG8_LDB(B1, 0, 1); PG8_STAGE(PG8_SB(0, 0), b2, voffB);
            PG8_BAR; PG8_WAIT_L(0); PG8_MMA(0, 1, At, B1); PG8_BAR;
            PG8_LDA(At, 0, 1); PG8_STAGE(PG8_SA(0, 0), a2, v20);
            PG8_BAR; PG8_WAIT_L(0); PG8_MMA(1, 0, At, B0); PG8_BAR; PG8_SCHED;
            PG8_STAGE(PG8_SB(0, 1), b2 + hstep, voffB);
            PG8_WAIT_V(6); PG8_BAR; PG8_MMA(1, 1, At, B1); PG8_BAR;
            PG8_LDB(B0, 1, 0); PG8_SCHED; PG8_LDA(At, 1, 0); PG8_STAGE(PG8_SA(0, 1), a2, v21);
            PG8_WAIT_L(8); PG8_BAR; PG8_WAIT_L(0); PG8_MMA(0, 0, At, B0); PG8_BAR; PG8_SCHED;
            PG8_LDB(B1, 1, 1); PG8_STAGE(PG8_SB(1, 0), b3, voffB);
            PG8_BAR; PG8_WAIT_L(0); PG8_MMA(0, 1, At, B1); PG8_BAR;
            PG8_LDA(At, 1, 1); PG8_STAGE(PG8_SA(1, 0), a3, v20);
            PG8_BAR; PG8_WAIT_L(0); PG8_MMA(1, 0, At, B0); PG8_BAR; PG8_SCHED;
            PG8_STAGE(PG8_SB(1, 1), b3 + hstep, voffB);
            PG8_WAIT_V(6); PG8_BAR; PG8_MMA(1, 1, At, B1); PG8_BAR;
            }
        }
        if constexpr (F8) asm volatile("s_nop 15\n\ts_nop 7" ::: "memory");
        if constexpr (ALIGN_EPI) { if (wr == 0) PG8_BAR; }
        if constexpr (!Epi::AFTER_DRAIN) { E(acc, cur, wr, wc, fr, fq); S.done(cur); }
        if (!has_next) break;
#pragma unroll
        for (int a = 0; a < 2; ++a)
#pragma unroll
            for (int b = 0; b < 2; ++b)
#pragma unroll
                for (int m = 0; m < 4; ++m)
#pragma unroll
                    for (int n = 0; n < 2; ++n) acc[a][b][m][n] = (f32x4){0.f, 0.f, 0.f, 0.f};
        cur = nxt; cA = nA; cB = nB; ++ui; vC0[0] = vN0[0]; vC0[1] = vN0[1]; vC1[0] = vN1[0]; vC1[1] = vN1[1];
        if constexpr (ALIGN_EPI) { if (wr == 1) PG8_BAR; }
    }
    PG8_WAIT_V(0);
    if constexpr (!ALIGN_EPI) { if (wr == 0) PG8_BAR; }
    PG8_BAR;
    if constexpr (Epi::AFTER_DRAIN) { E.fused(acc, cur, wr, wc, fr, fq, lds, wid, lane); S.done(cur); }
#undef PG8_SA
#undef PG8_SB
#undef PG8_STAGE
#undef PG8_LDA
#undef PG8_LDB
#undef PG8_MMA
#undef PG8_CAT8
#undef PG8_WAIT_V
#undef PG8_WAIT_L
#undef PG8_BAR
#undef PG8_SCHED
}

struct ExpertRows {
    const PG8_LAS int* tab; const int* lst_tok; int lcap;
    __device__ __forceinline__ void rows(const Unit& u, const int (&Rr)[2], const int (&Cc)[2], int K, unsigned (&v0)[2], unsigned (&v1)[2]) const {
        const int e = u.pn >> 3, mi = u.pm - tab[40 + e], cnt = tab[80 + e];
#pragma unroll
        for (int i = 0; i < 2; ++i) { const int p0 = mi * BM + Rr[i], p1 = p0 + HALF;
            const int t0 = p0 < cnt ? lst_tok[(size_t)e * lcap + p0] : 0, t1 = p1 < cnt ? lst_tok[(size_t)e * lcap + p1] : 0;
            v0[i] = (unsigned)(t0 * K + Cc[i]) * 2u; v1[i] = (unsigned)(t1 * K + Cc[i]) * 2u; }
    }
};
}

#ifndef PG8_SP2
#define PG8_SP2 true
#endif
#ifndef PG8_ALIGN
#define PG8_ALIGN true
#endif

namespace attn_body {
using bf16=__hip_bfloat16;
using bf16x8=__attribute__((ext_vector_type(8)))short;
using s16x4=__attribute__((ext_vector_type(4)))short;
using f32x16=__attribute__((ext_vector_type(16)))float;
using u32x4=__attribute__((ext_vector_type(4)))unsigned;
constexpr int SEQ=2048,D=64,QP=1024,KP=1024,VP=5632,OP=1024;
constexpr int NW=8,QBLK=32,QB=QBLK*NW,KVBLK=64,NQB=SEQ/QB;
constexpr int ATTN_UNIT_ROWS=QB;
__device__ __forceinline__ int crow(int r,int hi){return (r&3)+8*(r>>2)+4*hi;}
#define SBAR() __builtin_amdgcn_sched_barrier(0)
__device__ __forceinline__ void cmask(f32x16&p0,f32x16&p1,int jb,int qrel,int hi){
  const float NEG=-INFINITY; int kb=64*jb+4*hi;
  #pragma unroll
  for(int r=0;r<16;++r){int kv=kb+(r&3)+8*(r>>2); if(kv>qrel)p0[r]=NEG; if(kv+32>qrel)p1[r]=NEG;}
}

constexpr int NSLOT=3, SLOTB=8192;
constexpr int LDS_K=0, LDS_V=NSLOT*SLOTB, LDS_WS=2*NSLOT*SLOTB, LDS_OST=LDS_WS+NW*64*4, LDS_BYTES=LDS_OST+NW*4096;
constexpr float C2=0.125f*1.4426950408889634f;
__device__ __forceinline__ void glds16(const void*gsrc,unsigned lds_dst){unsigned keep;
  asm volatile("s_mov_b32 %0, m0\n\ts_mov_b32 m0, %2\n\ts_nop 0\n\tglobal_load_lds_dwordx4 %1, off\n\ts_mov_b32 m0, %0":"=&s"(keep):"v"(gsrc),"s"(lds_dst):"memory");}
__device__ __forceinline__ float max3f(float a,float b,float c){float r;asm("v_max3_f32 %0, %1, %2, %3":"=v"(r):"v"(a),"v"(b),"v"(c));return r;}
__device__ __forceinline__ float max2f(float a,float b){float r;asm("v_max_f32_e32 %0, %1, %2":"=v"(r):"v"(a),"v"(b));return r;}
__device__ __forceinline__ float fadd_s(float a,float b){float r;asm("v_add_f32_e32 %0, %1, %2":"=v"(r):"v"(a),"v"(b));return r;}
__device__ __forceinline__ float fsub_s(float a,float b){float r;asm("v_sub_f32_e32 %0, %1, %2":"=v"(r):"v"(a),"v"(b));return r;}
typedef float f32x2_t __attribute__((ext_vector_type(2))); typedef __bf16 bf16x2_t __attribute__((ext_vector_type(2)));
__device__ __forceinline__ unsigned cvtpk_s(float lo,float hi){f32x2_t v={lo,hi};bf16x2_t b=__builtin_convertvector(v,bf16x2_t);return __builtin_bit_cast(unsigned,b);}
#define WAIT_BAR(N) asm volatile("s_waitcnt vmcnt(" #N ") lgkmcnt(0)\n\ts_barrier":::"memory")

__device__ __forceinline__ void qkt(f32x16&p0,f32x16&p1,const char*Kslot,const bf16x8*qr,const f32x16&negm,int r32,int hi){
  const char*kb=Kslot+hi*1024+r32*16;
  #pragma unroll
  for(int d0=0;d0<4;++d0){
    const bf16x8 b0=*reinterpret_cast<const bf16x8*>(kb+d0*2048);
    const bf16x8 b1=*reinterpret_cast<const bf16x8*>(kb+d0*2048+512);
    if(d0==0){p0=__builtin_amdgcn_mfma_f32_32x32x16_bf16(b0,qr[0],negm,0,0,0);p1=__builtin_amdgcn_mfma_f32_32x32x16_bf16(b1,qr[0],negm,0,0,0);}
    else{p0=__builtin_amdgcn_mfma_f32_32x32x16_bf16(b0,qr[d0],p0,0,0,0);p1=__builtin_amdgcn_mfma_f32_32x32x16_bf16(b1,qr[d0],p1,0,0,0);}}
}
typedef __attribute__((address_space(3))) const char* lds_cptr;
typedef short v4i16_t __attribute__((ext_vector_type(4)));
__device__ __forceinline__ void kload8(bf16x8*kf,lds_cptr kp){
  kf[0]=*(const __attribute__((address_space(3))) bf16x8*)(kp);      kf[1]=*(const __attribute__((address_space(3))) bf16x8*)(kp+512);
  kf[2]=*(const __attribute__((address_space(3))) bf16x8*)(kp+2048); kf[3]=*(const __attribute__((address_space(3))) bf16x8*)(kp+2560);
  kf[4]=*(const __attribute__((address_space(3))) bf16x8*)(kp+4096); kf[5]=*(const __attribute__((address_space(3))) bf16x8*)(kp+4608);
  kf[6]=*(const __attribute__((address_space(3))) bf16x8*)(kp+6144); kf[7]=*(const __attribute__((address_space(3))) bf16x8*)(kp+6656);
}
__device__ __forceinline__ void kload2(bf16x8*kf,lds_cptr kp,int j){ kf[2*j]=*(const __attribute__((address_space(3))) bf16x8*)(kp+j*2048); kf[2*j+1]=*(const __attribute__((address_space(3))) bf16x8*)(kp+j*2048+512); }
__device__ __forceinline__ s16x4 vtr(lds_cptr p){ return __builtin_bit_cast(s16x4,__builtin_amdgcn_ds_read_tr16_b64_v4i16((__attribute__((address_space(3))) v4i16_t*)p)); }
__device__ __forceinline__ float rowmax(const f32x16&p0,const f32x16&p1){
  float a=max3f(p0[0],p0[1],p1[0]),b=max3f(p0[2],p0[3],p1[1]);a=max3f(a,p1[2],p1[3]);
  #pragma unroll
  for(int r=4;r<16;r+=4){a=max3f(a,p0[r],p0[r+1]);b=max3f(b,p0[r+2],p0[r+3]);a=max3f(a,p1[r],p1[r+1]);b=max3f(b,p1[r+2],p1[r+3]);}
  const float m=max2f(a,b);
  auto rr=__builtin_amdgcn_permlane32_swap(__float_as_uint(m),__float_as_uint(m),false,false);
  return max2f(__uint_as_float(rr[0]),__uint_as_float(rr[1]));
}
__device__ __forceinline__ void pv(f32x16*o,int vb,bf16x8 pa0,bf16x8 pa1,bf16x8 pa2,bf16x8 pa3){
  #pragma unroll
  for(int d0=0;d0<2;++d0){s16x4 lo[4],hi[4];
    #pragma unroll
    for(int ks=0;ks<4;++ks){
      asm volatile("ds_read_b64_tr_b16 %0,%1 offset:%c2":"=&v"(lo[ks]):"v"(vb),"i"(d0*4096+ks*1024):"memory");
      asm volatile("ds_read_b64_tr_b16 %0,%1 offset:%c2":"=&v"(hi[ks]):"v"(vb),"i"(d0*4096+ks*1024+512):"memory");}
    asm volatile("s_waitcnt lgkmcnt(0)":::"memory");SBAR();
    #define PK(k) (bf16x8){lo[k][0],lo[k][1],lo[k][2],lo[k][3],hi[k][0],hi[k][1],hi[k][2],hi[k][3]}
    o[d0]=__builtin_amdgcn_mfma_f32_32x32x16_bf16(pa0,PK(0),o[d0],0,0,0);
    o[d0]=__builtin_amdgcn_mfma_f32_32x32x16_bf16(pa1,PK(1),o[d0],0,0,0);
    o[d0]=__builtin_amdgcn_mfma_f32_32x32x16_bf16(pa2,PK(2),o[d0],0,0,0);
    o[d0]=__builtin_amdgcn_mfma_f32_32x32x16_bf16(pa3,PK(3),o[d0],0,0,0);
    #undef PK
  }
}

#ifndef ATTN_STORE16
#define ATTN_STORE16(p,v) (*(u32x4*)(p)=(v))
#endif
template<int THRL> __device__ __forceinline__ void attn_unit(int b,int h,int qb,const bf16*Q,const bf16*__restrict__ K,const bf16*__restrict__ V,bf16*O,char*shm){
  int tid_=threadIdx.x; asm volatile("" : "+v"(tid_));
  const int tid=tid_,lane=tid&63,r32=lane&31,hi=lane>>5; const int wid=__builtin_amdgcn_readfirstlane(tid>>6);
  const long rowbase=(long)b*SEQ; const int q0=qb*QB;
  const bf16*Qw=Q+(rowbase+q0+wid*QBLK)*QP+h*D;
  const bf16*Kh=K+rowbase*KP+h*D,*Vh=V+rowbase*VP+h*D;
  const unsigned lds0=(unsigned)(uintptr_t)shm;
  float*wsf=(float*)(shm+LDS_WS)+wid*64;
  const bf16*ksrc=Kh+(long)lane*KP+wid*8;
  const bf16*vsrc=Vh+(long)(16*(wid&3)+(lane>>2))*VP+(wid>>2)*32+(lane&3)*8;
  const unsigned kdst=lds0+LDS_K+wid*1024, vdst=lds0+LDS_V+wid*1024;
  #define DMA_K(t,slot) glds16(ksrc+(long)(t)*KVBLK*KP,(unsigned)__builtin_amdgcn_readfirstlane(kdst+(slot)))
  #define DMA_V(t,slot) glds16(vsrc+(long)(t)*KVBLK*VP,(unsigned)__builtin_amdgcn_readfirstlane(vdst+(slot)))
  const int vb0=(int)(lds0+LDS_V)+((lane>>4)&1)*32+(lane&3)*8+(4*hi+((lane&15)>>2))*64;
  const char*Kbase=shm+LDS_K; bf16x8 kf[8];
  const lds_cptr shm3=(lds_cptr)shm; const lds_cptr kp0=shm3+LDS_K+hi*1024+r32*16; const lds_cptr vp0=shm3+LDS_V+((lane>>4)&1)*32+(lane&3)*8+(4*hi+((lane&15)>>2))*64;
  const int NT=(q0+QB)/KVBLK;
  DMA_K(0,0);DMA_V(0,0);DMA_K(1,SLOTB);
  bf16x8 qr[4];
  #pragma unroll
  for(int d0=0;d0<4;++d0)qr[d0]=*reinterpret_cast<const bf16x8*>(&Qw[(long)r32*QP+d0*16+hi*8]);
  float mhat=0.f,l_reg=0.f;f32x16 o[2];o[0]=f32x16{};o[1]=f32x16{};f32x16 negm=f32x16{};asm volatile("":"+v"(negm));
  const int qrel=wid*QBLK+r32;
  #define CMASK(P0,P1,t) do{int jb_=(t)-(NT-4); if(jb_>=0)cmask(P0,P1,jb_,qrel,hi);}while(0)
  bool resc=false;
  #define START(P0,P1) do{ const float rm=rowmax(P0,P1); resc=false; \
    { const float dl=rm; mhat=fadd_s(mhat,dl); \
      _Pragma("unroll") for(int r=0;r<16;++r){P0[r]=fsub_s(P0[r],dl);P1[r]=fsub_s(P1[r],dl);} \
      _Pragma("unroll") for(int r=0;r<16;++r)negm[r]=-mhat; asm volatile("":"+v"(negm)); } \
    _Pragma("unroll") for(int r=0;r<16;++r)P0[r]=__builtin_amdgcn_exp2f(P0[r]); }while(0)
  #define RESC() do{ if(resc){ asm volatile("s_waitcnt lgkmcnt(0)":::"memory"); \
      _Pragma("unroll") for(int d_=0;d_<2;++d_) _Pragma("unroll") for(int r=0;r<16;++r)o[d_][r]*=wsf[crow(r,hi)]; } }while(0)
  f32x16 pA0,pA1,pB0,pB1;
  int sl_prev=0,sl_cur=0,sl_next=SLOTB;
  #define ROT() do{sl_prev=sl_cur;sl_cur=sl_next;sl_next=(sl_next==(NSLOT-1)*SLOTB)?0:sl_next+SLOTB;}while(0)
  DMA_K(2,2*SLOTB);
  WAIT_BAR(3);
  qkt(pA0,pA1,Kbase,qr,negm,r32,hi);asm volatile("s_nop 15\n\ts_nop 7":"+v"(pA0),"+v"(pA1));CMASK(pA0,pA1,0);
  START(pA0,pA1);
  _Pragma("unroll") for(int r=0;r<16;++r)pA1[r]=__builtin_amdgcn_exp2f(pA1[r]);
  WAIT_BAR(0);
  DMA_K(3,0);DMA_V(1,SLOTB);
  ROT();
  kload8(kf,kp0+sl_cur);
  WAIT_BAR(2);
  s16x4 vlo[8],vhi[8]; u32x4 pw0,pw1,pw2,pw3;
  #define PKW(P,B) cvtpk_s(P[B],P[B+1])
  #define PAF(k) __builtin_bit_cast(bf16x8,pw##k)
  #define VFR(i) (bf16x8){vlo[i][0],vlo[i][1],vlo[i][2],vlo[i][3],vhi[i][0],vhi[i][1],vhi[i][2],vhi[i][3]}
  #define PIN(x) asm volatile("":"+v"(x))
  #define MX3(a,b,c) __builtin_fmaxf(__builtin_fmaxf((a),(b)),(c))
  #define GAPA(MF,A0,A1,A2,A3,W0,W1,PW) do{ MF; sacc+=A0; sacc+=A1; sacc+=A2; sacc+=A3; PIN(sacc); W0; W1; PIN(PW); SBAR(); }while(0)
  #define EX(v) __builtin_amdgcn_exp2f(v)
  #define GAPB(MF,X,B) do{ MF; X[B]=EX(X[B]); X[B+1]=EX(X[B+1]); X[B+2]=EX(X[B+2]); X[B+3]=EX(X[B+3]); PIN(X); SBAR(); }while(0)
  #define VRD(i) do{ vlo[i]=vtr(vp_+(((i)>>2)*4096+((i)&3)*1024)); vhi[i]=vtr(vp_+(((i)>>2)*4096+((i)&3)*1024+512)); }while(0)
  #define KRD(G,j) do{ if(G){ kload2(kf,kp0+sl_next,j); SBAR(); } }while(0)
  #define STEP(C0,C1,P0,P1,t,GK,GV,GL) do{ SBAR(); \
    const lds_cptr vp_=vp0+sl_prev; \
    VRD(0); SBAR(); float sacc=(P0[0]+P0[1]); \
    GAPA(C0=__builtin_amdgcn_mfma_f32_32x32x16_bf16(kf[0],qr[0],negm,0,0,0), P0[2],P0[3],P0[4],P0[5],     pw0[0]=PKW(P0,0), pw0[1]=PKW(P0,2), pw0); \
    VRD(4); SBAR(); GAPA(C1=__builtin_amdgcn_mfma_f32_32x32x16_bf16(kf[1],qr[0],negm,0,0,0), P0[6],P0[7],P0[8],P0[9],     pw0[2]=PKW(P0,4), pw0[3]=PKW(P0,6), pw0); \
    VRD(1); SBAR(); GAPA(C0=__builtin_amdgcn_mfma_f32_32x32x16_bf16(kf[2],qr[1],C0,0,0,0),   P0[10],P0[11],P0[12],P0[13], pw1[0]=PKW(P0,8), pw1[1]=PKW(P0,10), pw1); \
    VRD(5); SBAR(); GAPA(C1=__builtin_amdgcn_mfma_f32_32x32x16_bf16(kf[3],qr[1],C1,0,0,0),   P0[14],P0[15],P1[0],P1[1],   pw1[2]=PKW(P0,12),pw1[3]=PKW(P0,14), pw1); \
    VRD(2); SBAR(); GAPA(C0=__builtin_amdgcn_mfma_f32_32x32x16_bf16(kf[4],qr[2],C0,0,0,0),   P1[2],P1[3],P1[4],P1[5],     pw2[0]=PKW(P1,0), pw2[1]=PKW(P1,2), pw2); \
    VRD(6); SBAR(); GAPA(C1=__builtin_amdgcn_mfma_f32_32x32x16_bf16(kf[5],qr[2],C1,0,0,0),   P1[6],P1[7],P1[8],P1[9],     pw2[2]=PKW(P1,4), pw2[3]=PKW(P1,6), pw2); \
    VRD(3); SBAR(); GAPA(C0=__builtin_amdgcn_mfma_f32_32x32x16_bf16(kf[6],qr[3],C0,0,0,0),   P1[10],P1[11],P1[12],P1[13], pw3[0]=PKW(P1,8), pw3[1]=PKW(P1,10), pw3); \
    VRD(7); SBAR(); GAPA(C1=__builtin_amdgcn_mfma_f32_32x32x16_bf16(kf[7],qr[3],C1,0,0,0),   P1[14],P1[15],0.f,0.f,       pw3[2]=PKW(P1,12),pw3[3]=PKW(P1,14), pw3); \
    l_reg+=sacc; \
    if(GK){DMA_K((t)+3,sl_cur);} if(GV){DMA_V((t)+1,sl_next);} \
    CMASK(C0,C1,t); \
    { float a=MX3(C0[0],C0[1],C1[0]),b=MX3(C0[2],C0[3],C1[1]); a=MX3(a,C1[2],C1[3]); \
      _Pragma("unroll") for(int r=4;r<16;r+=4){a=MX3(a,C0[r],C0[r+1]);b=MX3(b,C0[r+2],C0[r+3]);a=MX3(a,C1[r],C1[r+1]);b=MX3(b,C1[r+2],C1[r+3]);} \
      float rm=__builtin_fmaxf(a,b); { auto rr=__builtin_amdgcn_permlane32_swap(__float_as_uint(rm),__float_as_uint(rm),false,false); rm=__builtin_fmaxf(__uint_as_float(rr[0]),__uint_as_float(rr[1])); } \
      resc=false; \
      if(__builtin_expect(__any(rm>(float)THRL),0)){ const float dl=__builtin_fmaxf(rm,0.f); mhat+=dl; \
        _Pragma("unroll") for(int r=0;r<16;++r){C0[r]-=dl;C1[r]-=dl;} \
        _Pragma("unroll") for(int r=0;r<16;++r)negm[r]=-mhat; asm volatile("":"+v"(negm)); \
        const float f=__builtin_amdgcn_exp2f(-dl); l_reg*=f; if(hi==0)wsf[r32]=f; resc=true; } } \
    SBAR(); \
    GAPB(o[0]=__builtin_amdgcn_mfma_f32_32x32x16_bf16(PAF(0),VFR(0),o[0],0,0,0), C0,0); \
    GAPB(o[1]=__builtin_amdgcn_mfma_f32_32x32x16_bf16(PAF(0),VFR(4),o[1],0,0,0), C0,4); \
    KRD(GL,0); GAPB(o[0]=__builtin_amdgcn_mfma_f32_32x32x16_bf16(PAF(1),VFR(1),o[0],0,0,0), C0,8); \
    KRD(GL,1); GAPB(o[1]=__builtin_amdgcn_mfma_f32_32x32x16_bf16(PAF(1),VFR(5),o[1],0,0,0), C0,12); \
    KRD(GL,2); GAPB(o[0]=__builtin_amdgcn_mfma_f32_32x32x16_bf16(PAF(2),VFR(2),o[0],0,0,0), C1,0); \
    KRD(GL,3); GAPB(o[1]=__builtin_amdgcn_mfma_f32_32x32x16_bf16(PAF(2),VFR(6),o[1],0,0,0), C1,4); \
    GAPB(o[0]=__builtin_amdgcn_mfma_f32_32x32x16_bf16(PAF(3),VFR(3),o[0],0,0,0), C1,8); \
    GAPB(o[1]=__builtin_amdgcn_mfma_f32_32x32x16_bf16(PAF(3),VFR(7),o[1],0,0,0), C1,12); \
    }while(0)
  int t=1;
  #undef CMASK
  #define CMASK(P0,P1,t) do{}while(0)
  for(;t+5<NT;t+=2){
    STEP(pB0,pB1,pA0,pA1,t,true,true,true);     WAIT_BAR(2); RESC(); ROT();
    STEP(pA0,pA1,pB0,pB1,t+1,true,true,true);   WAIT_BAR(2); RESC(); ROT();
  }
  #undef CMASK
  #define CMASK(P0,P1,t) do{int jb_=(t)-(NT-4); if(jb_>=0)cmask(P0,P1,jb_,qrel,hi);}while(0)
  #define ENDW(tt) do{ if((tt)+3<NT){WAIT_BAR(2);} else if((tt)+2<NT){WAIT_BAR(1);} else {WAIT_BAR(0);} }while(0)
  for(;t+1<NT;t+=2){
    STEP(pB0,pB1,pA0,pA1,t,(t+3<NT),(t+1<NT),(t+1<NT));       ENDW(t);   RESC(); ROT();
    STEP(pA0,pA1,pB0,pB1,t+1,(t+4<NT),(t+2<NT),(t+2<NT));     ENDW(t+1); RESC(); ROT();
  }
  STEP(pB0,pB1,pA0,pA1,NT-1,false,false,false); RESC();
  { float sacc=pB0[0]+pB0[1]; _Pragma("unroll") for(int r=2;r<16;++r)sacc+=pB0[r]; _Pragma("unroll") for(int r=0;r<16;++r)sacc+=pB1[r]; l_reg+=sacc;
    pw0=(u32x4){PKW(pB0,0),PKW(pB0,2),PKW(pB0,4),PKW(pB0,6)};pw1=(u32x4){PKW(pB0,8),PKW(pB0,10),PKW(pB0,12),PKW(pB0,14)};pw2=(u32x4){PKW(pB1,0),PKW(pB1,2),PKW(pB1,4),PKW(pB1,6)};pw3=(u32x4){PKW(pB1,8),PKW(pB1,10),PKW(pB1,12),PKW(pB1,14)};
    SBAR(); pv(o,vb0+sl_cur,PAF(0),PAF(1),PAF(2),PAF(3)); }
  #undef PKW
  #undef PAF
  #undef VFR
  #undef PIN
  #undef MX3
  #undef GAPA
  #undef GAPB
  #undef EX
  #undef VRD
  #undef KRD
  #undef STEP
  #undef ENDW
  {auto rr=__builtin_amdgcn_permlane32_swap(__float_as_uint(l_reg),__float_as_uint(l_reg),false,false);l_reg=__uint_as_float(rr[0])+__uint_as_float(rr[1]);}
  if(hi==0)wsf[32+r32]=l_reg;asm volatile("s_waitcnt lgkmcnt(0)":::"memory");
  float rli[16];
  #pragma unroll
  for(int r=0;r<16;++r)rli[r]=__builtin_amdgcn_rcpf(wsf[32+crow(r,hi)]);
  bf16*Ow=O+(rowbase+q0+wid*QBLK)*OP+h*D;
  { bf16*stg=(bf16*)(shm+LDS_OST)+wid*2048;
    #pragma unroll
    for(int r=0;r<16;++r){const int orow=crow(r,hi);
      #pragma unroll
      for(int d0=0;d0<2;++d0)stg[orow*64+d0*32+r32]=__float2bfloat16(o[d0][r]*rli[r]);}
    asm volatile("s_waitcnt lgkmcnt(0)":::"memory");
    #pragma unroll
    for(int i=0;i<4;++i){const int row=i*8+(lane>>3),ch=lane&7; const u32x4 v=*(const u32x4*)(stg+row*64+ch*8); ATTN_STORE16(Ow+(long)row*OP+ch*8,v);} }
  asm volatile("s_waitcnt lgkmcnt(0)\n\ts_barrier":::"memory");
  #undef DMA_K
  #undef DMA_V
  #undef CMASK
  #undef START
  #undef RESC
  #undef ROT
}
constexpr int ATTN_LDS_BYTES=LDS_BYTES;
#undef SBAR
#undef WAIT_BAR
}

#define GAS __attribute__((address_space(1)))
#define LAS __attribute__((address_space(3)))
typedef unsigned short bf16;
typedef unsigned v4u __attribute__((ext_vector_type(4)));
typedef unsigned v2u __attribute__((ext_vector_type(2)));
typedef float f32x4 __attribute__((ext_vector_type(4)));
typedef short bf16x8 __attribute__((ext_vector_type(8)));
typedef GAS unsigned gu32;
#define RLX_AGENT __ATOMIC_RELAXED, __HIP_MEMORY_SCOPE_AGENT
#define LDS_WAIT() asm volatile("s_waitcnt lgkmcnt(0)" ::: "memory")
#define VM_WAIT() asm volatile("s_waitcnt vmcnt(0)" ::: "memory")

#ifndef P1_HOSTS_P0B
#define P1_HOSTS_P0B 1
#endif
constexpr int NWAVES = 8;
constexpr int DM = 2048, NBATCH = 8, SEQ = 2048, M = NBATCH * SEQ;
constexpr int IN_COLS = 5648;
constexpr int NIN = 5632;
constexpr int NIN_G = 5888;
constexpr int UC_Z = 0, UC_XBC = 1024, UC_Q = 2560, UC_K = 3584, UC_V = 4608;
constexpr int NE = 32, EH = 1024;
constexpr float EPS = 1e-6f;
constexpr float F8_WSCALE = 64.f;
constexpr float Y8_SCALE = 16.f;
constexpr size_t MiB = 1u << 20;

constexpr int RING_OFF = 0, RING_BYTES = 131072;
constexpr int LDSCTL_OFF = 159744, MISC_OFF = LDSCTL_OFF + 320;
constexpr int LDS_BYTES = 163840;

namespace mp {
constexpr size_t ctl = 0, small = 1 * MiB, wr = 2 * MiB, rope = 3 * MiB, dt = 5 * MiB, win = 6 * MiB, wout = 30 * MiB, wgu = 38 * MiB, wd = 166 * MiB;
constexpr size_t xn = 230 * MiB, xn2 = 230 * MiB, ycat = 294 * MiB, u16 = 358 * MiB, qn = 534 * MiB, kn = 566 * MiB, xbc = 598 * MiB, o1 = 646 * MiB, o2 = 678 * MiB, ys = 710 * MiB;
constexpr size_t y = 358 * MiB, hid = 518 * MiB;
constexpr size_t lst = 742 * MiB;
constexpr size_t xn8 = 748 * MiB;
constexpr size_t END = 780 * MiB;
}
constexpr size_t CTL_ZERO_BYTES = 1 * MiB;
constexpr int CW_TMO = 0, CW_CODE = 1, CW_BAR = 4096;
constexpr int CW_Q0 = 66560;
constexpr int CW_LOC = 8192, CW_RANK = 10240;
constexpr int CW_CNT = 65536;
constexpr int LCAP = 16384;
constexpr int SLOT_CAP = 40960;
constexpr int TAB_OFF = LDSCTL_OFF + 1024;
constexpr size_t SM_TOK_E = 0, SM_TOK_POS = 131072, SM_TOK_W = 262144, SM_TOK_SLOT = 393216, SM_RINV = 524288, SM_SLOT_W = 655360, SM_SLOT_R = 851968, SM_END = 1048576;

__device__ __forceinline__ void st16_wt(void* p, v4u v) { asm volatile("global_store_dwordx4 %0, %1, off sc1\n\ts_nop 1" :: "v"(p), "v"(v) : "memory"); }
__device__ __forceinline__ unsigned f2bf(float f) { unsigned u = __builtin_bit_cast(unsigned, f); return (u + 0x7fffu + ((u >> 16) & 1u)) >> 16; }
typedef float f32x2_pk __attribute__((ext_vector_type(2))); typedef __bf16 bf16x2_pk __attribute__((ext_vector_type(2)));
__device__ __forceinline__ unsigned pk2(float lo, float hi) { f32x2_pk v = {lo, hi}; bf16x2_pk b = __builtin_convertvector(v, bf16x2_pk); return __builtin_bit_cast(unsigned, b); }
__device__ __forceinline__ float bf2f(unsigned short b) { return __builtin_bit_cast(float, (unsigned)b << 16); }
__device__ __forceinline__ float wave_sum(float v) {
#pragma unroll
    for (int o = 1; o < 64; o <<= 1) v += __shfl_xor(v, o);
    return v;
}

#define XB_TMO      128
#define XB_XCNT(j)  (256  + 64 * (j))
#define XB_XSUB(j)  (1280 + 64 * (j))
#define XB_XGEN(j)  (2304 + 64 * (j))
#define XB_TOP      3328
#define XB_TOPGEN   3392
#define XCD_BAR_WORDS 3456
#define XB_SPIN_CAP (1u << 18)

__device__ __forceinline__ unsigned xb_ld(unsigned* p)              { return __hip_atomic_load(p, __ATOMIC_RELAXED, __HIP_MEMORY_SCOPE_AGENT); }
__device__ __forceinline__ unsigned xb_add(unsigned* p, unsigned v) { return __hip_atomic_fetch_add(p, v, __ATOMIC_RELAXED, __HIP_MEMORY_SCOPE_AGENT); }
__device__ __forceinline__ unsigned xb_xcc_id() { return (unsigned)__builtin_amdgcn_s_getreg((3 << 11) | 20) & 0xFu; }
#define XB_SPIN(cond, bar) do { unsigned _sp = 0; while (cond) { __builtin_amdgcn_s_sleep(1); \
    if ((++_sp & 255u) == 0u) { if (xb_ld(&(bar)[XB_TMO])) break; if (_sp > XB_SPIN_CAP) { atomicAdd(&(bar)[XB_TMO], 1u); break; } } } } while (0)

struct XcdBarrier {
    unsigned* bar; unsigned x;
    volatile LAS unsigned* st;
};

__device__ __forceinline__ XcdBarrier xcd_barrier_post(unsigned* bar, volatile LAS unsigned* st) {
    XcdBarrier b; b.bar = bar; b.x = xb_xcc_id(); b.st = st;
    if (threadIdx.x == 0) (void)xb_add(&bar[XB_XCNT(b.x)], 1u);
    return b;
}
__device__ __forceinline__ void xcd_barrier_complete(unsigned* bar, unsigned x, unsigned& nloc, unsigned& nx) {
    const unsigned G = gridDim.x * gridDim.y * gridDim.z;
    unsigned sum, cnt, mine, sp = 0u;
    for (;;) {
        sum = 0u; cnt = 0u; mine = 0u;
#pragma unroll
        for (unsigned j = 0; j < 16; ++j) { const unsigned c = xb_ld(&bar[XB_XCNT(j)]); sum += c; cnt += (c > 0u) ? 1u : 0u; mine = (j == x) ? c : mine; }
        if (sum == G) break;
        __builtin_amdgcn_s_sleep(1);
        if ((++sp & 255u) == 0u) { if (xb_ld(&bar[XB_TMO])) break; if (sp > XB_SPIN_CAP) { atomicAdd(&bar[XB_TMO], 1u); break; } }
    }
    nloc = mine > 0u ? mine : 1u; nx = cnt > 0u ? cnt : 1u;
}

__device__ __forceinline__ void xcd_barrier(const XcdBarrier& b) {
    asm volatile("s_waitcnt vmcnt(0)" ::: "memory");
    __syncthreads();
    if (threadIdx.x == 0) {
        unsigned* bar = b.bar;
        __builtin_amdgcn_s_waitcnt(0);
        unsigned nloc = b.st[0], nx = b.st[1];
        if (nloc == 0u) { xcd_barrier_complete(bar, b.x, nloc, nx); b.st[0] = nloc; b.st[1] = nx; }
        const unsigned old = xb_add(&bar[XB_XSUB(b.x)], 1u);
        const unsigned gen = old / nloc;
        if (old + 1u == (gen + 1u) * nloc) {
            __builtin_amdgcn_fence(__ATOMIC_RELEASE, "agent");
            asm volatile("s_waitcnt vmcnt(0)" ::: "memory");
            const unsigned og = xb_add(&bar[XB_TOP], 1u);
            const unsigned tg = og / nx;
            if (og + 1u == (tg + 1u) * nx) xb_add(&bar[XB_TOPGEN], 1u);
            else XB_SPIN(xb_ld(&bar[XB_TOPGEN]) == tg, bar);
            __builtin_amdgcn_fence(__ATOMIC_ACQUIRE, "agent");
            xb_add(&bar[XB_XGEN(b.x)], 1u);
            asm volatile("s_waitcnt vmcnt(0)" ::: "memory");
        } else {
            XB_SPIN(xb_ld(&bar[XB_XGEN(b.x)]) == gen, bar);
            __builtin_amdgcn_fence(__ATOMIC_ACQUIRE, "agent");
            asm volatile("s_waitcnt vmcnt(0)" ::: "memory");
        }
    }
    __syncthreads();
}

__device__ __forceinline__ void xcd_local_barrier(unsigned* bar, unsigned* ctr, unsigned n) {
    asm volatile("s_waitcnt vmcnt(0)" ::: "memory");
    __syncthreads();
    if (threadIdx.x == 0) {
        __builtin_amdgcn_s_waitcnt(0);
        const unsigned old = xb_add(ctr, 1u), target = (old / n + 1u) * n;
        XB_SPIN(xb_ld(ctr) < target, bar);
        __builtin_amdgcn_fence(__ATOMIC_ACQUIRE, "agent");
        asm volatile("s_waitcnt vmcnt(0)" ::: "memory");
    }
    __syncthreads();
}

struct Frame {
    LAS unsigned char* lds;
    volatile LAS unsigned* MISC;
    gu32* ctl;
    int tid, lane, wave;
    int vcu, G;
    int cid;
    unsigned char* ws;
};

struct TItem { const float* W; bf16* base; const float* kscale; int ldw, nvalid, k0, n0, kind, pitch, f8; };
constexpr int TI_PC = 36, TI_P1 = 8 * TI_PC, TI_BYTES = 16 * TI_P1 * 4;
template <int NI> __device__ __forceinline__ void titem_issue(const TItem& d, int lane, f32x4 (&ld)[NI]) {
    const int nq = d.n0 + 4 * (lane & 7); const bool ok = nq < d.nvalid;
#pragma unroll
    for (int i = 0; i < NI; ++i) ld[i] = ok ? __builtin_nontemporal_load((const GAS f32x4*)(d.W + (size_t)(d.k0 + (lane >> 3) + 8 * i) * d.ldw + nq)) : (f32x4){0.f, 0.f, 0.f, 0.f};
}
template <int NI> __device__ __forceinline__ void titem_finish(const TItem& d, int lane, const f32x4 (&ld)[NI], LAS float* scr, bf16* WIN, bf16* WDT) {
#pragma unroll
    for (int i = 0; i < NI; ++i) { const int k = (lane >> 3) + 8 * i; *(LAS f32x4*)(scr + (k % NI) * TI_P1 + (k / NI) * TI_PC + 4 * (lane & 7)) = ld[i]; }
    LDS_WAIT(); asm volatile("" ::: "memory");
    const int c = lane & 7;
    if constexpr (NI == 16) {
#pragma unroll
        for (int j = 0; j < 4; ++j) { const int nl = (lane >> 3) + 8 * j, n = d.n0 + nl; const LAS float* s = scr + c * TI_PC + nl;
            const size_t rowi = d.kind == 3 ? (size_t)((n & ~255) + ((n >> 3) & 1) * 128 + ((n >> 6) & 3) * 32 + ((n >> 4) & 3) * 8 + (n & 7))
                                            : (size_t)((n >> 7) * 256 + (n & 127));
            v4u q; q.x = pg8::cvt4_fp8(s[0 * TI_P1] * F8_WSCALE, s[1 * TI_P1] * F8_WSCALE, s[2 * TI_P1] * F8_WSCALE, s[3 * TI_P1] * F8_WSCALE); q.y = pg8::cvt4_fp8(s[4 * TI_P1] * F8_WSCALE, s[5 * TI_P1] * F8_WSCALE, s[6 * TI_P1] * F8_WSCALE, s[7 * TI_P1] * F8_WSCALE);
            q.z = pg8::cvt4_fp8(s[8 * TI_P1] * F8_WSCALE, s[9 * TI_P1] * F8_WSCALE, s[10 * TI_P1] * F8_WSCALE, s[11 * TI_P1] * F8_WSCALE); q.w = pg8::cvt4_fp8(s[12 * TI_P1] * F8_WSCALE, s[13 * TI_P1] * F8_WSCALE, s[14 * TI_P1] * F8_WSCALE, s[15 * TI_P1] * F8_WSCALE);
            if (n < d.nvalid) __builtin_nontemporal_store(q, (GAS v4u*)((unsigned char*)d.base + rowi * d.pitch + d.k0 + 16 * c)); }
    } else {
#pragma unroll
        for (int j = 0; j < 4; ++j) { const int nl = (lane >> 3) + 8 * j, n = d.n0 + nl; const LAS float* s = scr + c * TI_PC + nl;
            v4u o; o.x = pk2(s[0 * TI_P1], s[1 * TI_P1]); o.y = pk2(s[2 * TI_P1], s[3 * TI_P1]); o.z = pk2(s[4 * TI_P1], s[5 * TI_P1]); o.w = pk2(s[6 * TI_P1], s[7 * TI_P1]);
            bf16* row;
            if (d.kind == 0) row = n < 2560 ? WIN + (size_t)n * DM : (n < 2576 ? WIN + (size_t)(NIN + n - 2560) * DM : WIN + (size_t)(n - 16) * DM);
            else row = d.base + (size_t)n * d.pitch;
            if (n < d.nvalid) *(GAS v4u*)(row + d.k0 + 8 * c) = o; }
    }
    LDS_WAIT(); asm volatile("" ::: "memory");
}

struct Args { const void* in[26]; float* out; unsigned char* ws; int ph_lo, ph_hi, li, p0_mask, rep_phase, pad; };
typedef const __attribute__((address_space(4))) Args* KA;

constexpr int P0B_NBLK = 3 * NE * 128, P0B_NSUB = 4 * P0B_NBLK;
__device__ __forceinline__ void p0b_blocks(Frame& F, KA args, int first, int nq, int gstride = 1) {
    const int lane = F.lane;
    const float* w_gate = (const float*)args->in[23]; const float* w_up = (const float*)args->in[24]; const float* w_down = (const float*)args->in[25];
    bf16* WGU = (bf16*)(F.ws + mp::wgu); bf16* WD = (bf16*)(F.ws + mp::wd);
    LAS float* scr = (LAS float*)(F.lds + F.wave * TI_BYTES);
    auto decodeB = [&](int q) -> TItem {
        const int g = first + q * gstride, cb = g >> 2, i = g & 3;
        if (cb < 8192) { const int up = cb >> 12, r = cb & 4095, e = r >> 7, kb = (r >> 3) & 15, nb = r & 7;
            return TItem{(up ? w_up : w_gate) + (size_t)e * DM * EH, (bf16*)((unsigned char*)WGU + (size_t)e * 2048 * DM + (up ? (size_t)128 * DM : 0)), nullptr, EH, EH, 128 * kb, 128 * nb + 32 * i, 2, DM, 1}; }
        const int r = cb - 8192, e = r >> 7, kb = (r >> 4) & 7, nb = r & 15;
        return TItem{w_down + (size_t)e * EH * DM, (bf16*)((unsigned char*)WD + (size_t)e * DM * EH), nullptr, DM, DM, 128 * kb, 128 * nb + 32 * i, 3, EH, 1};
    };
    if (nq <= 0) return;
    TItem d0 = decodeB(0), d1 = d0, d2 = d0; f32x4 l0[16], l1[16], l2[16];
    titem_issue<16>(d0, lane, l0);
    if (nq > 1) { d1 = decodeB(1); titem_issue<16>(d1, lane, l1); }
    for (int q = 0; q < nq; q += 3) {
        if (q + 2 < nq) { d2 = decodeB(q + 2); titem_issue<16>(d2, lane, l2); }
        titem_finish<16>(d0, lane, l0, scr, nullptr, nullptr);
        if (q + 1 >= nq) break;
        if (q + 3 < nq) { d0 = decodeB(q + 3); titem_issue<16>(d0, lane, l0); }
        titem_finish<16>(d1, lane, l1, scr, nullptr, nullptr);
        if (q + 2 >= nq) break;
        if (q + 4 < nq) { d1 = decodeB(q + 4); titem_issue<16>(d1, lane, l1); }
        titem_finish<16>(d2, lane, l2, scr, nullptr, nullptr);
    }
}
constexpr int P1_UNITS = (M / 256) * (NIN_G / 256);
#if P1_HOSTS_P0B == 2
constexpr int P1_INLOOP_BLOCKS = P1_UNITS * NWAVES;
static_assert(P0B_NBLK - P1_INLOOP_BLOCKS == 64 * NWAVES, "the 64 CUs with one GEMM unit less take one more block per wave");
#endif
#ifndef P1_SKEW
#define P1_SKEW 1
#endif
__device__ __forceinline__ void p1_convert_share(Frame& F, KA args, int part) {
    const int c = F.cid, xcd = c & 7, l = c >> 3;
    constexpr int E0[8] = {21, 0, 0, 11, 0, 11, 7, 14}, E1[8] = {21, 21, 0, 21, 11, 11, 14, 14};
    const int e0 = P1_SKEW ? E0[xcd] : 21, e1 = P1_SKEW ? E1[xcd] : 21;
    const int ex = l < 24 ? 0 : 12, q = 21 + ex;
    const int base = xcd * (P0B_NSUB / 8);
    const int first = l < 24 ? base + l * (NWAVES * 21) : base + 24 * NWAVES * 21 + (l - 24) * (NWAVES * 33);
    const int lo = part == 0 ? 0 : ex + (part == 1 ? e0 : e1), hi = ex + (part == 0 ? e0 : (part == 1 ? e1 : 21));
    p0b_blocks(F, args, first + F.wave * q + lo, hi - lo);
}

__device__ __forceinline__ void p0_prologue(Frame& F, KA args) {
    const int gw = F.vcu * NWAVES + F.wave, NGW = F.G * NWAVES, lane = F.lane;
    const float* w_in = (const float*)args->in[3]; const float* w_out = (const float*)args->in[17];
    bf16* WIN = (bf16*)(F.ws + mp::win); bf16* WDT = nullptr; bf16* WOUT = (bf16*)(F.ws + mp::wout);
    constexpr int NB_IN = (IN_COLS + 31) / 32;
    constexpr int I_IN = (DM / 64) * NB_IN, I_OUT = (DM / 64) * (DM / 32), NITEMS_A = I_IN + I_OUT;
    LAS float* scr = (LAS float*)(F.lds + F.wave * TI_BYTES);
    auto decodeA = [&](int it) -> TItem {
        int r = it;
        if (r < I_IN) { const int kb = r / NB_IN, nb = r % NB_IN; return TItem{w_in, WIN, nullptr, IN_COLS, IN_COLS, 64 * kb, 32 * nb, 0, DM, 0}; }
        r -= I_IN; const int kb = r / (DM / 32), nb = r % (DM / 32); return TItem{w_out, WOUT, nullptr, DM, DM, 64 * kb, 32 * nb, 1, DM, 0};
    };
    if (gw < NITEMS_A) {
        TItem dc = decodeA(gw); f32x4 la[8], lb[8];
        titem_issue<8>(dc, lane, la);
        for (int it = gw; it < NITEMS_A; it += NGW) {
            const int nx = it + NGW; TItem dn = dc;
            if (nx < NITEMS_A) { dn = decodeA(nx); titem_issue<8>(dn, lane, lb); }
            titem_finish<8>(dc, lane, la, scr, WIN, WDT);
            dc = dn;
#pragma unroll
            for (int i = 0; i < 8; ++i) la[i] = lb[i];
        }
    }
#if !P1_HOSTS_P0B
    p0b_blocks(F, args, gw * (P0B_NSUB / NGW), P0B_NSUB / NGW);
#endif
    const float* x = (const float*)args->in[0]; const float* ln1 = (const float*)args->in[2]; bf16* XN = (bf16*)(F.ws + mp::xn);
    for (int m0 = gw * 2; m0 < M; m0 += NGW * 2) {
        f32x4 v[2][8];
#pragma unroll
        for (int rr = 0; rr < 2; ++rr)
#pragma unroll
            for (int j = 0; j < 8; ++j) v[rr][j] = __builtin_nontemporal_load((const GAS f32x4*)(x + (size_t)(m0 + rr) * DM) + lane + 64 * j);
#pragma unroll
        for (int rr = 0; rr < 2; ++rr) { float s = 0.f;
#pragma unroll
            for (int j = 0; j < 8; ++j) s += (v[rr][j].x * v[rr][j].x + v[rr][j].y * v[rr][j].y) + (v[rr][j].z * v[rr][j].z + v[rr][j].w * v[rr][j].w);
            const float r = 1.0f / sqrtf(wave_sum(s) * (1.f / DM) + EPS);
            GAS v2u* o8 = (GAS v2u*)(XN + (size_t)(m0 + rr) * DM) + lane; const GAS f32x4* wr = (const GAS f32x4*)ln1 + lane;
#pragma unroll
            for (int j = 0; j < 8; ++j) { const f32x4 ww = wr[64 * j]; v2u o; o.x = pk2(v[rr][j].x * r * ww.x, v[rr][j].y * r * ww.y); o.y = pk2(v[rr][j].z * r * ww.z, v[rr][j].w * r * ww.w); o8[64 * j] = o; } }
    }
}


__device__ __forceinline__ void p0_rope(Frame& F, KA args) {
    const int gt = (F.vcu * NWAVES + F.wave) * 64 + F.lane, NGT = F.G * NWAVES * 64;
    const int* pos = (const int*)args->in[1]; float* rope = (float*)(F.ws + mp::rope);
    for (int i = gt; i < M * 8; i += NGT) { const int m = i >> 3, j = i & 7;
        const float inv_freq = powf(500000.0f, -(float)(2 * j) / 16.0f);
        const float ang = (float)pos[m] * inv_freq;
        rope[m * 16 + j] = cosf(ang); rope[m * 16 + 8 + j] = sinf(ang); }
}

__device__ __forceinline__ void p2_qknorm(Frame& F, KA args) {
    const int gw = F.vcu * NWAVES + F.wave, NGW = F.G * NWAVES, lane = F.lane;
    const bf16* U16 = (const bf16*)(F.ws + mp::u16); const float* rope = (const float*)(F.ws + mp::rope);
    bf16* QN = (bf16*)(F.ws + mp::qn); bf16* KN = (bf16*)(F.ws + mp::kn);
    const float* qw = (const float*)args->in[10]; const float* kw = (const float*)args->in[11];
    const int sub = lane & 7;
    float wq[8], wk[8];
#pragma unroll
    for (int j = 0; j < 8; ++j) { wq[j] = qw[sub * 8 + j] * attn_body::C2; wk[j] = kw[sub * 8 + j]; }
    for (int it = 0; it < 2; ++it) { const int m0 = (F.vcu >> 5) * 2048 + it * 1024 + ((F.vcu & 31) * NWAVES + F.wave) * 4;
        v4u raw[4][4]; f32x4 rp[4][4];
#pragma unroll
        for (int rr = 0; rr < 4; ++rr) {
#pragma unroll
            for (int pc = 0; pc < 4; ++pc) raw[rr][pc] = __builtin_nontemporal_load((const GAS v4u*)(U16 + (size_t)(m0 + rr) * NIN + ((pc >> 1) ? UC_K : UC_Q) + (pc & 1) * 512 + lane * 8));
#pragma unroll
            for (int q = 0; q < 4; ++q) rp[rr][q] = *(const GAS f32x4*)(rope + (size_t)(m0 + rr) * 16 + 4 * q);
        }
#pragma unroll
        for (int rr = 0; rr < 4; ++rr) {
            const int m = m0 + rr;
            const float cs[8] = {rp[rr][0].x, rp[rr][0].y, rp[rr][0].z, rp[rr][0].w, rp[rr][1].x, rp[rr][1].y, rp[rr][1].z, rp[rr][1].w};
            const float sn[8] = {rp[rr][2].x, rp[rr][2].y, rp[rr][2].z, rp[rr][2].w, rp[rr][3].x, rp[rr][3].y, rp[rr][3].z, rp[rr][3].w};
#pragma unroll
            for (int pc = 0; pc < 4; ++pc) {
                const int isk = pc >> 1, col = (pc & 1) * 512 + lane * 8;
                const v4u rw = raw[rr][pc];
                float v[8];
                v[0] = __builtin_bit_cast(float, rw.x << 16); v[1] = __builtin_bit_cast(float, rw.x & 0xffff0000u); v[2] = __builtin_bit_cast(float, rw.y << 16); v[3] = __builtin_bit_cast(float, rw.y & 0xffff0000u);
                v[4] = __builtin_bit_cast(float, rw.z << 16); v[5] = __builtin_bit_cast(float, rw.z & 0xffff0000u); v[6] = __builtin_bit_cast(float, rw.w << 16); v[7] = __builtin_bit_cast(float, rw.w & 0xffff0000u);
                float ss = 0.f;
#pragma unroll
                for (int j = 0; j < 8; ++j) ss += v[j] * v[j];
                ss += __shfl_xor(ss, 1); ss += __shfl_xor(ss, 2); ss += __shfl_xor(ss, 4);
                const float r = 1.0f / sqrtf(ss * (1.f / 64.f) + EPS);
                float y[8];
#pragma unroll
                for (int j = 0; j < 8; ++j) y[j] = v[j] * r * (isk ? wk[j] : wq[j]);
#pragma unroll
                for (int j = 0; j < 8; ++j) { const float pv = __shfl_xor(y[j], 1);
                    if (sub == 0) y[j] = y[j] * cs[j] - pv * sn[j]; else if (sub == 1) y[j] = y[j] * cs[j] + pv * sn[j]; }
                v4u o; o.x = pk2(y[0], y[1]); o.y = pk2(y[2], y[3]); o.z = pk2(y[4], y[5]); o.w = pk2(y[6], y[7]);
                *(GAS v4u*)((isk ? KN : QN) + (size_t)m * 1024 + col) = o;
            }
        }
    }
}

struct AttnOrder { int vcu;
  __device__ __forceinline__ bool next(int i, int& bh, int& qb) const { if (i >= 8) return false; const int s = vcu & 7; bh = vcu; qb = (i + s) & 7; return true; } };
__device__ __forceinline__ void p3_attention(Frame& F, KA args, unsigned char* lds_generic) {
    const attn_body::bf16* QN = (const attn_body::bf16*)(F.ws + mp::qn); const attn_body::bf16* KN = (const attn_body::bf16*)(F.ws + mp::kn);
    const attn_body::bf16* U16 = (const attn_body::bf16*)(F.ws + mp::u16); attn_body::bf16* O1 = (attn_body::bf16*)(F.ws + mp::o1); attn_body::bf16* O2 = (attn_body::bf16*)(F.ws + mp::o2);
    AttnOrder S{F.vcu}; int bh, qb;
    for (int i = 0; S.next(i, bh, qb); ++i) {
        const int b = bh >> 5, h = (bh >> 2) & 7, comp = (bh >> 1) & 1, vh = bh & 1;
        attn_body::attn_unit<8>(b, 0, qb, QN + (h * 2 + comp) * 64, KN + (h * 2 + comp) * 64, U16 + UC_V + h * 128 + vh * 64, (comp ? O2 : O1) + h * 128 + vh * 64, (char*)lds_generic + RING_OFF);
    }
}

__device__ __forceinline__ void p4_ycat(Frame& F, KA args, int parts) {
    const int gw = F.vcu * NWAVES + F.wave, NGW = F.G * NWAVES, lane = F.lane;
    const bf16* U16 = (const bf16*)(F.ws + mp::u16); const bf16* YS = (const bf16*)(F.ws + mp::ys);
    const bf16* O1 = (const bf16*)(F.ws + mp::o1); const bf16* O2 = (const bf16*)(F.ws + mp::o2); bf16* YCAT = (bf16*)(F.ws + mp::ycat);
    const float* nw = (const float*)args->in[9]; const float* subw = (const float*)args->in[16];
    float lam;
    { const float* lq1 = (const float*)args->in[12]; const float* lk1 = (const float*)args->in[13]; const float* lq2 = (const float*)args->in[14]; const float* lk2 = (const float*)args->in[15];
      const float s1 = wave_sum(lq1[lane] * lk1[lane]), s2 = wave_sum(lq2[lane] * lk2[lane]); lam = expf(s1) - expf(s2) + 0.2f; }
    float w_s[2][8], w_a[8];
#pragma unroll
    for (int j = 0; j < 8; ++j) { w_s[0][j] = nw[lane * 8 + j]; w_s[1][j] = nw[512 + lane * 8 + j]; w_a[j] = subw[(lane & 15) * 8 + j] * 0.8f; }
    for (int it = 0; it < 4; ++it) { const int m0 = (F.vcu >> 5) * 2048 + it * 512 + ((F.vcu & 31) * NWAVES + F.wave) * 2;
        v4u yv[2][2], zv[2][2], av[2][2], bv[2][2];
#pragma unroll
        for (int rr = 0; rr < 2; ++rr) { const size_t m = (size_t)(m0 + rr);
#pragma unroll
            for (int sl = 0; sl < 2; ++sl) {
                if (parts & 1) { yv[rr][sl] = __builtin_nontemporal_load((const GAS v4u*)(YS + m * 1024 + 512 * sl + lane * 8)); zv[rr][sl] = __builtin_nontemporal_load((const GAS v4u*)(U16 + m * NIN + UC_Z + 512 * sl + lane * 8)); }
                if (parts & 2) { av[rr][sl] = __builtin_nontemporal_load((const GAS v4u*)(O1 + m * 1024 + 512 * sl + lane * 8)); bv[rr][sl] = __builtin_nontemporal_load((const GAS v4u*)(O2 + m * 1024 + 512 * sl + lane * 8)); } } }
#pragma unroll
        for (int rr = 0; rr < 2; ++rr) { const size_t m = (size_t)(m0 + rr);
#pragma unroll
        for (int sl = 0; sl < 2; ++sl) {
        if (parts & 1) {
            const v4u y0 = yv[rr][sl], z0 = zv[rr][sl];
            const unsigned yy[4] = {y0.x, y0.y, y0.z, y0.w}, zz[4] = {z0.x, z0.y, z0.z, z0.w};
            float v[8]; float ss = 0.f;
#pragma unroll
            for (int j = 0; j < 4; ++j) { const float ya = __builtin_bit_cast(float, yy[j] << 16), yb = __builtin_bit_cast(float, yy[j] & 0xffff0000u), za = __builtin_bit_cast(float, zz[j] << 16), zb = __builtin_bit_cast(float, zz[j] & 0xffff0000u);
                v[2 * j] = ya * za / (1.f + __expf(-za)); v[2 * j + 1] = yb * zb / (1.f + __expf(-zb)); ss += v[2 * j] * v[2 * j] + v[2 * j + 1] * v[2 * j + 1]; }
            ss = wave_sum(ss);
            const float r = 1.0f / sqrtf(ss * (1.f / 512.f) + EPS);
            v4u o0; o0.x = pk2(v[0] * r * w_s[sl][0], v[1] * r * w_s[sl][1]); o0.y = pk2(v[2] * r * w_s[sl][2], v[3] * r * w_s[sl][3]); o0.z = pk2(v[4] * r * w_s[sl][4], v[5] * r * w_s[sl][5]); o0.w = pk2(v[6] * r * w_s[sl][6], v[7] * r * w_s[sl][7]);
            *(GAS v4u*)(YCAT + m * DM + 512 * sl + lane * 8) = o0;
        }
        if (parts & 2) {
            const v4u a0 = av[rr][sl], b0 = bv[rr][sl];
            const unsigned aa[4] = {a0.x, a0.y, a0.z, a0.w}, bb[4] = {b0.x, b0.y, b0.z, b0.w};
            float v[8]; float ss = 0.f;
#pragma unroll
            for (int j = 0; j < 4; ++j) { v[2 * j] = __builtin_bit_cast(float, aa[j] << 16) - lam * __builtin_bit_cast(float, bb[j] << 16); v[2 * j + 1] = __builtin_bit_cast(float, aa[j] & 0xffff0000u) - lam * __builtin_bit_cast(float, bb[j] & 0xffff0000u);
                ss += v[2 * j] * v[2 * j] + v[2 * j + 1] * v[2 * j + 1]; }
            ss += __shfl_xor(ss, 1); ss += __shfl_xor(ss, 2); ss += __shfl_xor(ss, 4); ss += __shfl_xor(ss, 8);
            const float r = 1.0f / sqrtf(ss * (1.f / 128.f) + EPS);
            v4u o0; o0.x = pk2(v[0] * r * w_a[0], v[1] * r * w_a[1]); o0.y = pk2(v[2] * r * w_a[2], v[3] * r * w_a[3]); o0.z = pk2(v[4] * r * w_a[4], v[5] * r * w_a[5]); o0.w = pk2(v[6] * r * w_a[6], v[7] * r * w_a[7]);
            *(GAS v4u*)(YCAT + m * DM + 1024 + 512 * sl + lane * 8) = o0;
        }
        }
        }
    }
}

constexpr int CONV_R = 8;
__device__ __forceinline__ void p2_conv(Frame& F, KA args) {
    const int gw = F.vcu * NWAVES + F.wave, NGW = F.G * NWAVES, lane = F.lane;
    const bf16* U16 = (const bf16*)(F.ws + mp::u16); bf16* XBC = (bf16*)(F.ws + mp::xbc);
    const float* cw = (const float*)args->in[4]; const float* cb = (const float*)args->in[5];
    for (int it = 0; it < 3; ++it) { const int task = (F.vcu & 31) * NWAVES + F.wave + 256 * it;
        const int cblk = task % 3, r0 = (F.vcu >> 5) * 2048 + (task / 3) * CONV_R, c0 = cblk * 512 + lane * 8;
        const bool seq_start = (r0 % SEQ) == 0;
        v4u raw[CONV_R + 3];
#pragma unroll
        for (int j = 0; j < CONV_R + 3; ++j) { raw[j] = (v4u){0u, 0u, 0u, 0u}; if (j >= 3 || !seq_start) raw[j] = __builtin_nontemporal_load((const GAS v4u*)(U16 + (size_t)(r0 - 3 + j) * NIN + UC_XBC + c0)); }
        float w[4][8], bias[8];
#pragma unroll
        for (int j = 0; j < 4; ++j)
#pragma unroll
            for (int i = 0; i < 8; ++i) w[j][i] = cw[j * 1536 + c0 + i];
#pragma unroll
        for (int i = 0; i < 8; ++i) bias[i] = cb[c0 + i];
#pragma unroll
        for (int t = 0; t < CONV_R; ++t) {
            float o[8];
#pragma unroll
            for (int i = 0; i < 8; ++i) o[i] = bias[i];
#pragma unroll
            for (int j = 0; j < 4; ++j) { const v4u rw = raw[t + j];
                const float e[8] = {__builtin_bit_cast(float, rw.x << 16), __builtin_bit_cast(float, rw.x & 0xffff0000u), __builtin_bit_cast(float, rw.y << 16), __builtin_bit_cast(float, rw.y & 0xffff0000u),
                                    __builtin_bit_cast(float, rw.z << 16), __builtin_bit_cast(float, rw.z & 0xffff0000u), __builtin_bit_cast(float, rw.w << 16), __builtin_bit_cast(float, rw.w & 0xffff0000u)};
#pragma unroll
                for (int i = 0; i < 8; ++i) o[i] += w[j][i] * e[i]; }
#pragma unroll
            for (int i = 0; i < 8; ++i) o[i] = o[i] / (1.f + __expf(-o[i]));
            v4u ov; ov.x = pk2(o[0], o[1]); ov.y = pk2(o[2], o[3]); ov.z = pk2(o[4], o[5]); ov.w = pk2(o[6], o[7]);
            *(GAS v4u*)(XBC + (size_t)(r0 + t) * 1536 + c0) = ov;
        }
    }
}

namespace ssd {
constexpr int BCS = 2064;
constexpr int LB = 0, LC = LB + 16 * BCS, LX = LC + 16 * BCS, LXW = LX + 8192, LST = LXW + 8192, STB = 8704, LA = LST + 2 * STB, LSL = LA + 4096, SSD_LDS_END = LSL + 10 * 4096;
static_assert(SSD_LDS_END <= LDSCTL_OFF, "SSD tiles vs LDS control words");
typedef float f32x16 __attribute__((ext_vector_type(16)));
#define SSD_PIN8(a) asm volatile("" : "+v"(a[0]), "+v"(a[1]), "+v"(a[2]), "+v"(a[3]), "+v"(a[4]), "+v"(a[5]), "+v"(a[6]), "+v"(a[7]))
#define SSD_PIN4(a) asm volatile("" : "+v"(a[0]), "+v"(a[1]), "+v"(a[2]), "+v"(a[3]))
struct Ctx { LAS unsigned char* lds; const LAS float* a2; const LAS float* dtl; const LAS float* fsl; int lane, r32, hi; };
__device__ __forceinline__ void load_cf(const Ctx& c, int lb, bf16x8 (&cf)[8]) {
#pragma unroll
    for (int ks = 0; ks < 8; ++ks) cf[ks] = *(const LAS bf16x8*)(c.lds + LC + (2 * ks + c.hi) * BCS + (32 * lb + c.r32) * 16);
    SSD_PIN8(cf);
}
template <bool DIAG> __device__ __forceinline__ void intra(const Ctx& c, int lb, int st, const bf16x8 (&cf)[8], f32x16& y) {
    bf16x8 bq[8];
#pragma unroll
    for (int ks = 0; ks < 8; ++ks) bq[ks] = *(const LAS bf16x8*)(c.lds + LB + (2 * ks + c.hi) * BCS + (32 * st + c.r32) * 16);
    f32x4 av[4], dv[4];
#pragma unroll
    for (int q = 0; q < 4; ++q) { av[q] = *(const LAS f32x4*)((DIAG ? c.a2 : c.fsl) + 32 * st + 8 * q + 4 * c.hi); if (DIAG) dv[q] = *(const LAS f32x4*)(c.dtl + 32 * st + 8 * q + 4 * c.hi); }
    const float al = c.a2[32 * lb + c.r32], aref = c.a2[32 * st + 31];
    SSD_PIN8(bq); SSD_PIN4(av); if (DIAG) SSD_PIN4(dv);
    f32x16 p;
#pragma unroll
    for (int r = 0; r < 16; ++r) p[r] = 0.f;
#pragma unroll
    for (int ks = 0; ks < 8; ++ks) p = __builtin_amdgcn_mfma_f32_32x32x16_bf16(bq[ks], cf[ks], p, 0, 0, 0);
    if (DIAG) {
        float e[16];
#pragma unroll
        for (int r = 0; r < 16; ++r) e[r] = __builtin_amdgcn_exp2f(fminf(al - av[r >> 2][r & 3], 0.f));
#pragma unroll
        for (int r = 0; r < 16; ++r) { const int sl = attn_body::crow(r, c.hi); const float v = p[r] * e[r] * dv[r >> 2][r & 3]; p[r] = sl > c.r32 ? 0.f : v; }
    } else {
        const float el = __builtin_amdgcn_exp2f(al - aref);
#pragma unroll
        for (int r = 0; r < 16; ++r) p[r] *= el * av[r >> 2][r & 3];
    }
    v4u pw0, pw1;
    pw0.x = attn_body::cvtpk_s(p[0], p[1]); pw0.y = attn_body::cvtpk_s(p[2], p[3]); pw0.z = attn_body::cvtpk_s(p[4], p[5]); pw0.w = attn_body::cvtpk_s(p[6], p[7]);
    pw1.x = attn_body::cvtpk_s(p[8], p[9]); pw1.y = attn_body::cvtpk_s(p[10], p[11]); pw1.z = attn_body::cvtpk_s(p[12], p[13]); pw1.w = attn_body::cvtpk_s(p[14], p[15]);
    const LAS unsigned char* xb = c.lds + LX + ((c.lane >> 4) & 1) * 32 + (c.lane & 3) * 8 + (4 * c.hi + ((c.lane & 15) >> 2)) * 64 + (32 * st) * 64;
    const attn_body::s16x4 lo0 = attn_body::vtr((attn_body::lds_cptr)(xb)), hh0 = attn_body::vtr((attn_body::lds_cptr)(xb + 512));
    const attn_body::s16x4 lo1 = attn_body::vtr((attn_body::lds_cptr)(xb + 1024)), hh1 = attn_body::vtr((attn_body::lds_cptr)(xb + 1024 + 512));
    y = __builtin_amdgcn_mfma_f32_32x32x16_bf16(__builtin_bit_cast(bf16x8, pw0), (bf16x8){lo0[0], lo0[1], lo0[2], lo0[3], hh0[0], hh0[1], hh0[2], hh0[3]}, y, 0, 0, 0);
    y = __builtin_amdgcn_mfma_f32_32x32x16_bf16(__builtin_bit_cast(bf16x8, pw1), (bf16x8){lo1[0], lo1[1], lo1[2], lo1[3], hh1[0], hh1[1], hh1[2], hh1[3]}, y, 0, 0, 0);
}
__device__ __forceinline__ void yoff(const Ctx& c, int lb, int sbuf, f32x16& y) {
    bf16x8 cf[8], sf[8]; f32x4 av[4];
    load_cf(c, lb, cf);
#pragma unroll
    for (int ks = 0; ks < 8; ++ks) sf[ks] = *(const LAS bf16x8*)(c.lds + LST + sbuf * STB + c.r32 * 272 + (16 * ks + 8 * c.hi) * 2);
#pragma unroll
    for (int q = 0; q < 4; ++q) av[q] = *(const LAS f32x4*)(c.a2 + 32 * lb + 8 * q + 4 * c.hi);
    SSD_PIN8(cf); SSD_PIN8(sf); SSD_PIN4(av);
#pragma unroll
    for (int r = 0; r < 16; ++r) y[r] = 0.f;
#pragma unroll
    for (int ks = 0; ks < 8; ++ks) y = __builtin_amdgcn_mfma_f32_32x32x16_bf16(cf[ks], sf[ks], y, 0, 0, 0);
#pragma unroll
    for (int r = 0; r < 16; ++r) y[r] *= __builtin_amdgcn_exp2f(av[r >> 2][r & 3]);
}
__device__ __forceinline__ void state_item(const Ctx& c, int nt, int nbuf, f32x16& st) {
    const int i16 = c.lane & 15, g1 = (c.lane >> 4) & 1;
    const float dall = __builtin_amdgcn_exp2f(c.a2[127]);
#pragma unroll
    for (int r = 0; r < 16; ++r) st[r] *= dall;
    const LAS unsigned char* ab = c.lds + LB + (4 * nt + 2 * g1 + ((i16 & 3) >> 1)) * BCS + (8 * c.hi + (i16 >> 2)) * 16 + (i16 & 1) * 8;
    const LAS unsigned char* wb = c.lds + LXW + (8 * c.hi + (i16 >> 2)) * 64 + g1 * 32 + (i16 & 3) * 8;
#pragma unroll
    for (int kb = 0; kb < 2; ++kb) {
        bf16x8 af[4], wf[4];
#pragma unroll
        for (int kk = 0; kk < 4; ++kk) { const int ks = kb * 4 + kk;
            const attn_body::s16x4 a0 = attn_body::vtr((attn_body::lds_cptr)(ab + ks * 256)), a1 = attn_body::vtr((attn_body::lds_cptr)(ab + ks * 256 + 64));
            const attn_body::s16x4 w0 = attn_body::vtr((attn_body::lds_cptr)(wb + ks * 1024)), w1 = attn_body::vtr((attn_body::lds_cptr)(wb + ks * 1024 + 256));
            af[kk] = (bf16x8){a0[0], a0[1], a0[2], a0[3], a1[0], a1[1], a1[2], a1[3]}; wf[kk] = (bf16x8){w0[0], w0[1], w0[2], w0[3], w1[0], w1[1], w1[2], w1[3]}; }
        SSD_PIN4(af); SSD_PIN4(wf);
#pragma unroll
        for (int kk = 0; kk < 4; ++kk) st = __builtin_amdgcn_mfma_f32_32x32x16_bf16(af[kk], wf[kk], st, 0, 0, 0);
    }
#pragma unroll
    for (int q = 0; q < 4; ++q) { v2u w; w.x = attn_body::cvtpk_s(st[4 * q], st[4 * q + 1]); w.y = attn_body::cvtpk_s(st[4 * q + 2], st[4 * q + 3]);
        *(LAS v2u*)(c.lds + LST + nbuf * STB + c.r32 * 272 + (32 * nt + 8 * q + 4 * c.hi) * 2) = w; }
}
__device__ __forceinline__ void put_slot(const Ctx& c, int slot, const f32x16& y) {
    LAS float* sp = (LAS float*)(c.lds + LSL + slot * 4096);
#pragma unroll
    for (int r = 0; r < 16; ++r) sp[attn_body::crow(r, c.hi) * 32 + c.r32] = y[r];
}
__device__ __forceinline__ void unit(Frame& F, KA args, int u) {
    const int tid = F.tid, lane = F.lane, wave = F.wave, r32 = lane & 31, hi = lane >> 5;
    const int b = u >> 5, h = (u >> 1) & 15, ph = u & 1, g = h >> 3;
    const bf16* XBC = (const bf16*)(F.ws + mp::xbc); const float* DTR = (const float*)(F.ws + mp::dt); bf16* YS = (bf16*)(F.ws + mp::ys);
    const float dtb = ((const float*)args->in[6])[h], Ah = -expf(((const float*)args->in[7])[h]) * 1.44269504089f, Dk = ((const float*)args->in[8])[h];
    LAS unsigned char* lds = F.lds + RING_OFF;
    const size_t mbase = (size_t)b * SEQ;
    const int brow = tid >> 4, bchk = tid & 15;
    const int xrow = tid >> 2, xpc = tid & 3;
    v4u Breg[4], Creg[4], xreg;
#define SSD_LOAD_REGS(k_) do { const size_t m0_ = mbase + (size_t)(k_) * 128; \
        _Pragma("unroll") for (int i = 0; i < 4; ++i) { Breg[i] = *(const GAS v4u*)(XBC + (m0_ + brow + 32 * i) * 1536 + 1024 + g * 128 + bchk * 8); Creg[i] = *(const GAS v4u*)(XBC + (m0_ + brow + 32 * i) * 1536 + 1280 + g * 128 + bchk * 8); } \
        xreg = *(const GAS v4u*)(XBC + (m0_ + xrow) * 1536 + h * 64 + ph * 32 + xpc * 8); } while (0)
    float dtr0 = 0.f, dtr1 = 0.f;
#define SSD_LOAD_DT(k_) do { const size_t m0_ = mbase + (size_t)(k_) * 128; dtr0 = DTR[(m0_ + 2 * lane) * 16 + h]; dtr1 = DTR[(m0_ + 2 * lane + 1) * 16 + h]; } while (0)
#define SSD_PREP_A(buf_) do { \
        const float r0 = dtr0 + dtb, r1 = dtr1 + dtb; \
        const float d0 = r0 > 20.f ? r0 : log1pf(expf(r0)), d1 = r1 > 20.f ? r1 : log1pf(expf(r1)); \
        const float v0 = d0 * Ah, v1 = d1 * Ah; float s_ = v0 + v1; \
        _Pragma("unroll") for (int o = 1; o < 64; o <<= 1) { const float t = __shfl_up(s_, o); if (lane >= o) s_ += t; } \
        LAS float* a2w = (LAS float*)(lds + LA + (buf_) * 2048); LAS float* dtw = a2w + 128; LAS float* fw = a2w + 256; \
        const float aref_ = __shfl(s_, (lane & 48) | 15); \
        a2w[2 * lane] = s_ - v1; a2w[2 * lane + 1] = s_; dtw[2 * lane] = d0; dtw[2 * lane + 1] = d1; \
        fw[2 * lane] = __builtin_amdgcn_exp2f(aref_ - (s_ - v1)) * d0; fw[2 * lane + 1] = __builtin_amdgcn_exp2f(aref_ - s_) * d1; } while (0)
    f32x16 stA, stB;
#pragma unroll
    for (int r = 0; r < 16; ++r) { stA[r] = 0.f; stB[r] = 0.f; }
    SSD_LOAD_REGS(0);
    if (wave == 1) { SSD_LOAD_DT(0); SSD_PREP_A(0); }
    LDS_WAIT(); __syncthreads();
#pragma nounroll
    for (int k = 0; k < 16; ++k) {
        const int buf = k & 1, nb = buf ^ 1; const size_t m0 = mbase + (size_t)k * 128;
        Ctx c; c.lds = lds; c.a2 = (const LAS float*)(lds + LA + buf * 2048); c.dtl = c.a2 + 128; c.fsl = c.a2 + 256; c.lane = lane; c.r32 = r32; c.hi = hi;
#pragma unroll
        for (int i = 0; i < 4; ++i) { *(LAS v4u*)(lds + LB + bchk * BCS + (brow + 32 * i) * 16) = Breg[i]; *(LAS v4u*)(lds + LC + bchk * BCS + (brow + 32 * i) * 16) = Creg[i]; }
        *(LAS v4u*)(lds + LX + xrow * 64 + xpc * 16) = xreg;
        { const float wsc = __builtin_amdgcn_exp2f(c.a2[127] - c.a2[xrow]) * c.dtl[xrow];
          const float x0 = __builtin_bit_cast(float, xreg.x << 16) * wsc, x1 = __builtin_bit_cast(float, xreg.x & 0xffff0000u) * wsc, x2 = __builtin_bit_cast(float, xreg.y << 16) * wsc, x3 = __builtin_bit_cast(float, xreg.y & 0xffff0000u) * wsc;
          const float x4 = __builtin_bit_cast(float, xreg.z << 16) * wsc, x5 = __builtin_bit_cast(float, xreg.z & 0xffff0000u) * wsc, x6 = __builtin_bit_cast(float, xreg.w << 16) * wsc, x7 = __builtin_bit_cast(float, xreg.w & 0xffff0000u) * wsc;
          v4u xw; xw.x = pk2(x0, x1); xw.y = pk2(x2, x3); xw.z = pk2(x4, x5); xw.w = pk2(x6, x7);
          *(LAS v4u*)(lds + LXW + xrow * 64 + xpc * 16) = xw; }
        LDS_WAIT(); __syncthreads();
        if (k < 15) { SSD_LOAD_REGS(k + 1); if (wave == 1) SSD_LOAD_DT(k + 1); }
        {
            f32x16 y; bf16x8 cf[8];
#pragma unroll
            for (int r = 0; r < 16; ++r) y[r] = 0.f;
            if (wave == 0)      { load_cf(c, 3, cf); intra<true>(c, 3, 3, cf, y); intra<false>(c, 3, 2, cf, y); put_slot(c, 0, y); }
            else if (wave == 1) { load_cf(c, 3, cf); intra<false>(c, 3, 1, cf, y); intra<false>(c, 3, 0, cf, y); put_slot(c, 1, y); if (k < 15) SSD_PREP_A(nb); }
            else if (wave == 2) { load_cf(c, 2, cf); intra<true>(c, 2, 2, cf, y); intra<false>(c, 2, 1, cf, y); put_slot(c, 3, y); }
            else if (wave == 3) { load_cf(c, 2, cf); intra<false>(c, 2, 0, cf, y); put_slot(c, 4, y);
#pragma unroll
                                  for (int r = 0; r < 16; ++r) y[r] = 0.f;
                                  load_cf(c, 0, cf); intra<true>(c, 0, 0, cf, y); put_slot(c, 8, y); }
            else if (wave == 4) { load_cf(c, 1, cf); intra<true>(c, 1, 1, cf, y); intra<false>(c, 1, 0, cf, y); put_slot(c, 6, y); }
            else if (wave == 5) { if (k > 0) { yoff(c, 3, buf, y); put_slot(c, 2, y); yoff(c, 2, buf, y); put_slot(c, 5, y); yoff(c, 1, buf, y); put_slot(c, 7, y); yoff(c, 0, buf, y); put_slot(c, 9, y); } }
            else if (wave == 6) { state_item(c, 0, nb, stA); state_item(c, 1, nb, stB); }
            else                { state_item(c, 2, nb, stA); state_item(c, 3, nb, stB); }
        }
        LDS_WAIT(); __syncthreads();
        { const int row = tid >> 2, pc = tid & 3, lb = wave >> 1, rl = row & 31;
          const int s0 = lb == 3 ? 0 : (lb == 2 ? 3 : (lb == 1 ? 6 : 8)), s1 = lb == 3 ? 1 : (lb == 2 ? 4 : -1), so = lb == 3 ? 2 : (lb == 2 ? 5 : (lb == 1 ? 7 : 9));
          const LAS float* p0 = (const LAS float*)(lds + LSL + s0 * 4096) + rl * 32 + pc * 8;
          f32x4 ya = *(const LAS f32x4*)p0, yb = *(const LAS f32x4*)(p0 + 4);
          if (s1 >= 0) { const LAS float* p1 = (const LAS float*)(lds + LSL + s1 * 4096) + rl * 32 + pc * 8; ya += *(const LAS f32x4*)p1; yb += *(const LAS f32x4*)(p1 + 4); }
          if (k > 0) { const LAS float* p2 = (const LAS float*)(lds + LSL + so * 4096) + rl * 32 + pc * 8; ya += *(const LAS f32x4*)p2; yb += *(const LAS f32x4*)(p2 + 4); }
          const v4u xv = *(const LAS v4u*)(lds + LX + row * 64 + pc * 16);
          v4u o; o.x = pk2(ya.x + Dk * __builtin_bit_cast(float, xv.x << 16), ya.y + Dk * __builtin_bit_cast(float, xv.x & 0xffff0000u)); o.y = pk2(ya.z + Dk * __builtin_bit_cast(float, xv.y << 16), ya.w + Dk * __builtin_bit_cast(float, xv.y & 0xffff0000u));
          o.z = pk2(yb.x + Dk * __builtin_bit_cast(float, xv.z << 16), yb.y + Dk * __builtin_bit_cast(float, xv.z & 0xffff0000u)); o.w = pk2(yb.z + Dk * __builtin_bit_cast(float, xv.w << 16), yb.w + Dk * __builtin_bit_cast(float, xv.w & 0xffff0000u));
          *(GAS v4u*)(YS + (m0 + row) * 1024 + h * 64 + ph * 32 + pc * 8) = o; }
    }
    LDS_WAIT(); __syncthreads();
#undef SSD_LOAD_REGS
#undef SSD_LOAD_DT
#undef SSD_PREP_A
}
#undef SSD_PIN8
#undef SSD_PIN4
}
__device__ __forceinline__ void p3_ssd(Frame& F, KA args) {
    for (int u = F.vcu; u < 256; u += F.G) ssd::unit(F, args, u);
}

__device__ __forceinline__ void p0_small(Frame& F, KA args) {
    const int gt = (F.vcu * NWAVES + F.wave) * 64 + F.lane, NGT = F.G * NWAVES * 64;
    const float* ln2 = (const float*)args->in[18]; const float* wrg = (const float*)args->in[19]; const float* wre = (const float*)args->in[21];
    bf16* WRH = (bf16*)(F.ws + mp::wr); bf16* WRL = WRH + 48 * DM;
    for (int i = gt; i < 48 * DM; i += NGT) { const int c = i / DM, k = i % DM;
        const float w = (c < 4 ? wrg[k * 4 + c] : (c < 36 ? wre[k * 32 + (c - 4)] : 0.f)) * ln2[k];
        const unsigned hi = f2bf(w); const float lo = w - bf2f((unsigned short)hi);
        WRH[i] = (bf16)hi; WRL[i] = (bf16)f2bf(lo); }
    { GAS v4u* z = (GAS v4u*)((bf16*)(F.ws + mp::win) + (size_t)(NIN + 16) * DM);
      for (int i = gt; i < (NIN_G - NIN - 16) * DM / 8; i += NGT) z[i] = (v4u){0u, 0u, 0u, 0u}; }
}

__device__ __forceinline__ void p5_route(Frame& F, KA args) {
    const int lane = F.lane;
    const bf16* h = (const bf16*)(F.ws + mp::xn2);
    const bf16* WRH = (const bf16*)(F.ws + mp::wr); const bf16* WRL = WRH + 48 * DM;
    const float* brg = (const float*)args->in[20]; const float* bre = (const float*)args->in[22];
    int* tok_e = (int*)(F.ws + mp::small + SM_TOK_E); int* tok_pos = (int*)(F.ws + mp::small + SM_TOK_POS); float* tok_w = (float*)(F.ws + mp::small + SM_TOK_W);
    int* lst_tok = (int*)(F.ws + mp::lst); float* lst_w = (float*)(F.ws + mp::lst) + NE * LCAP; float* lst_r = lst_w + NE * LCAP;
    unsigned* cnt = (unsigned*)(F.ctl + CW_CNT);
    LAS float* lg = (LAS float*)(F.lds + RING_OFF + F.wave * 4096);
    constexpr int KQ = 512, WQB = 2 * 48 * KQ * 2;
    LAS unsigned char* wq = F.lds + RING_OFF + 32768;
    for (int wt = F.vcu; wt < M / 64; wt += F.G) {
        const int rt = F.wave & 3, kh = F.wave >> 2, task = wt * 4 + rt;
        const bf16* hr = h + (size_t)(task * 16 + (lane & 15)) * DM + (lane >> 4) * 8;
        f32x4 acc0 = (f32x4){0.f, 0.f, 0.f, 0.f}, acc1 = acc0, acc2 = acc0; float ss = 0.f;
        for (int q = 0; q < DM / KQ; ++q) {
            __syncthreads();
#pragma unroll
            for (int i = 0; i < 12; ++i) { const int pc = F.tid + 512 * i, row = pc >> 6, c16 = pc & 63;
                const v4u v = *(const GAS v4u*)((row < 48 ? WRH + (size_t)row * DM : WRL + (size_t)(row - 48) * DM) + q * KQ + c16 * 8);
                *(LAS v4u*)(wq + row * 1040 + c16 * 16) = v; }
            LDS_WAIT(); __syncthreads();
#pragma unroll 4
            for (int k8 = 0; k8 < 8; ++k8) {
                const int kt = kh * 8 + k8;
                const v4u hv = *(const GAS v4u*)(hr + q * KQ + kt * 32);
                { const float e0 = __builtin_bit_cast(float, hv.x << 16), e1 = __builtin_bit_cast(float, hv.x & 0xffff0000u), e2 = __builtin_bit_cast(float, hv.y << 16), e3 = __builtin_bit_cast(float, hv.y & 0xffff0000u);
                  const float e4 = __builtin_bit_cast(float, hv.z << 16), e5 = __builtin_bit_cast(float, hv.z & 0xffff0000u), e6 = __builtin_bit_cast(float, hv.w << 16), e7 = __builtin_bit_cast(float, hv.w & 0xffff0000u);
                  ss += (e0 * e0 + e1 * e1) + (e2 * e2 + e3 * e3) + (e4 * e4 + e5 * e5) + (e6 * e6 + e7 * e7); }
                const bf16x8 ah = __builtin_bit_cast(bf16x8, hv);
                const LAS unsigned char* bp = wq + (lane & 15) * 1040 + kt * 64 + (lane >> 4) * 16;
                { const bf16x8 b_h = *(const LAS bf16x8*)(bp), b_l = *(const LAS bf16x8*)(bp + 48 * 1040);
                  acc0 = __builtin_amdgcn_mfma_f32_16x16x32_bf16(ah, b_h, acc0, 0, 0, 0); acc0 = __builtin_amdgcn_mfma_f32_16x16x32_bf16(ah, b_l, acc0, 0, 0, 0); }
                { const bf16x8 b_h = *(const LAS bf16x8*)(bp + 16 * 1040), b_l = *(const LAS bf16x8*)(bp + 64 * 1040);
                  acc1 = __builtin_amdgcn_mfma_f32_16x16x32_bf16(ah, b_h, acc1, 0, 0, 0); acc1 = __builtin_amdgcn_mfma_f32_16x16x32_bf16(ah, b_l, acc1, 0, 0, 0); }
                { const bf16x8 b_h = *(const LAS bf16x8*)(bp + 32 * 1040), b_l = *(const LAS bf16x8*)(bp + 80 * 1040);
                  acc2 = __builtin_amdgcn_mfma_f32_16x16x32_bf16(ah, b_h, acc2, 0, 0, 0); acc2 = __builtin_amdgcn_mfma_f32_16x16x32_bf16(ah, b_l, acc2, 0, 0, 0); }
            }
        }
        __syncthreads();
        LAS float* xp = (LAS float*)(F.lds + RING_OFF + 32768 + rt * 4096) + lane * 13;
        if (kh == 1) {
#pragma unroll
            for (int q = 0; q < 4; ++q) { xp[q] = acc0[q]; xp[4 + q] = acc1[q]; xp[8 + q] = acc2[q]; }
            xp[12] = ss; }
        LDS_WAIT(); __syncthreads();
        if (kh == 0) {
#pragma unroll
        for (int q = 0; q < 4; ++q) { acc0[q] += xp[q]; acc1[q] += xp[4 + q]; acc2[q] += xp[8 + q]; }
        ss += xp[12];
        ss += __shfl_xor(ss, 16); ss += __shfl_xor(ss, 32);
        const float r = 1.0f / sqrtf(ss * (1.f / DM) + EPS);
#pragma unroll
        for (int reg = 0; reg < 4; ++reg) { const int row = (lane >> 4) * 4 + reg; const float rr = __shfl(r, row);
            lg[row * 48 + (lane & 15)] = acc0[reg] * rr; lg[row * 48 + 16 + (lane & 15)] = acc1[reg] * rr; lg[row * 48 + 32 + (lane & 15)] = acc2[reg] * rr; }
        LDS_WAIT(); asm volatile("" ::: "memory");
        if (lane < 16) {
            const LAS float* L = lg + lane * 48; const int tok = task * 16 + lane;
            float gl[4];
#pragma unroll
            for (int j = 0; j < 4; ++j) gl[j] = L[j] + brg[j];
            int gs = 0; float gm = gl[0];
#pragma unroll
            for (int j = 1; j < 4; ++j) if (gl[j] > gm) { gm = gl[j]; gs = j; }
            float gsum = 0.f;
#pragma unroll
            for (int j = 0; j < 4; ++j) gsum += expf(gl[j] - gm);
            const float gwt = 1.f / gsum;
            float el[8];
#pragma unroll
            for (int j = 0; j < 8; ++j) el[j] = L[4 + gs * 8 + j] + bre[gs * 8 + j];
            int i1 = 0; float m1 = el[0];
#pragma unroll
            for (int j = 1; j < 8; ++j) if (el[j] > m1) { m1 = el[j]; i1 = j; }
            int i2 = 0; float m2 = -INFINITY;
#pragma unroll
            for (int j = 0; j < 8; ++j) if (j != i1 && el[j] > m2) { m2 = el[j]; i2 = j; }
            const float e2 = expf(m2 - m1); const float w1 = gwt / (1.f + e2), w2 = gwt * e2 / (1.f + e2);
            const int ea = gs * 8 + i1, eb = gs * 8 + i2;
            tok_e[tok * 2] = ea; tok_e[tok * 2 + 1] = eb; tok_w[tok * 2] = w1; tok_w[tok * 2 + 1] = w2;
            const int pa = (int)__hip_atomic_fetch_add(cnt + ea, 1u, RLX_AGENT), pb = (int)__hip_atomic_fetch_add(cnt + eb, 1u, RLX_AGENT);
            tok_pos[tok * 2] = pa; tok_pos[tok * 2 + 1] = pb;
            lst_tok[ea * LCAP + pa] = tok; lst_w[ea * LCAP + pa] = w1; lst_r[ea * LCAP + pa] = r; lst_tok[eb * LCAP + pb] = tok; lst_w[eb * LCAP + pb] = w2; lst_r[eb * LCAP + pb] = r;
        }
        }
        LDS_WAIT(); __syncthreads();
    }
}

__device__ __forceinline__ void build_tab(Frame& F, KA args) {
    LAS int* tab = (LAS int*)(F.lds + TAB_OFF);
    if (F.wave == 0) {
        const int lane = F.lane, e = lane & 31; unsigned* cnt = (unsigned*)(F.ctl + CW_CNT);
        const int c = (int)__hip_atomic_load(cnt + e, RLX_AGENT), mt = (c + 255) >> 8;
        int sc = mt;
#pragma unroll
        for (int o = 1; o < 32; o <<= 1) { const int t = __shfl_up(sc, o); if (e >= o) sc += t; }
        if (lane < 32) { tab[e] = (sc - mt) * 8; tab[40 + e] = sc - mt; tab[80 + e] = c; }
        if (lane == 31) { tab[32] = sc * 8; tab[72] = sc; }
    }
    LDS_WAIT(); __syncthreads();
}

__device__ __forceinline__ void p8_combine(Frame& F, KA args) {
    const int gw = F.vcu * NWAVES + F.wave, NGW = F.G * NWAVES, lane = F.lane;
    build_tab(F, args);
    const LAS int* tab = (const LAS int*)(F.lds + TAB_OFF);
    const int* tok_e = (const int*)(F.ws + mp::small + SM_TOK_E); const int* tok_pos = (const int*)(F.ws + mp::small + SM_TOK_POS); const unsigned char* Y8 = (const unsigned char*)(F.ws + mp::y); float* out = args->out;
    const bf16* HB = (const bf16*)(F.ws + mp::xn2);
    v4u hvA[2][2], avA[2], bvA[2], hvB[2][2], avB[2], bvB[2];
#define P8_LOAD(t_, hv_, av_, bv_) do { const int s0_ = tab[40 + tok_e[2 * (t_)]] * 256 + tok_pos[2 * (t_)], s1_ = tab[40 + tok_e[2 * (t_) + 1]] * 256 + tok_pos[2 * (t_) + 1]; \
        _Pragma("unroll") for (int j = 0; j < 2; ++j) { const int c0 = 16 * (lane + 64 * j); \
            hv_[j][0] = __builtin_nontemporal_load((const GAS v4u*)(HB + (size_t)(t_) * DM + c0)); hv_[j][1] = __builtin_nontemporal_load((const GAS v4u*)(HB + (size_t)(t_) * DM + c0 + 8)); \
            av_[j] = __builtin_nontemporal_load((const GAS v4u*)(Y8 + (size_t)s0_ * DM + c0)); bv_[j] = __builtin_nontemporal_load((const GAS v4u*)(Y8 + (size_t)s1_ * DM + c0)); } } while (0)
#define P8_STORE(t_, hv_, av_, bv_) do { \
        _Pragma("unroll") for (int j = 0; j < 2; ++j) { const int c0 = 16 * (lane + 64 * j); \
            const unsigned hw[8] = {hv_[j][0].x, hv_[j][0].y, hv_[j][0].z, hv_[j][0].w, hv_[j][1].x, hv_[j][1].y, hv_[j][1].z, hv_[j][1].w}; \
            const unsigned aw[4] = {av_[j].x, av_[j].y, av_[j].z, av_[j].w}, bw[4] = {bv_[j].x, bv_[j].y, bv_[j].z, bv_[j].w}; \
            _Pragma("unroll") for (int q = 0; q < 4; ++q) { \
                const f32x2_t a01 = __builtin_amdgcn_cvt_pk_f32_fp8((int)aw[q], false), a23 = __builtin_amdgcn_cvt_pk_f32_fp8((int)aw[q], true); \
                const f32x2_t b01 = __builtin_amdgcn_cvt_pk_f32_fp8((int)bw[q], false), b23 = __builtin_amdgcn_cvt_pk_f32_fp8((int)bw[q], true); \
                f32x4 v; \
                v.x = __builtin_bit_cast(float, hw[2 * q] << 16) + (a01.x + b01.x) * (1.f / Y8_SCALE); v.y = __builtin_bit_cast(float, hw[2 * q] & 0xffff0000u) + (a01.y + b01.y) * (1.f / Y8_SCALE); \
                v.z = __builtin_bit_cast(float, hw[2 * q + 1] << 16) + (a23.x + b23.x) * (1.f / Y8_SCALE); v.w = __builtin_bit_cast(float, hw[2 * q + 1] & 0xffff0000u) + (a23.y + b23.y) * (1.f / Y8_SCALE); \
                *(GAS f32x4*)(out + (size_t)(t_) * DM + c0 + 4 * q) = v; } } } while (0)
    typedef float f32x2_t __attribute__((ext_vector_type(2)));
    if (gw < M) P8_LOAD(gw, hvA, avA, bvA);
    for (int t = gw; t < M; t += 2 * NGW) {
        P8_LOAD(t + NGW, hvB, avB, bvB);
        P8_STORE(t, hvA, avA, bvA);
        if (t + 2 * NGW < M) P8_LOAD(t + 2 * NGW, hvA, avA, bvA);
        P8_STORE(t + NGW, hvB, avB, bvB);
    }
#undef P8_LOAD
#undef P8_STORE
}

constexpr int N_PHASES = 11;
#ifndef MK_REP_BAR
#define MK_REP_BAR 0
#endif
#ifndef MK_REP_PHASE
#define MK_REP_PHASE -1
#endif
#define PHASE_ARGS() ({ KA p_ = (KA)__builtin_amdgcn_kernarg_segment_ptr(); asm volatile("" : "+s"(p_)); p_; })
__global__ void __launch_bounds__(NWAVES * 64, 2) mega(Args args_byval) {
    KA args = PHASE_ARGS(); (void)args_byval;
    extern __shared__ __attribute__((aligned(16))) unsigned char lds[];
    Frame F;
    F.lds = (LAS unsigned char*)lds;
    F.MISC = (volatile LAS unsigned*)(F.lds + MISC_OFF);
    F.tid = threadIdx.x; F.lane = F.tid & 63; F.wave = __builtin_amdgcn_readfirstlane(F.tid >> 6);
    F.G = gridDim.x; { const int bx = blockIdx.x; F.vcu = (F.G % 8 == 0) ? (bx % 8) * (F.G / 8) + bx / 8 : bx; }
    F.cid = (int)blockIdx.x;
    F.ws = args->ws;
    F.ctl = (gu32*)(F.ws + mp::ctl);
    for (int u = F.tid; u < (LDS_BYTES - LDSCTL_OFF) / 4; u += NWAVES * 64) ((LAS unsigned*)(F.lds + LDSCTL_OFF))[u] = 0u;
    __syncthreads();
    const bool one_launch = (args->li < 0);
    XcdBarrier bar; bar.bar = (unsigned*)(F.ctl + CW_BAR); bar.x = 0; bar.st = nullptr;
    if (one_launch) bar = xcd_barrier_post((unsigned*)(F.ctl + CW_BAR), F.MISC + 8);
    if (one_launch && F.tid == 0) { const unsigned x_ = xb_xcc_id(); F.MISC[10] = x_; F.MISC[11] = xb_add((unsigned*)(F.ctl + CW_RANK + 64 * x_), 1u); }
    bool local_ok = false; unsigned* loc_ctr = nullptr;
    const int lo = args->ph_lo, hi = args->ph_hi;
#define IN(k) (lo <= (k) && (k) < hi)
#define SEAM(k) do { if (IN(k) && IN((k) + 1)) xcd_barrier(bar); } while (0)
#define SEAM_LOCAL(k) do { if (IN(k) && IN((k) + 1)) { if (local_ok) xcd_local_barrier(bar.bar, loc_ctr, 32u); else xcd_barrier(bar); } } while (0)

    if (IN(0)) for (int rep_ = 0; rep_ < (MK_REP_PHASE == 0 ? 2 : 1); ++rep_) { args = PHASE_ARGS(); p0_prologue(F, args); if (args->p0_mask & 8) p0_small(F, args); if (args->p0_mask & 16) p0_rope(F, args); }
    SEAM(0);
    if (one_launch && IN(0) && IN(1)) {
        if (F.tid == 0) { unsigned ok_ = (F.G == 256) ? 1u : 0u;
            for (unsigned j = 0; j < 16; ++j) { const unsigned c_ = xb_ld(&bar.bar[XB_XCNT(j)]); if (c_ != (j < 8 ? 32u : 0u)) ok_ = 0u; }
            F.MISC[12] = ok_; }
        __syncthreads();
        if (F.MISC[12]) { const int x_ = (int)F.MISC[10], r_ = (int)F.MISC[11]; local_ok = true; F.vcu = x_ * 32 + r_; F.cid = r_ * 8 + x_; loc_ctr = (unsigned*)(F.ctl + CW_LOC + 64 * x_); }
    }
    if (IN(1)) for (int rep_ = 0; rep_ < (MK_REP_PHASE == 1 ? 2 : 1); ++rep_) { args = PHASE_ARGS();
        pg8::Gemm g{(const bf16*)(F.ws + mp::xn), (const bf16*)(F.ws + mp::win), M, NIN_G, DM};
        pg8::EpiInProj E{(bf16*)(F.ws + mp::u16), NIN, (float*)(F.ws + mp::dt)};
#if P1_HOSTS_P0B == 1
        const int c_ = F.cid, xcd_ = c_ & 7, team_ = c_ >> 6;
        const int ks = team_ < 3 ? (xcd_ + 2 * team_) % 7 : xcd_ % 6;
        for (int part = 0; part < 2; ++part) {
            pg8::TeamOrder S{c_, part == 0 ? 0 : ks, part == 0 ? ks : 6};
            pg8::gemm_phase<pg8::EpiInProj, pg8::TeamOrder, PG8_ALIGN, PG8_SP2>(F.lds + RING_OFF, g, S, E);
            if (part == 0) { __syncthreads(); args = PHASE_ARGS(); p1_convert_share(F, args, 0); __syncthreads(); }
        }
#elif P1_HOSTS_P0B == 2
        pg8::StaticOrder S; S.init(M, NIN_G, F.G, (int)blockIdx.x);
        typedef pg8::ConvMoE<KA, 23, mp::wgu, mp::wd, mp::END, RING_OFF + RING_BYTES> CvJob;
        pg8::gemm_phase<pg8::EpiInProj, pg8::StaticOrder, PG8_ALIGN, PG8_SP2, false, CvJob>(F.lds + RING_OFF, g, S, E, CvJob{});
        if ((int)blockIdx.x >= P1_UNITS - 5 * F.G) { __syncthreads(); args = PHASE_ARGS(); p0b_blocks(F, args, 4 * (P1_INLOOP_BLOCKS + ((int)blockIdx.x - (P1_UNITS - 5 * F.G)) * NWAVES + F.wave), 4); }
#else
        pg8::StaticOrder S; S.init(M, NIN_G, F.G, (int)blockIdx.x);
        pg8::gemm_phase<pg8::EpiInProj, pg8::StaticOrder, PG8_ALIGN, PG8_SP2>(F.lds + RING_OFF, g, S, E);
#endif
    }
    SEAM_LOCAL(1);
    if (IN(2)) for (int rep_ = 0; rep_ < (MK_REP_PHASE == 2 ? 2 : 1); ++rep_) { if (MK_REP_BAR && rep_) xcd_barrier(bar); args = PHASE_ARGS(); p2_qknorm(F, args); p2_conv(F, args); }
    SEAM_LOCAL(2);
    if (IN(3)) for (int rep_ = 0; rep_ < (MK_REP_PHASE == 3 ? 2 : 1); ++rep_) { args = PHASE_ARGS(); if (args->p0_mask & 128) p3_ssd(F, args); p3_attention(F, args, lds);
#if P1_HOSTS_P0B == 1
        if (rep_ == 0) { __syncthreads(); args = PHASE_ARGS(); p1_convert_share(F, args, 1); }
#endif
    }
    SEAM_LOCAL(3);
    if (IN(4)) for (int rep_ = 0; rep_ < (MK_REP_PHASE == 4 ? 2 : 1); ++rep_) { args = PHASE_ARGS(); p4_ycat(F, args, (args->p0_mask >> 5) & 3); }
    SEAM_LOCAL(4);
    if (IN(5)) for (int rep_ = 0; rep_ < (MK_REP_PHASE == 5 ? 2 : 1); ++rep_) { args = PHASE_ARGS();
        pg8::Gemm g{(const bf16*)(F.ws + mp::ycat), (const bf16*)(F.ws + mp::wout), M, DM, DM}; pg8::StaticOrder S; S.init(M, DM, F.G, F.cid);
        pg8::EpiResid E{(const float*)args->in[0], (bf16*)(F.ws + mp::xn2), (unsigned char*)(F.ws + mp::xn8), DM, (const float*)args->in[18]};
        pg8::gemm_phase<pg8::EpiResid, pg8::StaticOrder, PG8_ALIGN, PG8_SP2>(F.lds + RING_OFF, g, S, E);
#if P1_HOSTS_P0B == 1
        if (rep_ == 0) { __syncthreads(); args = PHASE_ARGS(); p1_convert_share(F, args, 2); }
#endif
    }
    SEAM_LOCAL(5);
    if (IN(6)) for (int rep_ = 0; rep_ < (MK_REP_PHASE == 6 ? 2 : 1); ++rep_) { args = PHASE_ARGS(); p5_route(F, args); }
    SEAM(6);
    if (IN(8)) for (int rep_ = 0; rep_ < (MK_REP_PHASE == 8 ? 2 : 1); ++rep_) { args = PHASE_ARGS();
        build_tab(F, args);
        pg8::Gemm g{(const bf16*)(F.ws + mp::xn8), (const bf16*)(F.ws + mp::wgu), M, NE * 2048, DM / 2};    pg8::ExpertOrder S; S.init((const LAS int*)(F.lds + TAB_OFF), F.G, F.cid);
        pg8::ExpertRows RS{(const LAS int*)(F.lds + TAB_OFF), (const int*)(F.ws + mp::lst), LCAP};
        pg8::EpiGateUp E{(unsigned char*)(F.ws + mp::hid), EH, pg8::ExpertScale{(const LAS int*)(F.lds + TAB_OFF), (const float*)(F.ws + mp::lst) + 2 * NE * LCAP, LCAP}, 1.f / F8_WSCALE};
        pg8::gemm_phase_g<pg8::EpiGateUp, pg8::ExpertOrder, pg8::ExpertRows, PG8_ALIGN, PG8_SP2, true>(F.lds + RING_OFF, g, S, E, RS);
    }
    SEAM(8);
    if (IN(9)) for (int rep_ = 0; rep_ < (MK_REP_PHASE == 9 ? 2 : 1); ++rep_) { args = PHASE_ARGS();
        build_tab(F, args);
        pg8::Gemm g{(const bf16*)(F.ws + mp::hid), (const bf16*)(F.ws + mp::wd), SLOT_CAP, NE * 2048, EH / 2};    pg8::ExpertOrder S; S.init((const LAS int*)(F.lds + TAB_OFF), F.G, F.cid);
        pg8::EpiRowScale E{(unsigned char*)(F.ws + mp::y), DM, pg8::ExpertScale{(const LAS int*)(F.lds + TAB_OFF), (const float*)(F.ws + mp::lst) + NE * LCAP, LCAP}, Y8_SCALE / F8_WSCALE};
        pg8::gemm_phase<pg8::EpiRowScale, pg8::ExpertOrder, PG8_ALIGN, PG8_SP2, true>(F.lds + RING_OFF, g, S, E);
    }
    SEAM(9);
    if (IN(10)) for (int rep_ = 0; rep_ < (MK_REP_PHASE == 10 ? 2 : 1); ++rep_) { args = PHASE_ARGS(); p8_combine(F, args); }
#undef IN
#undef SEAM
#undef SEAM_LOCAL
}

__global__ void __launch_bounds__(256) k_u16_to_f32(const bf16* __restrict__ U16, const float* __restrict__ DT, float* __restrict__ U) {
    const size_t idx = (size_t)blockIdx.x * 256 + threadIdx.x;
    const int c = (int)(idx % IN_COLS); const size_t m = idx / IN_COLS;
    float v;
    if (c < 2560) v = bf2f(U16[m * NIN + c]); else if (c < 2576) v = DT[m * 16 + (c - 2560)]; else v = bf2f(U16[m * NIN + c - 16]);
    U[idx] = v;
}
__global__ void __launch_bounds__(256) k_f32_to_bf16(const float* __restrict__ src, bf16* __restrict__ dst) {
    const size_t i = (size_t)blockIdx.x * 256 + threadIdx.x;
    const float4 v = ((const float4*)src)[i]; v2u o; o.x = pk2(v.x, v.y); o.y = pk2(v.z, v.w); ((v2u*)dst)[i] = o;
}
__global__ void __launch_bounds__(256) k_ssdhalf_to_bf16(const float* __restrict__ YCATf, bf16* __restrict__ YCAT16) {
    const size_t i = (size_t)blockIdx.x * 256 + threadIdx.x;
    const size_t m = i >> 8; const int c4 = (int)(i & 255);
    const float4 v = ((const float4*)(YCATf + m * DM))[c4]; v2u o; o.x = pk2(v.x, v.y); o.y = pk2(v.z, v.w); ((v2u*)(YCAT16 + m * DM))[c4] = o;
}

#ifndef MK_ONE_LAUNCH
#define MK_ONE_LAUNCH 1
#endif
extern "C" void kernel_launch(void* const* d_in, const int* in_sizes, int n_in, void* d_out, int out_size, void* d_ws, size_t ws_size, hipStream_t stream) {
    static int ready = 0;
    if (!ready) {
        if (hipFuncSetAttribute((const void*)mega, hipFuncAttributeMaxDynamicSharedMemorySize, LDS_BYTES) != hipSuccess) { fprintf(stderr, "hipFuncSetAttribute failed\n"); }
        if (ws_size < mp::END) fprintf(stderr, "kernel_launch: ws_size %zu too small\n", ws_size);
        ready = 1;
    }
    (void)hipMemsetAsync(d_ws, 0, CTL_ZERO_BYTES, stream);
    Args a{};
    for (int i = 0; i < 26; ++i) a.in[i] = d_in[i];
    a.out = (float*)d_out; a.ws = (unsigned char*)d_ws;
    a.p0_mask = 1 | 2 | 4 | 8 | 16 | (3 << 5) | 128; a.rep_phase = MK_REP_PHASE;
#if MK_ONE_LAUNCH
    a.ph_lo = 0; a.ph_hi = N_PHASES; a.li = -1; hipLaunchKernelGGL(mega, dim3(256), dim3(NWAVES * 64), LDS_BYTES, stream, a);
#else
    for (int ph = 0; ph < N_PHASES; ++ph) { a.ph_lo = ph; a.ph_hi = ph + 1; a.li = ph; hipLaunchKernelGGL(mega, dim3(256), dim3(NWAVES * 64), LDS_BYTES, stream, a); }
#endif
}
```

```cpp
#include <hip/hip_runtime.h>
#include <hip/hip_bf16.h>
#include <math.h>
#include <stdint.h>
#include <cstdio>
#include <cmath>
namespace pg8 {
#define PG8_LAS __attribute__((address_space(3)))
typedef unsigned short bf16_t;
typedef short bf16x8 __attribute__((ext_vector_type(8)));
typedef float f32x4 __attribute__((ext_vector_type(4)));
typedef unsigned u32x4 __attribute__((ext_vector_type(4)));
typedef int v8i_t __attribute__((ext_vector_type(8)));
constexpr int BM = 256, BK = 64, HALF = 128, HTB = HALF * BK * 2  , STAGE_BYTES = 8 * HTB, NXCD = 8, WGM = 8;

__host__ __device__ __forceinline__ int lds_byte(int r, int c) { const int st = (r >> 4) * 2 + (c >> 5), rr = r & 15, cc = c & 31, ob = rr * 64 + cc * 2; return st * 1024 + (ob ^ (((ob >> 9) & 1) << 5)); }
__host__ __device__ __forceinline__ void stage_rc(int b, int& R, int& C) { const int st = b / 1024, sb = b % 1024, swz = sb ^ (((sb >> 9) & 1) << 5); R = (st >> 1) * 16 + swz / 64; C = (st & 1) * 32 + (swz % 64) / 2; }
__host__ __device__ __forceinline__ int perm32(int rho) { const int n = rho >> 4, i = rho & 15; return 8 * (i >> 2) + 4 * n + (i & 3); }

struct Unit { int pm, pn; };
struct Gemm { const bf16_t* A; const bf16_t* Bt; int M, N, K; };

struct StaticOrder {
    int nM, nN, nwg, G, c;
    __host__ __device__ void init(int M, int N, int G_, int c_) { nM = M / BM; nN = N / BM; nwg = nM * nN; G = G_; c = c_; }
    __host__ __device__ bool next(int i, Unit& u) const {
        const long L = (long)i * G + c; if (L >= nwg) return false;
        int wgid = (int)L; { const int q = nwg / NXCD, r = nwg % NXCD, xcd = wgid % NXCD, off = wgid / NXCD; wgid = (xcd < r ? xcd * (q + 1) : r * (q + 1) + (xcd - r) * q) + off; }
        const int nig = WGM * nN, gid = wgid / nig, fm = gid * WGM, gsz = (nM - fm) < WGM ? (nM - fm) : WGM;
        u.pm = fm + ((wgid % nig) % gsz); u.pn = (wgid % nig) / gsz; return true;
    }
    __device__ __forceinline__ void a_ready(const Unit&) const {}
    __device__ __forceinline__ void done(const Unit&) const {}
};

__device__ __forceinline__ unsigned cvt_pk_bf16(float lo, float hi) { unsigned r; asm volatile("v_cvt_pk_bf16_f32 %0, %1, %2" : "=v"(r) : "v"(lo), "v"(hi)); return r; }
typedef float f32x2 __attribute__((ext_vector_type(2)));
__device__ __forceinline__ f32x2 gelu_pk(f32x2 v) {
    const f32x2 av = __builtin_elementwise_abs(v), d = av * 0.2316418882f + 1.0f;
    f32x2 t; t.x = __builtin_amdgcn_rcpf(d.x); t.y = __builtin_amdgcn_rcpf(d.y);
    f32x2 q = t * 0.5307027145f + (-0.7265760135f); q = q * t + 0.7107068705f; q = q * t + (-0.142248368f); q = q * t + 0.127414796f; q = q * t;
    const f32x2 s = (v * v) * (-0.72134752044f);
    f32x2 e; e.x = __builtin_amdgcn_exp2f(s.x); e.y = __builtin_amdgcn_exp2f(s.y);
    const f32x2 m = v * (q * e), r = v - m;
    f32x2 o; o.x = v.x < 0.f ? m.x : r.x; o.y = v.y < 0.f ? m.y : r.y; return o;
}

template <int ACT  > struct EpiBf16 {
    static constexpr bool PERM = true, AFTER_DRAIN = false; static_assert(ACT == 0 || ACT == 1, "EpiBf16: ACT is 0 (none) or 1 (gelu_pk)");
    bf16_t* O; int ldc; const float* bias; int split_cols; size_t split_stride; float scale0;
    __device__ __forceinline__ void operator()(const f32x4 (&acc)[2][2][4][2], const Unit& u, int wr, int wc, int fr, int fq) const {
        const int row0 = u.pm * BM + wr * 64 + fr; int colt = u.pn * BM; bf16_t* base = O;
        float sc = 1.f; if (split_cols) { const int t = colt / split_cols; base += (size_t)t * split_stride; colt -= t * split_cols; if (t == 0) sc = scale0; }
        const int col0 = colt + wc * 32 + 8 * fq, bcol0 = u.pn * BM + wc * 32 + 8 * fq;
        f32x4 bv[2][2];
#pragma unroll
        for (int bj = 0; bj < 2; ++bj)
#pragma unroll
            for (int n = 0; n < 2; ++n) bv[bj][n] = bias ? *(const f32x4*)(bias + bcol0 + bj * HALF + 4 * n) : (f32x4){0.f, 0.f, 0.f, 0.f};
#pragma unroll
        for (int ai = 0; ai < 2; ++ai)
#pragma unroll
            for (int m = 0; m < 4; ++m) { bf16_t* rowp = base + (size_t)(row0 + ai * HALF + m * 16) * ldc + col0;
#pragma unroll
                for (int bj = 0; bj < 2; ++bj) { f32x4 v0 = acc[ai][bj][m][0] + bv[bj][0], v1 = acc[ai][bj][m][1] + bv[bj][1];
                    if (ACT == 1) { f32x2 a = gelu_pk((f32x2){v0[0], v0[1]}), b = gelu_pk((f32x2){v0[2], v0[3]}), c = gelu_pk((f32x2){v1[0], v1[1]}), d = gelu_pk((f32x2){v1[2], v1[3]});
                        v0 = (f32x4){a.x, a.y, b.x, b.y}; v1 = (f32x4){c.x, c.y, d.x, d.y}; }
                    v0 = v0 * sc; v1 = v1 * sc; u32x4 w; w.x = cvt_pk_bf16(v0[0], v0[1]); w.y = cvt_pk_bf16(v0[2], v0[3]); w.z = cvt_pk_bf16(v1[0], v1[1]); w.w = cvt_pk_bf16(v1[2], v1[3]);
                    *(u32x4*)(rowp + bj * HALF) = w; } }
    }
};

struct ConvNone { static constexpr bool ON = false; static constexpr int LDS_OFF = 0; };
template <class Epi, class Sched, bool ALIGN_EPI = false, bool SP2 = false, bool F8 = false, class CV = ConvNone>
__device__ __forceinline__ void gemm_phase(PG8_LAS unsigned char* lds, const Gemm g, const Sched& S, const Epi& E, const CV& cv = CV{}) {
    static_assert(!CV::ON || SP2, "the side job's vmcnt arithmetic is written for the SP2 schedule");
    const int tid = threadIdx.x, wid = __builtin_amdgcn_readfirstlane(tid >> 6), lane = tid & 63, wr = wid >> 2, wc = wid & 3, fr = lane & 15, fq = lane >> 4;
    const int K = g.K, nt = K / BK;
    unsigned voffA[2], voffB[2];
#pragma unroll
    for (int i = 0; i < 2; ++i) { int R, C; stage_rc(tid * 16 + i * 8192, R, C); const int Rb = Epi::PERM ? ((R & ~31) + perm32(R & 31)) : R;
        voffA[i] = (unsigned)(R * K + C) * 2u; voffB[i] = (unsigned)(Rb * K + C) * 2u; }
    const size_t kstep = (size_t)(BK * 2);
    const size_t hstep = (size_t)HALF * K * 2;
    const size_t tstep = 2 * hstep;
    const unsigned ldsw = (unsigned)wid * 1024u;
    const int aoff = lds_byte(wr * 64 + fr, fq * 8), boff = lds_byte(wc * 32 + fr, fq * 8);
#define PG8_CAT8(x, y) __builtin_bit_cast(v8i_t, __builtin_shufflevector((x), (y), 0, 1, 2, 3, 4, 5, 6, 7, 8, 9, 10, 11, 12, 13, 14, 15))
#define PG8_SA(b, h) (((b) * 2 + (h)) * HTB)
#define PG8_SB(b, h) ((4 + (b) * 2 + (h)) * HTB)
#define PG8_STAGE(bufoff, gbase, voff) do { _Pragma("unroll") for (int _i = 0; _i < 2; ++_i) \
        __builtin_amdgcn_global_load_lds((const unsigned*)((const char*)(gbase) + (voff)[_i]), (PG8_LAS unsigned*)(lds + (bufoff) + ldsw + _i * 8192), 16, 0, 0); } while (0)
#define PG8_LDA(dst, b, h) do { if constexpr (F8) { _Pragma("unroll") for (int m = 0; m < 4; ++m) dst##8[m] = PG8_CAT8(*(const PG8_LAS bf16x8*)(lds + PG8_SA(b, h) + aoff + m * 2048), *(const PG8_LAS bf16x8*)(lds + PG8_SA(b, h) + aoff + m * 2048 + 1024)); } else _Pragma("unroll") for (int m = 0; m < 4; ++m) _Pragma("unroll") for (int k = 0; k < 2; ++k) dst[m][k] = *(const PG8_LAS bf16x8*)(lds + PG8_SA(b, h) + aoff + m * 2048 + k * 1024); } while (0)
#define PG8_LDB(dst, b, h) do { if constexpr (F8) { _Pragma("unroll") for (int n = 0; n < 2; ++n) dst##8[n] = PG8_CAT8(*(const PG8_LAS bf16x8*)(lds + PG8_SB(b, h) + boff + n * 2048), *(const PG8_LAS bf16x8*)(lds + PG8_SB(b, h) + boff + n * 2048 + 1024)); } else _Pragma("unroll") for (int n = 0; n < 2; ++n) _Pragma("unroll") for (int k = 0; k < 2; ++k) dst[n][k] = *(const PG8_LAS bf16x8*)(lds + PG8_SB(b, h) + boff + n * 2048 + k * 1024); } while (0)
#define PG8_MMA(ai, bj, At, Bt) do { __builtin_amdgcn_s_setprio(1); \
        if constexpr (F8) { _Pragma("unroll") for (int m = 0; m < 4; ++m) _Pragma("unroll") for (int n = 0; n < 2; ++n) \
            asm volatile("v_mfma_f32_16x16x128_f8f6f4 %0, %1, %2, %0" : "+v"(acc[ai][bj][m][n]) : "v"(Bt##8[n]), "v"(At##8[m])); }     \
        else { _Pragma("unroll") for (int m = 0; m < 4; ++m) _Pragma("unroll") for (int n = 0; n < 2; ++n) _Pragma("unroll") for (int k = 0; k < 2; ++k) \
            acc[ai][bj][m][n] = __builtin_amdgcn_mfma_f32_16x16x32_bf16(Bt[n][k], At[m][k], acc[ai][bj][m][n], 0, 0, 0); } \
        __builtin_amdgcn_s_setprio(0); } while (0)
#define PG8_WAIT_V(n) asm volatile("s_waitcnt vmcnt(" #n ")" ::: "memory")
#define PG8_WAIT_L(n) asm volatile("s_waitcnt lgkmcnt(" #n ")" ::: "memory")
#define PG8_BAR __builtin_amdgcn_s_barrier()
#define PG8_SCHED __builtin_amdgcn_sched_barrier(0)
    Unit cur, nxt; int ui = 0;
    if (!S.next(0, cur)) return;
    f32x4 acc[2][2][4][2];
#pragma unroll
    for (int a = 0; a < 2; ++a)
#pragma unroll
        for (int b = 0; b < 2; ++b)
#pragma unroll
            for (int m = 0; m < 4; ++m)
#pragma unroll
                for (int n = 0; n < 2; ++n) acc[a][b][m][n] = (f32x4){0.f, 0.f, 0.f, 0.f};
    bf16x8 At[4][2], B0[2][2], B1[2][2];
    v8i_t At8[4], B08[2], B18[2];
    const char* cA = (const char*)g.A + (size_t)cur.pm * tstep; const char* cB = (const char*)g.Bt + (size_t)cur.pn * tstep;
    S.a_ready(cur);
    typedef float cvf2 __attribute__((ext_vector_type(2))); typedef unsigned cvu2 __attribute__((ext_vector_type(2)));
    cvu2 cvo0 = {0u, 0u}, cvo1 = {0u, 0u};
    const char* cv_sb = nullptr; unsigned cv_sv = 0, cv_db = 0, cv_dv = 0, cv_stb = 0, cv_stv = 0; int cv_dn = 0, cv_stdn = 0;
    unsigned char* cv_ws = nullptr; unsigned cv_slot = 0;
    PG8_LAS unsigned char* const cv_lds = lds + CV::LDS_OFF + wid * 3072;
    if constexpr (CV::ON) { cv.decode(cur, wid, lane, cv_sb, cv_dn, cv_db, cv_dv, cv_sv); cv_ws = cv.wsbase(); cv_stb = CV::DUMMY_OFF; cv_stdn = 0; cv_stv = (unsigned)tid * 16u; }
#define CV_LD(slot) do { if constexpr (CV::ON) { \
        __builtin_amdgcn_global_load_lds((const unsigned*)(cv_sb + (size_t)((2 * slot) * (cv_dn ? 8192u : 4096u)) + cv_sv), (PG8_LAS unsigned*)(cv_lds + cv_slot), 16, 0, 0); \
        cv_slot = cv_slot == 2048u ? 0u : cv_slot + 1024u; } } while (0)
#define CV_CVT(slot, dw, hi) do { if constexpr (CV::ON) { \
        const cvf2 ra_ = *(const PG8_LAS cvf2*)(cv_lds + cv_slot + lane * 8), rb_ = *(const PG8_LAS cvf2*)(cv_lds + cv_slot + 512 + lane * 8); \
        cvo0[dw] = (unsigned)__builtin_amdgcn_cvt_pk_fp8_f32(ra_.x * CV::SCALE, rb_.x * CV::SCALE, (int)cvo0[dw], hi); \
        cvo1[dw] = (unsigned)__builtin_amdgcn_cvt_pk_fp8_f32(ra_.y * CV::SCALE, rb_.y * CV::SCALE, (int)cvo1[dw], hi); } } while (0)
#define CV_ST() do { if constexpr (CV::ON) { unsigned char* p_ = cv_ws + cv_stb; *(__attribute__((address_space(1))) cvu2*)(p_ + cv_stv) = cvo0; *(__attribute__((address_space(1))) cvu2*)(p_ + (cv_stdn ? 1024u : 2048u) + cv_stv) = cvo1; } } while (0)
    if constexpr (SP2) {
        PG8_STAGE(PG8_SB(0, 0), cB, voffB); PG8_STAGE(PG8_SB(0, 1), cB + hstep, voffB); PG8_STAGE(PG8_SA(0, 0), cA, voffA); PG8_STAGE(PG8_SA(0, 1), cA + hstep, voffA);
        if (wr == 1) PG8_BAR;
        PG8_WAIT_V(2); PG8_BAR;
        PG8_STAGE(PG8_SB(1, 0), cB + kstep, voffB); PG8_STAGE(PG8_SA(1, 0), cA + kstep, voffA); PG8_STAGE(PG8_SB(1, 1), cB + hstep + kstep, voffB);
        PG8_WAIT_V(6); PG8_BAR;
    } else {
        PG8_STAGE(PG8_SB(0, 0), cB, voffB); PG8_STAGE(PG8_SA(0, 0), cA, voffA); PG8_STAGE(PG8_SB(0, 1), cB + hstep, voffB); PG8_STAGE(PG8_SA(0, 1), cA + hstep, voffA);
        if (wr == 1) PG8_BAR;
        PG8_WAIT_V(4); PG8_BAR;
        PG8_STAGE(PG8_SB(1, 0), cB + kstep, voffB); PG8_STAGE(PG8_SA(1, 0), cA + kstep, voffA); PG8_STAGE(PG8_SB(1, 1), cB + hstep + kstep, voffB);
        PG8_WAIT_V(6); PG8_BAR;
    }
    for (;;) {
        const bool has_next = S.next(ui + 1, nxt);
        const char* nA = has_next ? (const char*)g.A + (size_t)nxt.pm * tstep : cA; const char* nB = has_next ? (const char*)g.Bt + (size_t)nxt.pn * tstep : cB;
#pragma clang loop unroll(disable)
        for (int t = 0; t < nt; t += 2) {
            const bool last = (t == nt - 2);
            const char* a1 = cA + (size_t)(t + 1) * kstep;
            const char* a2 = last ? nA : cA + (size_t)(t + 2) * kstep; const char* b2 = last ? nB : cB + (size_t)(t + 2) * kstep;
            const char* a3 = a2 + kstep; const char* b3 = b2 + kstep;
            if (last && has_next) S.a_ready(nxt);
            if constexpr (SP2) {
            PG8_LDB(B0, 0, 0); PG8_LDB(B1, 0, 1); PG8_SCHED; PG8_LDA(At, 0, 0); PG8_STAGE(PG8_SA(1, 1), a1 + hstep, voffA); CV_LD(0);
            if constexpr (CV::ON) PG8_WAIT_V(10); else PG8_WAIT_V(8);
            PG8_WAIT_L(0); PG8_BAR; PG8_MMA(0, 0, At, B0); PG8_MMA(0, 1, At, B1); CV_CVT(2, 1, false); PG8_BAR; PG8_SCHED;
            PG8_LDA(At, 0, 1); PG8_STAGE(PG8_SB(0, 0), b2, voffB); PG8_STAGE(PG8_SB(0, 1), b2 + hstep, voffB); PG8_STAGE(PG8_SA(0, 0), a2, voffA); CV_LD(1);
            if constexpr (CV::ON) PG8_WAIT_V(10); else PG8_WAIT_V(8);
            PG8_WAIT_L(0); PG8_BAR; PG8_MMA(1, 0, At, B0); PG8_MMA(1, 1, At, B1); CV_CVT(3, 1, true); PG8_BAR; PG8_SCHED;
            CV_ST(); if constexpr (CV::ON) { cv_stb = cv_db + 4 * t; cv_stdn = cv_dn; cv_stv = cv_dv; }
            PG8_LDB(B0, 1, 0); PG8_LDB(B1, 1, 1); PG8_SCHED; PG8_LDA(At, 1, 0); PG8_STAGE(PG8_SA(0, 1), a2 + hstep, voffA); CV_LD(2);
            if constexpr (CV::ON) PG8_WAIT_V(12); else PG8_WAIT_V(8);
            PG8_WAIT_L(0); PG8_BAR; PG8_MMA(0, 0, At, B0); PG8_MMA(0, 1, At, B1); CV_CVT(0, 0, false); PG8_BAR; PG8_SCHED;
            PG8_LDA(At, 1, 1); PG8_STAGE(PG8_SB(1, 0), b3, voffB); PG8_STAGE(PG8_SB(1, 1), b3 + hstep, voffB); PG8_STAGE(PG8_SA(1, 0), a3, voffA); CV_LD(3);
            if constexpr (CV::ON) PG8_WAIT_V(12); else PG8_WAIT_V(8);
            PG8_WAIT_L(0); PG8_BAR; PG8_MMA(1, 0, At, B0); PG8_MMA(1, 1, At, B1); CV_CVT(1, 0, true); PG8_BAR; PG8_SCHED;
            if constexpr (CV::ON) cv_sb += cv_dn ? 65536 : 32768;
            } else {
            PG8_LDB(B0, 0, 0); PG8_SCHED; PG8_LDA(At, 0, 0); PG8_STAGE(PG8_SA(1, 1), a1 + hstep, voffA);
            PG8_WAIT_L(8); PG8_BAR; PG8_WAIT_L(0); PG8_MMA(0, 0, At, B0); PG8_BAR; PG8_SCHED;
            PG8_LDB(B1, 0, 1); PG8_STAGE(PG8_SB(0, 0), b2, voffB);
            PG8_BAR; PG8_WAIT_L(0); PG8_MMA(0, 1, At, B1); PG8_BAR;
            PG8_LDA(At, 0, 1); PG8_STAGE(PG8_SA(0, 0), a2, voffA);
            PG8_BAR; PG8_WAIT_L(0); PG8_MMA(1, 0, At, B0); PG8_BAR; PG8_SCHED;
            PG8_STAGE(PG8_SB(0, 1), b2 + hstep, voffB);
            PG8_WAIT_V(6); PG8_BAR; PG8_MMA(1, 1, At, B1); PG8_BAR;
            PG8_LDB(B0, 1, 0); PG8_SCHED; PG8_LDA(At, 1, 0); PG8_STAGE(PG8_SA(0, 1), a2 + hstep, voffA);
            PG8_WAIT_L(8); PG8_BAR; PG8_WAIT_L(0); PG8_MMA(0, 0, At, B0); PG8_BAR; PG8_SCHED;
            PG8_LDB(B1, 1, 1); PG8_STAGE(PG8_SB(1, 0), b3, voffB);
            PG8_BAR; PG8_WAIT_L(0); PG8_MMA(0, 1, At, B1); PG8_BAR;
            PG8_LDA(At, 1, 1); PG8_STAGE(PG8_SA(1, 0), a3, voffA);
            PG8_BAR; PG8_WAIT_L(0); PG8_MMA(1, 0, At, B0); PG8_BAR; PG8_SCHED;
            PG8_STAGE(PG8_SB(1, 1), b3 + hstep, voffB);
            PG8_WAIT_V(6); PG8_BAR; PG8_MMA(1, 1, At, B1); PG8_BAR;
            }
        }
        if constexpr (F8) asm volatile("s_nop 15\n\ts_nop 7" ::: "memory");
        if constexpr (ALIGN_EPI) { if (wr == 0) PG8_BAR; }
        if constexpr (!Epi::AFTER_DRAIN) { int fr_ = fr, fq_ = fq; asm volatile("" : "+v"(fr_), "+v"(fq_));
            E(acc, cur, wr, wc, fr_, fq_); S.done(cur); }
        if (!has_next) break;
#pragma unroll
        for (int a = 0; a < 2; ++a)
#pragma unroll
            for (int b = 0; b < 2; ++b)
#pragma unroll
                for (int m = 0; m < 4; ++m)
#pragma unroll
                    for (int n = 0; n < 2; ++n) acc[a][b][m][n] = (f32x4){0.f, 0.f, 0.f, 0.f};
        cur = nxt; cA = nA; cB = nB; ++ui;
        if constexpr (CV::ON) cv.decode(cur, wid, lane, cv_sb, cv_dn, cv_db, cv_dv, cv_sv);
        if constexpr (ALIGN_EPI) { if (wr == 1) PG8_BAR; }
    }
    PG8_WAIT_V(0);
    if constexpr (CV::ON) { cv_slot = cv_slot == 2048u ? 0u : cv_slot + 1024u; CV_CVT(2, 1, false); cv_slot = cv_slot == 2048u ? 0u : cv_slot + 1024u; CV_CVT(3, 1, true); CV_ST(); }
    if constexpr (!ALIGN_EPI) { if (wr == 0) PG8_BAR; }
    PG8_BAR;
    if constexpr (Epi::AFTER_DRAIN) { E.fused(acc, cur, wr, wc, fr, fq, lds, wid, lane); S.done(cur); }
#undef PG8_SA
#undef PG8_SB
#undef PG8_STAGE
#undef PG8_LDA
#undef PG8_LDB
#undef PG8_MMA
#undef PG8_CAT8
#undef PG8_WAIT_V
#undef PG8_WAIT_L
#undef PG8_BAR
#undef PG8_SCHED
#undef CV_LD
#undef CV_CVT
#undef CV_ST
}
}

namespace pg8 {
__device__ __forceinline__ void store16_wt(void* p, u32x4 v) { asm volatile("global_store_dwordx4 %0, %1, off sc1\n\ts_nop 1" :: "v"(p), "v"(v) : "memory"); }
__device__ __forceinline__ float clamp_f8(float v) { return __builtin_fminf(__builtin_fmaxf(v, -448.f), 448.f); }
__device__ __forceinline__ unsigned cvt4_fp8(float a, float b, float c, float d) { int w = 0; w = __builtin_amdgcn_cvt_pk_fp8_f32(a, b, w, false); w = __builtin_amdgcn_cvt_pk_fp8_f32(c, d, w, true); return (unsigned)w; }
__device__ __forceinline__ unsigned cvt4_fp8c(float a, float b, float c, float d) { return cvt4_fp8(clamp_f8(a), clamp_f8(b), clamp_f8(c), clamp_f8(d)); }
struct EpiInProj {
    static constexpr bool PERM = true, AFTER_DRAIN = false;
    bf16_t* O; int ldc; float* DT;
    __device__ __forceinline__ void operator()(const f32x4 (&acc)[2][2][4][2], const Unit& u, int wr, int wc, int fr, int fq) const {
        const int row0 = u.pm * BM + wr * 64 + fr;
        if (u.pn == 22) {
            if (wc == 0 && fq < 2) {
#pragma unroll
                for (int ai = 0; ai < 2; ++ai)
#pragma unroll
                    for (int m = 0; m < 4; ++m) { float* dp = DT + (size_t)(row0 + ai * HALF + m * 16) * 16 + 8 * fq; *(f32x4*)dp = acc[ai][0][m][0]; *(f32x4*)(dp + 4) = acc[ai][0][m][1]; } }
            return; }
        const int col0 = u.pn * BM + wc * 32 + 8 * fq;
#pragma unroll
        for (int ai = 0; ai < 2; ++ai)
#pragma unroll
            for (int m = 0; m < 4; ++m) { bf16_t* rowp = O + (size_t)(row0 + ai * HALF + m * 16) * ldc + col0;
#pragma unroll
                for (int bj = 0; bj < 2; ++bj) { const f32x4 v0 = acc[ai][bj][m][0], v1 = acc[ai][bj][m][1];
                    u32x4 w; w.x = cvt_pk_bf16(v0[0], v0[1]); w.y = cvt_pk_bf16(v0[2], v0[3]); w.z = cvt_pk_bf16(v1[0], v1[1]); w.w = cvt_pk_bf16(v1[2], v1[3]);
                    *(u32x4*)(rowp + bj * HALF) = w; } }
    }
};
struct EpiResid {
    static constexpr bool PERM = true, AFTER_DRAIN = false;
    const float* base; bf16_t* hb; unsigned char* h8; int ldc; const float* cs;
    __device__ __forceinline__ void operator()(const f32x4 (&acc)[2][2][4][2], const Unit& u, int wr, int wc, int fr, int fq) const {
        const int row0 = u.pm * BM + wr * 64 + fr, col0 = u.pn * BM + wc * 32 + 8 * fq;
        typedef unsigned u32x2_t __attribute__((ext_vector_type(2)));
        f32x4 csv[2][2];
#pragma unroll
        for (int bj = 0; bj < 2; ++bj) { csv[bj][0] = *(const f32x4*)(cs + col0 + bj * HALF); csv[bj][1] = *(const f32x4*)(cs + col0 + bj * HALF + 4); }
#pragma unroll
        for (int ai = 0; ai < 2; ++ai) {
            f32x4 xr[4][2][2];
#pragma unroll
            for (int m = 0; m < 4; ++m) { const size_t off = (size_t)(row0 + ai * HALF + m * 16) * ldc + col0;
#pragma unroll
                for (int bj = 0; bj < 2; ++bj) { xr[m][bj][0] = __builtin_nontemporal_load((const f32x4*)(base + off + bj * HALF)); xr[m][bj][1] = __builtin_nontemporal_load((const f32x4*)(base + off + bj * HALF + 4)); } }
#pragma unroll
            for (int m = 0; m < 4; ++m) { const size_t off = (size_t)(row0 + ai * HALF + m * 16) * ldc + col0;
#pragma unroll
                for (int bj = 0; bj < 2; ++bj) {
                    const f32x4 v0 = acc[ai][bj][m][0] + xr[m][bj][0], v1 = acc[ai][bj][m][1] + xr[m][bj][1];
                    u32x4 w; w.x = cvt_pk_bf16(v0[0], v0[1]); w.y = cvt_pk_bf16(v0[2], v0[3]); w.z = cvt_pk_bf16(v1[0], v1[1]); w.w = cvt_pk_bf16(v1[2], v1[3]);
                    *(u32x4*)(hb + off + bj * HALF) = w;
                    const f32x4 s0 = v0 * csv[bj][0], s1 = v1 * csv[bj][1];
                    u32x2_t q; q.x = cvt4_fp8c(s0[0], s0[1], s0[2], s0[3]); q.y = cvt4_fp8c(s1[0], s1[1], s1[2], s1[3]);
                    *(u32x2_t*)(h8 + off + bj * HALF) = q; } }
        }
    }
};
struct ExpertScale {
    const PG8_LAS int* tab; const float* lst; int lcap;
    __device__ __forceinline__ float at(const Unit& u, int rowlocal) const { const int e = u.pn >> 3, p = (u.pm - tab[40 + e]) * BM + rowlocal; return p < tab[80 + e] ? lst[(size_t)e * lcap + p] : 0.f; }
};
struct EpiGateUp {
    static constexpr bool PERM = true, AFTER_DRAIN = false;
    unsigned char* O; int ldc; ExpertScale rs; float wsc;
    __device__ __forceinline__ void operator()(const f32x4 (&acc)[2][2][4][2], const Unit& u, int wr, int wc, int fr, int fq) const {
        const int rl0 = wr * 64 + fr, col0 = (u.pn & 7) * HALF + wc * 32 + 8 * fq;
        float rsc[2][4];
#pragma unroll
        for (int ai = 0; ai < 2; ++ai)
#pragma unroll
            for (int m = 0; m < 4; ++m) rsc[ai][m] = rs.at(u, rl0 + ai * HALF + m * 16) * wsc;
#pragma unroll
        for (int ai = 0; ai < 2; ++ai)
#pragma unroll
            for (int m = 0; m < 4; ++m) { const int rl = rl0 + ai * HALF + m * 16; const float r = rsc[ai][m];
                float hv[8];
#pragma unroll
                for (int n = 0; n < 2; ++n)
#pragma unroll
                    for (int j = 0; j < 4; ++j) { const float g = acc[ai][0][m][n][j] * r, up = acc[ai][1][m][n][j] * r; hv[n * 4 + j] = g * __builtin_amdgcn_rcpf(1.f + __builtin_amdgcn_exp2f(-1.44269504089f * g)) * up; }
                typedef unsigned u32x2_t __attribute__((ext_vector_type(2))); u32x2_t q; q.x = cvt4_fp8c(hv[0], hv[1], hv[2], hv[3]); q.y = cvt4_fp8c(hv[4], hv[5], hv[6], hv[7]);
                *(u32x2_t*)(O + (size_t)(u.pm * BM + rl) * ldc + col0) = q; }
    }
};
struct EpiRowScale {
    static constexpr bool PERM = true, AFTER_DRAIN = false;
    unsigned char* O; int ldc; ExpertScale rs; float wsc;
    __device__ __forceinline__ void operator()(const f32x4 (&acc)[2][2][4][2], const Unit& u, int wr, int wc, int fr, int fq) const {
        const int rl0 = wr * 64 + fr, col0 = (u.pn & 7) * BM + wc * 64 + 16 * fq;
        float rsc[2][4];
#pragma unroll
        for (int ai = 0; ai < 2; ++ai)
#pragma unroll
            for (int m = 0; m < 4; ++m) rsc[ai][m] = rs.at(u, rl0 + ai * HALF + m * 16) * wsc;
#pragma unroll
        for (int ai = 0; ai < 2; ++ai)
#pragma unroll
            for (int m = 0; m < 4; ++m) { const int rl = rl0 + ai * HALF + m * 16; const float r = rsc[ai][m];
                const f32x4 v0 = acc[ai][0][m][0] * r, v1 = acc[ai][0][m][1] * r, v2 = acc[ai][1][m][0] * r, v3 = acc[ai][1][m][1] * r;
                u32x4 q; q.x = cvt4_fp8c(v0[0], v0[1], v0[2], v0[3]); q.y = cvt4_fp8c(v1[0], v1[1], v1[2], v1[3]); q.z = cvt4_fp8c(v2[0], v2[1], v2[2], v2[3]); q.w = cvt4_fp8c(v3[0], v3[1], v3[2], v3[3]);
                *(u32x4*)(O + (size_t)(u.pm * BM + rl) * ldc + col0) = q; }
    }
};
struct ExpertOrder {
    const PG8_LAS int* tab; int nwg, G, c;
    __device__ __forceinline__ void init(const PG8_LAS int* t, int G_, int c_) { tab = t; nwg = t[32]; G = G_; c = c_; }
    __device__ __forceinline__ bool next(int i, Unit& u) const {
        const long L = (long)i * G + c; if (L >= nwg) return false;
        int wgid = (int)L; { const int q = nwg / NXCD, r = nwg % NXCD, xcd = wgid % NXCD, off = wgid / NXCD; wgid = (xcd < r ? xcd * (q + 1) : r * (q + 1) + (xcd - r) * q) + off; }
        const int tj = tab[threadIdx.x & 31];
        const int e = __builtin_popcountll(__ballot(wgid >= tj) & 0xffffffffull) - 1;
        const int local_i = wgid - tab[e], mt = (tab[e + 1] - tab[e]) >> 3;
        u.pm = tab[40 + e] + local_i % mt; u.pn = e * 8 + local_i / mt; return true;
    }
    __device__ __forceinline__ void a_ready(const Unit&) const {}
    __device__ __forceinline__ void done(const Unit&) const {}
};
struct TeamOrder {
    int c, i0, i1;
    __device__ __forceinline__ bool next(int i, Unit& u) const {
        i += i0; if (i >= i1) return false;
        const int xcd = c & 7, l = c >> 3; if (i * 32 + l >= 184) return false;
        int pmo, pn;
        if (i < 5) { const int t = l >> 3, j = l & 7; pmo = 4 * (t & 1) + (j & 3); pn = 4 * i + 2 * (t >> 1) + (j >> 2); }
        else { pmo = l & 7; pn = 20 + (l >> 3); }
        u.pm = 8 * xcd + pmo; u.pn = pn; return true;
    }
    __device__ __forceinline__ void a_ready(const Unit&) const {}
    __device__ __forceinline__ void done(const Unit&) const {}
};
template <class KArgs, int IN_GATE, size_t WGU_OFF, size_t WD_OFF, size_t DUMMY, int LDSOFF> struct ConvMoE {
    static constexpr bool ON = true; static constexpr float SCALE = 64.f;
    static constexpr unsigned DUMMY_OFF = (unsigned)DUMMY; static constexpr int LDS_OFF = LDSOFF; static constexpr int nN = 23;
    static_assert(WD_OFF + 64u * 1024 * 1024 < (1ull << 32) && DUMMY < (1ull << 32), "32-bit workspace offsets");
    __device__ __forceinline__ unsigned char* wsbase() const { const KArgs a = (KArgs)__builtin_amdgcn_kernarg_segment_ptr(); return a->ws; }
    __device__ __forceinline__ void decode(const Unit& u, int wid, int lane, const char*& sb, int& dn, unsigned& db, unsigned& dv, unsigned& sv) const {
        const KArgs a = (KArgs)__builtin_amdgcn_kernarg_segment_ptr();
        const int cb = (u.pm * nN + u.pn) * 8 + wid, nl = 2 * lane;
        if (cb < 8192) { const int up = cb >> 12, r = cb & 4095, e = r >> 7, kb = (r >> 3) & 15, nb = r & 7;
            sb = (const char*)((const float*)a->in[IN_GATE + up] + (size_t)e * 2048 * 1024 + (size_t)(128 * kb) * 1024 + 128 * nb); dn = 0;
            db = (unsigned)(WGU_OFF + (size_t)e * 2048 * 2048 + (size_t)(nb * 256 + up * 128) * 2048 + 128 * kb); dv = (unsigned)nl * 2048u; sv = (unsigned)(lane >> 5) * 4096u + (unsigned)(lane & 31) * 16u; }
        else { const int r = cb - 8192, e = r >> 7, kb = (r >> 4) & 7, nb = r & 15;
            sb = (const char*)((const float*)a->in[IN_GATE + 2] + (size_t)e * 1024 * 2048 + (size_t)(128 * kb) * 2048 + 128 * nb); dn = 1;
            db = (unsigned)(WD_OFF + (size_t)e * 2048 * 1024 + (size_t)(256 * (nb >> 1)) * 1024 + 128 * kb);
            dv = (unsigned)(((nl >> 3) & 1) * 128 + (2 * (nb & 1) + (nl >> 6)) * 32 + ((nl >> 4) & 3) * 8 + (nl & 7)) * 1024u; sv = (unsigned)(lane >> 5) * 8192u + (unsigned)(lane & 31) * 16u; }
    }
};
}

namespace pg8 {
template <class Epi, class Sched, class RowSrc, bool ALIGN_EPI = false, bool SP2 = false, bool F8 = false>
__device__ __forceinline__ void gemm_phase_g(PG8_LAS unsigned char* lds, const Gemm g, const Sched& S, const Epi& E, const RowSrc& RS) {
    const int tid = threadIdx.x, wid = __builtin_amdgcn_readfirstlane(tid >> 6), lane = tid & 63, wr = wid >> 2, wc = wid & 3, fr = lane & 15, fq = lane >> 4;
    const int K = g.K, nt = K / BK;
    unsigned voffB[2]; unsigned vC0[2], vC1[2], vN0[2], vN1[2]; int Rr[2], Cc[2];
#pragma unroll
    for (int i = 0; i < 2; ++i) { int R, C; stage_rc(tid * 16 + i * 8192, R, C); const int Rb = Epi::PERM ? ((R & ~31) + perm32(R & 31)) : R;
        Rr[i] = R; Cc[i] = C; voffB[i] = (unsigned)(Rb * K + C) * 2u; }
    const size_t kstep = (size_t)(BK * 2);
    const size_t hstep = (size_t)HALF * K * 2;
    const size_t tstep = 2 * hstep;
    const unsigned ldsw = (unsigned)wid * 1024u;
    const int aoff = lds_byte(wr * 64 + fr, fq * 8), boff = lds_byte(wc * 32 + fr, fq * 8);
#define PG8_CAT8(x, y) __builtin_bit_cast(v8i_t, __builtin_shufflevector((x), (y), 0, 1, 2, 3, 4, 5, 6, 7, 8, 9, 10, 11, 12, 13, 14, 15))
#define PG8_SA(b, h) (((b) * 2 + (h)) * HTB)
#define PG8_SB(b, h) ((4 + (b) * 2 + (h)) * HTB)
#define PG8_STAGE(bufoff, gbase, voff) do { _Pragma("unroll") for (int _i = 0; _i < 2; ++_i) \
        __builtin_amdgcn_global_load_lds((const unsigned*)((const char*)(gbase) + (voff)[_i]), (PG8_LAS unsigned*)(lds + (bufoff) + ldsw + _i * 8192), 16, 0, 0); } while (0)
#define PG8_LDA(dst, b, h) do { if constexpr (F8) { _Pragma("unroll") for (int m = 0; m < 4; ++m) dst##8[m] = PG8_CAT8(*(const PG8_LAS bf16x8*)(lds + PG8_SA(b, h) + aoff + m * 2048), *(const PG8_LAS bf16x8*)(lds + PG8_SA(b, h) + aoff + m * 2048 + 1024)); } else _Pragma("unroll") for (int m = 0; m < 4; ++m) _Pragma("unroll") for (int k = 0; k < 2; ++k) dst[m][k] = *(const PG8_LAS bf16x8*)(lds + PG8_SA(b, h) + aoff + m * 2048 + k * 1024); } while (0)
#define PG8_LDB(dst, b, h) do { if constexpr (F8) { _Pragma("unroll") for (int n = 0; n < 2; ++n) dst##8[n] = PG8_CAT8(*(const PG8_LAS bf16x8*)(lds + PG8_SB(b, h) + boff + n * 2048), *(const PG8_LAS bf16x8*)(lds + PG8_SB(b, h) + boff + n * 2048 + 1024)); } else _Pragma("unroll") for (int n = 0; n < 2; ++n) _Pragma("unroll") for (int k = 0; k < 2; ++k) dst[n][k] = *(const PG8_LAS bf16x8*)(lds + PG8_SB(b, h) + boff + n * 2048 + k * 1024); } while (0)
#define PG8_MMA(ai, bj, At, Bt) do { __builtin_amdgcn_s_setprio(1); \
        if constexpr (F8) { _Pragma("unroll") for (int m = 0; m < 4; ++m) _Pragma("unroll") for (int n = 0; n < 2; ++n) \
            asm volatile("v_mfma_f32_16x16x128_f8f6f4 %0, %1, %2, %0" : "+v"(acc[ai][bj][m][n]) : "v"(Bt##8[n]), "v"(At##8[m])); }     \
        else { _Pragma("unroll") for (int m = 0; m < 4; ++m) _Pragma("unroll") for (int n = 0; n < 2; ++n) _Pragma("unroll") for (int k = 0; k < 2; ++k) \
            acc[ai][bj][m][n] = __builtin_amdgcn_mfma_f32_16x16x32_bf16(Bt[n][k], At[m][k], acc[ai][bj][m][n], 0, 0, 0); } \
        __builtin_amdgcn_s_setprio(0); } while (0)
#define PG8_WAIT_V(n) asm volatile("s_waitcnt vmcnt(" #n ")" ::: "memory")
#define PG8_WAIT_L(n) asm volatile("s_waitcnt lgkmcnt(" #n ")" ::: "memory")
#define PG8_BAR __builtin_amdgcn_s_barrier()
#define PG8_SCHED __builtin_amdgcn_sched_barrier(0)
    Unit cur, nxt; int ui = 0;
    if (!S.next(0, cur)) return;
    f32x4 acc[2][2][4][2];
#pragma unroll
    for (int a = 0; a < 2; ++a)
#pragma unroll
        for (int b = 0; b < 2; ++b)
#pragma unroll
            for (int m = 0; m < 4; ++m)
#pragma unroll
                for (int n = 0; n < 2; ++n) acc[a][b][m][n] = (f32x4){0.f, 0.f, 0.f, 0.f};
    bf16x8 At[4][2], B0[2][2], B1[2][2];
    v8i_t At8[4], B08[2], B18[2];
    const char* cA = (const char*)g.A; const char* cB = (const char*)g.Bt + (size_t)cur.pn * tstep;
    RS.rows(cur, Rr, Cc, K, vC0, vC1);
    S.a_ready(cur);
    if constexpr (SP2) {
        PG8_STAGE(PG8_SB(0, 0), cB, voffB); PG8_STAGE(PG8_SB(0, 1), cB + hstep, voffB); PG8_STAGE(PG8_SA(0, 0), cA, vC0); PG8_STAGE(PG8_SA(0, 1), cA, vC1);
        if (wr == 1) PG8_BAR;
        PG8_WAIT_V(2); PG8_BAR;
        PG8_STAGE(PG8_SB(1, 0), cB + kstep, voffB); PG8_STAGE(PG8_SA(1, 0), cA + kstep, vC0); PG8_STAGE(PG8_SB(1, 1), cB + hstep + kstep, voffB);
        PG8_WAIT_V(6); PG8_BAR;
    } else {
        PG8_STAGE(PG8_SB(0, 0), cB, voffB); PG8_STAGE(PG8_SA(0, 0), cA, vC0); PG8_STAGE(PG8_SB(0, 1), cB + hstep, voffB); PG8_STAGE(PG8_SA(0, 1), cA, vC1);
        if (wr == 1) PG8_BAR;
        PG8_WAIT_V(4); PG8_BAR;
        PG8_STAGE(PG8_SB(1, 0), cB + kstep, voffB); PG8_STAGE(PG8_SA(1, 0), cA + kstep, vC0); PG8_STAGE(PG8_SB(1, 1), cB + hstep + kstep, voffB);
        PG8_WAIT_V(6); PG8_BAR;
    }
    for (;;) {
        const bool has_next = S.next(ui + 1, nxt);
        const char* nA = cA; const char* nB = has_next ? (const char*)g.Bt + (size_t)nxt.pn * tstep : cB;
        if (has_next) RS.rows(nxt, Rr, Cc, K, vN0, vN1); else { vN0[0] = vC0[0]; vN0[1] = vC0[1]; vN1[0] = vC1[0]; vN1[1] = vC1[1]; }
        for (int t = 0; t < nt; t += 2) {
            const bool last = (t == nt - 2);
            const char* a1 = cA + (size_t)(t + 1) * kstep;
            const char* a2 = last ? nA : cA + (size_t)(t + 2) * kstep; const char* b2 = last ? nB : cB + (size_t)(t + 2) * kstep;
            const char* a3 = a2 + kstep; const char* b3 = b2 + kstep;
            const unsigned v20[2] = {last ? vN0[0] : vC0[0], last ? vN0[1] : vC0[1]}, v21[2] = {last ? vN1[0] : vC1[0], last ? vN1[1] : vC1[1]};
            if (last && has_next) S.a_ready(nxt);
            if constexpr (SP2) {
            PG8_LDB(B0, 0, 0); PG8_LDB(B1, 0, 1); PG8_SCHED; PG8_LDA(At, 0, 0); PG8_STAGE(PG8_SA(1, 1), a1, vC1);
            PG8_WAIT_V(8); PG8_WAIT_L(0); PG8_BAR; PG8_MMA(0, 0, At, B0); PG8_MMA(0, 1, At, B1); PG8_BAR; PG8_SCHED;
            PG8_LDA(At, 0, 1); PG8_STAGE(PG8_SB(0, 0), b2, voffB); PG8_STAGE(PG8_SB(0, 1), b2 + hstep, voffB); PG8_STAGE(PG8_SA(0, 0), a2, v20);
            PG8_WAIT_V(8); PG8_WAIT_L(0); PG8_BAR; PG8_MMA(1, 0, At, B0); PG8_MMA(1, 1, At, B1); PG8_BAR; PG8_SCHED;
            PG8_LDB(B0, 1, 0); PG8_LDB(B1, 1, 1); PG8_SCHED; PG8_LDA(At, 1, 0); PG8_STAGE(PG8_SA(0, 1), a2, v21);
            PG8_WAIT_V(8); PG8_WAIT_L(0); PG8_BAR; PG8_MMA(0, 0, At, B0); PG8_MMA(0, 1, At, B1); PG8_BAR; PG8_SCHED;
            PG8_LDA(At, 1, 1); PG8_STAGE(PG8_SB(1, 0), b3, voffB); PG8_STAGE(PG8_SB(1, 1), b3 + hstep, voffB); PG8_STAGE(PG8_SA(1, 0), a3, v20);
            PG8_WAIT_V(8); PG8_WAIT_L(0); PG8_BAR; PG8_MMA(1, 0, At, B0); PG8_MMA(1, 1, At, B1); PG8_BAR; PG8_SCHED;
            } else {
            PG8_LDB(B0, 0, 0); PG8_SCHED; PG8_LDA(At, 0, 0); PG8_STAGE(PG8_SA(1, 1), a1, vC1);
            PG8_WAIT_L(8); PG8_BAR; PG8_WAIT_L(0); PG8_MMA(0, 0, At, B0); PG8_BAR; PG8_SCHED;
            PG8_LDB(B1, 0, 1); PG8_STAGE(PG8_SB(0, 0), b2, voffB);
            PG8_BAR; PG8_WAIT_L(0); PG8_MMA(0, 1, At, B1); PG8_BAR;
            PG8_LDA(At, 0, 1); PG8_STAGE(PG8_SA(0, 0), a2, v20);
            PG8_BAR; PG8_WAIT_L(0); PG8_MMA(1, 0, At, B0); PG8_BAR; PG8_SCHED;
            PG8_STAGE(PG8_SB(0, 1), b2 + hstep, voffB);
            PG8_WAIT_V(6); PG8_BAR; PG8_MMA(1, 1, At, B1); PG8_BAR;
            PG8_LDB(B0, 1, 0); PG8_SCHED; PG8_LDA(At, 1, 0); PG8_STAGE(PG8_SA(0, 1), a2, v21);
            PG8_WAIT_L(8); PG8_BAR; PG8_WAIT_L(0); PG8_MMA(0, 0, At, B0); PG8_BAR; PG8_SCHED;
            PG8_LDB(B1, 1, 1); PG8_STAGE(PG8_SB(1, 0), b3, voffB);
            PG8_BAR; PG8_WAIT_L(0); PG8_MMA(0, 1, At, B1); PG8_BAR;
            PG8_LDA(At, 1, 1); PG8_STAGE(PG8_SA(1, 0), a3, v20);
            PG8_BAR; PG8_WAIT_L(0); PG8_MMA(1, 0, At, B0); PG8_BAR; PG8_SCHED;
            PG8_STAGE(PG8_SB(1, 1), b3 + hstep, voffB);
            PG8_WAIT_V(6); PG8_BAR; PG8_MMA(1, 1, At, B1); PG8_BAR;
            }
        }
        if constexpr (F8) asm volatile("s_nop 15\n\ts_nop 7" ::: "memory");
        if constexpr (ALIGN_EPI) { if (wr == 0) PG8_BAR; }
        if constexpr (!Epi::AFTER_DRAIN) { E(acc, cur, wr, wc, fr, fq); S.done(cur); }
        if (!has_next) break;
#pragma unroll
        for (int a = 0; a < 2; ++a)
#pragma unroll
            for (int b = 0; b < 2; ++b)
#pragma unroll
                for (int m = 0; m < 4; ++m)
#pragma unroll
                    for (int n = 0; n < 2; ++n) acc[a][b][m][n] = (f32x4){0.f, 0.f, 0.f, 0.f};
        cur = nxt; cA = nA; cB = nB; ++ui; vC0[0] = vN0[0]; vC0[1] = vN0[1]; vC1[0] = vN1[0]; vC1[1] = vN1[1];
        if constexpr (ALIGN_EPI) { if (wr == 1) PG8_BAR; }
    }
    PG8_WAIT_V(0);
    if constexpr (!ALIGN_EPI) { if (wr == 0) PG8_BAR; }
    PG8_BAR;
    if constexpr (Epi::AFTER_DRAIN) { E.fused(acc, cur, wr, wc, fr, fq, lds, wid, lane); S.done(cur); }
#undef PG8_SA
#undef PG8_SB
#undef PG8_STAGE
#undef PG8_LDA
#undef PG8_LDB
#undef PG8_MMA
#undef PG8_CAT8
#undef PG8_WAIT_V
#undef PG8_WAIT_L
#undef PG8_BAR
#undef PG8_SCHED
}

struct ExpertRows {
    const PG8_LAS int* tab; const int* lst_tok; int lcap;
    __device__ __forceinline__ void rows(const Unit& u, const int (&Rr)[2], const int (&Cc)[2], int K, unsigned (&v0)[2], unsigned (&v1)[2]) const {
        const int e = u.pn >> 3, mi = u.pm - tab[40 + e], cnt = tab[80 + e];
#pragma unroll
        for (int i = 0; i < 2; ++i) { const int p0 = mi * BM + Rr[i], p1 = p0 + HALF;
            const int t0 = p0 < cnt ? lst_tok[(size_t)e * lcap + p0] : 0, t1 = p1 < cnt ? lst_tok[(size_t)e * lcap + p1] : 0;
            v0[i] = (unsigned)(t0 * K + Cc[i]) * 2u; v1[i] = (unsigned)(t1 * K + Cc[i]) * 2u; }
    }
};
}

#ifndef PG8_SP2
#define PG8_SP2 true
#endif
#ifndef PG8_ALIGN
#define PG8_ALIGN true
#endif

namespace attn_body {
using bf16=__hip_bfloat16;
using bf16x8=__attribute__((ext_vector_type(8)))short;
using s16x4=__attribute__((ext_vector_type(4)))short;
using f32x16=__attribute__((ext_vector_type(16)))float;
using u32x4=__attribute__((ext_vector_type(4)))unsigned;
constexpr int SEQ=2048,D=64,QP=1024,KP=1024,VP=5632,OP=1024;
constexpr int NW=8,QBLK=32,QB=QBLK*NW,KVBLK=64,NQB=SEQ/QB;
constexpr int ATTN_UNIT_ROWS=QB;
__device__ __forceinline__ int crow(int r,int hi){return (r&3)+8*(r>>2)+4*hi;}
#define SBAR() __builtin_amdgcn_sched_barrier(0)
__device__ __forceinline__ void cmask(f32x16&p0,f32x16&p1,int jb,int qrel,int hi){
  const float NEG=-INFINITY; int kb=64*jb+4*hi;
  #pragma unroll
  for(int r=0;r<16;++r){int kv=kb+(r&3)+8*(r>>2); if(kv>qrel)p0[r]=NEG; if(kv+32>qrel)p1[r]=NEG;}
}

constexpr int NSLOT=3, SLOTB=8192;
constexpr int LDS_K=0, LDS_V=NSLOT*SLOTB, LDS_WS=2*NSLOT*SLOTB, LDS_OST=LDS_WS+NW*64*4, LDS_BYTES=LDS_OST+NW*4096;
constexpr float C2=0.125f*1.4426950408889634f;
__device__ __forceinline__ void glds16(const void*gsrc,unsigned lds_dst){unsigned keep;
  asm volatile("s_mov_b32 %0, m0\n\ts_mov_b32 m0, %2\n\ts_nop 0\n\tglobal_load_lds_dwordx4 %1, off\n\ts_mov_b32 m0, %0":"=&s"(keep):"v"(gsrc),"s"(lds_dst):"memory");}
__device__ __forceinline__ float max3f(float a,float b,float c){float r;asm("v_max3_f32 %0, %1, %2, %3":"=v"(r):"v"(a),"v"(b),"v"(c));return r;}
__device__ __forceinline__ float max2f(float a,float b){float r;asm("v_max_f32_e32 %0, %1, %2":"=v"(r):"v"(a),"v"(b));return r;}
__device__ __forceinline__ float fadd_s(float a,float b){float r;asm("v_add_f32_e32 %0, %1, %2":"=v"(r):"v"(a),"v"(b));return r;}
__device__ __forceinline__ float fsub_s(float a,float b){float r;asm("v_sub_f32_e32 %0, %1, %2":"=v"(r):"v"(a),"v"(b));return r;}
typedef float f32x2_t __attribute__((ext_vector_type(2))); typedef __bf16 bf16x2_t __attribute__((ext_vector_type(2)));
__device__ __forceinline__ unsigned cvtpk_s(float lo,float hi){f32x2_t v={lo,hi};bf16x2_t b=__builtin_convertvector(v,bf16x2_t);return __builtin_bit_cast(unsigned,b);}
#define WAIT_BAR(N) asm volatile("s_waitcnt vmcnt(" #N ") lgkmcnt(0)\n\ts_barrier":::"memory")

__device__ __forceinline__ void qkt(f32x16&p0,f32x16&p1,const char*Kslot,const bf16x8*qr,const f32x16&negm,int r32,int hi){
  const char*kb=Kslot+hi*1024+r32*16;
  #pragma unroll
  for(int d0=0;d0<4;++d0){
    const bf16x8 b0=*reinterpret_cast<const bf16x8*>(kb+d0*2048);
    const bf16x8 b1=*reinterpret_cast<const bf16x8*>(kb+d0*2048+512);
    if(d0==0){p0=__builtin_amdgcn_mfma_f32_32x32x16_bf16(b0,qr[0],negm,0,0,0);p1=__builtin_amdgcn_mfma_f32_32x32x16_bf16(b1,qr[0],negm,0,0,0);}
    else{p0=__builtin_amdgcn_mfma_f32_32x32x16_bf16(b0,qr[d0],p0,0,0,0);p1=__builtin_amdgcn_mfma_f32_32x32x16_bf16(b1,qr[d0],p1,0,0,0);}}
}
typedef __attribute__((address_space(3))) const char* lds_cptr;
typedef short v4i16_t __attribute__((ext_vector_type(4)));
__device__ __forceinline__ void kload8(bf16x8*kf,lds_cptr kp){
  kf[0]=*(const __attribute__((address_space(3))) bf16x8*)(kp);      kf[1]=*(const __attribute__((address_space(3))) bf16x8*)(kp+512);
  kf[2]=*(const __attribute__((address_space(3))) bf16x8*)(kp+2048); kf[3]=*(const __attribute__((address_space(3))) bf16x8*)(kp+2560);
  kf[4]=*(const __attribute__((address_space(3))) bf16x8*)(kp+4096); kf[5]=*(const __attribute__((address_space(3))) bf16x8*)(kp+4608);
  kf[6]=*(const __attribute__((address_space(3))) bf16x8*)(kp+6144); kf[7]=*(const __attribute__((address_space(3))) bf16x8*)(kp+6656);
}
__device__ __forceinline__ void kload2(bf16x8*kf,lds_cptr kp,int j){ kf[2*j]=*(const __attribute__((address_space(3))) bf16x8*)(kp+j*2048); kf[2*j+1]=*(const __attribute__((address_space(3))) bf16x8*)(kp+j*2048+512); }
__device__ __forceinline__ s16x4 vtr(lds_cptr p){ return __builtin_bit_cast(s16x4,__builtin_amdgcn_ds_read_tr16_b64_v4i16((__attribute__((address_space(3))) v4i16_t*)p)); }
__device__ __forceinline__ float rowmax(const f32x16&p0,const f32x16&p1){
  float a=max3f(p0[0],p0[1],p1[0]),b=max3f(p0[2],p0[3],p1[1]);a=max3f(a,p1[2],p1[3]);
  #pragma unroll
  for(int r=4;r<16;r+=4){a=max3f(a,p0[r],p0[r+1]);b=max3f(b,p0[r+2],p0[r+3]);a=max3f(a,p1[r],p1[r+1]);b=max3f(b,p1[r+2],p1[r+3]);}
  const float m=max2f(a,b);
  auto rr=__builtin_amdgcn_permlane32_swap(__float_as_uint(m),__float_as_uint(m),false,false);
  return max2f(__uint_as_float(rr[0]),__uint_as_float(rr[1]));
}
__device__ __forceinline__ void pv(f32x16*o,int vb,bf16x8 pa0,bf16x8 pa1,bf16x8 pa2,bf16x8 pa3){
  #pragma unroll
  for(int d0=0;d0<2;++d0){s16x4 lo[4],hi[4];
    #pragma unroll
    for(int ks=0;ks<4;++ks){
      asm volatile("ds_read_b64_tr_b16 %0,%1 offset:%c2":"=&v"(lo[ks]):"v"(vb),"i"(d0*4096+ks*1024):"memory");
      asm volatile("ds_read_b64_tr_b16 %0,%1 offset:%c2":"=&v"(hi[ks]):"v"(vb),"i"(d0*4096+ks*1024+512):"memory");}
    asm volatile("s_waitcnt lgkmcnt(0)":::"memory");SBAR();
    #define PK(k) (bf16x8){lo[k][0],lo[k][1],lo[k][2],lo[k][3],hi[k][0],hi[k][1],hi[k][2],hi[k][3]}
    o[d0]=__builtin_amdgcn_mfma_f32_32x32x16_bf16(pa0,PK(0),o[d0],0,0,0);
    o[d0]=__builtin_amdgcn_mfma_f32_32x32x16_bf16(pa1,PK(1),o[d0],0,0,0);
    o[d0]=__builtin_amdgcn_mfma_f32_32x32x16_bf16(pa2,PK(2),o[d0],0,0,0);
    o[d0]=__builtin_amdgcn_mfma_f32_32x32x16_bf16(pa3,PK(3),o[d0],0,0,0);
    #undef PK
  }
}

#ifndef ATTN_STORE16
#define ATTN_STORE16(p,v) (*(u32x4*)(p)=(v))
#endif
template<int THRL> __device__ __forceinline__ void attn_unit(int b,int h,int qb,const bf16*Q,const bf16*__restrict__ K,const bf16*__restrict__ V,bf16*O,char*shm){
  int tid_=threadIdx.x; asm volatile("" : "+v"(tid_));
  const int tid=tid_,lane=tid&63,r32=lane&31,hi=lane>>5; const int wid=__builtin_amdgcn_readfirstlane(tid>>6);
  const long rowbase=(long)b*SEQ; const int q0=qb*QB;
  const bf16*Qw=Q+(rowbase+q0+wid*QBLK)*QP+h*D;
  const bf16*Kh=K+rowbase*KP+h*D,*Vh=V+rowbase*VP+h*D;
  const unsigned lds0=(unsigned)(uintptr_t)shm;
  float*wsf=(float*)(shm+LDS_WS)+wid*64;
  const bf16*ksrc=Kh+(long)lane*KP+wid*8;
  const bf16*vsrc=Vh+(long)(16*(wid&3)+(lane>>2))*VP+(wid>>2)*32+(lane&3)*8;
  const unsigned kdst=lds0+LDS_K+wid*1024, vdst=lds0+LDS_V+wid*1024;
  #define DMA_K(t,slot) glds16(ksrc+(long)(t)*KVBLK*KP,(unsigned)__builtin_amdgcn_readfirstlane(kdst+(slot)))
  #define DMA_V(t,slot) glds16(vsrc+(long)(t)*KVBLK*VP,(unsigned)__builtin_amdgcn_readfirstlane(vdst+(slot)))
  const int vb0=(int)(lds0+LDS_V)+((lane>>4)&1)*32+(lane&3)*8+(4*hi+((lane&15)>>2))*64;
  const char*Kbase=shm+LDS_K; bf16x8 kf[8];
  const lds_cptr shm3=(lds_cptr)shm; const lds_cptr kp0=shm3+LDS_K+hi*1024+r32*16; const lds_cptr vp0=shm3+LDS_V+((lane>>4)&1)*32+(lane&3)*8+(4*hi+((lane&15)>>2))*64;
  const int NT=(q0+QB)/KVBLK;
  DMA_K(0,0);DMA_V(0,0);DMA_K(1,SLOTB);
  bf16x8 qr[4];
  #pragma unroll
  for(int d0=0;d0<4;++d0)qr[d0]=*reinterpret_cast<const bf16x8*>(&Qw[(long)r32*QP+d0*16+hi*8]);
  float mhat=0.f,l_reg=0.f;f32x16 o[2];o[0]=f32x16{};o[1]=f32x16{};f32x16 negm=f32x16{};asm volatile("":"+v"(negm));
  const int qrel=wid*QBLK+r32;
  #define CMASK(P0,P1,t) do{int jb_=(t)-(NT-4); if(jb_>=0)cmask(P0,P1,jb_,qrel,hi);}while(0)
  bool resc=false;
  #define START(P0,P1) do{ const float rm=rowmax(P0,P1); resc=false; \
    { const float dl=rm; mhat=fadd_s(mhat,dl); \
      _Pragma("unroll") for(int r=0;r<16;++r){P0[r]=fsub_s(P0[r],dl);P1[r]=fsub_s(P1[r],dl);} \
      _Pragma("unroll") for(int r=0;r<16;++r)negm[r]=-mhat; asm volatile("":"+v"(negm)); } \
    _Pragma("unroll") for(int r=0;r<16;++r)P0[r]=__builtin_amdgcn_exp2f(P0[r]); }while(0)
  #define RESC() do{ if(resc){ asm volatile("s_waitcnt lgkmcnt(0)":::"memory"); \
      _Pragma("unroll") for(int d_=0;d_<2;++d_) _Pragma("unroll") for(int r=0;r<16;++r)o[d_][r]*=wsf[crow(r,hi)]; } }while(0)
  f32x16 pA0,pA1,pB0,pB1;
  int sl_prev=0,sl_cur=0,sl_next=SLOTB;
  #define ROT() do{sl_prev=sl_cur;sl_cur=sl_next;sl_next=(sl_next==(NSLOT-1)*SLOTB)?0:sl_next+SLOTB;}while(0)
  DMA_K(2,2*SLOTB);
  WAIT_BAR(3);
  qkt(pA0,pA1,Kbase,qr,negm,r32,hi);asm volatile("s_nop 15\n\ts_nop 7":"+v"(pA0),"+v"(pA1));CMASK(pA0,pA1,0);
  START(pA0,pA1);
  _Pragma("unroll") for(int r=0;r<16;++r)pA1[r]=__builtin_amdgcn_exp2f(pA1[r]);
  WAIT_BAR(0);
  DMA_K(3,0);DMA_V(1,SLOTB);
  ROT();
  kload8(kf,kp0+sl_cur);
  WAIT_BAR(2);
  s16x4 vlo[8],vhi[8]; u32x4 pw0,pw1,pw2,pw3;
  #define PKW(P,B) cvtpk_s(P[B],P[B+1])
  #define PAF(k) __builtin_bit_cast(bf16x8,pw##k)
  #define VFR(i) (bf16x8){vlo[i][0],vlo[i][1],vlo[i][2],vlo[i][3],vhi[i][0],vhi[i][1],vhi[i][2],vhi[i][3]}
  #define PIN(x) asm volatile("":"+v"(x))
  #define MX3(a,b,c) __builtin_fmaxf(__builtin_fmaxf((a),(b)),(c))
  #define GAPA(MF,A0,A1,A2,A3,W0,W1,PW) do{ MF; sacc+=A0; sacc+=A1; sacc+=A2; sacc+=A3; PIN(sacc); W0; W1; PIN(PW); SBAR(); }while(0)
  #define EX(v) __builtin_amdgcn_exp2f(v)
  #define GAPB(MF,X,B) do{ MF; X[B]=EX(X[B]); X[B+1]=EX(X[B+1]); X[B+2]=EX(X[B+2]); X[B+3]=EX(X[B+3]); PIN(X); SBAR(); }while(0)
  #define VRD(i) do{ vlo[i]=vtr(vp_+(((i)>>2)*4096+((i)&3)*1024)); vhi[i]=vtr(vp_+(((i)>>2)*4096+((i)&3)*1024+512)); }while(0)
  #define KRD(G,j) do{ if(G){ kload2(kf,kp0+sl_next,j); SBAR(); } }while(0)
  #define STEP(C0,C1,P0,P1,t,GK,GV,GL) do{ SBAR(); \
    const lds_cptr vp_=vp0+sl_prev; \
    VRD(0); SBAR(); float sacc=(P0[0]+P0[1]); \
    GAPA(C0=__builtin_amdgcn_mfma_f32_32x32x16_bf16(kf[0],qr[0],negm,0,0,0), P0[2],P0[3],P0[4],P0[5],     pw0[0]=PKW(P0,0), pw0[1]=PKW(P0,2), pw0); \
    VRD(4); SBAR(); GAPA(C1=__builtin_amdgcn_mfma_f32_32x32x16_bf16(kf[1],qr[0],negm,0,0,0), P0[6],P0[7],P0[8],P0[9],     pw0[2]=PKW(P0,4), pw0[3]=PKW(P0,6), pw0); \
    VRD(1); SBAR(); GAPA(C0=__builtin_amdgcn_mfma_f32_32x32x16_bf16(kf[2],qr[1],C0,0,0,0),   P0[10],P0[11],P0[12],P0[13], pw1[0]=PKW(P0,8), pw1[1]=PKW(P0,10), pw1); \
    VRD(5); SBAR(); GAPA(C1=__builtin_amdgcn_mfma_f32_32x32x16_bf16(kf[3],qr[1],C1,0,0,0),   P0[14],P0[15],P1[0],P1[1],   pw1[2]=PKW(P0,12),pw1[3]=PKW(P0,14), pw1); \
    VRD(2); SBAR(); GAPA(C0=__builtin_amdgcn_mfma_f32_32x32x16_bf16(kf[4],qr[2],C0,0,0,0),   P1[2],P1[3],P1[4],P1[5],     pw2[0]=PKW(P1,0), pw2[1]=PKW(P1,2), pw2); \
    VRD(6); SBAR(); GAPA(C1=__builtin_amdgcn_mfma_f32_32x32x16_bf16(kf[5],qr[2],C1,0,0,0),   P1[6],P1[7],P1[8],P1[9],     pw2[2]=PKW(P1,4), pw2[3]=PKW(P1,6), pw2); \
    VRD(3); SBAR(); GAPA(C0=__builtin_amdgcn_mfma_f32_32x32x16_bf16(kf[6],qr[3],C0,0,0,0),   P1[10],P1[11],P1[12],P1[13], pw3[0]=PKW(P1,8), pw3[1]=PKW(P1,10), pw3); \
    VRD(7); SBAR(); GAPA(C1=__builtin_amdgcn_mfma_f32_32x32x16_bf16(kf[7],qr[3],C1,0,0,0),   P1[14],P1[15],0.f,0.f,       pw3[2]=PKW(P1,12),pw3[3]=PKW(P1,14), pw3); \
    l_reg+=sacc; \
    if(GK){DMA_K((t)+3,sl_cur);} if(GV){DMA_V((t)+1,sl_next);} \
    CMASK(C0,C1,t); \
    { float a=MX3(C0[0],C0[1],C1[0]),b=MX3(C0[2],C0[3],C1[1]); a=MX3(a,C1[2],C1[3]); \
      _Pragma("unroll") for(int r=4;r<16;r+=4){a=MX3(a,C0[r],C0[r+1]);b=MX3(b,C0[r+2],C0[r+3]);a=MX3(a,C1[r],C1[r+1]);b=MX3(b,C1[r+2],C1[r+3]);} \
      float rm=__builtin_fmaxf(a,b); { auto rr=__builtin_amdgcn_permlane32_swap(__float_as_uint(rm),__float_as_uint(rm),false,false); rm=__builtin_fmaxf(__uint_as_float(rr[0]),__uint_as_float(rr[1])); } \
      resc=false; \
      if(__builtin_expect(__any(rm>(float)THRL),0)){ const float dl=__builtin_fmaxf(rm,0.f); mhat+=dl; \
        _Pragma("unroll") for(int r=0;r<16;++r){C0[r]-=dl;C1[r]-=dl;} \
        _Pragma("unroll") for(int r=0;r<16;++r)negm[r]=-mhat; asm volatile("":"+v"(negm)); \
        const float f=__builtin_amdgcn_exp2f(-dl); l_reg*=f; if(hi==0)wsf[r32]=f; resc=true; } } \
    SBAR(); \
    GAPB(o[0]=__builtin_amdgcn_mfma_f32_32x32x16_bf16(PAF(0),VFR(0),o[0],0,0,0), C0,0); \
    GAPB(o[1]=__builtin_amdgcn_mfma_f32_32x32x16_bf16(PAF(0),VFR(4),o[1],0,0,0), C0,4); \
    KRD(GL,0); GAPB(o[0]=__builtin_amdgcn_mfma_f32_32x32x16_bf16(PAF(1),VFR(1),o[0],0,0,0), C0,8); \
    KRD(GL,1); GAPB(o[1]=__builtin_amdgcn_mfma_f32_32x32x16_bf16(PAF(1),VFR(5),o[1],0,0,0), C0,12); \
    KRD(GL,2); GAPB(o[0]=__builtin_amdgcn_mfma_f32_32x32x16_bf16(PAF(2),VFR(2),o[0],0,0,0), C1,0); \
    KRD(GL,3); GAPB(o[1]=__builtin_amdgcn_mfma_f32_32x32x16_bf16(PAF(2),VFR(6),o[1],0,0,0), C1,4); \
    GAPB(o[0]=__builtin_amdgcn_mfma_f32_32x32x16_bf16(PAF(3),VFR(3),o[0],0,0,0), C1,8); \
    GAPB(o[1]=__builtin_amdgcn_mfma_f32_32x32x16_bf16(PAF(3),VFR(7),o[1],0,0,0), C1,12); \
    }while(0)
  int t=1;
  #undef CMASK
  #define CMASK(P0,P1,t) do{}while(0)
  for(;t+5<NT;t+=2){
    STEP(pB0,pB1,pA0,pA1,t,true,true,true);     WAIT_BAR(2); RESC(); ROT();
    STEP(pA0,pA1,pB0,pB1,t+1,true,true,true);   WAIT_BAR(2); RESC(); ROT();
  }
  #undef CMASK
  #define CMASK(P0,P1,t) do{int jb_=(t)-(NT-4); if(jb_>=0)cmask(P0,P1,jb_,qrel,hi);}while(0)
  #define ENDW(tt) do{ if((tt)+3<NT){WAIT_BAR(2);} else if((tt)+2<NT){WAIT_BAR(1);} else {WAIT_BAR(0);} }while(0)
  for(;t+1<NT;t+=2){
    STEP(pB0,pB1,pA0,pA1,t,(t+3<NT),(t+1<NT),(t+1<NT));       ENDW(t);   RESC(); ROT();
    STEP(pA0,pA1,pB0,pB1,t+1,(t+4<NT),(t+2<NT),(t+2<NT));     ENDW(t+1); RESC(); ROT();
  }
  STEP(pB0,pB1,pA0,pA1,NT-1,false,false,false); RESC();
  { float sacc=pB0[0]+pB0[1]; _Pragma("unroll") for(int r=2;r<16;++r)sacc+=pB0[r]; _Pragma("unroll") for(int r=0;r<16;++r)sacc+=pB1[r]; l_reg+=sacc;
    pw0=(u32x4){PKW(pB0,0),PKW(pB0,2),PKW(pB0,4),PKW(pB0,6)};pw1=(u32x4){PKW(pB0,8),PKW(pB0,10),PKW(pB0,12),PKW(pB0,14)};pw2=(u32x4){PKW(pB1,0),PKW(pB1,2),PKW(pB1,4),PKW(pB1,6)};pw3=(u32x4){PKW(pB1,8),PKW(pB1,10),PKW(pB1,12),PKW(pB1,14)};
    SBAR(); pv(o,vb0+sl_cur,PAF(0),PAF(1),PAF(2),PAF(3)); }
  #undef PKW
  #undef PAF
  #undef VFR
  #undef PIN
  #undef MX3
  #undef GAPA
  #undef GAPB
  #undef EX
  #undef VRD
  #undef KRD
  #undef STEP
  #undef ENDW
  {auto rr=__builtin_amdgcn_permlane32_swap(__float_as_uint(l_reg),__float_as_uint(l_reg),false,false);l_reg=__uint_as_float(rr[0])+__uint_as_float(rr[1]);}
  if(hi==0)wsf[32+r32]=l_reg;asm volatile("s_waitcnt lgkmcnt(0)":::"memory");
  float rli[16];
  #pragma unroll
  for(int r=0;r<16;++r)rli[r]=__builtin_amdgcn_rcpf(wsf[32+crow(r,hi)]);
  bf16*Ow=O+(rowbase+q0+wid*QBLK)*OP+h*D;
  { bf16*stg=(bf16*)(shm+LDS_OST)+wid*2048;
    #pragma unroll
    for(int r=0;r<16;++r){const int orow=crow(r,hi);
      #pragma unroll
      for(int d0=0;d0<2;++d0)stg[orow*64+d0*32+r32]=__float2bfloat16(o[d0][r]*rli[r]);}
    asm volatile("s_waitcnt lgkmcnt(0)":::"memory");
    #pragma unroll
    for(int i=0;i<4;++i){const int row=i*8+(lane>>3),ch=lane&7; const u32x4 v=*(const u32x4*)(stg+row*64+ch*8); ATTN_STORE16(Ow+(long)row*OP+ch*8,v);} }
  asm volatile("s_waitcnt lgkmcnt(0)\n\ts_barrier":::"memory");
  #undef DMA_K
  #undef DMA_V
  #undef CMASK
  #undef START
  #undef RESC
  #undef ROT
}
constexpr int ATTN_LDS_BYTES=LDS_BYTES;
#undef SBAR
#undef WAIT_BAR
}

#define GAS __attribute__((address_space(1)))
#define LAS __attribute__((address_space(3)))
typedef unsigned short bf16;
typedef unsigned v4u __attribute__((ext_vector_type(4)));
typedef unsigned v2u __attribute__((ext_vector_type(2)));
typedef float f32x4 __attribute__((ext_vector_type(4)));
typedef short bf16x8 __attribute__((ext_vector_type(8)));
typedef GAS unsigned gu32;
#define RLX_AGENT __ATOMIC_RELAXED, __HIP_MEMORY_SCOPE_AGENT
#define LDS_WAIT() asm volatile("s_waitcnt lgkmcnt(0)" ::: "memory")
#define VM_WAIT() asm volatile("s_waitcnt vmcnt(0)" ::: "memory")

#ifndef P1_HOSTS_P0B
#define P1_HOSTS_P0B 1
#endif
constexpr int NWAVES = 8;
constexpr int DM = 2048, NBATCH = 8, SEQ = 2048, M = NBATCH * SEQ;
constexpr int IN_COLS = 5648;
constexpr int NIN = 5632;
constexpr int NIN_G = 5888;
constexpr int UC_Z = 0, UC_XBC = 1024, UC_Q = 2560, UC_K = 3584, UC_V = 4608;
constexpr int NE = 32, EH = 1024;
constexpr float EPS = 1e-6f;
constexpr float F8_WSCALE = 64.f;
constexpr float Y8_SCALE = 16.f;
constexpr size_t MiB = 1u << 20;

constexpr int RING_OFF = 0, RING_BYTES = 131072;
constexpr int LDSCTL_OFF = 159744, MISC_OFF = LDSCTL_OFF + 320;
constexpr int LDS_BYTES = 163840;

namespace mp {
constexpr size_t ctl = 0, small = 1 * MiB, wr = 2 * MiB, rope = 3 * MiB, dt = 5 * MiB, win = 6 * MiB, wout = 30 * MiB, wgu = 38 * MiB, wd = 166 * MiB;
constexpr size_t xn = 230 * MiB, xn2 = 230 * MiB, ycat = 294 * MiB, u16 = 358 * MiB, qn = 534 * MiB, kn = 566 * MiB, xbc = 598 * MiB, o1 = 646 * MiB, o2 = 678 * MiB, ys = 710 * MiB;
constexpr size_t y = 358 * MiB, hid = 518 * MiB;
constexpr size_t lst = 742 * MiB;
constexpr size_t xn8 = 748 * MiB;
constexpr size_t END = 780 * MiB;
}
constexpr size_t CTL_ZERO_BYTES = 1 * MiB;
constexpr int CW_TMO = 0, CW_CODE = 1, CW_BAR = 4096;
constexpr int CW_Q0 = 66560;
constexpr int CW_LOC = 8192, CW_RANK = 10240;
constexpr int CW_CNT = 65536;
constexpr int LCAP = 16384;
constexpr int SLOT_CAP = 40960;
constexpr int TAB_OFF = LDSCTL_OFF + 1024;
constexpr size_t SM_TOK_E = 0, SM_TOK_POS = 131072, SM_TOK_W = 262144, SM_TOK_SLOT = 393216, SM_RINV = 524288, SM_SLOT_W = 655360, SM_SLOT_R = 851968, SM_END = 1048576;

__device__ __forceinline__ void st16_wt(void* p, v4u v) { asm volatile("global_store_dwordx4 %0, %1, off sc1\n\ts_nop 1" :: "v"(p), "v"(v) : "memory"); }
__device__ __forceinline__ unsigned f2bf(float f) { unsigned u = __builtin_bit_cast(unsigned, f); return (u + 0x7fffu + ((u >> 16) & 1u)) >> 16; }
typedef float f32x2_pk __attribute__((ext_vector_type(2))); typedef __bf16 bf16x2_pk __attribute__((ext_vector_type(2)));
__device__ __forceinline__ unsigned pk2(float lo, float hi) { f32x2_pk v = {lo, hi}; bf16x2_pk b = __builtin_convertvector(v, bf16x2_pk); return __builtin_bit_cast(unsigned, b); }
__device__ __forceinline__ float bf2f(unsigned short b) { return __builtin_bit_cast(float, (unsigned)b << 16); }
__device__ __forceinline__ float wave_sum(float v) {
#pragma unroll
    for (int o = 1; o < 64; o <<= 1) v += __shfl_xor(v, o);
    return v;
}

#define XB_TMO      128
#define XB_XCNT(j)  (256  + 64 * (j))
#define XB_XSUB(j)  (1280 + 64 * (j))
#define XB_XGEN(j)  (2304 + 64 * (j))
#define XB_TOP      3328
#define XB_TOPGEN   3392
#define XCD_BAR_WORDS 3456
#define XB_SPIN_CAP (1u << 18)

__device__ __forceinline__ unsigned xb_ld(unsigned* p)              { return __hip_atomic_load(p, __ATOMIC_RELAXED, __HIP_MEMORY_SCOPE_AGENT); }
__device__ __forceinline__ unsigned xb_add(unsigned* p, unsigned v) { return __hip_atomic_fetch_add(p, v, __ATOMIC_RELAXED, __HIP_MEMORY_SCOPE_AGENT); }
__device__ __forceinline__ unsigned xb_xcc_id() { return (unsigned)__builtin_amdgcn_s_getreg((3 << 11) | 20) & 0xFu; }
#define XB_SPIN(cond, bar) do { unsigned _sp = 0; while (cond) { __builtin_amdgcn_s_sleep(1); \
    if ((++_sp & 255u) == 0u) { if (xb_ld(&(bar)[XB_TMO])) break; if (_sp > XB_SPIN_CAP) { atomicAdd(&(bar)[XB_TMO], 1u); break; } } } } while (0)

struct XcdBarrier {
    unsigned* bar; unsigned x;
    volatile LAS unsigned* st;
};

__device__ __forceinline__ XcdBarrier xcd_barrier_post(unsigned* bar, volatile LAS unsigned* st) {
    XcdBarrier b; b.bar = bar; b.x = xb_xcc_id(); b.st = st;
    if (threadIdx.x == 0) (void)xb_add(&bar[XB_XCNT(b.x)], 1u);
    return b;
}
__device__ __forceinline__ void xcd_barrier_complete(unsigned* bar, unsigned x, unsigned& nloc, unsigned& nx) {
    const unsigned G = gridDim.x * gridDim.y * gridDim.z;
    unsigned sum, cnt, mine, sp = 0u;
    for (;;) {
        sum = 0u; cnt = 0u; mine = 0u;
#pragma unroll
        for (unsigned j = 0; j < 16; ++j) { const unsigned c = xb_ld(&bar[XB_XCNT(j)]); sum += c; cnt += (c > 0u) ? 1u : 0u; mine = (j == x) ? c : mine; }
        if (sum == G) break;
        __builtin_amdgcn_s_sleep(1);
        if ((++sp & 255u) == 0u) { if (xb_ld(&bar[XB_TMO])) break; if (sp > XB_SPIN_CAP) { atomicAdd(&bar[XB_TMO], 1u); break; } }
    }
    nloc = mine > 0u ? mine : 1u; nx = cnt > 0u ? cnt : 1u;
}

__device__ __forceinline__ void xcd_barrier(const XcdBarrier& b) {
    asm volatile("s_waitcnt vmcnt(0)" ::: "memory");
    __syncthreads();
    if (threadIdx.x == 0) {
        unsigned* bar = b.bar;
        __builtin_amdgcn_s_waitcnt(0);
        unsigned nloc = b.st[0], nx = b.st[1];
        if (nloc == 0u) { xcd_barrier_complete(bar, b.x, nloc, nx); b.st[0] = nloc; b.st[1] = nx; }
        const unsigned old = xb_add(&bar[XB_XSUB(b.x)], 1u);
        const unsigned gen = old / nloc;
        if (old + 1u == (gen + 1u) * nloc) {
            __builtin_amdgcn_fence(__ATOMIC_RELEASE, "agent");
            asm volatile("s_waitcnt vmcnt(0)" ::: "memory");
            const unsigned og = xb_add(&bar[XB_TOP], 1u);
            const unsigned tg = og / nx;
            if (og + 1u == (tg + 1u) * nx) xb_add(&bar[XB_TOPGEN], 1u);
            else XB_SPIN(xb_ld(&bar[XB_TOPGEN]) == tg, bar);
            __builtin_amdgcn_fence(__ATOMIC_ACQUIRE, "agent");
            xb_add(&bar[XB_XGEN(b.x)], 1u);
            asm volatile("s_waitcnt vmcnt(0)" ::: "memory");
        } else {
            XB_SPIN(xb_ld(&bar[XB_XGEN(b.x)]) == gen, bar);
            __builtin_amdgcn_fence(__ATOMIC_ACQUIRE, "agent");
            asm volatile("s_waitcnt vmcnt(0)" ::: "memory");
        }
    }
    __syncthreads();
}

__device__ __forceinline__ void xcd_local_barrier(unsigned* bar, unsigned* ctr, unsigned n) {
    asm volatile("s_waitcnt vmcnt(0)" ::: "memory");
    __syncthreads();
    if (threadIdx.x == 0) {
        __builtin_amdgcn_s_waitcnt(0);
        const unsigned old = xb_add(ctr, 1u), target = (old / n + 1u) * n;
        XB_SPIN(xb_ld(ctr) < target, bar);
        __builtin_amdgcn_fence(__ATOMIC_ACQUIRE, "agent");
        asm volatile("s_waitcnt vmcnt(0)" ::: "memory");
    }
    __syncthreads();
}

struct Frame {
    LAS unsigned char* lds;
    volatile LAS unsigned* MISC;
    gu32* ctl;
    int tid, lane, wave;
    int vcu, G;
    int cid;
    unsigned char* ws;
};

struct TItem { const float* W; bf16* base; const float* kscale; int ldw, nvalid, k0, n0, kind, pitch, f8; };
constexpr int TI_PC = 36, TI_P1 = 8 * TI_PC, TI_BYTES = 16 * TI_P1 * 4;
template <int NI> __device__ __forceinline__ void titem_issue(const TItem& d, int lane, f32x4 (&ld)[NI]) {
    const int nq = d.n0 + 4 * (lane & 7); const bool ok = nq < d.nvalid;
#pragma unroll
    for (int i = 0; i < NI; ++i) ld[i] = ok ? __builtin_nontemporal_load((const GAS f32x4*)(d.W + (size_t)(d.k0 + (lane >> 3) + 8 * i) * d.ldw + nq)) : (f32x4){0.f, 0.f, 0.f, 0.f};
}
template <int NI> __device__ __forceinline__ void titem_finish(const TItem& d, int lane, const f32x4 (&ld)[NI], LAS float* scr, bf16* WIN, bf16* WDT) {
#pragma unroll
    for (int i = 0; i < NI; ++i) { const int k = (lane >> 3) + 8 * i; *(LAS f32x4*)(scr + (k % NI) * TI_P1 + (k / NI) * TI_PC + 4 * (lane & 7)) = ld[i]; }
    LDS_WAIT(); asm volatile("" ::: "memory");
    const int c = lane & 7;
    if constexpr (NI == 16) {
#pragma unroll
        for (int j = 0; j < 4; ++j) { const int nl = (lane >> 3) + 8 * j, n = d.n0 + nl; const LAS float* s = scr + c * TI_PC + nl;
            const size_t rowi = d.kind == 3 ? (size_t)((n & ~255) + ((n >> 3) & 1) * 128 + ((n >> 6) & 3) * 32 + ((n >> 4) & 3) * 8 + (n & 7))
                                            : (size_t)((n >> 7) * 256 + (n & 127));
            v4u q; q.x = pg8::cvt4_fp8(s[0 * TI_P1] * F8_WSCALE, s[1 * TI_P1] * F8_WSCALE, s[2 * TI_P1] * F8_WSCALE, s[3 * TI_P1] * F8_WSCALE); q.y = pg8::cvt4_fp8(s[4 * TI_P1] * F8_WSCALE, s[5 * TI_P1] * F8_WSCALE, s[6 * TI_P1] * F8_WSCALE, s[7 * TI_P1] * F8_WSCALE);
            q.z = pg8::cvt4_fp8(s[8 * TI_P1] * F8_WSCALE, s[9 * TI_P1] * F8_WSCALE, s[10 * TI_P1] * F8_WSCALE, s[11 * TI_P1] * F8_WSCALE); q.w = pg8::cvt4_fp8(s[12 * TI_P1] * F8_WSCALE, s[13 * TI_P1] * F8_WSCALE, s[14 * TI_P1] * F8_WSCALE, s[15 * TI_P1] * F8_WSCALE);
            if (n < d.nvalid) __builtin_nontemporal_store(q, (GAS v4u*)((unsigned char*)d.base + rowi * d.pitch + d.k0 + 16 * c)); }
    } else {
#pragma unroll
        for (int j = 0; j < 4; ++j) { const int nl = (lane >> 3) + 8 * j, n = d.n0 + nl; const LAS float* s = scr + c * TI_PC + nl;
            v4u o; o.x = pk2(s[0 * TI_P1], s[1 * TI_P1]); o.y = pk2(s[2 * TI_P1], s[3 * TI_P1]); o.z = pk2(s[4 * TI_P1], s[5 * TI_P1]); o.w = pk2(s[6 * TI_P1], s[7 * TI_P1]);
            bf16* row;
            if (d.kind == 0) row = n < 2560 ? WIN + (size_t)n * DM : (n < 2576 ? WIN + (size_t)(NIN + n - 2560) * DM : WIN + (size_t)(n - 16) * DM);
            else row = d.base + (size_t)n * d.pitch;
            if (n < d.nvalid) *(GAS v4u*)(row + d.k0 + 8 * c) = o; }
    }
    LDS_WAIT(); asm volatile("" ::: "memory");
}

struct Args { const void* in[26]; float* out; unsigned char* ws; int ph_lo, ph_hi, li, p0_mask, rep_phase, pad; };
typedef const __attribute__((address_space(4))) Args* KA;

constexpr int P0B_NBLK = 3 * NE * 128, P0B_NSUB = 4 * P0B_NBLK;
__device__ __forceinline__ void p0b_blocks(Frame& F, KA args, int first, int nq, int gstride = 1) {
    const int lane = F.lane;
    const float* w_gate = (const float*)args->in[23]; const float* w_up = (const float*)args->in[24]; const float* w_down = (const float*)args->in[25];
    bf16* WGU = (bf16*)(F.ws + mp::wgu); bf16* WD = (bf16*)(F.ws + mp::wd);
    LAS float* scr = (LAS float*)(F.lds + F.wave * TI_BYTES);
    auto decodeB = [&](int q) -> TItem {
        const int g = first + q * gstride, cb = g >> 2, i = g & 3;
        if (cb < 8192) { const int up = cb >> 12, r = cb & 4095, e = r >> 7, kb = (r >> 3) & 15, nb = r & 7;
            return TItem{(up ? w_up : w_gate) + (size_t)e * DM * EH, (bf16*)((unsigned char*)WGU + (size_t)e * 2048 * DM + (up ? (size_t)128 * DM : 0)), nullptr, EH, EH, 128 * kb, 128 * nb + 32 * i, 2, DM, 1}; }
        const int r = cb - 8192, e = r >> 7, kb = (r >> 4) & 7, nb = r & 15;
        return TItem{w_down + (size_t)e * EH * DM, (bf16*)((unsigned char*)WD + (size_t)e * DM * EH), nullptr, DM, DM, 128 * kb, 128 * nb + 32 * i, 3, EH, 1};
    };
    if (nq <= 0) return;
    TItem d0 = decodeB(0), d1 = d0, d2 = d0; f32x4 l0[16], l1[16], l2[16];
    titem_issue<16>(d0, lane, l0);
    if (nq > 1) { d1 = decodeB(1); titem_issue<16>(d1, lane, l1); }
    for (int q = 0; q < nq; q += 3) {
        if (q + 2 < nq) { d2 = decodeB(q + 2); titem_issue<16>(d2, lane, l2); }
        titem_finish<16>(d0, lane, l0, scr, nullptr, nullptr);
        if (q + 1 >= nq) break;
        if (q + 3 < nq) { d0 = decodeB(q + 3); titem_issue<16>(d0, lane, l0); }
        titem_finish<16>(d1, lane, l1, scr, nullptr, nullptr);
        if (q + 2 >= nq) break;
        if (q + 4 < nq) { d1 = decodeB(q + 4); titem_issue<16>(d1, lane, l1); }
        titem_finish<16>(d2, lane, l2, scr, nullptr, nullptr);
    }
}
constexpr int P1_UNITS = (M / 256) * (NIN_G / 256);
#if P1_HOSTS_P0B == 2
constexpr int P1_INLOOP_BLOCKS = P1_UNITS * NWAVES;
static_assert(P0B_NBLK - P1_INLOOP_BLOCKS == 64 * NWAVES, "the 64 CUs with one GEMM unit less take one more block per wave");
#endif
#ifndef P1_NCLASS
#define P1_NCLASS 4
#endif
__device__ __forceinline__ void p1_convert_share(Frame& F, KA args, int part) {
    const int c = F.cid, xcd = c & 7, l = c >> 3, lclass = xcd % P1_NCLASS;
    const int ex = l < 24 ? 0 : 12, q = 21 + ex;
    const int base = xcd * (P0B_NSUB / 8);
    const int first = l < 24 ? base + l * (NWAVES * 21) : base + 24 * NWAVES * 21 + (l - 24) * (NWAVES * 33);
    int lo, hi;
    if (part == 0) { lo = 0; hi = lclass == 0 ? q : ex; } else if (part == lclass) { lo = ex; hi = q; } else return;
    p0b_blocks(F, args, first + F.wave * q + lo, hi - lo);
}

__device__ __forceinline__ void p0_prologue(Frame& F, KA args) {
    const int gw = F.vcu * NWAVES + F.wave, NGW = F.G * NWAVES, lane = F.lane;
    const float* w_in = (const float*)args->in[3]; const float* w_out = (const float*)args->in[17];
    bf16* WIN = (bf16*)(F.ws + mp::win); bf16* WDT = nullptr; bf16* WOUT = (bf16*)(F.ws + mp::wout);
    constexpr int NB_IN = (IN_COLS + 31) / 32;
    constexpr int I_IN = (DM / 64) * NB_IN, I_OUT = (DM / 64) * (DM / 32), NITEMS_A = I_IN + I_OUT;
    LAS float* scr = (LAS float*)(F.lds + F.wave * TI_BYTES);
    auto decodeA = [&](int it) -> TItem {
        int r = it;
        if (r < I_IN) { const int kb = r / NB_IN, nb = r % NB_IN; return TItem{w_in, WIN, nullptr, IN_COLS, IN_COLS, 64 * kb, 32 * nb, 0, DM, 0}; }
        r -= I_IN; const int kb = r / (DM / 32), nb = r % (DM / 32); return TItem{w_out, WOUT, nullptr, DM, DM, 64 * kb, 32 * nb, 1, DM, 0};
    };
    if (gw < NITEMS_A) {
        TItem dc = decodeA(gw); f32x4 la[8], lb[8];
        titem_issue<8>(dc, lane, la);
        for (int it = gw; it < NITEMS_A; it += NGW) {
            const int nx = it + NGW; TItem dn = dc;
            if (nx < NITEMS_A) { dn = decodeA(nx); titem_issue<8>(dn, lane, lb); }
            titem_finish<8>(dc, lane, la, scr, WIN, WDT);
            dc = dn;
#pragma unroll
            for (int i = 0; i < 8; ++i) la[i] = lb[i];
        }
    }
#if !P1_HOSTS_P0B
    p0b_blocks(F, args, gw * (P0B_NSUB / NGW), P0B_NSUB / NGW);
#endif
    const float* x = (const float*)args->in[0]; const float* ln1 = (const float*)args->in[2]; bf16* XN = (bf16*)(F.ws + mp::xn);
    for (int m0 = gw * 2; m0 < M; m0 += NGW * 2) {
        f32x4 v[2][8];
#pragma unroll
        for (int rr = 0; rr < 2; ++rr)
#pragma unroll
            for (int j = 0; j < 8; ++j) v[rr][j] = __builtin_nontemporal_load((const GAS f32x4*)(x + (size_t)(m0 + rr) * DM) + lane + 64 * j);
#pragma unroll
        for (int rr = 0; rr < 2; ++rr) { float s = 0.f;
#pragma unroll
            for (int j = 0; j < 8; ++j) s += (v[rr][j].x * v[rr][j].x + v[rr][j].y * v[rr][j].y) + (v[rr][j].z * v[rr][j].z + v[rr][j].w * v[rr][j].w);
            const float r = 1.0f / sqrtf(wave_sum(s) * (1.f / DM) + EPS);
            GAS v2u* o8 = (GAS v2u*)(XN + (size_t)(m0 + rr) * DM) + lane; const GAS f32x4* wr = (const GAS f32x4*)ln1 + lane;
#pragma unroll
            for (int j = 0; j < 8; ++j) { const f32x4 ww = wr[64 * j]; v2u o; o.x = pk2(v[rr][j].x * r * ww.x, v[rr][j].y * r * ww.y); o.y = pk2(v[rr][j].z * r * ww.z, v[rr][j].w * r * ww.w); o8[64 * j] = o; } }
    }
}


__device__ __forceinline__ void p0_rope(Frame& F, KA args) {
    const int gt = (F.vcu * NWAVES + F.wave) * 64 + F.lane, NGT = F.G * NWAVES * 64;
    const int* pos = (const int*)args->in[1]; float* rope = (float*)(F.ws + mp::rope);
    for (int i = gt; i < M * 8; i += NGT) { const int m = i >> 3, j = i & 7;
        const float inv_freq = powf(500000.0f, -(float)(2 * j) / 16.0f);
        const float ang = (float)pos[m] * inv_freq;
        rope[m * 16 + j] = cosf(ang); rope[m * 16 + 8 + j] = sinf(ang); }
}

__device__ __forceinline__ void p2_qknorm(Frame& F, KA args) {
    const int gw = F.vcu * NWAVES + F.wave, NGW = F.G * NWAVES, lane = F.lane;
    const bf16* U16 = (const bf16*)(F.ws + mp::u16); const float* rope = (const float*)(F.ws + mp::rope);
    bf16* QN = (bf16*)(F.ws + mp::qn); bf16* KN = (bf16*)(F.ws + mp::kn);
    const float* qw = (const float*)args->in[10]; const float* kw = (const float*)args->in[11];
    const int sub = lane & 7;
    float wq[8], wk[8];
#pragma unroll
    for (int j = 0; j < 8; ++j) { wq[j] = qw[sub * 8 + j] * attn_body::C2; wk[j] = kw[sub * 8 + j]; }
    for (int it = 0; it < 2; ++it) { const int m0 = (F.vcu >> 5) * 2048 + it * 1024 + ((F.vcu & 31) * NWAVES + F.wave) * 4;
        v4u raw[4][4]; f32x4 rp[4][4];
#pragma unroll
        for (int rr = 0; rr < 4; ++rr) {
#pragma unroll
            for (int pc = 0; pc < 4; ++pc) raw[rr][pc] = __builtin_nontemporal_load((const GAS v4u*)(U16 + (size_t)(m0 + rr) * NIN + ((pc >> 1) ? UC_K : UC_Q) + (pc & 1) * 512 + lane * 8));
#pragma unroll
            for (int q = 0; q < 4; ++q) rp[rr][q] = *(const GAS f32x4*)(rope + (size_t)(m0 + rr) * 16 + 4 * q);
        }
#pragma unroll
        for (int rr = 0; rr < 4; ++rr) {
            const int m = m0 + rr;
            const float cs[8] = {rp[rr][0].x, rp[rr][0].y, rp[rr][0].z, rp[rr][0].w, rp[rr][1].x, rp[rr][1].y, rp[rr][1].z, rp[rr][1].w};
            const float sn[8] = {rp[rr][2].x, rp[rr][2].y, rp[rr][2].z, rp[rr][2].w, rp[rr][3].x, rp[rr][3].y, rp[rr][3].z, rp[rr][3].w};
#pragma unroll
            for (int pc = 0; pc < 4; ++pc) {
                const int isk = pc >> 1, col = (pc & 1) * 512 + lane * 8;
                const v4u rw = raw[rr][pc];
                float v[8];
                v[0] = __builtin_bit_cast(float, rw.x << 16); v[1] = __builtin_bit_cast(float, rw.x & 0xffff0000u); v[2] = __builtin_bit_cast(float, rw.y << 16); v[3] = __builtin_bit_cast(float, rw.y & 0xffff0000u);
                v[4] = __builtin_bit_cast(float, rw.z << 16); v[5] = __builtin_bit_cast(float, rw.z & 0xffff0000u); v[6] = __builtin_bit_cast(float, rw.w << 16); v[7] = __builtin_bit_cast(float, rw.w & 0xffff0000u);
                float ss = 0.f;
#pragma unroll
                for (int j = 0; j < 8; ++j) ss += v[j] * v[j];
                ss += __shfl_xor(ss, 1); ss += __shfl_xor(ss, 2); ss += __shfl_xor(ss, 4);
                const float r = 1.0f / sqrtf(ss * (1.f / 64.f) + EPS);
                float y[8];
#pragma unroll
                for (int j = 0; j < 8; ++j) y[j] = v[j] * r * (isk ? wk[j] : wq[j]);
#pragma unroll
                for (int j = 0; j < 8; ++j) { const float pv = __shfl_xor(y[j], 1);
                    if (sub == 0) y[j] = y[j] * cs[j] - pv * sn[j]; else if (sub == 1) y[j] = y[j] * cs[j] + pv * sn[j]; }
                v4u o; o.x = pk2(y[0], y[1]); o.y = pk2(y[2], y[3]); o.z = pk2(y[4], y[5]); o.w = pk2(y[6], y[7]);
                *(GAS v4u*)((isk ? KN : QN) + (size_t)m * 1024 + col) = o;
            }
        }
    }
}

struct AttnOrder { int vcu;
  __device__ __forceinline__ bool next(int i, int& bh, int& qb) const { if (i >= 8) return false; const int s = vcu & 7; bh = vcu; qb = (i + s) & 7; return true; } };
__device__ __forceinline__ void p3_attention(Frame& F, KA args, unsigned char* lds_generic) {
    const attn_body::bf16* QN = (const attn_body::bf16*)(F.ws + mp::qn); const attn_body::bf16* KN = (const attn_body::bf16*)(F.ws + mp::kn);
    const attn_body::bf16* U16 = (const attn_body::bf16*)(F.ws + mp::u16); attn_body::bf16* O1 = (attn_body::bf16*)(F.ws + mp::o1); attn_body::bf16* O2 = (attn_body::bf16*)(F.ws + mp::o2);
    AttnOrder S{F.vcu}; int bh, qb;
    for (int i = 0; S.next(i, bh, qb); ++i) {
        const int b = bh >> 5, h = (bh >> 2) & 7, comp = (bh >> 1) & 1, vh = bh & 1;
        attn_body::attn_unit<8>(b, 0, qb, QN + (h * 2 + comp) * 64, KN + (h * 2 + comp) * 64, U16 + UC_V + h * 128 + vh * 64, (comp ? O2 : O1) + h * 128 + vh * 64, (char*)lds_generic + RING_OFF);
    }
}

__device__ __forceinline__ void p4_ycat(Frame& F, KA args, int parts) {
    const int gw = F.vcu * NWAVES + F.wave, NGW = F.G * NWAVES, lane = F.lane;
    const bf16* U16 = (const bf16*)(F.ws + mp::u16); const bf16* YS = (const bf16*)(F.ws + mp::ys);
    const bf16* O1 = (const bf16*)(F.ws + mp::o1); const bf16* O2 = (const bf16*)(F.ws + mp::o2); bf16* YCAT = (bf16*)(F.ws + mp::ycat);
    const float* nw = (const float*)args->in[9]; const float* subw = (const float*)args->in[16];
    float lam;
    { const float* lq1 = (const float*)args->in[12]; const float* lk1 = (const float*)args->in[13]; const float* lq2 = (const float*)args->in[14]; const float* lk2 = (const float*)args->in[15];
      const float s1 = wave_sum(lq1[lane] * lk1[lane]), s2 = wave_sum(lq2[lane] * lk2[lane]); lam = expf(s1) - expf(s2) + 0.2f; }
    float w_s[2][8], w_a[8];
#pragma unroll
    for (int j = 0; j < 8; ++j) { w_s[0][j] = nw[lane * 8 + j]; w_s[1][j] = nw[512 + lane * 8 + j]; w_a[j] = subw[(lane & 15) * 8 + j] * 0.8f; }
    for (int it = 0; it < 4; ++it) { const int m0 = (F.vcu >> 5) * 2048 + it * 512 + ((F.vcu & 31) * NWAVES + F.wave) * 2;
        v4u yv[2][2], zv[2][2], av[2][2], bv[2][2];
#pragma unroll
        for (int rr = 0; rr < 2; ++rr) { const size_t m = (size_t)(m0 + rr);
#pragma unroll
            for (int sl = 0; sl < 2; ++sl) {
                if (parts & 1) { yv[rr][sl] = __builtin_nontemporal_load((const GAS v4u*)(YS + m * 1024 + 512 * sl + lane * 8)); zv[rr][sl] = __builtin_nontemporal_load((const GAS v4u*)(U16 + m * NIN + UC_Z + 512 * sl + lane * 8)); }
                if (parts & 2) { av[rr][sl] = __builtin_nontemporal_load((const GAS v4u*)(O1 + m * 1024 + 512 * sl + lane * 8)); bv[rr][sl] = __builtin_nontemporal_load((const GAS v4u*)(O2 + m * 1024 + 512 * sl + lane * 8)); } } }
#pragma unroll
        for (int rr = 0; rr < 2; ++rr) { const size_t m = (size_t)(m0 + rr);
#pragma unroll
        for (int sl = 0; sl < 2; ++sl) {
        if (parts & 1) {
            const v4u y0 = yv[rr][sl], z0 = zv[rr][sl];
            const unsigned yy[4] = {y0.x, y0.y, y0.z, y0.w}, zz[4] = {z0.x, z0.y, z0.z, z0.w};
            float v[8]; float ss = 0.f;
#pragma unroll
            for (int j = 0; j < 4; ++j) { const float ya = __builtin_bit_cast(float, yy[j] << 16), yb = __builtin_bit_cast(float, yy[j] & 0xffff0000u), za = __builtin_bit_cast(float, zz[j] << 16), zb = __builtin_bit_cast(float, zz[j] & 0xffff0000u);
                v[2 * j] = ya * za / (1.f + __expf(-za)); v[2 * j + 1] = yb * zb / (1.f + __expf(-zb)); ss += v[2 * j] * v[2 * j] + v[2 * j + 1] * v[2 * j + 1]; }
            ss = wave_sum(ss);
            const float r = 1.0f / sqrtf(ss * (1.f / 512.f) + EPS);
            v4u o0; o0.x = pk2(v[0] * r * w_s[sl][0], v[1] * r * w_s[sl][1]); o0.y = pk2(v[2] * r * w_s[sl][2], v[3] * r * w_s[sl][3]); o0.z = pk2(v[4] * r * w_s[sl][4], v[5] * r * w_s[sl][5]); o0.w = pk2(v[6] * r * w_s[sl][6], v[7] * r * w_s[sl][7]);
            *(GAS v4u*)(YCAT + m * DM + 512 * sl + lane * 8) = o0;
        }
        if (parts & 2) {
            const v4u a0 = av[rr][sl], b0 = bv[rr][sl];
            const unsigned aa[4] = {a0.x, a0.y, a0.z, a0.w}, bb[4] = {b0.x, b0.y, b0.z, b0.w};
            float v[8]; float ss = 0.f;
#pragma unroll
            for (int j = 0; j < 4; ++j) { v[2 * j] = __builtin_bit_cast(float, aa[j] << 16) - lam * __builtin_bit_cast(float, bb[j] << 16); v[2 * j + 1] = __builtin_bit_cast(float, aa[j] & 0xffff0000u) - lam * __builtin_bit_cast(float, bb[j] & 0xffff0000u);
                ss += v[2 * j] * v[2 * j] + v[2 * j + 1] * v[2 * j + 1]; }
            ss += __shfl_xor(ss, 1); ss += __shfl_xor(ss, 2); ss += __shfl_xor(ss, 4); ss += __shfl_xor(ss, 8);
            const float r = 1.0f / sqrtf(ss * (1.f / 128.f) + EPS);
            v4u o0; o0.x = pk2(v[0] * r * w_a[0], v[1] * r * w_a[1]); o0.y = pk2(v[2] * r * w_a[2], v[3] * r * w_a[3]); o0.z = pk2(v[4] * r * w_a[4], v[5] * r * w_a[5]); o0.w = pk2(v[6] * r * w_a[6], v[7] * r * w_a[7]);
            *(GAS v4u*)(YCAT + m * DM + 1024 + 512 * sl + lane * 8) = o0;
        }
        }
        }
    }
}

constexpr int CONV_R = 8;
__device__ __forceinline__ void p2_conv(Frame& F, KA args) {
    const int gw = F.vcu * NWAVES + F.wave, NGW = F.G * NWAVES, lane = F.lane;
    const bf16* U16 = (const bf16*)(F.ws + mp::u16); bf16* XBC = (bf16*)(F.ws + mp::xbc);
    const float* cw = (const float*)args->in[4]; const float* cb = (const float*)args->in[5];
    for (int it = 0; it < 3; ++it) { const int task = (F.vcu & 31) * NWAVES + F.wave + 256 * it;
        const int cblk = task % 3, r0 = (F.vcu >> 5) * 2048 + (task / 3) * CONV_R, c0 = cblk * 512 + lane * 8;
        const bool seq_start = (r0 % SEQ) == 0;
        v4u raw[CONV_R + 3];
#pragma unroll
        for (int j = 0; j < CONV_R + 3; ++j) { raw[j] = (v4u){0u, 0u, 0u, 0u}; if (j >= 3 || !seq_start) raw[j] = __builtin_nontemporal_load((const GAS v4u*)(U16 + (size_t)(r0 - 3 + j) * NIN + UC_XBC + c0)); }
        float w[4][8], bias[8];
#pragma unroll
        for (int j = 0; j < 4; ++j)
#pragma unroll
            for (int i = 0; i < 8; ++i) w[j][i] = cw[j * 1536 + c0 + i];
#pragma unroll
        for (int i = 0; i < 8; ++i) bias[i] = cb[c0 + i];
#pragma unroll
        for (int t = 0; t < CONV_R; ++t) {
            float o[8];
#pragma unroll
            for (int i = 0; i < 8; ++i) o[i] = bias[i];
#pragma unroll
            for (int j = 0; j < 4; ++j) { const v4u rw = raw[t + j];
                const float e[8] = {__builtin_bit_cast(float, rw.x << 16), __builtin_bit_cast(float, rw.x & 0xffff0000u), __builtin_bit_cast(float, rw.y << 16), __builtin_bit_cast(float, rw.y & 0xffff0000u),
                                    __builtin_bit_cast(float, rw.z << 16), __builtin_bit_cast(float, rw.z & 0xffff0000u), __builtin_bit_cast(float, rw.w << 16), __builtin_bit_cast(float, rw.w & 0xffff0000u)};
#pragma unroll
                for (int i = 0; i < 8; ++i) o[i] += w[j][i] * e[i]; }
#pragma unroll
            for (int i = 0; i < 8; ++i) o[i] = o[i] / (1.f + __expf(-o[i]));
            v4u ov; ov.x = pk2(o[0], o[1]); ov.y = pk2(o[2], o[3]); ov.z = pk2(o[4], o[5]); ov.w = pk2(o[6], o[7]);
            *(GAS v4u*)(XBC + (size_t)(r0 + t) * 1536 + c0) = ov;
        }
    }
}

namespace ssd {
constexpr int BCS = 2064;
constexpr int LB = 0, LC = LB + 16 * BCS, LX = LC + 16 * BCS, LXW = LX + 8192, LST = LXW + 8192, STB = 8704, LA = LST + 2 * STB, LSL = LA + 4096, SSD_LDS_END = LSL + 10 * 4096;
static_assert(SSD_LDS_END <= LDSCTL_OFF, "SSD tiles vs LDS control words");
typedef float f32x16 __attribute__((ext_vector_type(16)));
#define SSD_PIN8(a) asm volatile("" : "+v"(a[0]), "+v"(a[1]), "+v"(a[2]), "+v"(a[3]), "+v"(a[4]), "+v"(a[5]), "+v"(a[6]), "+v"(a[7]))
#define SSD_PIN4(a) asm volatile("" : "+v"(a[0]), "+v"(a[1]), "+v"(a[2]), "+v"(a[3]))
struct Ctx { LAS unsigned char* lds; const LAS float* a2; const LAS float* dtl; const LAS float* fsl; int lane, r32, hi; };
__device__ __forceinline__ void load_cf(const Ctx& c, int lb, bf16x8 (&cf)[8]) {
#pragma unroll
    for (int ks = 0; ks < 8; ++ks) cf[ks] = *(const LAS bf16x8*)(c.lds + LC + (2 * ks + c.hi) * BCS + (32 * lb + c.r32) * 16);
    SSD_PIN8(cf);
}
template <bool DIAG> __device__ __forceinline__ void intra(const Ctx& c, int lb, int st, const bf16x8 (&cf)[8], f32x16& y) {
    bf16x8 bq[8];
#pragma unroll
    for (int ks = 0; ks < 8; ++ks) bq[ks] = *(const LAS bf16x8*)(c.lds + LB + (2 * ks + c.hi) * BCS + (32 * st + c.r32) * 16);
    f32x4 av[4], dv[4];
#pragma unroll
    for (int q = 0; q < 4; ++q) { av[q] = *(const LAS f32x4*)((DIAG ? c.a2 : c.fsl) + 32 * st + 8 * q + 4 * c.hi); if (DIAG) dv[q] = *(const LAS f32x4*)(c.dtl + 32 * st + 8 * q + 4 * c.hi); }
    const float al = c.a2[32 * lb + c.r32], aref = c.a2[32 * st + 31];
    SSD_PIN8(bq); SSD_PIN4(av); if (DIAG) SSD_PIN4(dv);
    f32x16 p;
#pragma unroll
    for (int r = 0; r < 16; ++r) p[r] = 0.f;
#pragma unroll
    for (int ks = 0; ks < 8; ++ks) p = __builtin_amdgcn_mfma_f32_32x32x16_bf16(bq[ks], cf[ks], p, 0, 0, 0);
    if (DIAG) {
        float e[16];
#pragma unroll
        for (int r = 0; r < 16; ++r) e[r] = __builtin_amdgcn_exp2f(fminf(al - av[r >> 2][r & 3], 0.f));
#pragma unroll
        for (int r = 0; r < 16; ++r) { const int sl = attn_body::crow(r, c.hi); const float v = p[r] * e[r] * dv[r >> 2][r & 3]; p[r] = sl > c.r32 ? 0.f : v; }
    } else {
        const float el = __builtin_amdgcn_exp2f(al - aref);
#pragma unroll
        for (int r = 0; r < 16; ++r) p[r] *= el * av[r >> 2][r & 3];
    }
    v4u pw0, pw1;
    pw0.x = attn_body::cvtpk_s(p[0], p[1]); pw0.y = attn_body::cvtpk_s(p[2], p[3]); pw0.z = attn_body::cvtpk_s(p[4], p[5]); pw0.w = attn_body::cvtpk_s(p[6], p[7]);
    pw1.x = attn_body::cvtpk_s(p[8], p[9]); pw1.y = attn_body::cvtpk_s(p[10], p[11]); pw1.z = attn_body::cvtpk_s(p[12], p[13]); pw1.w = attn_body::cvtpk_s(p[14], p[15]);
    const LAS unsigned char* xb = c.lds + LX + ((c.lane >> 4) & 1) * 32 + (c.lane & 3) * 8 + (4 * c.hi + ((c.lane & 15) >> 2)) * 64 + (32 * st) * 64;
    const attn_body::s16x4 lo0 = attn_body::vtr((attn_body::lds_cptr)(xb)), hh0 = attn_body::vtr((attn_body::lds_cptr)(xb + 512));
    const attn_body::s16x4 lo1 = attn_body::vtr((attn_body::lds_cptr)(xb + 1024)), hh1 = attn_body::vtr((attn_body::lds_cptr)(xb + 1024 + 512));
    y = __builtin_amdgcn_mfma_f32_32x32x16_bf16(__builtin_bit_cast(bf16x8, pw0), (bf16x8){lo0[0], lo0[1], lo0[2], lo0[3], hh0[0], hh0[1], hh0[2], hh0[3]}, y, 0, 0, 0);
    y = __builtin_amdgcn_mfma_f32_32x32x16_bf16(__builtin_bit_cast(bf16x8, pw1), (bf16x8){lo1[0], lo1[1], lo1[2], lo1[3], hh1[0], hh1[1], hh1[2], hh1[3]}, y, 0, 0, 0);
}
__device__ __forceinline__ void yoff(const Ctx& c, int lb, int sbuf, f32x16& y) {
    bf16x8 cf[8], sf[8]; f32x4 av[4];
    load_cf(c, lb, cf);
#pragma unroll
    for (int ks = 0; ks < 8; ++ks) sf[ks] = *(const LAS bf16x8*)(c.lds + LST + sbuf * STB + c.r32 * 272 + (16 * ks + 8 * c.hi) * 2);
#pragma unroll
    for (int q = 0; q < 4; ++q) av[q] = *(const LAS f32x4*)(c.a2 + 32 * lb + 8 * q + 4 * c.hi);
    SSD_PIN8(cf); SSD_PIN8(sf); SSD_PIN4(av);
#pragma unroll
    for (int r = 0; r < 16; ++r) y[r] = 0.f;
#pragma unroll
    for (int ks = 0; ks < 8; ++ks) y = __builtin_amdgcn_mfma_f32_32x32x16_bf16(cf[ks], sf[ks], y, 0, 0, 0);
#pragma unroll
    for (int r = 0; r < 16; ++r) y[r] *= __builtin_amdgcn_exp2f(av[r >> 2][r & 3]);
}
__device__ __forceinline__ void state_item(const Ctx& c, int nt, int nbuf, f32x16& st) {
    const int i16 = c.lane & 15, g1 = (c.lane >> 4) & 1;
    const float dall = __builtin_amdgcn_exp2f(c.a2[127]);
#pragma unroll
    for (int r = 0; r < 16; ++r) st[r] *= dall;
    const LAS unsigned char* ab = c.lds + LB + (4 * nt + 2 * g1 + ((i16 & 3) >> 1)) * BCS + (8 * c.hi + (i16 >> 2)) * 16 + (i16 & 1) * 8;
    const LAS unsigned char* wb = c.lds + LXW + (8 * c.hi + (i16 >> 2)) * 64 + g1 * 32 + (i16 & 3) * 8;
#pragma unroll
    for (int kb = 0; kb < 2; ++kb) {
        bf16x8 af[4], wf[4];
#pragma unroll
        for (int kk = 0; kk < 4; ++kk) { const int ks = kb * 4 + kk;
            const attn_body::s16x4 a0 = attn_body::vtr((attn_body::lds_cptr)(ab + ks * 256)), a1 = attn_body::vtr((attn_body::lds_cptr)(ab + ks * 256 + 64));
            const attn_body::s16x4 w0 = attn_body::vtr((attn_body::lds_cptr)(wb + ks * 1024)), w1 = attn_body::vtr((attn_body::lds_cptr)(wb + ks * 1024 + 256));
            af[kk] = (bf16x8){a0[0], a0[1], a0[2], a0[3], a1[0], a1[1], a1[2], a1[3]}; wf[kk] = (bf16x8){w0[0], w0[1], w0[2], w0[3], w1[0], w1[1], w1[2], w1[3]}; }
        SSD_PIN4(af); SSD_PIN4(wf);
#pragma unroll
        for (int kk = 0; kk < 4; ++kk) st = __builtin_amdgcn_mfma_f32_32x32x16_bf16(af[kk], wf[kk], st, 0, 0, 0);
    }
#pragma unroll
    for (int q = 0; q < 4; ++q) { v2u w; w.x = attn_body::cvtpk_s(st[4 * q], st[4 * q + 1]); w.y = attn_body::cvtpk_s(st[4 * q + 2], st[4 * q + 3]);
        *(LAS v2u*)(c.lds + LST + nbuf * STB + c.r32 * 272 + (32 * nt + 8 * q + 4 * c.hi) * 2) = w; }
}
__device__ __forceinline__ void put_slot(const Ctx& c, int slot, const f32x16& y) {
    LAS float* sp = (LAS float*)(c.lds + LSL + slot * 4096);
#pragma unroll
    for (int r = 0; r < 16; ++r) sp[attn_body::crow(r, c.hi) * 32 + c.r32] = y[r];
}
__device__ __forceinline__ void unit(Frame& F, KA args, int u) {
    const int tid = F.tid, lane = F.lane, wave = F.wave, r32 = lane & 31, hi = lane >> 5;
    const int b = u >> 5, h = (u >> 1) & 15, ph = u & 1, g = h >> 3;
    const bf16* XBC = (const bf16*)(F.ws + mp::xbc); const float* DTR = (const float*)(F.ws + mp::dt); bf16* YS = (bf16*)(F.ws + mp::ys);
    const float dtb = ((const float*)args->in[6])[h], Ah = -expf(((const float*)args->in[7])[h]) * 1.44269504089f, Dk = ((const float*)args->in[8])[h];
    LAS unsigned char* lds = F.lds + RING_OFF;
    const size_t mbase = (size_t)b * SEQ;
    const int brow = tid >> 4, bchk = tid & 15;
    const int xrow = tid >> 2, xpc = tid & 3;
    v4u Breg[4], Creg[4], xreg;
#define SSD_LOAD_REGS(k_) do { const size_t m0_ = mbase + (size_t)(k_) * 128; \
        _Pragma("unroll") for (int i = 0; i < 4; ++i) { Breg[i] = *(const GAS v4u*)(XBC + (m0_ + brow + 32 * i) * 1536 + 1024 + g * 128 + bchk * 8); Creg[i] = *(const GAS v4u*)(XBC + (m0_ + brow + 32 * i) * 1536 + 1280 + g * 128 + bchk * 8); } \
        xreg = *(const GAS v4u*)(XBC + (m0_ + xrow) * 1536 + h * 64 + ph * 32 + xpc * 8); } while (0)
    float dtr0 = 0.f, dtr1 = 0.f;
#define SSD_LOAD_DT(k_) do { const size_t m0_ = mbase + (size_t)(k_) * 128; dtr0 = DTR[(m0_ + 2 * lane) * 16 + h]; dtr1 = DTR[(m0_ + 2 * lane + 1) * 16 + h]; } while (0)
#define SSD_PREP_A(buf_) do { \
        const float r0 = dtr0 + dtb, r1 = dtr1 + dtb; \
        const float d0 = r0 > 20.f ? r0 : log1pf(expf(r0)), d1 = r1 > 20.f ? r1 : log1pf(expf(r1)); \
        const float v0 = d0 * Ah, v1 = d1 * Ah; float s_ = v0 + v1; \
        _Pragma("unroll") for (int o = 1; o < 64; o <<= 1) { const float t = __shfl_up(s_, o); if (lane >= o) s_ += t; } \
        LAS float* a2w = (LAS float*)(lds + LA + (buf_) * 2048); LAS float* dtw = a2w + 128; LAS float* fw = a2w + 256; \
        const float aref_ = __shfl(s_, (lane & 48) | 15); \
        a2w[2 * lane] = s_ - v1; a2w[2 * lane + 1] = s_; dtw[2 * lane] = d0; dtw[2 * lane + 1] = d1; \
        fw[2 * lane] = __builtin_amdgcn_exp2f(aref_ - (s_ - v1)) * d0; fw[2 * lane + 1] = __builtin_amdgcn_exp2f(aref_ - s_) * d1; } while (0)
    f32x16 stA, stB;
#pragma unroll
    for (int r = 0; r < 16; ++r) { stA[r] = 0.f; stB[r] = 0.f; }
    SSD_LOAD_REGS(0);
    if (wave == 1) { SSD_LOAD_DT(0); SSD_PREP_A(0); }
    LDS_WAIT(); __syncthreads();
#pragma nounroll
    for (int k = 0; k < 16; ++k) {
        const int buf = k & 1, nb = buf ^ 1; const size_t m0 = mbase + (size_t)k * 128;
        Ctx c; c.lds = lds; c.a2 = (const LAS float*)(lds + LA + buf * 2048); c.dtl = c.a2 + 128; c.fsl = c.a2 + 256; c.lane = lane; c.r32 = r32; c.hi = hi;
#pragma unroll
        for (int i = 0; i < 4; ++i) { *(LAS v4u*)(lds + LB + bchk * BCS + (brow + 32 * i) * 16) = Breg[i]; *(LAS v4u*)(lds + LC + bchk * BCS + (brow + 32 * i) * 16) = Creg[i]; }
        *(LAS v4u*)(lds + LX + xrow * 64 + xpc * 16) = xreg;
        { const float wsc = __builtin_amdgcn_exp2f(c.a2[127] - c.a2[xrow]) * c.dtl[xrow];
          const float x0 = __builtin_bit_cast(float, xreg.x << 16) * wsc, x1 = __builtin_bit_cast(float, xreg.x & 0xffff0000u) * wsc, x2 = __builtin_bit_cast(float, xreg.y << 16) * wsc, x3 = __builtin_bit_cast(float, xreg.y & 0xffff0000u) * wsc;
          const float x4 = __builtin_bit_cast(float, xreg.z << 16) * wsc, x5 = __builtin_bit_cast(float, xreg.z & 0xffff0000u) * wsc, x6 = __builtin_bit_cast(float, xreg.w << 16) * wsc, x7 = __builtin_bit_cast(float, xreg.w & 0xffff0000u) * wsc;
          v4u xw; xw.x = pk2(x0, x1); xw.y = pk2(x2, x3); xw.z = pk2(x4, x5); xw.w = pk2(x6, x7);
          *(LAS v4u*)(lds + LXW + xrow * 64 + xpc * 16) = xw; }
        LDS_WAIT(); __syncthreads();
        if (k < 15) { SSD_LOAD_REGS(k + 1); if (wave == 1) SSD_LOAD_DT(k + 1); }
        {
            f32x16 y; bf16x8 cf[8];
#pragma unroll
            for (int r = 0; r < 16; ++r) y[r] = 0.f;
            if (wave == 0)      { load_cf(c, 3, cf); intra<true>(c, 3, 3, cf, y); intra<false>(c, 3, 2, cf, y); put_slot(c, 0, y); }
            else if (wave == 1) { load_cf(c, 3, cf); intra<false>(c, 3, 1, cf, y); intra<false>(c, 3, 0, cf, y); put_slot(c, 1, y); if (k < 15) SSD_PREP_A(nb); }
            else if (wave == 2) { load_cf(c, 2, cf); intra<true>(c, 2, 2, cf, y); intra<false>(c, 2, 1, cf, y); put_slot(c, 3, y); }
            else if (wave == 3) { load_cf(c, 2, cf); intra<false>(c, 2, 0, cf, y); put_slot(c, 4, y);
#pragma unroll
                                  for (int r = 0; r < 16; ++r) y[r] = 0.f;
                                  load_cf(c, 0, cf); intra<true>(c, 0, 0, cf, y); put_slot(c, 8, y); }
            else if (wave == 4) { load_cf(c, 1, cf); intra<true>(c, 1, 1, cf, y); intra<false>(c, 1, 0, cf, y); put_slot(c, 6, y); }
            else if (wave == 5) { if (k > 0) { yoff(c, 3, buf, y); put_slot(c, 2, y); yoff(c, 2, buf, y); put_slot(c, 5, y); yoff(c, 1, buf, y); put_slot(c, 7, y); yoff(c, 0, buf, y); put_slot(c, 9, y); } }
            else if (wave == 6) { state_item(c, 0, nb, stA); state_item(c, 1, nb, stB); }
            else                { state_item(c, 2, nb, stA); state_item(c, 3, nb, stB); }
        }
        LDS_WAIT(); __syncthreads();
        { const int row = tid >> 2, pc = tid & 3, lb = wave >> 1, rl = row & 31;
          const int s0 = lb == 3 ? 0 : (lb == 2 ? 3 : (lb == 1 ? 6 : 8)), s1 = lb == 3 ? 1 : (lb == 2 ? 4 : -1), so = lb == 3 ? 2 : (lb == 2 ? 5 : (lb == 1 ? 7 : 9));
          const LAS float* p0 = (const LAS float*)(lds + LSL + s0 * 4096) + rl * 32 + pc * 8;
          f32x4 ya = *(const LAS f32x4*)p0, yb = *(const LAS f32x4*)(p0 + 4);
          if (s1 >= 0) { const LAS float* p1 = (const LAS float*)(lds + LSL + s1 * 4096) + rl * 32 + pc * 8; ya += *(const LAS f32x4*)p1; yb += *(const LAS f32x4*)(p1 + 4); }
          if (k > 0) { const LAS float* p2 = (const LAS float*)(lds + LSL + so * 4096) + rl * 32 + pc * 8; ya += *(const LAS f32x4*)p2; yb += *(const LAS f32x4*)(p2 + 4); }
          const v4u xv = *(const LAS v4u*)(lds + LX + row * 64 + pc * 16);
          v4u o; o.x = pk2(ya.x + Dk * __builtin_bit_cast(float, xv.x << 16), ya.y + Dk * __builtin_bit_cast(float, xv.x & 0xffff0000u)); o.y = pk2(ya.z + Dk * __builtin_bit_cast(float, xv.y << 16), ya.w + Dk * __builtin_bit_cast(float, xv.y & 0xffff0000u));
          o.z = pk2(yb.x + Dk * __builtin_bit_cast(float, xv.z << 16), yb.y + Dk * __builtin_bit_cast(float, xv.z & 0xffff0000u)); o.w = pk2(yb.z + Dk * __builtin_bit_cast(float, xv.w << 16), yb.w + Dk * __builtin_bit_cast(float, xv.w & 0xffff0000u));
          *(GAS v4u*)(YS + (m0 + row) * 1024 + h * 64 + ph * 32 + pc * 8) = o; }
    }
    LDS_WAIT(); __syncthreads();
#undef SSD_LOAD_REGS
#undef SSD_LOAD_DT
#undef SSD_PREP_A
}
#undef SSD_PIN8
#undef SSD_PIN4
}
__device__ __forceinline__ void p3_ssd(Frame& F, KA args) {
    for (int u = F.vcu; u < 256; u += F.G) ssd::unit(F, args, u);
}

__device__ __forceinline__ void p0_small(Frame& F, KA args) {
    const int gt = (F.vcu * NWAVES + F.wave) * 64 + F.lane, NGT = F.G * NWAVES * 64;
    const float* ln2 = (const float*)args->in[18]; const float* wrg = (const float*)args->in[19]; const float* wre = (const float*)args->in[21];
    bf16* WRH = (bf16*)(F.ws + mp::wr); bf16* WRL = WRH + 48 * DM;
    for (int i = gt; i < 48 * DM; i += NGT) { const int c = i / DM, k = i % DM;
        const float w = (c < 4 ? wrg[k * 4 + c] : (c < 36 ? wre[k * 32 + (c - 4)] : 0.f)) * ln2[k];
        const unsigned hi = f2bf(w); const float lo = w - bf2f((unsigned short)hi);
        WRH[i] = (bf16)hi; WRL[i] = (bf16)f2bf(lo); }
    { GAS v4u* z = (GAS v4u*)((bf16*)(F.ws + mp::win) + (size_t)(NIN + 16) * DM);
      for (int i = gt; i < (NIN_G - NIN - 16) * DM / 8; i += NGT) z[i] = (v4u){0u, 0u, 0u, 0u}; }
}

__device__ __forceinline__ void p5_route(Frame& F, KA args) {
    const int lane = F.lane;
    const bf16* h = (const bf16*)(F.ws + mp::xn2);
    const bf16* WRH = (const bf16*)(F.ws + mp::wr); const bf16* WRL = WRH + 48 * DM;
    const float* brg = (const float*)args->in[20]; const float* bre = (const float*)args->in[22];
    int* tok_e = (int*)(F.ws + mp::small + SM_TOK_E); int* tok_pos = (int*)(F.ws + mp::small + SM_TOK_POS); float* tok_w = (float*)(F.ws + mp::small + SM_TOK_W);
    int* lst_tok = (int*)(F.ws + mp::lst); float* lst_w = (float*)(F.ws + mp::lst) + NE * LCAP; float* lst_r = lst_w + NE * LCAP;
    unsigned* cnt = (unsigned*)(F.ctl + CW_CNT);
    LAS float* lg = (LAS float*)(F.lds + RING_OFF + F.wave * 4096);
    constexpr int KQ = 512, WQB = 2 * 48 * KQ * 2;
    LAS unsigned char* wq = F.lds + RING_OFF + 32768;
    for (int wt = F.vcu; wt < M / 64; wt += F.G) {
        const int rt = F.wave & 3, kh = F.wave >> 2, task = wt * 4 + rt;
        const bf16* hr = h + (size_t)(task * 16 + (lane & 15)) * DM + (lane >> 4) * 8;
        f32x4 acc0 = (f32x4){0.f, 0.f, 0.f, 0.f}, acc1 = acc0, acc2 = acc0; float ss = 0.f;
        for (int q = 0; q < DM / KQ; ++q) {
            __syncthreads();
#pragma unroll
            for (int i = 0; i < 12; ++i) { const int pc = F.tid + 512 * i, row = pc >> 6, c16 = pc & 63;
                const v4u v = *(const GAS v4u*)((row < 48 ? WRH + (size_t)row * DM : WRL + (size_t)(row - 48) * DM) + q * KQ + c16 * 8);
                *(LAS v4u*)(wq + row * 1040 + c16 * 16) = v; }
            LDS_WAIT(); __syncthreads();
#pragma unroll 4
            for (int k8 = 0; k8 < 8; ++k8) {
                const int kt = kh * 8 + k8;
                const v4u hv = *(const GAS v4u*)(hr + q * KQ + kt * 32);
                { const float e0 = __builtin_bit_cast(float, hv.x << 16), e1 = __builtin_bit_cast(float, hv.x & 0xffff0000u), e2 = __builtin_bit_cast(float, hv.y << 16), e3 = __builtin_bit_cast(float, hv.y & 0xffff0000u);
                  const float e4 = __builtin_bit_cast(float, hv.z << 16), e5 = __builtin_bit_cast(float, hv.z & 0xffff0000u), e6 = __builtin_bit_cast(float, hv.w << 16), e7 = __builtin_bit_cast(float, hv.w & 0xffff0000u);
                  ss += (e0 * e0 + e1 * e1) + (e2 * e2 + e3 * e3) + (e4 * e4 + e5 * e5) + (e6 * e6 + e7 * e7); }
                const bf16x8 ah = __builtin_bit_cast(bf16x8, hv);
                const LAS unsigned char* bp = wq + (lane & 15) * 1040 + kt * 64 + (lane >> 4) * 16;
                { const bf16x8 b_h = *(const LAS bf16x8*)(bp), b_l = *(const LAS bf16x8*)(bp + 48 * 1040);
                  acc0 = __builtin_amdgcn_mfma_f32_16x16x32_bf16(ah, b_h, acc0, 0, 0, 0); acc0 = __builtin_amdgcn_mfma_f32_16x16x32_bf16(ah, b_l, acc0, 0, 0, 0); }
                { const bf16x8 b_h = *(const LAS bf16x8*)(bp + 16 * 1040), b_l = *(const LAS bf16x8*)(bp + 64 * 1040);
                  acc1 = __builtin_amdgcn_mfma_f32_16x16x32_bf16(ah, b_h, acc1, 0, 0, 0); acc1 = __builtin_amdgcn_mfma_f32_16x16x32_bf16(ah, b_l, acc1, 0, 0, 0); }
                { const bf16x8 b_h = *(const LAS bf16x8*)(bp + 32 * 1040), b_l = *(const LAS bf16x8*)(bp + 80 * 1040);
                  acc2 = __builtin_amdgcn_mfma_f32_16x16x32_bf16(ah, b_h, acc2, 0, 0, 0); acc2 = __builtin_amdgcn_mfma_f32_16x16x32_bf16(ah, b_l, acc2, 0, 0, 0); }
            }
        }
        __syncthreads();
        LAS float* xp = (LAS float*)(F.lds + RING_OFF + 32768 + rt * 4096) + lane * 13;
        if (kh == 1) {
#pragma unroll
            for (int q = 0; q < 4; ++q) { xp[q] = acc0[q]; xp[4 + q] = acc1[q]; xp[8 + q] = acc2[q]; }
            xp[12] = ss; }
        LDS_WAIT(); __syncthreads();
        if (kh == 0) {
#pragma unroll
        for (int q = 0; q < 4; ++q) { acc0[q] += xp[q]; acc1[q] += xp[4 + q]; acc2[q] += xp[8 + q]; }
        ss += xp[12];
        ss += __shfl_xor(ss, 16); ss += __shfl_xor(ss, 32);
        const float r = 1.0f / sqrtf(ss * (1.f / DM) + EPS);
#pragma unroll
        for (int reg = 0; reg < 4; ++reg) { const int row = (lane >> 4) * 4 + reg; const float rr = __shfl(r, row);
            lg[row * 48 + (lane & 15)] = acc0[reg] * rr; lg[row * 48 + 16 + (lane & 15)] = acc1[reg] * rr; lg[row * 48 + 32 + (lane & 15)] = acc2[reg] * rr; }
        LDS_WAIT(); asm volatile("" ::: "memory");
        if (lane < 16) {
            const LAS float* L = lg + lane * 48; const int tok = task * 16 + lane;
            float gl[4];
#pragma unroll
            for (int j = 0; j < 4; ++j) gl[j] = L[j] + brg[j];
            int gs = 0; float gm = gl[0];
#pragma unroll
            for (int j = 1; j < 4; ++j) if (gl[j] > gm) { gm = gl[j]; gs = j; }
            float gsum = 0.f;
#pragma unroll
            for (int j = 0; j < 4; ++j) gsum += expf(gl[j] - gm);
            const float gwt = 1.f / gsum;
            float el[8];
#pragma unroll
            for (int j = 0; j < 8; ++j) el[j] = L[4 + gs * 8 + j] + bre[gs * 8 + j];
            int i1 = 0; float m1 = el[0];
#pragma unroll
            for (int j = 1; j < 8; ++j) if (el[j] > m1) { m1 = el[j]; i1 = j; }
            int i2 = 0; float m2 = -INFINITY;
#pragma unroll
            for (int j = 0; j < 8; ++j) if (j != i1 && el[j] > m2) { m2 = el[j]; i2 = j; }
            const float e2 = expf(m2 - m1); const float w1 = gwt / (1.f + e2), w2 = gwt * e2 / (1.f + e2);
            const int ea = gs * 8 + i1, eb = gs * 8 + i2;
            tok_e[tok * 2] = ea; tok_e[tok * 2 + 1] = eb; tok_w[tok * 2] = w1; tok_w[tok * 2 + 1] = w2;
            const int pa = (int)__hip_atomic_fetch_add(cnt + ea, 1u, RLX_AGENT), pb = (int)__hip_atomic_fetch_add(cnt + eb, 1u, RLX_AGENT);
            tok_pos[tok * 2] = pa; tok_pos[tok * 2 + 1] = pb;
            lst_tok[ea * LCAP + pa] = tok; lst_w[ea * LCAP + pa] = w1; lst_r[ea * LCAP + pa] = r; lst_tok[eb * LCAP + pb] = tok; lst_w[eb * LCAP + pb] = w2; lst_r[eb * LCAP + pb] = r;
        }
        }
        LDS_WAIT(); __syncthreads();
    }
}

__device__ __forceinline__ void build_tab(Frame& F, KA args) {
    LAS int* tab = (LAS int*)(F.lds + TAB_OFF);
    if (F.wave == 0) {
        const int lane = F.lane, e = lane & 31; unsigned* cnt = (unsigned*)(F.ctl + CW_CNT);
        const int c = (int)__hip_atomic_load(cnt + e, RLX_AGENT), mt = (c + 255) >> 8;
        int sc = mt;
#pragma unroll
        for (int o = 1; o < 32; o <<= 1) { const int t = __shfl_up(sc, o); if (e >= o) sc += t; }
        if (lane < 32) { tab[e] = (sc - mt) * 8; tab[40 + e] = sc - mt; tab[80 + e] = c; }
        if (lane == 31) { tab[32] = sc * 8; tab[72] = sc; }
    }
    LDS_WAIT(); __syncthreads();
}

__device__ __forceinline__ void p8_combine(Frame& F, KA args) {
    const int gw = F.vcu * NWAVES + F.wave, NGW = F.G * NWAVES, lane = F.lane;
    build_tab(F, args);
    const LAS int* tab = (const LAS int*)(F.lds + TAB_OFF);
    const int* tok_e = (const int*)(F.ws + mp::small + SM_TOK_E); const int* tok_pos = (const int*)(F.ws + mp::small + SM_TOK_POS); const unsigned char* Y8 = (const unsigned char*)(F.ws + mp::y); float* out = args->out;
    const bf16* HB = (const bf16*)(F.ws + mp::xn2);
    v4u hvA[2][2], avA[2], bvA[2], hvB[2][2], avB[2], bvB[2];
#define P8_LOAD(t_, hv_, av_, bv_) do { const int s0_ = tab[40 + tok_e[2 * (t_)]] * 256 + tok_pos[2 * (t_)], s1_ = tab[40 + tok_e[2 * (t_) + 1]] * 256 + tok_pos[2 * (t_) + 1]; \
        _Pragma("unroll") for (int j = 0; j < 2; ++j) { const int c0 = 16 * (lane + 64 * j); \
            hv_[j][0] = __builtin_nontemporal_load((const GAS v4u*)(HB + (size_t)(t_) * DM + c0)); hv_[j][1] = __builtin_nontemporal_load((const GAS v4u*)(HB + (size_t)(t_) * DM + c0 + 8)); \
            av_[j] = __builtin_nontemporal_load((const GAS v4u*)(Y8 + (size_t)s0_ * DM + c0)); bv_[j] = __builtin_nontemporal_load((const GAS v4u*)(Y8 + (size_t)s1_ * DM + c0)); } } while (0)
#define P8_STORE(t_, hv_, av_, bv_) do { \
        _Pragma("unroll") for (int j = 0; j < 2; ++j) { const int c0 = 16 * (lane + 64 * j); \
            const unsigned hw[8] = {hv_[j][0].x, hv_[j][0].y, hv_[j][0].z, hv_[j][0].w, hv_[j][1].x, hv_[j][1].y, hv_[j][1].z, hv_[j][1].w}; \
            const unsigned aw[4] = {av_[j].x, av_[j].y, av_[j].z, av_[j].w}, bw[4] = {bv_[j].x, bv_[j].y, bv_[j].z, bv_[j].w}; \
            _Pragma("unroll") for (int q = 0; q < 4; ++q) { \
                const f32x2_t a01 = __builtin_amdgcn_cvt_pk_f32_fp8((int)aw[q], false), a23 = __builtin_amdgcn_cvt_pk_f32_fp8((int)aw[q], true); \
                const f32x2_t b01 = __builtin_amdgcn_cvt_pk_f32_fp8((int)bw[q], false), b23 = __builtin_amdgcn_cvt_pk_f32_fp8((int)bw[q], true); \
                f32x4 v; \
                v.x = __builtin_bit_cast(float, hw[2 * q] << 16) + (a01.x + b01.x) * (1.f / Y8_SCALE); v.y = __builtin_bit_cast(float, hw[2 * q] & 0xffff0000u) + (a01.y + b01.y) * (1.f / Y8_SCALE); \
                v.z = __builtin_bit_cast(float, hw[2 * q + 1] << 16) + (a23.x + b23.x) * (1.f / Y8_SCALE); v.w = __builtin_bit_cast(float, hw[2 * q + 1] & 0xffff0000u) + (a23.y + b23.y) * (1.f / Y8_SCALE); \
                *(GAS f32x4*)(out + (size_t)(t_) * DM + c0 + 4 * q) = v; } } } while (0)
    typedef float f32x2_t __attribute__((ext_vector_type(2)));
    if (gw < M) P8_LOAD(gw, hvA, avA, bvA);
    for (int t = gw; t < M; t += 2 * NGW) {
        P8_LOAD(t + NGW, hvB, avB, bvB);
        P8_STORE(t, hvA, avA, bvA);
        if (t + 2 * NGW < M) P8_LOAD(t + 2 * NGW, hvA, avA, bvA);
        P8_STORE(t + NGW, hvB, avB, bvB);
    }
#undef P8_LOAD
#undef P8_STORE
}

constexpr int N_PHASES = 11;
#ifndef MK_REP_BAR
#define MK_REP_BAR 0
#endif
#ifndef MK_REP_PHASE
#define MK_REP_PHASE -1
#endif
#define PHASE_ARGS() ({ KA p_ = (KA)__builtin_amdgcn_kernarg_segment_ptr(); asm volatile("" : "+s"(p_)); p_; })
__global__ void __launch_bounds__(NWAVES * 64, 2) mega(Args args_byval) {
    KA args = PHASE_ARGS(); (void)args_byval;
    extern __shared__ __attribute__((aligned(16))) unsigned char lds[];
    Frame F;
    F.lds = (LAS unsigned char*)lds;
    F.MISC = (volatile LAS unsigned*)(F.lds + MISC_OFF);
    F.tid = threadIdx.x; F.lane = F.tid & 63; F.wave = __builtin_amdgcn_readfirstlane(F.tid >> 6);
    F.G = gridDim.x; { const int bx = blockIdx.x; F.vcu = (F.G % 8 == 0) ? (bx % 8) * (F.G / 8) + bx / 8 : bx; }
    F.cid = (int)blockIdx.x;
    F.ws = args->ws;
    F.ctl = (gu32*)(F.ws + mp::ctl);
    for (int u = F.tid; u < (LDS_BYTES - LDSCTL_OFF) / 4; u += NWAVES * 64) ((LAS unsigned*)(F.lds + LDSCTL_OFF))[u] = 0u;
    __syncthreads();
    const bool one_launch = (args->li < 0);
    XcdBarrier bar; bar.bar = (unsigned*)(F.ctl + CW_BAR); bar.x = 0; bar.st = nullptr;
    if (one_launch) bar = xcd_barrier_post((unsigned*)(F.ctl + CW_BAR), F.MISC + 8);
    if (one_launch && F.tid == 0) { const unsigned x_ = xb_xcc_id(); F.MISC[10] = x_; F.MISC[11] = xb_add((unsigned*)(F.ctl + CW_RANK + 64 * x_), 1u); }
    bool local_ok = false; unsigned* loc_ctr = nullptr;
    const int lo = args->ph_lo, hi = args->ph_hi;
#define IN(k) (lo <= (k) && (k) < hi)
#define SEAM(k) do { if (IN(k) && IN((k) + 1)) xcd_barrier(bar); } while (0)
#define SEAM_LOCAL(k) do { if (IN(k) && IN((k) + 1)) { if (local_ok) xcd_local_barrier(bar.bar, loc_ctr, 32u); else xcd_barrier(bar); } } while (0)

    if (IN(0)) for (int rep_ = 0; rep_ < (MK_REP_PHASE == 0 ? 2 : 1); ++rep_) { args = PHASE_ARGS(); p0_prologue(F, args); if (args->p0_mask & 8) p0_small(F, args); if (args->p0_mask & 16) p0_rope(F, args); }
    SEAM(0);
    if (one_launch && IN(0) && IN(1)) {
        if (F.tid == 0) { unsigned ok_ = (F.G == 256) ? 1u : 0u;
            for (unsigned j = 0; j < 16; ++j) { const unsigned c_ = xb_ld(&bar.bar[XB_XCNT(j)]); if (c_ != (j < 8 ? 32u : 0u)) ok_ = 0u; }
            F.MISC[12] = ok_; }
        __syncthreads();
        if (F.MISC[12]) { const int x_ = (int)F.MISC[10], r_ = (int)F.MISC[11]; local_ok = true; F.vcu = x_ * 32 + r_; F.cid = r_ * 8 + x_; loc_ctr = (unsigned*)(F.ctl + CW_LOC + 64 * x_); }
    }
    if (IN(1)) for (int rep_ = 0; rep_ < (MK_REP_PHASE == 1 ? 2 : 1); ++rep_) { args = PHASE_ARGS();
        pg8::Gemm g{(const bf16*)(F.ws + mp::xn), (const bf16*)(F.ws + mp::win), M, NIN_G, DM};
        pg8::EpiInProj E{(bf16*)(F.ws + mp::u16), NIN, (float*)(F.ws + mp::dt)};
#if P1_HOSTS_P0B == 1
        const int c_ = F.cid, xcd_ = c_ & 7, team_ = c_ >> 6;
        const int ks = team_ < 3 ? (xcd_ + 2 * team_) % 7 : xcd_ % 6;
        for (int part = 0; part < 2; ++part) {
            pg8::TeamOrder S{c_, part == 0 ? 0 : ks, part == 0 ? ks : 6};
            pg8::gemm_phase<pg8::EpiInProj, pg8::TeamOrder, PG8_ALIGN, PG8_SP2>(F.lds + RING_OFF, g, S, E);
            if (part == 0) { __syncthreads(); args = PHASE_ARGS(); p1_convert_share(F, args, 0); __syncthreads(); }
        }
#elif P1_HOSTS_P0B == 2
        pg8::StaticOrder S; S.init(M, NIN_G, F.G, (int)blockIdx.x);
        typedef pg8::ConvMoE<KA, 23, mp::wgu, mp::wd, mp::END, RING_OFF + RING_BYTES> CvJob;
        pg8::gemm_phase<pg8::EpiInProj, pg8::StaticOrder, PG8_ALIGN, PG8_SP2, false, CvJob>(F.lds + RING_OFF, g, S, E, CvJob{});
        if ((int)blockIdx.x >= P1_UNITS - 5 * F.G) { __syncthreads(); args = PHASE_ARGS(); p0b_blocks(F, args, 4 * (P1_INLOOP_BLOCKS + ((int)blockIdx.x - (P1_UNITS - 5 * F.G)) * NWAVES + F.wave), 4); }
#else
        pg8::StaticOrder S; S.init(M, NIN_G, F.G, (int)blockIdx.x);
        pg8::gemm_phase<pg8::EpiInProj, pg8::StaticOrder, PG8_ALIGN, PG8_SP2>(F.lds + RING_OFF, g, S, E);
#endif
    }
    SEAM_LOCAL(1);
    if (IN(2)) for (int rep_ = 0; rep_ < (MK_REP_PHASE == 2 ? 2 : 1); ++rep_) { if (MK_REP_BAR && rep_) xcd_barrier(bar); args = PHASE_ARGS(); p2_qknorm(F, args); p2_conv(F, args); }
    SEAM_LOCAL(2);
    if (IN(3)) for (int rep_ = 0; rep_ < (MK_REP_PHASE == 3 ? 2 : 1); ++rep_) { args = PHASE_ARGS(); if (args->p0_mask & 128) p3_ssd(F, args); p3_attention(F, args, lds);
#if P1_HOSTS_P0B == 1
        if (rep_ == 0) { __syncthreads(); args = PHASE_ARGS(); p1_convert_share(F, args, 1); }
#endif
    }
    SEAM_LOCAL(3);
    if (IN(4)) for (int rep_ = 0; rep_ < (MK_REP_PHASE == 4 ? 2 : 1); ++rep_) { args = PHASE_ARGS(); p4_ycat(F, args, (args->p0_mask >> 5) & 3); }
    SEAM_LOCAL(4);
    if (IN(5)) for (int rep_ = 0; rep_ < (MK_REP_PHASE == 5 ? 2 : 1); ++rep_) { args = PHASE_ARGS();
        pg8::Gemm g{(const bf16*)(F.ws + mp::ycat), (const bf16*)(F.ws + mp::wout), M, DM, DM}; pg8::StaticOrder S; S.init(M, DM, F.G, F.cid);
        pg8::EpiResid E{(const float*)args->in[0], (bf16*)(F.ws + mp::xn2), (unsigned char*)(F.ws + mp::xn8), DM, (const float*)args->in[18]};
        pg8::gemm_phase<pg8::EpiResid, pg8::StaticOrder, PG8_ALIGN, PG8_SP2>(F.lds + RING_OFF, g, S, E);
#if P1_HOSTS_P0B == 1
        if (rep_ == 0) { __syncthreads(); args = PHASE_ARGS(); p1_convert_share(F, args, 2); }
#endif
    }
    SEAM_LOCAL(5);
    if (IN(6)) for (int rep_ = 0; rep_ < (MK_REP_PHASE == 6 ? 2 : 1); ++rep_) { args = PHASE_ARGS(); p5_route(F, args);
#if P1_HOSTS_P0B == 1
        if (rep_ == 0) { __syncthreads(); args = PHASE_ARGS(); p1_convert_share(F, args, 3); }
#endif
    }
    SEAM(6);
    if (IN(8)) for (int rep_ = 0; rep_ < (MK_REP_PHASE == 8 ? 2 : 1); ++rep_) { args = PHASE_ARGS();
        build_tab(F, args);
        pg8::Gemm g{(const bf16*)(F.ws + mp::xn8), (const bf16*)(F.ws + mp::wgu), M, NE * 2048, DM / 2};    pg8::ExpertOrder S; S.init((const LAS int*)(F.lds + TAB_OFF), F.G, F.cid);
        pg8::ExpertRows RS{(const LAS int*)(F.lds + TAB_OFF), (const int*)(F.ws + mp::lst), LCAP};
        pg8::EpiGateUp E{(unsigned char*)(F.ws + mp::hid), EH, pg8::ExpertScale{(const LAS int*)(F.lds + TAB_OFF), (const float*)(F.ws + mp::lst) + 2 * NE * LCAP, LCAP}, 1.f / F8_WSCALE};
        pg8::gemm_phase_g<pg8::EpiGateUp, pg8::ExpertOrder, pg8::ExpertRows, PG8_ALIGN, PG8_SP2, true>(F.lds + RING_OFF, g, S, E, RS);
    }
    SEAM(8);
    if (IN(9)) for (int rep_ = 0; rep_ < (MK_REP_PHASE == 9 ? 2 : 1); ++rep_) { args = PHASE_ARGS();
        build_tab(F, args);
        pg8::Gemm g{(const bf16*)(F.ws + mp::hid), (const bf16*)(F.ws + mp::wd), SLOT_CAP, NE * 2048, EH / 2};    pg8::ExpertOrder S; S.init((const LAS int*)(F.lds + TAB_OFF), F.G, F.cid);
        pg8::EpiRowScale E{(unsigned char*)(F.ws + mp::y), DM, pg8::ExpertScale{(const LAS int*)(F.lds + TAB_OFF), (const float*)(F.ws + mp::lst) + NE * LCAP, LCAP}, Y8_SCALE / F8_WSCALE};
        pg8::gemm_phase<pg8::EpiRowScale, pg8::ExpertOrder, PG8_ALIGN, PG8_SP2, true>(F.lds + RING_OFF, g, S, E);
    }
    SEAM(9);
    if (IN(10)) for (int rep_ = 0; rep_ < (MK_REP_PHASE == 10 ? 2 : 1); ++rep_) { args = PHASE_ARGS(); p8_combine(F, args); }
#undef IN
#undef SEAM
#undef SEAM_LOCAL
}

__global__ void __launch_bounds__(256) k_u16_to_f32(const bf16* __restrict__ U16, const float* __restrict__ DT, float* __restrict__ U) {
    const size_t idx = (size_t)blockIdx.x * 256 + threadIdx.x;
    const int c = (int)(idx % IN_COLS); const size_t m = idx / IN_COLS;
    float v;
    if (c < 2560) v = bf2f(U16[m * NIN + c]); else if (c < 2576) v = DT[m * 16 + (c - 2560)]; else v = bf2f(U16[m * NIN + c - 16]);
    U[idx] = v;
}
__global__ void __launch_bounds__(256) k_f32_to_bf16(const float* __restrict__ src, bf16* __restrict__ dst) {
    const size_t i = (size_t)blockIdx.x * 256 + threadIdx.x;
    const float4 v = ((const float4*)src)[i]; v2u o; o.x = pk2(v.x, v.y); o.y = pk2(v.z, v.w); ((v2u*)dst)[i] = o;
}
__global__ void __launch_bounds__(256) k_ssdhalf_to_bf16(const float* __restrict__ YCATf, bf16* __restrict__ YCAT16) {
    const size_t i = (size_t)blockIdx.x * 256 + threadIdx.x;
    const size_t m = i >> 8; const int c4 = (int)(i & 255);
    const float4 v = ((const float4*)(YCATf + m * DM))[c4]; v2u o; o.x = pk2(v.x, v.y); o.y = pk2(v.z, v.w); ((v2u*)(YCAT16 + m * DM))[c4] = o;
}

#ifndef MK_ONE_LAUNCH
#define MK_ONE_LAUNCH 1
#endif
extern "C" void kernel_launch(void* const* d_in, const int* in_sizes, int n_in, void* d_out, int out_size, void* d_ws, size_t ws_size, hipStream_t stream) {
    static int ready = 0;
    if (!ready) {
        if (hipFuncSetAttribute((const void*)mega, hipFuncAttributeMaxDynamicSharedMemorySize, LDS_BYTES) != hipSuccess) { fprintf(stderr, "hipFuncSetAttribute failed\n"); }
        if (ws_size < mp::END) fprintf(stderr, "kernel_launch: ws_size %zu too small\n", ws_size);
        ready = 1;
    }
    (void)hipMemsetAsync(d_ws, 0, CTL_ZERO_BYTES, stream);
    Args a{};
    for (int i = 0; i < 26; ++i) a.in[i] = d_in[i];
    a.out = (float*)d_out; a.ws = (unsigned char*)d_ws;
    a.p0_mask = 1 | 2 | 4 | 8 | 16 | (3 << 5) | 128; a.rep_phase = MK_REP_PHASE;
#if MK_ONE_LAUNCH
    a.ph_lo = 0; a.ph_hi = N_PHASES; a.li = -1; hipLaunchKernelGGL(mega, dim3(256), dim3(NWAVES * 64), LDS_BYTES, stream, a);
#else
    for (int ph = 0; ph < N_PHASES; ++ph) { a.ph_lo = ph; a.ph_hi = ph + 1; a.li = ph; hipLaunchKernelGGL(mega, dim3(256), dim3(NWAVES * 64), LDS_BYTES, stream, a); }
#endif
}
```

```cpp
#include <hip/hip_runtime.h>
#include <hip/hip_bf16.h>
#include <math.h>
#include <stdint.h>
#include <cstdio>
#include <cmath>
namespace pg8 {
#define PG8_LAS __attribute__((address_space(3)))
typedef unsigned short bf16_t;
typedef short bf16x8 __attribute__((ext_vector_type(8)));
typedef float f32x4 __attribute__((ext_vector_type(4)));
typedef unsigned u32x4 __attribute__((ext_vector_type(4)));
typedef int v8i_t __attribute__((ext_vector_type(8)));
constexpr int BM = 256, BK = 64, HALF = 128, HTB = HALF * BK * 2  , STAGE_BYTES = 8 * HTB, NXCD = 8, WGM = 8;

__host__ __device__ __forceinline__ int lds_byte(int r, int c) { const int st = (r >> 4) * 2 + (c >> 5), rr = r & 15, cc = c & 31, ob = rr * 64 + cc * 2; return st * 1024 + (ob ^ (((ob >> 9) & 1) << 5)); }
__host__ __device__ __forceinline__ void stage_rc(int b, int& R, int& C) { const int st = b / 1024, sb = b % 1024, swz = sb ^ (((sb >> 9) & 1) << 5); R = (st >> 1) * 16 + swz / 64; C = (st & 1) * 32 + (swz % 64) / 2; }
__host__ __device__ __forceinline__ int perm32(int rho) { const int n = rho >> 4, i = rho & 15; return 8 * (i >> 2) + 4 * n + (i & 3); }

struct Unit { int pm, pn; };
struct Gemm { const bf16_t* A; const bf16_t* Bt; int M, N, K; };

struct StaticOrder {
    int nM, nN, nwg, G, c;
    __host__ __device__ void init(int M, int N, int G_, int c_) { nM = M / BM; nN = N / BM; nwg = nM * nN; G = G_; c = c_; }
    __host__ __device__ bool next(int i, Unit& u) const {
        const long L = (long)i * G + c; if (L >= nwg) return false;
        int wgid = (int)L; { const int q = nwg / NXCD, r = nwg % NXCD, xcd = wgid % NXCD, off = wgid / NXCD; wgid = (xcd < r ? xcd * (q + 1) : r * (q + 1) + (xcd - r) * q) + off; }
        const int nig = WGM * nN, gid = wgid / nig, fm = gid * WGM, gsz = (nM - fm) < WGM ? (nM - fm) : WGM;
        u.pm = fm + ((wgid % nig) % gsz); u.pn = (wgid % nig) / gsz; return true;
    }
    __device__ __forceinline__ int rows(const Unit&) const { return BM; }
    __device__ __forceinline__ void a_ready(const Unit&) const {}
    __device__ __forceinline__ void done(const Unit&) const {}
};

__device__ __forceinline__ unsigned cvt_pk_bf16(float lo, float hi) { unsigned r; asm volatile("v_cvt_pk_bf16_f32 %0, %1, %2" : "=v"(r) : "v"(lo), "v"(hi)); return r; }
typedef float f32x2 __attribute__((ext_vector_type(2)));
__device__ __forceinline__ f32x2 gelu_pk(f32x2 v) {
    const f32x2 av = __builtin_elementwise_abs(v), d = av * 0.2316418882f + 1.0f;
    f32x2 t; t.x = __builtin_amdgcn_rcpf(d.x); t.y = __builtin_amdgcn_rcpf(d.y);
    f32x2 q = t * 0.5307027145f + (-0.7265760135f); q = q * t + 0.7107068705f; q = q * t + (-0.142248368f); q = q * t + 0.127414796f; q = q * t;
    const f32x2 s = (v * v) * (-0.72134752044f);
    f32x2 e; e.x = __builtin_amdgcn_exp2f(s.x); e.y = __builtin_amdgcn_exp2f(s.y);
    const f32x2 m = v * (q * e), r = v - m;
    f32x2 o; o.x = v.x < 0.f ? m.x : r.x; o.y = v.y < 0.f ? m.y : r.y; return o;
}

template <int ACT  > struct EpiBf16 {
    static constexpr bool PERM = true, AFTER_DRAIN = false; static_assert(ACT == 0 || ACT == 1, "EpiBf16: ACT is 0 (none) or 1 (gelu_pk)");
    bf16_t* O; int ldc; const float* bias; int split_cols; size_t split_stride; float scale0;
    __device__ __forceinline__ void operator()(const f32x4 (&acc)[2][2][4][2], const Unit& u, int wr, int wc, int fr, int fq) const {
        const int row0 = u.pm * BM + wr * 64 + fr; int colt = u.pn * BM; bf16_t* base = O;
        float sc = 1.f; if (split_cols) { const int t = colt / split_cols; base += (size_t)t * split_stride; colt -= t * split_cols; if (t == 0) sc = scale0; }
        const int col0 = colt + wc * 32 + 8 * fq, bcol0 = u.pn * BM + wc * 32 + 8 * fq;
        f32x4 bv[2][2];
#pragma unroll
        for (int bj = 0; bj < 2; ++bj)
#pragma unroll
            for (int n = 0; n < 2; ++n) bv[bj][n] = bias ? *(const f32x4*)(bias + bcol0 + bj * HALF + 4 * n) : (f32x4){0.f, 0.f, 0.f, 0.f};
#pragma unroll
        for (int ai = 0; ai < 2; ++ai)
#pragma unroll
            for (int m = 0; m < 4; ++m) { bf16_t* rowp = base + (size_t)(row0 + ai * HALF + m * 16) * ldc + col0;
#pragma unroll
                for (int bj = 0; bj < 2; ++bj) { f32x4 v0 = acc[ai][bj][m][0] + bv[bj][0], v1 = acc[ai][bj][m][1] + bv[bj][1];
                    if (ACT == 1) { f32x2 a = gelu_pk((f32x2){v0[0], v0[1]}), b = gelu_pk((f32x2){v0[2], v0[3]}), c = gelu_pk((f32x2){v1[0], v1[1]}), d = gelu_pk((f32x2){v1[2], v1[3]});
                        v0 = (f32x4){a.x, a.y, b.x, b.y}; v1 = (f32x4){c.x, c.y, d.x, d.y}; }
                    v0 = v0 * sc; v1 = v1 * sc; u32x4 w; w.x = cvt_pk_bf16(v0[0], v0[1]); w.y = cvt_pk_bf16(v0[2], v0[3]); w.z = cvt_pk_bf16(v1[0], v1[1]); w.w = cvt_pk_bf16(v1[2], v1[3]);
                    *(u32x4*)(rowp + bj * HALF) = w; } }
    }
};

struct ConvNone { static constexpr bool ON = false; static constexpr int LDS_OFF = 0; };
template <class Epi, class Sched, bool ALIGN_EPI = false, bool SP2 = false, bool F8 = false, class CV = ConvNone>
__device__ __forceinline__ void gemm_phase(PG8_LAS unsigned char* lds, const Gemm g, const Sched& S, const Epi& E, const CV& cv = CV{}) {
    static_assert(!CV::ON || SP2, "the side job's vmcnt arithmetic is written for the SP2 schedule");
    const int tid = threadIdx.x, wid = __builtin_amdgcn_readfirstlane(tid >> 6), lane = tid & 63, wr = wid >> 2, wc = wid & 3, fr = lane & 15, fq = lane >> 4;
    const int K = g.K, nt = K / BK;
    unsigned voffA[2], voffB[2];
#pragma unroll
    for (int i = 0; i < 2; ++i) { int R, C; stage_rc(tid * 16 + i * 8192, R, C); const int Rb = Epi::PERM ? ((R & ~31) + perm32(R & 31)) : R;
        voffA[i] = (unsigned)(R * K + C) * 2u; voffB[i] = (unsigned)(Rb * K + C) * 2u; }
    const size_t kstep = (size_t)(BK * 2);
    const size_t hstep = (size_t)HALF * K * 2;
    const size_t tstep = 2 * hstep;
    const unsigned ldsw = (unsigned)wid * 1024u;
    const int aoff = lds_byte(wr * 64 + fr, fq * 8), boff = lds_byte(wc * 32 + fr, fq * 8);
#define PG8_CAT8(x, y) __builtin_bit_cast(v8i_t, __builtin_shufflevector((x), (y), 0, 1, 2, 3, 4, 5, 6, 7, 8, 9, 10, 11, 12, 13, 14, 15))
#define PG8_SA(b, h) (((b) * 2 + (h)) * HTB)
#define PG8_SB(b, h) ((4 + (b) * 2 + (h)) * HTB)
#define PG8_STAGE(bufoff, gbase, voff) do { _Pragma("unroll") for (int _i = 0; _i < 2; ++_i) \
        __builtin_amdgcn_global_load_lds((const unsigned*)((const char*)(gbase) + (voff)[_i]), (PG8_LAS unsigned*)(lds + (bufoff) + ldsw + _i * 8192), 16, 0, 0); } while (0)
#define PG8_LDA(dst, b, h) do { if constexpr (F8) { _Pragma("unroll") for (int m = 0; m < 4; ++m) dst##8[m] = PG8_CAT8(*(const PG8_LAS bf16x8*)(lds + PG8_SA(b, h) + aoff + m * 2048), *(const PG8_LAS bf16x8*)(lds + PG8_SA(b, h) + aoff + m * 2048 + 1024)); } else _Pragma("unroll") for (int m = 0; m < 4; ++m) _Pragma("unroll") for (int k = 0; k < 2; ++k) dst[m][k] = *(const PG8_LAS bf16x8*)(lds + PG8_SA(b, h) + aoff + m * 2048 + k * 1024); } while (0)
#define PG8_LDB(dst, b, h) do { if constexpr (F8) { _Pragma("unroll") for (int n = 0; n < 2; ++n) dst##8[n] = PG8_CAT8(*(const PG8_LAS bf16x8*)(lds + PG8_SB(b, h) + boff + n * 2048), *(const PG8_LAS bf16x8*)(lds + PG8_SB(b, h) + boff + n * 2048 + 1024)); } else _Pragma("unroll") for (int n = 0; n < 2; ++n) _Pragma("unroll") for (int k = 0; k < 2; ++k) dst[n][k] = *(const PG8_LAS bf16x8*)(lds + PG8_SB(b, h) + boff + n * 2048 + k * 1024); } while (0)
#define PG8_MMA(ai, bj, At, Bt) do { __builtin_amdgcn_s_setprio(1); \
        if constexpr (F8) { _Pragma("unroll") for (int m = 0; m < 4; ++m) _Pragma("unroll") for (int n = 0; n < 2; ++n) \
            asm volatile("v_mfma_f32_16x16x128_f8f6f4 %0, %1, %2, %0" : "+v"(acc[ai][bj][m][n]) : "v"(Bt##8[n]), "v"(At##8[m])); }     \
        else { _Pragma("unroll") for (int m = 0; m < 4; ++m) _Pragma("unroll") for (int n = 0; n < 2; ++n) _Pragma("unroll") for (int k = 0; k < 2; ++k) \
            acc[ai][bj][m][n] = __builtin_amdgcn_mfma_f32_16x16x32_bf16(Bt[n][k], At[m][k], acc[ai][bj][m][n], 0, 0, 0); } \
        __builtin_amdgcn_s_setprio(0); } while (0)
#define PG8_WAIT_V(n) asm volatile("s_waitcnt vmcnt(" #n ")" ::: "memory")
#define PG8_WAIT_L(n) asm volatile("s_waitcnt lgkmcnt(" #n ")" ::: "memory")
#define PG8_BAR __builtin_amdgcn_s_barrier()
#define PG8_SCHED __builtin_amdgcn_sched_barrier(0)
    Unit cur, nxt; int ui = 0;
    if (!S.next(0, cur)) return;
    bool skip1 = S.rows(cur) <= HALF;
    f32x4 acc[2][2][4][2];
#pragma unroll
    for (int a = 0; a < 2; ++a)
#pragma unroll
        for (int b = 0; b < 2; ++b)
#pragma unroll
            for (int m = 0; m < 4; ++m)
#pragma unroll
                for (int n = 0; n < 2; ++n) acc[a][b][m][n] = (f32x4){0.f, 0.f, 0.f, 0.f};
    bf16x8 At[4][2], B0[2][2], B1[2][2];
    v8i_t At8[4], B08[2], B18[2];
    const char* cA = (const char*)g.A + (size_t)cur.pm * tstep; const char* cB = (const char*)g.Bt + (size_t)cur.pn * tstep;
    S.a_ready(cur);
    typedef float cvf2 __attribute__((ext_vector_type(2))); typedef unsigned cvu2 __attribute__((ext_vector_type(2)));
    cvu2 cvo0 = {0u, 0u}, cvo1 = {0u, 0u};
    const char* cv_sb = nullptr; unsigned cv_sv = 0, cv_db = 0, cv_dv = 0, cv_stb = 0, cv_stv = 0; int cv_dn = 0, cv_stdn = 0;
    unsigned char* cv_ws = nullptr; unsigned cv_slot = 0;
    PG8_LAS unsigned char* const cv_lds = lds + CV::LDS_OFF + wid * 3072;
    if constexpr (CV::ON) { cv.decode(cur, wid, lane, cv_sb, cv_dn, cv_db, cv_dv, cv_sv); cv_ws = cv.wsbase(); cv_stb = CV::DUMMY_OFF; cv_stdn = 0; cv_stv = (unsigned)tid * 16u; }
#define CV_LD(slot) do { if constexpr (CV::ON) { \
        __builtin_amdgcn_global_load_lds((const unsigned*)(cv_sb + (size_t)((2 * slot) * (cv_dn ? 8192u : 4096u)) + cv_sv), (PG8_LAS unsigned*)(cv_lds + cv_slot), 16, 0, 0); \
        cv_slot = cv_slot == 2048u ? 0u : cv_slot + 1024u; } } while (0)
#define CV_CVT(slot, dw, hi) do { if constexpr (CV::ON) { \
        const cvf2 ra_ = *(const PG8_LAS cvf2*)(cv_lds + cv_slot + lane * 8), rb_ = *(const PG8_LAS cvf2*)(cv_lds + cv_slot + 512 + lane * 8); \
        cvo0[dw] = (unsigned)__builtin_amdgcn_cvt_pk_fp8_f32(ra_.x * CV::SCALE, rb_.x * CV::SCALE, (int)cvo0[dw], hi); \
        cvo1[dw] = (unsigned)__builtin_amdgcn_cvt_pk_fp8_f32(ra_.y * CV::SCALE, rb_.y * CV::SCALE, (int)cvo1[dw], hi); } } while (0)
#define CV_ST() do { if constexpr (CV::ON) { unsigned char* p_ = cv_ws + cv_stb; *(__attribute__((address_space(1))) cvu2*)(p_ + cv_stv) = cvo0; *(__attribute__((address_space(1))) cvu2*)(p_ + (cv_stdn ? 1024u : 2048u) + cv_stv) = cvo1; } } while (0)
    if constexpr (SP2) {
        PG8_STAGE(PG8_SB(0, 0), cB, voffB); PG8_STAGE(PG8_SB(0, 1), cB + hstep, voffB); PG8_STAGE(PG8_SA(0, 0), cA, voffA); PG8_STAGE(PG8_SA(0, 1), cA + hstep, voffA);
        if (wr == 1) PG8_BAR;
        PG8_WAIT_V(2); PG8_BAR;
        PG8_STAGE(PG8_SB(1, 0), cB + kstep, voffB); PG8_STAGE(PG8_SA(1, 0), cA + kstep, voffA); PG8_STAGE(PG8_SB(1, 1), cB + hstep + kstep, voffB);
        PG8_WAIT_V(6); PG8_BAR;
    } else {
        PG8_STAGE(PG8_SB(0, 0), cB, voffB); PG8_STAGE(PG8_SA(0, 0), cA, voffA); PG8_STAGE(PG8_SB(0, 1), cB + hstep, voffB); PG8_STAGE(PG8_SA(0, 1), cA + hstep, voffA);
        if (wr == 1) PG8_BAR;
        PG8_WAIT_V(4); PG8_BAR;
        PG8_STAGE(PG8_SB(1, 0), cB + kstep, voffB); PG8_STAGE(PG8_SA(1, 0), cA + kstep, voffA); PG8_STAGE(PG8_SB(1, 1), cB + hstep + kstep, voffB);
        PG8_WAIT_V(6); PG8_BAR;
    }
    for (;;) {
        const bool has_next = S.next(ui + 1, nxt);
        const char* nA = has_next ? (const char*)g.A + (size_t)nxt.pm * tstep : cA; const char* nB = has_next ? (const char*)g.Bt + (size_t)nxt.pn * tstep : cB;
#pragma clang loop unroll(disable)
        for (int t = 0; t < nt; t += 2) {
            const bool last = (t == nt - 2);
            const char* a1 = cA + (size_t)(t + 1) * kstep;
            const char* a2 = last ? nA : cA + (size_t)(t + 2) * kstep; const char* b2 = last ? nB : cB + (size_t)(t + 2) * kstep;
            const char* a3 = a2 + kstep; const char* b3 = b2 + kstep;
            if (last && has_next) S.a_ready(nxt);
            if constexpr (SP2) {
            PG8_LDB(B0, 0, 0); PG8_LDB(B1, 0, 1); PG8_SCHED; PG8_LDA(At, 0, 0); PG8_STAGE(PG8_SA(1, 1), a1 + hstep, voffA); CV_LD(0);
            if constexpr (CV::ON) PG8_WAIT_V(10); else PG8_WAIT_V(8);
            PG8_WAIT_L(0); PG8_BAR; PG8_MMA(0, 0, At, B0); PG8_MMA(0, 1, At, B1); CV_CVT(2, 1, false); PG8_BAR; PG8_SCHED;
            PG8_LDA(At, 0, 1); PG8_STAGE(PG8_SB(0, 0), b2, voffB); PG8_STAGE(PG8_SB(0, 1), b2 + hstep, voffB); PG8_STAGE(PG8_SA(0, 0), a2, voffA); CV_LD(1);
            if constexpr (CV::ON) PG8_WAIT_V(10); else PG8_WAIT_V(8);
            PG8_WAIT_L(0); PG8_BAR; if (!skip1) { PG8_MMA(1, 0, At, B0); PG8_MMA(1, 1, At, B1); } CV_CVT(3, 1, true); PG8_BAR; PG8_SCHED;
            CV_ST(); if constexpr (CV::ON) { cv_stb = cv_db + 4 * t; cv_stdn = cv_dn; cv_stv = cv_dv; }
            PG8_LDB(B0, 1, 0); PG8_LDB(B1, 1, 1); PG8_SCHED; PG8_LDA(At, 1, 0); PG8_STAGE(PG8_SA(0, 1), a2 + hstep, voffA); CV_LD(2);
            if constexpr (CV::ON) PG8_WAIT_V(12); else PG8_WAIT_V(8);
            PG8_WAIT_L(0); PG8_BAR; PG8_MMA(0, 0, At, B0); PG8_MMA(0, 1, At, B1); CV_CVT(0, 0, false); PG8_BAR; PG8_SCHED;
            PG8_LDA(At, 1, 1); PG8_STAGE(PG8_SB(1, 0), b3, voffB); PG8_STAGE(PG8_SB(1, 1), b3 + hstep, voffB); PG8_STAGE(PG8_SA(1, 0), a3, voffA); CV_LD(3);
            if constexpr (CV::ON) PG8_WAIT_V(12); else PG8_WAIT_V(8);
            PG8_WAIT_L(0); PG8_BAR; if (!skip1) { PG8_MMA(1, 0, At, B0); PG8_MMA(1, 1, At, B1); } CV_CVT(1, 0, true); PG8_BAR; PG8_SCHED;
            if constexpr (CV::ON) cv_sb += cv_dn ? 65536 : 32768;
            } else {
            PG8_LDB(B0, 0, 0); PG8_SCHED; PG8_LDA(At, 0, 0); PG8_STAGE(PG8_SA(1, 1), a1 + hstep, voffA);
            PG8_WAIT_L(8); PG8_BAR; PG8_WAIT_L(0); PG8_MMA(0, 0, At, B0); PG8_BAR; PG8_SCHED;
            PG8_LDB(B1, 0, 1); PG8_STAGE(PG8_SB(0, 0), b2, voffB);
            PG8_BAR; PG8_WAIT_L(0); PG8_MMA(0, 1, At, B1); PG8_BAR;
            PG8_LDA(At, 0, 1); PG8_STAGE(PG8_SA(0, 0), a2, voffA);
            PG8_BAR; PG8_WAIT_L(0); PG8_MMA(1, 0, At, B0); PG8_BAR; PG8_SCHED;
            PG8_STAGE(PG8_SB(0, 1), b2 + hstep, voffB);
            PG8_WAIT_V(6); PG8_BAR; PG8_MMA(1, 1, At, B1); PG8_BAR;
            PG8_LDB(B0, 1, 0); PG8_SCHED; PG8_LDA(At, 1, 0); PG8_STAGE(PG8_SA(0, 1), a2 + hstep, voffA);
            PG8_WAIT_L(8); PG8_BAR; PG8_WAIT_L(0); PG8_MMA(0, 0, At, B0); PG8_BAR; PG8_SCHED;
            PG8_LDB(B1, 1, 1); PG8_STAGE(PG8_SB(1, 0), b3, voffB);
            PG8_BAR; PG8_WAIT_L(0); PG8_MMA(0, 1, At, B1); PG8_BAR;
            PG8_LDA(At, 1, 1); PG8_STAGE(PG8_SA(1, 0), a3, voffA);
            PG8_BAR; PG8_WAIT_L(0); PG8_MMA(1, 0, At, B0); PG8_BAR; PG8_SCHED;
            PG8_STAGE(PG8_SB(1, 1), b3 + hstep, voffB);
            PG8_WAIT_V(6); PG8_BAR; PG8_MMA(1, 1, At, B1); PG8_BAR;
            }
        }
        if constexpr (F8) asm volatile("s_nop 15\n\ts_nop 7" ::: "memory");
        if constexpr (ALIGN_EPI) { if (wr == 0) PG8_BAR; }
        if constexpr (!Epi::AFTER_DRAIN) { int fr_ = fr, fq_ = fq; asm volatile("" : "+v"(fr_), "+v"(fq_));
            E(acc, cur, wr, wc, fr_, fq_); S.done(cur); }
        if (!has_next) break;
#pragma unroll
        for (int a = 0; a < 2; ++a)
#pragma unroll
            for (int b = 0; b < 2; ++b)
#pragma unroll
                for (int m = 0; m < 4; ++m)
#pragma unroll
                    for (int n = 0; n < 2; ++n) acc[a][b][m][n] = (f32x4){0.f, 0.f, 0.f, 0.f};
        cur = nxt; cA = nA; cB = nB; ++ui; skip1 = S.rows(cur) <= HALF;
        if constexpr (CV::ON) cv.decode(cur, wid, lane, cv_sb, cv_dn, cv_db, cv_dv, cv_sv);
        if constexpr (ALIGN_EPI) { if (wr == 1) PG8_BAR; }
    }
    PG8_WAIT_V(0);
    if constexpr (CV::ON) { cv_slot = cv_slot == 2048u ? 0u : cv_slot + 1024u; CV_CVT(2, 1, false); cv_slot = cv_slot == 2048u ? 0u : cv_slot + 1024u; CV_CVT(3, 1, true); CV_ST(); }
    if constexpr (!ALIGN_EPI) { if (wr == 0) PG8_BAR; }
    PG8_BAR;
    if constexpr (Epi::AFTER_DRAIN) { E.fused(acc, cur, wr, wc, fr, fq, lds, wid, lane); S.done(cur); }
#undef PG8_SA
#undef PG8_SB
#undef PG8_STAGE
#undef PG8_LDA
#undef PG8_LDB
#undef PG8_MMA
#undef PG8_CAT8
#undef PG8_WAIT_V
#undef PG8_WAIT_L
#undef PG8_BAR
#undef PG8_SCHED
#undef CV_LD
#undef CV_CVT
#undef CV_ST
}
}

namespace pg8 {
__device__ __forceinline__ void store16_wt(void* p, u32x4 v) { asm volatile("global_store_dwordx4 %0, %1, off sc1\n\ts_nop 1" :: "v"(p), "v"(v) : "memory"); }
__device__ __forceinline__ float clamp_f8(float v) { return __builtin_fminf(__builtin_fmaxf(v, -448.f), 448.f); }
__device__ __forceinline__ unsigned cvt4_fp8(float a, float b, float c, float d) { int w = 0; w = __builtin_amdgcn_cvt_pk_fp8_f32(a, b, w, false); w = __builtin_amdgcn_cvt_pk_fp8_f32(c, d, w, true); return (unsigned)w; }
__device__ __forceinline__ unsigned cvt4_fp8c(float a, float b, float c, float d) { return cvt4_fp8(clamp_f8(a), clamp_f8(b), clamp_f8(c), clamp_f8(d)); }
struct EpiInProj {
    static constexpr bool PERM = true, AFTER_DRAIN = false;
    bf16_t* O; int ldc; float* DT;
    __device__ __forceinline__ void operator()(const f32x4 (&acc)[2][2][4][2], const Unit& u, int wr, int wc, int fr, int fq) const {
        const int row0 = u.pm * BM + wr * 64 + fr;
        if (u.pn == 22) {
            if (wc == 0 && fq < 2) {
#pragma unroll
                for (int ai = 0; ai < 2; ++ai)
#pragma unroll
                    for (int m = 0; m < 4; ++m) { float* dp = DT + (size_t)(row0 + ai * HALF + m * 16) * 16 + 8 * fq; *(f32x4*)dp = acc[ai][0][m][0]; *(f32x4*)(dp + 4) = acc[ai][0][m][1]; } }
            return; }
        const int col0 = u.pn * BM + wc * 32 + 8 * fq;
#pragma unroll
        for (int ai = 0; ai < 2; ++ai)
#pragma unroll
            for (int m = 0; m < 4; ++m) { bf16_t* rowp = O + (size_t)(row0 + ai * HALF + m * 16) * ldc + col0;
#pragma unroll
                for (int bj = 0; bj < 2; ++bj) { const f32x4 v0 = acc[ai][bj][m][0], v1 = acc[ai][bj][m][1];
                    u32x4 w; w.x = cvt_pk_bf16(v0[0], v0[1]); w.y = cvt_pk_bf16(v0[2], v0[3]); w.z = cvt_pk_bf16(v1[0], v1[1]); w.w = cvt_pk_bf16(v1[2], v1[3]);
                    *(u32x4*)(rowp + bj * HALF) = w; } }
    }
};
struct EpiResid {
    static constexpr bool PERM = true, AFTER_DRAIN = false;
    const float* base; bf16_t* hb; unsigned char* h8; int ldc; const float* cs;
    __device__ __forceinline__ void operator()(const f32x4 (&acc)[2][2][4][2], const Unit& u, int wr, int wc, int fr, int fq) const {
        const int row0 = u.pm * BM + wr * 64 + fr, col0 = u.pn * BM + wc * 32 + 8 * fq;
        typedef unsigned u32x2_t __attribute__((ext_vector_type(2)));
        f32x4 csv[2][2];
#pragma unroll
        for (int bj = 0; bj < 2; ++bj) { csv[bj][0] = *(const f32x4*)(cs + col0 + bj * HALF); csv[bj][1] = *(const f32x4*)(cs + col0 + bj * HALF + 4); }
#pragma unroll
        for (int ai = 0; ai < 2; ++ai) {
            f32x4 xr[4][2][2];
#pragma unroll
            for (int m = 0; m < 4; ++m) { const size_t off = (size_t)(row0 + ai * HALF + m * 16) * ldc + col0;
#pragma unroll
                for (int bj = 0; bj < 2; ++bj) { xr[m][bj][0] = __builtin_nontemporal_load((const f32x4*)(base + off + bj * HALF)); xr[m][bj][1] = __builtin_nontemporal_load((const f32x4*)(base + off + bj * HALF + 4)); } }
#pragma unroll
            for (int m = 0; m < 4; ++m) { const size_t off = (size_t)(row0 + ai * HALF + m * 16) * ldc + col0;
#pragma unroll
                for (int bj = 0; bj < 2; ++bj) {
                    const f32x4 v0 = acc[ai][bj][m][0] + xr[m][bj][0], v1 = acc[ai][bj][m][1] + xr[m][bj][1];
                    u32x4 w; w.x = cvt_pk_bf16(v0[0], v0[1]); w.y = cvt_pk_bf16(v0[2], v0[3]); w.z = cvt_pk_bf16(v1[0], v1[1]); w.w = cvt_pk_bf16(v1[2], v1[3]);
                    *(u32x4*)(hb + off + bj * HALF) = w;
                    const f32x4 s0 = v0 * csv[bj][0], s1 = v1 * csv[bj][1];
                    u32x2_t q; q.x = cvt4_fp8c(s0[0], s0[1], s0[2], s0[3]); q.y = cvt4_fp8c(s1[0], s1[1], s1[2], s1[3]);
                    *(u32x2_t*)(h8 + off + bj * HALF) = q; } }
        }
    }
};
struct ExpertScale {
    const PG8_LAS int* tab; const float* lst; int lcap;
    __device__ __forceinline__ int rows(const Unit& u) const { const int e = u.pn >> 3; return tab[80 + e] - (u.pm - tab[40 + e]) * BM; }
    __device__ __forceinline__ float at(const Unit& u, int rowlocal) const { const int e = u.pn >> 3, p = (u.pm - tab[40 + e]) * BM + rowlocal; return p < tab[80 + e] ? lst[(size_t)e * lcap + p] : 0.f; }
};
struct EpiGateUp {
    static constexpr bool PERM = true, AFTER_DRAIN = false;
    unsigned char* O; int ldc; ExpertScale rs; float wsc;
    __device__ __forceinline__ void operator()(const f32x4 (&acc)[2][2][4][2], const Unit& u, int wr, int wc, int fr, int fq) const {
        const int rl0 = wr * 64 + fr, col0 = (u.pn & 7) * HALF + wc * 32 + 8 * fq;
        float rsc[2][4];
#pragma unroll
        for (int ai = 0; ai < 2; ++ai)
#pragma unroll
            for (int m = 0; m < 4; ++m) rsc[ai][m] = rs.at(u, rl0 + ai * HALF + m * 16) * wsc;
        const bool half_only = rs.rows(u) <= HALF;
#pragma unroll
        for (int ai = 0; ai < 2; ++ai) { if (ai == 1 && half_only) continue;
#pragma unroll
            for (int m = 0; m < 4; ++m) { const int rl = rl0 + ai * HALF + m * 16; const float r = rsc[ai][m];
                float hv[8];
#pragma unroll
                for (int n = 0; n < 2; ++n)
#pragma unroll
                    for (int j = 0; j < 4; ++j) { const float g = acc[ai][0][m][n][j] * r, up = acc[ai][1][m][n][j] * r; hv[n * 4 + j] = g * __builtin_amdgcn_rcpf(1.f + __builtin_amdgcn_exp2f(-1.44269504089f * g)) * up; }
                typedef unsigned u32x2_t __attribute__((ext_vector_type(2))); u32x2_t q; q.x = cvt4_fp8c(hv[0], hv[1], hv[2], hv[3]); q.y = cvt4_fp8c(hv[4], hv[5], hv[6], hv[7]);
                *(u32x2_t*)(O + (size_t)(u.pm * BM + rl) * ldc + col0) = q; } }
    }
};
struct EpiRowScale {
    static constexpr bool PERM = true, AFTER_DRAIN = false;
    unsigned char* O; int ldc; ExpertScale rs; float wsc;
    __device__ __forceinline__ void operator()(const f32x4 (&acc)[2][2][4][2], const Unit& u, int wr, int wc, int fr, int fq) const {
        const int rl0 = wr * 64 + fr, col0 = (u.pn & 7) * BM + wc * 64 + 16 * fq;
        float rsc[2][4];
#pragma unroll
        for (int ai = 0; ai < 2; ++ai)
#pragma unroll
            for (int m = 0; m < 4; ++m) rsc[ai][m] = rs.at(u, rl0 + ai * HALF + m * 16) * wsc;
        const bool half_only = rs.rows(u) <= HALF;
#pragma unroll
        for (int ai = 0; ai < 2; ++ai) { if (ai == 1 && half_only) continue;
#pragma unroll
            for (int m = 0; m < 4; ++m) { const int rl = rl0 + ai * HALF + m * 16; const float r = rsc[ai][m];
                const f32x4 v0 = acc[ai][0][m][0] * r, v1 = acc[ai][0][m][1] * r, v2 = acc[ai][1][m][0] * r, v3 = acc[ai][1][m][1] * r;
                u32x4 q; q.x = cvt4_fp8c(v0[0], v0[1], v0[2], v0[3]); q.y = cvt4_fp8c(v1[0], v1[1], v1[2], v1[3]); q.z = cvt4_fp8c(v2[0], v2[1], v2[2], v2[3]); q.w = cvt4_fp8c(v3[0], v3[1], v3[2], v3[3]);
                *(u32x4*)(O + (size_t)(u.pm * BM + rl) * ldc + col0) = q; } }
    }
};
struct ExpertOrder {
    const PG8_LAS int* tab; int nwg, G, c;
    __device__ __forceinline__ void init(const PG8_LAS int* t, int G_, int c_) { tab = t; nwg = t[32]; G = G_; c = c_; }
    __device__ __forceinline__ bool next(int i, Unit& u) const {
        const long L = (long)i * G + c; if (L >= nwg) return false;
        int wgid = (int)L; { const int q = nwg / NXCD, r = nwg % NXCD, xcd = wgid % NXCD, off = wgid / NXCD; wgid = (xcd < r ? xcd * (q + 1) : r * (q + 1) + (xcd - r) * q) + off; }
        const int tj = tab[threadIdx.x & 31];
        const int e = __builtin_popcountll(__ballot(wgid >= tj) & 0xffffffffull) - 1;
        const int local_i = wgid - tab[e], mt = (tab[e + 1] - tab[e]) >> 3;
        u.pm = tab[40 + e] + local_i % mt; u.pn = e * 8 + local_i / mt; return true;
    }
    __device__ __forceinline__ int rows(const Unit& u) const { const int e = u.pn >> 3; return tab[80 + e] - (u.pm - tab[40 + e]) * BM; }
    __device__ __forceinline__ void a_ready(const Unit&) const {}
    __device__ __forceinline__ void done(const Unit&) const {}
};
struct TeamOrder {
    int c, i0, i1;
    __device__ __forceinline__ bool next(int i, Unit& u) const {
        i += i0; if (i >= i1) return false;
        const int xcd = c & 7, l = c >> 3; if (i * 32 + l >= 184) return false;
        int pmo, pn;
        if (i < 5) { const int t = l >> 3, j = l & 7; pmo = 4 * (t & 1) + (j & 3); pn = 4 * i + 2 * (t >> 1) + (j >> 2); }
        else { pmo = l & 7; pn = 20 + (l >> 3); }
        u.pm = 8 * xcd + pmo; u.pn = pn; return true;
    }
    __device__ __forceinline__ int rows(const Unit&) const { return BM; }
    __device__ __forceinline__ void a_ready(const Unit&) const {}
    __device__ __forceinline__ void done(const Unit&) const {}
};
template <class KArgs, int IN_GATE, size_t WGU_OFF, size_t WD_OFF, size_t DUMMY, int LDSOFF> struct ConvMoE {
    static constexpr bool ON = true; static constexpr float SCALE = 64.f;
    static constexpr unsigned DUMMY_OFF = (unsigned)DUMMY; static constexpr int LDS_OFF = LDSOFF; static constexpr int nN = 23;
    static_assert(WD_OFF + 64u * 1024 * 1024 < (1ull << 32) && DUMMY < (1ull << 32), "32-bit workspace offsets");
    __device__ __forceinline__ unsigned char* wsbase() const { const KArgs a = (KArgs)__builtin_amdgcn_kernarg_segment_ptr(); return a->ws; }
    __device__ __forceinline__ void decode(const Unit& u, int wid, int lane, const char*& sb, int& dn, unsigned& db, unsigned& dv, unsigned& sv) const {
        const KArgs a = (KArgs)__builtin_amdgcn_kernarg_segment_ptr();
        const int cb = (u.pm * nN + u.pn) * 8 + wid, nl = 2 * lane;
        if (cb < 8192) { const int up = cb >> 12, r = cb & 4095, e = r >> 7, kb = (r >> 3) & 15, nb = r & 7;
            sb = (const char*)((const float*)a->in[IN_GATE + up] + (size_t)e * 2048 * 1024 + (size_t)(128 * kb) * 1024 + 128 * nb); dn = 0;
            db = (unsigned)(WGU_OFF + (size_t)e * 2048 * 2048 + (size_t)(nb * 256 + up * 128) * 2048 + 128 * kb); dv = (unsigned)nl * 2048u; sv = (unsigned)(lane >> 5) * 4096u + (unsigned)(lane & 31) * 16u; }
        else { const int r = cb - 8192, e = r >> 7, kb = (r >> 4) & 7, nb = r & 15;
            sb = (const char*)((const float*)a->in[IN_GATE + 2] + (size_t)e * 1024 * 2048 + (size_t)(128 * kb) * 2048 + 128 * nb); dn = 1;
            db = (unsigned)(WD_OFF + (size_t)e * 2048 * 1024 + (size_t)(256 * (nb >> 1)) * 1024 + 128 * kb);
            dv = (unsigned)(((nl >> 3) & 1) * 128 + (2 * (nb & 1) + (nl >> 6)) * 32 + ((nl >> 4) & 3) * 8 + (nl & 7)) * 1024u; sv = (unsigned)(lane >> 5) * 8192u + (unsigned)(lane & 31) * 16u; }
    }
};
}

namespace pg8 {
template <class Epi, class Sched, class RowSrc, bool ALIGN_EPI = false, bool SP2 = false, bool F8 = false>
__device__ __forceinline__ void gemm_phase_g(PG8_LAS unsigned char* lds, const Gemm g, const Sched& S, const Epi& E, const RowSrc& RS) {
    const int tid = threadIdx.x, wid = __builtin_amdgcn_readfirstlane(tid >> 6), lane = tid & 63, wr = wid >> 2, wc = wid & 3, fr = lane & 15, fq = lane >> 4;
    const int K = g.K, nt = K / BK;
    unsigned voffB[2]; unsigned vC0[2], vC1[2], vN0[2], vN1[2]; int Rr[2], Cc[2];
#pragma unroll
    for (int i = 0; i < 2; ++i) { int R, C; stage_rc(tid * 16 + i * 8192, R, C); const int Rb = Epi::PERM ? ((R & ~31) + perm32(R & 31)) : R;
        Rr[i] = R; Cc[i] = C; voffB[i] = (unsigned)(Rb * K + C) * 2u; }
    const size_t kstep = (size_t)(BK * 2);
    const size_t hstep = (size_t)HALF * K * 2;
    const size_t tstep = 2 * hstep;
    const unsigned ldsw = (unsigned)wid * 1024u;
    const int aoff = lds_byte(wr * 64 + fr, fq * 8), boff = lds_byte(wc * 32 + fr, fq * 8);
#define PG8_CAT8(x, y) __builtin_bit_cast(v8i_t, __builtin_shufflevector((x), (y), 0, 1, 2, 3, 4, 5, 6, 7, 8, 9, 10, 11, 12, 13, 14, 15))
#define PG8_SA(b, h) (((b) * 2 + (h)) * HTB)
#define PG8_SB(b, h) ((4 + (b) * 2 + (h)) * HTB)
#define PG8_STAGE(bufoff, gbase, voff) do { _Pragma("unroll") for (int _i = 0; _i < 2; ++_i) \
        __builtin_amdgcn_global_load_lds((const unsigned*)((const char*)(gbase) + (voff)[_i]), (PG8_LAS unsigned*)(lds + (bufoff) + ldsw + _i * 8192), 16, 0, 0); } while (0)
#define PG8_LDA(dst, b, h) do { if constexpr (F8) { _Pragma("unroll") for (int m = 0; m < 4; ++m) dst##8[m] = PG8_CAT8(*(const PG8_LAS bf16x8*)(lds + PG8_SA(b, h) + aoff + m * 2048), *(const PG8_LAS bf16x8*)(lds + PG8_SA(b, h) + aoff + m * 2048 + 1024)); } else _Pragma("unroll") for (int m = 0; m < 4; ++m) _Pragma("unroll") for (int k = 0; k < 2; ++k) dst[m][k] = *(const PG8_LAS bf16x8*)(lds + PG8_SA(b, h) + aoff + m * 2048 + k * 1024); } while (0)
#define PG8_LDB(dst, b, h) do { if constexpr (F8) { _Pragma("unroll") for (int n = 0; n < 2; ++n) dst##8[n] = PG8_CAT8(*(const PG8_LAS bf16x8*)(lds + PG8_SB(b, h) + boff + n * 2048), *(const PG8_LAS bf16x8*)(lds + PG8_SB(b, h) + boff + n * 2048 + 1024)); } else _Pragma("unroll") for (int n = 0; n < 2; ++n) _Pragma("unroll") for (int k = 0; k < 2; ++k) dst[n][k] = *(const PG8_LAS bf16x8*)(lds + PG8_SB(b, h) + boff + n * 2048 + k * 1024); } while (0)
#define PG8_MMA(ai, bj, At, Bt) do { __builtin_amdgcn_s_setprio(1); \
        if constexpr (F8) { _Pragma("unroll") for (int m = 0; m < 4; ++m) _Pragma("unroll") for (int n = 0; n < 2; ++n) \
            asm volatile("v_mfma_f32_16x16x128_f8f6f4 %0, %1, %2, %0" : "+v"(acc[ai][bj][m][n]) : "v"(Bt##8[n]), "v"(At##8[m])); }     \
        else { _Pragma("unroll") for (int m = 0; m < 4; ++m) _Pragma("unroll") for (int n = 0; n < 2; ++n) _Pragma("unroll") for (int k = 0; k < 2; ++k) \
            acc[ai][bj][m][n] = __builtin_amdgcn_mfma_f32_16x16x32_bf16(Bt[n][k], At[m][k], acc[ai][bj][m][n], 0, 0, 0); } \
        __builtin_amdgcn_s_setprio(0); } while (0)
#define PG8_WAIT_V(n) asm volatile("s_waitcnt vmcnt(" #n ")" ::: "memory")
#define PG8_WAIT_L(n) asm volatile("s_waitcnt lgkmcnt(" #n ")" ::: "memory")
#define PG8_BAR __builtin_amdgcn_s_barrier()
#define PG8_SCHED __builtin_amdgcn_sched_barrier(0)
    Unit cur, nxt; int ui = 0;
    if (!S.next(0, cur)) return;
    bool skip1 = S.rows(cur) <= HALF;
    f32x4 acc[2][2][4][2];
#pragma unroll
    for (int a = 0; a < 2; ++a)
#pragma unroll
        for (int b = 0; b < 2; ++b)
#pragma unroll
            for (int m = 0; m < 4; ++m)
#pragma unroll
                for (int n = 0; n < 2; ++n) acc[a][b][m][n] = (f32x4){0.f, 0.f, 0.f, 0.f};
    bf16x8 At[4][2], B0[2][2], B1[2][2];
    v8i_t At8[4], B08[2], B18[2];
    const char* cA = (const char*)g.A; const char* cB = (const char*)g.Bt + (size_t)cur.pn * tstep;
    RS.rows(cur, Rr, Cc, K, vC0, vC1);
    S.a_ready(cur);
    if constexpr (SP2) {
        PG8_STAGE(PG8_SB(0, 0), cB, voffB); PG8_STAGE(PG8_SB(0, 1), cB + hstep, voffB); PG8_STAGE(PG8_SA(0, 0), cA, vC0); PG8_STAGE(PG8_SA(0, 1), cA, vC1);
        if (wr == 1) PG8_BAR;
        PG8_WAIT_V(2); PG8_BAR;
        PG8_STAGE(PG8_SB(1, 0), cB + kstep, voffB); PG8_STAGE(PG8_SA(1, 0), cA + kstep, vC0); PG8_STAGE(PG8_SB(1, 1), cB + hstep + kstep, voffB);
        PG8_WAIT_V(6); PG8_BAR;
    } else {
        PG8_STAGE(PG8_SB(0, 0), cB, voffB); PG8_STAGE(PG8_SA(0, 0), cA, vC0); PG8_STAGE(PG8_SB(0, 1), cB + hstep, voffB); PG8_STAGE(PG8_SA(0, 1), cA, vC1);
        if (wr == 1) PG8_BAR;
        PG8_WAIT_V(4); PG8_BAR;
        PG8_STAGE(PG8_SB(1, 0), cB + kstep, voffB); PG8_STAGE(PG8_SA(1, 0), cA + kstep, vC0); PG8_STAGE(PG8_SB(1, 1), cB + hstep + kstep, voffB);
        PG8_WAIT_V(6); PG8_BAR;
    }
    for (;;) {
        const bool has_next = S.next(ui + 1, nxt);
        const char* nA = cA; const char* nB = has_next ? (const char*)g.Bt + (size_t)nxt.pn * tstep : cB;
        if (has_next) RS.rows(nxt, Rr, Cc, K, vN0, vN1); else { vN0[0] = vC0[0]; vN0[1] = vC0[1]; vN1[0] = vC1[0]; vN1[1] = vC1[1]; }
        for (int t = 0; t < nt; t += 2) {
            const bool last = (t == nt - 2);
            const char* a1 = cA + (size_t)(t + 1) * kstep;
            const char* a2 = last ? nA : cA + (size_t)(t + 2) * kstep; const char* b2 = last ? nB : cB + (size_t)(t + 2) * kstep;
            const char* a3 = a2 + kstep; const char* b3 = b2 + kstep;
            const unsigned v20[2] = {last ? vN0[0] : vC0[0], last ? vN0[1] : vC0[1]}, v21[2] = {last ? vN1[0] : vC1[0], last ? vN1[1] : vC1[1]};
            if (last && has_next) S.a_ready(nxt);
            if constexpr (SP2) {
            PG8_LDB(B0, 0, 0); PG8_LDB(B1, 0, 1); PG8_SCHED; PG8_LDA(At, 0, 0); PG8_STAGE(PG8_SA(1, 1), a1, vC1);
            PG8_WAIT_V(8); PG8_WAIT_L(0); PG8_BAR; PG8_MMA(0, 0, At, B0); PG8_MMA(0, 1, At, B1); PG8_BAR; PG8_SCHED;
            PG8_LDA(At, 0, 1); PG8_STAGE(PG8_SB(0, 0), b2, voffB); PG8_STAGE(PG8_SB(0, 1), b2 + hstep, voffB); PG8_STAGE(PG8_SA(0, 0), a2, v20);
            PG8_WAIT_V(8); PG8_WAIT_L(0); PG8_BAR; if (!skip1) { PG8_MMA(1, 0, At, B0); PG8_MMA(1, 1, At, B1); } PG8_BAR; PG8_SCHED;
            PG8_LDB(B0, 1, 0); PG8_LDB(B1, 1, 1); PG8_SCHED; PG8_LDA(At, 1, 0); PG8_STAGE(PG8_SA(0, 1), a2, v21);
            PG8_WAIT_V(8); PG8_WAIT_L(0); PG8_BAR; PG8_MMA(0, 0, At, B0); PG8_MMA(0, 1, At, B1); PG8_BAR; PG8_SCHED;
            PG8_LDA(At, 1, 1); PG8_STAGE(PG8_SB(1, 0), b3, voffB); PG8_STAGE(PG8_SB(1, 1), b3 + hstep, voffB); PG8_STAGE(PG8_SA(1, 0), a3, v20);
            PG8_WAIT_V(8); PG8_WAIT_L(0); PG8_BAR; if (!skip1) { PG8_MMA(1, 0, At, B0); PG8_MMA(1, 1, At, B1); } PG8_BAR; PG8_SCHED;
            } else {
            PG8_LDB(B0, 0, 0); PG8_SCHED; PG8_LDA(At, 0, 0); PG8_STAGE(PG8_SA(1, 1), a1, vC1);
            PG8_WAIT_L(8); PG8_BAR; PG8_WAIT_L(0); PG8_MMA(0, 0, At, B0); PG8_BAR; PG8_SCHED;
            PG8_LDB(B1, 0, 1); PG8_STAGE(PG8_SB(0, 0), b2, voffB);
            PG8_BAR; PG8_WAIT_L(0); PG8_MMA(0, 1, At, B1); PG8_BAR;
            PG8_LDA(At, 0, 1); PG8_STAGE(PG8_SA(0, 0), a2, v20);
            PG8_BAR; PG8_WAIT_L(0); PG8_MMA(1, 0, At, B0); PG8_BAR; PG8_SCHED;
            PG8_STAGE(PG8_SB(0, 1), b2 + hstep, voffB);
            PG8_WAIT_V(6); PG8_BAR; PG8_MMA(1, 1, At, B1); PG8_BAR;
            PG8_LDB(B0, 1, 0); PG8_SCHED; PG8_LDA(At, 1, 0); PG8_STAGE(PG8_SA(0, 1), a2, v21);
            PG8_WAIT_L(8); PG8_BAR; PG8_WAIT_L(0); PG8_MMA(0, 0, At, B0); PG8_BAR; PG8_SCHED;
            PG8_LDB(B1, 1, 1); PG8_STAGE(PG8_SB(1, 0), b3, voffB);
            PG8_BAR; PG8_WAIT_L(0); PG8_MMA(0, 1, At, B1); PG8_BAR;
            PG8_LDA(At, 1, 1); PG8_STAGE(PG8_SA(1, 0), a3, v20);
            PG8_BAR; PG8_WAIT_L(0); PG8_MMA(1, 0, At, B0); PG8_BAR; PG8_SCHED;
            PG8_STAGE(PG8_SB(1, 1), b3 + hstep, voffB);
            PG8_WAIT_V(6); PG8_BAR; PG8_MMA(1, 1, At, B1); PG8_BAR;
            }
        }
        if constexpr (F8) asm volatile("s_nop 15\n\ts_nop 7" ::: "memory");
        if constexpr (ALIGN_EPI) { if (wr == 0) PG8_BAR; }
        if constexpr (!Epi::AFTER_DRAIN) { E(acc, cur, wr, wc, fr, fq); S.done(cur); }
        if (!has_next) break;
#pragma unroll
        for (int a = 0; a < 2; ++a)
#pragma unroll
            for (int b = 0; b < 2; ++b)
#pragma unroll
                for (int m = 0; m < 4; ++m)
#pragma unroll
                    for (int n = 0; n < 2; ++n) acc[a][b][m][n] = (f32x4){0.f, 0.f, 0.f, 0.f};
        cur = nxt; cA = nA; cB = nB; ++ui; skip1 = S.rows(cur) <= HALF; vC0[0] = vN0[0]; vC0[1] = vN0[1]; vC1[0] = vN1[0]; vC1[1] = vN1[1];
        if constexpr (ALIGN_EPI) { if (wr == 1) PG8_BAR; }
    }
    PG8_WAIT_V(0);
    if constexpr (!ALIGN_EPI) { if (wr == 0) PG8_BAR; }
    PG8_BAR;
    if constexpr (Epi::AFTER_DRAIN) { E.fused(acc, cur, wr, wc, fr, fq, lds, wid, lane); S.done(cur); }
#undef PG8_SA
#undef PG8_SB
#undef PG8_STAGE
#undef PG8_LDA
#undef PG8_LDB
#undef PG8_MMA
#undef PG8_CAT8
#undef PG8_WAIT_V
#undef PG8_WAIT_L
#undef PG8_BAR
#undef PG8_SCHED
}

struct ExpertRows {
    const PG8_LAS int* tab; const int* lst_tok; int lcap;
    __device__ __forceinline__ void rows(const Unit& u, const int (&Rr)[2], const int (&Cc)[2], int K, unsigned (&v0)[2], unsigned (&v1)[2]) const {
        const int e = u.pn >> 3, mi = u.pm - tab[40 + e], cnt = tab[80 + e];
#pragma unroll
        for (int i = 0; i < 2; ++i) { const int p0 = mi * BM + Rr[i], p1 = p0 + HALF;
            const int t0 = p0 < cnt ? lst_tok[(size_t)e * lcap + p0] : 0, t1 = p1 < cnt ? lst_tok[(size_t)e * lcap + p1] : 0;
            v0[i] = (unsigned)(t0 * K + Cc[i]) * 2u; v1[i] = (unsigned)(t1 * K + Cc[i]) * 2u; }
    }
};
}

#ifndef PG8_SP2
#define PG8_SP2 true
#endif
#ifndef PG8_ALIGN
#define PG8_ALIGN true
#endif

namespace attn_body {
using bf16=__hip_bfloat16;
using bf16x8=__attribute__((ext_vector_type(8)))short;
using s16x4=__attribute__((ext_vector_type(4)))short;
using f32x16=__attribute__((ext_vector_type(16)))float;
using u32x4=__attribute__((ext_vector_type(4)))unsigned;
constexpr int SEQ=2048,D=64,QP=1024,KP=1024,VP=5632,OP=1024;
constexpr int NW=8,QBLK=32,QB=QBLK*NW,KVBLK=64,NQB=SEQ/QB;
constexpr int ATTN_UNIT_ROWS=QB;
__device__ __forceinline__ int crow(int r,int hi){return (r&3)+8*(r>>2)+4*hi;}
#define SBAR() __builtin_amdgcn_sched_barrier(0)
__device__ __forceinline__ void cmask(f32x16&p0,f32x16&p1,int jb,int qrel,int hi){
  const float NEG=-INFINITY; int kb=64*jb+4*hi;
  #pragma unroll
  for(int r=0;r<16;++r){int kv=kb+(r&3)+8*(r>>2); if(kv>qrel)p0[r]=NEG; if(kv+32>qrel)p1[r]=NEG;}
}

constexpr int NSLOT=3, SLOTB=8192;
constexpr int LDS_K=0, LDS_V=NSLOT*SLOTB, LDS_WS=2*NSLOT*SLOTB, LDS_OST=LDS_WS+NW*64*4, LDS_BYTES=LDS_OST+NW*4096;
constexpr float C2=0.125f*1.4426950408889634f;
__device__ __forceinline__ void glds16(const void*gsrc,unsigned lds_dst){unsigned keep;
  asm volatile("s_mov_b32 %0, m0\n\ts_mov_b32 m0, %2\n\ts_nop 0\n\tglobal_load_lds_dwordx4 %1, off\n\ts_mov_b32 m0, %0":"=&s"(keep):"v"(gsrc),"s"(lds_dst):"memory");}
__device__ __forceinline__ float max3f(float a,float b,float c){float r;asm("v_max3_f32 %0, %1, %2, %3":"=v"(r):"v"(a),"v"(b),"v"(c));return r;}
__device__ __forceinline__ float max2f(float a,float b){float r;asm("v_max_f32_e32 %0, %1, %2":"=v"(r):"v"(a),"v"(b));return r;}
__device__ __forceinline__ float fadd_s(float a,float b){float r;asm("v_add_f32_e32 %0, %1, %2":"=v"(r):"v"(a),"v"(b));return r;}
__device__ __forceinline__ float fsub_s(float a,float b){float r;asm("v_sub_f32_e32 %0, %1, %2":"=v"(r):"v"(a),"v"(b));return r;}
typedef float f32x2_t __attribute__((ext_vector_type(2))); typedef __bf16 bf16x2_t __attribute__((ext_vector_type(2)));
__device__ __forceinline__ unsigned cvtpk_s(float lo,float hi){f32x2_t v={lo,hi};bf16x2_t b=__builtin_convertvector(v,bf16x2_t);return __builtin_bit_cast(unsigned,b);}
#define WAIT_BAR(N) asm volatile("s_waitcnt vmcnt(" #N ") lgkmcnt(0)\n\ts_barrier":::"memory")

__device__ __forceinline__ void qkt(f32x16&p0,f32x16&p1,const char*Kslot,const bf16x8*qr,const f32x16&negm,int r32,int hi){
  const char*kb=Kslot+hi*1024+r32*16;
  #pragma unroll
  for(int d0=0;d0<4;++d0){
    const bf16x8 b0=*reinterpret_cast<const bf16x8*>(kb+d0*2048);
    const bf16x8 b1=*reinterpret_cast<const bf16x8*>(kb+d0*2048+512);
    if(d0==0){p0=__builtin_amdgcn_mfma_f32_32x32x16_bf16(b0,qr[0],negm,0,0,0);p1=__builtin_amdgcn_mfma_f32_32x32x16_bf16(b1,qr[0],negm,0,0,0);}
    else{p0=__builtin_amdgcn_mfma_f32_32x32x16_bf16(b0,qr[d0],p0,0,0,0);p1=__builtin_amdgcn_mfma_f32_32x32x16_bf16(b1,qr[d0],p1,0,0,0);}}
}
typedef __attribute__((address_space(3))) const char* lds_cptr;
typedef short v4i16_t __attribute__((ext_vector_type(4)));
__device__ __forceinline__ void kload8(bf16x8*kf,lds_cptr kp){
  kf[0]=*(const __attribute__((address_space(3))) bf16x8*)(kp);      kf[1]=*(const __attribute__((address_space(3))) bf16x8*)(kp+512);
  kf[2]=*(const __attribute__((address_space(3))) bf16x8*)(kp+2048); kf[3]=*(const __attribute__((address_space(3))) bf16x8*)(kp+2560);
  kf[4]=*(const __attribute__((address_space(3))) bf16x8*)(kp+4096); kf[5]=*(const __attribute__((address_space(3))) bf16x8*)(kp+4608);
  kf[6]=*(const __attribute__((address_space(3))) bf16x8*)(kp+6144); kf[7]=*(const __attribute__((address_space(3))) bf16x8*)(kp+6656);
}
__device__ __forceinline__ void kload2(bf16x8*kf,lds_cptr kp,int j){ kf[2*j]=*(const __attribute__((address_space(3))) bf16x8*)(kp+j*2048); kf[2*j+1]=*(const __attribute__((address_space(3))) bf16x8*)(kp+j*2048+512); }
__device__ __forceinline__ s16x4 vtr(lds_cptr p){ return __builtin_bit_cast(s16x4,__builtin_amdgcn_ds_read_tr16_b64_v4i16((__attribute__((address_space(3))) v4i16_t*)p)); }
__device__ __forceinline__ float rowmax(const f32x16&p0,const f32x16&p1){
  float a=max3f(p0[0],p0[1],p1[0]),b=max3f(p0[2],p0[3],p1[1]);a=max3f(a,p1[2],p1[3]);
  #pragma unroll
  for(int r=4;r<16;r+=4){a=max3f(a,p0[r],p0[r+1]);b=max3f(b,p0[r+2],p0[r+3]);a=max3f(a,p1[r],p1[r+1]);b=max3f(b,p1[r+2],p1[r+3]);}
  const float m=max2f(a,b);
  auto rr=__builtin_amdgcn_permlane32_swap(__float_as_uint(m),__float_as_uint(m),false,false);
  return max2f(__uint_as_float(rr[0]),__uint_as_float(rr[1]));
}
__device__ __forceinline__ void pv(f32x16*o,int vb,bf16x8 pa0,bf16x8 pa1,bf16x8 pa2,bf16x8 pa3){
  #pragma unroll
  for(int d0=0;d0<2;++d0){s16x4 lo[4],hi[4];
    #pragma unroll
    for(int ks=0;ks<4;++ks){
      asm volatile("ds_read_b64_tr_b16 %0,%1 offset:%c2":"=&v"(lo[ks]):"v"(vb),"i"(d0*4096+ks*1024):"memory");
      asm volatile("ds_read_b64_tr_b16 %0,%1 offset:%c2":"=&v"(hi[ks]):"v"(vb),"i"(d0*4096+ks*1024+512):"memory");}
    asm volatile("s_waitcnt lgkmcnt(0)":::"memory");SBAR();
    #define PK(k) (bf16x8){lo[k][0],lo[k][1],lo[k][2],lo[k][3],hi[k][0],hi[k][1],hi[k][2],hi[k][3]}
    o[d0]=__builtin_amdgcn_mfma_f32_32x32x16_bf16(pa0,PK(0),o[d0],0,0,0);
    o[d0]=__builtin_amdgcn_mfma_f32_32x32x16_bf16(pa1,PK(1),o[d0],0,0,0);
    o[d0]=__builtin_amdgcn_mfma_f32_32x32x16_bf16(pa2,PK(2),o[d0],0,0,0);
    o[d0]=__builtin_amdgcn_mfma_f32_32x32x16_bf16(pa3,PK(3),o[d0],0,0,0);
    #undef PK
  }
}

#ifndef ATTN_STORE16
#define ATTN_STORE16(p,v) (*(u32x4*)(p)=(v))
#endif
template<int THRL> __device__ __forceinline__ void attn_unit(int b,int h,int qb,const bf16*Q,const bf16*__restrict__ K,const bf16*__restrict__ V,bf16*O,char*shm){
  int tid_=threadIdx.x; asm volatile("" : "+v"(tid_));
  const int tid=tid_,lane=tid&63,r32=lane&31,hi=lane>>5; const int wid=__builtin_amdgcn_readfirstlane(tid>>6);
  const long rowbase=(long)b*SEQ; const int q0=qb*QB;
  const bf16*Qw=Q+(rowbase+q0+wid*QBLK)*QP+h*D;
  const bf16*Kh=K+rowbase*KP+h*D,*Vh=V+rowbase*VP+h*D;
  const unsigned lds0=(unsigned)(uintptr_t)shm;
  float*wsf=(float*)(shm+LDS_WS)+wid*64;
  const bf16*ksrc=Kh+(long)lane*KP+wid*8;
  const bf16*vsrc=Vh+(long)(16*(wid&3)+(lane>>2))*VP+(wid>>2)*32+(lane&3)*8;
  const unsigned kdst=lds0+LDS_K+wid*1024, vdst=lds0+LDS_V+wid*1024;
  #define DMA_K(t,slot) glds16(ksrc+(long)(t)*KVBLK*KP,(unsigned)__builtin_amdgcn_readfirstlane(kdst+(slot)))
  #define DMA_V(t,slot) glds16(vsrc+(long)(t)*KVBLK*VP,(unsigned)__builtin_amdgcn_readfirstlane(vdst+(slot)))
  const int vb0=(int)(lds0+LDS_V)+((lane>>4)&1)*32+(lane&3)*8+(4*hi+((lane&15)>>2))*64;
  const char*Kbase=shm+LDS_K; bf16x8 kf[8];
  const lds_cptr shm3=(lds_cptr)shm; const lds_cptr kp0=shm3+LDS_K+hi*1024+r32*16; const lds_cptr vp0=shm3+LDS_V+((lane>>4)&1)*32+(lane&3)*8+(4*hi+((lane&15)>>2))*64;
  const int NT=(q0+QB)/KVBLK;
  DMA_K(0,0);DMA_V(0,0);DMA_K(1,SLOTB);
  bf16x8 qr[4];
  #pragma unroll
  for(int d0=0;d0<4;++d0)qr[d0]=*reinterpret_cast<const bf16x8*>(&Qw[(long)r32*QP+d0*16+hi*8]);
  float mhat=0.f,l_reg=0.f;f32x16 o[2];o[0]=f32x16{};o[1]=f32x16{};f32x16 negm=f32x16{};asm volatile("":"+v"(negm));
  const int qrel=wid*QBLK+r32;
  #define CMASK(P0,P1,t) do{int jb_=(t)-(NT-4); if(jb_>=0)cmask(P0,P1,jb_,qrel,hi);}while(0)
  bool resc=false;
  #define START(P0,P1) do{ const float rm=rowmax(P0,P1); resc=false; \
    { const float dl=rm; mhat=fadd_s(mhat,dl); \
      _Pragma("unroll") for(int r=0;r<16;++r){P0[r]=fsub_s(P0[r],dl);P1[r]=fsub_s(P1[r],dl);} \
      _Pragma("unroll") for(int r=0;r<16;++r)negm[r]=-mhat; asm volatile("":"+v"(negm)); } \
    _Pragma("unroll") for(int r=0;r<16;++r)P0[r]=__builtin_amdgcn_exp2f(P0[r]); }while(0)
  #define RESC() do{ if(resc){ asm volatile("s_waitcnt lgkmcnt(0)":::"memory"); \
      _Pragma("unroll") for(int d_=0;d_<2;++d_) _Pragma("unroll") for(int r=0;r<16;++r)o[d_][r]*=wsf[crow(r,hi)]; } }while(0)
  f32x16 pA0,pA1,pB0,pB1;
  int sl_prev=0,sl_cur=0,sl_next=SLOTB;
  #define ROT() do{sl_prev=sl_cur;sl_cur=sl_next;sl_next=(sl_next==(NSLOT-1)*SLOTB)?0:sl_next+SLOTB;}while(0)
  DMA_K(2,2*SLOTB);
  WAIT_BAR(3);
  qkt(pA0,pA1,Kbase,qr,negm,r32,hi);asm volatile("s_nop 15\n\ts_nop 7":"+v"(pA0),"+v"(pA1));CMASK(pA0,pA1,0);
  START(pA0,pA1);
  _Pragma("unroll") for(int r=0;r<16;++r)pA1[r]=__builtin_amdgcn_exp2f(pA1[r]);
  WAIT_BAR(0);
  DMA_K(3,0);DMA_V(1,SLOTB);
  ROT();
  kload8(kf,kp0+sl_cur);
  WAIT_BAR(2);
  s16x4 vlo[8],vhi[8]; u32x4 pw0,pw1,pw2,pw3;
  #define PKW(P,B) cvtpk_s(P[B],P[B+1])
  #define PAF(k) __builtin_bit_cast(bf16x8,pw##k)
  #define VFR(i) (bf16x8){vlo[i][0],vlo[i][1],vlo[i][2],vlo[i][3],vhi[i][0],vhi[i][1],vhi[i][2],vhi[i][3]}
  #define PIN(x) asm volatile("":"+v"(x))
  #define MX3(a,b,c) __builtin_fmaxf(__builtin_fmaxf((a),(b)),(c))
  #define GAPA(MF,A0,A1,A2,A3,W0,W1,PW) do{ MF; sacc+=A0; sacc+=A1; sacc+=A2; sacc+=A3; PIN(sacc); W0; W1; PIN(PW); SBAR(); }while(0)
  #define EX(v) __builtin_amdgcn_exp2f(v)
  #define GAPB(MF,X,B) do{ MF; X[B]=EX(X[B]); X[B+1]=EX(X[B+1]); X[B+2]=EX(X[B+2]); X[B+3]=EX(X[B+3]); PIN(X); SBAR(); }while(0)
  #define VRD(i) do{ vlo[i]=vtr(vp_+(((i)>>2)*4096+((i)&3)*1024)); vhi[i]=vtr(vp_+(((i)>>2)*4096+((i)&3)*1024+512)); }while(0)
  #define KRD(G,j) do{ if(G){ kload2(kf,kp0+sl_next,j); SBAR(); } }while(0)
  #define STEP(C0,C1,P0,P1,t,GK,GV,GL) do{ SBAR(); \
    const lds_cptr vp_=vp0+sl_prev; \
    VRD(0); SBAR(); float sacc=(P0[0]+P0[1]); \
    GAPA(C0=__builtin_amdgcn_mfma_f32_32x32x16_bf16(kf[0],qr[0],negm,0,0,0), P0[2],P0[3],P0[4],P0[5],     pw0[0]=PKW(P0,0), pw0[1]=PKW(P0,2), pw0); \
    VRD(4); SBAR(); GAPA(C1=__builtin_amdgcn_mfma_f32_32x32x16_bf16(kf[1],qr[0],negm,0,0,0), P0[6],P0[7],P0[8],P0[9],     pw0[2]=PKW(P0,4), pw0[3]=PKW(P0,6), pw0); \
    VRD(1); SBAR(); GAPA(C0=__builtin_amdgcn_mfma_f32_32x32x16_bf16(kf[2],qr[1],C0,0,0,0),   P0[10],P0[11],P0[12],P0[13], pw1[0]=PKW(P0,8), pw1[1]=PKW(P0,10), pw1); \
    VRD(5); SBAR(); GAPA(C1=__builtin_amdgcn_mfma_f32_32x32x16_bf16(kf[3],qr[1],C1,0,0,0),   P0[14],P0[15],P1[0],P1[1],   pw1[2]=PKW(P0,12),pw1[3]=PKW(P0,14), pw1); \
    VRD(2); SBAR(); GAPA(C0=__builtin_amdgcn_mfma_f32_32x32x16_bf16(kf[4],qr[2],C0,0,0,0),   P1[2],P1[3],P1[4],P1[5],     pw2[0]=PKW(P1,0), pw2[1]=PKW(P1,2), pw2); \
    VRD(6); SBAR(); GAPA(C1=__builtin_amdgcn_mfma_f32_32x32x16_bf16(kf[5],qr[2],C1,0,0,0),   P1[6],P1[7],P1[8],P1[9],     pw2[2]=PKW(P1,4), pw2[3]=PKW(P1,6), pw2); \
    VRD(3); SBAR(); GAPA(C0=__builtin_amdgcn_mfma_f32_32x32x16_bf16(kf[6],qr[3],C0,0,0,0),   P1[10],P1[11],P1[12],P1[13], pw3[0]=PKW(P1,8), pw3[1]=PKW(P1,10), pw3); \
    VRD(7); SBAR(); GAPA(C1=__builtin_amdgcn_mfma_f32_32x32x16_bf16(kf[7],qr[3],C1,0,0,0),   P1[14],P1[15],0.f,0.f,       pw3[2]=PKW(P1,12),pw3[3]=PKW(P1,14), pw3); \
    l_reg+=sacc; \
    if(GK){DMA_K((t)+3,sl_cur);} if(GV){DMA_V((t)+1,sl_next);} \
    CMASK(C0,C1,t); \
    { float a=MX3(C0[0],C0[1],C1[0]),b=MX3(C0[2],C0[3],C1[1]); a=MX3(a,C1[2],C1[3]); \
      _Pragma("unroll") for(int r=4;r<16;r+=4){a=MX3(a,C0[r],C0[r+1]);b=MX3(b,C0[r+2],C0[r+3]);a=MX3(a,C1[r],C1[r+1]);b=MX3(b,C1[r+2],C1[r+3]);} \
      float rm=__builtin_fmaxf(a,b); { auto rr=__builtin_amdgcn_permlane32_swap(__float_as_uint(rm),__float_as_uint(rm),false,false); rm=__builtin_fmaxf(__uint_as_float(rr[0]),__uint_as_float(rr[1])); } \
      resc=false; \
      if(__builtin_expect(__any(rm>(float)THRL),0)){ const float dl=__builtin_fmaxf(rm,0.f); mhat+=dl; \
        _Pragma("unroll") for(int r=0;r<16;++r){C0[r]-=dl;C1[r]-=dl;} \
        _Pragma("unroll") for(int r=0;r<16;++r)negm[r]=-mhat; asm volatile("":"+v"(negm)); \
        const float f=__builtin_amdgcn_exp2f(-dl); l_reg*=f; if(hi==0)wsf[r32]=f; resc=true; } } \
    SBAR(); \
    GAPB(o[0]=__builtin_amdgcn_mfma_f32_32x32x16_bf16(PAF(0),VFR(0),o[0],0,0,0), C0,0); \
    GAPB(o[1]=__builtin_amdgcn_mfma_f32_32x32x16_bf16(PAF(0),VFR(4),o[1],0,0,0), C0,4); \
    KRD(GL,0); GAPB(o[0]=__builtin_amdgcn_mfma_f32_32x32x16_bf16(PAF(1),VFR(1),o[0],0,0,0), C0,8); \
    KRD(GL,1); GAPB(o[1]=__builtin_amdgcn_mfma_f32_32x32x16_bf16(PAF(1),VFR(5),o[1],0,0,0), C0,12); \
    KRD(GL,2); GAPB(o[0]=__builtin_amdgcn_mfma_f32_32x32x16_bf16(PAF(2),VFR(2),o[0],0,0,0), C1,0); \
    KRD(GL,3); GAPB(o[1]=__builtin_amdgcn_mfma_f32_32x32x16_bf16(PAF(2),VFR(6),o[1],0,0,0), C1,4); \
    GAPB(o[0]=__builtin_amdgcn_mfma_f32_32x32x16_bf16(PAF(3),VFR(3),o[0],0,0,0), C1,8); \
    GAPB(o[1]=__builtin_amdgcn_mfma_f32_32x32x16_bf16(PAF(3),VFR(7),o[1],0,0,0), C1,12); \
    }while(0)
  int t=1;
  #undef CMASK
  #define CMASK(P0,P1,t) do{}while(0)
  for(;t+5<NT;t+=2){
    STEP(pB0,pB1,pA0,pA1,t,true,true,true);     WAIT_BAR(2); RESC(); ROT();
    STEP(pA0,pA1,pB0,pB1,t+1,true,true,true);   WAIT_BAR(2); RESC(); ROT();
  }
  #undef CMASK
  #define CMASK(P0,P1,t) do{int jb_=(t)-(NT-4); if(jb_>=0)cmask(P0,P1,jb_,qrel,hi);}while(0)
  #define ENDW(tt) do{ if((tt)+3<NT){WAIT_BAR(2);} else if((tt)+2<NT){WAIT_BAR(1);} else {WAIT_BAR(0);} }while(0)
  for(;t+1<NT;t+=2){
    STEP(pB0,pB1,pA0,pA1,t,(t+3<NT),(t+1<NT),(t+1<NT));       ENDW(t);   RESC(); ROT();
    STEP(pA0,pA1,pB0,pB1,t+1,(t+4<NT),(t+2<NT),(t+2<NT));     ENDW(t+1); RESC(); ROT();
  }
  STEP(pB0,pB1,pA0,pA1,NT-1,false,false,false); RESC();
  { float sacc=pB0[0]+pB0[1]; _Pragma("unroll") for(int r=2;r<16;++r)sacc+=pB0[r]; _Pragma("unroll") for(int r=0;r<16;++r)sacc+=pB1[r]; l_reg+=sacc;
    pw0=(u32x4){PKW(pB0,0),PKW(pB0,2),PKW(pB0,4),PKW(pB0,6)};pw1=(u32x4){PKW(pB0,8),PKW(pB0,10),PKW(pB0,12),PKW(pB0,14)};pw2=(u32x4){PKW(pB1,0),PKW(pB1,2),PKW(pB1,4),PKW(pB1,6)};pw3=(u32x4){PKW(pB1,8),PKW(pB1,10),PKW(pB1,12),PKW(pB1,14)};
    SBAR(); pv(o,vb0+sl_cur,PAF(0),PAF(1),PAF(2),PAF(3)); }
  #undef PKW
  #undef PAF
  #undef VFR
  #undef PIN
  #undef MX3
  #undef GAPA
  #undef GAPB
  #undef EX
  #undef VRD
  #undef KRD
  #undef STEP
  #undef ENDW
  {auto rr=__builtin_amdgcn_permlane32_swap(__float_as_uint(l_reg),__float_as_uint(l_reg),false,false);l_reg=__uint_as_float(rr[0])+__uint_as_float(rr[1]);}
  if(hi==0)wsf[32+r32]=l_reg;asm volatile("s_waitcnt lgkmcnt(0)":::"memory");
  float rli[16];
  #pragma unroll
  for(int r=0;r<16;++r)rli[r]=__builtin_amdgcn_rcpf(wsf[32+crow(r,hi)]);
  bf16*Ow=O+(rowbase+q0+wid*QBLK)*OP+h*D;
  { bf16*stg=(bf16*)(shm+LDS_OST)+wid*2048;
    #pragma unroll
    for(int r=0;r<16;++r){const int orow=crow(r,hi);
      #pragma unroll
      for(int d0=0;d0<2;++d0)stg[orow*64+d0*32+r32]=__float2bfloat16(o[d0][r]*rli[r]);}
    asm volatile("s_waitcnt lgkmcnt(0)":::"memory");
    #pragma unroll
    for(int i=0;i<4;++i){const int row=i*8+(lane>>3),ch=lane&7; const u32x4 v=*(const u32x4*)(stg+row*64+ch*8); ATTN_STORE16(Ow+(long)row*OP+ch*8,v);} }
  asm volatile("s_waitcnt lgkmcnt(0)\n\ts_barrier":::"memory");
  #undef DMA_K
  #undef DMA_V
  #undef CMASK
  #undef START
  #undef RESC
  #undef ROT
}
constexpr int ATTN_LDS_BYTES=LDS_BYTES;
#undef SBAR
#undef WAIT_BAR
}

#define GAS __attribute__((address_space(1)))
#define LAS __attribute__((address_space(3)))
typedef unsigned short bf16;
typedef unsigned v4u __attribute__((ext_vector_type(4)));
typedef unsigned v2u __attribute__((ext_vector_type(2)));
typedef float f32x4 __attribute__((ext_vector_type(4)));
typedef short bf16x8 __attribute__((ext_vector_type(8)));
typedef GAS unsigned gu32;
#define RLX_AGENT __ATOMIC_RELAXED, __HIP_MEMORY_SCOPE_AGENT
#define LDS_WAIT() asm volatile("s_waitcnt lgkmcnt(0)" ::: "memory")
#define VM_WAIT() asm volatile("s_waitcnt vmcnt(0)" ::: "memory")

#ifndef P1_HOSTS_P0B
#define P1_HOSTS_P0B 1
#endif
constexpr int NWAVES = 8;
constexpr int DM = 2048, NBATCH = 8, SEQ = 2048, M = NBATCH * SEQ;
constexpr int IN_COLS = 5648;
constexpr int NIN = 5632;
constexpr int NIN_G = 5888;
constexpr int UC_Z = 0, UC_XBC = 1024, UC_Q = 2560, UC_K = 3584, UC_V = 4608;
constexpr int NE = 32, EH = 1024;
constexpr float EPS = 1e-6f;
constexpr float F8_WSCALE = 64.f;
constexpr float Y8_SCALE = 16.f;
constexpr size_t MiB = 1u << 20;

constexpr int RING_OFF = 0, RING_BYTES = 131072;
constexpr int LDSCTL_OFF = 159744, MISC_OFF = LDSCTL_OFF + 320;
constexpr int LDS_BYTES = 163840;

namespace mp {
constexpr size_t ctl = 0, small = 1 * MiB, wr = 2 * MiB, rope = 3 * MiB, dt = 5 * MiB, win = 6 * MiB, wout = 30 * MiB, wgu = 38 * MiB, wd = 166 * MiB;
constexpr size_t xn = 230 * MiB, xn2 = 230 * MiB, ycat = 294 * MiB, u16 = 358 * MiB, qn = 534 * MiB, kn = 566 * MiB, xbc = 598 * MiB, o1 = 646 * MiB, o2 = 678 * MiB, ys = 710 * MiB;
constexpr size_t y = 358 * MiB, hid = 518 * MiB;
constexpr size_t lst = 742 * MiB;
constexpr size_t xn8 = 748 * MiB;
constexpr size_t END = 780 * MiB;
}
constexpr size_t CTL_ZERO_BYTES = 1 * MiB;
constexpr int CW_TMO = 0, CW_CODE = 1, CW_BAR = 4096;
constexpr int CW_Q0 = 66560;
constexpr int CW_LOC = 8192, CW_RANK = 10240;
constexpr int CW_CNT = 65536;
constexpr int LCAP = 16384;
constexpr int SLOT_CAP = 40960;
constexpr int TAB_OFF = LDSCTL_OFF + 1024;
constexpr size_t SM_TOK_E = 0, SM_TOK_POS = 131072, SM_TOK_W = 262144, SM_TOK_SLOT = 393216, SM_RINV = 524288, SM_SLOT_W = 655360, SM_SLOT_R = 851968, SM_END = 1048576;

__device__ __forceinline__ void st16_wt(void* p, v4u v) { asm volatile("global_store_dwordx4 %0, %1, off sc1\n\ts_nop 1" :: "v"(p), "v"(v) : "memory"); }
__device__ __forceinline__ unsigned f2bf(float f) { unsigned u = __builtin_bit_cast(unsigned, f); return (u + 0x7fffu + ((u >> 16) & 1u)) >> 16; }
typedef float f32x2_pk __attribute__((ext_vector_type(2))); typedef __bf16 bf16x2_pk __attribute__((ext_vector_type(2)));
__device__ __forceinline__ unsigned pk2(float lo, float hi) { f32x2_pk v = {lo, hi}; bf16x2_pk b = __builtin_convertvector(v, bf16x2_pk); return __builtin_bit_cast(unsigned, b); }
__device__ __forceinline__ float bf2f(unsigned short b) { return __builtin_bit_cast(float, (unsigned)b << 16); }
__device__ __forceinline__ float wave_sum(float v) {
#pragma unroll
    for (int o = 1; o < 64; o <<= 1) v += __shfl_xor(v, o);
    return v;
}

#define XB_TMO      128
#define XB_XCNT(j)  (256  + 64 * (j))
#define XB_XSUB(j)  (1280 + 64 * (j))
#define XB_XGEN(j)  (2304 + 64 * (j))
#define XB_TOP      3328
#define XB_TOPGEN   3392
#define XCD_BAR_WORDS 3456
#define XB_SPIN_CAP (1u << 18)

__device__ __forceinline__ unsigned xb_ld(unsigned* p)              { return __hip_atomic_load(p, __ATOMIC_RELAXED, __HIP_MEMORY_SCOPE_AGENT); }
__device__ __forceinline__ unsigned xb_add(unsigned* p, unsigned v) { return __hip_atomic_fetch_add(p, v, __ATOMIC_RELAXED, __HIP_MEMORY_SCOPE_AGENT); }
__device__ __forceinline__ unsigned xb_xcc_id() { return (unsigned)__builtin_amdgcn_s_getreg((3 << 11) | 20) & 0xFu; }
#define XB_SPIN(cond, bar) do { unsigned _sp = 0; while (cond) { __builtin_amdgcn_s_sleep(1); \
    if ((++_sp & 255u) == 0u) { if (xb_ld(&(bar)[XB_TMO])) break; if (_sp > XB_SPIN_CAP) { atomicAdd(&(bar)[XB_TMO], 1u); break; } } } } while (0)

struct XcdBarrier {
    unsigned* bar; unsigned x;
    volatile LAS unsigned* st;
};

__device__ __forceinline__ XcdBarrier xcd_barrier_post(unsigned* bar, volatile LAS unsigned* st) {
    XcdBarrier b; b.bar = bar; b.x = xb_xcc_id(); b.st = st;
    if (threadIdx.x == 0) (void)xb_add(&bar[XB_XCNT(b.x)], 1u);
    return b;
}
__device__ __forceinline__ void xcd_barrier_complete(unsigned* bar, unsigned x, unsigned& nloc, unsigned& nx) {
    const unsigned G = gridDim.x * gridDim.y * gridDim.z;
    unsigned sum, cnt, mine, sp = 0u;
    for (;;) {
        sum = 0u; cnt = 0u; mine = 0u;
#pragma unroll
        for (unsigned j = 0; j < 16; ++j) { const unsigned c = xb_ld(&bar[XB_XCNT(j)]); sum += c; cnt += (c > 0u) ? 1u : 0u; mine = (j == x) ? c : mine; }
        if (sum == G) break;
        __builtin_amdgcn_s_sleep(1);
        if ((++sp & 255u) == 0u) { if (xb_ld(&bar[XB_TMO])) break; if (sp > XB_SPIN_CAP) { atomicAdd(&bar[XB_TMO], 1u); break; } }
    }
    nloc = mine > 0u ? mine : 1u; nx = cnt > 0u ? cnt : 1u;
}

__device__ __forceinline__ void xcd_barrier(const XcdBarrier& b) {
    asm volatile("s_waitcnt vmcnt(0)" ::: "memory");
    __syncthreads();
    if (threadIdx.x == 0) {
        unsigned* bar = b.bar;
        __builtin_amdgcn_s_waitcnt(0);
        unsigned nloc = b.st[0], nx = b.st[1];
        if (nloc == 0u) { xcd_barrier_complete(bar, b.x, nloc, nx); b.st[0] = nloc; b.st[1] = nx; }
        const unsigned old = xb_add(&bar[XB_XSUB(b.x)], 1u);
        const unsigned gen = old / nloc;
        if (old + 1u == (gen + 1u) * nloc) {
            __builtin_amdgcn_fence(__ATOMIC_RELEASE, "agent");
            asm volatile("s_waitcnt vmcnt(0)" ::: "memory");
            const unsigned og = xb_add(&bar[XB_TOP], 1u);
            const unsigned tg = og / nx;
            if (og + 1u == (tg + 1u) * nx) xb_add(&bar[XB_TOPGEN], 1u);
            else XB_SPIN(xb_ld(&bar[XB_TOPGEN]) == tg, bar);
            __builtin_amdgcn_fence(__ATOMIC_ACQUIRE, "agent");
            xb_add(&bar[XB_XGEN(b.x)], 1u);
            asm volatile("s_waitcnt vmcnt(0)" ::: "memory");
        } else {
            XB_SPIN(xb_ld(&bar[XB_XGEN(b.x)]) == gen, bar);
            __builtin_amdgcn_fence(__ATOMIC_ACQUIRE, "agent");
            asm volatile("s_waitcnt vmcnt(0)" ::: "memory");
        }
    }
    __syncthreads();
}

__device__ __forceinline__ void xcd_local_barrier(unsigned* bar, unsigned* ctr, unsigned n) {
    asm volatile("s_waitcnt vmcnt(0)" ::: "memory");
    __syncthreads();
    if (threadIdx.x == 0) {
        __builtin_amdgcn_s_waitcnt(0);
        const unsigned old = xb_add(ctr, 1u), target = (old / n + 1u) * n;
        XB_SPIN(xb_ld(ctr) < target, bar);
        __builtin_amdgcn_fence(__ATOMIC_ACQUIRE, "agent");
        asm volatile("s_waitcnt vmcnt(0)" ::: "memory");
    }
    __syncthreads();
}

struct Frame {
    LAS unsigned char* lds;
    volatile LAS unsigned* MISC;
    gu32* ctl;
    int tid, lane, wave;
    int vcu, G;
    int cid;
    unsigned char* ws;
};

struct TItem { const float* W; bf16* base; const float* kscale; int ldw, nvalid, k0, n0, kind, pitch, f8; };
constexpr int TI_PC = 36, TI_P1 = 8 * TI_PC, TI_BYTES = 16 * TI_P1 * 4;
template <int NI> __device__ __forceinline__ void titem_issue(const TItem& d, int lane, f32x4 (&ld)[NI]) {
    const int nq = d.n0 + 4 * (lane & 7); const bool ok = nq < d.nvalid;
#pragma unroll
    for (int i = 0; i < NI; ++i) ld[i] = ok ? __builtin_nontemporal_load((const GAS f32x4*)(d.W + (size_t)(d.k0 + (lane >> 3) + 8 * i) * d.ldw + nq)) : (f32x4){0.f, 0.f, 0.f, 0.f};
}
template <int NI> __device__ __forceinline__ void titem_finish(const TItem& d, int lane, const f32x4 (&ld)[NI], LAS float* scr, bf16* WIN, bf16* WDT) {
#pragma unroll
    for (int i = 0; i < NI; ++i) { const int k = (lane >> 3) + 8 * i; *(LAS f32x4*)(scr + (k % NI) * TI_P1 + (k / NI) * TI_PC + 4 * (lane & 7)) = ld[i]; }
    LDS_WAIT(); asm volatile("" ::: "memory");
    const int c = lane & 7;
    if constexpr (NI == 16) {
#pragma unroll
        for (int j = 0; j < 4; ++j) { const int nl = (lane >> 3) + 8 * j, n = d.n0 + nl; const LAS float* s = scr + c * TI_PC + nl;
            const size_t rowi = d.kind == 3 ? (size_t)((n & ~255) + ((n >> 3) & 1) * 128 + ((n >> 6) & 3) * 32 + ((n >> 4) & 3) * 8 + (n & 7))
                                            : (size_t)((n >> 7) * 256 + (n & 127));
            v4u q; q.x = pg8::cvt4_fp8(s[0 * TI_P1] * F8_WSCALE, s[1 * TI_P1] * F8_WSCALE, s[2 * TI_P1] * F8_WSCALE, s[3 * TI_P1] * F8_WSCALE); q.y = pg8::cvt4_fp8(s[4 * TI_P1] * F8_WSCALE, s[5 * TI_P1] * F8_WSCALE, s[6 * TI_P1] * F8_WSCALE, s[7 * TI_P1] * F8_WSCALE);
            q.z = pg8::cvt4_fp8(s[8 * TI_P1] * F8_WSCALE, s[9 * TI_P1] * F8_WSCALE, s[10 * TI_P1] * F8_WSCALE, s[11 * TI_P1] * F8_WSCALE); q.w = pg8::cvt4_fp8(s[12 * TI_P1] * F8_WSCALE, s[13 * TI_P1] * F8_WSCALE, s[14 * TI_P1] * F8_WSCALE, s[15 * TI_P1] * F8_WSCALE);
            if (n < d.nvalid) __builtin_nontemporal_store(q, (GAS v4u*)((unsigned char*)d.base + rowi * d.pitch + d.k0 + 16 * c)); }
    } else {
#pragma unroll
        for (int j = 0; j < 4; ++j) { const int nl = (lane >> 3) + 8 * j, n = d.n0 + nl; const LAS float* s = scr + c * TI_PC + nl;
            v4u o; o.x = pk2(s[0 * TI_P1], s[1 * TI_P1]); o.y = pk2(s[2 * TI_P1], s[3 * TI_P1]); o.z = pk2(s[4 * TI_P1], s[5 * TI_P1]); o.w = pk2(s[6 * TI_P1], s[7 * TI_P1]);
            bf16* row;
            if (d.kind == 0) row = n < 2560 ? WIN + (size_t)n * DM : (n < 2576 ? WIN + (size_t)(NIN + n - 2560) * DM : WIN + (size_t)(n - 16) * DM);
            else row = d.base + (size_t)n * d.pitch;
            if (n < d.nvalid) *(GAS v4u*)(row + d.k0 + 8 * c) = o; }
    }
    LDS_WAIT(); asm volatile("" ::: "memory");
}

struct Args { const void* in[26]; float* out; unsigned char* ws; int ph_lo, ph_hi, li, p0_mask, rep_phase, pad; };
typedef const __attribute__((address_space(4))) Args* KA;

constexpr int P0B_NBLK = 3 * NE * 128, P0B_NSUB = 4 * P0B_NBLK;
__device__ __forceinline__ void p0b_blocks(Frame& F, KA args, int first, int nq, int gstride = 1) {
    const int lane = F.lane;
    const float* w_gate = (const float*)args->in[23]; const float* w_up = (const float*)args->in[24]; const float* w_down = (const float*)args->in[25];
    bf16* WGU = (bf16*)(F.ws + mp::wgu); bf16* WD = (bf16*)(F.ws + mp::wd);
    LAS float* scr = (LAS float*)(F.lds + F.wave * TI_BYTES);
    auto decodeB = [&](int q) -> TItem {
        const int g = first + q * gstride, cb = g >> 2, i = g & 3;
        if (cb < 8192) { const int up = cb >> 12, r = cb & 4095, e = r >> 7, kb = (r >> 3) & 15, nb = r & 7;
            return TItem{(up ? w_up : w_gate) + (size_t)e * DM * EH, (bf16*)((unsigned char*)WGU + (size_t)e * 2048 * DM + (up ? (size_t)128 * DM : 0)), nullptr, EH, EH, 128 * kb, 128 * nb + 32 * i, 2, DM, 1}; }
        const int r = cb - 8192, e = r >> 7, kb = (r >> 4) & 7, nb = r & 15;
        return TItem{w_down + (size_t)e * EH * DM, (bf16*)((unsigned char*)WD + (size_t)e * DM * EH), nullptr, DM, DM, 128 * kb, 128 * nb + 32 * i, 3, EH, 1};
    };
    if (nq <= 0) return;
    TItem d0 = decodeB(0), d1 = d0, d2 = d0; f32x4 l0[16], l1[16], l2[16];
    titem_issue<16>(d0, lane, l0);
    if (nq > 1) { d1 = decodeB(1); titem_issue<16>(d1, lane, l1); }
    for (int q = 0; q < nq; q += 3) {
        if (q + 2 < nq) { d2 = decodeB(q + 2); titem_issue<16>(d2, lane, l2); }
        titem_finish<16>(d0, lane, l0, scr, nullptr, nullptr);
        if (q + 1 >= nq) break;
        if (q + 3 < nq) { d0 = decodeB(q + 3); titem_issue<16>(d0, lane, l0); }
        titem_finish<16>(d1, lane, l1, scr, nullptr, nullptr);
        if (q + 2 >= nq) break;
        if (q + 4 < nq) { d1 = decodeB(q + 4); titem_issue<16>(d1, lane, l1); }
        titem_finish<16>(d2, lane, l2, scr, nullptr, nullptr);
    }
}
constexpr int P1_UNITS = (M / 256) * (NIN_G / 256);
#if P1_HOSTS_P0B == 2
constexpr int P1_INLOOP_BLOCKS = P1_UNITS * NWAVES;
static_assert(P0B_NBLK - P1_INLOOP_BLOCKS == 64 * NWAVES, "the 64 CUs with one GEMM unit less take one more block per wave");
#endif
#ifndef P1_NCLASS
#define P1_NCLASS 3
#endif
__device__ __forceinline__ void p1_convert_share(Frame& F, KA args, int part) {
    const int c = F.cid, xcd = c & 7, l = c >> 3, lclass = xcd % P1_NCLASS;
    const int ex = l < 24 ? 0 : 12, q = 21 + ex;
    const int base = xcd * (P0B_NSUB / 8);
    const int first = l < 24 ? base + l * (NWAVES * 21) : base + 24 * NWAVES * 21 + (l - 24) * (NWAVES * 33);
    int lo, hi;
    if (part == 0) { lo = 0; hi = lclass == 0 ? q : ex; } else if (part == lclass) { lo = ex; hi = q; } else return;
    p0b_blocks(F, args, first + F.wave * q + lo, hi - lo);
}

__device__ __forceinline__ void p0_prologue(Frame& F, KA args) {
    const int gw = F.vcu * NWAVES + F.wave, NGW = F.G * NWAVES, lane = F.lane;
    const float* w_in = (const float*)args->in[3]; const float* w_out = (const float*)args->in[17];
    bf16* WIN = (bf16*)(F.ws + mp::win); bf16* WDT = nullptr; bf16* WOUT = (bf16*)(F.ws + mp::wout);
    constexpr int NB_IN = (IN_COLS + 31) / 32;
    constexpr int I_IN = (DM / 64) * NB_IN, I_OUT = (DM / 64) * (DM / 32), NITEMS_A = I_IN + I_OUT;
    LAS float* scr = (LAS float*)(F.lds + F.wave * TI_BYTES);
    auto decodeA = [&](int it) -> TItem {
        int r = it;
        if (r < I_IN) { const int kb = r / NB_IN, nb = r % NB_IN; return TItem{w_in, WIN, nullptr, IN_COLS, IN_COLS, 64 * kb, 32 * nb, 0, DM, 0}; }
        r -= I_IN; const int kb = r / (DM / 32), nb = r % (DM / 32); return TItem{w_out, WOUT, nullptr, DM, DM, 64 * kb, 32 * nb, 1, DM, 0};
    };
    if (gw < NITEMS_A) {
        TItem dc = decodeA(gw); f32x4 la[8], lb[8];
        titem_issue<8>(dc, lane, la);
        for (int it = gw; it < NITEMS_A; it += NGW) {
            const int nx = it + NGW; TItem dn = dc;
            if (nx < NITEMS_A) { dn = decodeA(nx); titem_issue<8>(dn, lane, lb); }
            titem_finish<8>(dc, lane, la, scr, WIN, WDT);
            dc = dn;
#pragma unroll
            for (int i = 0; i < 8; ++i) la[i] = lb[i];
        }
    }
#if !P1_HOSTS_P0B
    p0b_blocks(F, args, gw * (P0B_NSUB / NGW), P0B_NSUB / NGW);
#endif
    const float* x = (const float*)args->in[0]; const float* ln1 = (const float*)args->in[2]; bf16* XN = (bf16*)(F.ws + mp::xn);
    for (int m0 = gw * 2; m0 < M; m0 += NGW * 2) {
        f32x4 v[2][8];
#pragma unroll
        for (int rr = 0; rr < 2; ++rr)
#pragma unroll
            for (int j = 0; j < 8; ++j) v[rr][j] = __builtin_nontemporal_load((const GAS f32x4*)(x + (size_t)(m0 + rr) * DM) + lane + 64 * j);
#pragma unroll
        for (int rr = 0; rr < 2; ++rr) { float s = 0.f;
#pragma unroll
            for (int j = 0; j < 8; ++j) s += (v[rr][j].x * v[rr][j].x + v[rr][j].y * v[rr][j].y) + (v[rr][j].z * v[rr][j].z + v[rr][j].w * v[rr][j].w);
            const float r = 1.0f / sqrtf(wave_sum(s) * (1.f / DM) + EPS);
            GAS v2u* o8 = (GAS v2u*)(XN + (size_t)(m0 + rr) * DM) + lane; const GAS f32x4* wr = (const GAS f32x4*)ln1 + lane;
#pragma unroll
            for (int j = 0; j < 8; ++j) { const f32x4 ww = wr[64 * j]; v2u o; o.x = pk2(v[rr][j].x * r * ww.x, v[rr][j].y * r * ww.y); o.y = pk2(v[rr][j].z * r * ww.z, v[rr][j].w * r * ww.w); o8[64 * j] = o; } }
    }
}


__device__ __forceinline__ void p0_rope(Frame& F, KA args) {
    const int gt = (F.vcu * NWAVES + F.wave) * 64 + F.lane, NGT = F.G * NWAVES * 64;
    const int* pos = (const int*)args->in[1]; float* rope = (float*)(F.ws + mp::rope);
    for (int i = gt; i < M * 8; i += NGT) { const int m = i >> 3, j = i & 7;
        const float inv_freq = powf(500000.0f, -(float)(2 * j) / 16.0f);
        const float ang = (float)pos[m] * inv_freq;
        rope[m * 16 + j] = cosf(ang); rope[m * 16 + 8 + j] = sinf(ang); }
}

__device__ __forceinline__ void p2_qknorm(Frame& F, KA args) {
    const int gw = F.vcu * NWAVES + F.wave, NGW = F.G * NWAVES, lane = F.lane;
    const bf16* U16 = (const bf16*)(F.ws + mp::u16); const float* rope = (const float*)(F.ws + mp::rope);
    bf16* QN = (bf16*)(F.ws + mp::qn); bf16* KN = (bf16*)(F.ws + mp::kn);
    const float* qw = (const float*)args->in[10]; const float* kw = (const float*)args->in[11];
    const int sub = lane & 7;
    float wq[8], wk[8];
#pragma unroll
    for (int j = 0; j < 8; ++j) { wq[j] = qw[sub * 8 + j] * attn_body::C2; wk[j] = kw[sub * 8 + j]; }
    for (int it = 0; it < 2; ++it) { const int m0 = (F.vcu >> 5) * 2048 + it * 1024 + ((F.vcu & 31) * NWAVES + F.wave) * 4;
        v4u raw[4][4]; f32x4 rp[4][4];
#pragma unroll
        for (int rr = 0; rr < 4; ++rr) {
#pragma unroll
            for (int pc = 0; pc < 4; ++pc) raw[rr][pc] = __builtin_nontemporal_load((const GAS v4u*)(U16 + (size_t)(m0 + rr) * NIN + ((pc >> 1) ? UC_K : UC_Q) + (pc & 1) * 512 + lane * 8));
#pragma unroll
            for (int q = 0; q < 4; ++q) rp[rr][q] = *(const GAS f32x4*)(rope + (size_t)(m0 + rr) * 16 + 4 * q);
        }
#pragma unroll
        for (int rr = 0; rr < 4; ++rr) {
            const int m = m0 + rr;
            const float cs[8] = {rp[rr][0].x, rp[rr][0].y, rp[rr][0].z, rp[rr][0].w, rp[rr][1].x, rp[rr][1].y, rp[rr][1].z, rp[rr][1].w};
            const float sn[8] = {rp[rr][2].x, rp[rr][2].y, rp[rr][2].z, rp[rr][2].w, rp[rr][3].x, rp[rr][3].y, rp[rr][3].z, rp[rr][3].w};
#pragma unroll
            for (int pc = 0; pc < 4; ++pc) {
                const int isk = pc >> 1, col = (pc & 1) * 512 + lane * 8;
                const v4u rw = raw[rr][pc];
                float v[8];
                v[0] = __builtin_bit_cast(float, rw.x << 16); v[1] = __builtin_bit_cast(float, rw.x & 0xffff0000u); v[2] = __builtin_bit_cast(float, rw.y << 16); v[3] = __builtin_bit_cast(float, rw.y & 0xffff0000u);
                v[4] = __builtin_bit_cast(float, rw.z << 16); v[5] = __builtin_bit_cast(float, rw.z & 0xffff0000u); v[6] = __builtin_bit_cast(float, rw.w << 16); v[7] = __builtin_bit_cast(float, rw.w & 0xffff0000u);
                float ss = 0.f;
#pragma unroll
                for (int j = 0; j < 8; ++j) ss += v[j] * v[j];
                ss += __shfl_xor(ss, 1); ss += __shfl_xor(ss, 2); ss += __shfl_xor(ss, 4);
                const float r = 1.0f / sqrtf(ss * (1.f / 64.f) + EPS);
                float y[8];
#pragma unroll
                for (int j = 0; j < 8; ++j) y[j] = v[j] * r * (isk ? wk[j] : wq[j]);
#pragma unroll
                for (int j = 0; j < 8; ++j) { const float pv = __shfl_xor(y[j], 1);
                    if (sub == 0) y[j] = y[j] * cs[j] - pv * sn[j]; else if (sub == 1) y[j] = y[j] * cs[j] + pv * sn[j]; }
                v4u o; o.x = pk2(y[0], y[1]); o.y = pk2(y[2], y[3]); o.z = pk2(y[4], y[5]); o.w = pk2(y[6], y[7]);
                *(GAS v4u*)((isk ? KN : QN) + (size_t)m * 1024 + col) = o;
            }
        }
    }
}

struct AttnOrder { int vcu;
  __device__ __forceinline__ bool next(int i, int& bh, int& qb) const { if (i >= 8) return false; const int s = vcu & 7; bh = vcu; qb = (i + s) & 7; return true; } };
__device__ __forceinline__ void p3_attention(Frame& F, KA args, unsigned char* lds_generic) {
    const attn_body::bf16* QN = (const attn_body::bf16*)(F.ws + mp::qn); const attn_body::bf16* KN = (const attn_body::bf16*)(F.ws + mp::kn);
    const attn_body::bf16* U16 = (const attn_body::bf16*)(F.ws + mp::u16); attn_body::bf16* O1 = (attn_body::bf16*)(F.ws + mp::o1); attn_body::bf16* O2 = (attn_body::bf16*)(F.ws + mp::o2);
    AttnOrder S{F.vcu}; int bh, qb;
    for (int i = 0; S.next(i, bh, qb); ++i) {
        const int b = bh >> 5, h = (bh >> 2) & 7, comp = (bh >> 1) & 1, vh = bh & 1;
        attn_body::attn_unit<8>(b, 0, qb, QN + (h * 2 + comp) * 64, KN + (h * 2 + comp) * 64, U16 + UC_V + h * 128 + vh * 64, (comp ? O2 : O1) + h * 128 + vh * 64, (char*)lds_generic + RING_OFF);
    }
}

__device__ __forceinline__ void p4_ycat(Frame& F, KA args, int parts) {
    const int gw = F.vcu * NWAVES + F.wave, NGW = F.G * NWAVES, lane = F.lane;
    const bf16* U16 = (const bf16*)(F.ws + mp::u16); const bf16* YS = (const bf16*)(F.ws + mp::ys);
    const bf16* O1 = (const bf16*)(F.ws + mp::o1); const bf16* O2 = (const bf16*)(F.ws + mp::o2); bf16* YCAT = (bf16*)(F.ws + mp::ycat);
    const float* nw = (const float*)args->in[9]; const float* subw = (const float*)args->in[16];
    float lam;
    { const float* lq1 = (const float*)args->in[12]; const float* lk1 = (const float*)args->in[13]; const float* lq2 = (const float*)args->in[14]; const float* lk2 = (const float*)args->in[15];
      const float s1 = wave_sum(lq1[lane] * lk1[lane]), s2 = wave_sum(lq2[lane] * lk2[lane]); lam = expf(s1) - expf(s2) + 0.2f; }
    float w_s[2][8], w_a[8];
#pragma unroll
    for (int j = 0; j < 8; ++j) { w_s[0][j] = nw[lane * 8 + j]; w_s[1][j] = nw[512 + lane * 8 + j]; w_a[j] = subw[(lane & 15) * 8 + j] * 0.8f; }
    for (int it = 0; it < 4; ++it) { const int m0 = (F.vcu >> 5) * 2048 + it * 512 + ((F.vcu & 31) * NWAVES + F.wave) * 2;
        v4u yv[2][2], zv[2][2], av[2][2], bv[2][2];
#pragma unroll
        for (int rr = 0; rr < 2; ++rr) { const size_t m = (size_t)(m0 + rr);
#pragma unroll
            for (int sl = 0; sl < 2; ++sl) {
                if (parts & 1) { yv[rr][sl] = __builtin_nontemporal_load((const GAS v4u*)(YS + m * 1024 + 512 * sl + lane * 8)); zv[rr][sl] = __builtin_nontemporal_load((const GAS v4u*)(U16 + m * NIN + UC_Z + 512 * sl + lane * 8)); }
                if (parts & 2) { av[rr][sl] = __builtin_nontemporal_load((const GAS v4u*)(O1 + m * 1024 + 512 * sl + lane * 8)); bv[rr][sl] = __builtin_nontemporal_load((const GAS v4u*)(O2 + m * 1024 + 512 * sl + lane * 8)); } } }
#pragma unroll
        for (int rr = 0; rr < 2; ++rr) { const size_t m = (size_t)(m0 + rr);
#pragma unroll
        for (int sl = 0; sl < 2; ++sl) {
        if (parts & 1) {
            const v4u y0 = yv[rr][sl], z0 = zv[rr][sl];
            const unsigned yy[4] = {y0.x, y0.y, y0.z, y0.w}, zz[4] = {z0.x, z0.y, z0.z, z0.w};
            float v[8]; float ss = 0.f;
#pragma unroll
            for (int j = 0; j < 4; ++j) { const float ya = __builtin_bit_cast(float, yy[j] << 16), yb = __builtin_bit_cast(float, yy[j] & 0xffff0000u), za = __builtin_bit_cast(float, zz[j] << 16), zb = __builtin_bit_cast(float, zz[j] & 0xffff0000u);
                v[2 * j] = ya * za / (1.f + __expf(-za)); v[2 * j + 1] = yb * zb / (1.f + __expf(-zb)); ss += v[2 * j] * v[2 * j] + v[2 * j + 1] * v[2 * j + 1]; }
            ss = wave_sum(ss);
            const float r = 1.0f / sqrtf(ss * (1.f / 512.f) + EPS);
            v4u o0; o0.x = pk2(v[0] * r * w_s[sl][0], v[1] * r * w_s[sl][1]); o0.y = pk2(v[2] * r * w_s[sl][2], v[3] * r * w_s[sl][3]); o0.z = pk2(v[4] * r * w_s[sl][4], v[5] * r * w_s[sl][5]); o0.w = pk2(v[6] * r * w_s[sl][6], v[7] * r * w_s[sl][7]);
            *(GAS v4u*)(YCAT + m * DM + 512 * sl + lane * 8) = o0;
        }
        if (parts & 2) {
            const v4u a0 = av[rr][sl], b0 = bv[rr][sl];
            const unsigned aa[4] = {a0.x, a0.y, a0.z, a0.w}, bb[4] = {b0.x, b0.y, b0.z, b0.w};
            float v[8]; float ss = 0.f;
#pragma unroll
            for (int j = 0; j < 4; ++j) { v[2 * j] = __builtin_bit_cast(float, aa[j] << 16) - lam * __builtin_bit_cast(float, bb[j] << 16); v[2 * j + 1] = __builtin_bit_cast(float, aa[j] & 0xffff0000u) - lam * __builtin_bit_cast(float, bb[j] & 0xffff0000u);
                ss += v[2 * j] * v[2 * j] + v[2 * j + 1] * v[2 * j + 1]; }
            ss += __shfl_xor(ss, 1); ss += __shfl_xor(ss, 2); ss += __shfl_xor(ss, 4); ss += __shfl_xor(ss, 8);
            const float r = 1.0f / sqrtf(ss * (1.f / 128.f) + EPS);
            v4u o0; o0.x = pk2(v[0] * r * w_a[0], v[1] * r * w_a[1]); o0.y = pk2(v[2] * r * w_a[2], v[3] * r * w_a[3]); o0.z = pk2(v[4] * r * w_a[4], v[5] * r * w_a[5]); o0.w = pk2(v[6] * r * w_a[6], v[7] * r * w_a[7]);
            *(GAS v4u*)(YCAT + m * DM + 1024 + 512 * sl + lane * 8) = o0;
        }
        }
        }
    }
}

constexpr int CONV_R = 8;
__device__ __forceinline__ void p2_conv(Frame& F, KA args) {
    const int gw = F.vcu * NWAVES + F.wave, NGW = F.G * NWAVES, lane = F.lane;
    const bf16* U16 = (const bf16*)(F.ws + mp::u16); bf16* XBC = (bf16*)(F.ws + mp::xbc);
    const float* cw = (const float*)args->in[4]; const float* cb = (const float*)args->in[5];
    for (int it = 0; it < 3; ++it) { const int task = (F.vcu & 31) * NWAVES + F.wave + 256 * it;
        const int cblk = task % 3, r0 = (F.vcu >> 5) * 2048 + (task / 3) * CONV_R, c0 = cblk * 512 + lane * 8;
        const bool seq_start = (r0 % SEQ) == 0;
        v4u raw[CONV_R + 3];
#pragma unroll
        for (int j = 0; j < CONV_R + 3; ++j) { raw[j] = (v4u){0u, 0u, 0u, 0u}; if (j >= 3 || !seq_start) raw[j] = __builtin_nontemporal_load((const GAS v4u*)(U16 + (size_t)(r0 - 3 + j) * NIN + UC_XBC + c0)); }
        float w[4][8], bias[8];
#pragma unroll
        for (int j = 0; j < 4; ++j)
#pragma unroll
            for (int i = 0; i < 8; ++i) w[j][i] = cw[j * 1536 + c0 + i];
#pragma unroll
        for (int i = 0; i < 8; ++i) bias[i] = cb[c0 + i];
#pragma unroll
        for (int t = 0; t < CONV_R; ++t) {
            float o[8];
#pragma unroll
            for (int i = 0; i < 8; ++i) o[i] = bias[i];
#pragma unroll
            for (int j = 0; j < 4; ++j) { const v4u rw = raw[t + j];
                const float e[8] = {__builtin_bit_cast(float, rw.x << 16), __builtin_bit_cast(float, rw.x & 0xffff0000u), __builtin_bit_cast(float, rw.y << 16), __builtin_bit_cast(float, rw.y & 0xffff0000u),
                                    __builtin_bit_cast(float, rw.z << 16), __builtin_bit_cast(float, rw.z & 0xffff0000u), __builtin_bit_cast(float, rw.w << 16), __builtin_bit_cast(float, rw.w & 0xffff0000u)};
#pragma unroll
                for (int i = 0; i < 8; ++i) o[i] += w[j][i] * e[i]; }
#pragma unroll
            for (int i = 0; i < 8; ++i) o[i] = o[i] / (1.f + __expf(-o[i]));
            v4u ov; ov.x = pk2(o[0], o[1]); ov.y = pk2(o[2], o[3]); ov.z = pk2(o[4], o[5]); ov.w = pk2(o[6], o[7]);
            *(GAS v4u*)(XBC + (size_t)(r0 + t) * 1536 + c0) = ov;
        }
    }
}

namespace ssd {
constexpr int BCS = 2064;
constexpr int LB = 0, LC = LB + 16 * BCS, LX = LC + 16 * BCS, LXW = LX + 8192, LST = LXW + 8192, STB = 8704, LA = LST + 2 * STB, LSL = LA + 4096, SSD_LDS_END = LSL + 10 * 4096;
static_assert(SSD_LDS_END <= LDSCTL_OFF, "SSD tiles vs LDS control words");
typedef float f32x16 __attribute__((ext_vector_type(16)));
#define SSD_PIN8(a) asm volatile("" : "+v"(a[0]), "+v"(a[1]), "+v"(a[2]), "+v"(a[3]), "+v"(a[4]), "+v"(a[5]), "+v"(a[6]), "+v"(a[7]))
#define SSD_PIN4(a) asm volatile("" : "+v"(a[0]), "+v"(a[1]), "+v"(a[2]), "+v"(a[3]))
struct Ctx { LAS unsigned char* lds; const LAS float* a2; const LAS float* dtl; const LAS float* fsl; int lane, r32, hi; };
__device__ __forceinline__ void load_cf(const Ctx& c, int lb, bf16x8 (&cf)[8]) {
#pragma unroll
    for (int ks = 0; ks < 8; ++ks) cf[ks] = *(const LAS bf16x8*)(c.lds + LC + (2 * ks + c.hi) * BCS + (32 * lb + c.r32) * 16);
    SSD_PIN8(cf);
}
template <bool DIAG> __device__ __forceinline__ void intra(const Ctx& c, int lb, int st, const bf16x8 (&cf)[8], f32x16& y) {
    bf16x8 bq[8];
#pragma unroll
    for (int ks = 0; ks < 8; ++ks) bq[ks] = *(const LAS bf16x8*)(c.lds + LB + (2 * ks + c.hi) * BCS + (32 * st + c.r32) * 16);
    f32x4 av[4], dv[4];
#pragma unroll
    for (int q = 0; q < 4; ++q) { av[q] = *(const LAS f32x4*)((DIAG ? c.a2 : c.fsl) + 32 * st + 8 * q + 4 * c.hi); if (DIAG) dv[q] = *(const LAS f32x4*)(c.dtl + 32 * st + 8 * q + 4 * c.hi); }
    const float al = c.a2[32 * lb + c.r32], aref = c.a2[32 * st + 31];
    SSD_PIN8(bq); SSD_PIN4(av); if (DIAG) SSD_PIN4(dv);
    f32x16 p;
#pragma unroll
    for (int r = 0; r < 16; ++r) p[r] = 0.f;
#pragma unroll
    for (int ks = 0; ks < 8; ++ks) p = __builtin_amdgcn_mfma_f32_32x32x16_bf16(bq[ks], cf[ks], p, 0, 0, 0);
    if (DIAG) {
        float e[16];
#pragma unroll
        for (int r = 0; r < 16; ++r) e[r] = __builtin_amdgcn_exp2f(fminf(al - av[r >> 2][r & 3], 0.f));
#pragma unroll
        for (int r = 0; r < 16; ++r) { const int sl = attn_body::crow(r, c.hi); const float v = p[r] * e[r] * dv[r >> 2][r & 3]; p[r] = sl > c.r32 ? 0.f : v; }
    } else {
        const float el = __builtin_amdgcn_exp2f(al - aref);
#pragma unroll
        for (int r = 0; r < 16; ++r) p[r] *= el * av[r >> 2][r & 3];
    }
    v4u pw0, pw1;
    pw0.x = attn_body::cvtpk_s(p[0], p[1]); pw0.y = attn_body::cvtpk_s(p[2], p[3]); pw0.z = attn_body::cvtpk_s(p[4], p[5]); pw0.w = attn_body::cvtpk_s(p[6], p[7]);
    pw1.x = attn_body::cvtpk_s(p[8], p[9]); pw1.y = attn_body::cvtpk_s(p[10], p[11]); pw1.z = attn_body::cvtpk_s(p[12], p[13]); pw1.w = attn_body::cvtpk_s(p[14], p[15]);
    const LAS unsigned char* xb = c.lds + LX + ((c.lane >> 4) & 1) * 32 + (c.lane & 3) * 8 + (4 * c.hi + ((c.lane & 15) >> 2)) * 64 + (32 * st) * 64;
    const attn_body::s16x4 lo0 = attn_body::vtr((attn_body::lds_cptr)(xb)), hh0 = attn_body::vtr((attn_body::lds_cptr)(xb + 512));
    const attn_body::s16x4 lo1 = attn_body::vtr((attn_body::lds_cptr)(xb + 1024)), hh1 = attn_body::vtr((attn_body::lds_cptr)(xb + 1024 + 512));
    y = __builtin_amdgcn_mfma_f32_32x32x16_bf16(__builtin_bit_cast(bf16x8, pw0), (bf16x8){lo0[0], lo0[1], lo0[2], lo0[3], hh0[0], hh0[1], hh0[2], hh0[3]}, y, 0, 0, 0);
    y = __builtin_amdgcn_mfma_f32_32x32x16_bf16(__builtin_bit_cast(bf16x8, pw1), (bf16x8){lo1[0], lo1[1], lo1[2], lo1[3], hh1[0], hh1[1], hh1[2], hh1[3]}, y, 0, 0, 0);
}
__device__ __forceinline__ void yoff(const Ctx& c, int lb, int sbuf, f32x16& y) {
    bf16x8 cf[8], sf[8]; f32x4 av[4];
    load_cf(c, lb, cf);
#pragma unroll
    for (int ks = 0; ks < 8; ++ks) sf[ks] = *(const LAS bf16x8*)(c.lds + LST + sbuf * STB + c.r32 * 272 + (16 * ks + 8 * c.hi) * 2);
#pragma unroll
    for (int q = 0; q < 4; ++q) av[q] = *(const LAS f32x4*)(c.a2 + 32 * lb + 8 * q + 4 * c.hi);
    SSD_PIN8(cf); SSD_PIN8(sf); SSD_PIN4(av);
#pragma unroll
    for (int r = 0; r < 16; ++r) y[r] = 0.f;
#pragma unroll
    for (int ks = 0; ks < 8; ++ks) y = __builtin_amdgcn_mfma_f32_32x32x16_bf16(cf[ks], sf[ks], y, 0, 0, 0);
#pragma unroll
    for (int r = 0; r < 16; ++r) y[r] *= __builtin_amdgcn_exp2f(av[r >> 2][r & 3]);
}
__device__ __forceinline__ void state_item(const Ctx& c, int nt, int nbuf, f32x16& st) {
    const int i16 = c.lane & 15, g1 = (c.lane >> 4) & 1;
    const float dall = __builtin_amdgcn_exp2f(c.a2[127]);
#pragma unroll
    for (int r = 0; r < 16; ++r) st[r] *= dall;
    const LAS unsigned char* ab = c.lds + LB + (4 * nt + 2 * g1 + ((i16 & 3) >> 1)) * BCS + (8 * c.hi + (i16 >> 2)) * 16 + (i16 & 1) * 8;
    const LAS unsigned char* wb = c.lds + LXW + (8 * c.hi + (i16 >> 2)) * 64 + g1 * 32 + (i16 & 3) * 8;
#pragma unroll
    for (int kb = 0; kb < 2; ++kb) {
        bf16x8 af[4], wf[4];
#pragma unroll
        for (int kk = 0; kk < 4; ++kk) { const int ks = kb * 4 + kk;
            const attn_body::s16x4 a0 = attn_body::vtr((attn_body::lds_cptr)(ab + ks * 256)), a1 = attn_body::vtr((attn_body::lds_cptr)(ab + ks * 256 + 64));
            const attn_body::s16x4 w0 = attn_body::vtr((attn_body::lds_cptr)(wb + ks * 1024)), w1 = attn_body::vtr((attn_body::lds_cptr)(wb + ks * 1024 + 256));
            af[kk] = (bf16x8){a0[0], a0[1], a0[2], a0[3], a1[0], a1[1], a1[2], a1[3]}; wf[kk] = (bf16x8){w0[0], w0[1], w0[2], w0[3], w1[0], w1[1], w1[2], w1[3]}; }
        SSD_PIN4(af); SSD_PIN4(wf);
#pragma unroll
        for (int kk = 0; kk < 4; ++kk) st = __builtin_amdgcn_mfma_f32_32x32x16_bf16(af[kk], wf[kk], st, 0, 0, 0);
    }
#pragma unroll
    for (int q = 0; q < 4; ++q) { v2u w; w.x = attn_body::cvtpk_s(st[4 * q], st[4 * q + 1]); w.y = attn_body::cvtpk_s(st[4 * q + 2], st[4 * q + 3]);
        *(LAS v2u*)(c.lds + LST + nbuf * STB + c.r32 * 272 + (32 * nt + 8 * q + 4 * c.hi) * 2) = w; }
}
__device__ __forceinline__ void put_slot(const Ctx& c, int slot, const f32x16& y) {
    LAS float* sp = (LAS float*)(c.lds + LSL + slot * 4096);
#pragma unroll
    for (int r = 0; r < 16; ++r) sp[attn_body::crow(r, c.hi) * 32 + c.r32] = y[r];
}
__device__ __forceinline__ void unit(Frame& F, KA args, int u) {
    const int tid = F.tid, lane = F.lane, wave = F.wave, r32 = lane & 31, hi = lane >> 5;
    const int b = u >> 5, h = (u >> 1) & 15, ph = u & 1, g = h >> 3;
    const bf16* XBC = (const bf16*)(F.ws + mp::xbc); const float* DTR = (const float*)(F.ws + mp::dt); bf16* YS = (bf16*)(F.ws + mp::ys);
    const float dtb = ((const float*)args->in[6])[h], Ah = -expf(((const float*)args->in[7])[h]) * 1.44269504089f, Dk = ((const float*)args->in[8])[h];
    LAS unsigned char* lds = F.lds + RING_OFF;
    const size_t mbase = (size_t)b * SEQ;
    const int brow = tid >> 4, bchk = tid & 15;
    const int xrow = tid >> 2, xpc = tid & 3;
    v4u Breg[4], Creg[4], xreg;
#define SSD_LOAD_REGS(k_) do { const size_t m0_ = mbase + (size_t)(k_) * 128; \
        _Pragma("unroll") for (int i = 0; i < 4; ++i) { Breg[i] = *(const GAS v4u*)(XBC + (m0_ + brow + 32 * i) * 1536 + 1024 + g * 128 + bchk * 8); Creg[i] = *(const GAS v4u*)(XBC + (m0_ + brow + 32 * i) * 1536 + 1280 + g * 128 + bchk * 8); } \
        xreg = *(const GAS v4u*)(XBC + (m0_ + xrow) * 1536 + h * 64 + ph * 32 + xpc * 8); } while (0)
    float dtr0 = 0.f, dtr1 = 0.f;
#define SSD_LOAD_DT(k_) do { const size_t m0_ = mbase + (size_t)(k_) * 128; dtr0 = DTR[(m0_ + 2 * lane) * 16 + h]; dtr1 = DTR[(m0_ + 2 * lane + 1) * 16 + h]; } while (0)
#define SSD_PREP_A(buf_) do { \
        const float r0 = dtr0 + dtb, r1 = dtr1 + dtb; \
        const float d0 = r0 > 20.f ? r0 : log1pf(expf(r0)), d1 = r1 > 20.f ? r1 : log1pf(expf(r1)); \
        const float v0 = d0 * Ah, v1 = d1 * Ah; float s_ = v0 + v1; \
        _Pragma("unroll") for (int o = 1; o < 64; o <<= 1) { const float t = __shfl_up(s_, o); if (lane >= o) s_ += t; } \
        LAS float* a2w = (LAS float*)(lds + LA + (buf_) * 2048); LAS float* dtw = a2w + 128; LAS float* fw = a2w + 256; \
        const float aref_ = __shfl(s_, (lane & 48) | 15); \
        a2w[2 * lane] = s_ - v1; a2w[2 * lane + 1] = s_; dtw[2 * lane] = d0; dtw[2 * lane + 1] = d1; \
        fw[2 * lane] = __builtin_amdgcn_exp2f(aref_ - (s_ - v1)) * d0; fw[2 * lane + 1] = __builtin_amdgcn_exp2f(aref_ - s_) * d1; } while (0)
    f32x16 stA, stB;
#pragma unroll
    for (int r = 0; r < 16; ++r) { stA[r] = 0.f; stB[r] = 0.f; }
    SSD_LOAD_REGS(0);
    if (wave == 1) { SSD_LOAD_DT(0); SSD_PREP_A(0); }
    LDS_WAIT(); __syncthreads();
#pragma nounroll
    for (int k = 0; k < 16; ++k) {
        const int buf = k & 1, nb = buf ^ 1; const size_t m0 = mbase + (size_t)k * 128;
        Ctx c; c.lds = lds; c.a2 = (const LAS float*)(lds + LA + buf * 2048); c.dtl = c.a2 + 128; c.fsl = c.a2 + 256; c.lane = lane; c.r32 = r32; c.hi = hi;
#pragma unroll
        for (int i = 0; i < 4; ++i) { *(LAS v4u*)(lds + LB + bchk * BCS + (brow + 32 * i) * 16) = Breg[i]; *(LAS v4u*)(lds + LC + bchk * BCS + (brow + 32 * i) * 16) = Creg[i]; }
        *(LAS v4u*)(lds + LX + xrow * 64 + xpc * 16) = xreg;
        { const float wsc = __builtin_amdgcn_exp2f(c.a2[127] - c.a2[xrow]) * c.dtl[xrow];
          const float x0 = __builtin_bit_cast(float, xreg.x << 16) * wsc, x1 = __builtin_bit_cast(float, xreg.x & 0xffff0000u) * wsc, x2 = __builtin_bit_cast(float, xreg.y << 16) * wsc, x3 = __builtin_bit_cast(float, xreg.y & 0xffff0000u) * wsc;
          const float x4 = __builtin_bit_cast(float, xreg.z << 16) * wsc, x5 = __builtin_bit_cast(float, xreg.z & 0xffff0000u) * wsc, x6 = __builtin_bit_cast(float, xreg.w << 16) * wsc, x7 = __builtin_bit_cast(float, xreg.w & 0xffff0000u) * wsc;
          v4u xw; xw.x = pk2(x0, x1); xw.y = pk2(x2, x3); xw.z = pk2(x4, x5); xw.w = pk2(x6, x7);
          *(LAS v4u*)(lds + LXW + xrow * 64 + xpc * 16) = xw; }
        LDS_WAIT(); __syncthreads();
        if (k < 15) { SSD_LOAD_REGS(k + 1); if (wave == 1) SSD_LOAD_DT(k + 1); }
        {
            f32x16 y; bf16x8 cf[8];
#pragma unroll
            for (int r = 0; r < 16; ++r) y[r] = 0.f;
            if (wave == 0)      { load_cf(c, 3, cf); intra<true>(c, 3, 3, cf, y); intra<false>(c, 3, 2, cf, y); put_slot(c, 0, y); }
            else if (wave == 1) { load_cf(c, 3, cf); intra<false>(c, 3, 1, cf, y); intra<false>(c, 3, 0, cf, y); put_slot(c, 1, y); if (k < 15) SSD_PREP_A(nb); }
            else if (wave == 2) { load_cf(c, 2, cf); intra<true>(c, 2, 2, cf, y); intra<false>(c, 2, 1, cf, y); put_slot(c, 3, y); }
            else if (wave == 3) { load_cf(c, 2, cf); intra<false>(c, 2, 0, cf, y); put_slot(c, 4, y);
#pragma unroll
                                  for (int r = 0; r < 16; ++r) y[r] = 0.f;
                                  load_cf(c, 0, cf); intra<true>(c, 0, 0, cf, y); put_slot(c, 8, y); }
            else if (wave == 4) { load_cf(c, 1, cf); intra<true>(c, 1, 1, cf, y); intra<false>(c, 1, 0, cf, y); put_slot(c, 6, y); }
            else if (wave == 5) { if (k > 0) { yoff(c, 3, buf, y); put_slot(c, 2, y); yoff(c, 2, buf, y); put_slot(c, 5, y); yoff(c, 1, buf, y); put_slot(c, 7, y); yoff(c, 0, buf, y); put_slot(c, 9, y); } }
            else if (wave == 6) { state_item(c, 0, nb, stA); state_item(c, 1, nb, stB); }
            else                { state_item(c, 2, nb, stA); state_item(c, 3, nb, stB); }
        }
        LDS_WAIT(); __syncthreads();
        { const int row = tid >> 2, pc = tid & 3, lb = wave >> 1, rl = row & 31;
          const int s0 = lb == 3 ? 0 : (lb == 2 ? 3 : (lb == 1 ? 6 : 8)), s1 = lb == 3 ? 1 : (lb == 2 ? 4 : -1), so = lb == 3 ? 2 : (lb == 2 ? 5 : (lb == 1 ? 7 : 9));
          const LAS float* p0 = (const LAS float*)(lds + LSL + s0 * 4096) + rl * 32 + pc * 8;
          f32x4 ya = *(const LAS f32x4*)p0, yb = *(const LAS f32x4*)(p0 + 4);
          if (s1 >= 0) { const LAS float* p1 = (const LAS float*)(lds + LSL + s1 * 4096) + rl * 32 + pc * 8; ya += *(const LAS f32x4*)p1; yb += *(const LAS f32x4*)(p1 + 4); }
          if (k > 0) { const LAS float* p2 = (const LAS float*)(lds + LSL + so * 4096) + rl * 32 + pc * 8; ya += *(const LAS f32x4*)p2; yb += *(const LAS f32x4*)(p2 + 4); }
          const v4u xv = *(const LAS v4u*)(lds + LX + row * 64 + pc * 16);
          v4u o; o.x = pk2(ya.x + Dk * __builtin_bit_cast(float, xv.x << 16), ya.y + Dk * __builtin_bit_cast(float, xv.x & 0xffff0000u)); o.y = pk2(ya.z + Dk * __builtin_bit_cast(float, xv.y << 16), ya.w + Dk * __builtin_bit_cast(float, xv.y & 0xffff0000u));
          o.z = pk2(yb.x + Dk * __builtin_bit_cast(float, xv.z << 16), yb.y + Dk * __builtin_bit_cast(float, xv.z & 0xffff0000u)); o.w = pk2(yb.z + Dk * __builtin_bit_cast(float, xv.w << 16), yb.w + Dk * __builtin_bit_cast(float, xv.w & 0xffff0000u));
          *(GAS v4u*)(YS + (m0 + row) * 1024 + h * 64 + ph * 32 + pc * 8) = o; }
    }
    LDS_WAIT(); __syncthreads();
#undef SSD_LOAD_REGS
#undef SSD_LOAD_DT
#undef SSD_PREP_A
}
#undef SSD_PIN8
#undef SSD_PIN4
}
__device__ __forceinline__ void p3_ssd(Frame& F, KA args) {
    for (int u = F.vcu; u < 256; u += F.G) ssd::unit(F, args, u);
}

__device__ __forceinline__ void p0_small(Frame& F, KA args) {
    const int gt = (F.vcu * NWAVES + F.wave) * 64 + F.lane, NGT = F.G * NWAVES * 64;
    const float* ln2 = (const float*)args->in[18]; const float* wrg = (const float*)args->in[19]; const float* wre = (const float*)args->in[21];
    bf16* WRH = (bf16*)(F.ws + mp::wr); bf16* WRL = WRH + 48 * DM;
    for (int i = gt; i < 48 * DM; i += NGT) { const int c = i / DM, k = i % DM;
        const float w = (c < 4 ? wrg[k * 4 + c] : (c < 36 ? wre[k * 32 + (c - 4)] : 0.f)) * ln2[k];
        const unsigned hi = f2bf(w); const float lo = w - bf2f((unsigned short)hi);
        WRH[i] = (bf16)hi; WRL[i] = (bf16)f2bf(lo); }
    { GAS v4u* z = (GAS v4u*)((bf16*)(F.ws + mp::win) + (size_t)(NIN + 16) * DM);
      for (int i = gt; i < (NIN_G - NIN - 16) * DM / 8; i += NGT) z[i] = (v4u){0u, 0u, 0u, 0u}; }
}

__device__ __forceinline__ void p5_route(Frame& F, KA args) {
    const int lane = F.lane;
    const bf16* h = (const bf16*)(F.ws + mp::xn2);
    const bf16* WRH = (const bf16*)(F.ws + mp::wr); const bf16* WRL = WRH + 48 * DM;
    const float* brg = (const float*)args->in[20]; const float* bre = (const float*)args->in[22];
    int* tok_e = (int*)(F.ws + mp::small + SM_TOK_E); int* tok_pos = (int*)(F.ws + mp::small + SM_TOK_POS); float* tok_w = (float*)(F.ws + mp::small + SM_TOK_W);
    int* lst_tok = (int*)(F.ws + mp::lst); float* lst_w = (float*)(F.ws + mp::lst) + NE * LCAP; float* lst_r = lst_w + NE * LCAP;
    unsigned* cnt = (unsigned*)(F.ctl + CW_CNT);
    LAS float* lg = (LAS float*)(F.lds + RING_OFF + F.wave * 4096);
    constexpr int KQ = 512, WQB = 2 * 48 * KQ * 2;
    LAS unsigned char* wq = F.lds + RING_OFF + 32768;
    for (int wt = F.vcu; wt < M / 64; wt += F.G) {
        const int rt = F.wave & 3, kh = F.wave >> 2, task = wt * 4 + rt;
        const bf16* hr = h + (size_t)(task * 16 + (lane & 15)) * DM + (lane >> 4) * 8;
        f32x4 acc0 = (f32x4){0.f, 0.f, 0.f, 0.f}, acc1 = acc0, acc2 = acc0; float ss = 0.f;
        for (int q = 0; q < DM / KQ; ++q) {
            __syncthreads();
#pragma unroll
            for (int i = 0; i < 12; ++i) { const int pc = F.tid + 512 * i, row = pc >> 6, c16 = pc & 63;
                const v4u v = *(const GAS v4u*)((row < 48 ? WRH + (size_t)row * DM : WRL + (size_t)(row - 48) * DM) + q * KQ + c16 * 8);
                *(LAS v4u*)(wq + row * 1040 + c16 * 16) = v; }
            LDS_WAIT(); __syncthreads();
#pragma unroll 4
            for (int k8 = 0; k8 < 8; ++k8) {
                const int kt = kh * 8 + k8;
                const v4u hv = *(const GAS v4u*)(hr + q * KQ + kt * 32);
                { const float e0 = __builtin_bit_cast(float, hv.x << 16), e1 = __builtin_bit_cast(float, hv.x & 0xffff0000u), e2 = __builtin_bit_cast(float, hv.y << 16), e3 = __builtin_bit_cast(float, hv.y & 0xffff0000u);
                  const float e4 = __builtin_bit_cast(float, hv.z << 16), e5 = __builtin_bit_cast(float, hv.z & 0xffff0000u), e6 = __builtin_bit_cast(float, hv.w << 16), e7 = __builtin_bit_cast(float, hv.w & 0xffff0000u);
                  ss += (e0 * e0 + e1 * e1) + (e2 * e2 + e3 * e3) + (e4 * e4 + e5 * e5) + (e6 * e6 + e7 * e7); }
                const bf16x8 ah = __builtin_bit_cast(bf16x8, hv);
                const LAS unsigned char* bp = wq + (lane & 15) * 1040 + kt * 64 + (lane >> 4) * 16;
                { const bf16x8 b_h = *(const LAS bf16x8*)(bp), b_l = *(const LAS bf16x8*)(bp + 48 * 1040);
                  acc0 = __builtin_amdgcn_mfma_f32_16x16x32_bf16(ah, b_h, acc0, 0, 0, 0); acc0 = __builtin_amdgcn_mfma_f32_16x16x32_bf16(ah, b_l, acc0, 0, 0, 0); }
                { const bf16x8 b_h = *(const LAS bf16x8*)(bp + 16 * 1040), b_l = *(const LAS bf16x8*)(bp + 64 * 1040);
                  acc1 = __builtin_amdgcn_mfma_f32_16x16x32_bf16(ah, b_h, acc1, 0, 0, 0); acc1 = __builtin_amdgcn_mfma_f32_16x16x32_bf16(ah, b_l, acc1, 0, 0, 0); }
                { const bf16x8 b_h = *(const LAS bf16x8*)(bp + 32 * 1040), b_l = *(const LAS bf16x8*)(bp + 80 * 1040);
                  acc2 = __builtin_amdgcn_mfma_f32_16x16x32_bf16(ah, b_h, acc2, 0, 0, 0); acc2 = __builtin_amdgcn_mfma_f32_16x16x32_bf16(ah, b_l, acc2, 0, 0, 0); }
            }
        }
        __syncthreads();
        LAS float* xp = (LAS float*)(F.lds + RING_OFF + 32768 + rt * 4096) + lane * 13;
        if (kh == 1) {
#pragma unroll
            for (int q = 0; q < 4; ++q) { xp[q] = acc0[q]; xp[4 + q] = acc1[q]; xp[8 + q] = acc2[q]; }
            xp[12] = ss; }
        LDS_WAIT(); __syncthreads();
        if (kh == 0) {
#pragma unroll
        for (int q = 0; q < 4; ++q) { acc0[q] += xp[q]; acc1[q] += xp[4 + q]; acc2[q] += xp[8 + q]; }
        ss += xp[12];
        ss += __shfl_xor(ss, 16); ss += __shfl_xor(ss, 32);
        const float r = 1.0f / sqrtf(ss * (1.f / DM) + EPS);
#pragma unroll
        for (int reg = 0; reg < 4; ++reg) { const int row = (lane >> 4) * 4 + reg; const float rr = __shfl(r, row);
            lg[row * 48 + (lane & 15)] = acc0[reg] * rr; lg[row * 48 + 16 + (lane & 15)] = acc1[reg] * rr; lg[row * 48 + 32 + (lane & 15)] = acc2[reg] * rr; }
        LDS_WAIT(); asm volatile("" ::: "memory");
        if (lane < 16) {
            const LAS float* L = lg + lane * 48; const int tok = task * 16 + lane;
            float gl[4];
#pragma unroll
            for (int j = 0; j < 4; ++j) gl[j] = L[j] + brg[j];
            int gs = 0; float gm = gl[0];
#pragma unroll
            for (int j = 1; j < 4; ++j) if (gl[j] > gm) { gm = gl[j]; gs = j; }
            float gsum = 0.f;
#pragma unroll
            for (int j = 0; j < 4; ++j) gsum += expf(gl[j] - gm);
            const float gwt = 1.f / gsum;
            float el[8];
#pragma unroll
            for (int j = 0; j < 8; ++j) el[j] = L[4 + gs * 8 + j] + bre[gs * 8 + j];
            int i1 = 0; float m1 = el[0];
#pragma unroll
            for (int j = 1; j < 8; ++j) if (el[j] > m1) { m1 = el[j]; i1 = j; }
            int i2 = 0; float m2 = -INFINITY;
#pragma unroll
            for (int j = 0; j < 8; ++j) if (j != i1 && el[j] > m2) { m2 = el[j]; i2 = j; }
            const float e2 = expf(m2 - m1); const float w1 = gwt / (1.f + e2), w2 = gwt * e2 / (1.f + e2);
            const int ea = gs * 8 + i1, eb = gs * 8 + i2;
            tok_e[tok * 2] = ea; tok_e[tok * 2 + 1] = eb; tok_w[tok * 2] = w1; tok_w[tok * 2 + 1] = w2;
            const int pa = (int)__hip_atomic_fetch_add(cnt + ea, 1u, RLX_AGENT), pb = (int)__hip_atomic_fetch_add(cnt + eb, 1u, RLX_AGENT);
            tok_pos[tok * 2] = pa; tok_pos[tok * 2 + 1] = pb;
            lst_tok[ea * LCAP + pa] = tok; lst_w[ea * LCAP + pa] = w1; lst_r[ea * LCAP + pa] = r; lst_tok[eb * LCAP + pb] = tok; lst_w[eb * LCAP + pb] = w2; lst_r[eb * LCAP + pb] = r;
        }
        }
        LDS_WAIT(); __syncthreads();
    }
}

__device__ __forceinline__ void build_tab(Frame& F, KA args) {
    LAS int* tab = (LAS int*)(F.lds + TAB_OFF);
    if (F.wave == 0) {
        const int lane = F.lane, e = lane & 31; unsigned* cnt = (unsigned*)(F.ctl + CW_CNT);
        const int c = (int)__hip_atomic_load(cnt + e, RLX_AGENT), mt = (c + 255) >> 8;
        int sc = mt;
#pragma unroll
        for (int o = 1; o < 32; o <<= 1) { const int t = __shfl_up(sc, o); if (e >= o) sc += t; }
        if (lane < 32) { tab[e] = (sc - mt) * 8; tab[40 + e] = sc - mt; tab[80 + e] = c; }
        if (lane == 31) { tab[32] = sc * 8; tab[72] = sc; }
    }
    LDS_WAIT(); __syncthreads();
}

__device__ __forceinline__ void p8_combine(Frame& F, KA args) {
    const int gw = F.vcu * NWAVES + F.wave, NGW = F.G * NWAVES, lane = F.lane;
    build_tab(F, args);
    const LAS int* tab = (const LAS int*)(F.lds + TAB_OFF);
    const int* tok_e = (const int*)(F.ws + mp::small + SM_TOK_E); const int* tok_pos = (const int*)(F.ws + mp::small + SM_TOK_POS); const unsigned char* Y8 = (const unsigned char*)(F.ws + mp::y); float* out = args->out;
    const bf16* HB = (const bf16*)(F.ws + mp::xn2);
    v4u hvA[2][2], avA[2], bvA[2], hvB[2][2], avB[2], bvB[2];
#define P8_LOAD(t_, hv_, av_, bv_) do { const int s0_ = tab[40 + tok_e[2 * (t_)]] * 256 + tok_pos[2 * (t_)], s1_ = tab[40 + tok_e[2 * (t_) + 1]] * 256 + tok_pos[2 * (t_) + 1]; \
        _Pragma("unroll") for (int j = 0; j < 2; ++j) { const int c0 = 16 * (lane + 64 * j); \
            hv_[j][0] = __builtin_nontemporal_load((const GAS v4u*)(HB + (size_t)(t_) * DM + c0)); hv_[j][1] = __builtin_nontemporal_load((const GAS v4u*)(HB + (size_t)(t_) * DM + c0 + 8)); \
            av_[j] = __builtin_nontemporal_load((const GAS v4u*)(Y8 + (size_t)s0_ * DM + c0)); bv_[j] = __builtin_nontemporal_load((const GAS v4u*)(Y8 + (size_t)s1_ * DM + c0)); } } while (0)
#define P8_STORE(t_, hv_, av_, bv_) do { \
        _Pragma("unroll") for (int j = 0; j < 2; ++j) { const int c0 = 16 * (lane + 64 * j); \
            const unsigned hw[8] = {hv_[j][0].x, hv_[j][0].y, hv_[j][0].z, hv_[j][0].w, hv_[j][1].x, hv_[j][1].y, hv_[j][1].z, hv_[j][1].w}; \
            const unsigned aw[4] = {av_[j].x, av_[j].y, av_[j].z, av_[j].w}, bw[4] = {bv_[j].x, bv_[j].y, bv_[j].z, bv_[j].w}; \
            _Pragma("unroll") for (int q = 0; q < 4; ++q) { \
                const f32x2_t a01 = __builtin_amdgcn_cvt_pk_f32_fp8((int)aw[q], false), a23 = __builtin_amdgcn_cvt_pk_f32_fp8((int)aw[q], true); \
                const f32x2_t b01 = __builtin_amdgcn_cvt_pk_f32_fp8((int)bw[q], false), b23 = __builtin_amdgcn_cvt_pk_f32_fp8((int)bw[q], true); \
                f32x4 v; \
                v.x = __builtin_bit_cast(float, hw[2 * q] << 16) + (a01.x + b01.x) * (1.f / Y8_SCALE); v.y = __builtin_bit_cast(float, hw[2 * q] & 0xffff0000u) + (a01.y + b01.y) * (1.f / Y8_SCALE); \
                v.z = __builtin_bit_cast(float, hw[2 * q + 1] << 16) + (a23.x + b23.x) * (1.f / Y8_SCALE); v.w = __builtin_bit_cast(float, hw[2 * q + 1] & 0xffff0000u) + (a23.y + b23.y) * (1.f / Y8_SCALE); \
                *(GAS f32x4*)(out + (size_t)(t_) * DM + c0 + 4 * q) = v; } } } while (0)
    typedef float f32x2_t __attribute__((ext_vector_type(2)));
    if (gw < M) P8_LOAD(gw, hvA, avA, bvA);
    for (int t = gw; t < M; t += 2 * NGW) {
        P8_LOAD(t + NGW, hvB, avB, bvB);
        P8_STORE(t, hvA, avA, bvA);
        if (t + 2 * NGW < M) P8_LOAD(t + 2 * NGW, hvA, avA, bvA);
        P8_STORE(t + NGW, hvB, avB, bvB);
    }
#undef P8_LOAD
#undef P8_STORE
}

constexpr int N_PHASES = 11;
#ifndef MK_REP_BAR
#define MK_REP_BAR 0
#endif
#ifndef MK_REP_PHASE
#define MK_REP_PHASE -1
#endif
#define PHASE_ARGS() ({ KA p_ = (KA)__builtin_amdgcn_kernarg_segment_ptr(); asm volatile("" : "+s"(p_)); p_; })
__global__ void __launch_bounds__(NWAVES * 64, 2) mega(Args args_byval) {
    KA args = PHASE_ARGS(); (void)args_byval;
    extern __shared__ __attribute__((aligned(16))) unsigned char lds[];
    Frame F;
    F.lds = (LAS unsigned char*)lds;
    F.MISC = (volatile LAS unsigned*)(F.lds + MISC_OFF);
    F.tid = threadIdx.x; F.lane = F.tid & 63; F.wave = __builtin_amdgcn_readfirstlane(F.tid >> 6);
    F.G = gridDim.x; { const int bx = blockIdx.x; F.vcu = (F.G % 8 == 0) ? (bx % 8) * (F.G / 8) + bx / 8 : bx; }
    F.cid = (int)blockIdx.x;
    F.ws = args->ws;
    F.ctl = (gu32*)(F.ws + mp::ctl);
    for (int u = F.tid; u < (LDS_BYTES - LDSCTL_OFF) / 4; u += NWAVES * 64) ((LAS unsigned*)(F.lds + LDSCTL_OFF))[u] = 0u;
    __syncthreads();
    const bool one_launch = (args->li < 0);
    XcdBarrier bar; bar.bar = (unsigned*)(F.ctl + CW_BAR); bar.x = 0; bar.st = nullptr;
    if (one_launch) bar = xcd_barrier_post((unsigned*)(F.ctl + CW_BAR), F.MISC + 8);
    if (one_launch && F.tid == 0) { const unsigned x_ = xb_xcc_id(); F.MISC[10] = x_; F.MISC[11] = xb_add((unsigned*)(F.ctl + CW_RANK + 64 * x_), 1u); }
    bool local_ok = false; unsigned* loc_ctr = nullptr;
    const int lo = args->ph_lo, hi = args->ph_hi;
#define IN(k) (lo <= (k) && (k) < hi)
#define SEAM(k) do { if (IN(k) && IN((k) + 1)) xcd_barrier(bar); } while (0)
#define SEAM_LOCAL(k) do { if (IN(k) && IN((k) + 1)) { if (local_ok) xcd_local_barrier(bar.bar, loc_ctr, 32u); else xcd_barrier(bar); } } while (0)

    if (IN(0)) for (int rep_ = 0; rep_ < (MK_REP_PHASE == 0 ? 2 : 1); ++rep_) { args = PHASE_ARGS(); p0_prologue(F, args); if (args->p0_mask & 8) p0_small(F, args); if (args->p0_mask & 16) p0_rope(F, args); }
    SEAM(0);
    if (one_launch && IN(0) && IN(1)) {
        if (F.tid == 0) { unsigned ok_ = (F.G == 256) ? 1u : 0u;
            for (unsigned j = 0; j < 16; ++j) { const unsigned c_ = xb_ld(&bar.bar[XB_XCNT(j)]); if (c_ != (j < 8 ? 32u : 0u)) ok_ = 0u; }
            F.MISC[12] = ok_; }
        __syncthreads();
        if (F.MISC[12]) { const int x_ = (int)F.MISC[10], r_ = (int)F.MISC[11]; local_ok = true; F.vcu = x_ * 32 + r_; F.cid = r_ * 8 + x_; loc_ctr = (unsigned*)(F.ctl + CW_LOC + 64 * x_); }
    }
    if (IN(1)) for (int rep_ = 0; rep_ < (MK_REP_PHASE == 1 ? 2 : 1); ++rep_) { args = PHASE_ARGS();
        pg8::Gemm g{(const bf16*)(F.ws + mp::xn), (const bf16*)(F.ws + mp::win), M, NIN_G, DM};
        pg8::EpiInProj E{(bf16*)(F.ws + mp::u16), NIN, (float*)(F.ws + mp::dt)};
#if P1_HOSTS_P0B == 1
        const int c_ = F.cid, xcd_ = c_ & 7, team_ = c_ >> 6;
        const int ks = team_ < 3 ? (xcd_ + 2 * team_) % 7 : xcd_ % 6;
        for (int part = 0; part < 2; ++part) {
            pg8::TeamOrder S{c_, part == 0 ? 0 : ks, part == 0 ? ks : 6};
            pg8::gemm_phase<pg8::EpiInProj, pg8::TeamOrder, PG8_ALIGN, PG8_SP2>(F.lds + RING_OFF, g, S, E);
            if (part == 0) { __syncthreads(); args = PHASE_ARGS(); p1_convert_share(F, args, 0); __syncthreads(); }
        }
#elif P1_HOSTS_P0B == 2
        pg8::StaticOrder S; S.init(M, NIN_G, F.G, (int)blockIdx.x);
        typedef pg8::ConvMoE<KA, 23, mp::wgu, mp::wd, mp::END, RING_OFF + RING_BYTES> CvJob;
        pg8::gemm_phase<pg8::EpiInProj, pg8::StaticOrder, PG8_ALIGN, PG8_SP2, false, CvJob>(F.lds + RING_OFF, g, S, E, CvJob{});
        if ((int)blockIdx.x >= P1_UNITS - 5 * F.G) { __syncthreads(); args = PHASE_ARGS(); p0b_blocks(F, args, 4 * (P1_INLOOP_BLOCKS + ((int)blockIdx.x - (P1_UNITS - 5 * F.G)) * NWAVES + F.wave), 4); }
#else
        pg8::StaticOrder S; S.init(M, NIN_G, F.G, (int)blockIdx.x);
        pg8::gemm_phase<pg8::EpiInProj, pg8::StaticOrder, PG8_ALIGN, PG8_SP2>(F.lds + RING_OFF, g, S, E);
#endif
    }
    SEAM_LOCAL(1);
    if (IN(2)) for (int rep_ = 0; rep_ < (MK_REP_PHASE == 2 ? 2 : 1); ++rep_) { if (MK_REP_BAR && rep_) xcd_barrier(bar); args = PHASE_ARGS(); p2_qknorm(F, args); p2_conv(F, args); }
    SEAM_LOCAL(2);
    if (IN(3)) for (int rep_ = 0; rep_ < (MK_REP_PHASE == 3 ? 2 : 1); ++rep_) { args = PHASE_ARGS(); if (args->p0_mask & 128) p3_ssd(F, args); p3_attention(F, args, lds);
#if P1_HOSTS_P0B == 1
        if (rep_ == 0) { __syncthreads(); args = PHASE_ARGS(); p1_convert_share(F, args, 1); }
#endif
    }
    SEAM_LOCAL(3);
    if (IN(4)) for (int rep_ = 0; rep_ < (MK_REP_PHASE == 4 ? 2 : 1); ++rep_) { args = PHASE_ARGS(); p4_ycat(F, args, (args->p0_mask >> 5) & 3); }
    SEAM_LOCAL(4);
    if (IN(5)) for (int rep_ = 0; rep_ < (MK_REP_PHASE == 5 ? 2 : 1); ++rep_) { args = PHASE_ARGS();
        pg8::Gemm g{(const bf16*)(F.ws + mp::ycat), (const bf16*)(F.ws + mp::wout), M, DM, DM}; pg8::StaticOrder S; S.init(M, DM, F.G, F.cid);
        pg8::EpiResid E{(const float*)args->in[0], (bf16*)(F.ws + mp::xn2), (unsigned char*)(F.ws + mp::xn8), DM, (const float*)args->in[18]};
        pg8::gemm_phase<pg8::EpiResid, pg8::StaticOrder, PG8_ALIGN, PG8_SP2>(F.lds + RING_OFF, g, S, E);
#if P1_HOSTS_P0B == 1
        if (rep_ == 0) { __syncthreads(); args = PHASE_ARGS(); p1_convert_share(F, args, 2); }
#endif
    }
    SEAM_LOCAL(5);
    if (IN(6)) for (int rep_ = 0; rep_ < (MK_REP_PHASE == 6 ? 2 : 1); ++rep_) { args = PHASE_ARGS(); p5_route(F, args);
#if P1_HOSTS_P0B == 1
        if (rep_ == 0) { __syncthreads(); args = PHASE_ARGS(); p1_convert_share(F, args, 3); }
#endif
    }
    SEAM(6);
    if (IN(8)) for (int rep_ = 0; rep_ < (MK_REP_PHASE == 8 ? 2 : 1); ++rep_) { args = PHASE_ARGS();
        build_tab(F, args);
        pg8::Gemm g{(const bf16*)(F.ws + mp::xn8), (const bf16*)(F.ws + mp::wgu), M, NE * 2048, DM / 2};    pg8::ExpertOrder S; S.init((const LAS int*)(F.lds + TAB_OFF), F.G, F.cid);
        pg8::ExpertRows RS{(const LAS int*)(F.lds + TAB_OFF), (const int*)(F.ws + mp::lst), LCAP};
        pg8::EpiGateUp E{(unsigned char*)(F.ws + mp::hid), EH, pg8::ExpertScale{(const LAS int*)(F.lds + TAB_OFF), (const float*)(F.ws + mp::lst) + 2 * NE * LCAP, LCAP}, 1.f / F8_WSCALE};
        pg8::gemm_phase_g<pg8::EpiGateUp, pg8::ExpertOrder, pg8::ExpertRows, PG8_ALIGN, PG8_SP2, true>(F.lds + RING_OFF, g, S, E, RS);
    }
    SEAM(8);
    if (IN(9)) for (int rep_ = 0; rep_ < (MK_REP_PHASE == 9 ? 2 : 1); ++rep_) { args = PHASE_ARGS();
        build_tab(F, args);
        pg8::Gemm g{(const bf16*)(F.ws + mp::hid), (const bf16*)(F.ws + mp::wd), SLOT_CAP, NE * 2048, EH / 2};    pg8::ExpertOrder S; S.init((const LAS int*)(F.lds + TAB_OFF), F.G, F.cid);
        pg8::EpiRowScale E{(unsigned char*)(F.ws + mp::y), DM, pg8::ExpertScale{(const LAS int*)(F.lds + TAB_OFF), (const float*)(F.ws + mp::lst) + NE * LCAP, LCAP}, Y8_SCALE / F8_WSCALE};
        pg8::gemm_phase<pg8::EpiRowScale, pg8::ExpertOrder, PG8_ALIGN, PG8_SP2, true>(F.lds + RING_OFF, g, S, E);
    }
    SEAM(9);
    if (IN(10)) for (int rep_ = 0; rep_ < (MK_REP_PHASE == 10 ? 2 : 1); ++rep_) { args = PHASE_ARGS(); p8_combine(F, args); }
#undef IN
#undef SEAM
#undef SEAM_LOCAL
}

__global__ void __launch_bounds__(256) k_u16_to_f32(const bf16* __restrict__ U16, const float* __restrict__ DT, float* __restrict__ U) {
    const size_t idx = (size_t)blockIdx.x * 256 + threadIdx.x;
    const int c = (int)(idx % IN_COLS); const size_t m = idx / IN_COLS;
    float v;
    if (c < 2560) v = bf2f(U16[m * NIN + c]); else if (c < 2576) v = DT[m * 16 + (c - 2560)]; else v = bf2f(U16[m * NIN + c - 16]);
    U[idx] = v;
}
__global__ void __launch_bounds__(256) k_f32_to_bf16(const float* __restrict__ src, bf16* __restrict__ dst) {
    const size_t i = (size_t)blockIdx.x * 256 + threadIdx.x;
    const float4 v = ((const float4*)src)[i]; v2u o; o.x = pk2(v.x, v.y); o.y = pk2(v.z, v.w); ((v2u*)dst)[i] = o;
}
__global__ void __launch_bounds__(256) k_ssdhalf_to_bf16(const float* __restrict__ YCATf, bf16* __restrict__ YCAT16) {
    const size_t i = (size_t)blockIdx.x * 256 + threadIdx.x;
    const size_t m = i >> 8; const int c4 = (int)(i & 255);
    const float4 v = ((const float4*)(YCATf + m * DM))[c4]; v2u o; o.x = pk2(v.x, v.y); o.y = pk2(v.z, v.w); ((v2u*)(YCAT16 + m * DM))[c4] = o;
}

#ifndef MK_ONE_LAUNCH
#define MK_ONE_LAUNCH 1
#endif
extern "C" void kernel_launch(void* const* d_in, const int* in_sizes, int n_in, void* d_out, int out_size, void* d_ws, size_t ws_size, hipStream_t stream) {
    static int ready = 0;
    if (!ready) {
        if (hipFuncSetAttribute((const void*)mega, hipFuncAttributeMaxDynamicSharedMemorySize, LDS_BYTES) != hipSuccess) { fprintf(stderr, "hipFuncSetAttribute failed\n"); }
        if (ws_size < mp::END) fprintf(stderr, "kernel_launch: ws_size %zu too small\n", ws_size);
        ready = 1;
    }
    (void)hipMemsetAsync(d_ws, 0, CTL_ZERO_BYTES, stream);
    Args a{};
    for (int i = 0; i < 26; ++i) a.in[i] = d_in[i];
    a.out = (float*)d_out; a.ws = (unsigned char*)d_ws;
    a.p0_mask = 1 | 2 | 4 | 8 | 16 | (3 << 5) | 128; a.rep_phase = MK_REP_PHASE;
#if MK_ONE_LAUNCH
    a.ph_lo = 0; a.ph_hi = N_PHASES; a.li = -1; hipLaunchKernelGGL(mega, dim3(256), dim3(NWAVES * 64), LDS_BYTES, stream, a);
#else
    for (int ph = 0; ph < N_PHASES; ++ph) { a.ph_lo = ph; a.ph_hi = ph + 1; a.li = ph; hipLaunchKernelGGL(mega, dim3(256), dim3(NWAVES * 64), LDS_BYTES, stream, a); }
#endif
}
```

```cpp
#include <hip/hip_runtime.h>
#include <hip/hip_bf16.h>
#include <math.h>
#include <stdint.h>
#include <cstdio>
#include <cmath>
namespace pg8 {
#define PG8_LAS __attribute__((address_space(3)))
typedef unsigned short bf16_t;
typedef short bf16x8 __attribute__((ext_vector_type(8)));
typedef float f32x4 __attribute__((ext_vector_type(4)));
typedef unsigned u32x4 __attribute__((ext_vector_type(4)));
typedef int v8i_t __attribute__((ext_vector_type(8)));
constexpr int BM = 256, BK = 64, HALF = 128, HTB = HALF * BK * 2  , STAGE_BYTES = 8 * HTB, NXCD = 8, WGM = 8;

__host__ __device__ __forceinline__ int lds_byte(int r, int c) { const int st = (r >> 4) * 2 + (c >> 5), rr = r & 15, cc = c & 31, ob = rr * 64 + cc * 2; return st * 1024 + (ob ^ (((ob >> 9) & 1) << 5)); }
__host__ __device__ __forceinline__ void stage_rc(int b, int& R, int& C) { const int st = b / 1024, sb = b % 1024, swz = sb ^ (((sb >> 9) & 1) << 5); R = (st >> 1) * 16 + swz / 64; C = (st & 1) * 32 + (swz % 64) / 2; }
__host__ __device__ __forceinline__ int perm32(int rho) { const int n = rho >> 4, i = rho & 15; return 8 * (i >> 2) + 4 * n + (i & 3); }

struct Unit { int pm, pn; };
struct Gemm { const bf16_t* A; const bf16_t* Bt; int M, N, K; };

struct StaticOrder {
    int nM, nN, nwg, G, c;
    __host__ __device__ void init(int M, int N, int G_, int c_) { nM = M / BM; nN = N / BM; nwg = nM * nN; G = G_; c = c_; }
    __host__ __device__ bool next(int i, Unit& u) const {
        const long L = (long)i * G + c; if (L >= nwg) return false;
        int wgid = (int)L; { const int q = nwg / NXCD, r = nwg % NXCD, xcd = wgid % NXCD, off = wgid / NXCD; wgid = (xcd < r ? xcd * (q + 1) : r * (q + 1) + (xcd - r) * q) + off; }
        const int nig = WGM * nN, gid = wgid / nig, fm = gid * WGM, gsz = (nM - fm) < WGM ? (nM - fm) : WGM;
        u.pm = fm + ((wgid % nig) % gsz); u.pn = (wgid % nig) / gsz; return true;
    }
    __device__ __forceinline__ int rows(const Unit&) const { return BM; }
    __device__ __forceinline__ void a_ready(const Unit&) const {}
    __device__ __forceinline__ void done(const Unit&) const {}
};

__device__ __forceinline__ unsigned cvt_pk_bf16(float lo, float hi) { unsigned r; asm volatile("v_cvt_pk_bf16_f32 %0, %1, %2" : "=v"(r) : "v"(lo), "v"(hi)); return r; }
typedef float f32x2 __attribute__((ext_vector_type(2)));
__device__ __forceinline__ f32x2 gelu_pk(f32x2 v) {
    const f32x2 av = __builtin_elementwise_abs(v), d = av * 0.2316418882f + 1.0f;
    f32x2 t; t.x = __builtin_amdgcn_rcpf(d.x); t.y = __builtin_amdgcn_rcpf(d.y);
    f32x2 q = t * 0.5307027145f + (-0.7265760135f); q = q * t + 0.7107068705f; q = q * t + (-0.142248368f); q = q * t + 0.127414796f; q = q * t;
    const f32x2 s = (v * v) * (-0.72134752044f);
    f32x2 e; e.x = __builtin_amdgcn_exp2f(s.x); e.y = __builtin_amdgcn_exp2f(s.y);
    const f32x2 m = v * (q * e), r = v - m;
    f32x2 o; o.x = v.x < 0.f ? m.x : r.x; o.y = v.y < 0.f ? m.y : r.y; return o;
}

template <int ACT  > struct EpiBf16 {
    static constexpr bool PERM = true, AFTER_DRAIN = false; static_assert(ACT == 0 || ACT == 1, "EpiBf16: ACT is 0 (none) or 1 (gelu_pk)");
    bf16_t* O; int ldc; const float* bias; int split_cols; size_t split_stride; float scale0;
    __device__ __forceinline__ void operator()(const f32x4 (&acc)[2][2][4][2], const Unit& u, int wr, int wc, int fr, int fq) const {
        const int row0 = u.pm * BM + wr * 64 + fr; int colt = u.pn * BM; bf16_t* base = O;
        float sc = 1.f; if (split_cols) { const int t = colt / split_cols; base += (size_t)t * split_stride; colt -= t * split_cols; if (t == 0) sc = scale0; }
        const int col0 = colt + wc * 32 + 8 * fq, bcol0 = u.pn * BM + wc * 32 + 8 * fq;
        f32x4 bv[2][2];
#pragma unroll
        for (int bj = 0; bj < 2; ++bj)
#pragma unroll
            for (int n = 0; n < 2; ++n) bv[bj][n] = bias ? *(const f32x4*)(bias + bcol0 + bj * HALF + 4 * n) : (f32x4){0.f, 0.f, 0.f, 0.f};
#pragma unroll
        for (int ai = 0; ai < 2; ++ai)
#pragma unroll
            for (int m = 0; m < 4; ++m) { bf16_t* rowp = base + (size_t)(row0 + ai * HALF + m * 16) * ldc + col0;
#pragma unroll
                for (int bj = 0; bj < 2; ++bj) { f32x4 v0 = acc[ai][bj][m][0] + bv[bj][0], v1 = acc[ai][bj][m][1] + bv[bj][1];
                    if (ACT == 1) { f32x2 a = gelu_pk((f32x2){v0[0], v0[1]}), b = gelu_pk((f32x2){v0[2], v0[3]}), c = gelu_pk((f32x2){v1[0], v1[1]}), d = gelu_pk((f32x2){v1[2], v1[3]});
                        v0 = (f32x4){a.x, a.y, b.x, b.y}; v1 = (f32x4){c.x, c.y, d.x, d.y}; }
                    v0 = v0 * sc; v1 = v1 * sc; u32x4 w; w.x = cvt_pk_bf16(v0[0], v0[1]); w.y = cvt_pk_bf16(v0[2], v0[3]); w.z = cvt_pk_bf16(v1[0], v1[1]); w.w = cvt_pk_bf16(v1[2], v1[3]);
                    *(u32x4*)(rowp + bj * HALF) = w; } }
    }
};

struct ConvNone { static constexpr bool ON = false; static constexpr int LDS_OFF = 0; };
template <class Epi, class Sched, bool ALIGN_EPI = false, bool SP2 = false, bool F8 = false, class CV = ConvNone>
__device__ __forceinline__ void gemm_phase(PG8_LAS unsigned char* lds, const Gemm g, const Sched& S, const Epi& E, const CV& cv = CV{}) {
    static_assert(!CV::ON || SP2, "the side job's vmcnt arithmetic is written for the SP2 schedule");
    const int tid = threadIdx.x, wid = __builtin_amdgcn_readfirstlane(tid >> 6), lane = tid & 63, wr = wid >> 2, wc = wid & 3, fr = lane & 15, fq = lane >> 4;
    const int K = g.K, nt = K / BK;
    unsigned voffA[2], voffB[2];
#pragma unroll
    for (int i = 0; i < 2; ++i) { int R, C; stage_rc(tid * 16 + i * 8192, R, C); const int Rb = Epi::PERM ? ((R & ~31) + perm32(R & 31)) : R;
        voffA[i] = (unsigned)(R * K + C) * 2u; voffB[i] = (unsigned)(Rb * K + C) * 2u; }
    const size_t kstep = (size_t)(BK * 2);
    const size_t hstep = (size_t)HALF * K * 2;
    const size_t tstep = 2 * hstep;
    const unsigned ldsw = (unsigned)wid * 1024u;
    const int aoff = lds_byte(wr * 64 + fr, fq * 8), boff = lds_byte(wc * 32 + fr, fq * 8);
#define PG8_CAT8(x, y) __builtin_bit_cast(v8i_t, __builtin_shufflevector((x), (y), 0, 1, 2, 3, 4, 5, 6, 7, 8, 9, 10, 11, 12, 13, 14, 15))
#define PG8_SA(b, h) (((b) * 2 + (h)) * HTB)
#define PG8_SB(b, h) ((4 + (b) * 2 + (h)) * HTB)
#define PG8_STAGE(bufoff, gbase, voff) do { _Pragma("unroll") for (int _i = 0; _i < 2; ++_i) \
        __builtin_amdgcn_global_load_lds((const unsigned*)((const char*)(gbase) + (voff)[_i]), (PG8_LAS unsigned*)(lds + (bufoff) + ldsw + _i * 8192), 16, 0, 0); } while (0)
#define PG8_LDA(dst, b, h) do { if constexpr (F8) { _Pragma("unroll") for (int m = 0; m < 4; ++m) dst##8[m] = PG8_CAT8(*(const PG8_LAS bf16x8*)(lds + PG8_SA(b, h) + aoff + m * 2048), *(const PG8_LAS bf16x8*)(lds + PG8_SA(b, h) + aoff + m * 2048 + 1024)); } else _Pragma("unroll") for (int m = 0; m < 4; ++m) _Pragma("unroll") for (int k = 0; k < 2; ++k) dst[m][k] = *(const PG8_LAS bf16x8*)(lds + PG8_SA(b, h) + aoff + m * 2048 + k * 1024); } while (0)
#define PG8_LDB(dst, b, h) do { if constexpr (F8) { _Pragma("unroll") for (int n = 0; n < 2; ++n) dst##8[n] = PG8_CAT8(*(const PG8_LAS bf16x8*)(lds + PG8_SB(b, h) + boff + n * 2048), *(const PG8_LAS bf16x8*)(lds + PG8_SB(b, h) + boff + n * 2048 + 1024)); } else _Pragma("unroll") for (int n = 0; n < 2; ++n) _Pragma("unroll") for (int k = 0; k < 2; ++k) dst[n][k] = *(const PG8_LAS bf16x8*)(lds + PG8_SB(b, h) + boff + n * 2048 + k * 1024); } while (0)
#define PG8_MMA(ai, bj, At, Bt) do { __builtin_amdgcn_s_setprio(1); \
        if constexpr (F8) { _Pragma("unroll") for (int m = 0; m < 4; ++m) _Pragma("unroll") for (int n = 0; n < 2; ++n) \
            asm volatile("v_mfma_f32_16x16x128_f8f6f4 %0, %1, %2, %0" : "+v"(acc[ai][bj][m][n]) : "v"(Bt##8[n]), "v"(At##8[m])); }     \
        else { _Pragma("unroll") for (int m = 0; m < 4; ++m) _Pragma("unroll") for (int n = 0; n < 2; ++n) _Pragma("unroll") for (int k = 0; k < 2; ++k) \
            acc[ai][bj][m][n] = __builtin_amdgcn_mfma_f32_16x16x32_bf16(Bt[n][k], At[m][k], acc[ai][bj][m][n], 0, 0, 0); } \
        __builtin_amdgcn_s_setprio(0); } while (0)
#define PG8_WAIT_V(n) asm volatile("s_waitcnt vmcnt(" #n ")" ::: "memory")
#define PG8_WAIT_L(n) asm volatile("s_waitcnt lgkmcnt(" #n ")" ::: "memory")
#define PG8_BAR __builtin_amdgcn_s_barrier()
#define PG8_SCHED __builtin_amdgcn_sched_barrier(0)
    Unit cur, nxt; int ui = 0;
    if (!S.next(0, cur)) return;
    bool skip1 = S.rows(cur) <= HALF;
    f32x4 acc[2][2][4][2];
#pragma unroll
    for (int a = 0; a < 2; ++a)
#pragma unroll
        for (int b = 0; b < 2; ++b)
#pragma unroll
            for (int m = 0; m < 4; ++m)
#pragma unroll
                for (int n = 0; n < 2; ++n) acc[a][b][m][n] = (f32x4){0.f, 0.f, 0.f, 0.f};
    bf16x8 At[4][2], B0[2][2], B1[2][2];
    v8i_t At8[4], B08[2], B18[2];
    const char* cA = (const char*)g.A + (size_t)cur.pm * tstep; const char* cB = (const char*)g.Bt + (size_t)cur.pn * tstep;
    S.a_ready(cur);
    typedef float cvf2 __attribute__((ext_vector_type(2))); typedef unsigned cvu2 __attribute__((ext_vector_type(2)));
    cvu2 cvo0 = {0u, 0u}, cvo1 = {0u, 0u};
    const char* cv_sb = nullptr; unsigned cv_sv = 0, cv_db = 0, cv_dv = 0, cv_stb = 0, cv_stv = 0; int cv_dn = 0, cv_stdn = 0;
    unsigned char* cv_ws = nullptr; unsigned cv_slot = 0;
    PG8_LAS unsigned char* const cv_lds = lds + CV::LDS_OFF + wid * 3072;
    if constexpr (CV::ON) { cv.decode(cur, wid, lane, cv_sb, cv_dn, cv_db, cv_dv, cv_sv); cv_ws = cv.wsbase(); cv_stb = CV::DUMMY_OFF; cv_stdn = 0; cv_stv = (unsigned)tid * 16u; }
#define CV_LD(slot) do { if constexpr (CV::ON) { \
        __builtin_amdgcn_global_load_lds((const unsigned*)(cv_sb + (size_t)((2 * slot) * (cv_dn ? 8192u : 4096u)) + cv_sv), (PG8_LAS unsigned*)(cv_lds + cv_slot), 16, 0, 0); \
        cv_slot = cv_slot == 2048u ? 0u : cv_slot + 1024u; } } while (0)
#define CV_CVT(slot, dw, hi) do { if constexpr (CV::ON) { \
        const cvf2 ra_ = *(const PG8_LAS cvf2*)(cv_lds + cv_slot + lane * 8), rb_ = *(const PG8_LAS cvf2*)(cv_lds + cv_slot + 512 + lane * 8); \
        cvo0[dw] = (unsigned)__builtin_amdgcn_cvt_pk_fp8_f32(ra_.x * CV::SCALE, rb_.x * CV::SCALE, (int)cvo0[dw], hi); \
        cvo1[dw] = (unsigned)__builtin_amdgcn_cvt_pk_fp8_f32(ra_.y * CV::SCALE, rb_.y * CV::SCALE, (int)cvo1[dw], hi); } } while (0)
#define CV_ST() do { if constexpr (CV::ON) { unsigned char* p_ = cv_ws + cv_stb; *(__attribute__((address_space(1))) cvu2*)(p_ + cv_stv) = cvo0; *(__attribute__((address_space(1))) cvu2*)(p_ + (cv_stdn ? 1024u : 2048u) + cv_stv) = cvo1; } } while (0)
    if constexpr (SP2) {
        PG8_STAGE(PG8_SB(0, 0), cB, voffB); PG8_STAGE(PG8_SB(0, 1), cB + hstep, voffB); PG8_STAGE(PG8_SA(0, 0), cA, voffA); PG8_STAGE(PG8_SA(0, 1), cA + hstep, voffA);
        if (wr == 1) PG8_BAR;
        PG8_WAIT_V(2); PG8_BAR;
        PG8_STAGE(PG8_SB(1, 0), cB + kstep, voffB); PG8_STAGE(PG8_SA(1, 0), cA + kstep, voffA); PG8_STAGE(PG8_SB(1, 1), cB + hstep + kstep, voffB);
        PG8_WAIT_V(6); PG8_BAR;
    } else {
        PG8_STAGE(PG8_SB(0, 0), cB, voffB); PG8_STAGE(PG8_SA(0, 0), cA, voffA); PG8_STAGE(PG8_SB(0, 1), cB + hstep, voffB); PG8_STAGE(PG8_SA(0, 1), cA + hstep, voffA);
        if (wr == 1) PG8_BAR;
        PG8_WAIT_V(4); PG8_BAR;
        PG8_STAGE(PG8_SB(1, 0), cB + kstep, voffB); PG8_STAGE(PG8_SA(1, 0), cA + kstep, voffA); PG8_STAGE(PG8_SB(1, 1), cB + hstep + kstep, voffB);
        PG8_WAIT_V(6); PG8_BAR;
    }
    for (;;) {
        const bool has_next = S.next(ui + 1, nxt);
        const char* nA = has_next ? (const char*)g.A + (size_t)nxt.pm * tstep : cA; const char* nB = has_next ? (const char*)g.Bt + (size_t)nxt.pn * tstep : cB;
#pragma clang loop unroll(disable)
        for (int t = 0; t < nt; t += 2) {
            const bool last = (t == nt - 2);
            const char* a1 = cA + (size_t)(t + 1) * kstep;
            const char* a2 = last ? nA : cA + (size_t)(t + 2) * kstep; const char* b2 = last ? nB : cB + (size_t)(t + 2) * kstep;
            const char* a3 = a2 + kstep; const char* b3 = b2 + kstep;
            if (last && has_next) S.a_ready(nxt);
            if constexpr (SP2) {
            PG8_LDB(B0, 0, 0); PG8_LDB(B1, 0, 1); PG8_SCHED; PG8_LDA(At, 0, 0); PG8_STAGE(PG8_SA(1, 1), a1 + hstep, voffA); CV_LD(0);
            if constexpr (CV::ON) PG8_WAIT_V(10); else PG8_WAIT_V(8);
            PG8_WAIT_L(0); PG8_BAR; PG8_MMA(0, 0, At, B0); PG8_MMA(0, 1, At, B1); CV_CVT(2, 1, false); PG8_BAR; PG8_SCHED;
            PG8_LDA(At, 0, 1); PG8_STAGE(PG8_SB(0, 0), b2, voffB); PG8_STAGE(PG8_SB(0, 1), b2 + hstep, voffB); PG8_STAGE(PG8_SA(0, 0), a2, voffA); CV_LD(1);
            if constexpr (CV::ON) PG8_WAIT_V(10); else PG8_WAIT_V(8);
            PG8_WAIT_L(0); PG8_BAR; if (!skip1) { PG8_MMA(1, 0, At, B0); PG8_MMA(1, 1, At, B1); } CV_CVT(3, 1, true); PG8_BAR; PG8_SCHED;
            CV_ST(); if constexpr (CV::ON) { cv_stb = cv_db + 4 * t; cv_stdn = cv_dn; cv_stv = cv_dv; }
            PG8_LDB(B0, 1, 0); PG8_LDB(B1, 1, 1); PG8_SCHED; PG8_LDA(At, 1, 0); PG8_STAGE(PG8_SA(0, 1), a2 + hstep, voffA); CV_LD(2);
            if constexpr (CV::ON) PG8_WAIT_V(12); else PG8_WAIT_V(8);
            PG8_WAIT_L(0); PG8_BAR; PG8_MMA(0, 0, At, B0); PG8_MMA(0, 1, At, B1); CV_CVT(0, 0, false); PG8_BAR; PG8_SCHED;
            PG8_LDA(At, 1, 1); PG8_STAGE(PG8_SB(1, 0), b3, voffB); PG8_STAGE(PG8_SB(1, 1), b3 + hstep, voffB); PG8_STAGE(PG8_SA(1, 0), a3, voffA); CV_LD(3);
            if constexpr (CV::ON) PG8_WAIT_V(12); else PG8_WAIT_V(8);
            PG8_WAIT_L(0); PG8_BAR; if (!skip1) { PG8_MMA(1, 0, At, B0); PG8_MMA(1, 1, At, B1); } CV_CVT(1, 0, true); PG8_BAR; PG8_SCHED;
            if constexpr (CV::ON) cv_sb += cv_dn ? 65536 : 32768;
            } else {
            PG8_LDB(B0, 0, 0); PG8_SCHED; PG8_LDA(At, 0, 0); PG8_STAGE(PG8_SA(1, 1), a1 + hstep, voffA);
            PG8_WAIT_L(8); PG8_BAR; PG8_WAIT_L(0); PG8_MMA(0, 0, At, B0); PG8_BAR; PG8_SCHED;
            PG8_LDB(B1, 0, 1); PG8_STAGE(PG8_SB(0, 0), b2, voffB);
            PG8_BAR; PG8_WAIT_L(0); PG8_MMA(0, 1, At, B1); PG8_BAR;
            PG8_LDA(At, 0, 1); PG8_STAGE(PG8_SA(0, 0), a2, voffA);
            PG8_BAR; PG8_WAIT_L(0); PG8_MMA(1, 0, At, B0); PG8_BAR; PG8_SCHED;
            PG8_STAGE(PG8_SB(0, 1), b2 + hstep, voffB);
            PG8_WAIT_V(6); PG8_BAR; PG8_MMA(1, 1, At, B1); PG8_BAR;
            PG8_LDB(B0, 1, 0); PG8_SCHED; PG8_LDA(At, 1, 0); PG8_STAGE(PG8_SA(0, 1), a2 + hstep, voffA);
            PG8_WAIT_L(8); PG8_BAR; PG8_WAIT_L(0); PG8_MMA(0, 0, At, B0); PG8_BAR; PG8_SCHED;
            PG8_LDB(B1, 1, 1); PG8_STAGE(PG8_SB(1, 0), b3, voffB);
            PG8_BAR; PG8_WAIT_L(0); PG8_MMA(0, 1, At, B1); PG8_BAR;
            PG8_LDA(At, 1, 1); PG8_STAGE(PG8_SA(1, 0), a3, voffA);
            PG8_BAR; PG8_WAIT_L(0); PG8_MMA(1, 0, At, B0); PG8_BAR; PG8_SCHED;
            PG8_STAGE(PG8_SB(1, 1), b3 + hstep, voffB);
            PG8_WAIT_V(6); PG8_BAR; PG8_MMA(1, 1, At, B1); PG8_BAR;
            }
        }
        if constexpr (F8) asm volatile("s_nop 15\n\ts_nop 7" ::: "memory");
        if constexpr (ALIGN_EPI) { if (wr == 0) PG8_BAR; }
        if constexpr (!Epi::AFTER_DRAIN) { int fr_ = fr, fq_ = fq; asm volatile("" : "+v"(fr_), "+v"(fq_));
            E(acc, cur, wr, wc, fr_, fq_); S.done(cur); }
        if (!has_next) break;
#pragma unroll
        for (int a = 0; a < 2; ++a)
#pragma unroll
            for (int b = 0; b < 2; ++b)
#pragma unroll
                for (int m = 0; m < 4; ++m)
#pragma unroll
                    for (int n = 0; n < 2; ++n) acc[a][b][m][n] = (f32x4){0.f, 0.f, 0.f, 0.f};
        cur = nxt; cA = nA; cB = nB; ++ui; skip1 = S.rows(cur) <= HALF;
        if constexpr (CV::ON) cv.decode(cur, wid, lane, cv_sb, cv_dn, cv_db, cv_dv, cv_sv);
        if constexpr (ALIGN_EPI) { if (wr == 1) PG8_BAR; }
    }
    PG8_WAIT_V(0);
    if constexpr (CV::ON) { cv_slot = cv_slot == 2048u ? 0u : cv_slot + 1024u; CV_CVT(2, 1, false); cv_slot = cv_slot == 2048u ? 0u : cv_slot + 1024u; CV_CVT(3, 1, true); CV_ST(); }
    if constexpr (!ALIGN_EPI) { if (wr == 0) PG8_BAR; }
    PG8_BAR;
    if constexpr (Epi::AFTER_DRAIN) { E.fused(acc, cur, wr, wc, fr, fq, lds, wid, lane); S.done(cur); }
#undef PG8_SA
#undef PG8_SB
#undef PG8_STAGE
#undef PG8_LDA
#undef PG8_LDB
#undef PG8_MMA
#undef PG8_CAT8
#undef PG8_WAIT_V
#undef PG8_WAIT_L
#undef PG8_BAR
#undef PG8_SCHED
#undef CV_LD
#undef CV_CVT
#undef CV_ST
}
}

namespace pg8 {
__device__ __forceinline__ void store16_wt(void* p, u32x4 v) { asm volatile("global_store_dwordx4 %0, %1, off sc1\n\ts_nop 1" :: "v"(p), "v"(v) : "memory"); }
__device__ __forceinline__ float clamp_f8(float v) { return __builtin_fminf(__builtin_fmaxf(v, -448.f), 448.f); }
__device__ __forceinline__ unsigned cvt4_fp8(float a, float b, float c, float d) { int w = 0; w = __builtin_amdgcn_cvt_pk_fp8_f32(a, b, w, false); w = __builtin_amdgcn_cvt_pk_fp8_f32(c, d, w, true); return (unsigned)w; }
__device__ __forceinline__ unsigned cvt4_fp8c(float a, float b, float c, float d) { return cvt4_fp8(clamp_f8(a), clamp_f8(b), clamp_f8(c), clamp_f8(d)); }
struct EpiInProj {
    static constexpr bool PERM = true, AFTER_DRAIN = false;
    bf16_t* O; int ldc; float* DT;
    __device__ __forceinline__ void operator()(const f32x4 (&acc)[2][2][4][2], const Unit& u, int wr, int wc, int fr, int fq) const {
        const int row0 = u.pm * BM + wr * 64 + fr;
        if (u.pn == 22) {
            if (wc == 0 && fq < 2) {
#pragma unroll
                for (int ai = 0; ai < 2; ++ai)
#pragma unroll
                    for (int m = 0; m < 4; ++m) { float* dp = DT + (size_t)(row0 + ai * HALF + m * 16) * 16 + 8 * fq; *(f32x4*)dp = acc[ai][0][m][0]; *(f32x4*)(dp + 4) = acc[ai][0][m][1]; } }
            return; }
        const int col0 = u.pn * BM + wc * 32 + 8 * fq;
#pragma unroll
        for (int ai = 0; ai < 2; ++ai)
#pragma unroll
            for (int m = 0; m < 4; ++m) { bf16_t* rowp = O + (size_t)(row0 + ai * HALF + m * 16) * ldc + col0;
#pragma unroll
                for (int bj = 0; bj < 2; ++bj) { const f32x4 v0 = acc[ai][bj][m][0], v1 = acc[ai][bj][m][1];
                    u32x4 w; w.x = cvt_pk_bf16(v0[0], v0[1]); w.y = cvt_pk_bf16(v0[2], v0[3]); w.z = cvt_pk_bf16(v1[0], v1[1]); w.w = cvt_pk_bf16(v1[2], v1[3]);
                    *(u32x4*)(rowp + bj * HALF) = w; } }
    }
};
struct EpiResid {
    static constexpr bool PERM = true, AFTER_DRAIN = false;
    const float* base; bf16_t* hb; unsigned char* h8; int ldc; const float* cs;
    __device__ __forceinline__ void operator()(const f32x4 (&acc)[2][2][4][2], const Unit& u, int wr, int wc, int fr, int fq) const {
        const int row0 = u.pm * BM + wr * 64 + fr, col0 = u.pn * BM + wc * 32 + 8 * fq;
        typedef unsigned u32x2_t __attribute__((ext_vector_type(2)));
        f32x4 csv[2][2];
#pragma unroll
        for (int bj = 0; bj < 2; ++bj) { csv[bj][0] = *(const f32x4*)(cs + col0 + bj * HALF); csv[bj][1] = *(const f32x4*)(cs + col0 + bj * HALF + 4); }
#pragma unroll
        for (int ai = 0; ai < 2; ++ai) {
            f32x4 xr[4][2][2];
#pragma unroll
            for (int m = 0; m < 4; ++m) { const size_t off = (size_t)(row0 + ai * HALF + m * 16) * ldc + col0;
#pragma unroll
                for (int bj = 0; bj < 2; ++bj) { xr[m][bj][0] = __builtin_nontemporal_load((const f32x4*)(base + off + bj * HALF)); xr[m][bj][1] = __builtin_nontemporal_load((const f32x4*)(base + off + bj * HALF + 4)); } }
#pragma unroll
            for (int m = 0; m < 4; ++m) { const size_t off = (size_t)(row0 + ai * HALF + m * 16) * ldc + col0;
#pragma unroll
                for (int bj = 0; bj < 2; ++bj) {
                    const f32x4 v0 = acc[ai][bj][m][0] + xr[m][bj][0], v1 = acc[ai][bj][m][1] + xr[m][bj][1];
                    u32x4 w; w.x = cvt_pk_bf16(v0[0], v0[1]); w.y = cvt_pk_bf16(v0[2], v0[3]); w.z = cvt_pk_bf16(v1[0], v1[1]); w.w = cvt_pk_bf16(v1[2], v1[3]);
                    *(u32x4*)(hb + off + bj * HALF) = w;
                    const f32x4 s0 = v0 * csv[bj][0], s1 = v1 * csv[bj][1];
                    u32x2_t q; q.x = cvt4_fp8c(s0[0], s0[1], s0[2], s0[3]); q.y = cvt4_fp8c(s1[0], s1[1], s1[2], s1[3]);
                    *(u32x2_t*)(h8 + off + bj * HALF) = q; } }
        }
    }
};
struct ExpertScale {
    const PG8_LAS int* tab; const float* lst; int lcap;
    __device__ __forceinline__ int rows(const Unit& u) const { const int e = u.pn >> 3; return tab[80 + e] - (u.pm - tab[40 + e]) * BM; }
    __device__ __forceinline__ float at(const Unit& u, int rowlocal) const { const int e = u.pn >> 3, p = (u.pm - tab[40 + e]) * BM + rowlocal; return p < tab[80 + e] ? lst[(size_t)e * lcap + p] : 0.f; }
};
struct EpiGateUp {
    static constexpr bool PERM = true, AFTER_DRAIN = false;
    unsigned char* O; int ldc; ExpertScale rs; float wsc;
    __device__ __forceinline__ void operator()(const f32x4 (&acc)[2][2][4][2], const Unit& u, int wr, int wc, int fr, int fq) const {
        const int rl0 = wr * 64 + fr, col0 = (u.pn & 7) * HALF + wc * 32 + 8 * fq;
        float rsc[2][4];
#pragma unroll
        for (int ai = 0; ai < 2; ++ai)
#pragma unroll
            for (int m = 0; m < 4; ++m) rsc[ai][m] = rs.at(u, rl0 + ai * HALF + m * 16) * wsc;
        const bool half_only = rs.rows(u) <= HALF;
#pragma unroll
        for (int ai = 0; ai < 2; ++ai) { if (ai == 1 && half_only) continue;
#pragma unroll
            for (int m = 0; m < 4; ++m) { const int rl = rl0 + ai * HALF + m * 16; const float r = rsc[ai][m];
                float hv[8];
#pragma unroll
                for (int n = 0; n < 2; ++n)
#pragma unroll
                    for (int j = 0; j < 4; ++j) { const float g = acc[ai][0][m][n][j] * r, up = acc[ai][1][m][n][j] * r; hv[n * 4 + j] = g * __builtin_amdgcn_rcpf(1.f + __builtin_amdgcn_exp2f(-1.44269504089f * g)) * up; }
                typedef unsigned u32x2_t __attribute__((ext_vector_type(2))); u32x2_t q; q.x = cvt4_fp8c(hv[0], hv[1], hv[2], hv[3]); q.y = cvt4_fp8c(hv[4], hv[5], hv[6], hv[7]);
                *(u32x2_t*)(O + (size_t)(u.pm * BM + rl) * ldc + col0) = q; } }
    }
};
struct EpiRowScale {
    static constexpr bool PERM = true, AFTER_DRAIN = false;
    unsigned char* O; int ldc; ExpertScale rs; float wsc;
    __device__ __forceinline__ void operator()(const f32x4 (&acc)[2][2][4][2], const Unit& u, int wr, int wc, int fr, int fq) const {
        const int rl0 = wr * 64 + fr, col0 = (u.pn & 7) * BM + wc * 64 + 16 * fq;
        float rsc[2][4];
#pragma unroll
        for (int ai = 0; ai < 2; ++ai)
#pragma unroll
            for (int m = 0; m < 4; ++m) rsc[ai][m] = rs.at(u, rl0 + ai * HALF + m * 16) * wsc;
        const bool half_only = rs.rows(u) <= HALF;
#pragma unroll
        for (int ai = 0; ai < 2; ++ai) { if (ai == 1 && half_only) continue;
#pragma unroll
            for (int m = 0; m < 4; ++m) { const int rl = rl0 + ai * HALF + m * 16; const float r = rsc[ai][m];
                const f32x4 v0 = acc[ai][0][m][0] * r, v1 = acc[ai][0][m][1] * r, v2 = acc[ai][1][m][0] * r, v3 = acc[ai][1][m][1] * r;
                u32x4 q; q.x = cvt4_fp8c(v0[0], v0[1], v0[2], v0[3]); q.y = cvt4_fp8c(v1[0], v1[1], v1[2], v1[3]); q.z = cvt4_fp8c(v2[0], v2[1], v2[2], v2[3]); q.w = cvt4_fp8c(v3[0], v3[1], v3[2], v3[3]);
                *(u32x4*)(O + (size_t)(u.pm * BM + rl) * ldc + col0) = q; } }
    }
};
struct ExpertOrder {
    const PG8_LAS int* tab; int nwg, G, c;
    __device__ __forceinline__ void init(const PG8_LAS int* t, int G_, int c_) { tab = t; nwg = t[32]; G = G_; c = c_; }
    __device__ __forceinline__ bool next(int i, Unit& u) const {
        const long L = (long)i * G + c; if (L >= nwg) return false;
        int wgid = (int)L; { const int q = nwg / NXCD, r = nwg % NXCD, xcd = wgid % NXCD, off = wgid / NXCD; wgid = (xcd < r ? xcd * (q + 1) : r * (q + 1) + (xcd - r) * q) + off; }
        const int tj = tab[threadIdx.x & 31];
        const int e = __builtin_popcountll(__ballot(wgid >= tj) & 0xffffffffull) - 1;
        const int local_i = wgid - tab[e], mt = (tab[e + 1] - tab[e]) >> 3;
        u.pm = tab[40 + e] + local_i % mt; u.pn = e * 8 + local_i / mt; return true;
    }
    __device__ __forceinline__ int rows(const Unit& u) const { const int e = u.pn >> 3; return tab[80 + e] - (u.pm - tab[40 + e]) * BM; }
    __device__ __forceinline__ void a_ready(const Unit&) const {}
    __device__ __forceinline__ void done(const Unit&) const {}
};
struct TeamOrder {
    int c, i0, i1;
    __device__ __forceinline__ bool next(int i, Unit& u) const {
        i += i0; if (i >= i1) return false;
        const int xcd = c & 7, l = c >> 3; if (i * 32 + l >= 184) return false;
        int pmo, pn;
        if (i < 5) { const int t = l >> 3, j = l & 7; pmo = 4 * (t & 1) + (j & 3); pn = 4 * i + 2 * (t >> 1) + (j >> 2); }
        else { pmo = l & 7; pn = 20 + (l >> 3); }
        u.pm = 8 * xcd + pmo; u.pn = pn; return true;
    }
    __device__ __forceinline__ int rows(const Unit&) const { return BM; }
    __device__ __forceinline__ void a_ready(const Unit&) const {}
    __device__ __forceinline__ void done(const Unit&) const {}
};
template <class KArgs, int IN_GATE, size_t WGU_OFF, size_t WD_OFF, size_t DUMMY, int LDSOFF> struct ConvMoE {
    static constexpr bool ON = true; static constexpr float SCALE = 64.f;
    static constexpr unsigned DUMMY_OFF = (unsigned)DUMMY; static constexpr int LDS_OFF = LDSOFF; static constexpr int nN = 23;
    static_assert(WD_OFF + 64u * 1024 * 1024 < (1ull << 32) && DUMMY < (1ull << 32), "32-bit workspace offsets");
    __device__ __forceinline__ unsigned char* wsbase() const { const KArgs a = (KArgs)__builtin_amdgcn_kernarg_segment_ptr(); return a->ws; }
    __device__ __forceinline__ void decode(const Unit& u, int wid, int lane, const char*& sb, int& dn, unsigned& db, unsigned& dv, unsigned& sv) const {
        const KArgs a = (KArgs)__builtin_amdgcn_kernarg_segment_ptr();
        const int cb = (u.pm * nN + u.pn) * 8 + wid, nl = 2 * lane;
        if (cb < 8192) { const int up = cb >> 12, r = cb & 4095, e = r >> 7, kb = (r >> 3) & 15, nb = r & 7;
            sb = (const char*)((const float*)a->in[IN_GATE + up] + (size_t)e * 2048 * 1024 + (size_t)(128 * kb) * 1024 + 128 * nb); dn = 0;
            db = (unsigned)(WGU_OFF + (size_t)e * 2048 * 2048 + (size_t)(nb * 256 + up * 128) * 2048 + 128 * kb); dv = (unsigned)nl * 2048u; sv = (unsigned)(lane >> 5) * 4096u + (unsigned)(lane & 31) * 16u; }
        else { const int r = cb - 8192, e = r >> 7, kb = (r >> 4) & 7, nb = r & 15;
            sb = (const char*)((const float*)a->in[IN_GATE + 2] + (size_t)e * 1024 * 2048 + (size_t)(128 * kb) * 2048 + 128 * nb); dn = 1;
            db = (unsigned)(WD_OFF + (size_t)e * 2048 * 1024 + (size_t)(256 * (nb >> 1)) * 1024 + 128 * kb);
            dv = (unsigned)(((nl >> 3) & 1) * 128 + (2 * (nb & 1) + (nl >> 6)) * 32 + ((nl >> 4) & 3) * 8 + (nl & 7)) * 1024u; sv = (unsigned)(lane >> 5) * 8192u + (unsigned)(lane & 31) * 16u; }
    }
};
}

namespace pg8 {
template <class Epi, class Sched, class RowSrc, bool ALIGN_EPI = false, bool SP2 = false, bool F8 = false>
__device__ __forceinline__ void gemm_phase_g(PG8_LAS unsigned char* lds, const Gemm g, const Sched& S, const Epi& E, const RowSrc& RS) {
    const int tid = threadIdx.x, wid = __builtin_amdgcn_readfirstlane(tid >> 6), lane = tid & 63, wr = wid >> 2, wc = wid & 3, fr = lane & 15, fq = lane >> 4;
    const int K = g.K, nt = K / BK;
    unsigned voffB[2]; unsigned vC0[2], vC1[2], vN0[2], vN1[2]; int Rr[2], Cc[2];
#pragma unroll
    for (int i = 0; i < 2; ++i) { int R, C; stage_rc(tid * 16 + i * 8192, R, C); const int Rb = Epi::PERM ? ((R & ~31) + perm32(R & 31)) : R;
        Rr[i] = R; Cc[i] = C; voffB[i] = (unsigned)(Rb * K + C) * 2u; }
    const size_t kstep = (size_t)(BK * 2);
    const size_t hstep = (size_t)HALF * K * 2;
    const size_t tstep = 2 * hstep;
    const unsigned ldsw = (unsigned)wid * 1024u;
    const int aoff = lds_byte(wr * 64 + fr, fq * 8), boff = lds_byte(wc * 32 + fr, fq * 8);
#define PG8_CAT8(x, y) __builtin_bit_cast(v8i_t, __builtin_shufflevector((x), (y), 0, 1, 2, 3, 4, 5, 6, 7, 8, 9, 10, 11, 12, 13, 14, 15))
#define PG8_SA(b, h) (((b) * 2 + (h)) * HTB)
#define PG8_SB(b, h) ((4 + (b) * 2 + (h)) * HTB)
#define PG8_STAGE(bufoff, gbase, voff) do { _Pragma("unroll") for (int _i = 0; _i < 2; ++_i) \
        __builtin_amdgcn_global_load_lds((const unsigned*)((const char*)(gbase) + (voff)[_i]), (PG8_LAS unsigned*)(lds + (bufoff) + ldsw + _i * 8192), 16, 0, 0); } while (0)
#define PG8_LDA(dst, b, h) do { if constexpr (F8) { _Pragma("unroll") for (int m = 0; m < 4; ++m) dst##8[m] = PG8_CAT8(*(const PG8_LAS bf16x8*)(lds + PG8_SA(b, h) + aoff + m * 2048), *(const PG8_LAS bf16x8*)(lds + PG8_SA(b, h) + aoff + m * 2048 + 1024)); } else _Pragma("unroll") for (int m = 0; m < 4; ++m) _Pragma("unroll") for (int k = 0; k < 2; ++k) dst[m][k] = *(const PG8_LAS bf16x8*)(lds + PG8_SA(b, h) + aoff + m * 2048 + k * 1024); } while (0)
#define PG8_LDB(dst, b, h) do { if constexpr (F8) { _Pragma("unroll") for (int n = 0; n < 2; ++n) dst##8[n] = PG8_CAT8(*(const PG8_LAS bf16x8*)(lds + PG8_SB(b, h) + boff + n * 2048), *(const PG8_LAS bf16x8*)(lds + PG8_SB(b, h) + boff + n * 2048 + 1024)); } else _Pragma("unroll") for (int n = 0; n < 2; ++n) _Pragma("unroll") for (int k = 0; k < 2; ++k) dst[n][k] = *(const PG8_LAS bf16x8*)(lds + PG8_SB(b, h) + boff + n * 2048 + k * 1024); } while (0)
#define PG8_MMA(ai, bj, At, Bt) do { __builtin_amdgcn_s_setprio(1); \
        if constexpr (F8) { _Pragma("unroll") for (int m = 0; m < 4; ++m) _Pragma("unroll") for (int n = 0; n < 2; ++n) \
            asm volatile("v_mfma_f32_16x16x128_f8f6f4 %0, %1, %2, %0" : "+v"(acc[ai][bj][m][n]) : "v"(Bt##8[n]), "v"(At##8[m])); }     \
        else { _Pragma("unroll") for (int m = 0; m < 4; ++m) _Pragma("unroll") for (int n = 0; n < 2; ++n) _Pragma("unroll") for (int k = 0; k < 2; ++k) \
            acc[ai][bj][m][n] = __builtin_amdgcn_mfma_f32_16x16x32_bf16(Bt[n][k], At[m][k], acc[ai][bj][m][n], 0, 0, 0); } \
        __builtin_amdgcn_s_setprio(0); } while (0)
#define PG8_WAIT_V(n) asm volatile("s_waitcnt vmcnt(" #n ")" ::: "memory")
#define PG8_WAIT_L(n) asm volatile("s_waitcnt lgkmcnt(" #n ")" ::: "memory")
#define PG8_BAR __builtin_amdgcn_s_barrier()
#define PG8_SCHED __builtin_amdgcn_sched_barrier(0)
    Unit cur, nxt; int ui = 0;
    if (!S.next(0, cur)) return;
    bool skip1 = S.rows(cur) <= HALF;
    f32x4 acc[2][2][4][2];
#pragma unroll
    for (int a = 0; a < 2; ++a)
#pragma unroll
        for (int b = 0; b < 2; ++b)
#pragma unroll
            for (int m = 0; m < 4; ++m)
#pragma unroll
                for (int n = 0; n < 2; ++n) acc[a][b][m][n] = (f32x4){0.f, 0.f, 0.f, 0.f};
    bf16x8 At[4][2], B0[2][2], B1[2][2];
    v8i_t At8[4], B08[2], B18[2];
    const char* cA = (const char*)g.A; const char* cB = (const char*)g.Bt + (size_t)cur.pn * tstep;
    RS.rows(cur, Rr, Cc, K, vC0, vC1);
    S.a_ready(cur);
    if constexpr (SP2) {
        PG8_STAGE(PG8_SB(0, 0), cB, voffB); PG8_STAGE(PG8_SB(0, 1), cB + hstep, voffB); PG8_STAGE(PG8_SA(0, 0), cA, vC0); PG8_STAGE(PG8_SA(0, 1), cA, vC1);
        if (wr == 1) PG8_BAR;
        PG8_WAIT_V(2); PG8_BAR;
        PG8_STAGE(PG8_SB(1, 0), cB + kstep, voffB); PG8_STAGE(PG8_SA(1, 0), cA + kstep, vC0); PG8_STAGE(PG8_SB(1, 1), cB + hstep + kstep, voffB);
        PG8_WAIT_V(6); PG8_BAR;
    } else {
        PG8_STAGE(PG8_SB(0, 0), cB, voffB); PG8_STAGE(PG8_SA(0, 0), cA, vC0); PG8_STAGE(PG8_SB(0, 1), cB + hstep, voffB); PG8_STAGE(PG8_SA(0, 1), cA, vC1);
        if (wr == 1) PG8_BAR;
        PG8_WAIT_V(4); PG8_BAR;
        PG8_STAGE(PG8_SB(1, 0), cB + kstep, voffB); PG8_STAGE(PG8_SA(1, 0), cA + kstep, vC0); PG8_STAGE(PG8_SB(1, 1), cB + hstep + kstep, voffB);
        PG8_WAIT_V(6); PG8_BAR;
    }
    for (;;) {
        const bool has_next = S.next(ui + 1, nxt);
        const char* nA = cA; const char* nB = has_next ? (const char*)g.Bt + (size_t)nxt.pn * tstep : cB;
        if (has_next) RS.rows(nxt, Rr, Cc, K, vN0, vN1); else { vN0[0] = vC0[0]; vN0[1] = vC0[1]; vN1[0] = vC1[0]; vN1[1] = vC1[1]; }
        for (int t = 0; t < nt; t += 2) {
            const bool last = (t == nt - 2);
            const char* a1 = cA + (size_t)(t + 1) * kstep;
            const char* a2 = last ? nA : cA + (size_t)(t + 2) * kstep; const char* b2 = last ? nB : cB + (size_t)(t + 2) * kstep;
            const char* a3 = a2 + kstep; const char* b3 = b2 + kstep;
            const unsigned v20[2] = {last ? vN0[0] : vC0[0], last ? vN0[1] : vC0[1]}, v21[2] = {last ? vN1[0] : vC1[0], last ? vN1[1] : vC1[1]};
            if (last && has_next) S.a_ready(nxt);
            if constexpr (SP2) {
            PG8_LDB(B0, 0, 0); PG8_LDB(B1, 0, 1); PG8_SCHED; PG8_LDA(At, 0, 0); PG8_STAGE(PG8_SA(1, 1), a1, vC1);
            PG8_WAIT_V(8); PG8_WAIT_L(0); PG8_BAR; PG8_MMA(0, 0, At, B0); PG8_MMA(0, 1, At, B1); PG8_BAR; PG8_SCHED;
            PG8_LDA(At, 0, 1); PG8_STAGE(PG8_SB(0, 0), b2, voffB); PG8_STAGE(PG8_SB(0, 1), b2 + hstep, voffB); PG8_STAGE(PG8_SA(0, 0), a2, v20);
            PG8_WAIT_V(8); PG8_WAIT_L(0); PG8_BAR; if (!skip1) { PG8_MMA(1, 0, At, B0); PG8_MMA(1, 1, At, B1); } PG8_BAR; PG8_SCHED;
            PG8_LDB(B0, 1, 0); PG8_LDB(B1, 1, 1); PG8_SCHED; PG8_LDA(At, 1, 0); PG8_STAGE(PG8_SA(0, 1), a2, v21);
            PG8_WAIT_V(8); PG8_WAIT_L(0); PG8_BAR; PG8_MMA(0, 0, At, B0); PG8_MMA(0, 1, At, B1); PG8_BAR; PG8_SCHED;
            PG8_LDA(At, 1, 1); PG8_STAGE(PG8_SB(1, 0), b3, voffB); PG8_STAGE(PG8_SB(1, 1), b3 + hstep, voffB); PG8_STAGE(PG8_SA(1, 0), a3, v20);
            PG8_WAIT_V(8); PG8_WAIT_L(0); PG8_BAR; if (!skip1) { PG8_MMA(1, 0, At, B0); PG8_MMA(1, 1, At, B1); } PG8_BAR; PG8_SCHED;
            } else {
            PG8_LDB(B0, 0, 0); PG8_SCHED; PG8_LDA(At, 0, 0); PG8_STAGE(PG8_SA(1, 1), a1, vC1);
            PG8_WAIT_L(8); PG8_BAR; PG8_WAIT_L(0); PG8_MMA(0, 0, At, B0); PG8_BAR; PG8_SCHED;
            PG8_LDB(B1, 0, 1); PG8_STAGE(PG8_SB(0, 0), b2, voffB);
            PG8_BAR; PG8_WAIT_L(0); PG8_MMA(0, 1, At, B1); PG8_BAR;
            PG8_LDA(At, 0, 1); PG8_STAGE(PG8_SA(0, 0), a2, v20);
            PG8_BAR; PG8_WAIT_L(0); PG8_MMA(1, 0, At, B0); PG8_BAR; PG8_SCHED;
            PG8_STAGE(PG8_SB(0, 1), b2 + hstep, voffB);
            PG8_WAIT_V(6); PG8_BAR; PG8_MMA(1, 1, At, B1); PG8_BAR;
            PG8_LDB(B0, 1, 0); PG8_SCHED; PG8_LDA(At, 1, 0); PG8_STAGE(PG8_SA(0, 1), a2, v21);
            PG8_WAIT_L(8); PG8_BAR; PG8_WAIT_L(0); PG8_MMA(0, 0, At, B0); PG8_BAR; PG8_SCHED;
            PG8_LDB(B1, 1, 1); PG8_STAGE(PG8_SB(1, 0), b3, voffB);
            PG8_BAR; PG8_WAIT_L(0); PG8_MMA(0, 1, At, B1); PG8_BAR;
            PG8_LDA(At, 1, 1); PG8_STAGE(PG8_SA(1, 0), a3, v20);
            PG8_BAR; PG8_WAIT_L(0); PG8_MMA(1, 0, At, B0); PG8_BAR; PG8_SCHED;
            PG8_STAGE(PG8_SB(1, 1), b3 + hstep, voffB);
            PG8_WAIT_V(6); PG8_BAR; PG8_MMA(1, 1, At, B1); PG8_BAR;
            }
        }
        if constexpr (F8) asm volatile("s_nop 15\n\ts_nop 7" ::: "memory");
        if constexpr (ALIGN_EPI) { if (wr == 0) PG8_BAR; }
        if constexpr (!Epi::AFTER_DRAIN) { E(acc, cur, wr, wc, fr, fq); S.done(cur); }
        if (!has_next) break;
#pragma unroll
        for (int a = 0; a < 2; ++a)
#pragma unroll
            for (int b = 0; b < 2; ++b)
#pragma unroll
                for (int m = 0; m < 4; ++m)
#pragma unroll
                    for (int n = 0; n < 2; ++n) acc[a][b][m][n] = (f32x4){0.f, 0.f, 0.f, 0.f};
        cur = nxt; cA = nA; cB = nB; ++ui; skip1 = S.rows(cur) <= HALF; vC0[0] = vN0[0]; vC0[1] = vN0[1]; vC1[0] = vN1[0]; vC1[1] = vN1[1];
        if constexpr (ALIGN_EPI) { if (wr == 1) PG8_BAR; }
    }
    PG8_WAIT_V(0);
    if constexpr (!ALIGN_EPI) { if (wr == 0) PG8_BAR; }
    PG8_BAR;
    if constexpr (Epi::AFTER_DRAIN) { E.fused(acc, cur, wr, wc, fr, fq, lds, wid, lane); S.done(cur); }
#undef PG8_SA
#undef PG8_SB
#undef PG8_STAGE
#undef PG8_LDA
#undef PG8_LDB
#undef PG8_MMA
#undef PG8_CAT8
#undef PG8_WAIT_V
#undef PG8_WAIT_L
#undef PG8_BAR
#undef PG8_SCHED
}

struct ExpertRows {
    const PG8_LAS int* tab; const int* lst_tok; int lcap;
    __device__ __forceinline__ void rows(const Unit& u, const int (&Rr)[2], const int (&Cc)[2], int K, unsigned (&v0)[2], unsigned (&v1)[2]) const {
        const int e = u.pn >> 3, mi = u.pm - tab[40 + e], cnt = tab[80 + e];
#pragma unroll
        for (int i = 0; i < 2; ++i) { const int p0 = mi * BM + Rr[i], p1 = p0 + HALF;
            const int t0 = p0 < cnt ? lst_tok[(size_t)e * lcap + p0] : 0, t1 = p1 < cnt ? lst_tok[(size_t)e * lcap + p1] : 0;
            v0[i] = (unsigned)(t0 * K + Cc[i]) * 2u; v1[i] = (unsigned)(t1 * K + Cc[i]) * 2u; }
    }
};
}

#ifndef PG8_SP2
#define PG8_SP2 true
#endif
#ifndef PG8_ALIGN
#define PG8_ALIGN true
#endif

namespace attn_body {
using bf16=__hip_bfloat16;
using bf16x8=__attribute__((ext_vector_type(8)))short;
using s16x4=__attribute__((ext_vector_type(4)))short;
using f32x16=__attribute__((ext_vector_type(16)))float;
using u32x4=__attribute__((ext_vector_type(4)))unsigned;
constexpr int SEQ=2048,D=64,QP=1024,KP=1024,VP=5632,OP=1024;
constexpr int NW=8,QBLK=32,QB=QBLK*NW,KVBLK=64,NQB=SEQ/QB;
constexpr int ATTN_UNIT_ROWS=QB;
__device__ __forceinline__ int crow(int r,int hi){return (r&3)+8*(r>>2)+4*hi;}
#define SBAR() __builtin_amdgcn_sched_barrier(0)
__device__ __forceinline__ void cmask(f32x16&p0,f32x16&p1,int jb,int qrel,int hi){
  const float NEG=-INFINITY; int kb=64*jb+4*hi;
  #pragma unroll
  for(int r=0;r<16;++r){int kv=kb+(r&3)+8*(r>>2); if(kv>qrel)p0[r]=NEG; if(kv+32>qrel)p1[r]=NEG;}
}

constexpr int NSLOT=3, SLOTB=8192;
constexpr int LDS_K=0, LDS_V=NSLOT*SLOTB, LDS_WS=2*NSLOT*SLOTB, LDS_OST=LDS_WS+NW*64*4, LDS_BYTES=LDS_OST+NW*4096;
constexpr float C2=0.125f*1.4426950408889634f;
__device__ __forceinline__ void glds16(const void*gsrc,unsigned lds_dst){unsigned keep;
  asm volatile("s_mov_b32 %0, m0\n\ts_mov_b32 m0, %2\n\ts_nop 0\n\tglobal_load_lds_dwordx4 %1, off\n\ts_mov_b32 m0, %0":"=&s"(keep):"v"(gsrc),"s"(lds_dst):"memory");}
__device__ __forceinline__ float max3f(float a,float b,float c){float r;asm("v_max3_f32 %0, %1, %2, %3":"=v"(r):"v"(a),"v"(b),"v"(c));return r;}
__device__ __forceinline__ float max2f(float a,float b){float r;asm("v_max_f32_e32 %0, %1, %2":"=v"(r):"v"(a),"v"(b));return r;}
__device__ __forceinline__ float fadd_s(float a,float b){float r;asm("v_add_f32_e32 %0, %1, %2":"=v"(r):"v"(a),"v"(b));return r;}
__device__ __forceinline__ float fsub_s(float a,float b){float r;asm("v_sub_f32_e32 %0, %1, %2":"=v"(r):"v"(a),"v"(b));return r;}
typedef float f32x2_t __attribute__((ext_vector_type(2))); typedef __bf16 bf16x2_t __attribute__((ext_vector_type(2)));
__device__ __forceinline__ unsigned cvtpk_s(float lo,float hi){f32x2_t v={lo,hi};bf16x2_t b=__builtin_convertvector(v,bf16x2_t);return __builtin_bit_cast(unsigned,b);}
#define WAIT_BAR(N) asm volatile("s_waitcnt vmcnt(" #N ") lgkmcnt(0)\n\ts_barrier":::"memory")

__device__ __forceinline__ void qkt(f32x16&p0,f32x16&p1,const char*Kslot,const bf16x8*qr,const f32x16&negm,int r32,int hi){
  const char*kb=Kslot+hi*1024+r32*16;
  #pragma unroll
  for(int d0=0;d0<4;++d0){
    const bf16x8 b0=*reinterpret_cast<const bf16x8*>(kb+d0*2048);
    const bf16x8 b1=*reinterpret_cast<const bf16x8*>(kb+d0*2048+512);
    if(d0==0){p0=__builtin_amdgcn_mfma_f32_32x32x16_bf16(b0,qr[0],negm,0,0,0);p1=__builtin_amdgcn_mfma_f32_32x32x16_bf16(b1,qr[0],negm,0,0,0);}
    else{p0=__builtin_amdgcn_mfma_f32_32x32x16_bf16(b0,qr[d0],p0,0,0,0);p1=__builtin_amdgcn_mfma_f32_32x32x16_bf16(b1,qr[d0],p1,0,0,0);}}
}
typedef __attribute__((address_space(3))) const char* lds_cptr;
typedef short v4i16_t __attribute__((ext_vector_type(4)));
__device__ __forceinline__ void kload8(bf16x8*kf,lds_cptr kp){
  kf[0]=*(const __attribute__((address_space(3))) bf16x8*)(kp);      kf[1]=*(const __attribute__((address_space(3))) bf16x8*)(kp+512);
  kf[2]=*(const __attribute__((address_space(3))) bf16x8*)(kp+2048); kf[3]=*(const __attribute__((address_space(3))) bf16x8*)(kp+2560);
  kf[4]=*(const __attribute__((address_space(3))) bf16x8*)(kp+4096); kf[5]=*(const __attribute__((address_space(3))) bf16x8*)(kp+4608);
  kf[6]=*(const __attribute__((address_space(3))) bf16x8*)(kp+6144); kf[7]=*(const __attribute__((address_space(3))) bf16x8*)(kp+6656);
}
__device__ __forceinline__ void kload2(bf16x8*kf,lds_cptr kp,int j){ kf[2*j]=*(const __attribute__((address_space(3))) bf16x8*)(kp+j*2048); kf[2*j+1]=*(const __attribute__((address_space(3))) bf16x8*)(kp+j*2048+512); }
__device__ __forceinline__ s16x4 vtr(lds_cptr p){ return __builtin_bit_cast(s16x4,__builtin_amdgcn_ds_read_tr16_b64_v4i16((__attribute__((address_space(3))) v4i16_t*)p)); }
__device__ __forceinline__ float rowmax(const f32x16&p0,const f32x16&p1){
  float a=max3f(p0[0],p0[1],p1[0]),b=max3f(p0[2],p0[3],p1[1]);a=max3f(a,p1[2],p1[3]);
  #pragma unroll
  for(int r=4;r<16;r+=4){a=max3f(a,p0[r],p0[r+1]);b=max3f(b,p0[r+2],p0[r+3]);a=max3f(a,p1[r],p1[r+1]);b=max3f(b,p1[r+2],p1[r+3]);}
  const float m=max2f(a,b);
  auto rr=__builtin_amdgcn_permlane32_swap(__float_as_uint(m),__float_as_uint(m),false,false);
  return max2f(__uint_as_float(rr[0]),__uint_as_float(rr[1]));
}
__device__ __forceinline__ void pv(f32x16*o,int vb,bf16x8 pa0,bf16x8 pa1,bf16x8 pa2,bf16x8 pa3){
  #pragma unroll
  for(int d0=0;d0<2;++d0){s16x4 lo[4],hi[4];
    #pragma unroll
    for(int ks=0;ks<4;++ks){
      asm volatile("ds_read_b64_tr_b16 %0,%1 offset:%c2":"=&v"(lo[ks]):"v"(vb),"i"(d0*4096+ks*1024):"memory");
      asm volatile("ds_read_b64_tr_b16 %0,%1 offset:%c2":"=&v"(hi[ks]):"v"(vb),"i"(d0*4096+ks*1024+512):"memory");}
    asm volatile("s_waitcnt lgkmcnt(0)":::"memory");SBAR();
    #define PK(k) (bf16x8){lo[k][0],lo[k][1],lo[k][2],lo[k][3],hi[k][0],hi[k][1],hi[k][2],hi[k][3]}
    o[d0]=__builtin_amdgcn_mfma_f32_32x32x16_bf16(pa0,PK(0),o[d0],0,0,0);
    o[d0]=__builtin_amdgcn_mfma_f32_32x32x16_bf16(pa1,PK(1),o[d0],0,0,0);
    o[d0]=__builtin_amdgcn_mfma_f32_32x32x16_bf16(pa2,PK(2),o[d0],0,0,0);
    o[d0]=__builtin_amdgcn_mfma_f32_32x32x16_bf16(pa3,PK(3),o[d0],0,0,0);
    #undef PK
  }
}

#ifndef ATTN_STORE16
#define ATTN_STORE16(p,v) (*(u32x4*)(p)=(v))
#endif
template<int THRL> __device__ __forceinline__ void attn_unit(int b,int h,int qb,const bf16*Q,const bf16*__restrict__ K,const bf16*__restrict__ V,bf16*O,char*shm){
  int tid_=threadIdx.x; asm volatile("" : "+v"(tid_));
  const int tid=tid_,lane=tid&63,r32=lane&31,hi=lane>>5; const int wid=__builtin_amdgcn_readfirstlane(tid>>6);
  const long rowbase=(long)b*SEQ; const int q0=qb*QB;
  const bf16*Qw=Q+(rowbase+q0+wid*QBLK)*QP+h*D;
  const bf16*Kh=K+rowbase*KP+h*D,*Vh=V+rowbase*VP+h*D;
  const unsigned lds0=(unsigned)(uintptr_t)shm;
  float*wsf=(float*)(shm+LDS_WS)+wid*64;
  const bf16*ksrc=Kh+(long)lane*KP+wid*8;
  const bf16*vsrc=Vh+(long)(16*(wid&3)+(lane>>2))*VP+(wid>>2)*32+(lane&3)*8;
  const unsigned kdst=lds0+LDS_K+wid*1024, vdst=lds0+LDS_V+wid*1024;
  #define DMA_K(t,slot) glds16(ksrc+(long)(t)*KVBLK*KP,(unsigned)__builtin_amdgcn_readfirstlane(kdst+(slot)))
  #define DMA_V(t,slot) glds16(vsrc+(long)(t)*KVBLK*VP,(unsigned)__builtin_amdgcn_readfirstlane(vdst+(slot)))
  const int vb0=(int)(lds0+LDS_V)+((lane>>4)&1)*32+(lane&3)*8+(4*hi+((lane&15)>>2))*64;
  const char*Kbase=shm+LDS_K; bf16x8 kf[8];
  const lds_cptr shm3=(lds_cptr)shm; const lds_cptr kp0=shm3+LDS_K+hi*1024+r32*16; const lds_cptr vp0=shm3+LDS_V+((lane>>4)&1)*32+(lane&3)*8+(4*hi+((lane&15)>>2))*64;
  const int NT=(q0+QB)/KVBLK;
  DMA_K(0,0);DMA_V(0,0);DMA_K(1,SLOTB);
  bf16x8 qr[4];
  #pragma unroll
  for(int d0=0;d0<4;++d0)qr[d0]=*reinterpret_cast<const bf16x8*>(&Qw[(long)r32*QP+d0*16+hi*8]);
  float mhat=0.f,l_reg=0.f;f32x16 o[2];o[0]=f32x16{};o[1]=f32x16{};f32x16 negm=f32x16{};asm volatile("":"+v"(negm));
  const int qrel=wid*QBLK+r32;
  #define CMASK(P0,P1,t) do{int jb_=(t)-(NT-4); if(jb_>=0)cmask(P0,P1,jb_,qrel,hi);}while(0)
  bool resc=false;
  #define START(P0,P1) do{ const float rm=rowmax(P0,P1); resc=false; \
    { const float dl=rm; mhat=fadd_s(mhat,dl); \
      _Pragma("unroll") for(int r=0;r<16;++r){P0[r]=fsub_s(P0[r],dl);P1[r]=fsub_s(P1[r],dl);} \
      _Pragma("unroll") for(int r=0;r<16;++r)negm[r]=-mhat; asm volatile("":"+v"(negm)); } \
    _Pragma("unroll") for(int r=0;r<16;++r)P0[r]=__builtin_amdgcn_exp2f(P0[r]); }while(0)
  #define RESC() do{ if(resc){ asm volatile("s_waitcnt lgkmcnt(0)":::"memory"); \
      _Pragma("unroll") for(int d_=0;d_<2;++d_) _Pragma("unroll") for(int r=0;r<16;++r)o[d_][r]*=wsf[crow(r,hi)]; } }while(0)
  f32x16 pA0,pA1,pB0,pB1;
  int sl_prev=0,sl_cur=0,sl_next=SLOTB;
  #define ROT() do{sl_prev=sl_cur;sl_cur=sl_next;sl_next=(sl_next==(NSLOT-1)*SLOTB)?0:sl_next+SLOTB;}while(0)
  DMA_K(2,2*SLOTB);
  WAIT_BAR(3);
  qkt(pA0,pA1,Kbase,qr,negm,r32,hi);asm volatile("s_nop 15\n\ts_nop 7":"+v"(pA0),"+v"(pA1));CMASK(pA0,pA1,0);
  START(pA0,pA1);
  _Pragma("unroll") for(int r=0;r<16;++r)pA1[r]=__builtin_amdgcn_exp2f(pA1[r]);
  WAIT_BAR(0);
  DMA_K(3,0);DMA_V(1,SLOTB);
  ROT();
  kload8(kf,kp0+sl_cur);
  WAIT_BAR(2);
  s16x4 vlo[8],vhi[8]; u32x4 pw0,pw1,pw2,pw3;
  #define PKW(P,B) cvtpk_s(P[B],P[B+1])
  #define PAF(k) __builtin_bit_cast(bf16x8,pw##k)
  #define VFR(i) (bf16x8){vlo[i][0],vlo[i][1],vlo[i][2],vlo[i][3],vhi[i][0],vhi[i][1],vhi[i][2],vhi[i][3]}
  #define PIN(x) asm volatile("":"+v"(x))
  #define MX3(a,b,c) __builtin_fmaxf(__builtin_fmaxf((a),(b)),(c))
  #define GAPA(MF,A0,A1,A2,A3,W0,W1,PW) do{ MF; sacc+=A0; sacc+=A1; sacc+=A2; sacc+=A3; PIN(sacc); W0; W1; PIN(PW); SBAR(); }while(0)
  #define EX(v) __builtin_amdgcn_exp2f(v)
  #define GAPB(MF,X,B) do{ MF; X[B]=EX(X[B]); X[B+1]=EX(X[B+1]); X[B+2]=EX(X[B+2]); X[B+3]=EX(X[B+3]); PIN(X); SBAR(); }while(0)
  #define VRD(i) do{ vlo[i]=vtr(vp_+(((i)>>2)*4096+((i)&3)*1024)); vhi[i]=vtr(vp_+(((i)>>2)*4096+((i)&3)*1024+512)); }while(0)
  #define KRD(G,j) do{ if(G){ kload2(kf,kp0+sl_next,j); SBAR(); } }while(0)
  #define STEP(C0,C1,P0,P1,t,GK,GV,GL) do{ SBAR(); \
    const lds_cptr vp_=vp0+sl_prev; \
    VRD(0); SBAR(); float sacc=(P0[0]+P0[1]); \
    GAPA(C0=__builtin_amdgcn_mfma_f32_32x32x16_bf16(kf[0],qr[0],negm,0,0,0), P0[2],P0[3],P0[4],P0[5],     pw0[0]=PKW(P0,0), pw0[1]=PKW(P0,2), pw0); \
    VRD(4); SBAR(); GAPA(C1=__builtin_amdgcn_mfma_f32_32x32x16_bf16(kf[1],qr[0],negm,0,0,0), P0[6],P0[7],P0[8],P0[9],     pw0[2]=PKW(P0,4), pw0[3]=PKW(P0,6), pw0); \
    VRD(1); SBAR(); GAPA(C0=__builtin_amdgcn_mfma_f32_32x32x16_bf16(kf[2],qr[1],C0,0,0,0),   P0[10],P0[11],P0[12],P0[13], pw1[0]=PKW(P0,8), pw1[1]=PKW(P0,10), pw1); \
    VRD(5); SBAR(); GAPA(C1=__builtin_amdgcn_mfma_f32_32x32x16_bf16(kf[3],qr[1],C1,0,0,0),   P0[14],P0[15],P1[0],P1[1],   pw1[2]=PKW(P0,12),pw1[3]=PKW(P0,14), pw1); \
    VRD(2); SBAR(); GAPA(C0=__builtin_amdgcn_mfma_f32_32x32x16_bf16(kf[4],qr[2],C0,0,0,0),   P1[2],P1[3],P1[4],P1[5],     pw2[0]=PKW(P1,0), pw2[1]=PKW(P1,2), pw2); \
    VRD(6); SBAR(); GAPA(C1=__builtin_amdgcn_mfma_f32_32x32x16_bf16(kf[5],qr[2],C1,0,0,0),   P1[6],P1[7],P1[8],P1[9],     pw2[2]=PKW(P1,4), pw2[3]=PKW(P1,6), pw2); \
    VRD(3); SBAR(); GAPA(C0=__builtin_amdgcn_mfma_f32_32x32x16_bf16(kf[6],qr[3],C0,0,0,0),   P1[10],P1[11],P1[12],P1[13], pw3[0]=PKW(P1,8), pw3[1]=PKW(P1,10), pw3); \
    VRD(7); SBAR(); GAPA(C1=__builtin_amdgcn_mfma_f32_32x32x16_bf16(kf[7],qr[3],C1,0,0,0),   P1[14],P1[15],0.f,0.f,       pw3[2]=PKW(P1,12),pw3[3]=PKW(P1,14), pw3); \
    l_reg+=sacc; \
    if(GK){DMA_K((t)+3,sl_cur);} if(GV){DMA_V((t)+1,sl_next);} \
    CMASK(C0,C1,t); \
    { float a=MX3(C0[0],C0[1],C1[0]),b=MX3(C0[2],C0[3],C1[1]); a=MX3(a,C1[2],C1[3]); \
      _Pragma("unroll") for(int r=4;r<16;r+=4){a=MX3(a,C0[r],C0[r+1]);b=MX3(b,C0[r+2],C0[r+3]);a=MX3(a,C1[r],C1[r+1]);b=MX3(b,C1[r+2],C1[r+3]);} \
      float rm=__builtin_fmaxf(a,b); { auto rr=__builtin_amdgcn_permlane32_swap(__float_as_uint(rm),__float_as_uint(rm),false,false); rm=__builtin_fmaxf(__uint_as_float(rr[0]),__uint_as_float(rr[1])); } \
      resc=false; \
      if(__builtin_expect(__any(rm>(float)THRL),0)){ const float dl=__builtin_fmaxf(rm,0.f); mhat+=dl; \
        _Pragma("unroll") for(int r=0;r<16;++r){C0[r]-=dl;C1[r]-=dl;} \
        _Pragma("unroll") for(int r=0;r<16;++r)negm[r]=-mhat; asm volatile("":"+v"(negm)); \
        const float f=__builtin_amdgcn_exp2f(-dl); l_reg*=f; if(hi==0)wsf[r32]=f; resc=true; } } \
    SBAR(); \
    GAPB(o[0]=__builtin_amdgcn_mfma_f32_32x32x16_bf16(PAF(0),VFR(0),o[0],0,0,0), C0,0); \
    GAPB(o[1]=__builtin_amdgcn_mfma_f32_32x32x16_bf16(PAF(0),VFR(4),o[1],0,0,0), C0,4); \
    KRD(GL,0); GAPB(o[0]=__builtin_amdgcn_mfma_f32_32x32x16_bf16(PAF(1),VFR(1),o[0],0,0,0), C0,8); \
    KRD(GL,1); GAPB(o[1]=__builtin_amdgcn_mfma_f32_32x32x16_bf16(PAF(1),VFR(5),o[1],0,0,0), C0,12); \
    KRD(GL,2); GAPB(o[0]=__builtin_amdgcn_mfma_f32_32x32x16_bf16(PAF(2),VFR(2),o[0],0,0,0), C1,0); \
    KRD(GL,3); GAPB(o[1]=__builtin_amdgcn_mfma_f32_32x32x16_bf16(PAF(2),VFR(6),o[1],0,0,0), C1,4); \
    GAPB(o[0]=__builtin_amdgcn_mfma_f32_32x32x16_bf16(PAF(3),VFR(3),o[0],0,0,0), C1,8); \
    GAPB(o[1]=__builtin_amdgcn_mfma_f32_32x32x16_bf16(PAF(3),VFR(7),o[1],0,0,0), C1,12); \
    }while(0)
  int t=1;
  #undef CMASK
  #define CMASK(P0,P1,t) do{}while(0)
  for(;t+5<NT;t+=2){
    STEP(pB0,pB1,pA0,pA1,t,true,true,true);     WAIT_BAR(2); RESC(); ROT();
    STEP(pA0,pA1,pB0,pB1,t+1,true,true,true);   WAIT_BAR(2); RESC(); ROT();
  }
  #undef CMASK
  #define CMASK(P0,P1,t) do{int jb_=(t)-(NT-4); if(jb_>=0)cmask(P0,P1,jb_,qrel,hi);}while(0)
  #define ENDW(tt) do{ if((tt)+3<NT){WAIT_BAR(2);} else if((tt)+2<NT){WAIT_BAR(1);} else {WAIT_BAR(0);} }while(0)
  for(;t+1<NT;t+=2){
    STEP(pB0,pB1,pA0,pA1,t,(t+3<NT),(t+1<NT),(t+1<NT));       ENDW(t);   RESC(); ROT();
    STEP(pA0,pA1,pB0,pB1,t+1,(t+4<NT),(t+2<NT),(t+2<NT));     ENDW(t+1); RESC(); ROT();
  }
  STEP(pB0,pB1,pA0,pA1,NT-1,false,false,false); RESC();
  { float sacc=pB0[0]+pB0[1]; _Pragma("unroll") for(int r=2;r<16;++r)sacc+=pB0[r]; _Pragma("unroll") for(int r=0;r<16;++r)sacc+=pB1[r]; l_reg+=sacc;
    pw0=(u32x4){PKW(pB0,0),PKW(pB0,2),PKW(pB0,4),PKW(pB0,6)};pw1=(u32x4){PKW(pB0,8),PKW(pB0,10),PKW(pB0,12),PKW(pB0,14)};pw2=(u32x4){PKW(pB1,0),PKW(pB1,2),PKW(pB1,4),PKW(pB1,6)};pw3=(u32x4){PKW(pB1,8),PKW(pB1,10),PKW(pB1,12),PKW(pB1,14)};
    SBAR(); pv(o,vb0+sl_cur,PAF(0),PAF(1),PAF(2),PAF(3)); }
  #undef PKW
  #undef PAF
  #undef VFR
  #undef PIN
  #undef MX3
  #undef GAPA
  #undef GAPB
  #undef EX
  #undef VRD
  #undef KRD
  #undef STEP
  #undef ENDW
  {auto rr=__builtin_amdgcn_permlane32_swap(__float_as_uint(l_reg),__float_as_uint(l_reg),false,false);l_reg=__uint_as_float(rr[0])+__uint_as_float(rr[1]);}
  if(hi==0)wsf[32+r32]=l_reg;asm volatile("s_waitcnt lgkmcnt(0)":::"memory");
  float rli[16];
  #pragma unroll
  for(int r=0;r<16;++r)rli[r]=__builtin_amdgcn_rcpf(wsf[32+crow(r,hi)]);
  bf16*Ow=O+(rowbase+q0+wid*QBLK)*OP+h*D;
  { bf16*stg=(bf16*)(shm+LDS_OST)+wid*2048;
    #pragma unroll
    for(int r=0;r<16;++r){const int orow=crow(r,hi);
      #pragma unroll
      for(int d0=0;d0<2;++d0)stg[orow*64+d0*32+r32]=__float2bfloat16(o[d0][r]*rli[r]);}
    asm volatile("s_waitcnt lgkmcnt(0)":::"memory");
    #pragma unroll
    for(int i=0;i<4;++i){const int row=i*8+(lane>>3),ch=lane&7; const u32x4 v=*(const u32x4*)(stg+row*64+ch*8); ATTN_STORE16(Ow+(long)row*OP+ch*8,v);} }
  asm volatile("s_waitcnt lgkmcnt(0)\n\ts_barrier":::"memory");
  #undef DMA_K
  #undef DMA_V
  #undef CMASK
  #undef START
  #undef RESC
  #undef ROT
}
constexpr int ATTN_LDS_BYTES=LDS_BYTES;
#undef SBAR
#undef WAIT_BAR
}

#define GAS __attribute__((address_space(1)))
#define LAS __attribute__((address_space(3)))
typedef unsigned short bf16;
typedef unsigned v4u __attribute__((ext_vector_type(4)));
typedef unsigned v2u __attribute__((ext_vector_type(2)));
typedef float f32x4 __attribute__((ext_vector_type(4)));
typedef short bf16x8 __attribute__((ext_vector_type(8)));
typedef GAS unsigned gu32;
#define RLX_AGENT __ATOMIC_RELAXED, __HIP_MEMORY_SCOPE_AGENT
#define LDS_WAIT() asm volatile("s_waitcnt lgkmcnt(0)" ::: "memory")
#define VM_WAIT() asm volatile("s_waitcnt vmcnt(0)" ::: "memory")

#ifndef P1_HOSTS_P0B
#define P1_HOSTS_P0B 1
#endif
constexpr int NWAVES = 8;
constexpr int DM = 2048, NBATCH = 8, SEQ = 2048, M = NBATCH * SEQ;
constexpr int IN_COLS = 5648;
constexpr int NIN = 5632;
constexpr int NIN_G = 5888;
constexpr int UC_Z = 0, UC_XBC = 1024, UC_Q = 2560, UC_K = 3584, UC_V = 4608;
constexpr int NE = 32, EH = 1024;
constexpr float EPS = 1e-6f;
constexpr float F8_WSCALE = 64.f;
constexpr float Y8_SCALE = 16.f;
constexpr size_t MiB = 1u << 20;

constexpr int RING_OFF = 0, RING_BYTES = 131072;
constexpr int LDSCTL_OFF = 159744, MISC_OFF = LDSCTL_OFF + 320;
constexpr int LDS_BYTES = 163840;

namespace mp {
constexpr size_t ctl = 0, small = 1 * MiB, wr = 2 * MiB, rope = 3 * MiB, dt = 5 * MiB, win = 6 * MiB, wout = 30 * MiB, wgu = 38 * MiB, wd = 166 * MiB;
constexpr size_t xn = 230 * MiB, xn2 = 230 * MiB, ycat = 294 * MiB, u16 = 358 * MiB, qn = 534 * MiB, kn = 566 * MiB, xbc = 598 * MiB, o1 = 646 * MiB, o2 = 678 * MiB, ys = 710 * MiB;
constexpr size_t y = 358 * MiB, hid = 518 * MiB;
constexpr size_t lst = 742 * MiB;
constexpr size_t xn8 = 748 * MiB;
constexpr size_t END = 780 * MiB;
}
constexpr size_t CTL_ZERO_BYTES = 1 * MiB;
constexpr int CW_TMO = 0, CW_CODE = 1, CW_BAR = 4096;
constexpr int CW_Q0 = 66560;
constexpr int CW_LOC = 8192, CW_RANK = 10240;
constexpr int CW_CNT = 65536;
constexpr int LCAP = 16384;
constexpr int SLOT_CAP = 40960;
constexpr int TAB_OFF = LDSCTL_OFF + 1024;
constexpr size_t SM_TOK_E = 0, SM_TOK_POS = 131072, SM_TOK_W = 262144, SM_TOK_SLOT = 393216, SM_RINV = 524288, SM_SLOT_W = 655360, SM_SLOT_R = 851968, SM_END = 1048576;

__device__ __forceinline__ void st16_wt(void* p, v4u v) { asm volatile("global_store_dwordx4 %0, %1, off sc1\n\ts_nop 1" :: "v"(p), "v"(v) : "memory"); }
__device__ __forceinline__ unsigned f2bf(float f) { unsigned u = __builtin_bit_cast(unsigned, f); return (u + 0x7fffu + ((u >> 16) & 1u)) >> 16; }
typedef float f32x2_pk __attribute__((ext_vector_type(2))); typedef __bf16 bf16x2_pk __attribute__((ext_vector_type(2)));
__device__ __forceinline__ unsigned pk2(float lo, float hi) { f32x2_pk v = {lo, hi}; bf16x2_pk b = __builtin_convertvector(v, bf16x2_pk); return __builtin_bit_cast(unsigned, b); }
__device__ __forceinline__ float bf2f(unsigned short b) { return __builtin_bit_cast(float, (unsigned)b << 16); }
__device__ __forceinline__ float wave_sum(float v) {
#pragma unroll
    for (int o = 1; o < 64; o <<= 1) v += __shfl_xor(v, o);
    return v;
}

#define XB_TMO      128
#define XB_XCNT(j)  (256  + 64 * (j))
#define XB_XSUB(j)  (1280 + 64 * (j))
#define XB_XGEN(j)  (2304 + 64 * (j))
#define XB_TOP      3328
#define XB_TOPGEN   3392
#define XCD_BAR_WORDS 3456
#define XB_SPIN_CAP (1u << 18)

__device__ __forceinline__ unsigned xb_ld(unsigned* p)              { return __hip_atomic_load(p, __ATOMIC_RELAXED, __HIP_MEMORY_SCOPE_AGENT); }
__device__ __forceinline__ unsigned xb_add(unsigned* p, unsigned v) { return __hip_atomic_fetch_add(p, v, __ATOMIC_RELAXED, __HIP_MEMORY_SCOPE_AGENT); }
__device__ __forceinline__ unsigned xb_xcc_id() { return (unsigned)__builtin_amdgcn_s_getreg((3 << 11) | 20) & 0xFu; }
#define XB_SPIN(cond, bar) do { unsigned _sp = 0; while (cond) { __builtin_amdgcn_s_sleep(1); \
    if ((++_sp & 255u) == 0u) { if (xb_ld(&(bar)[XB_TMO])) break; if (_sp > XB_SPIN_CAP) { atomicAdd(&(bar)[XB_TMO], 1u); break; } } } } while (0)

struct XcdBarrier {
    unsigned* bar; unsigned x;
    volatile LAS unsigned* st;
};

__device__ __forceinline__ XcdBarrier xcd_barrier_post(unsigned* bar, volatile LAS unsigned* st) {
    XcdBarrier b; b.bar = bar; b.x = xb_xcc_id(); b.st = st;
    if (threadIdx.x == 0) (void)xb_add(&bar[XB_XCNT(b.x)], 1u);
    return b;
}
__device__ __forceinline__ void xcd_barrier_complete(unsigned* bar, unsigned x, unsigned& nloc, unsigned& nx) {
    const unsigned G = gridDim.x * gridDim.y * gridDim.z;
    unsigned sum, cnt, mine, sp = 0u;
    for (;;) {
        sum = 0u; cnt = 0u; mine = 0u;
#pragma unroll
        for (unsigned j = 0; j < 16; ++j) { const unsigned c = xb_ld(&bar[XB_XCNT(j)]); sum += c; cnt += (c > 0u) ? 1u : 0u; mine = (j == x) ? c : mine; }
        if (sum == G) break;
        __builtin_amdgcn_s_sleep(1);
        if ((++sp & 255u) == 0u) { if (xb_ld(&bar[XB_TMO])) break; if (sp > XB_SPIN_CAP) { atomicAdd(&bar[XB_TMO], 1u); break; } }
    }
    nloc = mine > 0u ? mine : 1u; nx = cnt > 0u ? cnt : 1u;
}

__device__ __forceinline__ void xcd_barrier(const XcdBarrier& b) {
    asm volatile("s_waitcnt vmcnt(0)" ::: "memory");
    __syncthreads();
    if (threadIdx.x == 0) {
        unsigned* bar = b.bar;
        __builtin_amdgcn_s_waitcnt(0);
        unsigned nloc = b.st[0], nx = b.st[1];
        if (nloc == 0u) { xcd_barrier_complete(bar, b.x, nloc, nx); b.st[0] = nloc; b.st[1] = nx; }
        const unsigned old = xb_add(&bar[XB_XSUB(b.x)], 1u);
        const unsigned gen = old / nloc;
        if (old + 1u == (gen + 1u) * nloc) {
            __builtin_amdgcn_fence(__ATOMIC_RELEASE, "agent");
            asm volatile("s_waitcnt vmcnt(0)" ::: "memory");
            const unsigned og = xb_add(&bar[XB_TOP], 1u);
            const unsigned tg = og / nx;
            if (og + 1u == (tg + 1u) * nx) xb_add(&bar[XB_TOPGEN], 1u);
            else XB_SPIN(xb_ld(&bar[XB_TOPGEN]) == tg, bar);
            __builtin_amdgcn_fence(__ATOMIC_ACQUIRE, "agent");
            xb_add(&bar[XB_XGEN(b.x)], 1u);
            asm volatile("s_waitcnt vmcnt(0)" ::: "memory");
        } else {
            XB_SPIN(xb_ld(&bar[XB_XGEN(b.x)]) == gen, bar);
            __builtin_amdgcn_fence(__ATOMIC_ACQUIRE, "agent");
            asm volatile("s_waitcnt vmcnt(0)" ::: "memory");
        }
    }
    __syncthreads();
}

__device__ __forceinline__ void xcd_local_barrier(unsigned* bar, unsigned* ctr, unsigned n) {
    asm volatile("s_waitcnt vmcnt(0)" ::: "memory");
    __syncthreads();
    if (threadIdx.x == 0) {
        __builtin_amdgcn_s_waitcnt(0);
        const unsigned old = xb_add(ctr, 1u), target = (old / n + 1u) * n;
        XB_SPIN(xb_ld(ctr) < target, bar);
        __builtin_amdgcn_fence(__ATOMIC_ACQUIRE, "agent");
        asm volatile("s_waitcnt vmcnt(0)" ::: "memory");
    }
    __syncthreads();
}

struct XbTok { unsigned gen, tg; int role; };
__device__ __forceinline__ void xcd_barrier_arrive(const XcdBarrier& b, XbTok& t) {
    asm volatile("s_waitcnt vmcnt(0)" ::: "memory");
    __syncthreads();
    t.gen = 0u; t.tg = 0u; t.role = 0;
    if (threadIdx.x == 0) {
        unsigned* bar = b.bar;
        __builtin_amdgcn_s_waitcnt(0);
        unsigned nloc = b.st[0], nx = b.st[1];
        if (nloc == 0u) { xcd_barrier_complete(bar, b.x, nloc, nx); b.st[0] = nloc; b.st[1] = nx; }
        const unsigned old = xb_add(&bar[XB_XSUB(b.x)], 1u);
        const unsigned gen = old / nloc; t.gen = gen;
        if (old + 1u == (gen + 1u) * nloc) {
            __builtin_amdgcn_fence(__ATOMIC_RELEASE, "agent");
            asm volatile("s_waitcnt vmcnt(0)" ::: "memory");
            const unsigned og = xb_add(&bar[XB_TOP], 1u);
            const unsigned tg = og / nx; t.tg = tg; t.role = 1;
            if (og + 1u == (tg + 1u) * nx) xb_add(&bar[XB_TOPGEN], 1u);
        }
    }
}
__device__ __forceinline__ void xcd_barrier_wait(const XcdBarrier& b, const XbTok& t) {
    if (threadIdx.x == 0) {
        unsigned* bar = b.bar;
        if (t.role == 1) { XB_SPIN(xb_ld(&bar[XB_TOPGEN]) == t.tg, bar);
            __builtin_amdgcn_fence(__ATOMIC_ACQUIRE, "agent");
            xb_add(&bar[XB_XGEN(b.x)], 1u);
            asm volatile("s_waitcnt vmcnt(0)" ::: "memory");
        } else { XB_SPIN(xb_ld(&bar[XB_XGEN(b.x)]) == t.gen, bar);
            __builtin_amdgcn_fence(__ATOMIC_ACQUIRE, "agent");
            asm volatile("s_waitcnt vmcnt(0)" ::: "memory"); }
    }
    __syncthreads();
}

struct Frame {
    LAS unsigned char* lds;
    volatile LAS unsigned* MISC;
    gu32* ctl;
    int tid, lane, wave;
    int vcu, G;
    int cid;
    unsigned char* ws;
};

struct TItem { const float* W; bf16* base; const float* kscale; int ldw, nvalid, k0, n0, kind, pitch, f8; };
constexpr int TI_PC = 36, TI_P1 = 8 * TI_PC, TI_BYTES = 16 * TI_P1 * 4;
template <int NI> __device__ __forceinline__ void titem_issue(const TItem& d, int lane, f32x4 (&ld)[NI]) {
    const int nq = d.n0 + 4 * (lane & 7); const bool ok = nq < d.nvalid;
#pragma unroll
    for (int i = 0; i < NI; ++i) ld[i] = ok ? __builtin_nontemporal_load((const GAS f32x4*)(d.W + (size_t)(d.k0 + (lane >> 3) + 8 * i) * d.ldw + nq)) : (f32x4){0.f, 0.f, 0.f, 0.f};
}
template <int NI> __device__ __forceinline__ void titem_finish(const TItem& d, int lane, const f32x4 (&ld)[NI], LAS float* scr, bf16* WIN, bf16* WDT) {
#pragma unroll
    for (int i = 0; i < NI; ++i) { const int k = (lane >> 3) + 8 * i; *(LAS f32x4*)(scr + (k % NI) * TI_P1 + (k / NI) * TI_PC + 4 * (lane & 7)) = ld[i]; }
    LDS_WAIT(); asm volatile("" ::: "memory");
    const int c = lane & 7;
    if constexpr (NI == 16) {
#pragma unroll
        for (int j = 0; j < 4; ++j) { const int nl = (lane >> 3) + 8 * j, n = d.n0 + nl; const LAS float* s = scr + c * TI_PC + nl;
            const size_t rowi = d.kind == 3 ? (size_t)((n & ~255) + ((n >> 3) & 1) * 128 + ((n >> 6) & 3) * 32 + ((n >> 4) & 3) * 8 + (n & 7))
                                            : (size_t)((n >> 7) * 256 + (n & 127));
            v4u q; q.x = pg8::cvt4_fp8(s[0 * TI_P1] * F8_WSCALE, s[1 * TI_P1] * F8_WSCALE, s[2 * TI_P1] * F8_WSCALE, s[3 * TI_P1] * F8_WSCALE); q.y = pg8::cvt4_fp8(s[4 * TI_P1] * F8_WSCALE, s[5 * TI_P1] * F8_WSCALE, s[6 * TI_P1] * F8_WSCALE, s[7 * TI_P1] * F8_WSCALE);
            q.z = pg8::cvt4_fp8(s[8 * TI_P1] * F8_WSCALE, s[9 * TI_P1] * F8_WSCALE, s[10 * TI_P1] * F8_WSCALE, s[11 * TI_P1] * F8_WSCALE); q.w = pg8::cvt4_fp8(s[12 * TI_P1] * F8_WSCALE, s[13 * TI_P1] * F8_WSCALE, s[14 * TI_P1] * F8_WSCALE, s[15 * TI_P1] * F8_WSCALE);
            if (n < d.nvalid) __builtin_nontemporal_store(q, (GAS v4u*)((unsigned char*)d.base + rowi * d.pitch + d.k0 + 16 * c)); }
    } else {
#pragma unroll
        for (int j = 0; j < 4; ++j) { const int nl = (lane >> 3) + 8 * j, n = d.n0 + nl; const LAS float* s = scr + c * TI_PC + nl;
            v4u o; o.x = pk2(s[0 * TI_P1], s[1 * TI_P1]); o.y = pk2(s[2 * TI_P1], s[3 * TI_P1]); o.z = pk2(s[4 * TI_P1], s[5 * TI_P1]); o.w = pk2(s[6 * TI_P1], s[7 * TI_P1]);
            bf16* row;
            if (d.kind == 0) row = n < 2560 ? WIN + (size_t)n * DM : (n < 2576 ? WIN + (size_t)(NIN + n - 2560) * DM : WIN + (size_t)(n - 16) * DM);
            else row = d.base + (size_t)n * d.pitch;
            if (n < d.nvalid) *(GAS v4u*)(row + d.k0 + 8 * c) = o; }
    }
    LDS_WAIT(); asm volatile("" ::: "memory");
}

struct Args { const void* in[26]; float* out; unsigned char* ws; int ph_lo, ph_hi, li, p0_mask, rep_phase, pad; };
typedef const __attribute__((address_space(4))) Args* KA;

constexpr int P0B_NBLK = 3 * NE * 128, P0B_NSUB = 4 * P0B_NBLK;
__device__ __forceinline__ void p0b_blocks(Frame& F, KA args, int first, int nq, int gstride = 1) {
    const int lane = F.lane;
    const float* w_gate = (const float*)args->in[23]; const float* w_up = (const float*)args->in[24]; const float* w_down = (const float*)args->in[25];
    bf16* WGU = (bf16*)(F.ws + mp::wgu); bf16* WD = (bf16*)(F.ws + mp::wd);
    LAS float* scr = (LAS float*)(F.lds + F.wave * TI_BYTES);
    auto decodeB = [&](int q) -> TItem {
        const int g = first + q * gstride, cb = g >> 2, i = g & 3;
        if (cb < 8192) { const int up = cb >> 12, r = cb & 4095, e = r >> 7, kb = (r >> 3) & 15, nb = r & 7;
            return TItem{(up ? w_up : w_gate) + (size_t)e * DM * EH, (bf16*)((unsigned char*)WGU + (size_t)e * 2048 * DM + (up ? (size_t)128 * DM : 0)), nullptr, EH, EH, 128 * kb, 128 * nb + 32 * i, 2, DM, 1}; }
        const int r = cb - 8192, e = r >> 7, kb = (r >> 4) & 7, nb = r & 15;
        return TItem{w_down + (size_t)e * EH * DM, (bf16*)((unsigned char*)WD + (size_t)e * DM * EH), nullptr, DM, DM, 128 * kb, 128 * nb + 32 * i, 3, EH, 1};
    };
    if (nq <= 0) return;
    TItem d0 = decodeB(0), d1 = d0, d2 = d0; f32x4 l0[16], l1[16], l2[16];
    titem_issue<16>(d0, lane, l0);
    if (nq > 1) { d1 = decodeB(1); titem_issue<16>(d1, lane, l1); }
    for (int q = 0; q < nq; q += 3) {
        if (q + 2 < nq) { d2 = decodeB(q + 2); titem_issue<16>(d2, lane, l2); }
        titem_finish<16>(d0, lane, l0, scr, nullptr, nullptr);
        if (q + 1 >= nq) break;
        if (q + 3 < nq) { d0 = decodeB(q + 3); titem_issue<16>(d0, lane, l0); }
        titem_finish<16>(d1, lane, l1, scr, nullptr, nullptr);
        if (q + 2 >= nq) break;
        if (q + 4 < nq) { d1 = decodeB(q + 4); titem_issue<16>(d1, lane, l1); }
        titem_finish<16>(d2, lane, l2, scr, nullptr, nullptr);
    }
}
constexpr int P1_UNITS = (M / 256) * (NIN_G / 256);
#if P1_HOSTS_P0B == 2
constexpr int P1_INLOOP_BLOCKS = P1_UNITS * NWAVES;
static_assert(P0B_NBLK - P1_INLOOP_BLOCKS == 64 * NWAVES, "the 64 CUs with one GEMM unit less take one more block per wave");
#endif
#ifndef P1_NCLASS
#define P1_NCLASS 3
#endif
__device__ __forceinline__ void p1_convert_share(Frame& F, KA args, int part) {
    const int c = F.cid, xcd = c & 7, l = c >> 3, lclass = xcd % P1_NCLASS;
    const int ex = l < 24 ? 0 : 12, q = 21 + ex;
    const int base = xcd * (P0B_NSUB / 8);
    const int first = l < 24 ? base + l * (NWAVES * 21) : base + 24 * NWAVES * 21 + (l - 24) * (NWAVES * 33);
    int lo, hi;
    if (part == 0) { lo = 0; hi = lclass == 0 ? q : ex; } else if (part == lclass) { lo = ex; hi = q; } else return;
    p0b_blocks(F, args, first + F.wave * q + lo, hi - lo);
}

__device__ __forceinline__ void p0_prologue(Frame& F, KA args) {
    const int gw = F.vcu * NWAVES + F.wave, NGW = F.G * NWAVES, lane = F.lane;
    const float* w_in = (const float*)args->in[3]; const float* w_out = (const float*)args->in[17];
    bf16* WIN = (bf16*)(F.ws + mp::win); bf16* WDT = nullptr; bf16* WOUT = (bf16*)(F.ws + mp::wout);
    constexpr int NB_IN = (IN_COLS + 31) / 32;
    constexpr int I_IN = (DM / 64) * NB_IN, I_OUT = (DM / 64) * (DM / 32), NITEMS_A = I_IN + I_OUT;
    LAS float* scr = (LAS float*)(F.lds + F.wave * TI_BYTES);
    auto decodeA = [&](int it) -> TItem {
        int r = it;
        if (r < I_IN) { const int kb = r / NB_IN, nb = r % NB_IN; return TItem{w_in, WIN, nullptr, IN_COLS, IN_COLS, 64 * kb, 32 * nb, 0, DM, 0}; }
        r -= I_IN; const int kb = r / (DM / 32), nb = r % (DM / 32); return TItem{w_out, WOUT, nullptr, DM, DM, 64 * kb, 32 * nb, 1, DM, 0};
    };
    if (gw < NITEMS_A) {
        TItem dc = decodeA(gw); f32x4 la[8], lb[8];
        titem_issue<8>(dc, lane, la);
        for (int it = gw; it < NITEMS_A; it += NGW) {
            const int nx = it + NGW; TItem dn = dc;
            if (nx < NITEMS_A) { dn = decodeA(nx); titem_issue<8>(dn, lane, lb); }
            titem_finish<8>(dc, lane, la, scr, WIN, WDT);
            dc = dn;
#pragma unroll
            for (int i = 0; i < 8; ++i) la[i] = lb[i];
        }
    }
#if !P1_HOSTS_P0B
    p0b_blocks(F, args, gw * (P0B_NSUB / NGW), P0B_NSUB / NGW);
#endif
}

__device__ __forceinline__ void p0_xn1(Frame& F, KA args) {
    const int lane = F.lane;
    const float* x = (const float*)args->in[0]; const float* ln1 = (const float*)args->in[2]; bf16* XN = (bf16*)(F.ws + mp::xn);
    for (int it = 0; it < 4; ++it) { const int m0 = (F.vcu >> 5) * 2048 + it * 512 + ((F.vcu & 31) * NWAVES + F.wave) * 2;
        f32x4 v[2][8];
#pragma unroll
        for (int rr = 0; rr < 2; ++rr)
#pragma unroll
            for (int j = 0; j < 8; ++j) v[rr][j] = __builtin_nontemporal_load((const GAS f32x4*)(x + (size_t)(m0 + rr) * DM) + lane + 64 * j);
#pragma unroll
        for (int rr = 0; rr < 2; ++rr) { float s = 0.f;
#pragma unroll
            for (int j = 0; j < 8; ++j) s += (v[rr][j].x * v[rr][j].x + v[rr][j].y * v[rr][j].y) + (v[rr][j].z * v[rr][j].z + v[rr][j].w * v[rr][j].w);
            const float r = 1.0f / sqrtf(wave_sum(s) * (1.f / DM) + EPS);
            GAS v2u* o8 = (GAS v2u*)(XN + (size_t)(m0 + rr) * DM) + lane; const GAS f32x4* wr = (const GAS f32x4*)ln1 + lane;
#pragma unroll
            for (int j = 0; j < 8; ++j) { const f32x4 ww = wr[64 * j]; v2u o; o.x = pk2(v[rr][j].x * r * ww.x, v[rr][j].y * r * ww.y); o.y = pk2(v[rr][j].z * r * ww.z, v[rr][j].w * r * ww.w); o8[64 * j] = o; } }
    }
}


__device__ __forceinline__ void p0_rope(Frame& F, KA args) {
    const int gt = (F.vcu * NWAVES + F.wave) * 64 + F.lane, NGT = F.G * NWAVES * 64;
    const int* pos = (const int*)args->in[1]; float* rope = (float*)(F.ws + mp::rope);
    for (int i = gt; i < M * 8; i += NGT) { const int m = i >> 3, j = i & 7;
        const float inv_freq = powf(500000.0f, -(float)(2 * j) / 16.0f);
        const float ang = (float)pos[m] * inv_freq;
        rope[m * 16 + j] = cosf(ang); rope[m * 16 + 8 + j] = sinf(ang); }
}

__device__ __forceinline__ void p2_qknorm(Frame& F, KA args) {
    const int gw = F.vcu * NWAVES + F.wave, NGW = F.G * NWAVES, lane = F.lane;
    const bf16* U16 = (const bf16*)(F.ws + mp::u16); const float* rope = (const float*)(F.ws + mp::rope);
    bf16* QN = (bf16*)(F.ws + mp::qn); bf16* KN = (bf16*)(F.ws + mp::kn);
    const float* qw = (const float*)args->in[10]; const float* kw = (const float*)args->in[11];
    const int sub = lane & 7;
    float wq[8], wk[8];
#pragma unroll
    for (int j = 0; j < 8; ++j) { wq[j] = qw[sub * 8 + j] * attn_body::C2; wk[j] = kw[sub * 8 + j]; }
    for (int it = 0; it < 2; ++it) { const int m0 = (F.vcu >> 5) * 2048 + it * 1024 + ((F.vcu & 31) * NWAVES + F.wave) * 4;
        v4u raw[4][4]; f32x4 rp[4][4];
#pragma unroll
        for (int rr = 0; rr < 4; ++rr) {
#pragma unroll
            for (int pc = 0; pc < 4; ++pc) raw[rr][pc] = __builtin_nontemporal_load((const GAS v4u*)(U16 + (size_t)(m0 + rr) * NIN + ((pc >> 1) ? UC_K : UC_Q) + (pc & 1) * 512 + lane * 8));
#pragma unroll
            for (int q = 0; q < 4; ++q) rp[rr][q] = *(const GAS f32x4*)(rope + (size_t)(m0 + rr) * 16 + 4 * q);
        }
#pragma unroll
        for (int rr = 0; rr < 4; ++rr) {
            const int m = m0 + rr;
            const float cs[8] = {rp[rr][0].x, rp[rr][0].y, rp[rr][0].z, rp[rr][0].w, rp[rr][1].x, rp[rr][1].y, rp[rr][1].z, rp[rr][1].w};
            const float sn[8] = {rp[rr][2].x, rp[rr][2].y, rp[rr][2].z, rp[rr][2].w, rp[rr][3].x, rp[rr][3].y, rp[rr][3].z, rp[rr][3].w};
#pragma unroll
            for (int pc = 0; pc < 4; ++pc) {
                const int isk = pc >> 1, col = (pc & 1) * 512 + lane * 8;
                const v4u rw = raw[rr][pc];
                float v[8];
                v[0] = __builtin_bit_cast(float, rw.x << 16); v[1] = __builtin_bit_cast(float, rw.x & 0xffff0000u); v[2] = __builtin_bit_cast(float, rw.y << 16); v[3] = __builtin_bit_cast(float, rw.y & 0xffff0000u);
                v[4] = __builtin_bit_cast(float, rw.z << 16); v[5] = __builtin_bit_cast(float, rw.z & 0xffff0000u); v[6] = __builtin_bit_cast(float, rw.w << 16); v[7] = __builtin_bit_cast(float, rw.w & 0xffff0000u);
                float ss = 0.f;
#pragma unroll
                for (int j = 0; j < 8; ++j) ss += v[j] * v[j];
                ss += __shfl_xor(ss, 1); ss += __shfl_xor(ss, 2); ss += __shfl_xor(ss, 4);
                const float r = 1.0f / sqrtf(ss * (1.f / 64.f) + EPS);
                float y[8];
#pragma unroll
                for (int j = 0; j < 8; ++j) y[j] = v[j] * r * (isk ? wk[j] : wq[j]);
#pragma unroll
                for (int j = 0; j < 8; ++j) { const float pv = __shfl_xor(y[j], 1);
                    if (sub == 0) y[j] = y[j] * cs[j] - pv * sn[j]; else if (sub == 1) y[j] = y[j] * cs[j] + pv * sn[j]; }
                v4u o; o.x = pk2(y[0], y[1]); o.y = pk2(y[2], y[3]); o.z = pk2(y[4], y[5]); o.w = pk2(y[6], y[7]);
                *(GAS v4u*)((isk ? KN : QN) + (size_t)m * 1024 + col) = o;
            }
        }
    }
}

struct AttnOrder { int vcu;
  __device__ __forceinline__ bool next(int i, int& bh, int& qb) const { if (i >= 8) return false; const int s = vcu & 7; bh = vcu; qb = (i + s) & 7; return true; } };
__device__ __forceinline__ void p3_attention(Frame& F, KA args, unsigned char* lds_generic) {
    const attn_body::bf16* QN = (const attn_body::bf16*)(F.ws + mp::qn); const attn_body::bf16* KN = (const attn_body::bf16*)(F.ws + mp::kn);
    const attn_body::bf16* U16 = (const attn_body::bf16*)(F.ws + mp::u16); attn_body::bf16* O1 = (attn_body::bf16*)(F.ws + mp::o1); attn_body::bf16* O2 = (attn_body::bf16*)(F.ws + mp::o2);
    AttnOrder S{F.vcu}; int bh, qb;
    for (int i = 0; S.next(i, bh, qb); ++i) {
        const int b = bh >> 5, h = (bh >> 2) & 7, comp = (bh >> 1) & 1, vh = bh & 1;
        attn_body::attn_unit<8>(b, 0, qb, QN + (h * 2 + comp) * 64, KN + (h * 2 + comp) * 64, U16 + UC_V + h * 128 + vh * 64, (comp ? O2 : O1) + h * 128 + vh * 64, (char*)lds_generic + RING_OFF);
    }
}

__device__ __forceinline__ void p4_ycat(Frame& F, KA args, int parts) {
    const int gw = F.vcu * NWAVES + F.wave, NGW = F.G * NWAVES, lane = F.lane;
    const bf16* U16 = (const bf16*)(F.ws + mp::u16); const bf16* YS = (const bf16*)(F.ws + mp::ys);
    const bf16* O1 = (const bf16*)(F.ws + mp::o1); const bf16* O2 = (const bf16*)(F.ws + mp::o2); bf16* YCAT = (bf16*)(F.ws + mp::ycat);
    const float* nw = (const float*)args->in[9]; const float* subw = (const float*)args->in[16];
    float lam;
    { const float* lq1 = (const float*)args->in[12]; const float* lk1 = (const float*)args->in[13]; const float* lq2 = (const float*)args->in[14]; const float* lk2 = (const float*)args->in[15];
      const float s1 = wave_sum(lq1[lane] * lk1[lane]), s2 = wave_sum(lq2[lane] * lk2[lane]); lam = expf(s1) - expf(s2) + 0.2f; }
    float w_s[2][8], w_a[8];
#pragma unroll
    for (int j = 0; j < 8; ++j) { w_s[0][j] = nw[lane * 8 + j]; w_s[1][j] = nw[512 + lane * 8 + j]; w_a[j] = subw[(lane & 15) * 8 + j] * 0.8f; }
    for (int it = 0; it < 4; ++it) { const int m0 = (F.vcu >> 5) * 2048 + it * 512 + ((F.vcu & 31) * NWAVES + F.wave) * 2;
        v4u yv[2][2], zv[2][2], av[2][2], bv[2][2];
#pragma unroll
        for (int rr = 0; rr < 2; ++rr) { const size_t m = (size_t)(m0 + rr);
#pragma unroll
            for (int sl = 0; sl < 2; ++sl) {
                if (parts & 1) { yv[rr][sl] = __builtin_nontemporal_load((const GAS v4u*)(YS + m * 1024 + 512 * sl + lane * 8)); zv[rr][sl] = __builtin_nontemporal_load((const GAS v4u*)(U16 + m * NIN + UC_Z + 512 * sl + lane * 8)); }
                if (parts & 2) { av[rr][sl] = __builtin_nontemporal_load((const GAS v4u*)(O1 + m * 1024 + 512 * sl + lane * 8)); bv[rr][sl] = __builtin_nontemporal_load((const GAS v4u*)(O2 + m * 1024 + 512 * sl + lane * 8)); } } }
#pragma unroll
        for (int rr = 0; rr < 2; ++rr) { const size_t m = (size_t)(m0 + rr);
#pragma unroll
        for (int sl = 0; sl < 2; ++sl) {
        if (parts & 1) {
            const v4u y0 = yv[rr][sl], z0 = zv[rr][sl];
            const unsigned yy[4] = {y0.x, y0.y, y0.z, y0.w}, zz[4] = {z0.x, z0.y, z0.z, z0.w};
            float v[8]; float ss = 0.f;
#pragma unroll
            for (int j = 0; j < 4; ++j) { const float ya = __builtin_bit_cast(float, yy[j] << 16), yb = __builtin_bit_cast(float, yy[j] & 0xffff0000u), za = __builtin_bit_cast(float, zz[j] << 16), zb = __builtin_bit_cast(float, zz[j] & 0xffff0000u);
                v[2 * j] = ya * za / (1.f + __expf(-za)); v[2 * j + 1] = yb * zb / (1.f + __expf(-zb)); ss += v[2 * j] * v[2 * j] + v[2 * j + 1] * v[2 * j + 1]; }
            ss = wave_sum(ss);
            const float r = 1.0f / sqrtf(ss * (1.f / 512.f) + EPS);
            v4u o0; o0.x = pk2(v[0] * r * w_s[sl][0], v[1] * r * w_s[sl][1]); o0.y = pk2(v[2] * r * w_s[sl][2], v[3] * r * w_s[sl][3]); o0.z = pk2(v[4] * r * w_s[sl][4], v[5] * r * w_s[sl][5]); o0.w = pk2(v[6] * r * w_s[sl][6], v[7] * r * w_s[sl][7]);
            *(GAS v4u*)(YCAT + m * DM + 512 * sl + lane * 8) = o0;
        }
        if (parts & 2) {
            const v4u a0 = av[rr][sl], b0 = bv[rr][sl];
            const unsigned aa[4] = {a0.x, a0.y, a0.z, a0.w}, bb[4] = {b0.x, b0.y, b0.z, b0.w};
            float v[8]; float ss = 0.f;
#pragma unroll
            for (int j = 0; j < 4; ++j) { v[2 * j] = __builtin_bit_cast(float, aa[j] << 16) - lam * __builtin_bit_cast(float, bb[j] << 16); v[2 * j + 1] = __builtin_bit_cast(float, aa[j] & 0xffff0000u) - lam * __builtin_bit_cast(float, bb[j] & 0xffff0000u);
                ss += v[2 * j] * v[2 * j] + v[2 * j + 1] * v[2 * j + 1]; }
            ss += __shfl_xor(ss, 1); ss += __shfl_xor(ss, 2); ss += __shfl_xor(ss, 4); ss += __shfl_xor(ss, 8);
            const float r = 1.0f / sqrtf(ss * (1.f / 128.f) + EPS);
            v4u o0; o0.x = pk2(v[0] * r * w_a[0], v[1] * r * w_a[1]); o0.y = pk2(v[2] * r * w_a[2], v[3] * r * w_a[3]); o0.z = pk2(v[4] * r * w_a[4], v[5] * r * w_a[5]); o0.w = pk2(v[6] * r * w_a[6], v[7] * r * w_a[7]);
            *(GAS v4u*)(YCAT + m * DM + 1024 + 512 * sl + lane * 8) = o0;
        }
        }
        }
    }
}

constexpr int CONV_R = 8;
__device__ __forceinline__ void p2_conv(Frame& F, KA args) {
    const int gw = F.vcu * NWAVES + F.wave, NGW = F.G * NWAVES, lane = F.lane;
    const bf16* U16 = (const bf16*)(F.ws + mp::u16); bf16* XBC = (bf16*)(F.ws + mp::xbc);
    const float* cw = (const float*)args->in[4]; const float* cb = (const float*)args->in[5];
    for (int it = 0; it < 3; ++it) { const int task = (F.vcu & 31) * NWAVES + F.wave + 256 * it;
        const int cblk = task % 3, r0 = (F.vcu >> 5) * 2048 + (task / 3) * CONV_R, c0 = cblk * 512 + lane * 8;
        const bool seq_start = (r0 % SEQ) == 0;
        v4u raw[CONV_R + 3];
#pragma unroll
        for (int j = 0; j < CONV_R + 3; ++j) { raw[j] = (v4u){0u, 0u, 0u, 0u}; if (j >= 3 || !seq_start) raw[j] = __builtin_nontemporal_load((const GAS v4u*)(U16 + (size_t)(r0 - 3 + j) * NIN + UC_XBC + c0)); }
        float w[4][8], bias[8];
#pragma unroll
        for (int j = 0; j < 4; ++j)
#pragma unroll
            for (int i = 0; i < 8; ++i) w[j][i] = cw[j * 1536 + c0 + i];
#pragma unroll
        for (int i = 0; i < 8; ++i) bias[i] = cb[c0 + i];
#pragma unroll
        for (int t = 0; t < CONV_R; ++t) {
            float o[8];
#pragma unroll
            for (int i = 0; i < 8; ++i) o[i] = bias[i];
#pragma unroll
            for (int j = 0; j < 4; ++j) { const v4u rw = raw[t + j];
                const float e[8] = {__builtin_bit_cast(float, rw.x << 16), __builtin_bit_cast(float, rw.x & 0xffff0000u), __builtin_bit_cast(float, rw.y << 16), __builtin_bit_cast(float, rw.y & 0xffff0000u),
                                    __builtin_bit_cast(float, rw.z << 16), __builtin_bit_cast(float, rw.z & 0xffff0000u), __builtin_bit_cast(float, rw.w << 16), __builtin_bit_cast(float, rw.w & 0xffff0000u)};
#pragma unroll
                for (int i = 0; i < 8; ++i) o[i] += w[j][i] * e[i]; }
#pragma unroll
            for (int i = 0; i < 8; ++i) o[i] = o[i] / (1.f + __expf(-o[i]));
            v4u ov; ov.x = pk2(o[0], o[1]); ov.y = pk2(o[2], o[3]); ov.z = pk2(o[4], o[5]); ov.w = pk2(o[6], o[7]);
            *(GAS v4u*)(XBC + (size_t)(r0 + t) * 1536 + c0) = ov;
        }
    }
}

namespace ssd {
constexpr int BCS = 2064;
constexpr int LB = 0, LC = LB + 16 * BCS, LX = LC + 16 * BCS, LXW = LX + 8192, LST = LXW + 8192, STB = 8704, LA = LST + 2 * STB, LSL = LA + 4096, SSD_LDS_END = LSL + 10 * 4096;
static_assert(SSD_LDS_END <= LDSCTL_OFF, "SSD tiles vs LDS control words");
typedef float f32x16 __attribute__((ext_vector_type(16)));
#define SSD_PIN8(a) asm volatile("" : "+v"(a[0]), "+v"(a[1]), "+v"(a[2]), "+v"(a[3]), "+v"(a[4]), "+v"(a[5]), "+v"(a[6]), "+v"(a[7]))
#define SSD_PIN4(a) asm volatile("" : "+v"(a[0]), "+v"(a[1]), "+v"(a[2]), "+v"(a[3]))
struct Ctx { LAS unsigned char* lds; const LAS float* a2; const LAS float* dtl; const LAS float* fsl; int lane, r32, hi; };
__device__ __forceinline__ void load_cf(const Ctx& c, int lb, bf16x8 (&cf)[8]) {
#pragma unroll
    for (int ks = 0; ks < 8; ++ks) cf[ks] = *(const LAS bf16x8*)(c.lds + LC + (2 * ks + c.hi) * BCS + (32 * lb + c.r32) * 16);
    SSD_PIN8(cf);
}
template <bool DIAG> __device__ __forceinline__ void intra(const Ctx& c, int lb, int st, const bf16x8 (&cf)[8], f32x16& y) {
    bf16x8 bq[8];
#pragma unroll
    for (int ks = 0; ks < 8; ++ks) bq[ks] = *(const LAS bf16x8*)(c.lds + LB + (2 * ks + c.hi) * BCS + (32 * st + c.r32) * 16);
    f32x4 av[4], dv[4];
#pragma unroll
    for (int q = 0; q < 4; ++q) { av[q] = *(const LAS f32x4*)((DIAG ? c.a2 : c.fsl) + 32 * st + 8 * q + 4 * c.hi); if (DIAG) dv[q] = *(const LAS f32x4*)(c.dtl + 32 * st + 8 * q + 4 * c.hi); }
    const float al = c.a2[32 * lb + c.r32], aref = c.a2[32 * st + 31];
    SSD_PIN8(bq); SSD_PIN4(av); if (DIAG) SSD_PIN4(dv);
    f32x16 p;
#pragma unroll
    for (int r = 0; r < 16; ++r) p[r] = 0.f;
#pragma unroll
    for (int ks = 0; ks < 8; ++ks) p = __builtin_amdgcn_mfma_f32_32x32x16_bf16(bq[ks], cf[ks], p, 0, 0, 0);
    if (DIAG) {
        float e[16];
#pragma unroll
        for (int r = 0; r < 16; ++r) e[r] = __builtin_amdgcn_exp2f(fminf(al - av[r >> 2][r & 3], 0.f));
#pragma unroll
        for (int r = 0; r < 16; ++r) { const int sl = attn_body::crow(r, c.hi); const float v = p[r] * e[r] * dv[r >> 2][r & 3]; p[r] = sl > c.r32 ? 0.f : v; }
    } else {
        const float el = __builtin_amdgcn_exp2f(al - aref);
#pragma unroll
        for (int r = 0; r < 16; ++r) p[r] *= el * av[r >> 2][r & 3];
    }
    v4u pw0, pw1;
    pw0.x = attn_body::cvtpk_s(p[0], p[1]); pw0.y = attn_body::cvtpk_s(p[2], p[3]); pw0.z = attn_body::cvtpk_s(p[4], p[5]); pw0.w = attn_body::cvtpk_s(p[6], p[7]);
    pw1.x = attn_body::cvtpk_s(p[8], p[9]); pw1.y = attn_body::cvtpk_s(p[10], p[11]); pw1.z = attn_body::cvtpk_s(p[12], p[13]); pw1.w = attn_body::cvtpk_s(p[14], p[15]);
    const LAS unsigned char* xb = c.lds + LX + ((c.lane >> 4) & 1) * 32 + (c.lane & 3) * 8 + (4 * c.hi + ((c.lane & 15) >> 2)) * 64 + (32 * st) * 64;
    const attn_body::s16x4 lo0 = attn_body::vtr((attn_body::lds_cptr)(xb)), hh0 = attn_body::vtr((attn_body::lds_cptr)(xb + 512));
    const attn_body::s16x4 lo1 = attn_body::vtr((attn_body::lds_cptr)(xb + 1024)), hh1 = attn_body::vtr((attn_body::lds_cptr)(xb + 1024 + 512));
    y = __builtin_amdgcn_mfma_f32_32x32x16_bf16(__builtin_bit_cast(bf16x8, pw0), (bf16x8){lo0[0], lo0[1], lo0[2], lo0[3], hh0[0], hh0[1], hh0[2], hh0[3]}, y, 0, 0, 0);
    y = __builtin_amdgcn_mfma_f32_32x32x16_bf16(__builtin_bit_cast(bf16x8, pw1), (bf16x8){lo1[0], lo1[1], lo1[2], lo1[3], hh1[0], hh1[1], hh1[2], hh1[3]}, y, 0, 0, 0);
}
__device__ __forceinline__ void yoff(const Ctx& c, int lb, int sbuf, f32x16& y) {
    bf16x8 cf[8], sf[8]; f32x4 av[4];
    load_cf(c, lb, cf);
#pragma unroll
    for (int ks = 0; ks < 8; ++ks) sf[ks] = *(const LAS bf16x8*)(c.lds + LST + sbuf * STB + c.r32 * 272 + (16 * ks + 8 * c.hi) * 2);
#pragma unroll
    for (int q = 0; q < 4; ++q) av[q] = *(const LAS f32x4*)(c.a2 + 32 * lb + 8 * q + 4 * c.hi);
    SSD_PIN8(cf); SSD_PIN8(sf); SSD_PIN4(av);
#pragma unroll
    for (int r = 0; r < 16; ++r) y[r] = 0.f;
#pragma unroll
    for (int ks = 0; ks < 8; ++ks) y = __builtin_amdgcn_mfma_f32_32x32x16_bf16(cf[ks], sf[ks], y, 0, 0, 0);
#pragma unroll
    for (int r = 0; r < 16; ++r) y[r] *= __builtin_amdgcn_exp2f(av[r >> 2][r & 3]);
}
__device__ __forceinline__ void state_item(const Ctx& c, int nt, int nbuf, f32x16& st) {
    const int i16 = c.lane & 15, g1 = (c.lane >> 4) & 1;
    const float dall = __builtin_amdgcn_exp2f(c.a2[127]);
#pragma unroll
    for (int r = 0; r < 16; ++r) st[r] *= dall;
    const LAS unsigned char* ab = c.lds + LB + (4 * nt + 2 * g1 + ((i16 & 3) >> 1)) * BCS + (8 * c.hi + (i16 >> 2)) * 16 + (i16 & 1) * 8;
    const LAS unsigned char* wb = c.lds + LXW + (8 * c.hi + (i16 >> 2)) * 64 + g1 * 32 + (i16 & 3) * 8;
#pragma unroll
    for (int kb = 0; kb < 2; ++kb) {
        bf16x8 af[4], wf[4];
#pragma unroll
        for (int kk = 0; kk < 4; ++kk) { const int ks = kb * 4 + kk;
            const attn_body::s16x4 a0 = attn_body::vtr((attn_body::lds_cptr)(ab + ks * 256)), a1 = attn_body::vtr((attn_body::lds_cptr)(ab + ks * 256 + 64));
            const attn_body::s16x4 w0 = attn_body::vtr((attn_body::lds_cptr)(wb + ks * 1024)), w1 = attn_body::vtr((attn_body::lds_cptr)(wb + ks * 1024 + 256));
            af[kk] = (bf16x8){a0[0], a0[1], a0[2], a0[3], a1[0], a1[1], a1[2], a1[3]}; wf[kk] = (bf16x8){w0[0], w0[1], w0[2], w0[3], w1[0], w1[1], w1[2], w1[3]}; }
        SSD_PIN4(af); SSD_PIN4(wf);
#pragma unroll
        for (int kk = 0; kk < 4; ++kk) st = __builtin_amdgcn_mfma_f32_32x32x16_bf16(af[kk], wf[kk], st, 0, 0, 0);
    }
#pragma unroll
    for (int q = 0; q < 4; ++q) { v2u w; w.x = attn_body::cvtpk_s(st[4 * q], st[4 * q + 1]); w.y = attn_body::cvtpk_s(st[4 * q + 2], st[4 * q + 3]);
        *(LAS v2u*)(c.lds + LST + nbuf * STB + c.r32 * 272 + (32 * nt + 8 * q + 4 * c.hi) * 2) = w; }
}
__device__ __forceinline__ void put_slot(const Ctx& c, int slot, const f32x16& y) {
    LAS float* sp = (LAS float*)(c.lds + LSL + slot * 4096);
#pragma unroll
    for (int r = 0; r < 16; ++r) sp[attn_body::crow(r, c.hi) * 32 + c.r32] = y[r];
}
__device__ __forceinline__ void unit(Frame& F, KA args, int u) {
    const int tid = F.tid, lane = F.lane, wave = F.wave, r32 = lane & 31, hi = lane >> 5;
    const int b = u >> 5, h = (u >> 1) & 15, ph = u & 1, g = h >> 3;
    const bf16* XBC = (const bf16*)(F.ws + mp::xbc); const float* DTR = (const float*)(F.ws + mp::dt); bf16* YS = (bf16*)(F.ws + mp::ys);
    const float dtb = ((const float*)args->in[6])[h], Ah = -expf(((const float*)args->in[7])[h]) * 1.44269504089f, Dk = ((const float*)args->in[8])[h];
    LAS unsigned char* lds = F.lds + RING_OFF;
    const size_t mbase = (size_t)b * SEQ;
    const int brow = tid >> 4, bchk = tid & 15;
    const int xrow = tid >> 2, xpc = tid & 3;
    v4u Breg[4], Creg[4], xreg;
#define SSD_LOAD_REGS(k_) do { const size_t m0_ = mbase + (size_t)(k_) * 128; \
        _Pragma("unroll") for (int i = 0; i < 4; ++i) { Breg[i] = *(const GAS v4u*)(XBC + (m0_ + brow + 32 * i) * 1536 + 1024 + g * 128 + bchk * 8); Creg[i] = *(const GAS v4u*)(XBC + (m0_ + brow + 32 * i) * 1536 + 1280 + g * 128 + bchk * 8); } \
        xreg = *(const GAS v4u*)(XBC + (m0_ + xrow) * 1536 + h * 64 + ph * 32 + xpc * 8); } while (0)
    float dtr0 = 0.f, dtr1 = 0.f;
#define SSD_LOAD_DT(k_) do { const size_t m0_ = mbase + (size_t)(k_) * 128; dtr0 = DTR[(m0_ + 2 * lane) * 16 + h]; dtr1 = DTR[(m0_ + 2 * lane + 1) * 16 + h]; } while (0)
#define SSD_PREP_A(buf_) do { \
        const float r0 = dtr0 + dtb, r1 = dtr1 + dtb; \
        const float d0 = r0 > 20.f ? r0 : log1pf(expf(r0)), d1 = r1 > 20.f ? r1 : log1pf(expf(r1)); \
        const float v0 = d0 * Ah, v1 = d1 * Ah; float s_ = v0 + v1; \
        _Pragma("unroll") for (int o = 1; o < 64; o <<= 1) { const float t = __shfl_up(s_, o); if (lane >= o) s_ += t; } \
        LAS float* a2w = (LAS float*)(lds + LA + (buf_) * 2048); LAS float* dtw = a2w + 128; LAS float* fw = a2w + 256; \
        const float aref_ = __shfl(s_, (lane & 48) | 15); \
        a2w[2 * lane] = s_ - v1; a2w[2 * lane + 1] = s_; dtw[2 * lane] = d0; dtw[2 * lane + 1] = d1; \
        fw[2 * lane] = __builtin_amdgcn_exp2f(aref_ - (s_ - v1)) * d0; fw[2 * lane + 1] = __builtin_amdgcn_exp2f(aref_ - s_) * d1; } while (0)
    f32x16 stA, stB;
#pragma unroll
    for (int r = 0; r < 16; ++r) { stA[r] = 0.f; stB[r] = 0.f; }
    SSD_LOAD_REGS(0);
    if (wave == 1) { SSD_LOAD_DT(0); SSD_PREP_A(0); }
    LDS_WAIT(); __syncthreads();
#pragma nounroll
    for (int k = 0; k < 16; ++k) {
        const int buf = k & 1, nb = buf ^ 1; const size_t m0 = mbase + (size_t)k * 128;
        Ctx c; c.lds = lds; c.a2 = (const LAS float*)(lds + LA + buf * 2048); c.dtl = c.a2 + 128; c.fsl = c.a2 + 256; c.lane = lane; c.r32 = r32; c.hi = hi;
#pragma unroll
        for (int i = 0; i < 4; ++i) { *(LAS v4u*)(lds + LB + bchk * BCS + (brow + 32 * i) * 16) = Breg[i]; *(LAS v4u*)(lds + LC + bchk * BCS + (brow + 32 * i) * 16) = Creg[i]; }
        *(LAS v4u*)(lds + LX + xrow * 64 + xpc * 16) = xreg;
        { const float wsc = __builtin_amdgcn_exp2f(c.a2[127] - c.a2[xrow]) * c.dtl[xrow];
          const float x0 = __builtin_bit_cast(float, xreg.x << 16) * wsc, x1 = __builtin_bit_cast(float, xreg.x & 0xffff0000u) * wsc, x2 = __builtin_bit_cast(float, xreg.y << 16) * wsc, x3 = __builtin_bit_cast(float, xreg.y & 0xffff0000u) * wsc;
          const float x4 = __builtin_bit_cast(float, xreg.z << 16) * wsc, x5 = __builtin_bit_cast(float, xreg.z & 0xffff0000u) * wsc, x6 = __builtin_bit_cast(float, xreg.w << 16) * wsc, x7 = __builtin_bit_cast(float, xreg.w & 0xffff0000u) * wsc;
          v4u xw; xw.x = pk2(x0, x1); xw.y = pk2(x2, x3); xw.z = pk2(x4, x5); xw.w = pk2(x6, x7);
          *(LAS v4u*)(lds + LXW + xrow * 64 + xpc * 16) = xw; }
        LDS_WAIT(); __syncthreads();
        if (k < 15) { SSD_LOAD_REGS(k + 1); if (wave == 1) SSD_LOAD_DT(k + 1); }
        {
            f32x16 y; bf16x8 cf[8];
#pragma unroll
            for (int r = 0; r < 16; ++r) y[r] = 0.f;
            if (wave == 0)      { load_cf(c, 3, cf); intra<true>(c, 3, 3, cf, y); intra<false>(c, 3, 2, cf, y); put_slot(c, 0, y); }
            else if (wave == 1) { load_cf(c, 3, cf); intra<false>(c, 3, 1, cf, y); intra<false>(c, 3, 0, cf, y); put_slot(c, 1, y); if (k < 15) SSD_PREP_A(nb); }
            else if (wave == 2) { load_cf(c, 2, cf); intra<true>(c, 2, 2, cf, y); intra<false>(c, 2, 1, cf, y); put_slot(c, 3, y); }
            else if (wave == 3) { load_cf(c, 2, cf); intra<false>(c, 2, 0, cf, y); put_slot(c, 4, y);
#pragma unroll
                                  for (int r = 0; r < 16; ++r) y[r] = 0.f;
                                  load_cf(c, 0, cf); intra<true>(c, 0, 0, cf, y); put_slot(c, 8, y); }
            else if (wave == 4) { load_cf(c, 1, cf); intra<true>(c, 1, 1, cf, y); intra<false>(c, 1, 0, cf, y); put_slot(c, 6, y); }
            else if (wave == 5) { if (k > 0) { yoff(c, 3, buf, y); put_slot(c, 2, y); yoff(c, 2, buf, y); put_slot(c, 5, y); yoff(c, 1, buf, y); put_slot(c, 7, y); yoff(c, 0, buf, y); put_slot(c, 9, y); } }
            else if (wave == 6) { state_item(c, 0, nb, stA); state_item(c, 1, nb, stB); }
            else                { state_item(c, 2, nb, stA); state_item(c, 3, nb, stB); }
        }
        LDS_WAIT(); __syncthreads();
        { const int row = tid >> 2, pc = tid & 3, lb = wave >> 1, rl = row & 31;
          const int s0 = lb == 3 ? 0 : (lb == 2 ? 3 : (lb == 1 ? 6 : 8)), s1 = lb == 3 ? 1 : (lb == 2 ? 4 : -1), so = lb == 3 ? 2 : (lb == 2 ? 5 : (lb == 1 ? 7 : 9));
          const LAS float* p0 = (const LAS float*)(lds + LSL + s0 * 4096) + rl * 32 + pc * 8;
          f32x4 ya = *(const LAS f32x4*)p0, yb = *(const LAS f32x4*)(p0 + 4);
          if (s1 >= 0) { const LAS float* p1 = (const LAS float*)(lds + LSL + s1 * 4096) + rl * 32 + pc * 8; ya += *(const LAS f32x4*)p1; yb += *(const LAS f32x4*)(p1 + 4); }
          if (k > 0) { const LAS float* p2 = (const LAS float*)(lds + LSL + so * 4096) + rl * 32 + pc * 8; ya += *(const LAS f32x4*)p2; yb += *(const LAS f32x4*)(p2 + 4); }
          const v4u xv = *(const LAS v4u*)(lds + LX + row * 64 + pc * 16);
          v4u o; o.x = pk2(ya.x + Dk * __builtin_bit_cast(float, xv.x << 16), ya.y + Dk * __builtin_bit_cast(float, xv.x & 0xffff0000u)); o.y = pk2(ya.z + Dk * __builtin_bit_cast(float, xv.y << 16), ya.w + Dk * __builtin_bit_cast(float, xv.y & 0xffff0000u));
          o.z = pk2(yb.x + Dk * __builtin_bit_cast(float, xv.z << 16), yb.y + Dk * __builtin_bit_cast(float, xv.z & 0xffff0000u)); o.w = pk2(yb.z + Dk * __builtin_bit_cast(float, xv.w << 16), yb.w + Dk * __builtin_bit_cast(float, xv.w & 0xffff0000u));
          *(GAS v4u*)(YS + (m0 + row) * 1024 + h * 64 + ph * 32 + pc * 8) = o; }
    }
    LDS_WAIT(); __syncthreads();
#undef SSD_LOAD_REGS
#undef SSD_LOAD_DT
#undef SSD_PREP_A
}
#undef SSD_PIN8
#undef SSD_PIN4
}
__device__ __forceinline__ void p3_ssd(Frame& F, KA args) {
    for (int u = F.vcu; u < 256; u += F.G) ssd::unit(F, args, u);
}

__device__ __forceinline__ void p0_small(Frame& F, KA args) {
    const int gt = (F.vcu * NWAVES + F.wave) * 64 + F.lane, NGT = F.G * NWAVES * 64;
    const float* ln2 = (const float*)args->in[18]; const float* wrg = (const float*)args->in[19]; const float* wre = (const float*)args->in[21];
    bf16* WRH = (bf16*)(F.ws + mp::wr); bf16* WRL = WRH + 48 * DM;
    for (int i = gt; i < 48 * DM; i += NGT) { const int c = i / DM, k = i % DM;
        const float w = (c < 4 ? wrg[k * 4 + c] : (c < 36 ? wre[k * 32 + (c - 4)] : 0.f)) * ln2[k];
        const unsigned hi = f2bf(w); const float lo = w - bf2f((unsigned short)hi);
        WRH[i] = (bf16)hi; WRL[i] = (bf16)f2bf(lo); }
    { GAS v4u* z = (GAS v4u*)((bf16*)(F.ws + mp::win) + (size_t)(NIN + 16) * DM);
      for (int i = gt; i < (NIN_G - NIN - 16) * DM / 8; i += NGT) z[i] = (v4u){0u, 0u, 0u, 0u}; }
}

__device__ __forceinline__ void p5_route(Frame& F, KA args) {
    const int lane = F.lane;
    const bf16* h = (const bf16*)(F.ws + mp::xn2);
    const bf16* WRH = (const bf16*)(F.ws + mp::wr); const bf16* WRL = WRH + 48 * DM;
    const float* brg = (const float*)args->in[20]; const float* bre = (const float*)args->in[22];
    int* tok_e = (int*)(F.ws + mp::small + SM_TOK_E); int* tok_pos = (int*)(F.ws + mp::small + SM_TOK_POS); float* tok_w = (float*)(F.ws + mp::small + SM_TOK_W);
    int* lst_tok = (int*)(F.ws + mp::lst); float* lst_w = (float*)(F.ws + mp::lst) + NE * LCAP; float* lst_r = lst_w + NE * LCAP;
    unsigned* cnt = (unsigned*)(F.ctl + CW_CNT);
    LAS float* lg = (LAS float*)(F.lds + RING_OFF + F.wave * 4096);
    constexpr int KQ = 512, WQB = 2 * 48 * KQ * 2;
    LAS unsigned char* wq = F.lds + RING_OFF + 32768;
    for (int wt = F.vcu; wt < M / 64; wt += F.G) {
        const int rt = F.wave & 3, kh = F.wave >> 2, task = wt * 4 + rt;
        const bf16* hr = h + (size_t)(task * 16 + (lane & 15)) * DM + (lane >> 4) * 8;
        f32x4 acc0 = (f32x4){0.f, 0.f, 0.f, 0.f}, acc1 = acc0, acc2 = acc0; float ss = 0.f;
        for (int q = 0; q < DM / KQ; ++q) {
            __syncthreads();
#pragma unroll
            for (int i = 0; i < 12; ++i) { const int pc = F.tid + 512 * i, row = pc >> 6, c16 = pc & 63;
                const v4u v = *(const GAS v4u*)((row < 48 ? WRH + (size_t)row * DM : WRL + (size_t)(row - 48) * DM) + q * KQ + c16 * 8);
                *(LAS v4u*)(wq + row * 1040 + c16 * 16) = v; }
            LDS_WAIT(); __syncthreads();
#pragma unroll 4
            for (int k8 = 0; k8 < 8; ++k8) {
                const int kt = kh * 8 + k8;
                const v4u hv = *(const GAS v4u*)(hr + q * KQ + kt * 32);
                { const float e0 = __builtin_bit_cast(float, hv.x << 16), e1 = __builtin_bit_cast(float, hv.x & 0xffff0000u), e2 = __builtin_bit_cast(float, hv.y << 16), e3 = __builtin_bit_cast(float, hv.y & 0xffff0000u);
                  const float e4 = __builtin_bit_cast(float, hv.z << 16), e5 = __builtin_bit_cast(float, hv.z & 0xffff0000u), e6 = __builtin_bit_cast(float, hv.w << 16), e7 = __builtin_bit_cast(float, hv.w & 0xffff0000u);
                  ss += (e0 * e0 + e1 * e1) + (e2 * e2 + e3 * e3) + (e4 * e4 + e5 * e5) + (e6 * e6 + e7 * e7); }
                const bf16x8 ah = __builtin_bit_cast(bf16x8, hv);
                const LAS unsigned char* bp = wq + (lane & 15) * 1040 + kt * 64 + (lane >> 4) * 16;
                { const bf16x8 b_h = *(const LAS bf16x8*)(bp), b_l = *(const LAS bf16x8*)(bp + 48 * 1040);
                  acc0 = __builtin_amdgcn_mfma_f32_16x16x32_bf16(ah, b_h, acc0, 0, 0, 0); acc0 = __builtin_amdgcn_mfma_f32_16x16x32_bf16(ah, b_l, acc0, 0, 0, 0); }
                { const bf16x8 b_h = *(const LAS bf16x8*)(bp + 16 * 1040), b_l = *(const LAS bf16x8*)(bp + 64 * 1040);
                  acc1 = __builtin_amdgcn_mfma_f32_16x16x32_bf16(ah, b_h, acc1, 0, 0, 0); acc1 = __builtin_amdgcn_mfma_f32_16x16x32_bf16(ah, b_l, acc1, 0, 0, 0); }
                { const bf16x8 b_h = *(const LAS bf16x8*)(bp + 32 * 1040), b_l = *(const LAS bf16x8*)(bp + 80 * 1040);
                  acc2 = __builtin_amdgcn_mfma_f32_16x16x32_bf16(ah, b_h, acc2, 0, 0, 0); acc2 = __builtin_amdgcn_mfma_f32_16x16x32_bf16(ah, b_l, acc2, 0, 0, 0); }
            }
        }
        __syncthreads();
        LAS float* xp = (LAS float*)(F.lds + RING_OFF + 32768 + rt * 4096) + lane * 13;
        if (kh == 1) {
#pragma unroll
            for (int q = 0; q < 4; ++q) { xp[q] = acc0[q]; xp[4 + q] = acc1[q]; xp[8 + q] = acc2[q]; }
            xp[12] = ss; }
        LDS_WAIT(); __syncthreads();
        if (kh == 0) {
#pragma unroll
        for (int q = 0; q < 4; ++q) { acc0[q] += xp[q]; acc1[q] += xp[4 + q]; acc2[q] += xp[8 + q]; }
        ss += xp[12];
        ss += __shfl_xor(ss, 16); ss += __shfl_xor(ss, 32);
        const float r = 1.0f / sqrtf(ss * (1.f / DM) + EPS);
#pragma unroll
        for (int reg = 0; reg < 4; ++reg) { const int row = (lane >> 4) * 4 + reg; const float rr = __shfl(r, row);
            lg[row * 48 + (lane & 15)] = acc0[reg] * rr; lg[row * 48 + 16 + (lane & 15)] = acc1[reg] * rr; lg[row * 48 + 32 + (lane & 15)] = acc2[reg] * rr; }
        LDS_WAIT(); asm volatile("" ::: "memory");
        if (lane < 16) {
            const LAS float* L = lg + lane * 48; const int tok = task * 16 + lane;
            float gl[4];
#pragma unroll
            for (int j = 0; j < 4; ++j) gl[j] = L[j] + brg[j];
            int gs = 0; float gm = gl[0];
#pragma unroll
            for (int j = 1; j < 4; ++j) if (gl[j] > gm) { gm = gl[j]; gs = j; }
            float gsum = 0.f;
#pragma unroll
            for (int j = 0; j < 4; ++j) gsum += expf(gl[j] - gm);
            const float gwt = 1.f / gsum;
            float el[8];
#pragma unroll
            for (int j = 0; j < 8; ++j) el[j] = L[4 + gs * 8 + j] + bre[gs * 8 + j];
            int i1 = 0; float m1 = el[0];
#pragma unroll
            for (int j = 1; j < 8; ++j) if (el[j] > m1) { m1 = el[j]; i1 = j; }
            int i2 = 0; float m2 = -INFINITY;
#pragma unroll
            for (int j = 0; j < 8; ++j) if (j != i1 && el[j] > m2) { m2 = el[j]; i2 = j; }
            const float e2 = expf(m2 - m1); const float w1 = gwt / (1.f + e2), w2 = gwt * e2 / (1.f + e2);
            const int ea = gs * 8 + i1, eb = gs * 8 + i2;
            tok_e[tok * 2] = ea; tok_e[tok * 2 + 1] = eb; tok_w[tok * 2] = w1; tok_w[tok * 2 + 1] = w2;
            const int pa = (int)__hip_atomic_fetch_add(cnt + ea, 1u, RLX_AGENT), pb = (int)__hip_atomic_fetch_add(cnt + eb, 1u, RLX_AGENT);
            tok_pos[tok * 2] = pa; tok_pos[tok * 2 + 1] = pb;
            lst_tok[ea * LCAP + pa] = tok; lst_w[ea * LCAP + pa] = w1; lst_r[ea * LCAP + pa] = r; lst_tok[eb * LCAP + pb] = tok; lst_w[eb * LCAP + pb] = w2; lst_r[eb * LCAP + pb] = r;
        }
        }
        LDS_WAIT(); __syncthreads();
    }
}

__device__ __forceinline__ void build_tab(Frame& F, KA args) {
    LAS int* tab = (LAS int*)(F.lds + TAB_OFF);
    if (F.wave == 0) {
        const int lane = F.lane, e = lane & 31; unsigned* cnt = (unsigned*)(F.ctl + CW_CNT);
        const int c = (int)__hip_atomic_load(cnt + e, RLX_AGENT), mt = (c + 255) >> 8;
        int sc = mt;
#pragma unroll
        for (int o = 1; o < 32; o <<= 1) { const int t = __shfl_up(sc, o); if (e >= o) sc += t; }
        if (lane < 32) { tab[e] = (sc - mt) * 8; tab[40 + e] = sc - mt; tab[80 + e] = c; }
        if (lane == 31) { tab[32] = sc * 8; tab[72] = sc; }
    }
    LDS_WAIT(); __syncthreads();
}

__device__ __forceinline__ void p8_combine(Frame& F, KA args) {
    const int gw = F.vcu * NWAVES + F.wave, NGW = F.G * NWAVES, lane = F.lane;
    build_tab(F, args);
    const LAS int* tab = (const LAS int*)(F.lds + TAB_OFF);
    const int* tok_e = (const int*)(F.ws + mp::small + SM_TOK_E); const int* tok_pos = (const int*)(F.ws + mp::small + SM_TOK_POS); const unsigned char* Y8 = (const unsigned char*)(F.ws + mp::y); float* out = args->out;
    const bf16* HB = (const bf16*)(F.ws + mp::xn2);
    v4u hvA[2][2], avA[2], bvA[2], hvB[2][2], avB[2], bvB[2];
#define P8_LOAD(t_, hv_, av_, bv_) do { const int s0_ = tab[40 + tok_e[2 * (t_)]] * 256 + tok_pos[2 * (t_)], s1_ = tab[40 + tok_e[2 * (t_) + 1]] * 256 + tok_pos[2 * (t_) + 1]; \
        _Pragma("unroll") for (int j = 0; j < 2; ++j) { const int c0 = 16 * (lane + 64 * j); \
            hv_[j][0] = __builtin_nontemporal_load((const GAS v4u*)(HB + (size_t)(t_) * DM + c0)); hv_[j][1] = __builtin_nontemporal_load((const GAS v4u*)(HB + (size_t)(t_) * DM + c0 + 8)); \
            av_[j] = __builtin_nontemporal_load((const GAS v4u*)(Y8 + (size_t)s0_ * DM + c0)); bv_[j] = __builtin_nontemporal_load((const GAS v4u*)(Y8 + (size_t)s1_ * DM + c0)); } } while (0)
#define P8_STORE(t_, hv_, av_, bv_) do { \
        _Pragma("unroll") for (int j = 0; j < 2; ++j) { const int c0 = 16 * (lane + 64 * j); \
            const unsigned hw[8] = {hv_[j][0].x, hv_[j][0].y, hv_[j][0].z, hv_[j][0].w, hv_[j][1].x, hv_[j][1].y, hv_[j][1].z, hv_[j][1].w}; \
            const unsigned aw[4] = {av_[j].x, av_[j].y, av_[j].z, av_[j].w}, bw[4] = {bv_[j].x, bv_[j].y, bv_[j].z, bv_[j].w}; \
            _Pragma("unroll") for (int q = 0; q < 4; ++q) { \
                const f32x2_t a01 = __builtin_amdgcn_cvt_pk_f32_fp8((int)aw[q], false), a23 = __builtin_amdgcn_cvt_pk_f32_fp8((int)aw[q], true); \
                const f32x2_t b01 = __builtin_amdgcn_cvt_pk_f32_fp8((int)bw[q], false), b23 = __builtin_amdgcn_cvt_pk_f32_fp8((int)bw[q], true); \
                f32x4 v; \
                v.x = __builtin_bit_cast(float, hw[2 * q] << 16) + (a01.x + b01.x) * (1.f / Y8_SCALE); v.y = __builtin_bit_cast(float, hw[2 * q] & 0xffff0000u) + (a01.y + b01.y) * (1.f / Y8_SCALE); \
                v.z = __builtin_bit_cast(float, hw[2 * q + 1] << 16) + (a23.x + b23.x) * (1.f / Y8_SCALE); v.w = __builtin_bit_cast(float, hw[2 * q + 1] & 0xffff0000u) + (a23.y + b23.y) * (1.f / Y8_SCALE); \
                *(GAS f32x4*)(out + (size_t)(t_) * DM + c0 + 4 * q) = v; } } } while (0)
    typedef float f32x2_t __attribute__((ext_vector_type(2)));
    if (gw < M) P8_LOAD(gw, hvA, avA, bvA);
    for (int t = gw; t < M; t += 2 * NGW) {
        P8_LOAD(t + NGW, hvB, avB, bvB);
        P8_STORE(t, hvA, avA, bvA);
        if (t + 2 * NGW < M) P8_LOAD(t + 2 * NGW, hvA, avA, bvA);
        P8_STORE(t + NGW, hvB, avB, bvB);
    }
#undef P8_LOAD
#undef P8_STORE
}

constexpr int N_PHASES = 11;
#ifndef MK_REP_BAR
#define MK_REP_BAR 0
#endif
#ifndef MK_REP_PHASE
#define MK_REP_PHASE -1
#endif
#define PHASE_ARGS() ({ KA p_ = (KA)__builtin_amdgcn_kernarg_segment_ptr(); asm volatile("" : "+s"(p_)); p_; })
__global__ void __launch_bounds__(NWAVES * 64, 2) mega(Args args_byval) {
    KA args = PHASE_ARGS(); (void)args_byval;
    extern __shared__ __attribute__((aligned(16))) unsigned char lds[];
    Frame F;
    F.lds = (LAS unsigned char*)lds;
    F.MISC = (volatile LAS unsigned*)(F.lds + MISC_OFF);
    F.tid = threadIdx.x; F.lane = F.tid & 63; F.wave = __builtin_amdgcn_readfirstlane(F.tid >> 6);
    F.G = gridDim.x; { const int bx = blockIdx.x; F.vcu = (F.G % 8 == 0) ? (bx % 8) * (F.G / 8) + bx / 8 : bx; }
    F.cid = (int)blockIdx.x;
    F.ws = args->ws;
    F.ctl = (gu32*)(F.ws + mp::ctl);
    for (int u = F.tid; u < (LDS_BYTES - LDSCTL_OFF) / 4; u += NWAVES * 64) ((LAS unsigned*)(F.lds + LDSCTL_OFF))[u] = 0u;
    __syncthreads();
    const bool one_launch = (args->li < 0);
    XcdBarrier bar; bar.bar = (unsigned*)(F.ctl + CW_BAR); bar.x = 0; bar.st = nullptr;
    if (one_launch) bar = xcd_barrier_post((unsigned*)(F.ctl + CW_BAR), F.MISC + 8);
    if (one_launch && F.tid == 0) { const unsigned x_ = xb_xcc_id(); F.MISC[10] = x_; F.MISC[11] = xb_add((unsigned*)(F.ctl + CW_RANK + 64 * x_), 1u); }
    bool local_ok = false; unsigned* loc_ctr = nullptr;
    const int lo = args->ph_lo, hi = args->ph_hi;
#define IN(k) (lo <= (k) && (k) < hi)
#define SEAM(k) do { if (IN(k) && IN((k) + 1)) xcd_barrier(bar); } while (0)
#define SEAM_LOCAL(k) do { if (IN(k) && IN((k) + 1)) { if (local_ok) xcd_local_barrier(bar.bar, loc_ctr, 32u); else xcd_barrier(bar); } } while (0)

    if (IN(0)) for (int rep_ = 0; rep_ < (MK_REP_PHASE == 0 ? 2 : 1); ++rep_) { args = PHASE_ARGS(); p0_prologue(F, args); if (args->p0_mask & 8) p0_small(F, args); if (args->p0_mask & 16) p0_rope(F, args); }
    if (one_launch && IN(0) && IN(1)) {
        XbTok tok; xcd_barrier_arrive(bar, tok);
        if (F.tid == 0) { unsigned ok_ = (F.G == 256) ? 1u : 0u;
            for (unsigned j = 0; j < 16; ++j) { const unsigned c_ = xb_ld(&bar.bar[XB_XCNT(j)]); if (c_ != (j < 8 ? 32u : 0u)) ok_ = 0u; }
            F.MISC[12] = ok_; }
        __syncthreads();
        if (F.MISC[12]) { const int x_ = (int)F.MISC[10], r_ = (int)F.MISC[11]; local_ok = true; F.vcu = x_ * 32 + r_; F.cid = r_ * 8 + x_; loc_ctr = (unsigned*)(F.ctl + CW_LOC + 64 * x_); }
        args = PHASE_ARGS(); p0_xn1(F, args);
        xcd_barrier_wait(bar, tok);
        if (local_ok) xcd_local_barrier(bar.bar, loc_ctr, 32u); else xcd_barrier(bar);
    } else {
        if (IN(0)) { args = PHASE_ARGS(); p0_xn1(F, args); }
        SEAM(0);
    }
    if (IN(1)) for (int rep_ = 0; rep_ < (MK_REP_PHASE == 1 ? 2 : 1); ++rep_) { args = PHASE_ARGS();
        pg8::Gemm g{(const bf16*)(F.ws + mp::xn), (const bf16*)(F.ws + mp::win), M, NIN_G, DM};
        pg8::EpiInProj E{(bf16*)(F.ws + mp::u16), NIN, (float*)(F.ws + mp::dt)};
#if P1_HOSTS_P0B == 1
        const int c_ = F.cid, xcd_ = c_ & 7, team_ = c_ >> 6;
        const int ks = team_ < 3 ? ((xcd_ % P1_NCLASS) == 0 ? (xcd_ + 2 * team_) % 7 : 0) : xcd_ % 6;
        for (int part = 0; part < 2; ++part) {
            pg8::TeamOrder S{c_, part == 0 ? 0 : ks, part == 0 ? ks : 6};
            pg8::gemm_phase<pg8::EpiInProj, pg8::TeamOrder, PG8_ALIGN, PG8_SP2>(F.lds + RING_OFF, g, S, E);
            if (part == 0) { __syncthreads(); args = PHASE_ARGS(); p1_convert_share(F, args, 0); __syncthreads(); }
        }
#elif P1_HOSTS_P0B == 2
        pg8::StaticOrder S; S.init(M, NIN_G, F.G, (int)blockIdx.x);
        typedef pg8::ConvMoE<KA, 23, mp::wgu, mp::wd, mp::END, RING_OFF + RING_BYTES> CvJob;
        pg8::gemm_phase<pg8::EpiInProj, pg8::StaticOrder, PG8_ALIGN, PG8_SP2, false, CvJob>(F.lds + RING_OFF, g, S, E, CvJob{});
        if ((int)blockIdx.x >= P1_UNITS - 5 * F.G) { __syncthreads(); args = PHASE_ARGS(); p0b_blocks(F, args, 4 * (P1_INLOOP_BLOCKS + ((int)blockIdx.x - (P1_UNITS - 5 * F.G)) * NWAVES + F.wave), 4); }
#else
        pg8::StaticOrder S; S.init(M, NIN_G, F.G, (int)blockIdx.x);
        pg8::gemm_phase<pg8::EpiInProj, pg8::StaticOrder, PG8_ALIGN, PG8_SP2>(F.lds + RING_OFF, g, S, E);
#endif
    }
    SEAM_LOCAL(1);
    if (IN(2)) for (int rep_ = 0; rep_ < (MK_REP_PHASE == 2 ? 2 : 1); ++rep_) { if (MK_REP_BAR && rep_) xcd_barrier(bar); args = PHASE_ARGS(); p2_qknorm(F, args); p2_conv(F, args); }
    SEAM_LOCAL(2);
    if (IN(3)) for (int rep_ = 0; rep_ < (MK_REP_PHASE == 3 ? 2 : 1); ++rep_) { args = PHASE_ARGS(); if (args->p0_mask & 128) p3_ssd(F, args); p3_attention(F, args, lds);
#if P1_HOSTS_P0B == 1
        if (rep_ == 0) { __syncthreads(); args = PHASE_ARGS(); p1_convert_share(F, args, 1); }
#endif
    }
    SEAM_LOCAL(3);
    if (IN(4)) for (int rep_ = 0; rep_ < (MK_REP_PHASE == 4 ? 2 : 1); ++rep_) { args = PHASE_ARGS(); p4_ycat(F, args, (args->p0_mask >> 5) & 3); }
    SEAM_LOCAL(4);
    if (IN(5)) for (int rep_ = 0; rep_ < (MK_REP_PHASE == 5 ? 2 : 1); ++rep_) { args = PHASE_ARGS();
        pg8::Gemm g{(const bf16*)(F.ws + mp::ycat), (const bf16*)(F.ws + mp::wout), M, DM, DM}; pg8::StaticOrder S; S.init(M, DM, F.G, F.cid);
        pg8::EpiResid E{(const float*)args->in[0], (bf16*)(F.ws + mp::xn2), (unsigned char*)(F.ws + mp::xn8), DM, (const float*)args->in[18]};
        pg8::gemm_phase<pg8::EpiResid, pg8::StaticOrder, PG8_ALIGN, PG8_SP2>(F.lds + RING_OFF, g, S, E);
#if P1_HOSTS_P0B == 1
        if (rep_ == 0) { __syncthreads(); args = PHASE_ARGS(); p1_convert_share(F, args, 2); }
#endif
    }
    SEAM_LOCAL(5);
    if (IN(6)) for (int rep_ = 0; rep_ < (MK_REP_PHASE == 6 ? 2 : 1); ++rep_) { args = PHASE_ARGS(); p5_route(F, args);
#if P1_HOSTS_P0B == 1
        if (rep_ == 0) { __syncthreads(); args = PHASE_ARGS(); p1_convert_share(F, args, 3); }
#endif
    }
    SEAM(6);
    if (IN(8)) for (int rep_ = 0; rep_ < (MK_REP_PHASE == 8 ? 2 : 1); ++rep_) { args = PHASE_ARGS();
        build_tab(F, args);
        pg8::Gemm g{(const bf16*)(F.ws + mp::xn8), (const bf16*)(F.ws + mp::wgu), M, NE * 2048, DM / 2};    pg8::ExpertOrder S; S.init((const LAS int*)(F.lds + TAB_OFF), F.G, F.cid);
        pg8::ExpertRows RS{(const LAS int*)(F.lds + TAB_OFF), (const int*)(F.ws + mp::lst), LCAP};
        pg8::EpiGateUp E{(unsigned char*)(F.ws + mp::hid), EH, pg8::ExpertScale{(const LAS int*)(F.lds + TAB_OFF), (const float*)(F.ws + mp::lst) + 2 * NE * LCAP, LCAP}, 1.f / F8_WSCALE};
        pg8::gemm_phase_g<pg8::EpiGateUp, pg8::ExpertOrder, pg8::ExpertRows, PG8_ALIGN, PG8_SP2, true>(F.lds + RING_OFF, g, S, E, RS);
    }
    SEAM(8);
    if (IN(9)) for (int rep_ = 0; rep_ < (MK_REP_PHASE == 9 ? 2 : 1); ++rep_) { args = PHASE_ARGS();
        build_tab(F, args);
        pg8::Gemm g{(const bf16*)(F.ws + mp::hid), (const bf16*)(F.ws + mp::wd), SLOT_CAP, NE * 2048, EH / 2};    pg8::ExpertOrder S; S.init((const LAS int*)(F.lds + TAB_OFF), F.G, F.cid);
        pg8::EpiRowScale E{(unsigned char*)(F.ws + mp::y), DM, pg8::ExpertScale{(const LAS int*)(F.lds + TAB_OFF), (const float*)(F.ws + mp::lst) + NE * LCAP, LCAP}, Y8_SCALE / F8_WSCALE};
        pg8::gemm_phase<pg8::EpiRowScale, pg8::ExpertOrder, PG8_ALIGN, PG8_SP2, true>(F.lds + RING_OFF, g, S, E);
    }
    SEAM(9);
    if (IN(10)) for (int rep_ = 0; rep_ < (MK_REP_PHASE == 10 ? 2 : 1); ++rep_) { args = PHASE_ARGS(); p8_combine(F, args); }
#undef IN
#undef SEAM
#undef SEAM_LOCAL
}

__global__ void __launch_bounds__(256) k_u16_to_f32(const bf16* __restrict__ U16, const float* __restrict__ DT, float* __restrict__ U) {
    const size_t idx = (size_t)blockIdx.x * 256 + threadIdx.x;
    const int c = (int)(idx % IN_COLS); const size_t m = idx / IN_COLS;
    float v;
    if (c < 2560) v = bf2f(U16[m * NIN + c]); else if (c < 2576) v = DT[m * 16 + (c - 2560)]; else v = bf2f(U16[m * NIN + c - 16]);
    U[idx] = v;
}
__global__ void __launch_bounds__(256) k_f32_to_bf16(const float* __restrict__ src, bf16* __restrict__ dst) {
    const size_t i = (size_t)blockIdx.x * 256 + threadIdx.x;
    const float4 v = ((const float4*)src)[i]; v2u o; o.x = pk2(v.x, v.y); o.y = pk2(v.z, v.w); ((v2u*)dst)[i] = o;
}
__global__ void __launch_bounds__(256) k_ssdhalf_to_bf16(const float* __restrict__ YCATf, bf16* __restrict__ YCAT16) {
    const size_t i = (size_t)blockIdx.x * 256 + threadIdx.x;
    const size_t m = i >> 8; const int c4 = (int)(i & 255);
    const float4 v = ((const float4*)(YCATf + m * DM))[c4]; v2u o; o.x = pk2(v.x, v.y); o.y = pk2(v.z, v.w); ((v2u*)(YCAT16 + m * DM))[c4] = o;
}

#ifndef MK_ONE_LAUNCH
#define MK_ONE_LAUNCH 1
#endif
extern "C" void kernel_launch(void* const* d_in, const int* in_sizes, int n_in, void* d_out, int out_size, void* d_ws, size_t ws_size, hipStream_t stream) {
    static int ready = 0;
    if (!ready) {
        if (hipFuncSetAttribute((const void*)mega, hipFuncAttributeMaxDynamicSharedMemorySize, LDS_BYTES) != hipSuccess) { fprintf(stderr, "hipFuncSetAttribute failed\n"); }
        if (ws_size < mp::END) fprintf(stderr, "kernel_launch: ws_size %zu too small\n", ws_size);
        ready = 1;
    }
    (void)hipMemsetAsync(d_ws, 0, CTL_ZERO_BYTES, stream);
    Args a{};
    for (int i = 0; i < 26; ++i) a.in[i] = d_in[i];
    a.out = (float*)d_out; a.ws = (unsigned char*)d_ws;
    a.p0_mask = 1 | 2 | 4 | 8 | 16 | (3 << 5) | 128; a.rep_phase = MK_REP_PHASE;
#if MK_ONE_LAUNCH
    a.ph_lo = 0; a.ph_hi = N_PHASES; a.li = -1; hipLaunchKernelGGL(mega, dim3(256), dim3(NWAVES * 64), LDS_BYTES, stream, a);
#else
    for (int ph = 0; ph < N_PHASES; ++ph) { a.ph_lo = ph; a.ph_hi = ph + 1; a.li = ph; hipLaunchKernelGGL(mega, dim3(256), dim3(NWAVES * 64), LDS_BYTES, stream, a); }
#endif
}
```

```cpp
#include <hip/hip_runtime.h>
#include <hip/hip_bf16.h>
#include <math.h>
#include <stdint.h>
#include <cstdio>
#include <cmath>
namespace pg8 {
#define PG8_LAS __attribute__((address_space(3)))
typedef unsigned short bf16_t;
typedef short bf16x8 __attribute__((ext_vector_type(8)));
typedef float f32x4 __attribute__((ext_vector_type(4)));
typedef unsigned u32x4 __attribute__((ext_vector_type(4)));
typedef int v8i_t __attribute__((ext_vector_type(8)));
constexpr int BM = 256, BK = 64, HALF = 128, HTB = HALF * BK * 2  , STAGE_BYTES = 8 * HTB, NXCD = 8, WGM = 8;

__host__ __device__ __forceinline__ int lds_byte(int r, int c) { const int st = (r >> 4) * 2 + (c >> 5), rr = r & 15, cc = c & 31, ob = rr * 64 + cc * 2; return st * 1024 + (ob ^ (((ob >> 9) & 1) << 5)); }
__host__ __device__ __forceinline__ void stage_rc(int b, int& R, int& C) { const int st = b / 1024, sb = b % 1024, swz = sb ^ (((sb >> 9) & 1) << 5); R = (st >> 1) * 16 + swz / 64; C = (st & 1) * 32 + (swz % 64) / 2; }
__host__ __device__ __forceinline__ int perm32(int rho) { const int n = rho >> 4, i = rho & 15; return 8 * (i >> 2) + 4 * n + (i & 3); }

struct Unit { int pm, pn; };
struct Gemm { const bf16_t* A; const bf16_t* Bt; int M, N, K; };

struct StaticOrder {
    int nM, nN, nwg, G, c;
    __host__ __device__ void init(int M, int N, int G_, int c_) { nM = M / BM; nN = N / BM; nwg = nM * nN; G = G_; c = c_; }
    __host__ __device__ bool next(int i, Unit& u) const {
        const long L = (long)i * G + c; if (L >= nwg) return false;
        int wgid = (int)L; { const int q = nwg / NXCD, r = nwg % NXCD, xcd = wgid % NXCD, off = wgid / NXCD; wgid = (xcd < r ? xcd * (q + 1) : r * (q + 1) + (xcd - r) * q) + off; }
        const int nig = WGM * nN, gid = wgid / nig, fm = gid * WGM, gsz = (nM - fm) < WGM ? (nM - fm) : WGM;
        u.pm = fm + ((wgid % nig) % gsz); u.pn = (wgid % nig) / gsz; return true;
    }
    __device__ __forceinline__ int rows(const Unit&) const { return BM; }
    __device__ __forceinline__ void a_ready(const Unit&) const {}
    __device__ __forceinline__ void done(const Unit&) const {}
};

__device__ __forceinline__ unsigned cvt_pk_bf16(float lo, float hi) { unsigned r; asm volatile("v_cvt_pk_bf16_f32 %0, %1, %2" : "=v"(r) : "v"(lo), "v"(hi)); return r; }
typedef float f32x2 __attribute__((ext_vector_type(2)));
__device__ __forceinline__ f32x2 gelu_pk(f32x2 v) {
    const f32x2 av = __builtin_elementwise_abs(v), d = av * 0.2316418882f + 1.0f;
    f32x2 t; t.x = __builtin_amdgcn_rcpf(d.x); t.y = __builtin_amdgcn_rcpf(d.y);
    f32x2 q = t * 0.5307027145f + (-0.7265760135f); q = q * t + 0.7107068705f; q = q * t + (-0.142248368f); q = q * t + 0.127414796f; q = q * t;
    const f32x2 s = (v * v) * (-0.72134752044f);
    f32x2 e; e.x = __builtin_amdgcn_exp2f(s.x); e.y = __builtin_amdgcn_exp2f(s.y);
    const f32x2 m = v * (q * e), r = v - m;
    f32x2 o; o.x = v.x < 0.f ? m.x : r.x; o.y = v.y < 0.f ? m.y : r.y; return o;
}

template <int ACT  > struct EpiBf16 {
    static constexpr bool PERM = true, AFTER_DRAIN = false; static_assert(ACT == 0 || ACT == 1, "EpiBf16: ACT is 0 (none) or 1 (gelu_pk)");
    bf16_t* O; int ldc; const float* bias; int split_cols; size_t split_stride; float scale0;
    __device__ __forceinline__ void operator()(const f32x4 (&acc)[2][2][4][2], const Unit& u, int wr, int wc, int fr, int fq) const {
        const int row0 = u.pm * BM + wr * 64 + fr; int colt = u.pn * BM; bf16_t* base = O;
        float sc = 1.f; if (split_cols) { const int t = colt / split_cols; base += (size_t)t * split_stride; colt -= t * split_cols; if (t == 0) sc = scale0; }
        const int col0 = colt + wc * 32 + 8 * fq, bcol0 = u.pn * BM + wc * 32 + 8 * fq;
        f32x4 bv[2][2];
#pragma unroll
        for (int bj = 0; bj < 2; ++bj)
#pragma unroll
            for (int n = 0; n < 2; ++n) bv[bj][n] = bias ? *(const f32x4*)(bias + bcol0 + bj * HALF + 4 * n) : (f32x4){0.f, 0.f, 0.f, 0.f};
#pragma unroll
        for (int ai = 0; ai < 2; ++ai)
#pragma unroll
            for (int m = 0; m < 4; ++m) { bf16_t* rowp = base + (size_t)(row0 + ai * HALF + m * 16) * ldc + col0;
#pragma unroll
                for (int bj = 0; bj < 2; ++bj) { f32x4 v0 = acc[ai][bj][m][0] + bv[bj][0], v1 = acc[ai][bj][m][1] + bv[bj][1];
                    if (ACT == 1) { f32x2 a = gelu_pk((f32x2){v0[0], v0[1]}), b = gelu_pk((f32x2){v0[2], v0[3]}), c = gelu_pk((f32x2){v1[0], v1[1]}), d = gelu_pk((f32x2){v1[2], v1[3]});
                        v0 = (f32x4){a.x, a.y, b.x, b.y}; v1 = (f32x4){c.x, c.y, d.x, d.y}; }
                    v0 = v0 * sc; v1 = v1 * sc; u32x4 w; w.x = cvt_pk_bf16(v0[0], v0[1]); w.y = cvt_pk_bf16(v0[2], v0[3]); w.z = cvt_pk_bf16(v1[0], v1[1]); w.w = cvt_pk_bf16(v1[2], v1[3]);
                    *(u32x4*)(rowp + bj * HALF) = w; } }
    }
};

struct ConvNone { static constexpr bool ON = false; static constexpr int LDS_OFF = 0; };
template <class Epi, class Sched, bool ALIGN_EPI = false, bool SP2 = false, bool F8 = false, class CV = ConvNone>
__device__ __forceinline__ void gemm_phase(PG8_LAS unsigned char* lds, const Gemm g, const Sched& S, const Epi& E, const CV& cv = CV{}) {
    static_assert(!CV::ON || SP2, "the side job's vmcnt arithmetic is written for the SP2 schedule");
    const int tid = threadIdx.x, wid = __builtin_amdgcn_readfirstlane(tid >> 6), lane = tid & 63, wr = wid >> 2, wc = wid & 3, fr = lane & 15, fq = lane >> 4;
    const int K = g.K, nt = K / BK;
    unsigned voffA[2], voffB[2];
#pragma unroll
    for (int i = 0; i < 2; ++i) { int R, C; stage_rc(tid * 16 + i * 8192, R, C); const int Rb = Epi::PERM ? ((R & ~31) + perm32(R & 31)) : R;
        voffA[i] = (unsigned)(R * K + C) * 2u; voffB[i] = (unsigned)(Rb * K + C) * 2u; }
    const size_t kstep = (size_t)(BK * 2);
    const size_t hstep = (size_t)HALF * K * 2;
    const size_t tstep = 2 * hstep;
    const unsigned ldsw = (unsigned)wid * 1024u;
    const int aoff = lds_byte(wr * 64 + fr, fq * 8), boff = lds_byte(wc * 32 + fr, fq * 8);
#define PG8_CAT8(x, y) __builtin_bit_cast(v8i_t, __builtin_shufflevector((x), (y), 0, 1, 2, 3, 4, 5, 6, 7, 8, 9, 10, 11, 12, 13, 14, 15))
#define PG8_SA(b, h) (((b) * 2 + (h)) * HTB)
#define PG8_SB(b, h) ((4 + (b) * 2 + (h)) * HTB)
#define PG8_STAGE(bufoff, gbase, voff) do { _Pragma("unroll") for (int _i = 0; _i < 2; ++_i) \
        __builtin_amdgcn_global_load_lds((const unsigned*)((const char*)(gbase) + (voff)[_i]), (PG8_LAS unsigned*)(lds + (bufoff) + ldsw + _i * 8192), 16, 0, 0); } while (0)
#define PG8_LDA(dst, b, h) do { if constexpr (F8) { _Pragma("unroll") for (int m = 0; m < 4; ++m) dst##8[m] = PG8_CAT8(*(const PG8_LAS bf16x8*)(lds + PG8_SA(b, h) + aoff + m * 2048), *(const PG8_LAS bf16x8*)(lds + PG8_SA(b, h) + aoff + m * 2048 + 1024)); } else _Pragma("unroll") for (int m = 0; m < 4; ++m) _Pragma("unroll") for (int k = 0; k < 2; ++k) dst[m][k] = *(const PG8_LAS bf16x8*)(lds + PG8_SA(b, h) + aoff + m * 2048 + k * 1024); } while (0)
#define PG8_LDB(dst, b, h) do { if constexpr (F8) { _Pragma("unroll") for (int n = 0; n < 2; ++n) dst##8[n] = PG8_CAT8(*(const PG8_LAS bf16x8*)(lds + PG8_SB(b, h) + boff + n * 2048), *(const PG8_LAS bf16x8*)(lds + PG8_SB(b, h) + boff + n * 2048 + 1024)); } else _Pragma("unroll") for (int n = 0; n < 2; ++n) _Pragma("unroll") for (int k = 0; k < 2; ++k) dst[n][k] = *(const PG8_LAS bf16x8*)(lds + PG8_SB(b, h) + boff + n * 2048 + k * 1024); } while (0)
#define PG8_MMA(ai, bj, At, Bt) do { __builtin_amdgcn_s_setprio(1); \
        if constexpr (F8) { _Pragma("unroll") for (int m = 0; m < 4; ++m) _Pragma("unroll") for (int n = 0; n < 2; ++n) \
            asm volatile("v_mfma_f32_16x16x128_f8f6f4 %0, %1, %2, %0" : "+v"(acc[ai][bj][m][n]) : "v"(Bt##8[n]), "v"(At##8[m])); }     \
        else { _Pragma("unroll") for (int m = 0; m < 4; ++m) _Pragma("unroll") for (int n = 0; n < 2; ++n) _Pragma("unroll") for (int k = 0; k < 2; ++k) \
            acc[ai][bj][m][n] = __builtin_amdgcn_mfma_f32_16x16x32_bf16(Bt[n][k], At[m][k], acc[ai][bj][m][n], 0, 0, 0); } \
        __builtin_amdgcn_s_setprio(0); } while (0)
#define PG8_WAIT_V(n) asm volatile("s_waitcnt vmcnt(" #n ")" ::: "memory")
#define PG8_WAIT_L(n) asm volatile("s_waitcnt lgkmcnt(" #n ")" ::: "memory")
#define PG8_BAR __builtin_amdgcn_s_barrier()
#define PG8_SCHED __builtin_amdgcn_sched_barrier(0)
    Unit cur, nxt; int ui = 0;
    if (!S.next(0, cur)) return;
    bool skip1 = S.rows(cur) <= HALF;
    f32x4 acc[2][2][4][2];
#pragma unroll
    for (int a = 0; a < 2; ++a)
#pragma unroll
        for (int b = 0; b < 2; ++b)
#pragma unroll
            for (int m = 0; m < 4; ++m)
#pragma unroll
                for (int n = 0; n < 2; ++n) acc[a][b][m][n] = (f32x4){0.f, 0.f, 0.f, 0.f};
    bf16x8 At[4][2], B0[2][2], B1[2][2];
    v8i_t At8[4], B08[2], B18[2];
    const char* cA = (const char*)g.A + (size_t)cur.pm * tstep; const char* cB = (const char*)g.Bt + (size_t)cur.pn * tstep;
    S.a_ready(cur);
    typedef float cvf2 __attribute__((ext_vector_type(2))); typedef unsigned cvu2 __attribute__((ext_vector_type(2)));
    cvu2 cvo0 = {0u, 0u}, cvo1 = {0u, 0u};
    const char* cv_sb = nullptr; unsigned cv_sv = 0, cv_db = 0, cv_dv = 0, cv_stb = 0, cv_stv = 0; int cv_dn = 0, cv_stdn = 0;
    unsigned char* cv_ws = nullptr; unsigned cv_slot = 0;
    PG8_LAS unsigned char* const cv_lds = lds + CV::LDS_OFF + wid * 3072;
    if constexpr (CV::ON) { cv.decode(cur, wid, lane, cv_sb, cv_dn, cv_db, cv_dv, cv_sv); cv_ws = cv.wsbase(); cv_stb = CV::DUMMY_OFF; cv_stdn = 0; cv_stv = (unsigned)tid * 16u; }
#define CV_LD(slot) do { if constexpr (CV::ON) { \
        __builtin_amdgcn_global_load_lds((const unsigned*)(cv_sb + (size_t)((2 * slot) * (cv_dn ? 8192u : 4096u)) + cv_sv), (PG8_LAS unsigned*)(cv_lds + cv_slot), 16, 0, 0); \
        cv_slot = cv_slot == 2048u ? 0u : cv_slot + 1024u; } } while (0)
#define CV_CVT(slot, dw, hi) do { if constexpr (CV::ON) { \
        const cvf2 ra_ = *(const PG8_LAS cvf2*)(cv_lds + cv_slot + lane * 8), rb_ = *(const PG8_LAS cvf2*)(cv_lds + cv_slot + 512 + lane * 8); \
        cvo0[dw] = (unsigned)__builtin_amdgcn_cvt_pk_fp8_f32(ra_.x * CV::SCALE, rb_.x * CV::SCALE, (int)cvo0[dw], hi); \
        cvo1[dw] = (unsigned)__builtin_amdgcn_cvt_pk_fp8_f32(ra_.y * CV::SCALE, rb_.y * CV::SCALE, (int)cvo1[dw], hi); } } while (0)
#define CV_ST() do { if constexpr (CV::ON) { unsigned char* p_ = cv_ws + cv_stb; *(__attribute__((address_space(1))) cvu2*)(p_ + cv_stv) = cvo0; *(__attribute__((address_space(1))) cvu2*)(p_ + (cv_stdn ? 1024u : 2048u) + cv_stv) = cvo1; } } while (0)
    if constexpr (SP2) {
        PG8_STAGE(PG8_SB(0, 0), cB, voffB); PG8_STAGE(PG8_SB(0, 1), cB + hstep, voffB); PG8_STAGE(PG8_SA(0, 0), cA, voffA); PG8_STAGE(PG8_SA(0, 1), cA + hstep, voffA);
        if (wr == 1) PG8_BAR;
        PG8_WAIT_V(2); PG8_BAR;
        PG8_STAGE(PG8_SB(1, 0), cB + kstep, voffB); PG8_STAGE(PG8_SA(1, 0), cA + kstep, voffA); PG8_STAGE(PG8_SB(1, 1), cB + hstep + kstep, voffB);
        PG8_WAIT_V(6); PG8_BAR;
    } else {
        PG8_STAGE(PG8_SB(0, 0), cB, voffB); PG8_STAGE(PG8_SA(0, 0), cA, voffA); PG8_STAGE(PG8_SB(0, 1), cB + hstep, voffB); PG8_STAGE(PG8_SA(0, 1), cA + hstep, voffA);
        if (wr == 1) PG8_BAR;
        PG8_WAIT_V(4); PG8_BAR;
        PG8_STAGE(PG8_SB(1, 0), cB + kstep, voffB); PG8_STAGE(PG8_SA(1, 0), cA + kstep, voffA); PG8_STAGE(PG8_SB(1, 1), cB + hstep + kstep, voffB);
        PG8_WAIT_V(6); PG8_BAR;
    }
    for (;;) {
        const bool has_next = S.next(ui + 1, nxt);
        const char* nA = has_next ? (const char*)g.A + (size_t)nxt.pm * tstep : cA; const char* nB = has_next ? (const char*)g.Bt + (size_t)nxt.pn * tstep : cB;
#pragma clang loop unroll(disable)
        for (int t = 0; t < nt; t += 2) {
            const bool last = (t == nt - 2);
            const char* a1 = cA + (size_t)(t + 1) * kstep;
            const char* a2 = last ? nA : cA + (size_t)(t + 2) * kstep; const char* b2 = last ? nB : cB + (size_t)(t + 2) * kstep;
            const char* a3 = a2 + kstep; const char* b3 = b2 + kstep;
            if (last && has_next) S.a_ready(nxt);
            if constexpr (SP2) {
            PG8_LDB(B0, 0, 0); PG8_LDB(B1, 0, 1); PG8_SCHED; PG8_LDA(At, 0, 0); PG8_STAGE(PG8_SA(1, 1), a1 + hstep, voffA); CV_LD(0);
            if constexpr (CV::ON) PG8_WAIT_V(10); else PG8_WAIT_V(8);
            PG8_WAIT_L(0); PG8_BAR; PG8_MMA(0, 0, At, B0); PG8_MMA(0, 1, At, B1); CV_CVT(2, 1, false); PG8_BAR; PG8_SCHED;
            PG8_LDA(At, 0, 1); PG8_STAGE(PG8_SB(0, 0), b2, voffB); PG8_STAGE(PG8_SB(0, 1), b2 + hstep, voffB); PG8_STAGE(PG8_SA(0, 0), a2, voffA); CV_LD(1);
            if constexpr (CV::ON) PG8_WAIT_V(10); else PG8_WAIT_V(8);
            PG8_WAIT_L(0); PG8_BAR; if (!skip1) { PG8_MMA(1, 0, At, B0); PG8_MMA(1, 1, At, B1); } CV_CVT(3, 1, true); PG8_BAR; PG8_SCHED;
            CV_ST(); if constexpr (CV::ON) { cv_stb = cv_db + 4 * t; cv_stdn = cv_dn; cv_stv = cv_dv; }
            PG8_LDB(B0, 1, 0); PG8_LDB(B1, 1, 1); PG8_SCHED; PG8_LDA(At, 1, 0); PG8_STAGE(PG8_SA(0, 1), a2 + hstep, voffA); CV_LD(2);
            if constexpr (CV::ON) PG8_WAIT_V(12); else PG8_WAIT_V(8);
            PG8_WAIT_L(0); PG8_BAR; PG8_MMA(0, 0, At, B0); PG8_MMA(0, 1, At, B1); CV_CVT(0, 0, false); PG8_BAR; PG8_SCHED;
            PG8_LDA(At, 1, 1); PG8_STAGE(PG8_SB(1, 0), b3, voffB); PG8_STAGE(PG8_SB(1, 1), b3 + hstep, voffB); PG8_STAGE(PG8_SA(1, 0), a3, voffA); CV_LD(3);
            if constexpr (CV::ON) PG8_WAIT_V(12); else PG8_WAIT_V(8);
            PG8_WAIT_L(0); PG8_BAR; if (!skip1) { PG8_MMA(1, 0, At, B0); PG8_MMA(1, 1, At, B1); } CV_CVT(1, 0, true); PG8_BAR; PG8_SCHED;
            if constexpr (CV::ON) cv_sb += cv_dn ? 65536 : 32768;
            } else {
            PG8_LDB(B0, 0, 0); PG8_SCHED; PG8_LDA(At, 0, 0); PG8_STAGE(PG8_SA(1, 1), a1 + hstep, voffA);
            PG8_WAIT_L(8); PG8_BAR; PG8_WAIT_L(0); PG8_MMA(0, 0, At, B0); PG8_BAR; PG8_SCHED;
            PG8_LDB(B1, 0, 1); PG8_STAGE(PG8_SB(0, 0), b2, voffB);
            PG8_BAR; PG8_WAIT_L(0); PG8_MMA(0, 1, At, B1); PG8_BAR;
            PG8_LDA(At, 0, 1); PG8_STAGE(PG8_SA(0, 0), a2, voffA);
            PG8_BAR; PG8_WAIT_L(0); PG8_MMA(1, 0, At, B0); PG8_BAR; PG8_SCHED;
            PG8_STAGE(PG8_SB(0, 1), b2 + hstep, voffB);
            PG8_WAIT_V(6); PG8_BAR; PG8_MMA(1, 1, At, B1); PG8_BAR;
            PG8_LDB(B0, 1, 0); PG8_SCHED; PG8_LDA(At, 1, 0); PG8_STAGE(PG8_SA(0, 1), a2 + hstep, voffA);
            PG8_WAIT_L(8); PG8_BAR; PG8_WAIT_L(0); PG8_MMA(0, 0, At, B0); PG8_BAR; PG8_SCHED;
            PG8_LDB(B1, 1, 1); PG8_STAGE(PG8_SB(1, 0), b3, voffB);
            PG8_BAR; PG8_WAIT_L(0); PG8_MMA(0, 1, At, B1); PG8_BAR;
            PG8_LDA(At, 1, 1); PG8_STAGE(PG8_SA(1, 0), a3, voffA);
            PG8_BAR; PG8_WAIT_L(0); PG8_MMA(1, 0, At, B0); PG8_BAR; PG8_SCHED;
            PG8_STAGE(PG8_SB(1, 1), b3 + hstep, voffB);
            PG8_WAIT_V(6); PG8_BAR; PG8_MMA(1, 1, At, B1); PG8_BAR;
            }
        }
        if constexpr (F8) asm volatile("s_nop 15\n\ts_nop 7" ::: "memory");
        if constexpr (ALIGN_EPI) { if (wr == 0) PG8_BAR; }
        if constexpr (!Epi::AFTER_DRAIN) { int fr_ = fr, fq_ = fq; asm volatile("" : "+v"(fr_), "+v"(fq_));
            E(acc, cur, wr, wc, fr_, fq_); S.done(cur); }
        if (!has_next) break;
#pragma unroll
        for (int a = 0; a < 2; ++a)
#pragma unroll
            for (int b = 0; b < 2; ++b)
#pragma unroll
                for (int m = 0; m < 4; ++m)
#pragma unroll
                    for (int n = 0; n < 2; ++n) acc[a][b][m][n] = (f32x4){0.f, 0.f, 0.f, 0.f};
        cur = nxt; cA = nA; cB = nB; ++ui; skip1 = S.rows(cur) <= HALF;
        if constexpr (CV::ON) cv.decode(cur, wid, lane, cv_sb, cv_dn, cv_db, cv_dv, cv_sv);
        if constexpr (ALIGN_EPI) { if (wr == 1) PG8_BAR; }
    }
    PG8_WAIT_V(0);
    if constexpr (CV::ON) { cv_slot = cv_slot == 2048u ? 0u : cv_slot + 1024u; CV_CVT(2, 1, false); cv_slot = cv_slot == 2048u ? 0u : cv_slot + 1024u; CV_CVT(3, 1, true); CV_ST(); }
    if constexpr (!ALIGN_EPI) { if (wr == 0) PG8_BAR; }
    PG8_BAR;
    if constexpr (Epi::AFTER_DRAIN) { E.fused(acc, cur, wr, wc, fr, fq, lds, wid, lane); S.done(cur); }
#undef PG8_SA
#undef PG8_SB
#undef PG8_STAGE
#undef PG8_LDA
#undef PG8_LDB
#undef PG8_MMA
#undef PG8_CAT8
#undef PG8_WAIT_V
#undef PG8_WAIT_L
#undef PG8_BAR
#undef PG8_SCHED
#undef CV_LD
#undef CV_CVT
#undef CV_ST
}
}

namespace pg8 {
__device__ __forceinline__ void store16_wt(void* p, u32x4 v) { asm volatile("global_store_dwordx4 %0, %1, off sc1\n\ts_nop 1" :: "v"(p), "v"(v) : "memory"); }
__device__ __forceinline__ float clamp_f8(float v) { return __builtin_fminf(__builtin_fmaxf(v, -448.f), 448.f); }
__device__ __forceinline__ unsigned cvt4_fp8(float a, float b, float c, float d) { int w = 0; w = __builtin_amdgcn_cvt_pk_fp8_f32(a, b, w, false); w = __builtin_amdgcn_cvt_pk_fp8_f32(c, d, w, true); return (unsigned)w; }
__device__ __forceinline__ unsigned cvt4_fp8c(float a, float b, float c, float d) { return cvt4_fp8(clamp_f8(a), clamp_f8(b), clamp_f8(c), clamp_f8(d)); }
struct EpiInProj {
    static constexpr bool PERM = true, AFTER_DRAIN = false;
    bf16_t* O; int ldc; float* DT;
    __device__ __forceinline__ void operator()(const f32x4 (&acc)[2][2][4][2], const Unit& u, int wr, int wc, int fr, int fq) const {
        const int row0 = u.pm * BM + wr * 64 + fr;
        if (u.pn == 22) {
            if (wc == 0 && fq < 2) {
#pragma unroll
                for (int ai = 0; ai < 2; ++ai)
#pragma unroll
                    for (int m = 0; m < 4; ++m) { float* dp = DT + (size_t)(row0 + ai * HALF + m * 16) * 16 + 8 * fq; *(f32x4*)dp = acc[ai][0][m][0]; *(f32x4*)(dp + 4) = acc[ai][0][m][1]; } }
            return; }
        const int col0 = u.pn * BM + wc * 32 + 8 * fq;
#pragma unroll
        for (int ai = 0; ai < 2; ++ai)
#pragma unroll
            for (int m = 0; m < 4; ++m) { bf16_t* rowp = O + (size_t)(row0 + ai * HALF + m * 16) * ldc + col0;
#pragma unroll
                for (int bj = 0; bj < 2; ++bj) { const f32x4 v0 = acc[ai][bj][m][0], v1 = acc[ai][bj][m][1];
                    u32x4 w; w.x = cvt_pk_bf16(v0[0], v0[1]); w.y = cvt_pk_bf16(v0[2], v0[3]); w.z = cvt_pk_bf16(v1[0], v1[1]); w.w = cvt_pk_bf16(v1[2], v1[3]);
                    *(u32x4*)(rowp + bj * HALF) = w; } }
    }
};
struct EpiResid {
    static constexpr bool PERM = true, AFTER_DRAIN = false;
    const float* base; bf16_t* hb; unsigned char* h8; int ldc; const float* cs;
    __device__ __forceinline__ void operator()(const f32x4 (&acc)[2][2][4][2], const Unit& u, int wr, int wc, int fr, int fq) const {
        const int row0 = u.pm * BM + wr * 64 + fr, col0 = u.pn * BM + wc * 32 + 8 * fq;
        typedef unsigned u32x2_t __attribute__((ext_vector_type(2)));
        f32x4 csv[2][2];
#pragma unroll
        for (int bj = 0; bj < 2; ++bj) { csv[bj][0] = *(const f32x4*)(cs + col0 + bj * HALF); csv[bj][1] = *(const f32x4*)(cs + col0 + bj * HALF + 4); }
#pragma unroll
        for (int ai = 0; ai < 2; ++ai) {
            f32x4 xr[4][2][2];
#pragma unroll
            for (int m = 0; m < 4; ++m) { const size_t off = (size_t)(row0 + ai * HALF + m * 16) * ldc + col0;
#pragma unroll
                for (int bj = 0; bj < 2; ++bj) { xr[m][bj][0] = __builtin_nontemporal_load((const f32x4*)(base + off + bj * HALF)); xr[m][bj][1] = __builtin_nontemporal_load((const f32x4*)(base + off + bj * HALF + 4)); } }
#pragma unroll
            for (int m = 0; m < 4; ++m) { const size_t off = (size_t)(row0 + ai * HALF + m * 16) * ldc + col0;
#pragma unroll
                for (int bj = 0; bj < 2; ++bj) {
                    const f32x4 v0 = acc[ai][bj][m][0] + xr[m][bj][0], v1 = acc[ai][bj][m][1] + xr[m][bj][1];
                    u32x4 w; w.x = cvt_pk_bf16(v0[0], v0[1]); w.y = cvt_pk_bf16(v0[2], v0[3]); w.z = cvt_pk_bf16(v1[0], v1[1]); w.w = cvt_pk_bf16(v1[2], v1[3]);
                    *(u32x4*)(hb + off + bj * HALF) = w;
                    const f32x4 s0 = v0 * csv[bj][0], s1 = v1 * csv[bj][1];
                    u32x2_t q; q.x = cvt4_fp8c(s0[0], s0[1], s0[2], s0[3]); q.y = cvt4_fp8c(s1[0], s1[1], s1[2], s1[3]);
                    *(u32x2_t*)(h8 + off + bj * HALF) = q; } }
        }
    }
};
struct ExpertScale {
    const PG8_LAS int* tab; const float* lst; int lcap;
    __device__ __forceinline__ int rows(const Unit& u) const { const int e = u.pn >> 3; return tab[80 + e] - (u.pm - tab[40 + e]) * BM; }
    __device__ __forceinline__ float at(const Unit& u, int rowlocal) const { const int e = u.pn >> 3, p = (u.pm - tab[40 + e]) * BM + rowlocal; return p < tab[80 + e] ? lst[(size_t)e * lcap + p] : 0.f; }
};
struct EpiGateUp {
    static constexpr bool PERM = true, AFTER_DRAIN = false;
    unsigned char* O; int ldc; ExpertScale rs; float wsc;
    __device__ __forceinline__ void operator()(const f32x4 (&acc)[2][2][4][2], const Unit& u, int wr, int wc, int fr, int fq) const {
        const int rl0 = wr * 64 + fr, col0 = (u.pn & 7) * HALF + wc * 32 + 8 * fq;
        float rsc[2][4];
#pragma unroll
        for (int ai = 0; ai < 2; ++ai)
#pragma unroll
            for (int m = 0; m < 4; ++m) rsc[ai][m] = rs.at(u, rl0 + ai * HALF + m * 16) * wsc;
        const bool half_only = rs.rows(u) <= HALF;
#pragma unroll
        for (int ai = 0; ai < 2; ++ai) { if (ai == 1 && half_only) continue;
#pragma unroll
            for (int m = 0; m < 4; ++m) { const int rl = rl0 + ai * HALF + m * 16; const float r = rsc[ai][m];
                float hv[8];
#pragma unroll
                for (int n = 0; n < 2; ++n)
#pragma unroll
                    for (int j = 0; j < 4; ++j) { const float g = acc[ai][0][m][n][j] * r, up = acc[ai][1][m][n][j] * r; hv[n * 4 + j] = g * __builtin_amdgcn_rcpf(1.f + __builtin_amdgcn_exp2f(-1.44269504089f * g)) * up; }
                typedef unsigned u32x2_t __attribute__((ext_vector_type(2))); u32x2_t q; q.x = cvt4_fp8c(hv[0], hv[1], hv[2], hv[3]); q.y = cvt4_fp8c(hv[4], hv[5], hv[6], hv[7]);
                *(u32x2_t*)(O + (size_t)(u.pm * BM + rl) * ldc + col0) = q; } }
    }
};
struct EpiRowScale {
    static constexpr bool PERM = true, AFTER_DRAIN = false;
    unsigned char* O; int ldc; ExpertScale rs; float wsc;
    __device__ __forceinline__ void operator()(const f32x4 (&acc)[2][2][4][2], const Unit& u, int wr, int wc, int fr, int fq) const {
        const int rl0 = wr * 64 + fr, col0 = (u.pn & 7) * BM + wc * 64 + 16 * fq;
        float rsc[2][4];
#pragma unroll
        for (int ai = 0; ai < 2; ++ai)
#pragma unroll
            for (int m = 0; m < 4; ++m) rsc[ai][m] = rs.at(u, rl0 + ai * HALF + m * 16) * wsc;
        const bool half_only = rs.rows(u) <= HALF;
#pragma unroll
        for (int ai = 0; ai < 2; ++ai) { if (ai == 1 && half_only) continue;
#pragma unroll
            for (int m = 0; m < 4; ++m) { const int rl = rl0 + ai * HALF + m * 16; const float r = rsc[ai][m];
                const f32x4 v0 = acc[ai][0][m][0] * r, v1 = acc[ai][0][m][1] * r, v2 = acc[ai][1][m][0] * r, v3 = acc[ai][1][m][1] * r;
                u32x4 q; q.x = cvt4_fp8c(v0[0], v0[1], v0[2], v0[3]); q.y = cvt4_fp8c(v1[0], v1[1], v1[2], v1[3]); q.z = cvt4_fp8c(v2[0], v2[1], v2[2], v2[3]); q.w = cvt4_fp8c(v3[0], v3[1], v3[2], v3[3]);
                *(u32x4*)(O + (size_t)(u.pm * BM + rl) * ldc + col0) = q; } }
    }
};
struct ExpertOrder {
    const PG8_LAS int* tab; int nwg, G, c;
    __device__ __forceinline__ void init(const PG8_LAS int* t, int G_, int c_) { tab = t; nwg = t[32]; G = G_; c = c_; }
    __device__ __forceinline__ bool next(int i, Unit& u) const {
        const long L = (long)i * G + c; if (L >= nwg) return false;
        int wgid = (int)L; { const int q = nwg / NXCD, r = nwg % NXCD, xcd = wgid % NXCD, off = wgid / NXCD; wgid = (xcd < r ? xcd * (q + 1) : r * (q + 1) + (xcd - r) * q) + off; }
        const int tj = tab[threadIdx.x & 31];
        const int e = __builtin_popcountll(__ballot(wgid >= tj) & 0xffffffffull) - 1;
        const int local_i = wgid - tab[e], mt = (tab[e + 1] - tab[e]) >> 3;
        u.pm = tab[40 + e] + local_i % mt; u.pn = e * 8 + local_i / mt; return true;
    }
    __device__ __forceinline__ int rows(const Unit& u) const { const int e = u.pn >> 3; return tab[80 + e] - (u.pm - tab[40 + e]) * BM; }
    __device__ __forceinline__ void a_ready(const Unit&) const {}
    __device__ __forceinline__ void done(const Unit&) const {}
};
struct TeamOrder {
    int c, i0, i1;
    __device__ __forceinline__ bool next(int i, Unit& u) const {
        i += i0; if (i >= i1) return false;
        const int xcd = c & 7, l = c >> 3; if (i * 32 + l >= 184) return false;
        int pmo, pn;
        if (i < 5) { const int t = l >> 3, j = l & 7; pmo = 4 * (t & 1) + (j & 3); pn = 4 * i + 2 * (t >> 1) + (j >> 2); }
        else { pmo = l & 7; pn = 20 + (l >> 3); }
        u.pm = 8 * xcd + pmo; u.pn = pn; return true;
    }
    __device__ __forceinline__ int rows(const Unit&) const { return BM; }
    __device__ __forceinline__ void a_ready(const Unit&) const {}
    __device__ __forceinline__ void done(const Unit&) const {}
};
template <class KArgs, int IN_GATE, size_t WGU_OFF, size_t WD_OFF, size_t DUMMY, int LDSOFF> struct ConvMoE {
    static constexpr bool ON = true; static constexpr float SCALE = 64.f;
    static constexpr unsigned DUMMY_OFF = (unsigned)DUMMY; static constexpr int LDS_OFF = LDSOFF; static constexpr int nN = 23;
    static_assert(WD_OFF + 64u * 1024 * 1024 < (1ull << 32) && DUMMY < (1ull << 32), "32-bit workspace offsets");
    __device__ __forceinline__ unsigned char* wsbase() const { const KArgs a = (KArgs)__builtin_amdgcn_kernarg_segment_ptr(); return a->ws; }
    __device__ __forceinline__ void decode(const Unit& u, int wid, int lane, const char*& sb, int& dn, unsigned& db, unsigned& dv, unsigned& sv) const {
        const KArgs a = (KArgs)__builtin_amdgcn_kernarg_segment_ptr();
        const int cb = (u.pm * nN + u.pn) * 8 + wid, nl = 2 * lane;
        if (cb < 8192) { const int up = cb >> 12, r = cb & 4095, e = r >> 7, kb = (r >> 3) & 15, nb = r & 7;
            sb = (const char*)((const float*)a->in[IN_GATE + up] + (size_t)e * 2048 * 1024 + (size_t)(128 * kb) * 1024 + 128 * nb); dn = 0;
            db = (unsigned)(WGU_OFF + (size_t)e * 2048 * 2048 + (size_t)(nb * 256 + up * 128) * 2048 + 128 * kb); dv = (unsigned)nl * 2048u; sv = (unsigned)(lane >> 5) * 4096u + (unsigned)(lane & 31) * 16u; }
        else { const int r = cb - 8192, e = r >> 7, kb = (r >> 4) & 7, nb = r & 15;
            sb = (const char*)((const float*)a->in[IN_GATE + 2] + (size_t)e * 1024 * 2048 + (size_t)(128 * kb) * 2048 + 128 * nb); dn = 1;
            db = (unsigned)(WD_OFF + (size_t)e * 2048 * 1024 + (size_t)(256 * (nb >> 1)) * 1024 + 128 * kb);
            dv = (unsigned)(((nl >> 3) & 1) * 128 + (2 * (nb & 1) + (nl >> 6)) * 32 + ((nl >> 4) & 3) * 8 + (nl & 7)) * 1024u; sv = (unsigned)(lane >> 5) * 8192u + (unsigned)(lane & 31) * 16u; }
    }
};
}

namespace pg8 {
template <class Epi, class Sched, class RowSrc, bool ALIGN_EPI = false, bool SP2 = false, bool F8 = false>
__device__ __forceinline__ void gemm_phase_g(PG8_LAS unsigned char* lds, const Gemm g, const Sched& S, const Epi& E, const RowSrc& RS) {
    const int tid = threadIdx.x, wid = __builtin_amdgcn_readfirstlane(tid >> 6), lane = tid & 63, wr = wid >> 2, wc = wid & 3, fr = lane & 15, fq = lane >> 4;
    const int K = g.K, nt = K / BK;
    unsigned voffB[2]; unsigned vC0[2], vC1[2], vN0[2], vN1[2]; int Rr[2], Cc[2];
#pragma unroll
    for (int i = 0; i < 2; ++i) { int R, C; stage_rc(tid * 16 + i * 8192, R, C); const int Rb = Epi::PERM ? ((R & ~31) + perm32(R & 31)) : R;
        Rr[i] = R; Cc[i] = C; voffB[i] = (unsigned)(Rb * K + C) * 2u; }
    const size_t kstep = (size_t)(BK * 2);
    const size_t hstep = (size_t)HALF * K * 2;
    const size_t tstep = 2 * hstep;
    const unsigned ldsw = (unsigned)wid * 1024u;
    const int aoff = lds_byte(wr * 64 + fr, fq * 8), boff = lds_byte(wc * 32 + fr, fq * 8);
#define PG8_CAT8(x, y) __builtin_bit_cast(v8i_t, __builtin_shufflevector((x), (y), 0, 1, 2, 3, 4, 5, 6, 7, 8, 9, 10, 11, 12, 13, 14, 15))
#define PG8_SA(b, h) (((b) * 2 + (h)) * HTB)
#define PG8_SB(b, h) ((4 + (b) * 2 + (h)) * HTB)
#define PG8_STAGE(bufoff, gbase, voff) do { _Pragma("unroll") for (int _i = 0; _i < 2; ++_i) \
        __builtin_amdgcn_global_load_lds((const unsigned*)((const char*)(gbase) + (voff)[_i]), (PG8_LAS unsigned*)(lds + (bufoff) + ldsw + _i * 8192), 16, 0, 0); } while (0)
#define PG8_LDA(dst, b, h) do { if constexpr (F8) { _Pragma("unroll") for (int m = 0; m < 4; ++m) dst##8[m] = PG8_CAT8(*(const PG8_LAS bf16x8*)(lds + PG8_SA(b, h) + aoff + m * 2048), *(const PG8_LAS bf16x8*)(lds + PG8_SA(b, h) + aoff + m * 2048 + 1024)); } else _Pragma("unroll") for (int m = 0; m < 4; ++m) _Pragma("unroll") for (int k = 0; k < 2; ++k) dst[m][k] = *(const PG8_LAS bf16x8*)(lds + PG8_SA(b, h) + aoff + m * 2048 + k * 1024); } while (0)
#define PG8_LDB(dst, b, h) do { if constexpr (F8) { _Pragma("unroll") for (int n = 0; n < 2; ++n) dst##8[n] = PG8_CAT8(*(const PG8_LAS bf16x8*)(lds + PG8_SB(b, h) + boff + n * 2048), *(const PG8_LAS bf16x8*)(lds + PG8_SB(b, h) + boff + n * 2048 + 1024)); } else _Pragma("unroll") for (int n = 0; n < 2; ++n) _Pragma("unroll") for (int k = 0; k < 2; ++k) dst[n][k] = *(const PG8_LAS bf16x8*)(lds + PG8_SB(b, h) + boff + n * 2048 + k * 1024); } while (0)
#define PG8_MMA(ai, bj, At, Bt) do { __builtin_amdgcn_s_setprio(1); \
        if constexpr (F8) { _Pragma("unroll") for (int m = 0; m < 4; ++m) _Pragma("unroll") for (int n = 0; n < 2; ++n) \
            asm volatile("v_mfma_f32_16x16x128_f8f6f4 %0, %1, %2, %0" : "+v"(acc[ai][bj][m][n]) : "v"(Bt##8[n]), "v"(At##8[m])); }     \
        else { _Pragma("unroll") for (int m = 0; m < 4; ++m) _Pragma("unroll") for (int n = 0; n < 2; ++n) _Pragma("unroll") for (int k = 0; k < 2; ++k) \
            acc[ai][bj][m][n] = __builtin_amdgcn_mfma_f32_16x16x32_bf16(Bt[n][k], At[m][k], acc[ai][bj][m][n], 0, 0, 0); } \
        __builtin_amdgcn_s_setprio(0); } while (0)
#define PG8_WAIT_V(n) asm volatile("s_waitcnt vmcnt(" #n ")" ::: "memory")
#define PG8_WAIT_L(n) asm volatile("s_waitcnt lgkmcnt(" #n ")" ::: "memory")
#define PG8_BAR __builtin_amdgcn_s_barrier()
#define PG8_SCHED __builtin_amdgcn_sched_barrier(0)
    Unit cur, nxt; int ui = 0;
    if (!S.next(0, cur)) return;
    bool skip1 = S.rows(cur) <= HALF;
    f32x4 acc[2][2][4][2];
#pragma unroll
    for (int a = 0; a < 2; ++a)
#pragma unroll
        for (int b = 0; b < 2; ++b)
#pragma unroll
            for (int m = 0; m < 4; ++m)
#pragma unroll
                for (int n = 0; n < 2; ++n) acc[a][b][m][n] = (f32x4){0.f, 0.f, 0.f, 0.f};
    bf16x8 At[4][2], B0[2][2], B1[2][2];
    v8i_t At8[4], B08[2], B18[2];
    const char* cA = (const char*)g.A; const char* cB = (const char*)g.Bt + (size_t)cur.pn * tstep;
    RS.rows(cur, Rr, Cc, K, vC0, vC1);
    S.a_ready(cur);
    if constexpr (SP2) {
        PG8_STAGE(PG8_SB(0, 0), cB, voffB); PG8_STAGE(PG8_SB(0, 1), cB + hstep, voffB); PG8_STAGE(PG8_SA(0, 0), cA, vC0); PG8_STAGE(PG8_SA(0, 1), cA, vC1);
        if (wr == 1) PG8_BAR;
        PG8_WAIT_V(2); PG8_BAR;
        PG8_STAGE(PG8_SB(1, 0), cB + kstep, voffB); PG8_STAGE(PG8_SA(1, 0), cA + kstep, vC0); PG8_STAGE(PG8_SB(1, 1), cB + hstep + kstep, voffB);
        PG8_WAIT_V(6); PG8_BAR;
    } else {
        PG8_STAGE(PG8_SB(0, 0), cB, voffB); PG8_STAGE(PG8_SA(0, 0), cA, vC0); PG8_STAGE(PG8_SB(0, 1), cB + hstep, voffB); PG8_STAGE(PG8_SA(0, 1), cA, vC1);
        if (wr == 1) PG8_BAR;
        PG8_WAIT_V(4); PG8_BAR;
        PG8_STAGE(PG8_SB(1, 0), cB + kstep, voffB); PG8_STAGE(PG8_SA(1, 0), cA + kstep, vC0); PG8_STAGE(PG8_SB(1, 1), cB + hstep + kstep, voffB);
        PG8_WAIT_V(6); PG8_BAR;
    }
    for (;;) {
        const bool has_next = S.next(ui + 1, nxt);
        const char* nA = cA; const char* nB = has_next ? (const char*)g.Bt + (size_t)nxt.pn * tstep : cB;
        if (has_next) RS.rows(nxt, Rr, Cc, K, vN0, vN1); else { vN0[0] = vC0[0]; vN0[1] = vC0[1]; vN1[0] = vC1[0]; vN1[1] = vC1[1]; }
        for (int t = 0; t < nt; t += 2) {
            const bool last = (t == nt - 2);
            const char* a1 = cA + (size_t)(t + 1) * kstep;
            const char* a2 = last ? nA : cA + (size_t)(t + 2) * kstep; const char* b2 = last ? nB : cB + (size_t)(t + 2) * kstep;
            const char* a3 = a2 + kstep; const char* b3 = b2 + kstep;
            const unsigned v20[2] = {last ? vN0[0] : vC0[0], last ? vN0[1] : vC0[1]}, v21[2] = {last ? vN1[0] : vC1[0], last ? vN1[1] : vC1[1]};
            if (last && has_next) S.a_ready(nxt);
            if constexpr (SP2) {
            PG8_LDB(B0, 0, 0); PG8_LDB(B1, 0, 1); PG8_SCHED; PG8_LDA(At, 0, 0); PG8_STAGE(PG8_SA(1, 1), a1, vC1);
            PG8_WAIT_V(8); PG8_WAIT_L(0); PG8_BAR; PG8_MMA(0, 0, At, B0); PG8_MMA(0, 1, At, B1); PG8_BAR; PG8_SCHED;
            PG8_LDA(At, 0, 1); PG8_STAGE(PG8_SB(0, 0), b2, voffB); PG8_STAGE(PG8_SB(0, 1), b2 + hstep, voffB); PG8_STAGE(PG8_SA(0, 0), a2, v20);
            PG8_WAIT_V(8); PG8_WAIT_L(0); PG8_BAR; if (!skip1) { PG8_MMA(1, 0, At, B0); PG8_MMA(1, 1, At, B1); } PG8_BAR; PG8_SCHED;
            PG8_LDB(B0, 1, 0); PG8_LDB(B1, 1, 1); PG8_SCHED; PG8_LDA(At, 1, 0); PG8_STAGE(PG8_SA(0, 1), a2, v21);
            PG8_WAIT_V(8); PG8_WAIT_L(0); PG8_BAR; PG8_MMA(0, 0, At, B0); PG8_MMA(0, 1, At, B1); PG8_BAR; PG8_SCHED;
            PG8_LDA(At, 1, 1); PG8_STAGE(PG8_SB(1, 0), b3, voffB); PG8_STAGE(PG8_SB(1, 1), b3 + hstep, voffB); PG8_STAGE(PG8_SA(1, 0), a3, v20);
            PG8_WAIT_V(8); PG8_WAIT_L(0); PG8_BAR; if (!skip1) { PG8_MMA(1, 0, At, B0); PG8_MMA(1, 1, At, B1); } PG8_BAR; PG8_SCHED;
            } else {
            PG8_LDB(B0, 0, 0); PG8_SCHED; PG8_LDA(At, 0, 0); PG8_STAGE(PG8_SA(1, 1), a1, vC1);
            PG8_WAIT_L(8); PG8_BAR; PG8_WAIT_L(0); PG8_MMA(0, 0, At, B0); PG8_BAR; PG8_SCHED;
            PG8_LDB(B1, 0, 1); PG8_STAGE(PG8_SB(0, 0), b2, voffB);
            PG8_BAR; PG8_WAIT_L(0); PG8_MMA(0, 1, At, B1); PG8_BAR;
            PG8_LDA(At, 0, 1); PG8_STAGE(PG8_SA(0, 0), a2, v20);
            PG8_BAR; PG8_WAIT_L(0); PG8_MMA(1, 0, At, B0); PG8_BAR; PG8_SCHED;
            PG8_STAGE(PG8_SB(0, 1), b2 + hstep, voffB);
            PG8_WAIT_V(6); PG8_BAR; PG8_MMA(1, 1, At, B1); PG8_BAR;
            PG8_LDB(B0, 1, 0); PG8_SCHED; PG8_LDA(At, 1, 0); PG8_STAGE(PG8_SA(0, 1), a2, v21);
            PG8_WAIT_L(8); PG8_BAR; PG8_WAIT_L(0); PG8_MMA(0, 0, At, B0); PG8_BAR; PG8_SCHED;
            PG8_LDB(B1, 1, 1); PG8_STAGE(PG8_SB(1, 0), b3, voffB);
            PG8_BAR; PG8_WAIT_L(0); PG8_MMA(0, 1, At, B1); PG8_BAR;
            PG8_LDA(At, 1, 1); PG8_STAGE(PG8_SA(1, 0), a3, v20);
            PG8_BAR; PG8_WAIT_L(0); PG8_MMA(1, 0, At, B0); PG8_BAR; PG8_SCHED;
            PG8_STAGE(PG8_SB(1, 1), b3 + hstep, voffB);
            PG8_WAIT_V(6); PG8_BAR; PG8_MMA(1, 1, At, B1); PG8_BAR;
            }
        }
        if constexpr (F8) asm volatile("s_nop 15\n\ts_nop 7" ::: "memory");
        if constexpr (ALIGN_EPI) { if (wr == 0) PG8_BAR; }
        if constexpr (!Epi::AFTER_DRAIN) { E(acc, cur, wr, wc, fr, fq); S.done(cur); }
        if (!has_next) break;
#pragma unroll
        for (int a = 0; a < 2; ++a)
#pragma unroll
            for (int b = 0; b < 2; ++b)
#pragma unroll
                for (int m = 0; m < 4; ++m)
#pragma unroll
                    for (int n = 0; n < 2; ++n) acc[a][b][m][n] = (f32x4){0.f, 0.f, 0.f, 0.f};
        cur = nxt; cA = nA; cB = nB; ++ui; skip1 = S.rows(cur) <= HALF; vC0[0] = vN0[0]; vC0[1] = vN0[1]; vC1[0] = vN1[0]; vC1[1] = vN1[1];
        if constexpr (ALIGN_EPI) { if (wr == 1) PG8_BAR; }
    }
    PG8_WAIT_V(0);
    if constexpr (!ALIGN_EPI) { if (wr == 0) PG8_BAR; }
    PG8_BAR;
    if constexpr (Epi::AFTER_DRAIN) { E.fused(acc, cur, wr, wc, fr, fq, lds, wid, lane); S.done(cur); }
#undef PG8_SA
#undef PG8_SB
#undef PG8_STAGE
#undef PG8_LDA
#undef PG8_LDB
#undef PG8_MMA
#undef PG8_CAT8
#undef PG8_WAIT_V
#undef PG8_WAIT_L
#undef PG8_BAR
#undef PG8_SCHED
}

struct ExpertRows {
    const PG8_LAS int* tab; const int* lst_tok; int lcap;
    __device__ __forceinline__ void rows(const Unit& u, const int (&Rr)[2], const int (&Cc)[2], int K, unsigned (&v0)[2], unsigned (&v1)[2]) const {
        const int e = u.pn >> 3, mi = u.pm - tab[40 + e], cnt = tab[80 + e];
#pragma unroll
        for (int i = 0; i < 2; ++i) { const int p0 = mi * BM + Rr[i], p1 = p0 + HALF;
            const int t0 = p0 < cnt ? lst_tok[(size_t)e * lcap + p0] : 0, t1 = p1 < cnt ? lst_tok[(size_t)e * lcap + p1] : 0;
            v0[i] = (unsigned)(t0 * K + Cc[i]) * 2u; v1[i] = (unsigned)(t1 * K + Cc[i]) * 2u; }
    }
};
}

#ifndef PG8_SP2
#define PG8_SP2 true
#endif
#ifndef PG8_ALIGN
#define PG8_ALIGN true
#endif

namespace attn_body {
using bf16=__hip_bfloat16;
using bf16x8=__attribute__((ext_vector_type(8)))short;
using s16x4=__attribute__((ext_vector_type(4)))short;
using f32x16=__attribute__((ext_vector_type(16)))float;
using u32x4=__attribute__((ext_vector_type(4)))unsigned;
constexpr int SEQ=2048,D=64,QP=1024,KP=1024,VP=5632,OP=1024;
constexpr int NW=8,QBLK=32,QB=QBLK*NW,KVBLK=64,NQB=SEQ/QB;
constexpr int ATTN_UNIT_ROWS=QB;
__device__ __forceinline__ int crow(int r,int hi){return (r&3)+8*(r>>2)+4*hi;}
#define SBAR() __builtin_amdgcn_sched_barrier(0)
__device__ __forceinline__ void cmask(f32x16&p0,f32x16&p1,int jb,int qrel,int hi){
  const float NEG=-INFINITY; int kb=64*jb+4*hi;
  #pragma unroll
  for(int r=0;r<16;++r){int kv=kb+(r&3)+8*(r>>2); if(kv>qrel)p0[r]=NEG; if(kv+32>qrel)p1[r]=NEG;}
}

constexpr int NSLOT=3, SLOTB=8192;
constexpr int LDS_K=0, LDS_V=NSLOT*SLOTB, LDS_WS=2*NSLOT*SLOTB, LDS_OST=LDS_WS+NW*64*4, LDS_BYTES=LDS_OST+NW*4096;
constexpr float C2=0.125f*1.4426950408889634f;
__device__ __forceinline__ void glds16(const void*gsrc,unsigned lds_dst){unsigned keep;
  asm volatile("s_mov_b32 %0, m0\n\ts_mov_b32 m0, %2\n\ts_nop 0\n\tglobal_load_lds_dwordx4 %1, off\n\ts_mov_b32 m0, %0":"=&s"(keep):"v"(gsrc),"s"(lds_dst):"memory");}
__device__ __forceinline__ float max3f(float a,float b,float c){float r;asm("v_max3_f32 %0, %1, %2, %3":"=v"(r):"v"(a),"v"(b),"v"(c));return r;}
__device__ __forceinline__ float max2f(float a,float b){float r;asm("v_max_f32_e32 %0, %1, %2":"=v"(r):"v"(a),"v"(b));return r;}
__device__ __forceinline__ float fadd_s(float a,float b){float r;asm("v_add_f32_e32 %0, %1, %2":"=v"(r):"v"(a),"v"(b));return r;}
__device__ __forceinline__ float fsub_s(float a,float b){float r;asm("v_sub_f32_e32 %0, %1, %2":"=v"(r):"v"(a),"v"(b));return r;}
typedef float f32x2_t __attribute__((ext_vector_type(2))); typedef __bf16 bf16x2_t __attribute__((ext_vector_type(2)));
__device__ __forceinline__ unsigned cvtpk_s(float lo,float hi){f32x2_t v={lo,hi};bf16x2_t b=__builtin_convertvector(v,bf16x2_t);return __builtin_bit_cast(unsigned,b);}
#define WAIT_BAR(N) asm volatile("s_waitcnt vmcnt(" #N ") lgkmcnt(0)\n\ts_barrier":::"memory")

__device__ __forceinline__ void qkt(f32x16&p0,f32x16&p1,const char*Kslot,const bf16x8*qr,const f32x16&negm,int r32,int hi){
  const char*kb=Kslot+hi*1024+r32*16;
  #pragma unroll
  for(int d0=0;d0<4;++d0){
    const bf16x8 b0=*reinterpret_cast<const bf16x8*>(kb+d0*2048);
    const bf16x8 b1=*reinterpret_cast<const bf16x8*>(kb+d0*2048+512);
    if(d0==0){p0=__builtin_amdgcn_mfma_f32_32x32x16_bf16(b0,qr[0],negm,0,0,0);p1=__builtin_amdgcn_mfma_f32_32x32x16_bf16(b1,qr[0],negm,0,0,0);}
    else{p0=__builtin_amdgcn_mfma_f32_32x32x16_bf16(b0,qr[d0],p0,0,0,0);p1=__builtin_amdgcn_mfma_f32_32x32x16_bf16(b1,qr[d0],p1,0,0,0);}}
}
typedef __attribute__((address_space(3))) const char* lds_cptr;
typedef short v4i16_t __attribute__((ext_vector_type(4)));
__device__ __forceinline__ void kload8(bf16x8*kf,lds_cptr kp){
  kf[0]=*(const __attribute__((address_space(3))) bf16x8*)(kp);      kf[1]=*(const __attribute__((address_space(3))) bf16x8*)(kp+512);
  kf[2]=*(const __attribute__((address_space(3))) bf16x8*)(kp+2048); kf[3]=*(const __attribute__((address_space(3))) bf16x8*)(kp+2560);
  kf[4]=*(const __attribute__((address_space(3))) bf16x8*)(kp+4096); kf[5]=*(const __attribute__((address_space(3))) bf16x8*)(kp+4608);
  kf[6]=*(const __attribute__((address_space(3))) bf16x8*)(kp+6144); kf[7]=*(const __attribute__((address_space(3))) bf16x8*)(kp+6656);
}
__device__ __forceinline__ void kload2(bf16x8*kf,lds_cptr kp,int j){ kf[2*j]=*(const __attribute__((address_space(3))) bf16x8*)(kp+j*2048); kf[2*j+1]=*(const __attribute__((address_space(3))) bf16x8*)(kp+j*2048+512); }
__device__ __forceinline__ s16x4 vtr(lds_cptr p){ return __builtin_bit_cast(s16x4,__builtin_amdgcn_ds_read_tr16_b64_v4i16((__attribute__((address_space(3))) v4i16_t*)p)); }
__device__ __forceinline__ float rowmax(const f32x16&p0,const f32x16&p1){
  float a=max3f(p0[0],p0[1],p1[0]),b=max3f(p0[2],p0[3],p1[1]);a=max3f(a,p1[2],p1[3]);
  #pragma unroll
  for(int r=4;r<16;r+=4){a=max3f(a,p0[r],p0[r+1]);b=max3f(b,p0[r+2],p0[r+3]);a=max3f(a,p1[r],p1[r+1]);b=max3f(b,p1[r+2],p1[r+3]);}
  const float m=max2f(a,b);
  auto rr=__builtin_amdgcn_permlane32_swap(__float_as_uint(m),__float_as_uint(m),false,false);
  return max2f(__uint_as_float(rr[0]),__uint_as_float(rr[1]));
}
__device__ __forceinline__ void pv(f32x16*o,int vb,bf16x8 pa0,bf16x8 pa1,bf16x8 pa2,bf16x8 pa3){
  #pragma unroll
  for(int d0=0;d0<2;++d0){s16x4 lo[4],hi[4];
    #pragma unroll
    for(int ks=0;ks<4;++ks){
      asm volatile("ds_read_b64_tr_b16 %0,%1 offset:%c2":"=&v"(lo[ks]):"v"(vb),"i"(d0*4096+ks*1024):"memory");
      asm volatile("ds_read_b64_tr_b16 %0,%1 offset:%c2":"=&v"(hi[ks]):"v"(vb),"i"(d0*4096+ks*1024+512):"memory");}
    asm volatile("s_waitcnt lgkmcnt(0)":::"memory");SBAR();
    #define PK(k) (bf16x8){lo[k][0],lo[k][1],lo[k][2],lo[k][3],hi[k][0],hi[k][1],hi[k][2],hi[k][3]}
    o[d0]=__builtin_amdgcn_mfma_f32_32x32x16_bf16(pa0,PK(0),o[d0],0,0,0);
    o[d0]=__builtin_amdgcn_mfma_f32_32x32x16_bf16(pa1,PK(1),o[d0],0,0,0);
    o[d0]=__builtin_amdgcn_mfma_f32_32x32x16_bf16(pa2,PK(2),o[d0],0,0,0);
    o[d0]=__builtin_amdgcn_mfma_f32_32x32x16_bf16(pa3,PK(3),o[d0],0,0,0);
    #undef PK
  }
}

#ifndef ATTN_STORE16
#define ATTN_STORE16(p,v) (*(u32x4*)(p)=(v))
#endif
template<int THRL> __device__ __forceinline__ void attn_unit(int b,int h,int qb,const bf16*Q,const bf16*__restrict__ K,const bf16*__restrict__ V,bf16*O,char*shm){
  int tid_=threadIdx.x; asm volatile("" : "+v"(tid_));
  const int tid=tid_,lane=tid&63,r32=lane&31,hi=lane>>5; const int wid=__builtin_amdgcn_readfirstlane(tid>>6);
  const long rowbase=(long)b*SEQ; const int q0=qb*QB;
  const bf16*Qw=Q+(rowbase+q0+wid*QBLK)*QP+h*D;
  const bf16*Kh=K+rowbase*KP+h*D,*Vh=V+rowbase*VP+h*D;
  const unsigned lds0=(unsigned)(uintptr_t)shm;
  float*wsf=(float*)(shm+LDS_WS)+wid*64;
  const bf16*ksrc=Kh+(long)lane*KP+wid*8;
  const bf16*vsrc=Vh+(long)(16*(wid&3)+(lane>>2))*VP+(wid>>2)*32+(lane&3)*8;
  const unsigned kdst=lds0+LDS_K+wid*1024, vdst=lds0+LDS_V+wid*1024;
  #define DMA_K(t,slot) glds16(ksrc+(long)(t)*KVBLK*KP,(unsigned)__builtin_amdgcn_readfirstlane(kdst+(slot)))
  #define DMA_V(t,slot) glds16(vsrc+(long)(t)*KVBLK*VP,(unsigned)__builtin_amdgcn_readfirstlane(vdst+(slot)))
  const int vb0=(int)(lds0+LDS_V)+((lane>>4)&1)*32+(lane&3)*8+(4*hi+((lane&15)>>2))*64;
  const char*Kbase=shm+LDS_K; bf16x8 kf[8];
  const lds_cptr shm3=(lds_cptr)shm; const lds_cptr kp0=shm3+LDS_K+hi*1024+r32*16; const lds_cptr vp0=shm3+LDS_V+((lane>>4)&1)*32+(lane&3)*8+(4*hi+((lane&15)>>2))*64;
  const int NT=(q0+QB)/KVBLK;
  DMA_K(0,0);DMA_V(0,0);DMA_K(1,SLOTB);
  bf16x8 qr[4];
  #pragma unroll
  for(int d0=0;d0<4;++d0)qr[d0]=*reinterpret_cast<const bf16x8*>(&Qw[(long)r32*QP+d0*16+hi*8]);
  float mhat=0.f,l_reg=0.f;f32x16 o[2];o[0]=f32x16{};o[1]=f32x16{};f32x16 negm=f32x16{};asm volatile("":"+v"(negm));
  const int qrel=wid*QBLK+r32;
  #define CMASK(P0,P1,t) do{int jb_=(t)-(NT-4); if(jb_>=0)cmask(P0,P1,jb_,qrel,hi);}while(0)
  bool resc=false;
  #define START(P0,P1) do{ const float rm=rowmax(P0,P1); resc=false; \
    { const float dl=rm; mhat=fadd_s(mhat,dl); \
      _Pragma("unroll") for(int r=0;r<16;++r){P0[r]=fsub_s(P0[r],dl);P1[r]=fsub_s(P1[r],dl);} \
      _Pragma("unroll") for(int r=0;r<16;++r)negm[r]=-mhat; asm volatile("":"+v"(negm)); } \
    _Pragma("unroll") for(int r=0;r<16;++r)P0[r]=__builtin_amdgcn_exp2f(P0[r]); }while(0)
  #define RESC() do{ if(resc){ asm volatile("s_waitcnt lgkmcnt(0)":::"memory"); \
      _Pragma("unroll") for(int d_=0;d_<2;++d_) _Pragma("unroll") for(int r=0;r<16;++r)o[d_][r]*=wsf[crow(r,hi)]; } }while(0)
  f32x16 pA0,pA1,pB0,pB1;
  int sl_prev=0,sl_cur=0,sl_next=SLOTB;
  #define ROT() do{sl_prev=sl_cur;sl_cur=sl_next;sl_next=(sl_next==(NSLOT-1)*SLOTB)?0:sl_next+SLOTB;}while(0)
  DMA_K(2,2*SLOTB);
  WAIT_BAR(3);
  qkt(pA0,pA1,Kbase,qr,negm,r32,hi);asm volatile("s_nop 15\n\ts_nop 7":"+v"(pA0),"+v"(pA1));CMASK(pA0,pA1,0);
  START(pA0,pA1);
  _Pragma("unroll") for(int r=0;r<16;++r)pA1[r]=__builtin_amdgcn_exp2f(pA1[r]);
  WAIT_BAR(0);
  DMA_K(3,0);DMA_V(1,SLOTB);
  ROT();
  kload8(kf,kp0+sl_cur);
  WAIT_BAR(2);
  s16x4 vlo[8],vhi[8]; u32x4 pw0,pw1,pw2,pw3;
  #define PKW(P,B) cvtpk_s(P[B],P[B+1])
  #define PAF(k) __builtin_bit_cast(bf16x8,pw##k)
  #define VFR(i) (bf16x8){vlo[i][0],vlo[i][1],vlo[i][2],vlo[i][3],vhi[i][0],vhi[i][1],vhi[i][2],vhi[i][3]}
  #define PIN(x) asm volatile("":"+v"(x))
  #define MX3(a,b,c) __builtin_fmaxf(__builtin_fmaxf((a),(b)),(c))
  #define GAPA(MF,A0,A1,A2,A3,W0,W1,PW) do{ MF; sacc+=A0; sacc+=A1; sacc+=A2; sacc+=A3; PIN(sacc); W0; W1; PIN(PW); SBAR(); }while(0)
  #define EX(v) __builtin_amdgcn_exp2f(v)
  #define GAPB(MF,X,B) do{ MF; X[B]=EX(X[B]); X[B+1]=EX(X[B+1]); X[B+2]=EX(X[B+2]); X[B+3]=EX(X[B+3]); PIN(X); SBAR(); }while(0)
  #define VRD(i) do{ vlo[i]=vtr(vp_+(((i)>>2)*4096+((i)&3)*1024)); vhi[i]=vtr(vp_+(((i)>>2)*4096+((i)&3)*1024+512)); }while(0)
  #define KRD(G,j) do{ if(G){ kload2(kf,kp0+sl_next,j); SBAR(); } }while(0)
  #define STEP(C0,C1,P0,P1,t,GK,GV,GL) do{ SBAR(); \
    const lds_cptr vp_=vp0+sl_prev; \
    VRD(0); SBAR(); float sacc=(P0[0]+P0[1]); \
    GAPA(C0=__builtin_amdgcn_mfma_f32_32x32x16_bf16(kf[0],qr[0],negm,0,0,0), P0[2],P0[3],P0[4],P0[5],     pw0[0]=PKW(P0,0), pw0[1]=PKW(P0,2), pw0); \
    VRD(4); SBAR(); GAPA(C1=__builtin_amdgcn_mfma_f32_32x32x16_bf16(kf[1],qr[0],negm,0,0,0), P0[6],P0[7],P0[8],P0[9],     pw0[2]=PKW(P0,4), pw0[3]=PKW(P0,6), pw0); \
    VRD(1); SBAR(); GAPA(C0=__builtin_amdgcn_mfma_f32_32x32x16_bf16(kf[2],qr[1],C0,0,0,0),   P0[10],P0[11],P0[12],P0[13], pw1[0]=PKW(P0,8), pw1[1]=PKW(P0,10), pw1); \
    VRD(5); SBAR(); GAPA(C1=__builtin_amdgcn_mfma_f32_32x32x16_bf16(kf[3],qr[1],C1,0,0,0),   P0[14],P0[15],P1[0],P1[1],   pw1[2]=PKW(P0,12),pw1[3]=PKW(P0,14), pw1); \
    VRD(2); SBAR(); GAPA(C0=__builtin_amdgcn_mfma_f32_32x32x16_bf16(kf[4],qr[2],C0,0,0,0),   P1[2],P1[3],P1[4],P1[5],     pw2[0]=PKW(P1,0), pw2[1]=PKW(P1,2), pw2); \
    VRD(6); SBAR(); GAPA(C1=__builtin_amdgcn_mfma_f32_32x32x16_bf16(kf[5],qr[2],C1,0,0,0),   P1[6],P1[7],P1[8],P1[9],     pw2[2]=PKW(P1,4), pw2[3]=PKW(P1,6), pw2); \
    VRD(3); SBAR(); GAPA(C0=__builtin_amdgcn_mfma_f32_32x32x16_bf16(kf[6],qr[3],C0,0,0,0),   P1[10],P1[11],P1[12],P1[13], pw3[0]=PKW(P1,8), pw3[1]=PKW(P1,10), pw3); \
    VRD(7); SBAR(); GAPA(C1=__builtin_amdgcn_mfma_f32_32x32x16_bf16(kf[7],qr[3],C1,0,0,0),   P1[14],P1[15],0.f,0.f,       pw3[2]=PKW(P1,12),pw3[3]=PKW(P1,14), pw3); \
    l_reg+=sacc; \
    if(GK){DMA_K((t)+3,sl_cur);} if(GV){DMA_V((t)+1,sl_next);} \
    CMASK(C0,C1,t); \
    { float a=MX3(C0[0],C0[1],C1[0]),b=MX3(C0[2],C0[3],C1[1]); a=MX3(a,C1[2],C1[3]); \
      _Pragma("unroll") for(int r=4;r<16;r+=4){a=MX3(a,C0[r],C0[r+1]);b=MX3(b,C0[r+2],C0[r+3]);a=MX3(a,C1[r],C1[r+1]);b=MX3(b,C1[r+2],C1[r+3]);} \
      float rm=__builtin_fmaxf(a,b); { auto rr=__builtin_amdgcn_permlane32_swap(__float_as_uint(rm),__float_as_uint(rm),false,false); rm=__builtin_fmaxf(__uint_as_float(rr[0]),__uint_as_float(rr[1])); } \
      resc=false; \
      if(__builtin_expect(__any(rm>(float)THRL),0)){ const float dl=__builtin_fmaxf(rm,0.f); mhat+=dl; \
        _Pragma("unroll") for(int r=0;r<16;++r){C0[r]-=dl;C1[r]-=dl;} \
        _Pragma("unroll") for(int r=0;r<16;++r)negm[r]=-mhat; asm volatile("":"+v"(negm)); \
        const float f=__builtin_amdgcn_exp2f(-dl); l_reg*=f; if(hi==0)wsf[r32]=f; resc=true; } } \
    SBAR(); \
    GAPB(o[0]=__builtin_amdgcn_mfma_f32_32x32x16_bf16(PAF(0),VFR(0),o[0],0,0,0), C0,0); \
    GAPB(o[1]=__builtin_amdgcn_mfma_f32_32x32x16_bf16(PAF(0),VFR(4),o[1],0,0,0), C0,4); \
    KRD(GL,0); GAPB(o[0]=__builtin_amdgcn_mfma_f32_32x32x16_bf16(PAF(1),VFR(1),o[0],0,0,0), C0,8); \
    KRD(GL,1); GAPB(o[1]=__builtin_amdgcn_mfma_f32_32x32x16_bf16(PAF(1),VFR(5),o[1],0,0,0), C0,12); \
    KRD(GL,2); GAPB(o[0]=__builtin_amdgcn_mfma_f32_32x32x16_bf16(PAF(2),VFR(2),o[0],0,0,0), C1,0); \
    KRD(GL,3); GAPB(o[1]=__builtin_amdgcn_mfma_f32_32x32x16_bf16(PAF(2),VFR(6),o[1],0,0,0), C1,4); \
    GAPB(o[0]=__builtin_amdgcn_mfma_f32_32x32x16_bf16(PAF(3),VFR(3),o[0],0,0,0), C1,8); \
    GAPB(o[1]=__builtin_amdgcn_mfma_f32_32x32x16_bf16(PAF(3),VFR(7),o[1],0,0,0), C1,12); \
    }while(0)
  int t=1;
  #undef CMASK
  #define CMASK(P0,P1,t) do{}while(0)
  for(;t+5<NT;t+=2){
    STEP(pB0,pB1,pA0,pA1,t,true,true,true);     WAIT_BAR(2); RESC(); ROT();
    STEP(pA0,pA1,pB0,pB1,t+1,true,true,true);   WAIT_BAR(2); RESC(); ROT();
  }
  #undef CMASK
  #define CMASK(P0,P1,t) do{int jb_=(t)-(NT-4); if(jb_>=0)cmask(P0,P1,jb_,qrel,hi);}while(0)
  #define ENDW(tt) do{ if((tt)+3<NT){WAIT_BAR(2);} else if((tt)+2<NT){WAIT_BAR(1);} else {WAIT_BAR(0);} }while(0)
  for(;t+1<NT;t+=2){
    STEP(pB0,pB1,pA0,pA1,t,(t+3<NT),(t+1<NT),(t+1<NT));       ENDW(t);   RESC(); ROT();
    STEP(pA0,pA1,pB0,pB1,t+1,(t+4<NT),(t+2<NT),(t+2<NT));     ENDW(t+1); RESC(); ROT();
  }
  STEP(pB0,pB1,pA0,pA1,NT-1,false,false,false); RESC();
  { float sacc=pB0[0]+pB0[1]; _Pragma("unroll") for(int r=2;r<16;++r)sacc+=pB0[r]; _Pragma("unroll") for(int r=0;r<16;++r)sacc+=pB1[r]; l_reg+=sacc;
    pw0=(u32x4){PKW(pB0,0),PKW(pB0,2),PKW(pB0,4),PKW(pB0,6)};pw1=(u32x4){PKW(pB0,8),PKW(pB0,10),PKW(pB0,12),PKW(pB0,14)};pw2=(u32x4){PKW(pB1,0),PKW(pB1,2),PKW(pB1,4),PKW(pB1,6)};pw3=(u32x4){PKW(pB1,8),PKW(pB1,10),PKW(pB1,12),PKW(pB1,14)};
    SBAR(); pv(o,vb0+sl_cur,PAF(0),PAF(1),PAF(2),PAF(3)); }
  #undef PKW
  #undef PAF
  #undef VFR
  #undef PIN
  #undef MX3
  #undef GAPA
  #undef GAPB
  #undef EX
  #undef VRD
  #undef KRD
  #undef STEP
  #undef ENDW
  {auto rr=__builtin_amdgcn_permlane32_swap(__float_as_uint(l_reg),__float_as_uint(l_reg),false,false);l_reg=__uint_as_float(rr[0])+__uint_as_float(rr[1]);}
  if(hi==0)wsf[32+r32]=l_reg;asm volatile("s_waitcnt lgkmcnt(0)":::"memory");
  float rli[16];
  #pragma unroll
  for(int r=0;r<16;++r)rli[r]=__builtin_amdgcn_rcpf(wsf[32+crow(r,hi)]);
  bf16*Ow=O+(rowbase+q0+wid*QBLK)*OP+h*D;
  { bf16*stg=(bf16*)(shm+LDS_OST)+wid*2048;
    #pragma unroll
    for(int r=0;r<16;++r){const int orow=crow(r,hi);
      #pragma unroll
      for(int d0=0;d0<2;++d0)stg[orow*64+d0*32+r32]=__float2bfloat16(o[d0][r]*rli[r]);}
    asm volatile("s_waitcnt lgkmcnt(0)":::"memory");
    #pragma unroll
    for(int i=0;i<4;++i){const int row=i*8+(lane>>3),ch=lane&7; const u32x4 v=*(const u32x4*)(stg+row*64+ch*8); ATTN_STORE16(Ow+(long)row*OP+ch*8,v);} }
  asm volatile("s_waitcnt lgkmcnt(0)\n\ts_barrier":::"memory");
  #undef DMA_K
  #undef DMA_V
  #undef CMASK
  #undef START
  #undef RESC
  #undef ROT
}
constexpr int ATTN_LDS_BYTES=LDS_BYTES;
#undef SBAR
#undef WAIT_BAR
}

namespace attn3 {
using namespace attn_body;
constexpr int DV=128,KSL=8192,VSL=16384;
constexpr int L_K=0,L_V=NSLOT*KSL,L_WS=L_V+NSLOT*VSL,L_OST=L_WS+NW*64*4,L_BYTES=L_OST+NW*8192;
#define SBAR() __builtin_amdgcn_sched_barrier(0)
#define WAIT_BAR(N) asm volatile("s_waitcnt vmcnt(" #N ") lgkmcnt(0)\n\ts_barrier":::"memory")
__device__ __forceinline__ void qkt0(f32x16&p0,f32x16&p1,const char*Kslot,const bf16x8*qr,int r32,int hi){
  const char*kb=Kslot+hi*1024+r32*16;
  #pragma unroll
  for(int d0=0;d0<4;++d0){
    const bf16x8 b0=*reinterpret_cast<const bf16x8*>(kb+d0*2048);
    const bf16x8 b1=*reinterpret_cast<const bf16x8*>(kb+d0*2048+512);
    if(d0==0){p0=__builtin_amdgcn_mfma_f32_32x32x16_bf16(b0,qr[0],f32x16{},0,0,0);p1=__builtin_amdgcn_mfma_f32_32x32x16_bf16(b1,qr[0],f32x16{},0,0,0);}
    else{p0=__builtin_amdgcn_mfma_f32_32x32x16_bf16(b0,qr[d0],p0,0,0,0);p1=__builtin_amdgcn_mfma_f32_32x32x16_bf16(b1,qr[d0],p1,0,0,0);}}
}
__device__ __forceinline__ void pv4(f32x16*o,int vb,bf16x8 pa0,bf16x8 pa1,bf16x8 pa2,bf16x8 pa3){
  #pragma unroll
  for(int d0=0;d0<4;++d0){s16x4 lo[4],hi[4];
    #pragma unroll
    for(int ks=0;ks<4;++ks){
      asm volatile("ds_read_b64_tr_b16 %0,%1 offset:%c2":"=&v"(lo[ks]):"v"(vb),"i"(d0*4096+ks*1024):"memory");
      asm volatile("ds_read_b64_tr_b16 %0,%1 offset:%c2":"=&v"(hi[ks]):"v"(vb),"i"(d0*4096+ks*1024+512):"memory");}
    asm volatile("s_waitcnt lgkmcnt(0)":::"memory");SBAR();
    #define PK(k) (bf16x8){lo[k][0],lo[k][1],lo[k][2],lo[k][3],hi[k][0],hi[k][1],hi[k][2],hi[k][3]}
    o[d0]=__builtin_amdgcn_mfma_f32_32x32x16_bf16(pa0,PK(0),o[d0],0,0,0);
    o[d0]=__builtin_amdgcn_mfma_f32_32x32x16_bf16(pa1,PK(1),o[d0],0,0,0);
    o[d0]=__builtin_amdgcn_mfma_f32_32x32x16_bf16(pa2,PK(2),o[d0],0,0,0);
    o[d0]=__builtin_amdgcn_mfma_f32_32x32x16_bf16(pa3,PK(3),o[d0],0,0,0);
    #undef PK
  }
}
template<int THRL> __device__ __forceinline__ void attn_unit128(int b,int qb,const bf16*Q,const bf16*__restrict__ K,const bf16*__restrict__ V,bf16*O,char*shm){
  int tid_=threadIdx.x; asm volatile("" : "+v"(tid_));
  const int tid=tid_,lane=tid&63,r32=lane&31,hi=lane>>5; const int wid=__builtin_amdgcn_readfirstlane(tid>>6);
  const long rowbase=(long)b*SEQ; const int q0=qb*QB;
  const bf16*Qw=Q+(rowbase+q0+wid*QBLK)*QP;
  const bf16*Kh=K+rowbase*KP,*Vh=V+rowbase*VP;
  const unsigned lds0=(unsigned)(uintptr_t)shm;
  float*wsf=(float*)(shm+L_WS)+wid*64;
  const bf16*ksrc=Kh+(long)lane*KP+wid*8;
  const bf16*vsrc=Vh+(long)(16*(wid&3)+(lane>>2))*VP+(wid>>2)*32+(lane&3)*8;
  const unsigned kdst=lds0+L_K+wid*1024, vdst=lds0+L_V+wid*1024;
  #define DMA_K(t,slot) glds16(ksrc+(long)(t)*KVBLK*KP,(unsigned)__builtin_amdgcn_readfirstlane(kdst+(slot)))
  #define DMA_V(t,slot) do{ glds16(vsrc+(long)(t)*KVBLK*VP,(unsigned)__builtin_amdgcn_readfirstlane(vdst+2*(slot))); glds16(vsrc+(long)(t)*KVBLK*VP+64,(unsigned)__builtin_amdgcn_readfirstlane(vdst+2*(slot)+8192)); }while(0)
  const int vb0=(int)(lds0+L_V)+((lane>>4)&1)*32+(lane&3)*8+(4*hi+((lane&15)>>2))*64;
  const char*Kbase=shm+L_K; bf16x8 kf[8];
  const lds_cptr shm3=(lds_cptr)shm; const lds_cptr kp0=shm3+L_K+hi*1024+r32*16; const lds_cptr vp0=shm3+L_V+((lane>>4)&1)*32+(lane&3)*8+(4*hi+((lane&15)>>2))*64;
  const int NT=(q0+QB)/KVBLK;
  DMA_K(0,0);DMA_V(0,0);DMA_K(1,KSL);
  bf16x8 qr[4];
  #pragma unroll
  for(int d0=0;d0<4;++d0)qr[d0]=*reinterpret_cast<const bf16x8*>(&Qw[(long)r32*QP+d0*16+hi*8]);
  float mhat=0.f,l_reg=0.f;f32x16 o[4];o[0]=f32x16{};o[1]=f32x16{};o[2]=f32x16{};o[3]=f32x16{};
  const int qrel=wid*QBLK+r32;
  #define CMASK(P0,P1,t) do{int jb_=(t)-(NT-4); if(jb_>=0)cmask(P0,P1,jb_,qrel,hi);}while(0)
  bool resc=false;
  #define START(P0,P1) do{ const float rm=rowmax(P0,P1); resc=false; \
    { const float dl=rm; mhat=fadd_s(mhat,dl); \
      _Pragma("unroll") for(int r=0;r<16;++r){P0[r]=fsub_s(P0[r],dl);P1[r]=fsub_s(P1[r],dl);} } \
    _Pragma("unroll") for(int r=0;r<16;++r)P0[r]=__builtin_amdgcn_exp2f(P0[r]); }while(0)
  #define RESC() do{ if(resc){ asm volatile("s_waitcnt lgkmcnt(0)":::"memory"); \
      _Pragma("unroll") for(int d_=0;d_<4;++d_) _Pragma("unroll") for(int r=0;r<16;++r)o[d_][r]*=wsf[crow(r,hi)]; } }while(0)
  f32x16 pA0,pA1,pB0,pB1;
  int sl_prev=0,sl_cur=0,sl_next=KSL;
  #define ROT() do{sl_prev=sl_cur;sl_cur=sl_next;sl_next=(sl_next==(NSLOT-1)*KSL)?0:sl_next+KSL;}while(0)
  DMA_K(2,2*KSL);
  WAIT_BAR(4);
  qkt0(pA0,pA1,Kbase,qr,r32,hi);asm volatile("s_nop 15\n\ts_nop 7":"+v"(pA0),"+v"(pA1));CMASK(pA0,pA1,0);
  START(pA0,pA1);
  _Pragma("unroll") for(int r=0;r<16;++r)pA1[r]=__builtin_amdgcn_exp2f(pA1[r]);
  WAIT_BAR(0);
  DMA_K(3,0);DMA_V(1,KSL);
  ROT();
  kload8(kf,kp0+sl_cur);
  WAIT_BAR(3);
  s16x4 vlo[4],vhi[4]; u32x4 pw0,pw1,pw2,pw3;
  #define PKW(P,B) cvtpk_s(P[B],P[B+1])
  #define PAF(k) __builtin_bit_cast(bf16x8,pw##k)
  #define VFR(i) (bf16x8){vlo[i][0],vlo[i][1],vlo[i][2],vlo[i][3],vhi[i][0],vhi[i][1],vhi[i][2],vhi[i][3]}
  #define PIN(x) asm volatile("":"+v"(x))
  #define MX3(a,b,c) __builtin_fmaxf(__builtin_fmaxf((a),(b)),(c))
  #define GAPA(MF,A0,A1,A2,A3,W0,W1,PW) do{ MF; sacc+=A0; sacc+=A1; sacc+=A2; sacc+=A3; PIN(sacc); W0; W1; PIN(PW); SBAR(); }while(0)
  #define EX(v) __builtin_amdgcn_exp2f((v)-mhat)
  #define VRD(j) do{ vlo[(j)&3]=vtr(vp_+(((j)&3)*4096+((j)>>2)*1024)); vhi[(j)&3]=vtr(vp_+(((j)&3)*4096+((j)>>2)*1024+512)); }while(0)
  #define GAPB(j,PA,X,B) do{ o[(j)&3]=__builtin_amdgcn_mfma_f32_32x32x16_bf16(PA,VFR((j)&3),o[(j)&3],0,0,0); if((j)+4<16){VRD((j)+4);} X[B]=EX(X[B]); X[B+1]=EX(X[B+1]); PIN(X); SBAR(); }while(0)
  #define KRD(G,j) do{ if(G){ kload2(kf,kp0+sl_next,j); SBAR(); } }while(0)
  #define STEP(C0,C1,P0,P1,t,GK,GV,GL) do{ SBAR(); \
    const lds_cptr vp_=vp0+2*sl_prev; \
    float sacc=(P0[0]+P0[1]); \
    GAPA(C0=__builtin_amdgcn_mfma_f32_32x32x16_bf16(kf[0],qr[0],f32x16{},0,0,0), P0[2],P0[3],P0[4],P0[5],     pw0[0]=PKW(P0,0), pw0[1]=PKW(P0,2), pw0); \
    GAPA(C1=__builtin_amdgcn_mfma_f32_32x32x16_bf16(kf[1],qr[0],f32x16{},0,0,0), P0[6],P0[7],P0[8],P0[9],     pw0[2]=PKW(P0,4), pw0[3]=PKW(P0,6), pw0); \
    GAPA(C0=__builtin_amdgcn_mfma_f32_32x32x16_bf16(kf[2],qr[1],C0,0,0,0),   P0[10],P0[11],P0[12],P0[13], pw1[0]=PKW(P0,8), pw1[1]=PKW(P0,10), pw1); \
    GAPA(C1=__builtin_amdgcn_mfma_f32_32x32x16_bf16(kf[3],qr[1],C1,0,0,0),   P0[14],P0[15],P1[0],P1[1],   pw1[2]=PKW(P0,12),pw1[3]=PKW(P0,14), pw1); \
    VRD(0); SBAR(); GAPA(C0=__builtin_amdgcn_mfma_f32_32x32x16_bf16(kf[4],qr[2],C0,0,0,0),   P1[2],P1[3],P1[4],P1[5],     pw2[0]=PKW(P1,0), pw2[1]=PKW(P1,2), pw2); \
    VRD(1); SBAR(); GAPA(C1=__builtin_amdgcn_mfma_f32_32x32x16_bf16(kf[5],qr[2],C1,0,0,0),   P1[6],P1[7],P1[8],P1[9],     pw2[2]=PKW(P1,4), pw2[3]=PKW(P1,6), pw2); \
    VRD(2); SBAR(); GAPA(C0=__builtin_amdgcn_mfma_f32_32x32x16_bf16(kf[6],qr[3],C0,0,0,0),   P1[10],P1[11],P1[12],P1[13], pw3[0]=PKW(P1,8), pw3[1]=PKW(P1,10), pw3); \
    VRD(3); SBAR(); GAPA(C1=__builtin_amdgcn_mfma_f32_32x32x16_bf16(kf[7],qr[3],C1,0,0,0),   P1[14],P1[15],0.f,0.f,       pw3[2]=PKW(P1,12),pw3[3]=PKW(P1,14), pw3); \
    l_reg+=sacc; \
    if(GK){DMA_K((t)+3,sl_cur);} if(GV){DMA_V((t)+1,sl_next);} \
    CMASK(C0,C1,t); \
    { float a=MX3(C0[0],C0[1],C1[0]),b=MX3(C0[2],C0[3],C1[1]); a=MX3(a,C1[2],C1[3]); \
      _Pragma("unroll") for(int r=4;r<16;r+=4){a=MX3(a,C0[r],C0[r+1]);b=MX3(b,C0[r+2],C0[r+3]);a=MX3(a,C1[r],C1[r+1]);b=MX3(b,C1[r+2],C1[r+3]);} \
      float rm=__builtin_fmaxf(a,b); { auto rr=__builtin_amdgcn_permlane32_swap(__float_as_uint(rm),__float_as_uint(rm),false,false); rm=__builtin_fmaxf(__uint_as_float(rr[0]),__uint_as_float(rr[1])); } \
      rm-=mhat; \
      resc=false; \
      if(__builtin_expect(__any(rm>(float)THRL),0)){ const float dl=__builtin_fmaxf(rm,0.f); mhat+=dl; \
        const float f=__builtin_amdgcn_exp2f(-dl); l_reg*=f; if(hi==0)wsf[r32]=f; resc=true; } } \
    SBAR(); \
    GAPB(0,PAF(0),C0,0); GAPB(1,PAF(0),C0,2); GAPB(2,PAF(0),C0,4); GAPB(3,PAF(0),C0,6); \
    KRD(GL,0); GAPB(4,PAF(1),C0,8); GAPB(5,PAF(1),C0,10); KRD(GL,1); GAPB(6,PAF(1),C0,12); GAPB(7,PAF(1),C0,14); \
    KRD(GL,2); GAPB(8,PAF(2),C1,0); GAPB(9,PAF(2),C1,2); KRD(GL,3); GAPB(10,PAF(2),C1,4); GAPB(11,PAF(2),C1,6); \
    GAPB(12,PAF(3),C1,8); GAPB(13,PAF(3),C1,10); GAPB(14,PAF(3),C1,12); GAPB(15,PAF(3),C1,14); \
    }while(0)
  int t=1;
  #undef CMASK
  #define CMASK(P0,P1,t) do{}while(0)
  for(;t+5<NT;t+=2){
    STEP(pB0,pB1,pA0,pA1,t,true,true,true);     WAIT_BAR(3); RESC(); ROT();
    STEP(pA0,pA1,pB0,pB1,t+1,true,true,true);   WAIT_BAR(3); RESC(); ROT();
  }
  #undef CMASK
  #define CMASK(P0,P1,t) do{int jb_=(t)-(NT-4); if(jb_>=0)cmask(P0,P1,jb_,qrel,hi);}while(0)
  #define ENDW(tt) do{ if((tt)+3<NT){WAIT_BAR(3);} else if((tt)+2<NT){WAIT_BAR(2);} else {WAIT_BAR(0);} }while(0)
  for(;t+1<NT;t+=2){
    STEP(pB0,pB1,pA0,pA1,t,(t+3<NT),(t+1<NT),(t+1<NT));       ENDW(t);   RESC(); ROT();
    STEP(pA0,pA1,pB0,pB1,t+1,(t+4<NT),(t+2<NT),(t+2<NT));     ENDW(t+1); RESC(); ROT();
  }
  STEP(pB0,pB1,pA0,pA1,NT-1,false,false,false); RESC();
  { float sacc=pB0[0]+pB0[1]; _Pragma("unroll") for(int r=2;r<16;++r)sacc+=pB0[r]; _Pragma("unroll") for(int r=0;r<16;++r)sacc+=pB1[r]; l_reg+=sacc;
    pw0=(u32x4){PKW(pB0,0),PKW(pB0,2),PKW(pB0,4),PKW(pB0,6)};pw1=(u32x4){PKW(pB0,8),PKW(pB0,10),PKW(pB0,12),PKW(pB0,14)};pw2=(u32x4){PKW(pB1,0),PKW(pB1,2),PKW(pB1,4),PKW(pB1,6)};pw3=(u32x4){PKW(pB1,8),PKW(pB1,10),PKW(pB1,12),PKW(pB1,14)};
    SBAR(); pv4(o,vb0+2*sl_cur,PAF(0),PAF(1),PAF(2),PAF(3)); }
  #undef PKW
  #undef PAF
  #undef VFR
  #undef PIN
  #undef MX3
  #undef GAPA
  #undef GAPB
  #undef EX
  #undef VRD
  #undef KRD
  #undef STEP
  #undef ENDW
  {auto rr=__builtin_amdgcn_permlane32_swap(__float_as_uint(l_reg),__float_as_uint(l_reg),false,false);l_reg=__uint_as_float(rr[0])+__uint_as_float(rr[1]);}
  if(hi==0)wsf[32+r32]=l_reg;asm volatile("s_waitcnt lgkmcnt(0)":::"memory");
  float rli[16];
  #pragma unroll
  for(int r=0;r<16;++r)rli[r]=__builtin_amdgcn_rcpf(wsf[32+crow(r,hi)]);
  bf16*Ow=O+(rowbase+q0+wid*QBLK)*OP;
  { bf16*stg=(bf16*)(shm+L_OST)+wid*4096;
    #pragma unroll
    for(int r=0;r<16;++r){const int orow=crow(r,hi);
      #pragma unroll
      for(int d0=0;d0<4;++d0)stg[orow*128+d0*32+r32]=__float2bfloat16(o[d0][r]*rli[r]);}
    asm volatile("s_waitcnt lgkmcnt(0)":::"memory");
    #pragma unroll
    for(int i=0;i<8;++i){const int row=i*4+(lane>>4),ch=lane&15; const u32x4 v=*(const u32x4*)(stg+row*128+ch*8); ATTN_STORE16(Ow+(long)row*OP+ch*8,v);} }
  asm volatile("s_waitcnt lgkmcnt(0)\n\ts_barrier":::"memory");
  #undef DMA_K
  #undef DMA_V
  #undef CMASK
  #undef START
  #undef RESC
  #undef ROT
}
#undef SBAR
#undef WAIT_BAR
}

#define GAS __attribute__((address_space(1)))
#define LAS __attribute__((address_space(3)))
typedef unsigned short bf16;
typedef unsigned v4u __attribute__((ext_vector_type(4)));
typedef unsigned v2u __attribute__((ext_vector_type(2)));
typedef float f32x4 __attribute__((ext_vector_type(4)));
typedef short bf16x8 __attribute__((ext_vector_type(8)));
typedef GAS unsigned gu32;
#define RLX_AGENT __ATOMIC_RELAXED, __HIP_MEMORY_SCOPE_AGENT
#define LDS_WAIT() asm volatile("s_waitcnt lgkmcnt(0)" ::: "memory")
#define VM_WAIT() asm volatile("s_waitcnt vmcnt(0)" ::: "memory")

#ifndef P1_HOSTS_P0B
#define P1_HOSTS_P0B 1
#endif
constexpr int NWAVES = 8;
constexpr int DM = 2048, NBATCH = 8, SEQ = 2048, M = NBATCH * SEQ;
constexpr int IN_COLS = 5648;
constexpr int NIN = 5632;
constexpr int NIN_G = 5888;
constexpr int UC_Z = 0, UC_XBC = 1024, UC_Q = 2560, UC_K = 3584, UC_V = 4608;
constexpr int NE = 32, EH = 1024;
constexpr float EPS = 1e-6f;
constexpr float F8_WSCALE = 64.f;
constexpr float Y8_SCALE = 16.f;
constexpr size_t MiB = 1u << 20;

constexpr int RING_OFF = 0, RING_BYTES = 131072;
constexpr int LDSCTL_OFF = 159744, MISC_OFF = LDSCTL_OFF + 320;
constexpr int LDS_BYTES = 163840;

namespace mp {
constexpr size_t ctl = 0, small = 1 * MiB, wr = 2 * MiB, rope = 3 * MiB, dt = 5 * MiB, win = 6 * MiB, wout = 30 * MiB, wgu = 38 * MiB, wd = 166 * MiB;
constexpr size_t xn = 230 * MiB, xn2 = 230 * MiB, ycat = 294 * MiB, u16 = 358 * MiB, qn = 534 * MiB, kn = 566 * MiB, xbc = 598 * MiB, o1 = 646 * MiB, o2 = 678 * MiB, ys = 710 * MiB;
constexpr size_t y = 358 * MiB, hid = 518 * MiB;
constexpr size_t lst = 742 * MiB;
constexpr size_t xn8 = 748 * MiB;
constexpr size_t END = 780 * MiB;
}
constexpr size_t CTL_ZERO_BYTES = 1 * MiB;
constexpr int CW_TMO = 0, CW_CODE = 1, CW_BAR = 4096;
constexpr int CW_Q0 = 66560;
constexpr int CW_LOC = 8192, CW_RANK = 10240;
constexpr int CW_CNT = 65536;
constexpr int LCAP = 16384;
constexpr int SLOT_CAP = 40960;
constexpr int TAB_OFF = LDSCTL_OFF + 1024;
constexpr size_t SM_TOK_E = 0, SM_TOK_POS = 131072, SM_TOK_W = 262144, SM_TOK_SLOT = 393216, SM_RINV = 524288, SM_SLOT_W = 655360, SM_SLOT_R = 851968, SM_END = 1048576;

__device__ __forceinline__ void st16_wt(void* p, v4u v) { asm volatile("global_store_dwordx4 %0, %1, off sc1\n\ts_nop 1" :: "v"(p), "v"(v) : "memory"); }
__device__ __forceinline__ unsigned f2bf(float f) { unsigned u = __builtin_bit_cast(unsigned, f); return (u + 0x7fffu + ((u >> 16) & 1u)) >> 16; }
typedef float f32x2_pk __attribute__((ext_vector_type(2))); typedef __bf16 bf16x2_pk __attribute__((ext_vector_type(2)));
__device__ __forceinline__ unsigned pk2(float lo, float hi) { f32x2_pk v = {lo, hi}; bf16x2_pk b = __builtin_convertvector(v, bf16x2_pk); return __builtin_bit_cast(unsigned, b); }
__device__ __forceinline__ float bf2f(unsigned short b) { return __builtin_bit_cast(float, (unsigned)b << 16); }
__device__ __forceinline__ float wave_sum(float v) {
#pragma unroll
    for (int o = 1; o < 64; o <<= 1) v += __shfl_xor(v, o);
    return v;
}

#define XB_TMO      128
#define XB_XCNT(j)  (256  + 64 * (j))
#define XB_XSUB(j)  (1280 + 64 * (j))
#define XB_XGEN(j)  (2304 + 64 * (j))
#define XB_TOP      3328
#define XB_TOPGEN   3392
#define XCD_BAR_WORDS 3456
#define XB_SPIN_CAP (1u << 18)

__device__ __forceinline__ unsigned xb_ld(unsigned* p)              { return __hip_atomic_load(p, __ATOMIC_RELAXED, __HIP_MEMORY_SCOPE_AGENT); }
__device__ __forceinline__ unsigned xb_add(unsigned* p, unsigned v) { return __hip_atomic_fetch_add(p, v, __ATOMIC_RELAXED, __HIP_MEMORY_SCOPE_AGENT); }
__device__ __forceinline__ unsigned xb_xcc_id() { return (unsigned)__builtin_amdgcn_s_getreg((3 << 11) | 20) & 0xFu; }
#define XB_SPIN(cond, bar) do { unsigned _sp = 0; while (cond) { __builtin_amdgcn_s_sleep(1); \
    if ((++_sp & 255u) == 0u) { if (xb_ld(&(bar)[XB_TMO])) break; if (_sp > XB_SPIN_CAP) { atomicAdd(&(bar)[XB_TMO], 1u); break; } } } } while (0)

struct XcdBarrier {
    unsigned* bar; unsigned x;
    volatile LAS unsigned* st;
};

__device__ __forceinline__ XcdBarrier xcd_barrier_post(unsigned* bar, volatile LAS unsigned* st) {
    XcdBarrier b; b.bar = bar; b.x = xb_xcc_id(); b.st = st;
    if (threadIdx.x == 0) (void)xb_add(&bar[XB_XCNT(b.x)], 1u);
    return b;
}
__device__ __forceinline__ void xcd_barrier_complete(unsigned* bar, unsigned x, unsigned& nloc, unsigned& nx) {
    const unsigned G = gridDim.x * gridDim.y * gridDim.z;
    unsigned sum, cnt, mine, sp = 0u;
    for (;;) {
        sum = 0u; cnt = 0u; mine = 0u;
#pragma unroll
        for (unsigned j = 0; j < 16; ++j) { const unsigned c = xb_ld(&bar[XB_XCNT(j)]); sum += c; cnt += (c > 0u) ? 1u : 0u; mine = (j == x) ? c : mine; }
        if (sum == G) break;
        __builtin_amdgcn_s_sleep(1);
        if ((++sp & 255u) == 0u) { if (xb_ld(&bar[XB_TMO])) break; if (sp > XB_SPIN_CAP) { atomicAdd(&bar[XB_TMO], 1u); break; } }
    }
    nloc = mine > 0u ? mine : 1u; nx = cnt > 0u ? cnt : 1u;
}

__device__ __forceinline__ void xcd_barrier(const XcdBarrier& b) {
    asm volatile("s_waitcnt vmcnt(0)" ::: "memory");
    __syncthreads();
    if (threadIdx.x == 0) {
        unsigned* bar = b.bar;
        __builtin_amdgcn_s_waitcnt(0);
        unsigned nloc = b.st[0], nx = b.st[1];
        if (nloc == 0u) { xcd_barrier_complete(bar, b.x, nloc, nx); b.st[0] = nloc; b.st[1] = nx; }
        const unsigned old = xb_add(&bar[XB_XSUB(b.x)], 1u);
        const unsigned gen = old / nloc;
        if (old + 1u == (gen + 1u) * nloc) {
            __builtin_amdgcn_fence(__ATOMIC_RELEASE, "agent");
            asm volatile("s_waitcnt vmcnt(0)" ::: "memory");
            const unsigned og = xb_add(&bar[XB_TOP], 1u);
            const unsigned tg = og / nx;
            if (og + 1u == (tg + 1u) * nx) xb_add(&bar[XB_TOPGEN], 1u);
            else XB_SPIN(xb_ld(&bar[XB_TOPGEN]) == tg, bar);
            __builtin_amdgcn_fence(__ATOMIC_ACQUIRE, "agent");
            xb_add(&bar[XB_XGEN(b.x)], 1u);
            asm volatile("s_waitcnt vmcnt(0)" ::: "memory");
        } else {
            XB_SPIN(xb_ld(&bar[XB_XGEN(b.x)]) == gen, bar);
            __builtin_amdgcn_fence(__ATOMIC_ACQUIRE, "agent");
            asm volatile("s_waitcnt vmcnt(0)" ::: "memory");
        }
    }
    __syncthreads();
}

__device__ __forceinline__ void xcd_local_barrier(unsigned* bar, unsigned* ctr, unsigned n) {
    asm volatile("s_waitcnt vmcnt(0)" ::: "memory");
    __syncthreads();
    if (threadIdx.x == 0) {
        __builtin_amdgcn_s_waitcnt(0);
        const unsigned old = xb_add(ctr, 1u), target = (old / n + 1u) * n;
        XB_SPIN(xb_ld(ctr) < target, bar);
        __builtin_amdgcn_fence(__ATOMIC_ACQUIRE, "agent");
        asm volatile("s_waitcnt vmcnt(0)" ::: "memory");
    }
    __syncthreads();
}

struct XbTok { unsigned gen, tg; int role; };
__device__ __forceinline__ void xcd_barrier_arrive(const XcdBarrier& b, XbTok& t) {
    asm volatile("s_waitcnt vmcnt(0)" ::: "memory");
    __syncthreads();
    t.gen = 0u; t.tg = 0u; t.role = 0;
    if (threadIdx.x == 0) {
        unsigned* bar = b.bar;
        __builtin_amdgcn_s_waitcnt(0);
        unsigned nloc = b.st[0], nx = b.st[1];
        if (nloc == 0u) { xcd_barrier_complete(bar, b.x, nloc, nx); b.st[0] = nloc; b.st[1] = nx; }
        const unsigned old = xb_add(&bar[XB_XSUB(b.x)], 1u);
        const unsigned gen = old / nloc; t.gen = gen;
        if (old + 1u == (gen + 1u) * nloc) {
            __builtin_amdgcn_fence(__ATOMIC_RELEASE, "agent");
            asm volatile("s_waitcnt vmcnt(0)" ::: "memory");
            const unsigned og = xb_add(&bar[XB_TOP], 1u);
            const unsigned tg = og / nx; t.tg = tg; t.role = 1;
            if (og + 1u == (tg + 1u) * nx) xb_add(&bar[XB_TOPGEN], 1u);
        }
    }
}
__device__ __forceinline__ void xcd_barrier_wait(const XcdBarrier& b, const XbTok& t) {
    if (threadIdx.x == 0) {
        unsigned* bar = b.bar;
        if (t.role == 1) { XB_SPIN(xb_ld(&bar[XB_TOPGEN]) == t.tg, bar);
            __builtin_amdgcn_fence(__ATOMIC_ACQUIRE, "agent");
            xb_add(&bar[XB_XGEN(b.x)], 1u);
            asm volatile("s_waitcnt vmcnt(0)" ::: "memory");
        } else { XB_SPIN(xb_ld(&bar[XB_XGEN(b.x)]) == t.gen, bar);
            __builtin_amdgcn_fence(__ATOMIC_ACQUIRE, "agent");
            asm volatile("s_waitcnt vmcnt(0)" ::: "memory"); }
    }
    __syncthreads();
}

struct Frame {
    LAS unsigned char* lds;
    volatile LAS unsigned* MISC;
    gu32* ctl;
    int tid, lane, wave;
    int vcu, G;
    int cid;
    unsigned char* ws;
};

struct TItem { const float* W; bf16* base; const float* kscale; int ldw, nvalid, k0, n0, kind, pitch, f8; };
constexpr int TI_PC = 36, TI_P1 = 8 * TI_PC, TI_BYTES = 16 * TI_P1 * 4;
template <int NI> __device__ __forceinline__ void titem_issue(const TItem& d, int lane, f32x4 (&ld)[NI]) {
    const int nq = d.n0 + 4 * (lane & 7); const bool ok = nq < d.nvalid;
#pragma unroll
    for (int i = 0; i < NI; ++i) ld[i] = ok ? __builtin_nontemporal_load((const GAS f32x4*)(d.W + (size_t)(d.k0 + (lane >> 3) + 8 * i) * d.ldw + nq)) : (f32x4){0.f, 0.f, 0.f, 0.f};
}
template <int NI> __device__ __forceinline__ void titem_finish(const TItem& d, int lane, const f32x4 (&ld)[NI], LAS float* scr, bf16* WIN, bf16* WDT) {
#pragma unroll
    for (int i = 0; i < NI; ++i) { const int k = (lane >> 3) + 8 * i; *(LAS f32x4*)(scr + (k % NI) * TI_P1 + (k / NI) * TI_PC + 4 * (lane & 7)) = ld[i]; }
    LDS_WAIT(); asm volatile("" ::: "memory");
    const int c = lane & 7;
    if constexpr (NI == 16) {
#pragma unroll
        for (int j = 0; j < 4; ++j) { const int nl = (lane >> 3) + 8 * j, n = d.n0 + nl; const LAS float* s = scr + c * TI_PC + nl;
            const size_t rowi = d.kind == 3 ? (size_t)((n & ~255) + ((n >> 3) & 1) * 128 + ((n >> 6) & 3) * 32 + ((n >> 4) & 3) * 8 + (n & 7))
                                            : (size_t)((n >> 7) * 256 + (n & 127));
            v4u q; q.x = pg8::cvt4_fp8(s[0 * TI_P1] * F8_WSCALE, s[1 * TI_P1] * F8_WSCALE, s[2 * TI_P1] * F8_WSCALE, s[3 * TI_P1] * F8_WSCALE); q.y = pg8::cvt4_fp8(s[4 * TI_P1] * F8_WSCALE, s[5 * TI_P1] * F8_WSCALE, s[6 * TI_P1] * F8_WSCALE, s[7 * TI_P1] * F8_WSCALE);
            q.z = pg8::cvt4_fp8(s[8 * TI_P1] * F8_WSCALE, s[9 * TI_P1] * F8_WSCALE, s[10 * TI_P1] * F8_WSCALE, s[11 * TI_P1] * F8_WSCALE); q.w = pg8::cvt4_fp8(s[12 * TI_P1] * F8_WSCALE, s[13 * TI_P1] * F8_WSCALE, s[14 * TI_P1] * F8_WSCALE, s[15 * TI_P1] * F8_WSCALE);
            if (n < d.nvalid) __builtin_nontemporal_store(q, (GAS v4u*)((unsigned char*)d.base + rowi * d.pitch + d.k0 + 16 * c)); }
    } else {
#pragma unroll
        for (int j = 0; j < 4; ++j) { const int nl = (lane >> 3) + 8 * j, n = d.n0 + nl; const LAS float* s = scr + c * TI_PC + nl;
            v4u o; o.x = pk2(s[0 * TI_P1], s[1 * TI_P1]); o.y = pk2(s[2 * TI_P1], s[3 * TI_P1]); o.z = pk2(s[4 * TI_P1], s[5 * TI_P1]); o.w = pk2(s[6 * TI_P1], s[7 * TI_P1]);
            bf16* row;
            if (d.kind == 0) row = n < 2560 ? WIN + (size_t)n * DM : (n < 2576 ? WIN + (size_t)(NIN + n - 2560) * DM : WIN + (size_t)(n - 16) * DM);
            else row = d.base + (size_t)n * d.pitch;
            if (n < d.nvalid) *(GAS v4u*)(row + d.k0 + 8 * c) = o; }
    }
    LDS_WAIT(); asm volatile("" ::: "memory");
}

struct Args { const void* in[26]; float* out; unsigned char* ws; int ph_lo, ph_hi, li, p0_mask, rep_phase, pad; };
typedef const __attribute__((address_space(4))) Args* KA;

constexpr int P0B_NBLK = 3 * NE * 128, P0B_NSUB = 4 * P0B_NBLK;
__device__ __forceinline__ void p0b_blocks(Frame& F, KA args, int first, int nq, int gstride = 1) {
    const int lane = F.lane;
    const float* w_gate = (const float*)args->in[23]; const float* w_up = (const float*)args->in[24]; const float* w_down = (const float*)args->in[25];
    bf16* WGU = (bf16*)(F.ws + mp::wgu); bf16* WD = (bf16*)(F.ws + mp::wd);
    LAS float* scr = (LAS float*)(F.lds + F.wave * TI_BYTES);
    auto decodeB = [&](int q) -> TItem {
        const int g = first + q * gstride, cb = g >> 2, i = g & 3;
        if (cb < 8192) { const int up = cb >> 12, r = cb & 4095, e = r >> 7, kb = (r >> 3) & 15, nb = r & 7;
            return TItem{(up ? w_up : w_gate) + (size_t)e * DM * EH, (bf16*)((unsigned char*)WGU + (size_t)e * 2048 * DM + (up ? (size_t)128 * DM : 0)), nullptr, EH, EH, 128 * kb, 128 * nb + 32 * i, 2, DM, 1}; }
        const int r = cb - 8192, e = r >> 7, kb = (r >> 4) & 7, nb = r & 15;
        return TItem{w_down + (size_t)e * EH * DM, (bf16*)((unsigned char*)WD + (size_t)e * DM * EH), nullptr, DM, DM, 128 * kb, 128 * nb + 32 * i, 3, EH, 1};
    };
    if (nq <= 0) return;
    TItem d0 = decodeB(0), d1 = d0, d2 = d0; f32x4 l0[16], l1[16], l2[16];
    titem_issue<16>(d0, lane, l0);
    if (nq > 1) { d1 = decodeB(1); titem_issue<16>(d1, lane, l1); }
    for (int q = 0; q < nq; q += 3) {
        if (q + 2 < nq) { d2 = decodeB(q + 2); titem_issue<16>(d2, lane, l2); }
        titem_finish<16>(d0, lane, l0, scr, nullptr, nullptr);
        if (q + 1 >= nq) break;
        if (q + 3 < nq) { d0 = decodeB(q + 3); titem_issue<16>(d0, lane, l0); }
        titem_finish<16>(d1, lane, l1, scr, nullptr, nullptr);
        if (q + 2 >= nq) break;
        if (q + 4 < nq) { d1 = decodeB(q + 4); titem_issue<16>(d1, lane, l1); }
        titem_finish<16>(d2, lane, l2, scr, nullptr, nullptr);
    }
}
constexpr int P1_UNITS = (M / 256) * (NIN_G / 256);
#if P1_HOSTS_P0B == 2
constexpr int P1_INLOOP_BLOCKS = P1_UNITS * NWAVES;
static_assert(P0B_NBLK - P1_INLOOP_BLOCKS == 64 * NWAVES, "the 64 CUs with one GEMM unit less take one more block per wave");
#endif
#ifndef P1_NCLASS
#define P1_NCLASS 3
#endif
__device__ __forceinline__ void p1_convert_share(Frame& F, KA args, int part) {
    const int c = F.cid, xcd = c & 7, l = c >> 3, lclass = xcd % P1_NCLASS;
    const int ex = l < 24 ? 0 : 12, q = 21 + ex;
    const int base = xcd * (P0B_NSUB / 8);
    const int first = l < 24 ? base + l * (NWAVES * 21) : base + 24 * NWAVES * 21 + (l - 24) * (NWAVES * 33);
    int lo, hi;
    if (part == 0) { lo = 0; hi = lclass == 0 ? q : ex; } else if (part == lclass) { lo = ex; hi = q; } else return;
    p0b_blocks(F, args, first + F.wave * q + lo, hi - lo);
}

__device__ __forceinline__ void p0_prologue(Frame& F, KA args) {
    const int gw = F.vcu * NWAVES + F.wave, NGW = F.G * NWAVES, lane = F.lane;
    const float* w_in = (const float*)args->in[3]; const float* w_out = (const float*)args->in[17];
    bf16* WIN = (bf16*)(F.ws + mp::win); bf16* WDT = nullptr; bf16* WOUT = (bf16*)(F.ws + mp::wout);
    constexpr int NB_IN = (IN_COLS + 31) / 32;
    constexpr int I_IN = (DM / 64) * NB_IN, I_OUT = (DM / 64) * (DM / 32), NITEMS_A = I_IN + I_OUT;
    LAS float* scr = (LAS float*)(F.lds + F.wave * TI_BYTES);
    auto decodeA = [&](int it) -> TItem {
        int r = it;
        if (r < I_IN) { const int kb = r / NB_IN, nb = r % NB_IN; return TItem{w_in, WIN, nullptr, IN_COLS, IN_COLS, 64 * kb, 32 * nb, 0, DM, 0}; }
        r -= I_IN; const int kb = r / (DM / 32), nb = r % (DM / 32); return TItem{w_out, WOUT, nullptr, DM, DM, 64 * kb, 32 * nb, 1, DM, 0};
    };
    if (gw < NITEMS_A) {
        TItem dc = decodeA(gw); f32x4 la[8], lb[8];
        titem_issue<8>(dc, lane, la);
        for (int it = gw; it < NITEMS_A; it += NGW) {
            const int nx = it + NGW; TItem dn = dc;
            if (nx < NITEMS_A) { dn = decodeA(nx); titem_issue<8>(dn, lane, lb); }
            titem_finish<8>(dc, lane, la, scr, WIN, WDT);
            dc = dn;
#pragma unroll
            for (int i = 0; i < 8; ++i) la[i] = lb[i];
        }
    }
#if !P1_HOSTS_P0B
    p0b_blocks(F, args, gw * (P0B_NSUB / NGW), P0B_NSUB / NGW);
#endif
}

__device__ __forceinline__ void p0_xn1(Frame& F, KA args) {
    const int lane = F.lane;
    const float* x = (const float*)args->in[0]; const float* ln1 = (const float*)args->in[2]; bf16* XN = (bf16*)(F.ws + mp::xn);
    for (int it = 0; it < 4; ++it) { const int m0 = (F.vcu >> 5) * 2048 + it * 512 + ((F.vcu & 31) * NWAVES + F.wave) * 2;
        f32x4 v[2][8];
#pragma unroll
        for (int rr = 0; rr < 2; ++rr)
#pragma unroll
            for (int j = 0; j < 8; ++j) v[rr][j] = __builtin_nontemporal_load((const GAS f32x4*)(x + (size_t)(m0 + rr) * DM) + lane + 64 * j);
#pragma unroll
        for (int rr = 0; rr < 2; ++rr) { float s = 0.f;
#pragma unroll
            for (int j = 0; j < 8; ++j) s += (v[rr][j].x * v[rr][j].x + v[rr][j].y * v[rr][j].y) + (v[rr][j].z * v[rr][j].z + v[rr][j].w * v[rr][j].w);
            const float r = 1.0f / sqrtf(wave_sum(s) * (1.f / DM) + EPS);
            GAS v2u* o8 = (GAS v2u*)(XN + (size_t)(m0 + rr) * DM) + lane; const GAS f32x4* wr = (const GAS f32x4*)ln1 + lane;
#pragma unroll
            for (int j = 0; j < 8; ++j) { const f32x4 ww = wr[64 * j]; v2u o; o.x = pk2(v[rr][j].x * r * ww.x, v[rr][j].y * r * ww.y); o.y = pk2(v[rr][j].z * r * ww.z, v[rr][j].w * r * ww.w); o8[64 * j] = o; } }
    }
}


__device__ __forceinline__ void p0_rope(Frame& F, KA args) {
    const int gt = (F.vcu * NWAVES + F.wave) * 64 + F.lane, NGT = F.G * NWAVES * 64;
    const int* pos = (const int*)args->in[1]; float* rope = (float*)(F.ws + mp::rope);
    for (int i = gt; i < M * 8; i += NGT) { const int m = i >> 3, j = i & 7;
        const float inv_freq = powf(500000.0f, -(float)(2 * j) / 16.0f);
        const float ang = (float)pos[m] * inv_freq;
        rope[m * 16 + j] = cosf(ang); rope[m * 16 + 8 + j] = sinf(ang); }
}

__device__ __forceinline__ void p2_qknorm(Frame& F, KA args) {
    const int gw = F.vcu * NWAVES + F.wave, NGW = F.G * NWAVES, lane = F.lane;
    const bf16* U16 = (const bf16*)(F.ws + mp::u16); const float* rope = (const float*)(F.ws + mp::rope);
    bf16* QN = (bf16*)(F.ws + mp::qn); bf16* KN = (bf16*)(F.ws + mp::kn);
    const float* qw = (const float*)args->in[10]; const float* kw = (const float*)args->in[11];
    const int sub = lane & 7;
    float wq[8], wk[8];
#pragma unroll
    for (int j = 0; j < 8; ++j) { wq[j] = qw[sub * 8 + j] * attn_body::C2; wk[j] = kw[sub * 8 + j]; }
    for (int it = 0; it < 2; ++it) { const int m0 = (F.vcu >> 5) * 2048 + it * 1024 + ((F.vcu & 31) * NWAVES + F.wave) * 4;
        v4u raw[4][4]; f32x4 rp[4][4];
#pragma unroll
        for (int rr = 0; rr < 4; ++rr) {
#pragma unroll
            for (int pc = 0; pc < 4; ++pc) raw[rr][pc] = __builtin_nontemporal_load((const GAS v4u*)(U16 + (size_t)(m0 + rr) * NIN + ((pc >> 1) ? UC_K : UC_Q) + (pc & 1) * 512 + lane * 8));
#pragma unroll
            for (int q = 0; q < 4; ++q) rp[rr][q] = *(const GAS f32x4*)(rope + (size_t)(m0 + rr) * 16 + 4 * q);
        }
#pragma unroll
        for (int rr = 0; rr < 4; ++rr) {
            const int m = m0 + rr;
            const float cs[8] = {rp[rr][0].x, rp[rr][0].y, rp[rr][0].z, rp[rr][0].w, rp[rr][1].x, rp[rr][1].y, rp[rr][1].z, rp[rr][1].w};
            const float sn[8] = {rp[rr][2].x, rp[rr][2].y, rp[rr][2].z, rp[rr][2].w, rp[rr][3].x, rp[rr][3].y, rp[rr][3].z, rp[rr][3].w};
#pragma unroll
            for (int pc = 0; pc < 4; ++pc) {
                const int isk = pc >> 1, col = (pc & 1) * 512 + lane * 8;
                const v4u rw = raw[rr][pc];
                float v[8];
                v[0] = __builtin_bit_cast(float, rw.x << 16); v[1] = __builtin_bit_cast(float, rw.x & 0xffff0000u); v[2] = __builtin_bit_cast(float, rw.y << 16); v[3] = __builtin_bit_cast(float, rw.y & 0xffff0000u);
                v[4] = __builtin_bit_cast(float, rw.z << 16); v[5] = __builtin_bit_cast(float, rw.z & 0xffff0000u); v[6] = __builtin_bit_cast(float, rw.w << 16); v[7] = __builtin_bit_cast(float, rw.w & 0xffff0000u);
                float ss = 0.f;
#pragma unroll
                for (int j = 0; j < 8; ++j) ss += v[j] * v[j];
                ss += __shfl_xor(ss, 1); ss += __shfl_xor(ss, 2); ss += __shfl_xor(ss, 4);
                const float r = 1.0f / sqrtf(ss * (1.f / 64.f) + EPS);
                float y[8];
#pragma unroll
                for (int j = 0; j < 8; ++j) y[j] = v[j] * r * (isk ? wk[j] : wq[j]);
#pragma unroll
                for (int j = 0; j < 8; ++j) { const float pv = __shfl_xor(y[j], 1);
                    if (sub == 0) y[j] = y[j] * cs[j] - pv * sn[j]; else if (sub == 1) y[j] = y[j] * cs[j] + pv * sn[j]; }
                v4u o; o.x = pk2(y[0], y[1]); o.y = pk2(y[2], y[3]); o.z = pk2(y[4], y[5]); o.w = pk2(y[6], y[7]);
                *(GAS v4u*)((isk ? KN : QN) + (size_t)m * 1024 + col) = o;
            }
        }
    }
}

struct AttnOrder { int vcu;
  __device__ __forceinline__ bool next(int i, int& bh, int& qb) const { if (i >= 4) return false; const int idx = vcu & 31, j = (i + (idx >> 2)) & 3; bh = vcu >> 1; qb = (j >> 1) * 4 + ((idx & 1) ? 1 + (j & 1) : (j & 1) * 3); return true; } };
__device__ __forceinline__ void p3_attention(Frame& F, KA args, unsigned char* lds_generic) {
    const attn_body::bf16* QN = (const attn_body::bf16*)(F.ws + mp::qn); const attn_body::bf16* KN = (const attn_body::bf16*)(F.ws + mp::kn);
    const attn_body::bf16* U16 = (const attn_body::bf16*)(F.ws + mp::u16); attn_body::bf16* O1 = (attn_body::bf16*)(F.ws + mp::o1); attn_body::bf16* O2 = (attn_body::bf16*)(F.ws + mp::o2);
    AttnOrder S{F.vcu}; int bh, qb;
    for (int i = 0; S.next(i, bh, qb); ++i) {
        const int b = bh >> 4, h = (bh >> 1) & 7, comp = bh & 1;
        attn3::attn_unit128<8>(b, qb, QN + (h * 2 + comp) * 64, KN + (h * 2 + comp) * 64, U16 + UC_V + h * 128, (comp ? O2 : O1) + h * 128, (char*)lds_generic + RING_OFF);
    }
}

__device__ __forceinline__ void p4_ycat(Frame& F, KA args, int parts) {
    const int gw = F.vcu * NWAVES + F.wave, NGW = F.G * NWAVES, lane = F.lane;
    const bf16* U16 = (const bf16*)(F.ws + mp::u16); const bf16* YS = (const bf16*)(F.ws + mp::ys);
    const bf16* O1 = (const bf16*)(F.ws + mp::o1); const bf16* O2 = (const bf16*)(F.ws + mp::o2); bf16* YCAT = (bf16*)(F.ws + mp::ycat);
    const float* nw = (const float*)args->in[9]; const float* subw = (const float*)args->in[16];
    float lam;
    { const float* lq1 = (const float*)args->in[12]; const float* lk1 = (const float*)args->in[13]; const float* lq2 = (const float*)args->in[14]; const float* lk2 = (const float*)args->in[15];
      const float s1 = wave_sum(lq1[lane] * lk1[lane]), s2 = wave_sum(lq2[lane] * lk2[lane]); lam = expf(s1) - expf(s2) + 0.2f; }
    float w_s[2][8], w_a[8];
#pragma unroll
    for (int j = 0; j < 8; ++j) { w_s[0][j] = nw[lane * 8 + j]; w_s[1][j] = nw[512 + lane * 8 + j]; w_a[j] = subw[(lane & 15) * 8 + j] * 0.8f; }
    for (int it = 0; it < 4; ++it) { const int m0 = (F.vcu >> 5) * 2048 + it * 512 + ((F.vcu & 31) * NWAVES + F.wave) * 2;
        v4u yv[2][2], zv[2][2], av[2][2], bv[2][2];
#pragma unroll
        for (int rr = 0; rr < 2; ++rr) { const size_t m = (size_t)(m0 + rr);
#pragma unroll
            for (int sl = 0; sl < 2; ++sl) {
                if (parts & 1) { yv[rr][sl] = __builtin_nontemporal_load((const GAS v4u*)(YS + m * 1024 + 512 * sl + lane * 8)); zv[rr][sl] = __builtin_nontemporal_load((const GAS v4u*)(U16 + m * NIN + UC_Z + 512 * sl + lane * 8)); }
                if (parts & 2) { av[rr][sl] = __builtin_nontemporal_load((const GAS v4u*)(O1 + m * 1024 + 512 * sl + lane * 8)); bv[rr][sl] = __builtin_nontemporal_load((const GAS v4u*)(O2 + m * 1024 + 512 * sl + lane * 8)); } } }
#pragma unroll
        for (int rr = 0; rr < 2; ++rr) { const size_t m = (size_t)(m0 + rr);
#pragma unroll
        for (int sl = 0; sl < 2; ++sl) {
        if (parts & 1) {
            const v4u y0 = yv[rr][sl], z0 = zv[rr][sl];
            const unsigned yy[4] = {y0.x, y0.y, y0.z, y0.w}, zz[4] = {z0.x, z0.y, z0.z, z0.w};
            float v[8]; float ss = 0.f;
#pragma unroll
            for (int j = 0; j < 4; ++j) { const float ya = __builtin_bit_cast(float, yy[j] << 16), yb = __builtin_bit_cast(float, yy[j] & 0xffff0000u), za = __builtin_bit_cast(float, zz[j] << 16), zb = __builtin_bit_cast(float, zz[j] & 0xffff0000u);
                v[2 * j] = ya * za / (1.f + __expf(-za)); v[2 * j + 1] = yb * zb / (1.f + __expf(-zb)); ss += v[2 * j] * v[2 * j] + v[2 * j + 1] * v[2 * j + 1]; }
            ss = wave_sum(ss);
            const float r = 1.0f / sqrtf(ss * (1.f / 512.f) + EPS);
            v4u o0; o0.x = pk2(v[0] * r * w_s[sl][0], v[1] * r * w_s[sl][1]); o0.y = pk2(v[2] * r * w_s[sl][2], v[3] * r * w_s[sl][3]); o0.z = pk2(v[4] * r * w_s[sl][4], v[5] * r * w_s[sl][5]); o0.w = pk2(v[6] * r * w_s[sl][6], v[7] * r * w_s[sl][7]);
            *(GAS v4u*)(YCAT + m * DM + 512 * sl + lane * 8) = o0;
        }
        if (parts & 2) {
            const v4u a0 = av[rr][sl], b0 = bv[rr][sl];
            const unsigned aa[4] = {a0.x, a0.y, a0.z, a0.w}, bb[4] = {b0.x, b0.y, b0.z, b0.w};
            float v[8]; float ss = 0.f;
#pragma unroll
            for (int j = 0; j < 4; ++j) { v[2 * j] = __builtin_bit_cast(float, aa[j] << 16) - lam * __builtin_bit_cast(float, bb[j] << 16); v[2 * j + 1] = __builtin_bit_cast(float, aa[j] & 0xffff0000u) - lam * __builtin_bit_cast(float, bb[j] & 0xffff0000u);
                ss += v[2 * j] * v[2 * j] + v[2 * j + 1] * v[2 * j + 1]; }
            ss += __shfl_xor(ss, 1); ss += __shfl_xor(ss, 2); ss += __shfl_xor(ss, 4); ss += __shfl_xor(ss, 8);
            const float r = 1.0f / sqrtf(ss * (1.f / 128.f) + EPS);
            v4u o0; o0.x = pk2(v[0] * r * w_a[0], v[1] * r * w_a[1]); o0.y = pk2(v[2] * r * w_a[2], v[3] * r * w_a[3]); o0.z = pk2(v[4] * r * w_a[4], v[5] * r * w_a[5]); o0.w = pk2(v[6] * r * w_a[6], v[7] * r * w_a[7]);
            *(GAS v4u*)(YCAT + m * DM + 1024 + 512 * sl + lane * 8) = o0;
        }
        }
        }
    }
}

constexpr int CONV_R = 8;
__device__ __forceinline__ void p2_conv(Frame& F, KA args) {
    const int gw = F.vcu * NWAVES + F.wave, NGW = F.G * NWAVES, lane = F.lane;
    const bf16* U16 = (const bf16*)(F.ws + mp::u16); bf16* XBC = (bf16*)(F.ws + mp::xbc);
    const float* cw = (const float*)args->in[4]; const float* cb = (const float*)args->in[5];
    for (int it = 0; it < 3; ++it) { const int task = (F.vcu & 31) * NWAVES + F.wave + 256 * it;
        const int cblk = task % 3, r0 = (F.vcu >> 5) * 2048 + (task / 3) * CONV_R, c0 = cblk * 512 + lane * 8;
        const bool seq_start = (r0 % SEQ) == 0;
        v4u raw[CONV_R + 3];
#pragma unroll
        for (int j = 0; j < CONV_R + 3; ++j) { raw[j] = (v4u){0u, 0u, 0u, 0u}; if (j >= 3 || !seq_start) raw[j] = __builtin_nontemporal_load((const GAS v4u*)(U16 + (size_t)(r0 - 3 + j) * NIN + UC_XBC + c0)); }
        float w[4][8], bias[8];
#pragma unroll
        for (int j = 0; j < 4; ++j)
#pragma unroll
            for (int i = 0; i < 8; ++i) w[j][i] = cw[j * 1536 + c0 + i];
#pragma unroll
        for (int i = 0; i < 8; ++i) bias[i] = cb[c0 + i];
#pragma unroll
        for (int t = 0; t < CONV_R; ++t) {
            float o[8];
#pragma unroll
            for (int i = 0; i < 8; ++i) o[i] = bias[i];
#pragma unroll
            for (int j = 0; j < 4; ++j) { const v4u rw = raw[t + j];
                const float e[8] = {__builtin_bit_cast(float, rw.x << 16), __builtin_bit_cast(float, rw.x & 0xffff0000u), __builtin_bit_cast(float, rw.y << 16), __builtin_bit_cast(float, rw.y & 0xffff0000u),
                                    __builtin_bit_cast(float, rw.z << 16), __builtin_bit_cast(float, rw.z & 0xffff0000u), __builtin_bit_cast(float, rw.w << 16), __builtin_bit_cast(float, rw.w & 0xffff0000u)};
#pragma unroll
                for (int i = 0; i < 8; ++i) o[i] += w[j][i] * e[i]; }
#pragma unroll
            for (int i = 0; i < 8; ++i) o[i] = o[i] / (1.f + __expf(-o[i]));
            v4u ov; ov.x = pk2(o[0], o[1]); ov.y = pk2(o[2], o[3]); ov.z = pk2(o[4], o[5]); ov.w = pk2(o[6], o[7]);
            *(GAS v4u*)(XBC + (size_t)(r0 + t) * 1536 + c0) = ov;
        }
    }
}

namespace ssd {
constexpr int BCS = 2064;
constexpr int LB = 0, LC = LB + 16 * BCS, LX = LC + 16 * BCS, LXW = LX + 8192, LST = LXW + 8192, STB = 8704, LA = LST + 2 * STB, LSL = LA + 4096, SSD_LDS_END = LSL + 10 * 4096;
static_assert(SSD_LDS_END <= LDSCTL_OFF, "SSD tiles vs LDS control words");
typedef float f32x16 __attribute__((ext_vector_type(16)));
#define SSD_PIN8(a) asm volatile("" : "+v"(a[0]), "+v"(a[1]), "+v"(a[2]), "+v"(a[3]), "+v"(a[4]), "+v"(a[5]), "+v"(a[6]), "+v"(a[7]))
#define SSD_PIN4(a) asm volatile("" : "+v"(a[0]), "+v"(a[1]), "+v"(a[2]), "+v"(a[3]))
struct Ctx { LAS unsigned char* lds; const LAS float* a2; const LAS float* dtl; const LAS float* fsl; int lane, r32, hi; };
__device__ __forceinline__ void load_cf(const Ctx& c, int lb, bf16x8 (&cf)[8]) {
#pragma unroll
    for (int ks = 0; ks < 8; ++ks) cf[ks] = *(const LAS bf16x8*)(c.lds + LC + (2 * ks + c.hi) * BCS + (32 * lb + c.r32) * 16);
    SSD_PIN8(cf);
}
template <bool DIAG> __device__ __forceinline__ void intra(const Ctx& c, int lb, int st, const bf16x8 (&cf)[8], f32x16& y) {
    bf16x8 bq[8];
#pragma unroll
    for (int ks = 0; ks < 8; ++ks) bq[ks] = *(const LAS bf16x8*)(c.lds + LB + (2 * ks + c.hi) * BCS + (32 * st + c.r32) * 16);
    f32x4 av[4], dv[4];
#pragma unroll
    for (int q = 0; q < 4; ++q) { av[q] = *(const LAS f32x4*)((DIAG ? c.a2 : c.fsl) + 32 * st + 8 * q + 4 * c.hi); if (DIAG) dv[q] = *(const LAS f32x4*)(c.dtl + 32 * st + 8 * q + 4 * c.hi); }
    const float al = c.a2[32 * lb + c.r32], aref = c.a2[32 * st + 31];
    SSD_PIN8(bq); SSD_PIN4(av); if (DIAG) SSD_PIN4(dv);
    f32x16 p;
#pragma unroll
    for (int r = 0; r < 16; ++r) p[r] = 0.f;
#pragma unroll
    for (int ks = 0; ks < 8; ++ks) p = __builtin_amdgcn_mfma_f32_32x32x16_bf16(bq[ks], cf[ks], p, 0, 0, 0);
    if (DIAG) {
        float e[16];
#pragma unroll
        for (int r = 0; r < 16; ++r) e[r] = __builtin_amdgcn_exp2f(fminf(al - av[r >> 2][r & 3], 0.f));
#pragma unroll
        for (int r = 0; r < 16; ++r) { const int sl = attn_body::crow(r, c.hi); const float v = p[r] * e[r] * dv[r >> 2][r & 3]; p[r] = sl > c.r32 ? 0.f : v; }
    } else {
        const float el = __builtin_amdgcn_exp2f(al - aref);
#pragma unroll
        for (int r = 0; r < 16; ++r) p[r] *= el * av[r >> 2][r & 3];
    }
    v4u pw0, pw1;
    pw0.x = attn_body::cvtpk_s(p[0], p[1]); pw0.y = attn_body::cvtpk_s(p[2], p[3]); pw0.z = attn_body::cvtpk_s(p[4], p[5]); pw0.w = attn_body::cvtpk_s(p[6], p[7]);
    pw1.x = attn_body::cvtpk_s(p[8], p[9]); pw1.y = attn_body::cvtpk_s(p[10], p[11]); pw1.z = attn_body::cvtpk_s(p[12], p[13]); pw1.w = attn_body::cvtpk_s(p[14], p[15]);
    const LAS unsigned char* xb = c.lds + LX + ((c.lane >> 4) & 1) * 32 + (c.lane & 3) * 8 + (4 * c.hi + ((c.lane & 15) >> 2)) * 64 + (32 * st) * 64;
    const attn_body::s16x4 lo0 = attn_body::vtr((attn_body::lds_cptr)(xb)), hh0 = attn_body::vtr((attn_body::lds_cptr)(xb + 512));
    const attn_body::s16x4 lo1 = attn_body::vtr((attn_body::lds_cptr)(xb + 1024)), hh1 = attn_body::vtr((attn_body::lds_cptr)(xb + 1024 + 512));
    y = __builtin_amdgcn_mfma_f32_32x32x16_bf16(__builtin_bit_cast(bf16x8, pw0), (bf16x8){lo0[0], lo0[1], lo0[2], lo0[3], hh0[0], hh0[1], hh0[2], hh0[3]}, y, 0, 0, 0);
    y = __builtin_amdgcn_mfma_f32_32x32x16_bf16(__builtin_bit_cast(bf16x8, pw1), (bf16x8){lo1[0], lo1[1], lo1[2], lo1[3], hh1[0], hh1[1], hh1[2], hh1[3]}, y, 0, 0, 0);
}
__device__ __forceinline__ void yoff(const Ctx& c, int lb, int sbuf, f32x16& y) {
    bf16x8 cf[8], sf[8]; f32x4 av[4];
    load_cf(c, lb, cf);
#pragma unroll
    for (int ks = 0; ks < 8; ++ks) sf[ks] = *(const LAS bf16x8*)(c.lds + LST + sbuf * STB + c.r32 * 272 + (16 * ks + 8 * c.hi) * 2);
#pragma unroll
    for (int q = 0; q < 4; ++q) av[q] = *(const LAS f32x4*)(c.a2 + 32 * lb + 8 * q + 4 * c.hi);
    SSD_PIN8(cf); SSD_PIN8(sf); SSD_PIN4(av);
#pragma unroll
    for (int r = 0; r < 16; ++r) y[r] = 0.f;
#pragma unroll
    for (int ks = 0; ks < 8; ++ks) y = __builtin_amdgcn_mfma_f32_32x32x16_bf16(cf[ks], sf[ks], y, 0, 0, 0);
#pragma unroll
    for (int r = 0; r < 16; ++r) y[r] *= __builtin_amdgcn_exp2f(av[r >> 2][r & 3]);
}
__device__ __forceinline__ void state_item(const Ctx& c, int nt, int nbuf, f32x16& st) {
    const int i16 = c.lane & 15, g1 = (c.lane >> 4) & 1;
    const float dall = __builtin_amdgcn_exp2f(c.a2[127]);
#pragma unroll
    for (int r = 0; r < 16; ++r) st[r] *= dall;
    const LAS unsigned char* ab = c.lds + LB + (4 * nt + 2 * g1 + ((i16 & 3) >> 1)) * BCS + (8 * c.hi + (i16 >> 2)) * 16 + (i16 & 1) * 8;
    const LAS unsigned char* wb = c.lds + LXW + (8 * c.hi + (i16 >> 2)) * 64 + g1 * 32 + (i16 & 3) * 8;
#pragma unroll
    for (int kb = 0; kb < 2; ++kb) {
        bf16x8 af[4], wf[4];
#pragma unroll
        for (int kk = 0; kk < 4; ++kk) { const int ks = kb * 4 + kk;
            const attn_body::s16x4 a0 = attn_body::vtr((attn_body::lds_cptr)(ab + ks * 256)), a1 = attn_body::vtr((attn_body::lds_cptr)(ab + ks * 256 + 64));
            const attn_body::s16x4 w0 = attn_body::vtr((attn_body::lds_cptr)(wb + ks * 1024)), w1 = attn_body::vtr((attn_body::lds_cptr)(wb + ks * 1024 + 256));
            af[kk] = (bf16x8){a0[0], a0[1], a0[2], a0[3], a1[0], a1[1], a1[2], a1[3]}; wf[kk] = (bf16x8){w0[0], w0[1], w0[2], w0[3], w1[0], w1[1], w1[2], w1[3]}; }
        SSD_PIN4(af); SSD_PIN4(wf);
#pragma unroll
        for (int kk = 0; kk < 4; ++kk) st = __builtin_amdgcn_mfma_f32_32x32x16_bf16(af[kk], wf[kk], st, 0, 0, 0);
    }
#pragma unroll
    for (int q = 0; q < 4; ++q) { v2u w; w.x = attn_body::cvtpk_s(st[4 * q], st[4 * q + 1]); w.y = attn_body::cvtpk_s(st[4 * q + 2], st[4 * q + 3]);
        *(LAS v2u*)(c.lds + LST + nbuf * STB + c.r32 * 272 + (32 * nt + 8 * q + 4 * c.hi) * 2) = w; }
}
__device__ __forceinline__ void put_slot(const Ctx& c, int slot, const f32x16& y) {
    LAS float* sp = (LAS float*)(c.lds + LSL + slot * 4096);
#pragma unroll
    for (int r = 0; r < 16; ++r) sp[attn_body::crow(r, c.hi) * 32 + c.r32] = y[r];
}
__device__ __forceinline__ void unit(Frame& F, KA args, int u) {
    const int tid = F.tid, lane = F.lane, wave = F.wave, r32 = lane & 31, hi = lane >> 5;
    const int b = u >> 5, h = (u >> 1) & 15, ph = u & 1, g = h >> 3;
    const bf16* XBC = (const bf16*)(F.ws + mp::xbc); const float* DTR = (const float*)(F.ws + mp::dt); bf16* YS = (bf16*)(F.ws + mp::ys);
    const float dtb = ((const float*)args->in[6])[h], Ah = -expf(((const float*)args->in[7])[h]) * 1.44269504089f, Dk = ((const float*)args->in[8])[h];
    LAS unsigned char* lds = F.lds + RING_OFF;
    const size_t mbase = (size_t)b * SEQ;
    const int brow = tid >> 4, bchk = tid & 15;
    const int xrow = tid >> 2, xpc = tid & 3;
    v4u Breg[4], Creg[4], xreg;
#define SSD_LOAD_REGS(k_) do { const size_t m0_ = mbase + (size_t)(k_) * 128; \
        _Pragma("unroll") for (int i = 0; i < 4; ++i) { Breg[i] = *(const GAS v4u*)(XBC + (m0_ + brow + 32 * i) * 1536 + 1024 + g * 128 + bchk * 8); Creg[i] = *(const GAS v4u*)(XBC + (m0_ + brow + 32 * i) * 1536 + 1280 + g * 128 + bchk * 8); } \
        xreg = *(const GAS v4u*)(XBC + (m0_ + xrow) * 1536 + h * 64 + ph * 32 + xpc * 8); } while (0)
    float dtr0 = 0.f, dtr1 = 0.f;
#define SSD_LOAD_DT(k_) do { const size_t m0_ = mbase + (size_t)(k_) * 128; dtr0 = DTR[(m0_ + 2 * lane) * 16 + h]; dtr1 = DTR[(m0_ + 2 * lane + 1) * 16 + h]; } while (0)
#define SSD_PREP_A(buf_) do { \
        const float r0 = dtr0 + dtb, r1 = dtr1 + dtb; \
        const float d0 = r0 > 20.f ? r0 : log1pf(expf(r0)), d1 = r1 > 20.f ? r1 : log1pf(expf(r1)); \
        const float v0 = d0 * Ah, v1 = d1 * Ah; float s_ = v0 + v1; \
        _Pragma("unroll") for (int o = 1; o < 64; o <<= 1) { const float t = __shfl_up(s_, o); if (lane >= o) s_ += t; } \
        LAS float* a2w = (LAS float*)(lds + LA + (buf_) * 2048); LAS float* dtw = a2w + 128; LAS float* fw = a2w + 256; \
        const float aref_ = __shfl(s_, (lane & 48) | 15); \
        a2w[2 * lane] = s_ - v1; a2w[2 * lane + 1] = s_; dtw[2 * lane] = d0; dtw[2 * lane + 1] = d1; \
        fw[2 * lane] = __builtin_amdgcn_exp2f(aref_ - (s_ - v1)) * d0; fw[2 * lane + 1] = __builtin_amdgcn_exp2f(aref_ - s_) * d1; } while (0)
    f32x16 stA, stB;
#pragma unroll
    for (int r = 0; r < 16; ++r) { stA[r] = 0.f; stB[r] = 0.f; }
    SSD_LOAD_REGS(0);
    if (wave == 1) { SSD_LOAD_DT(0); SSD_PREP_A(0); }
    LDS_WAIT(); __syncthreads();
#pragma nounroll
    for (int k = 0; k < 16; ++k) {
        const int buf = k & 1, nb = buf ^ 1; const size_t m0 = mbase + (size_t)k * 128;
        Ctx c; c.lds = lds; c.a2 = (const LAS float*)(lds + LA + buf * 2048); c.dtl = c.a2 + 128; c.fsl = c.a2 + 256; c.lane = lane; c.r32 = r32; c.hi = hi;
#pragma unroll
        for (int i = 0; i < 4; ++i) { *(LAS v4u*)(lds + LB + bchk * BCS + (brow + 32 * i) * 16) = Breg[i]; *(LAS v4u*)(lds + LC + bchk * BCS + (brow + 32 * i) * 16) = Creg[i]; }
        *(LAS v4u*)(lds + LX + xrow * 64 + xpc * 16) = xreg;
        { const float wsc = __builtin_amdgcn_exp2f(c.a2[127] - c.a2[xrow]) * c.dtl[xrow];
          const float x0 = __builtin_bit_cast(float, xreg.x << 16) * wsc, x1 = __builtin_bit_cast(float, xreg.x & 0xffff0000u) * wsc, x2 = __builtin_bit_cast(float, xreg.y << 16) * wsc, x3 = __builtin_bit_cast(float, xreg.y & 0xffff0000u) * wsc;
          const float x4 = __builtin_bit_cast(float, xreg.z << 16) * wsc, x5 = __builtin_bit_cast(float, xreg.z & 0xffff0000u) * wsc, x6 = __builtin_bit_cast(float, xreg.w << 16) * wsc, x7 = __builtin_bit_cast(float, xreg.w & 0xffff0000u) * wsc;
          v4u xw; xw.x = pk2(x0, x1); xw.y = pk2(x2, x3); xw.z = pk2(x4, x5); xw.w = pk2(x6, x7);
          *(LAS v4u*)(lds + LXW + xrow * 64 + xpc * 16) = xw; }
        LDS_WAIT(); __syncthreads();
        if (k < 15) { SSD_LOAD_REGS(k + 1); if (wave == 1) SSD_LOAD_DT(k + 1); }
        {
            f32x16 y; bf16x8 cf[8];
#pragma unroll
            for (int r = 0; r < 16; ++r) y[r] = 0.f;
            if (wave == 0)      { load_cf(c, 3, cf); intra<true>(c, 3, 3, cf, y); intra<false>(c, 3, 2, cf, y); put_slot(c, 0, y); }
            else if (wave == 1) { load_cf(c, 3, cf); intra<false>(c, 3, 1, cf, y); intra<false>(c, 3, 0, cf, y); put_slot(c, 1, y); if (k < 15) SSD_PREP_A(nb); }
            else if (wave == 2) { load_cf(c, 2, cf); intra<true>(c, 2, 2, cf, y); intra<false>(c, 2, 1, cf, y); put_slot(c, 3, y); }
            else if (wave == 3) { load_cf(c, 2, cf); intra<false>(c, 2, 0, cf, y); put_slot(c, 4, y);
#pragma unroll
                                  for (int r = 0; r < 16; ++r) y[r] = 0.f;
                                  load_cf(c, 0, cf); intra<true>(c, 0, 0, cf, y); put_slot(c, 8, y); }
            else if (wave == 4) { load_cf(c, 1, cf); intra<true>(c, 1, 1, cf, y); intra<false>(c, 1, 0, cf, y); put_slot(c, 6, y); }
            else if (wave == 5) { if (k > 0) { yoff(c, 3, buf, y); put_slot(c, 2, y); yoff(c, 2, buf, y); put_slot(c, 5, y); yoff(c, 1, buf, y); put_slot(c, 7, y); yoff(c, 0, buf, y); put_slot(c, 9, y); } }
            else if (wave == 6) { state_item(c, 0, nb, stA); state_item(c, 1, nb, stB); }
            else                { state_item(c, 2, nb, stA); state_item(c, 3, nb, stB); }
        }
        LDS_WAIT(); __syncthreads();
        { const int row = tid >> 2, pc = tid & 3, lb = wave >> 1, rl = row & 31;
          const int s0 = lb == 3 ? 0 : (lb == 2 ? 3 : (lb == 1 ? 6 : 8)), s1 = lb == 3 ? 1 : (lb == 2 ? 4 : -1), so = lb == 3 ? 2 : (lb == 2 ? 5 : (lb == 1 ? 7 : 9));
          const LAS float* p0 = (const LAS float*)(lds + LSL + s0 * 4096) + rl * 32 + pc * 8;
          f32x4 ya = *(const LAS f32x4*)p0, yb = *(const LAS f32x4*)(p0 + 4);
          if (s1 >= 0) { const LAS float* p1 = (const LAS float*)(lds + LSL + s1 * 4096) + rl * 32 + pc * 8; ya += *(const LAS f32x4*)p1; yb += *(const LAS f32x4*)(p1 + 4); }
          if (k > 0) { const LAS float* p2 = (const LAS float*)(lds + LSL + so * 4096) + rl * 32 + pc * 8; ya += *(const LAS f32x4*)p2; yb += *(const LAS f32x4*)(p2 + 4); }
          const v4u xv = *(const LAS v4u*)(lds + LX + row * 64 + pc * 16);
          v4u o; o.x = pk2(ya.x + Dk * __builtin_bit_cast(float, xv.x << 16), ya.y + Dk * __builtin_bit_cast(float, xv.x & 0xffff0000u)); o.y = pk2(ya.z + Dk * __builtin_bit_cast(float, xv.y << 16), ya.w + Dk * __builtin_bit_cast(float, xv.y & 0xffff0000u));
          o.z = pk2(yb.x + Dk * __builtin_bit_cast(float, xv.z << 16), yb.y + Dk * __builtin_bit_cast(float, xv.z & 0xffff0000u)); o.w = pk2(yb.z + Dk * __builtin_bit_cast(float, xv.w << 16), yb.w + Dk * __builtin_bit_cast(float, xv.w & 0xffff0000u));
          *(GAS v4u*)(YS + (m0 + row) * 1024 + h * 64 + ph * 32 + pc * 8) = o; }
    }
    LDS_WAIT(); __syncthreads();
#undef SSD_LOAD_REGS
#undef SSD_LOAD_DT
#undef SSD_PREP_A
}
#undef SSD_PIN8
#undef SSD_PIN4
}
__device__ __forceinline__ void p3_ssd(Frame& F, KA args) {
    for (int u = F.vcu; u < 256; u += F.G) ssd::unit(F, args, u);
}

__device__ __forceinline__ void p0_small(Frame& F, KA args) {
    const int gt = (F.vcu * NWAVES + F.wave) * 64 + F.lane, NGT = F.G * NWAVES * 64;
    const float* ln2 = (const float*)args->in[18]; const float* wrg = (const float*)args->in[19]; const float* wre = (const float*)args->in[21];
    bf16* WRH = (bf16*)(F.ws + mp::wr); bf16* WRL = WRH + 48 * DM;
    for (int i = gt; i < 48 * DM; i += NGT) { const int c = i / DM, k = i % DM;
        const float w = (c < 4 ? wrg[k * 4 + c] : (c < 36 ? wre[k * 32 + (c - 4)] : 0.f)) * ln2[k];
        const unsigned hi = f2bf(w); const float lo = w - bf2f((unsigned short)hi);
        WRH[i] = (bf16)hi; WRL[i] = (bf16)f2bf(lo); }
    { GAS v4u* z = (GAS v4u*)((bf16*)(F.ws + mp::win) + (size_t)(NIN + 16) * DM);
      for (int i = gt; i < (NIN_G - NIN - 16) * DM / 8; i += NGT) z[i] = (v4u){0u, 0u, 0u, 0u}; }
}

__device__ __forceinline__ void p5_route(Frame& F, KA args) {
    const int lane = F.lane;
    const bf16* h = (const bf16*)(F.ws + mp::xn2);
    const bf16* WRH = (const bf16*)(F.ws + mp::wr); const bf16* WRL = WRH + 48 * DM;
    const float* brg = (const float*)args->in[20]; const float* bre = (const float*)args->in[22];
    int* tok_e = (int*)(F.ws + mp::small + SM_TOK_E); int* tok_pos = (int*)(F.ws + mp::small + SM_TOK_POS); float* tok_w = (float*)(F.ws + mp::small + SM_TOK_W);
    int* lst_tok = (int*)(F.ws + mp::lst); float* lst_w = (float*)(F.ws + mp::lst) + NE * LCAP; float* lst_r = lst_w + NE * LCAP;
    unsigned* cnt = (unsigned*)(F.ctl + CW_CNT);
    LAS float* lg = (LAS float*)(F.lds + RING_OFF + F.wave * 4096);
    constexpr int KQ = 512, WQB = 2 * 48 * KQ * 2;
    LAS unsigned char* wq = F.lds + RING_OFF + 32768;
    for (int wt = F.vcu; wt < M / 64; wt += F.G) {
        const int rt = F.wave & 3, kh = F.wave >> 2, task = wt * 4 + rt;
        const bf16* hr = h + (size_t)(task * 16 + (lane & 15)) * DM + (lane >> 4) * 8;
        f32x4 acc0 = (f32x4){0.f, 0.f, 0.f, 0.f}, acc1 = acc0, acc2 = acc0; float ss = 0.f;
        for (int q = 0; q < DM / KQ; ++q) {
            __syncthreads();
#pragma unroll
            for (int i = 0; i < 12; ++i) { const int pc = F.tid + 512 * i, row = pc >> 6, c16 = pc & 63;
                const v4u v = *(const GAS v4u*)((row < 48 ? WRH + (size_t)row * DM : WRL + (size_t)(row - 48) * DM) + q * KQ + c16 * 8);
                *(LAS v4u*)(wq + row * 1040 + c16 * 16) = v; }
            LDS_WAIT(); __syncthreads();
#pragma unroll 4
            for (int k8 = 0; k8 < 8; ++k8) {
                const int kt = kh * 8 + k8;
                const v4u hv = *(const GAS v4u*)(hr + q * KQ + kt * 32);
                { const float e0 = __builtin_bit_cast(float, hv.x << 16), e1 = __builtin_bit_cast(float, hv.x & 0xffff0000u), e2 = __builtin_bit_cast(float, hv.y << 16), e3 = __builtin_bit_cast(float, hv.y & 0xffff0000u);
                  const float e4 = __builtin_bit_cast(float, hv.z << 16), e5 = __builtin_bit_cast(float, hv.z & 0xffff0000u), e6 = __builtin_bit_cast(float, hv.w << 16), e7 = __builtin_bit_cast(float, hv.w & 0xffff0000u);
                  ss += (e0 * e0 + e1 * e1) + (e2 * e2 + e3 * e3) + (e4 * e4 + e5 * e5) + (e6 * e6 + e7 * e7); }
                const bf16x8 ah = __builtin_bit_cast(bf16x8, hv);
                const LAS unsigned char* bp = wq + (lane & 15) * 1040 + kt * 64 + (lane >> 4) * 16;
                { const bf16x8 b_h = *(const LAS bf16x8*)(bp), b_l = *(const LAS bf16x8*)(bp + 48 * 1040);
                  acc0 = __builtin_amdgcn_mfma_f32_16x16x32_bf16(ah, b_h, acc0, 0, 0, 0); acc0 = __builtin_amdgcn_mfma_f32_16x16x32_bf16(ah, b_l, acc0, 0, 0, 0); }
                { const bf16x8 b_h = *(const LAS bf16x8*)(bp + 16 * 1040), b_l = *(const LAS bf16x8*)(bp + 64 * 1040);
                  acc1 = __builtin_amdgcn_mfma_f32_16x16x32_bf16(ah, b_h, acc1, 0, 0, 0); acc1 = __builtin_amdgcn_mfma_f32_16x16x32_bf16(ah, b_l, acc1, 0, 0, 0); }
                { const bf16x8 b_h = *(const LAS bf16x8*)(bp + 32 * 1040), b_l = *(const LAS bf16x8*)(bp + 80 * 1040);
                  acc2 = __builtin_amdgcn_mfma_f32_16x16x32_bf16(ah, b_h, acc2, 0, 0, 0); acc2 = __builtin_amdgcn_mfma_f32_16x16x32_bf16(ah, b_l, acc2, 0, 0, 0); }
            }
        }
        __syncthreads();
        LAS float* xp = (LAS float*)(F.lds + RING_OFF + 32768 + rt * 4096) + lane * 13;
        if (kh == 1) {
#pragma unroll
            for (int q = 0; q < 4; ++q) { xp[q] = acc0[q]; xp[4 + q] = acc1[q]; xp[8 + q] = acc2[q]; }
            xp[12] = ss; }
        LDS_WAIT(); __syncthreads();
        if (kh == 0) {
#pragma unroll
        for (int q = 0; q < 4; ++q) { acc0[q] += xp[q]; acc1[q] += xp[4 + q]; acc2[q] += xp[8 + q]; }
        ss += xp[12];
        ss += __shfl_xor(ss, 16); ss += __shfl_xor(ss, 32);
        const float r = 1.0f / sqrtf(ss * (1.f / DM) + EPS);
#pragma unroll
        for (int reg = 0; reg < 4; ++reg) { const int row = (lane >> 4) * 4 + reg; const float rr = __shfl(r, row);
            lg[row * 48 + (lane & 15)] = acc0[reg] * rr; lg[row * 48 + 16 + (lane & 15)] = acc1[reg] * rr; lg[row * 48 + 32 + (lane & 15)] = acc2[reg] * rr; }
        LDS_WAIT(); asm volatile("" ::: "memory");
        if (lane < 16) {
            const LAS float* L = lg + lane * 48; const int tok = task * 16 + lane;
            float gl[4];
#pragma unroll
            for (int j = 0; j < 4; ++j) gl[j] = L[j] + brg[j];
            int gs = 0; float gm = gl[0];
#pragma unroll
            for (int j = 1; j < 4; ++j) if (gl[j] > gm) { gm = gl[j]; gs = j; }
            float gsum = 0.f;
#pragma unroll
            for (int j = 0; j < 4; ++j) gsum += expf(gl[j] - gm);
            const float gwt = 1.f / gsum;
            float el[8];
#pragma unroll
            for (int j = 0; j < 8; ++j) el[j] = L[4 + gs * 8 + j] + bre[gs * 8 + j];
            int i1 = 0; float m1 = el[0];
#pragma unroll
            for (int j = 1; j < 8; ++j) if (el[j] > m1) { m1 = el[j]; i1 = j; }
            int i2 = 0; float m2 = -INFINITY;
#pragma unroll
            for (int j = 0; j < 8; ++j) if (j != i1 && el[j] > m2) { m2 = el[j]; i2 = j; }
            const float e2 = expf(m2 - m1); const float w1 = gwt / (1.f + e2), w2 = gwt * e2 / (1.f + e2);
            const int ea = gs * 8 + i1, eb = gs * 8 + i2;
            tok_e[tok * 2] = ea; tok_e[tok * 2 + 1] = eb; tok_w[tok * 2] = w1; tok_w[tok * 2 + 1] = w2;
            const int pa = (int)__hip_atomic_fetch_add(cnt + ea, 1u, RLX_AGENT), pb = (int)__hip_atomic_fetch_add(cnt + eb, 1u, RLX_AGENT);
            tok_pos[tok * 2] = pa; tok_pos[tok * 2 + 1] = pb;
            lst_tok[ea * LCAP + pa] = tok; lst_w[ea * LCAP + pa] = w1; lst_r[ea * LCAP + pa] = r; lst_tok[eb * LCAP + pb] = tok; lst_w[eb * LCAP + pb] = w2; lst_r[eb * LCAP + pb] = r;
        }
        }
        LDS_WAIT(); __syncthreads();
    }
}

__device__ __forceinline__ void build_tab(Frame& F, KA args) {
    LAS int* tab = (LAS int*)(F.lds + TAB_OFF);
    if (F.wave == 0) {
        const int lane = F.lane, e = lane & 31; unsigned* cnt = (unsigned*)(F.ctl + CW_CNT);
        const int c = (int)__hip_atomic_load(cnt + e, RLX_AGENT), mt = (c + 255) >> 8;
        int sc = mt;
#pragma unroll
        for (int o = 1; o < 32; o <<= 1) { const int t = __shfl_up(sc, o); if (e >= o) sc += t; }
        if (lane < 32) { tab[e] = (sc - mt) * 8; tab[40 + e] = sc - mt; tab[80 + e] = c; }
        if (lane == 31) { tab[32] = sc * 8; tab[72] = sc; }
    }
    LDS_WAIT(); __syncthreads();
}

__device__ __forceinline__ void p8_combine(Frame& F, KA args) {
    const int gw = F.vcu * NWAVES + F.wave, NGW = F.G * NWAVES, lane = F.lane;
    build_tab(F, args);
    const LAS int* tab = (const LAS int*)(F.lds + TAB_OFF);
    const int* tok_e = (const int*)(F.ws + mp::small + SM_TOK_E); const int* tok_pos = (const int*)(F.ws + mp::small + SM_TOK_POS); const unsigned char* Y8 = (const unsigned char*)(F.ws + mp::y); float* out = args->out;
    const bf16* HB = (const bf16*)(F.ws + mp::xn2);
    v4u hvA[2][2], avA[2], bvA[2], hvB[2][2], avB[2], bvB[2];
#define P8_LOAD(t_, hv_, av_, bv_) do { const int s0_ = tab[40 + tok_e[2 * (t_)]] * 256 + tok_pos[2 * (t_)], s1_ = tab[40 + tok_e[2 * (t_) + 1]] * 256 + tok_pos[2 * (t_) + 1]; \
        _Pragma("unroll") for (int j = 0; j < 2; ++j) { const int c0 = 16 * (lane + 64 * j); \
            hv_[j][0] = __builtin_nontemporal_load((const GAS v4u*)(HB + (size_t)(t_) * DM + c0)); hv_[j][1] = __builtin_nontemporal_load((const GAS v4u*)(HB + (size_t)(t_) * DM + c0 + 8)); \
            av_[j] = __builtin_nontemporal_load((const GAS v4u*)(Y8 + (size_t)s0_ * DM + c0)); bv_[j] = __builtin_nontemporal_load((const GAS v4u*)(Y8 + (size_t)s1_ * DM + c0)); } } while (0)
#define P8_STORE(t_, hv_, av_, bv_) do { \
        _Pragma("unroll") for (int j = 0; j < 2; ++j) { const int c0 = 16 * (lane + 64 * j); \
            const unsigned hw[8] = {hv_[j][0].x, hv_[j][0].y, hv_[j][0].z, hv_[j][0].w, hv_[j][1].x, hv_[j][1].y, hv_[j][1].z, hv_[j][1].w}; \
            const unsigned aw[4] = {av_[j].x, av_[j].y, av_[j].z, av_[j].w}, bw[4] = {bv_[j].x, bv_[j].y, bv_[j].z, bv_[j].w}; \
            _Pragma("unroll") for (int q = 0; q < 4; ++q) { \
                const f32x2_t a01 = __builtin_amdgcn_cvt_pk_f32_fp8((int)aw[q], false), a23 = __builtin_amdgcn_cvt_pk_f32_fp8((int)aw[q], true); \
                const f32x2_t b01 = __builtin_amdgcn_cvt_pk_f32_fp8((int)bw[q], false), b23 = __builtin_amdgcn_cvt_pk_f32_fp8((int)bw[q], true); \
                f32x4 v; \
                v.x = __builtin_bit_cast(float, hw[2 * q] << 16) + (a01.x + b01.x) * (1.f / Y8_SCALE); v.y = __builtin_bit_cast(float, hw[2 * q] & 0xffff0000u) + (a01.y + b01.y) * (1.f / Y8_SCALE); \
                v.z = __builtin_bit_cast(float, hw[2 * q + 1] << 16) + (a23.x + b23.x) * (1.f / Y8_SCALE); v.w = __builtin_bit_cast(float, hw[2 * q + 1] & 0xffff0000u) + (a23.y + b23.y) * (1.f / Y8_SCALE); \
                *(GAS f32x4*)(out + (size_t)(t_) * DM + c0 + 4 * q) = v; } } } while (0)
    typedef float f32x2_t __attribute__((ext_vector_type(2)));
    if (gw < M) P8_LOAD(gw, hvA, avA, bvA);
    for (int t = gw; t < M; t += 2 * NGW) {
        P8_LOAD(t + NGW, hvB, avB, bvB);
        P8_STORE(t, hvA, avA, bvA);
        if (t + 2 * NGW < M) P8_LOAD(t + 2 * NGW, hvA, avA, bvA);
        P8_STORE(t + NGW, hvB, avB, bvB);
    }
#undef P8_LOAD
#undef P8_STORE
}

constexpr int N_PHASES = 11;
#ifndef MK_REP_BAR
#define MK_REP_BAR 0
#endif
#ifndef MK_REP_PHASE
#define MK_REP_PHASE -1
#endif
#define PHASE_ARGS() ({ KA p_ = (KA)__builtin_amdgcn_kernarg_segment_ptr(); asm volatile("" : "+s"(p_)); p_; })
__global__ void __launch_bounds__(NWAVES * 64, 2) mega(Args args_byval) {
    KA args = PHASE_ARGS(); (void)args_byval;
    extern __shared__ __attribute__((aligned(16))) unsigned char lds[];
    Frame F;
    F.lds = (LAS unsigned char*)lds;
    F.MISC = (volatile LAS unsigned*)(F.lds + MISC_OFF);
    F.tid = threadIdx.x; F.lane = F.tid & 63; F.wave = __builtin_amdgcn_readfirstlane(F.tid >> 6);
    F.G = gridDim.x; { const int bx = blockIdx.x; F.vcu = (F.G % 8 == 0) ? (bx % 8) * (F.G / 8) + bx / 8 : bx; }
    F.cid = (int)blockIdx.x;
    F.ws = args->ws;
    F.ctl = (gu32*)(F.ws + mp::ctl);
    for (int u = F.tid; u < (LDS_BYTES - LDSCTL_OFF) / 4; u += NWAVES * 64) ((LAS unsigned*)(F.lds + LDSCTL_OFF))[u] = 0u;
    __syncthreads();
    const bool one_launch = (args->li < 0);
    XcdBarrier bar; bar.bar = (unsigned*)(F.ctl + CW_BAR); bar.x = 0; bar.st = nullptr;
    if (one_launch) bar = xcd_barrier_post((unsigned*)(F.ctl + CW_BAR), F.MISC + 8);
    if (one_launch && F.tid == 0) { const unsigned x_ = xb_xcc_id(); F.MISC[10] = x_; F.MISC[11] = xb_add((unsigned*)(F.ctl + CW_RANK + 64 * x_), 1u); }
    bool local_ok = false; unsigned* loc_ctr = nullptr;
    const int lo = args->ph_lo, hi = args->ph_hi;
#define IN(k) (lo <= (k) && (k) < hi)
#define SEAM(k) do { if (IN(k) && IN((k) + 1)) xcd_barrier(bar); } while (0)
#define SEAM_LOCAL(k) do { if (IN(k) && IN((k) + 1)) { if (local_ok) xcd_local_barrier(bar.bar, loc_ctr, 32u); else xcd_barrier(bar); } } while (0)

    if (IN(0)) for (int rep_ = 0; rep_ < (MK_REP_PHASE == 0 ? 2 : 1); ++rep_) { args = PHASE_ARGS(); p0_prologue(F, args); if (args->p0_mask & 8) p0_small(F, args); if (args->p0_mask & 16) p0_rope(F, args); }
    if (one_launch && IN(0) && IN(1)) {
        XbTok tok; xcd_barrier_arrive(bar, tok);
        if (F.tid == 0) { unsigned ok_ = (F.G == 256) ? 1u : 0u;
            for (unsigned j = 0; j < 16; ++j) { const unsigned c_ = xb_ld(&bar.bar[XB_XCNT(j)]); if (c_ != (j < 8 ? 32u : 0u)) ok_ = 0u; }
            F.MISC[12] = ok_; }
        __syncthreads();
        if (F.MISC[12]) { const int x_ = (int)F.MISC[10], r_ = (int)F.MISC[11]; local_ok = true; F.vcu = x_ * 32 + r_; F.cid = r_ * 8 + x_; loc_ctr = (unsigned*)(F.ctl + CW_LOC + 64 * x_); }
        args = PHASE_ARGS(); p0_xn1(F, args);
        xcd_barrier_wait(bar, tok);
        if (local_ok) xcd_local_barrier(bar.bar, loc_ctr, 32u); else xcd_barrier(bar);
    } else {
        if (IN(0)) { args = PHASE_ARGS(); p0_xn1(F, args); }
        SEAM(0);
    }
    if (IN(1)) for (int rep_ = 0; rep_ < (MK_REP_PHASE == 1 ? 2 : 1); ++rep_) { args = PHASE_ARGS();
        pg8::Gemm g{(const bf16*)(F.ws + mp::xn), (const bf16*)(F.ws + mp::win), M, NIN_G, DM};
        pg8::EpiInProj E{(bf16*)(F.ws + mp::u16), NIN, (float*)(F.ws + mp::dt)};
#if P1_HOSTS_P0B == 1
        const int c_ = F.cid, xcd_ = c_ & 7, team_ = c_ >> 6;
        const int ks = team_ < 3 ? ((xcd_ % P1_NCLASS) == 0 ? (xcd_ + 2 * team_) % 7 : 0) : xcd_ % 6;
        for (int part = 0; part < 2; ++part) {
            pg8::TeamOrder S{c_, part == 0 ? 0 : ks, part == 0 ? ks : 6};
            pg8::gemm_phase<pg8::EpiInProj, pg8::TeamOrder, PG8_ALIGN, PG8_SP2>(F.lds + RING_OFF, g, S, E);
            if (part == 0) { __syncthreads(); args = PHASE_ARGS(); p1_convert_share(F, args, 0); __syncthreads(); }
        }
#elif P1_HOSTS_P0B == 2
        pg8::StaticOrder S; S.init(M, NIN_G, F.G, (int)blockIdx.x);
        typedef pg8::ConvMoE<KA, 23, mp::wgu, mp::wd, mp::END, RING_OFF + RING_BYTES> CvJob;
        pg8::gemm_phase<pg8::EpiInProj, pg8::StaticOrder, PG8_ALIGN, PG8_SP2, false, CvJob>(F.lds + RING_OFF, g, S, E, CvJob{});
        if ((int)blockIdx.x >= P1_UNITS - 5 * F.G) { __syncthreads(); args = PHASE_ARGS(); p0b_blocks(F, args, 4 * (P1_INLOOP_BLOCKS + ((int)blockIdx.x - (P1_UNITS - 5 * F.G)) * NWAVES + F.wave), 4); }
#else
        pg8::StaticOrder S; S.init(M, NIN_G, F.G, (int)blockIdx.x);
        pg8::gemm_phase<pg8::EpiInProj, pg8::StaticOrder, PG8_ALIGN, PG8_SP2>(F.lds + RING_OFF, g, S, E);
#endif
    }
    SEAM_LOCAL(1);
    if (IN(2)) for (int rep_ = 0; rep_ < (MK_REP_PHASE == 2 ? 2 : 1); ++rep_) { if (MK_REP_BAR && rep_) xcd_barrier(bar); args = PHASE_ARGS(); p2_qknorm(F, args); p2_conv(F, args); }
    SEAM_LOCAL(2);
    if (IN(3)) for (int rep_ = 0; rep_ < (MK_REP_PHASE == 3 ? 2 : 1); ++rep_) { args = PHASE_ARGS(); if (args->p0_mask & 128) p3_ssd(F, args); p3_attention(F, args, lds);
#if P1_HOSTS_P0B == 1
        if (rep_ == 0) { __syncthreads(); args = PHASE_ARGS(); p1_convert_share(F, args, 1); }
#endif
    }
    SEAM_LOCAL(3);
    if (IN(4)) for (int rep_ = 0; rep_ < (MK_REP_PHASE == 4 ? 2 : 1); ++rep_) { args = PHASE_ARGS(); p4_ycat(F, args, (args->p0_mask >> 5) & 3); }
    SEAM_LOCAL(4);
    if (IN(5)) for (int rep_ = 0; rep_ < (MK_REP_PHASE == 5 ? 2 : 1); ++rep_) { args = PHASE_ARGS();
        pg8::Gemm g{(const bf16*)(F.ws + mp::ycat), (const bf16*)(F.ws + mp::wout), M, DM, DM}; pg8::StaticOrder S; S.init(M, DM, F.G, F.cid);
        pg8::EpiResid E{(const float*)args->in[0], (bf16*)(F.ws + mp::xn2), (unsigned char*)(F.ws + mp::xn8), DM, (const float*)args->in[18]};
        pg8::gemm_phase<pg8::EpiResid, pg8::StaticOrder, PG8_ALIGN, PG8_SP2>(F.lds + RING_OFF, g, S, E);
#if P1_HOSTS_P0B == 1
        if (rep_ == 0) { __syncthreads(); args = PHASE_ARGS(); p1_convert_share(F, args, 2); }
#endif
    }
    SEAM_LOCAL(5);
    if (IN(6)) for (int rep_ = 0; rep_ < (MK_REP_PHASE == 6 ? 2 : 1); ++rep_) { args = PHASE_ARGS(); p5_route(F, args);
#if P1_HOSTS_P0B == 1
        if (rep_ == 0) { __syncthreads(); args = PHASE_ARGS(); p1_convert_share(F, args, 3); }
#endif
    }
    SEAM(6);
    if (IN(8)) for (int rep_ = 0; rep_ < (MK_REP_PHASE == 8 ? 2 : 1); ++rep_) { args = PHASE_ARGS();
        build_tab(F, args);
        pg8::Gemm g{(const bf16*)(F.ws + mp::xn8), (const bf16*)(F.ws + mp::wgu), M, NE * 2048, DM / 2};    pg8::ExpertOrder S; S.init((const LAS int*)(F.lds + TAB_OFF), F.G, F.cid);
        pg8::ExpertRows RS{(const LAS int*)(F.lds + TAB_OFF), (const int*)(F.ws + mp::lst), LCAP};
        pg8::EpiGateUp E{(unsigned char*)(F.ws + mp::hid), EH, pg8::ExpertScale{(const LAS int*)(F.lds + TAB_OFF), (const float*)(F.ws + mp::lst) + 2 * NE * LCAP, LCAP}, 1.f / F8_WSCALE};
        pg8::gemm_phase_g<pg8::EpiGateUp, pg8::ExpertOrder, pg8::ExpertRows, PG8_ALIGN, PG8_SP2, true>(F.lds + RING_OFF, g, S, E, RS);
    }
    SEAM(8);
    if (IN(9)) for (int rep_ = 0; rep_ < (MK_REP_PHASE == 9 ? 2 : 1); ++rep_) { args = PHASE_ARGS();
        build_tab(F, args);
        pg8::Gemm g{(const bf16*)(F.ws + mp::hid), (const bf16*)(F.ws + mp::wd), SLOT_CAP, NE * 2048, EH / 2};    pg8::ExpertOrder S; S.init((const LAS int*)(F.lds + TAB_OFF), F.G, F.cid);
        pg8::EpiRowScale E{(unsigned char*)(F.ws + mp::y), DM, pg8::ExpertScale{(const LAS int*)(F.lds + TAB_OFF), (const float*)(F.ws + mp::lst) + NE * LCAP, LCAP}, Y8_SCALE / F8_WSCALE};
        pg8::gemm_phase<pg8::EpiRowScale, pg8::ExpertOrder, PG8_ALIGN, PG8_SP2, true>(F.lds + RING_OFF, g, S, E);
    }
    SEAM(9);
    if (IN(10)) for (int rep_ = 0; rep_ < (MK_REP_PHASE == 10 ? 2 : 1); ++rep_) { args = PHASE_ARGS(); p8_combine(F, args); }
#undef IN
#undef SEAM
#undef SEAM_LOCAL
}

__global__ void __launch_bounds__(256) k_u16_to_f32(const bf16* __restrict__ U16, const float* __restrict__ DT, float* __restrict__ U) {
    const size_t idx = (size_t)blockIdx.x * 256 + threadIdx.x;
    const int c = (int)(idx % IN_COLS); const size_t m = idx / IN_COLS;
    float v;
    if (c < 2560) v = bf2f(U16[m * NIN + c]); else if (c < 2576) v = DT[m * 16 + (c - 2560)]; else v = bf2f(U16[m * NIN + c - 16]);
    U[idx] = v;
}
__global__ void __launch_bounds__(256) k_f32_to_bf16(const float* __restrict__ src, bf16* __restrict__ dst) {
    const size_t i = (size_t)blockIdx.x * 256 + threadIdx.x;
    const float4 v = ((const float4*)src)[i]; v2u o; o.x = pk2(v.x, v.y); o.y = pk2(v.z, v.w); ((v2u*)dst)[i] = o;
}
__global__ void __launch_bounds__(256) k_ssdhalf_to_bf16(const float* __restrict__ YCATf, bf16* __restrict__ YCAT16) {
    const size_t i = (size_t)blockIdx.x * 256 + threadIdx.x;
    const size_t m = i >> 8; const int c4 = (int)(i & 255);
    const float4 v = ((const float4*)(YCATf + m * DM))[c4]; v2u o; o.x = pk2(v.x, v.y); o.y = pk2(v.z, v.w); ((v2u*)(YCAT16 + m * DM))[c4] = o;
}

#ifndef MK_ONE_LAUNCH
#define MK_ONE_LAUNCH 1
#endif
extern "C" void kernel_launch(void* const* d_in, const int* in_sizes, int n_in, void* d_out, int out_size, void* d_ws, size_t ws_size, hipStream_t stream) {
    static int ready = 0;
    if (!ready) {
        if (hipFuncSetAttribute((const void*)mega, hipFuncAttributeMaxDynamicSharedMemorySize, LDS_BYTES) != hipSuccess) { fprintf(stderr, "hipFuncSetAttribute failed\n"); }
        if (ws_size < mp::END) fprintf(stderr, "kernel_launch: ws_size %zu too small\n", ws_size);
        ready = 1;
    }
    (void)hipMemsetAsync(d_ws, 0, CTL_ZERO_BYTES, stream);
    Args a{};
    for (int i = 0; i < 26; ++i) a.in[i] = d_in[i];
    a.out = (float*)d_out; a.ws = (unsigned char*)d_ws;
    a.p0_mask = 1 | 2 | 4 | 8 | 16 | (3 << 5) | 128; a.rep_phase = MK_REP_PHASE;
#if MK_ONE_LAUNCH
    a.ph_lo = 0; a.ph_hi = N_PHASES; a.li = -1; hipLaunchKernelGGL(mega, dim3(256), dim3(NWAVES * 64), LDS_BYTES, stream, a);
#else
    for (int ph = 0; ph < N_PHASES; ++ph) { a.ph_lo = ph; a.ph_hi = ph + 1; a.li = ph; hipLaunchKernelGGL(mega, dim3(256), dim3(NWAVES * 64), LDS_BYTES, stream, a); }
#endif
}
```

```cpp
#include <hip/hip_runtime.h>
#include <hip/hip_bf16.h>
#include <math.h>
#include <stdint.h>
#include <cstdio>
#include <cmath>
namespace pg8 {
#define PG8_LAS __attribute__((address_space(3)))
typedef unsigned short bf16_t;
typedef short bf16x8 __attribute__((ext_vector_type(8)));
typedef float f32x4 __attribute__((ext_vector_type(4)));
typedef unsigned u32x4 __attribute__((ext_vector_type(4)));
typedef int v8i_t __attribute__((ext_vector_type(8)));
constexpr int BM = 256, BK = 64, HALF = 128, HTB = HALF * BK * 2  , STAGE_BYTES = 8 * HTB, NXCD = 8, WGM = 8;

__host__ __device__ __forceinline__ int lds_byte(int r, int c) { const int st = (r >> 4) * 2 + (c >> 5), rr = r & 15, cc = c & 31, ob = rr * 64 + cc * 2; return st * 1024 + (ob ^ (((ob >> 9) & 1) << 5)); }
__host__ __device__ __forceinline__ void stage_rc(int b, int& R, int& C) { const int st = b / 1024, sb = b % 1024, swz = sb ^ (((sb >> 9) & 1) << 5); R = (st >> 1) * 16 + swz / 64; C = (st & 1) * 32 + (swz % 64) / 2; }
__host__ __device__ __forceinline__ int perm32(int rho) { const int n = rho >> 4, i = rho & 15; return 8 * (i >> 2) + 4 * n + (i & 3); }

struct Unit { int pm, pn; };
struct Gemm { const bf16_t* A; const bf16_t* Bt; int M, N, K; };

struct StaticOrder {
    int nM, nN, nwg, G, c;
    __host__ __device__ void init(int M, int N, int G_, int c_) { nM = M / BM; nN = N / BM; nwg = nM * nN; G = G_; c = c_; }
    __host__ __device__ bool next(int i, Unit& u) const {
        const long L = (long)i * G + c; if (L >= nwg) return false;
        int wgid = (int)L; { const int q = nwg / NXCD, r = nwg % NXCD, xcd = wgid % NXCD, off = wgid / NXCD; wgid = (xcd < r ? xcd * (q + 1) : r * (q + 1) + (xcd - r) * q) + off; }
        const int nig = WGM * nN, gid = wgid / nig, fm = gid * WGM, gsz = (nM - fm) < WGM ? (nM - fm) : WGM;
        u.pm = fm + ((wgid % nig) % gsz); u.pn = (wgid % nig) / gsz; return true;
    }
    __device__ __forceinline__ int rows(const Unit&) const { return BM; }
    __device__ __forceinline__ void a_ready(const Unit&) const {}
    __device__ __forceinline__ void done(const Unit&) const {}
};

__device__ __forceinline__ unsigned cvt_pk_bf16(float lo, float hi) { unsigned r; asm volatile("v_cvt_pk_bf16_f32 %0, %1, %2" : "=v"(r) : "v"(lo), "v"(hi)); return r; }
typedef float f32x2 __attribute__((ext_vector_type(2)));
__device__ __forceinline__ f32x2 gelu_pk(f32x2 v) {
    const f32x2 av = __builtin_elementwise_abs(v), d = av * 0.2316418882f + 1.0f;
    f32x2 t; t.x = __builtin_amdgcn_rcpf(d.x); t.y = __builtin_amdgcn_rcpf(d.y);
    f32x2 q = t * 0.5307027145f + (-0.7265760135f); q = q * t + 0.7107068705f; q = q * t + (-0.142248368f); q = q * t + 0.127414796f; q = q * t;
    const f32x2 s = (v * v) * (-0.72134752044f);
    f32x2 e; e.x = __builtin_amdgcn_exp2f(s.x); e.y = __builtin_amdgcn_exp2f(s.y);
    const f32x2 m = v * (q * e), r = v - m;
    f32x2 o; o.x = v.x < 0.f ? m.x : r.x; o.y = v.y < 0.f ? m.y : r.y; return o;
}

template <int ACT  > struct EpiBf16 {
    static constexpr bool PERM = true, AFTER_DRAIN = false; static_assert(ACT == 0 || ACT == 1, "EpiBf16: ACT is 0 (none) or 1 (gelu_pk)");
    bf16_t* O; int ldc; const float* bias; int split_cols; size_t split_stride; float scale0;
    __device__ __forceinline__ void operator()(const f32x4 (&acc)[2][2][4][2], const Unit& u, int wr, int wc, int fr, int fq) const {
        const int row0 = u.pm * BM + wr * 64 + fr; int colt = u.pn * BM; bf16_t* base = O;
        float sc = 1.f; if (split_cols) { const int t = colt / split_cols; base += (size_t)t * split_stride; colt -= t * split_cols; if (t == 0) sc = scale0; }
        const int col0 = colt + wc * 32 + 8 * fq, bcol0 = u.pn * BM + wc * 32 + 8 * fq;
        f32x4 bv[2][2];
#pragma unroll
        for (int bj = 0; bj < 2; ++bj)
#pragma unroll
            for (int n = 0; n < 2; ++n) bv[bj][n] = bias ? *(const f32x4*)(bias + bcol0 + bj * HALF + 4 * n) : (f32x4){0.f, 0.f, 0.f, 0.f};
#pragma unroll
        for (int ai = 0; ai < 2; ++ai)
#pragma unroll
            for (int m = 0; m < 4; ++m) { bf16_t* rowp = base + (size_t)(row0 + ai * HALF + m * 16) * ldc + col0;
#pragma unroll
                for (int bj = 0; bj < 2; ++bj) { f32x4 v0 = acc[ai][bj][m][0] + bv[bj][0], v1 = acc[ai][bj][m][1] + bv[bj][1];
                    if (ACT == 1) { f32x2 a = gelu_pk((f32x2){v0[0], v0[1]}), b = gelu_pk((f32x2){v0[2], v0[3]}), c = gelu_pk((f32x2){v1[0], v1[1]}), d = gelu_pk((f32x2){v1[2], v1[3]});
                        v0 = (f32x4){a.x, a.y, b.x, b.y}; v1 = (f32x4){c.x, c.y, d.x, d.y}; }
                    v0 = v0 * sc; v1 = v1 * sc; u32x4 w; w.x = cvt_pk_bf16(v0[0], v0[1]); w.y = cvt_pk_bf16(v0[2], v0[3]); w.z = cvt_pk_bf16(v1[0], v1[1]); w.w = cvt_pk_bf16(v1[2], v1[3]);
                    *(u32x4*)(rowp + bj * HALF) = w; } }
    }
};

struct ConvNone { static constexpr bool ON = false; static constexpr int LDS_OFF = 0; };
template <class Epi, class Sched, bool ALIGN_EPI = false, bool SP2 = false, bool F8 = false, class CV = ConvNone>
__device__ __forceinline__ void gemm_phase(PG8_LAS unsigned char* lds, const Gemm g, const Sched& S, const Epi& E, const CV& cv = CV{}) {
    static_assert(!CV::ON || SP2, "the side job's vmcnt arithmetic is written for the SP2 schedule");
    const int tid = threadIdx.x, wid = __builtin_amdgcn_readfirstlane(tid >> 6), lane = tid & 63, wr = wid >> 2, wc = wid & 3, fr = lane & 15, fq = lane >> 4;
    const int K = g.K, nt = K / BK;
    unsigned voffA[2], voffB[2];
#pragma unroll
    for (int i = 0; i < 2; ++i) { int R, C; stage_rc(tid * 16 + i * 8192, R, C); const int Rb = Epi::PERM ? ((R & ~31) + perm32(R & 31)) : R;
        voffA[i] = (unsigned)(R * K + C) * 2u; voffB[i] = (unsigned)(Rb * K + C) * 2u; }
    const size_t kstep = (size_t)(BK * 2);
    const size_t hstep = (size_t)HALF * K * 2;
    const size_t tstep = 2 * hstep;
    const unsigned ldsw = (unsigned)wid * 1024u;
    const int aoff = lds_byte(wr * 64 + fr, fq * 8), boff = lds_byte(wc * 32 + fr, fq * 8);
#define PG8_CAT8(x, y) __builtin_bit_cast(v8i_t, __builtin_shufflevector((x), (y), 0, 1, 2, 3, 4, 5, 6, 7, 8, 9, 10, 11, 12, 13, 14, 15))
#define PG8_SA(b, h) (((b) * 2 + (h)) * HTB)
#define PG8_SB(b, h) ((4 + (b) * 2 + (h)) * HTB)
#define PG8_STAGE(bufoff, gbase, voff) do { _Pragma("unroll") for (int _i = 0; _i < 2; ++_i) \
        __builtin_amdgcn_global_load_lds((const unsigned*)((const char*)(gbase) + (voff)[_i]), (PG8_LAS unsigned*)(lds + (bufoff) + ldsw + _i * 8192), 16, 0, 0); } while (0)
#define PG8_LDA(dst, b, h) do { if constexpr (F8) { _Pragma("unroll") for (int m = 0; m < 4; ++m) dst##8[m] = PG8_CAT8(*(const PG8_LAS bf16x8*)(lds + PG8_SA(b, h) + aoff + m * 2048), *(const PG8_LAS bf16x8*)(lds + PG8_SA(b, h) + aoff + m * 2048 + 1024)); } else _Pragma("unroll") for (int m = 0; m < 4; ++m) _Pragma("unroll") for (int k = 0; k < 2; ++k) dst[m][k] = *(const PG8_LAS bf16x8*)(lds + PG8_SA(b, h) + aoff + m * 2048 + k * 1024); } while (0)
#define PG8_LDB(dst, b, h) do { if constexpr (F8) { _Pragma("unroll") for (int n = 0; n < 2; ++n) dst##8[n] = PG8_CAT8(*(const PG8_LAS bf16x8*)(lds + PG8_SB(b, h) + boff + n * 2048), *(const PG8_LAS bf16x8*)(lds + PG8_SB(b, h) + boff + n * 2048 + 1024)); } else _Pragma("unroll") for (int n = 0; n < 2; ++n) _Pragma("unroll") for (int k = 0; k < 2; ++k) dst[n][k] = *(const PG8_LAS bf16x8*)(lds + PG8_SB(b, h) + boff + n * 2048 + k * 1024); } while (0)
#define PG8_MMA(ai, bj, At, Bt) do { __builtin_amdgcn_s_setprio(1); \
        if constexpr (F8) { _Pragma("unroll") for (int m = 0; m < 4; ++m) _Pragma("unroll") for (int n = 0; n < 2; ++n) \
            asm volatile("v_mfma_f32_16x16x128_f8f6f4 %0, %1, %2, %0" : "+v"(acc[ai][bj][m][n]) : "v"(Bt##8[n]), "v"(At##8[m])); }     \
        else { _Pragma("unroll") for (int m = 0; m < 4; ++m) _Pragma("unroll") for (int n = 0; n < 2; ++n) _Pragma("unroll") for (int k = 0; k < 2; ++k) \
            acc[ai][bj][m][n] = __builtin_amdgcn_mfma_f32_16x16x32_bf16(Bt[n][k], At[m][k], acc[ai][bj][m][n], 0, 0, 0); } \
        __builtin_amdgcn_s_setprio(0); } while (0)
#define PG8_WAIT_V(n) asm volatile("s_waitcnt vmcnt(" #n ")" ::: "memory")
#define PG8_WAIT_L(n) asm volatile("s_waitcnt lgkmcnt(" #n ")" ::: "memory")
#define PG8_BAR __builtin_amdgcn_s_barrier()
#define PG8_SCHED __builtin_amdgcn_sched_barrier(0)
    Unit cur, nxt; int ui = 0;
    if (!S.next(0, cur)) return;
    bool skip1 = S.rows(cur) <= HALF;
    f32x4 acc[2][2][4][2];
#pragma unroll
    for (int a = 0; a < 2; ++a)
#pragma unroll
        for (int b = 0; b < 2; ++b)
#pragma unroll
            for (int m = 0; m < 4; ++m)
#pragma unroll
                for (int n = 0; n < 2; ++n) acc[a][b][m][n] = (f32x4){0.f, 0.f, 0.f, 0.f};
    bf16x8 At[4][2], B0[2][2], B1[2][2];
    v8i_t At8[4], B08[2], B18[2];
    const char* cA = (const char*)g.A + (size_t)cur.pm * tstep; const char* cB = (const char*)g.Bt + (size_t)cur.pn * tstep;
    S.a_ready(cur);
    typedef float cvf2 __attribute__((ext_vector_type(2))); typedef unsigned cvu2 __attribute__((ext_vector_type(2)));
    cvu2 cvo0 = {0u, 0u}, cvo1 = {0u, 0u};
    const char* cv_sb = nullptr; unsigned cv_sv = 0, cv_db = 0, cv_dv = 0, cv_stb = 0, cv_stv = 0; int cv_dn = 0, cv_stdn = 0;
    unsigned char* cv_ws = nullptr; unsigned cv_slot = 0;
    PG8_LAS unsigned char* const cv_lds = lds + CV::LDS_OFF + wid * 3072;
    if constexpr (CV::ON) { cv.decode(cur, wid, lane, cv_sb, cv_dn, cv_db, cv_dv, cv_sv); cv_ws = cv.wsbase(); cv_stb = CV::DUMMY_OFF; cv_stdn = 0; cv_stv = (unsigned)tid * 16u; }
#define CV_LD(slot) do { if constexpr (CV::ON) { \
        __builtin_amdgcn_global_load_lds((const unsigned*)(cv_sb + (size_t)((2 * slot) * (cv_dn ? 8192u : 4096u)) + cv_sv), (PG8_LAS unsigned*)(cv_lds + cv_slot), 16, 0, 0); \
        cv_slot = cv_slot == 2048u ? 0u : cv_slot + 1024u; } } while (0)
#define CV_CVT(slot, dw, hi) do { if constexpr (CV::ON) { \
        const cvf2 ra_ = *(const PG8_LAS cvf2*)(cv_lds + cv_slot + lane * 8), rb_ = *(const PG8_LAS cvf2*)(cv_lds + cv_slot + 512 + lane * 8); \
        cvo0[dw] = (unsigned)__builtin_amdgcn_cvt_pk_fp8_f32(ra_.x * CV::SCALE, rb_.x * CV::SCALE, (int)cvo0[dw], hi); \
        cvo1[dw] = (unsigned)__builtin_amdgcn_cvt_pk_fp8_f32(ra_.y * CV::SCALE, rb_.y * CV::SCALE, (int)cvo1[dw], hi); } } while (0)
#define CV_ST() do { if constexpr (CV::ON) { unsigned char* p_ = cv_ws + cv_stb; *(__attribute__((address_space(1))) cvu2*)(p_ + cv_stv) = cvo0; *(__attribute__((address_space(1))) cvu2*)(p_ + (cv_stdn ? 1024u : 2048u) + cv_stv) = cvo1; } } while (0)
    if constexpr (SP2) {
        PG8_STAGE(PG8_SB(0, 0), cB, voffB); PG8_STAGE(PG8_SB(0, 1), cB + hstep, voffB); PG8_STAGE(PG8_SA(0, 0), cA, voffA); PG8_STAGE(PG8_SA(0, 1), cA + hstep, voffA);
        if (wr == 1) PG8_BAR;
        PG8_WAIT_V(2); PG8_BAR;
        PG8_STAGE(PG8_SB(1, 0), cB + kstep, voffB); PG8_STAGE(PG8_SA(1, 0), cA + kstep, voffA); PG8_STAGE(PG8_SB(1, 1), cB + hstep + kstep, voffB);
        PG8_WAIT_V(6); PG8_BAR;
    } else {
        PG8_STAGE(PG8_SB(0, 0), cB, voffB); PG8_STAGE(PG8_SA(0, 0), cA, voffA); PG8_STAGE(PG8_SB(0, 1), cB + hstep, voffB); PG8_STAGE(PG8_SA(0, 1), cA + hstep, voffA);
        if (wr == 1) PG8_BAR;
        PG8_WAIT_V(4); PG8_BAR;
        PG8_STAGE(PG8_SB(1, 0), cB + kstep, voffB); PG8_STAGE(PG8_SA(1, 0), cA + kstep, voffA); PG8_STAGE(PG8_SB(1, 1), cB + hstep + kstep, voffB);
        PG8_WAIT_V(6); PG8_BAR;
    }
    for (;;) {
        const bool has_next = S.next(ui + 1, nxt);
        const char* nA = has_next ? (const char*)g.A + (size_t)nxt.pm * tstep : cA; const char* nB = has_next ? (const char*)g.Bt + (size_t)nxt.pn * tstep : cB;
#pragma clang loop unroll(disable)
        for (int t = 0; t < nt; t += 2) {
            const bool last = (t == nt - 2);
            const char* a1 = cA + (size_t)(t + 1) * kstep;
            const char* a2 = last ? nA : cA + (size_t)(t + 2) * kstep; const char* b2 = last ? nB : cB + (size_t)(t + 2) * kstep;
            const char* a3 = a2 + kstep; const char* b3 = b2 + kstep;
            if (last && has_next) S.a_ready(nxt);
            if constexpr (SP2) {
            PG8_LDB(B0, 0, 0); PG8_LDB(B1, 0, 1); PG8_SCHED; PG8_LDA(At, 0, 0); PG8_STAGE(PG8_SA(1, 1), a1 + hstep, voffA); CV_LD(0);
            if constexpr (CV::ON) PG8_WAIT_V(10); else PG8_WAIT_V(8);
            PG8_WAIT_L(0); PG8_BAR; PG8_MMA(0, 0, At, B0); PG8_MMA(0, 1, At, B1); CV_CVT(2, 1, false); PG8_BAR; PG8_SCHED;
            PG8_LDA(At, 0, 1); PG8_STAGE(PG8_SB(0, 0), b2, voffB); PG8_STAGE(PG8_SB(0, 1), b2 + hstep, voffB); PG8_STAGE(PG8_SA(0, 0), a2, voffA); CV_LD(1);
            if constexpr (CV::ON) PG8_WAIT_V(10); else PG8_WAIT_V(8);
            PG8_WAIT_L(0); PG8_BAR; if (!skip1) { PG8_MMA(1, 0, At, B0); PG8_MMA(1, 1, At, B1); } CV_CVT(3, 1, true); PG8_BAR; PG8_SCHED;
            CV_ST(); if constexpr (CV::ON) { cv_stb = cv_db + 4 * t; cv_stdn = cv_dn; cv_stv = cv_dv; }
            PG8_LDB(B0, 1, 0); PG8_LDB(B1, 1, 1); PG8_SCHED; PG8_LDA(At, 1, 0); PG8_STAGE(PG8_SA(0, 1), a2 + hstep, voffA); CV_LD(2);
            if constexpr (CV::ON) PG8_WAIT_V(12); else PG8_WAIT_V(8);
            PG8_WAIT_L(0); PG8_BAR; PG8_MMA(0, 0, At, B0); PG8_MMA(0, 1, At, B1); CV_CVT(0, 0, false); PG8_BAR; PG8_SCHED;
            PG8_LDA(At, 1, 1); PG8_STAGE(PG8_SB(1, 0), b3, voffB); PG8_STAGE(PG8_SB(1, 1), b3 + hstep, voffB); PG8_STAGE(PG8_SA(1, 0), a3, voffA); CV_LD(3);
            if constexpr (CV::ON) PG8_WAIT_V(12); else PG8_WAIT_V(8);
            PG8_WAIT_L(0); PG8_BAR; if (!skip1) { PG8_MMA(1, 0, At, B0); PG8_MMA(1, 1, At, B1); } CV_CVT(1, 0, true); PG8_BAR; PG8_SCHED;
            if constexpr (CV::ON) cv_sb += cv_dn ? 65536 : 32768;
            } else {
            PG8_LDB(B0, 0, 0); PG8_SCHED; PG8_LDA(At, 0, 0); PG8_STAGE(PG8_SA(1, 1), a1 + hstep, voffA);
            PG8_WAIT_L(8); PG8_BAR; PG8_WAIT_L(0); PG8_MMA(0, 0, At, B0); PG8_BAR; PG8_SCHED;
            PG8_LDB(B1, 0, 1); PG8_STAGE(PG8_SB(0, 0), b2, voffB);
            PG8_BAR; PG8_WAIT_L(0); PG8_MMA(0, 1, At, B1); PG8_BAR;
            PG8_LDA(At, 0, 1); PG8_STAGE(PG8_SA(0, 0), a2, voffA);
            PG8_BAR; PG8_WAIT_L(0); PG8_MMA(1, 0, At, B0); PG8_BAR; PG8_SCHED;
            PG8_STAGE(PG8_SB(0, 1), b2 + hstep, voffB);
            PG8_WAIT_V(6); PG8_BAR; PG8_MMA(1, 1, At, B1); PG8_BAR;
            PG8_LDB(B0, 1, 0); PG8_SCHED; PG8_LDA(At, 1, 0); PG8_STAGE(PG8_SA(0, 1), a2 + hstep, voffA);
            PG8_WAIT_L(8); PG8_BAR; PG8_WAIT_L(0); PG8_MMA(0, 0, At, B0); PG8_BAR; PG8_SCHED;
            PG8_LDB(B1, 1, 1); PG8_STAGE(PG8_SB(1, 0), b3, voffB);
            PG8_BAR; PG8_WAIT_L(0); PG8_MMA(0, 1, At, B1); PG8_BAR;
            PG8_LDA(At, 1, 1); PG8_STAGE(PG8_SA(1, 0), a3, voffA);
            PG8_BAR; PG8_WAIT_L(0); PG8_MMA(1, 0, At, B0); PG8_BAR; PG8_SCHED;
            PG8_STAGE(PG8_SB(1, 1), b3 + hstep, voffB);
            PG8_WAIT_V(6); PG8_BAR; PG8_MMA(1, 1, At, B1); PG8_BAR;
            }
        }
        if constexpr (F8) asm volatile("s_nop 15\n\ts_nop 7" ::: "memory");
        if constexpr (ALIGN_EPI) { if (wr == 0) PG8_BAR; }
        if constexpr (!Epi::AFTER_DRAIN) { int fr_ = fr, fq_ = fq; asm volatile("" : "+v"(fr_), "+v"(fq_));
            E(acc, cur, wr, wc, fr_, fq_); S.done(cur); }
        if (!has_next) break;
#pragma unroll
        for (int a = 0; a < 2; ++a)
#pragma unroll
            for (int b = 0; b < 2; ++b)
#pragma unroll
                for (int m = 0; m < 4; ++m)
#pragma unroll
                    for (int n = 0; n < 2; ++n) acc[a][b][m][n] = (f32x4){0.f, 0.f, 0.f, 0.f};
        cur = nxt; cA = nA; cB = nB; ++ui; skip1 = S.rows(cur) <= HALF;
        if constexpr (CV::ON) cv.decode(cur, wid, lane, cv_sb, cv_dn, cv_db, cv_dv, cv_sv);
        if constexpr (ALIGN_EPI) { if (wr == 1) PG8_BAR; }
    }
    PG8_WAIT_V(0);
    if constexpr (CV::ON) { cv_slot = cv_slot == 2048u ? 0u : cv_slot + 1024u; CV_CVT(2, 1, false); cv_slot = cv_slot == 2048u ? 0u : cv_slot + 1024u; CV_CVT(3, 1, true); CV_ST(); }
    if constexpr (!ALIGN_EPI) { if (wr == 0) PG8_BAR; }
    PG8_BAR;
    if constexpr (Epi::AFTER_DRAIN) { E.fused(acc, cur, wr, wc, fr, fq, lds, wid, lane); S.done(cur); }
#undef PG8_SA
#undef PG8_SB
#undef PG8_STAGE
#undef PG8_LDA
#undef PG8_LDB
#undef PG8_MMA
#undef PG8_CAT8
#undef PG8_WAIT_V
#undef PG8_WAIT_L
#undef PG8_BAR
#undef PG8_SCHED
#undef CV_LD
#undef CV_CVT
#undef CV_ST
}
}

namespace pg8 {
__device__ __forceinline__ void store16_wt(void* p, u32x4 v) { asm volatile("global_store_dwordx4 %0, %1, off sc1\n\ts_nop 1" :: "v"(p), "v"(v) : "memory"); }
__device__ __forceinline__ float clamp_f8(float v) { return __builtin_fminf(__builtin_fmaxf(v, -448.f), 448.f); }
__device__ __forceinline__ unsigned cvt4_fp8(float a, float b, float c, float d) { int w = 0; w = __builtin_amdgcn_cvt_pk_fp8_f32(a, b, w, false); w = __builtin_amdgcn_cvt_pk_fp8_f32(c, d, w, true); return (unsigned)w; }
__device__ __forceinline__ unsigned cvt4_fp8c(float a, float b, float c, float d) { return cvt4_fp8(clamp_f8(a), clamp_f8(b), clamp_f8(c), clamp_f8(d)); }
struct EpiInProj {
    static constexpr bool PERM = true, AFTER_DRAIN = false;
    bf16_t* O; int ldc; float* DT;
    __device__ __forceinline__ void operator()(const f32x4 (&acc)[2][2][4][2], const Unit& u, int wr, int wc, int fr, int fq) const {
        const int row0 = u.pm * BM + wr * 64 + fr;
        if (u.pn == 22) {
            if (wc == 0 && fq < 2) {
#pragma unroll
                for (int ai = 0; ai < 2; ++ai)
#pragma unroll
                    for (int m = 0; m < 4; ++m) { float* dp = DT + (size_t)(row0 + ai * HALF + m * 16) * 16 + 8 * fq; *(f32x4*)dp = acc[ai][0][m][0]; *(f32x4*)(dp + 4) = acc[ai][0][m][1]; } }
            return; }
        const int col0 = u.pn * BM + wc * 32 + 8 * fq;
#pragma unroll
        for (int ai = 0; ai < 2; ++ai)
#pragma unroll
            for (int m = 0; m < 4; ++m) { bf16_t* rowp = O + (size_t)(row0 + ai * HALF + m * 16) * ldc + col0;
#pragma unroll
                for (int bj = 0; bj < 2; ++bj) { const f32x4 v0 = acc[ai][bj][m][0], v1 = acc[ai][bj][m][1];
                    u32x4 w; w.x = cvt_pk_bf16(v0[0], v0[1]); w.y = cvt_pk_bf16(v0[2], v0[3]); w.z = cvt_pk_bf16(v1[0], v1[1]); w.w = cvt_pk_bf16(v1[2], v1[3]);
                    *(u32x4*)(rowp + bj * HALF) = w; } }
    }
};
struct EpiResid {
    static constexpr bool PERM = true, AFTER_DRAIN = false;
    const float* base; bf16_t* hb; unsigned char* h8; int ldc; const float* cs;
    __device__ __forceinline__ void operator()(const f32x4 (&acc)[2][2][4][2], const Unit& u, int wr, int wc, int fr, int fq) const {
        const int row0 = u.pm * BM + wr * 64 + fr, col0 = u.pn * BM + wc * 32 + 8 * fq;
        typedef unsigned u32x2_t __attribute__((ext_vector_type(2)));
        f32x4 csv[2][2];
#pragma unroll
        for (int bj = 0; bj < 2; ++bj) { csv[bj][0] = *(const f32x4*)(cs + col0 + bj * HALF); csv[bj][1] = *(const f32x4*)(cs + col0 + bj * HALF + 4); }
#pragma unroll
        for (int ai = 0; ai < 2; ++ai) {
            f32x4 xr[4][2][2];
#pragma unroll
            for (int m = 0; m < 4; ++m) { const size_t off = (size_t)(row0 + ai * HALF + m * 16) * ldc + col0;
#pragma unroll
                for (int bj = 0; bj < 2; ++bj) { xr[m][bj][0] = __builtin_nontemporal_load((const f32x4*)(base + off + bj * HALF)); xr[m][bj][1] = __builtin_nontemporal_load((const f32x4*)(base + off + bj * HALF + 4)); } }
#pragma unroll
            for (int m = 0; m < 4; ++m) { const size_t off = (size_t)(row0 + ai * HALF + m * 16) * ldc + col0;
#pragma unroll
                for (int bj = 0; bj < 2; ++bj) {
                    const f32x4 v0 = acc[ai][bj][m][0] + xr[m][bj][0], v1 = acc[ai][bj][m][1] + xr[m][bj][1];
                    u32x4 w; w.x = cvt_pk_bf16(v0[0], v0[1]); w.y = cvt_pk_bf16(v0[2], v0[3]); w.z = cvt_pk_bf16(v1[0], v1[1]); w.w = cvt_pk_bf16(v1[2], v1[3]);
                    *(u32x4*)(hb + off + bj * HALF) = w;
                    const f32x4 s0 = v0 * csv[bj][0], s1 = v1 * csv[bj][1];
                    u32x2_t q; q.x = cvt4_fp8c(s0[0], s0[1], s0[2], s0[3]); q.y = cvt4_fp8c(s1[0], s1[1], s1[2], s1[3]);
                    *(u32x2_t*)(h8 + off + bj * HALF) = q; } }
        }
    }
};
struct ExpertScale {
    const PG8_LAS int* tab; const float* lst; int lcap;
    __device__ __forceinline__ int rows(const Unit& u) const { const int e = u.pn >> 3; return tab[80 + e] - (u.pm - tab[40 + e]) * BM; }
    __device__ __forceinline__ float at(const Unit& u, int rowlocal) const { const int e = u.pn >> 3, p = (u.pm - tab[40 + e]) * BM + rowlocal; return p < tab[80 + e] ? lst[(size_t)e * lcap + p] : 0.f; }
};
struct EpiGateUp {
    static constexpr bool PERM = true, AFTER_DRAIN = false;
    unsigned char* O; int ldc; ExpertScale rs; float wsc;
    __device__ __forceinline__ void operator()(const f32x4 (&acc)[2][2][4][2], const Unit& u, int wr, int wc, int fr, int fq) const {
        const int rl0 = wr * 64 + fr, col0 = (u.pn & 7) * HALF + wc * 32 + 8 * fq;
        float rsc[2][4];
#pragma unroll
        for (int ai = 0; ai < 2; ++ai)
#pragma unroll
            for (int m = 0; m < 4; ++m) rsc[ai][m] = rs.at(u, rl0 + ai * HALF + m * 16) * wsc;
        const bool half_only = rs.rows(u) <= HALF;
#pragma unroll
        for (int ai = 0; ai < 2; ++ai) { if (ai == 1 && half_only) continue;
#pragma unroll
            for (int m = 0; m < 4; ++m) { const int rl = rl0 + ai * HALF + m * 16; const float r = rsc[ai][m];
                float hv[8];
#pragma unroll
                for (int n = 0; n < 2; ++n)
#pragma unroll
                    for (int j = 0; j < 4; ++j) { const float g = acc[ai][0][m][n][j] * r, up = acc[ai][1][m][n][j] * r; hv[n * 4 + j] = g * __builtin_amdgcn_rcpf(1.f + __builtin_amdgcn_exp2f(-1.44269504089f * g)) * up; }
                typedef unsigned u32x2_t __attribute__((ext_vector_type(2))); u32x2_t q; q.x = cvt4_fp8c(hv[0], hv[1], hv[2], hv[3]); q.y = cvt4_fp8c(hv[4], hv[5], hv[6], hv[7]);
                *(u32x2_t*)(O + (size_t)(u.pm * BM + rl) * ldc + col0) = q; } }
    }
};
struct EpiRowScale {
    static constexpr bool PERM = true, AFTER_DRAIN = false;
    unsigned char* O; int ldc; ExpertScale rs; float wsc;
    __device__ __forceinline__ void operator()(const f32x4 (&acc)[2][2][4][2], const Unit& u, int wr, int wc, int fr, int fq) const {
        const int rl0 = wr * 64 + fr, col0 = (u.pn & 7) * BM + wc * 64 + 16 * fq;
        float rsc[2][4];
#pragma unroll
        for (int ai = 0; ai < 2; ++ai)
#pragma unroll
            for (int m = 0; m < 4; ++m) rsc[ai][m] = rs.at(u, rl0 + ai * HALF + m * 16) * wsc;
        const bool half_only = rs.rows(u) <= HALF;
#pragma unroll
        for (int ai = 0; ai < 2; ++ai) { if (ai == 1 && half_only) continue;
#pragma unroll
            for (int m = 0; m < 4; ++m) { const int rl = rl0 + ai * HALF + m * 16; const float r = rsc[ai][m];
                const f32x4 v0 = acc[ai][0][m][0] * r, v1 = acc[ai][0][m][1] * r, v2 = acc[ai][1][m][0] * r, v3 = acc[ai][1][m][1] * r;
                u32x4 q; q.x = cvt4_fp8c(v0[0], v0[1], v0[2], v0[3]); q.y = cvt4_fp8c(v1[0], v1[1], v1[2], v1[3]); q.z = cvt4_fp8c(v2[0], v2[1], v2[2], v2[3]); q.w = cvt4_fp8c(v3[0], v3[1], v3[2], v3[3]);
                *(u32x4*)(O + (size_t)(u.pm * BM + rl) * ldc + col0) = q; } }
    }
};
struct ExpertOrder {
    const PG8_LAS int* tab; int nwg, G, c;
    __device__ __forceinline__ void init(const PG8_LAS int* t, int G_, int c_) { tab = t; nwg = t[32]; G = G_; c = c_; }
    __device__ __forceinline__ bool next(int i, Unit& u) const {
        const long L = (long)i * G + c; if (L >= nwg) return false;
        int wgid = (int)L; { const int q = nwg / NXCD, r = nwg % NXCD, xcd = wgid % NXCD, off = wgid / NXCD; wgid = (xcd < r ? xcd * (q + 1) : r * (q + 1) + (xcd - r) * q) + off; }
        const int tj = tab[threadIdx.x & 31];
        const int e = __builtin_popcountll(__ballot(wgid >= tj) & 0xffffffffull) - 1;
        const int local_i = wgid - tab[e], mt = (tab[e + 1] - tab[e]) >> 3;
        u.pm = tab[40 + e] + local_i % mt; u.pn = e * 8 + local_i / mt; return true;
    }
    __device__ __forceinline__ int rows(const Unit& u) const { const int e = u.pn >> 3; return tab[80 + e] - (u.pm - tab[40 + e]) * BM; }
    __device__ __forceinline__ void a_ready(const Unit&) const {}
    __device__ __forceinline__ void done(const Unit&) const {}
};
struct TeamOrder {
    int c, i0, i1;
    __device__ __forceinline__ bool next(int i, Unit& u) const {
        i += i0; if (i >= i1) return false;
        const int xcd = c & 7, l = c >> 3; if (i * 32 + l >= 184) return false;
        int pmo, pn;
        if (i < 5) { const int t = l >> 3, j = l & 7; pmo = 4 * (t & 1) + (j & 3); pn = 4 * i + 2 * (t >> 1) + (j >> 2); }
        else { pmo = l & 7; pn = 20 + (l >> 3); }
        u.pm = 8 * xcd + pmo; u.pn = pn; return true;
    }
    __device__ __forceinline__ int rows(const Unit&) const { return BM; }
    __device__ __forceinline__ void a_ready(const Unit&) const {}
    __device__ __forceinline__ void done(const Unit&) const {}
};
template <class KArgs, int IN_GATE, size_t WGU_OFF, size_t WD_OFF, size_t DUMMY, int LDSOFF> struct ConvMoE {
    static constexpr bool ON = true; static constexpr float SCALE = 64.f;
    static constexpr unsigned DUMMY_OFF = (unsigned)DUMMY; static constexpr int LDS_OFF = LDSOFF; static constexpr int nN = 23;
    static_assert(WD_OFF + 64u * 1024 * 1024 < (1ull << 32) && DUMMY < (1ull << 32), "32-bit workspace offsets");
    __device__ __forceinline__ unsigned char* wsbase() const { const KArgs a = (KArgs)__builtin_amdgcn_kernarg_segment_ptr(); return a->ws; }
    __device__ __forceinline__ void decode(const Unit& u, int wid, int lane, const char*& sb, int& dn, unsigned& db, unsigned& dv, unsigned& sv) const {
        const KArgs a = (KArgs)__builtin_amdgcn_kernarg_segment_ptr();
        const int cb = (u.pm * nN + u.pn) * 8 + wid, nl = 2 * lane;
        if (cb < 8192) { const int up = cb >> 12, r = cb & 4095, e = r >> 7, kb = (r >> 3) & 15, nb = r & 7;
            sb = (const char*)((const float*)a->in[IN_GATE + up] + (size_t)e * 2048 * 1024 + (size_t)(128 * kb) * 1024 + 128 * nb); dn = 0;
            db = (unsigned)(WGU_OFF + (size_t)e * 2048 * 2048 + (size_t)(nb * 256 + up * 128) * 2048 + 128 * kb); dv = (unsigned)nl * 2048u; sv = (unsigned)(lane >> 5) * 4096u + (unsigned)(lane & 31) * 16u; }
        else { const int r = cb - 8192, e = r >> 7, kb = (r >> 4) & 7, nb = r & 15;
            sb = (const char*)((const float*)a->in[IN_GATE + 2] + (size_t)e * 1024 * 2048 + (size_t)(128 * kb) * 2048 + 128 * nb); dn = 1;
            db = (unsigned)(WD_OFF + (size_t)e * 2048 * 1024 + (size_t)(256 * (nb >> 1)) * 1024 + 128 * kb);
            dv = (unsigned)(((nl >> 3) & 1) * 128 + (2 * (nb & 1) + (nl >> 6)) * 32 + ((nl >> 4) & 3) * 8 + (nl & 7)) * 1024u; sv = (unsigned)(lane >> 5) * 8192u + (unsigned)(lane & 31) * 16u; }
    }
};
}

namespace pg8 {
template <class Epi, class Sched, class RowSrc, bool ALIGN_EPI = false, bool SP2 = false, bool F8 = false>
__device__ __forceinline__ void gemm_phase_g(PG8_LAS unsigned char* lds, const Gemm g, const Sched& S, const Epi& E, const RowSrc& RS) {
    const int tid = threadIdx.x, wid = __builtin_amdgcn_readfirstlane(tid >> 6), lane = tid & 63, wr = wid >> 2, wc = wid & 3, fr = lane & 15, fq = lane >> 4;
    const int K = g.K, nt = K / BK;
    unsigned voffB[2]; unsigned vC0[2], vC1[2], vN0[2], vN1[2]; int Rr[2], Cc[2];
#pragma unroll
    for (int i = 0; i < 2; ++i) { int R, C; stage_rc(tid * 16 + i * 8192, R, C); const int Rb = Epi::PERM ? ((R & ~31) + perm32(R & 31)) : R;
        Rr[i] = R; Cc[i] = C; voffB[i] = (unsigned)(Rb * K + C) * 2u; }
    const size_t kstep = (size_t)(BK * 2);
    const size_t hstep = (size_t)HALF * K * 2;
    const size_t tstep = 2 * hstep;
    const unsigned ldsw = (unsigned)wid * 1024u;
    const int aoff = lds_byte(wr * 64 + fr, fq * 8), boff = lds_byte(wc * 32 + fr, fq * 8);
#define PG8_CAT8(x, y) __builtin_bit_cast(v8i_t, __builtin_shufflevector((x), (y), 0, 1, 2, 3, 4, 5, 6, 7, 8, 9, 10, 11, 12, 13, 14, 15))
#define PG8_SA(b, h) (((b) * 2 + (h)) * HTB)
#define PG8_SB(b, h) ((4 + (b) * 2 + (h)) * HTB)
#define PG8_STAGE(bufoff, gbase, voff) do { _Pragma("unroll") for (int _i = 0; _i < 2; ++_i) \
        __builtin_amdgcn_global_load_lds((const unsigned*)((const char*)(gbase) + (voff)[_i]), (PG8_LAS unsigned*)(lds + (bufoff) + ldsw + _i * 8192), 16, 0, 0); } while (0)
#define PG8_LDA(dst, b, h) do { if constexpr (F8) { _Pragma("unroll") for (int m = 0; m < 4; ++m) dst##8[m] = PG8_CAT8(*(const PG8_LAS bf16x8*)(lds + PG8_SA(b, h) + aoff + m * 2048), *(const PG8_LAS bf16x8*)(lds + PG8_SA(b, h) + aoff + m * 2048 + 1024)); } else _Pragma("unroll") for (int m = 0; m < 4; ++m) _Pragma("unroll") for (int k = 0; k < 2; ++k) dst[m][k] = *(const PG8_LAS bf16x8*)(lds + PG8_SA(b, h) + aoff + m * 2048 + k * 1024); } while (0)
#define PG8_LDB(dst, b, h) do { if constexpr (F8) { _Pragma("unroll") for (int n = 0; n < 2; ++n) dst##8[n] = PG8_CAT8(*(const PG8_LAS bf16x8*)(lds + PG8_SB(b, h) + boff + n * 2048), *(const PG8_LAS bf16x8*)(lds + PG8_SB(b, h) + boff + n * 2048 + 1024)); } else _Pragma("unroll") for (int n = 0; n < 2; ++n) _Pragma("unroll") for (int k = 0; k < 2; ++k) dst[n][k] = *(const PG8_LAS bf16x8*)(lds + PG8_SB(b, h) + boff + n * 2048 + k * 1024); } while (0)
#define PG8_MMA(ai, bj, At, Bt) do { __builtin_amdgcn_s_setprio(1); \
        if constexpr (F8) { _Pragma("unroll") for (int m = 0; m < 4; ++m) _Pragma("unroll") for (int n = 0; n < 2; ++n) \
            asm volatile("v_mfma_f32_16x16x128_f8f6f4 %0, %1, %2, %0" : "+v"(acc[ai][bj][m][n]) : "v"(Bt##8[n]), "v"(At##8[m])); }     \
        else { _Pragma("unroll") for (int m = 0; m < 4; ++m) _Pragma("unroll") for (int n = 0; n < 2; ++n) _Pragma("unroll") for (int k = 0; k < 2; ++k) \
            acc[ai][bj][m][n] = __builtin_amdgcn_mfma_f32_16x16x32_bf16(Bt[n][k], At[m][k], acc[ai][bj][m][n], 0, 0, 0); } \
        __builtin_amdgcn_s_setprio(0); } while (0)
#define PG8_WAIT_V(n) asm volatile("s_waitcnt vmcnt(" #n ")" ::: "memory")
#define PG8_WAIT_L(n) asm volatile("s_waitcnt lgkmcnt(" #n ")" ::: "memory")
#define PG8_BAR __builtin_amdgcn_s_barrier()
#define PG8_SCHED __builtin_amdgcn_sched_barrier(0)
    Unit cur, nxt; int ui = 0;
    if (!S.next(0, cur)) return;
    bool skip1 = S.rows(cur) <= HALF;
    f32x4 acc[2][2][4][2];
#pragma unroll
    for (int a = 0; a < 2; ++a)
#pragma unroll
        for (int b = 0; b < 2; ++b)
#pragma unroll
            for (int m = 0; m < 4; ++m)
#pragma unroll
                for (int n = 0; n < 2; ++n) acc[a][b][m][n] = (f32x4){0.f, 0.f, 0.f, 0.f};
    bf16x8 At[4][2], B0[2][2], B1[2][2];
    v8i_t At8[4], B08[2], B18[2];
    const char* cA = (const char*)g.A; const char* cB = (const char*)g.Bt + (size_t)cur.pn * tstep;
    RS.rows(cur, Rr, Cc, K, vC0, vC1);
    S.a_ready(cur);
    if constexpr (SP2) {
        PG8_STAGE(PG8_SB(0, 0), cB, voffB); PG8_STAGE(PG8_SB(0, 1), cB + hstep, voffB); PG8_STAGE(PG8_SA(0, 0), cA, vC0); PG8_STAGE(PG8_SA(0, 1), cA, vC1);
        if (wr == 1) PG8_BAR;
        PG8_WAIT_V(2); PG8_BAR;
        PG8_STAGE(PG8_SB(1, 0), cB + kstep, voffB); PG8_STAGE(PG8_SA(1, 0), cA + kstep, vC0); PG8_STAGE(PG8_SB(1, 1), cB + hstep + kstep, voffB);
        PG8_WAIT_V(6); PG8_BAR;
    } else {
        PG8_STAGE(PG8_SB(0, 0), cB, voffB); PG8_STAGE(PG8_SA(0, 0), cA, vC0); PG8_STAGE(PG8_SB(0, 1), cB + hstep, voffB); PG8_STAGE(PG8_SA(0, 1), cA, vC1);
        if (wr == 1) PG8_BAR;
        PG8_WAIT_V(4); PG8_BAR;
        PG8_STAGE(PG8_SB(1, 0), cB + kstep, voffB); PG8_STAGE(PG8_SA(1, 0), cA + kstep, vC0); PG8_STAGE(PG8_SB(1, 1), cB + hstep + kstep, voffB);
        PG8_WAIT_V(6); PG8_BAR;
    }
    for (;;) {
        const bool has_next = S.next(ui + 1, nxt);
        const char* nA = cA; const char* nB = has_next ? (const char*)g.Bt + (size_t)nxt.pn * tstep : cB;
        if (has_next) RS.rows(nxt, Rr, Cc, K, vN0, vN1); else { vN0[0] = vC0[0]; vN0[1] = vC0[1]; vN1[0] = vC1[0]; vN1[1] = vC1[1]; }
        for (int t = 0; t < nt; t += 2) {
            const bool last = (t == nt - 2);
            const char* a1 = cA + (size_t)(t + 1) * kstep;
            const char* a2 = last ? nA : cA + (size_t)(t + 2) * kstep; const char* b2 = last ? nB : cB + (size_t)(t + 2) * kstep;
            const char* a3 = a2 + kstep; const char* b3 = b2 + kstep;
            const unsigned v20[2] = {last ? vN0[0] : vC0[0], last ? vN0[1] : vC0[1]}, v21[2] = {last ? vN1[0] : vC1[0], last ? vN1[1] : vC1[1]};
            if (last && has_next) S.a_ready(nxt);
            if constexpr (SP2) {
            PG8_LDB(B0, 0, 0); PG8_LDB(B1, 0, 1); PG8_SCHED; PG8_LDA(At, 0, 0); PG8_STAGE(PG8_SA(1, 1), a1, vC1);
            PG8_WAIT_V(8); PG8_WAIT_L(0); PG8_BAR; PG8_MMA(0, 0, At, B0); PG8_MMA(0, 1, At, B1); PG8_BAR; PG8_SCHED;
            PG8_LDA(At, 0, 1); PG8_STAGE(PG8_SB(0, 0), b2, voffB); PG8_STAGE(PG8_SB(0, 1), b2 + hstep, voffB); PG8_STAGE(PG8_SA(0, 0), a2, v20);
            PG8_WAIT_V(8); PG8_WAIT_L(0); PG8_BAR; if (!skip1) { PG8_MMA(1, 0, At, B0); PG8_MMA(1, 1, At, B1); } PG8_BAR; PG8_SCHED;
            PG8_LDB(B0, 1, 0); PG8_LDB(B1, 1, 1); PG8_SCHED; PG8_LDA(At, 1, 0); PG8_STAGE(PG8_SA(0, 1), a2, v21);
            PG8_WAIT_V(8); PG8_WAIT_L(0); PG8_BAR; PG8_MMA(0, 0, At, B0); PG8_MMA(0, 1, At, B1); PG8_BAR; PG8_SCHED;
            PG8_LDA(At, 1, 1); PG8_STAGE(PG8_SB(1, 0), b3, voffB); PG8_STAGE(PG8_SB(1, 1), b3 + hstep, voffB); PG8_STAGE(PG8_SA(1, 0), a3, v20);
            PG8_WAIT_V(8); PG8_WAIT_L(0); PG8_BAR; if (!skip1) { PG8_MMA(1, 0, At, B0); PG8_MMA(1, 1, At, B1); } PG8_BAR; PG8_SCHED;
            } else {
            PG8_LDB(B0, 0, 0); PG8_SCHED; PG8_LDA(At, 0, 0); PG8_STAGE(PG8_SA(1, 1), a1, vC1);
            PG8_WAIT_L(8); PG8_BAR; PG8_WAIT_L(0); PG8_MMA(0, 0, At, B0); PG8_BAR; PG8_SCHED;
            PG8_LDB(B1, 0, 1); PG8_STAGE(PG8_SB(0, 0), b2, voffB);
            PG8_BAR; PG8_WAIT_L(0); PG8_MMA(0, 1, At, B1); PG8_BAR;
            PG8_LDA(At, 0, 1); PG8_STAGE(PG8_SA(0, 0), a2, v20);
            PG8_BAR; PG8_WAIT_L(0); PG8_MMA(1, 0, At, B0); PG8_BAR; PG8_SCHED;
            PG8_STAGE(PG8_SB(0, 1), b2 + hstep, voffB);
            PG8_WAIT_V(6); PG8_BAR; PG8_MMA(1, 1, At, B1); PG8_BAR;
            PG8_LDB(B0, 1, 0); PG8_SCHED; PG8_LDA(At, 1, 0); PG8_STAGE(PG8_SA(0, 1), a2, v21);
            PG8_WAIT_L(8); PG8_BAR; PG8_WAIT_L(0); PG8_MMA(0, 0, At, B0); PG8_BAR; PG8_SCHED;
            PG8_LDB(B1, 1, 1); PG8_STAGE(PG8_SB(1, 0), b3, voffB);
            PG8_BAR; PG8_WAIT_L(0); PG8_MMA(0, 1, At, B1); PG8_BAR;
            PG8_LDA(At, 1, 1); PG8_STAGE(PG8_SA(1, 0), a3, v20);
            PG8_BAR; PG8_WAIT_L(0); PG8_MMA(1, 0, At, B0); PG8_BAR; PG8_SCHED;
            PG8_STAGE(PG8_SB(1, 1), b3 + hstep, voffB);
            PG8_WAIT_V(6); PG8_BAR; PG8_MMA(1, 1, At, B1); PG8_BAR;
            }
        }
        if constexpr (F8) asm volatile("s_nop 15\n\ts_nop 7" ::: "memory");
        if constexpr (ALIGN_EPI) { if (wr == 0) PG8_BAR; }
        if constexpr (!Epi::AFTER_DRAIN) { E(acc, cur, wr, wc, fr, fq); S.done(cur); }
        if (!has_next) break;
#pragma unroll
        for (int a = 0; a < 2; ++a)
#pragma unroll
            for (int b = 0; b < 2; ++b)
#pragma unroll
                for (int m = 0; m < 4; ++m)
#pragma unroll
                    for (int n = 0; n < 2; ++n) acc[a][b][m][n] = (f32x4){0.f, 0.f, 0.f, 0.f};
        cur = nxt; cA = nA; cB = nB; ++ui; skip1 = S.rows(cur) <= HALF; vC0[0] = vN0[0]; vC0[1] = vN0[1]; vC1[0] = vN1[0]; vC1[1] = vN1[1];
        if constexpr (ALIGN_EPI) { if (wr == 1) PG8_BAR; }
    }
    PG8_WAIT_V(0);
    if constexpr (!ALIGN_EPI) { if (wr == 0) PG8_BAR; }
    PG8_BAR;
    if constexpr (Epi::AFTER_DRAIN) { E.fused(acc, cur, wr, wc, fr, fq, lds, wid, lane); S.done(cur); }
#undef PG8_SA
#undef PG8_SB
#undef PG8_STAGE
#undef PG8_LDA
#undef PG8_LDB
#undef PG8_MMA
#undef PG8_CAT8
#undef PG8_WAIT_V
#undef PG8_WAIT_L
#undef PG8_BAR
#undef PG8_SCHED
}

struct ExpertRows {
    const PG8_LAS int* tab; const int* lst_tok; int lcap;
    __device__ __forceinline__ void rows(const Unit& u, const int (&Rr)[2], const int (&Cc)[2], int K, unsigned (&v0)[2], unsigned (&v1)[2]) const {
        const int e = u.pn >> 3, mi = u.pm - tab[40 + e], cnt = tab[80 + e];
#pragma unroll
        for (int i = 0; i < 2; ++i) { const int p0 = mi * BM + Rr[i], p1 = p0 + HALF;
            const int t0 = p0 < cnt ? lst_tok[(size_t)e * lcap + p0] : 0, t1 = p1 < cnt ? lst_tok[(size_t)e * lcap + p1] : 0;
            v0[i] = (unsigned)(t0 * K + Cc[i]) * 2u; v1[i] = (unsigned)(t1 * K + Cc[i]) * 2u; }
    }
};
}

#ifndef PG8_SP2
#define PG8_SP2 true
#endif
#ifndef PG8_ALIGN
#define PG8_ALIGN true
#endif

namespace attn_body {
using bf16=__hip_bfloat16;
using bf16x8=__attribute__((ext_vector_type(8)))short;
using s16x4=__attribute__((ext_vector_type(4)))short;
using f32x16=__attribute__((ext_vector_type(16)))float;
using u32x4=__attribute__((ext_vector_type(4)))unsigned;
constexpr int SEQ=2048,D=64,QP=1024,KP=1024,VP=5632,OP=1024;
constexpr int NW=8,QBLK=32,QB=QBLK*NW,KVBLK=64,NQB=SEQ/QB;
constexpr int ATTN_UNIT_ROWS=QB;
__device__ __forceinline__ int crow(int r,int hi){return (r&3)+8*(r>>2)+4*hi;}
#define SBAR() __builtin_amdgcn_sched_barrier(0)
__device__ __forceinline__ void cmask(f32x16&p0,f32x16&p1,int jb,int qrel,int hi){
  const float NEG=-INFINITY; int kb=64*jb+4*hi;
  #pragma unroll
  for(int r=0;r<16;++r){int kv=kb+(r&3)+8*(r>>2); if(kv>qrel)p0[r]=NEG; if(kv+32>qrel)p1[r]=NEG;}
}

constexpr int NSLOT=3, SLOTB=8192;
constexpr int LDS_K=0, LDS_V=NSLOT*SLOTB, LDS_WS=2*NSLOT*SLOTB, LDS_OST=LDS_WS+NW*64*4, LDS_BYTES=LDS_OST+NW*4096;
constexpr float C2=0.125f*1.4426950408889634f;
__device__ __forceinline__ void glds16(const void*gsrc,unsigned lds_dst){unsigned keep;
  asm volatile("s_mov_b32 %0, m0\n\ts_mov_b32 m0, %2\n\ts_nop 0\n\tglobal_load_lds_dwordx4 %1, off\n\ts_mov_b32 m0, %0":"=&s"(keep):"v"(gsrc),"s"(lds_dst):"memory");}
__device__ __forceinline__ float max3f(float a,float b,float c){float r;asm("v_max3_f32 %0, %1, %2, %3":"=v"(r):"v"(a),"v"(b),"v"(c));return r;}
__device__ __forceinline__ float max2f(float a,float b){float r;asm("v_max_f32_e32 %0, %1, %2":"=v"(r):"v"(a),"v"(b));return r;}
__device__ __forceinline__ float fadd_s(float a,float b){float r;asm("v_add_f32_e32 %0, %1, %2":"=v"(r):"v"(a),"v"(b));return r;}
__device__ __forceinline__ float fsub_s(float a,float b){float r;asm("v_sub_f32_e32 %0, %1, %2":"=v"(r):"v"(a),"v"(b));return r;}
typedef float f32x2_t __attribute__((ext_vector_type(2))); typedef __bf16 bf16x2_t __attribute__((ext_vector_type(2)));
__device__ __forceinline__ unsigned cvtpk_s(float lo,float hi){f32x2_t v={lo,hi};bf16x2_t b=__builtin_convertvector(v,bf16x2_t);return __builtin_bit_cast(unsigned,b);}
#define WAIT_BAR(N) asm volatile("s_waitcnt vmcnt(" #N ") lgkmcnt(0)\n\ts_barrier":::"memory")

__device__ __forceinline__ void qkt(f32x16&p0,f32x16&p1,const char*Kslot,const bf16x8*qr,const f32x16&negm,int r32,int hi){
  const char*kb=Kslot+hi*1024+r32*16;
  #pragma unroll
  for(int d0=0;d0<4;++d0){
    const bf16x8 b0=*reinterpret_cast<const bf16x8*>(kb+d0*2048);
    const bf16x8 b1=*reinterpret_cast<const bf16x8*>(kb+d0*2048+512);
    if(d0==0){p0=__builtin_amdgcn_mfma_f32_32x32x16_bf16(b0,qr[0],negm,0,0,0);p1=__builtin_amdgcn_mfma_f32_32x32x16_bf16(b1,qr[0],negm,0,0,0);}
    else{p0=__builtin_amdgcn_mfma_f32_32x32x16_bf16(b0,qr[d0],p0,0,0,0);p1=__builtin_amdgcn_mfma_f32_32x32x16_bf16(b1,qr[d0],p1,0,0,0);}}
}
typedef __attribute__((address_space(3))) const char* lds_cptr;
typedef short v4i16_t __attribute__((ext_vector_type(4)));
__device__ __forceinline__ void kload8(bf16x8*kf,lds_cptr kp){
  kf[0]=*(const __attribute__((address_space(3))) bf16x8*)(kp);      kf[1]=*(const __attribute__((address_space(3))) bf16x8*)(kp+512);
  kf[2]=*(const __attribute__((address_space(3))) bf16x8*)(kp+2048); kf[3]=*(const __attribute__((address_space(3))) bf16x8*)(kp+2560);
  kf[4]=*(const __attribute__((address_space(3))) bf16x8*)(kp+4096); kf[5]=*(const __attribute__((address_space(3))) bf16x8*)(kp+4608);
  kf[6]=*(const __attribute__((address_space(3))) bf16x8*)(kp+6144); kf[7]=*(const __attribute__((address_space(3))) bf16x8*)(kp+6656);
}
__device__ __forceinline__ void kload2(bf16x8*kf,lds_cptr kp,int j){ kf[2*j]=*(const __attribute__((address_space(3))) bf16x8*)(kp+j*2048); kf[2*j+1]=*(const __attribute__((address_space(3))) bf16x8*)(kp+j*2048+512); }
__device__ __forceinline__ s16x4 vtr(lds_cptr p){ return __builtin_bit_cast(s16x4,__builtin_amdgcn_ds_read_tr16_b64_v4i16((__attribute__((address_space(3))) v4i16_t*)p)); }
__device__ __forceinline__ float rowmax(const f32x16&p0,const f32x16&p1){
  float a=max3f(p0[0],p0[1],p1[0]),b=max3f(p0[2],p0[3],p1[1]);a=max3f(a,p1[2],p1[3]);
  #pragma unroll
  for(int r=4;r<16;r+=4){a=max3f(a,p0[r],p0[r+1]);b=max3f(b,p0[r+2],p0[r+3]);a=max3f(a,p1[r],p1[r+1]);b=max3f(b,p1[r+2],p1[r+3]);}
  const float m=max2f(a,b);
  auto rr=__builtin_amdgcn_permlane32_swap(__float_as_uint(m),__float_as_uint(m),false,false);
  return max2f(__uint_as_float(rr[0]),__uint_as_float(rr[1]));
}
__device__ __forceinline__ void pv(f32x16*o,int vb,bf16x8 pa0,bf16x8 pa1,bf16x8 pa2,bf16x8 pa3){
  #pragma unroll
  for(int d0=0;d0<2;++d0){s16x4 lo[4],hi[4];
    #pragma unroll
    for(int ks=0;ks<4;++ks){
      asm volatile("ds_read_b64_tr_b16 %0,%1 offset:%c2":"=&v"(lo[ks]):"v"(vb),"i"(d0*4096+ks*1024):"memory");
      asm volatile("ds_read_b64_tr_b16 %0,%1 offset:%c2":"=&v"(hi[ks]):"v"(vb),"i"(d0*4096+ks*1024+512):"memory");}
    asm volatile("s_waitcnt lgkmcnt(0)":::"memory");SBAR();
    #define PK(k) (bf16x8){lo[k][0],lo[k][1],lo[k][2],lo[k][3],hi[k][0],hi[k][1],hi[k][2],hi[k][3]}
    o[d0]=__builtin_amdgcn_mfma_f32_32x32x16_bf16(pa0,PK(0),o[d0],0,0,0);
    o[d0]=__builtin_amdgcn_mfma_f32_32x32x16_bf16(pa1,PK(1),o[d0],0,0,0);
    o[d0]=__builtin_amdgcn_mfma_f32_32x32x16_bf16(pa2,PK(2),o[d0],0,0,0);
    o[d0]=__builtin_amdgcn_mfma_f32_32x32x16_bf16(pa3,PK(3),o[d0],0,0,0);
    #undef PK
  }
}

#ifndef ATTN_STORE16
#define ATTN_STORE16(p,v) (*(u32x4*)(p)=(v))
#endif
template<int THRL> __device__ __forceinline__ void attn_unit(int b,int h,int qb,const bf16*Q,const bf16*__restrict__ K,const bf16*__restrict__ V,bf16*O,char*shm){
  int tid_=threadIdx.x; asm volatile("" : "+v"(tid_));
  const int tid=tid_,lane=tid&63,r32=lane&31,hi=lane>>5; const int wid=__builtin_amdgcn_readfirstlane(tid>>6);
  const long rowbase=(long)b*SEQ; const int q0=qb*QB;
  const bf16*Qw=Q+(rowbase+q0+wid*QBLK)*QP+h*D;
  const bf16*Kh=K+rowbase*KP+h*D,*Vh=V+rowbase*VP+h*D;
  const unsigned lds0=(unsigned)(uintptr_t)shm;
  float*wsf=(float*)(shm+LDS_WS)+wid*64;
  const bf16*ksrc=Kh+(long)lane*KP+wid*8;
  const bf16*vsrc=Vh+(long)(16*(wid&3)+(lane>>2))*VP+(wid>>2)*32+(lane&3)*8;
  const unsigned kdst=lds0+LDS_K+wid*1024, vdst=lds0+LDS_V+wid*1024;
  #define DMA_K(t,slot) glds16(ksrc+(long)(t)*KVBLK*KP,(unsigned)__builtin_amdgcn_readfirstlane(kdst+(slot)))
  #define DMA_V(t,slot) glds16(vsrc+(long)(t)*KVBLK*VP,(unsigned)__builtin_amdgcn_readfirstlane(vdst+(slot)))
  const int vb0=(int)(lds0+LDS_V)+((lane>>4)&1)*32+(lane&3)*8+(4*hi+((lane&15)>>2))*64;
  const char*Kbase=shm+LDS_K; bf16x8 kf[8];
  const lds_cptr shm3=(lds_cptr)shm; const lds_cptr kp0=shm3+LDS_K+hi*1024+r32*16; const lds_cptr vp0=shm3+LDS_V+((lane>>4)&1)*32+(lane&3)*8+(4*hi+((lane&15)>>2))*64;
  const int NT=(q0+QB)/KVBLK;
  DMA_K(0,0);DMA_V(0,0);DMA_K(1,SLOTB);
  bf16x8 qr[4];
  #pragma unroll
  for(int d0=0;d0<4;++d0)qr[d0]=*reinterpret_cast<const bf16x8*>(&Qw[(long)r32*QP+d0*16+hi*8]);
  float mhat=0.f,l_reg=0.f;f32x16 o[2];o[0]=f32x16{};o[1]=f32x16{};f32x16 negm=f32x16{};asm volatile("":"+v"(negm));
  const int qrel=wid*QBLK+r32;
  #define CMASK(P0,P1,t) do{int jb_=(t)-(NT-4); if(jb_>=0)cmask(P0,P1,jb_,qrel,hi);}while(0)
  bool resc=false;
  #define START(P0,P1) do{ const float rm=rowmax(P0,P1); resc=false; \
    { const float dl=rm; mhat=fadd_s(mhat,dl); \
      _Pragma("unroll") for(int r=0;r<16;++r){P0[r]=fsub_s(P0[r],dl);P1[r]=fsub_s(P1[r],dl);} \
      _Pragma("unroll") for(int r=0;r<16;++r)negm[r]=-mhat; asm volatile("":"+v"(negm)); } \
    _Pragma("unroll") for(int r=0;r<16;++r)P0[r]=__builtin_amdgcn_exp2f(P0[r]); }while(0)
  #define RESC() do{ if(resc){ asm volatile("s_waitcnt lgkmcnt(0)":::"memory"); \
      _Pragma("unroll") for(int d_=0;d_<2;++d_) _Pragma("unroll") for(int r=0;r<16;++r)o[d_][r]*=wsf[crow(r,hi)]; } }while(0)
  f32x16 pA0,pA1,pB0,pB1;
  int sl_prev=0,sl_cur=0,sl_next=SLOTB;
  #define ROT() do{sl_prev=sl_cur;sl_cur=sl_next;sl_next=(sl_next==(NSLOT-1)*SLOTB)?0:sl_next+SLOTB;}while(0)
  DMA_K(2,2*SLOTB);
  WAIT_BAR(3);
  qkt(pA0,pA1,Kbase,qr,negm,r32,hi);asm volatile("s_nop 15\n\ts_nop 7":"+v"(pA0),"+v"(pA1));CMASK(pA0,pA1,0);
  START(pA0,pA1);
  _Pragma("unroll") for(int r=0;r<16;++r)pA1[r]=__builtin_amdgcn_exp2f(pA1[r]);
  WAIT_BAR(0);
  DMA_K(3,0);DMA_V(1,SLOTB);
  ROT();
  kload8(kf,kp0+sl_cur);
  WAIT_BAR(2);
  s16x4 vlo[8],vhi[8]; u32x4 pw0,pw1,pw2,pw3;
  #define PKW(P,B) cvtpk_s(P[B],P[B+1])
  #define PAF(k) __builtin_bit_cast(bf16x8,pw##k)
  #define VFR(i) (bf16x8){vlo[i][0],vlo[i][1],vlo[i][2],vlo[i][3],vhi[i][0],vhi[i][1],vhi[i][2],vhi[i][3]}
  #define PIN(x) asm volatile("":"+v"(x))
  #define MX3(a,b,c) __builtin_fmaxf(__builtin_fmaxf((a),(b)),(c))
  #define GAPA(MF,A0,A1,A2,A3,W0,W1,PW) do{ MF; sacc+=A0; sacc+=A1; sacc+=A2; sacc+=A3; PIN(sacc); W0; W1; PIN(PW); SBAR(); }while(0)
  #define EX(v) __builtin_amdgcn_exp2f(v)
  #define GAPB(MF,X,B) do{ MF; X[B]=EX(X[B]); X[B+1]=EX(X[B+1]); X[B+2]=EX(X[B+2]); X[B+3]=EX(X[B+3]); PIN(X); SBAR(); }while(0)
  #define VRD(i) do{ vlo[i]=vtr(vp_+(((i)>>2)*4096+((i)&3)*1024)); vhi[i]=vtr(vp_+(((i)>>2)*4096+((i)&3)*1024+512)); }while(0)
  #define KRD(G,j) do{ if(G){ kload2(kf,kp0+sl_next,j); SBAR(); } }while(0)
  #define STEP(C0,C1,P0,P1,t,GK,GV,GL) do{ SBAR(); \
    const lds_cptr vp_=vp0+sl_prev; \
    VRD(0); SBAR(); float sacc=(P0[0]+P0[1]); \
    GAPA(C0=__builtin_amdgcn_mfma_f32_32x32x16_bf16(kf[0],qr[0],negm,0,0,0), P0[2],P0[3],P0[4],P0[5],     pw0[0]=PKW(P0,0), pw0[1]=PKW(P0,2), pw0); \
    VRD(4); SBAR(); GAPA(C1=__builtin_amdgcn_mfma_f32_32x32x16_bf16(kf[1],qr[0],negm,0,0,0), P0[6],P0[7],P0[8],P0[9],     pw0[2]=PKW(P0,4), pw0[3]=PKW(P0,6), pw0); \
    VRD(1); SBAR(); GAPA(C0=__builtin_amdgcn_mfma_f32_32x32x16_bf16(kf[2],qr[1],C0,0,0,0),   P0[10],P0[11],P0[12],P0[13], pw1[0]=PKW(P0,8), pw1[1]=PKW(P0,10), pw1); \
    VRD(5); SBAR(); GAPA(C1=__builtin_amdgcn_mfma_f32_32x32x16_bf16(kf[3],qr[1],C1,0,0,0),   P0[14],P0[15],P1[0],P1[1],   pw1[2]=PKW(P0,12),pw1[3]=PKW(P0,14), pw1); \
    VRD(2); SBAR(); GAPA(C0=__builtin_amdgcn_mfma_f32_32x32x16_bf16(kf[4],qr[2],C0,0,0,0),   P1[2],P1[3],P1[4],P1[5],     pw2[0]=PKW(P1,0), pw2[1]=PKW(P1,2), pw2); \
    VRD(6); SBAR(); GAPA(C1=__builtin_amdgcn_mfma_f32_32x32x16_bf16(kf[5],qr[2],C1,0,0,0),   P1[6],P1[7],P1[8],P1[9],     pw2[2]=PKW(P1,4), pw2[3]=PKW(P1,6), pw2); \
    VRD(3); SBAR(); GAPA(C0=__builtin_amdgcn_mfma_f32_32x32x16_bf16(kf[6],qr[3],C0,0,0,0),   P1[10],P1[11],P1[12],P1[13], pw3[0]=PKW(P1,8), pw3[1]=PKW(P1,10), pw3); \
    VRD(7); SBAR(); GAPA(C1=__builtin_amdgcn_mfma_f32_32x32x16_bf16(kf[7],qr[3],C1,0,0,0),   P1[14],P1[15],0.f,0.f,       pw3[2]=PKW(P1,12),pw3[3]=PKW(P1,14), pw3); \
    l_reg+=sacc; \
    if(GK){DMA_K((t)+3,sl_cur);} if(GV){DMA_V((t)+1,sl_next);} \
    CMASK(C0,C1,t); \
    { float a=MX3(C0[0],C0[1],C1[0]),b=MX3(C0[2],C0[3],C1[1]); a=MX3(a,C1[2],C1[3]); \
      _Pragma("unroll") for(int r=4;r<16;r+=4){a=MX3(a,C0[r],C0[r+1]);b=MX3(b,C0[r+2],C0[r+3]);a=MX3(a,C1[r],C1[r+1]);b=MX3(b,C1[r+2],C1[r+3]);} \
      float rm=__builtin_fmaxf(a,b); { auto rr=__builtin_amdgcn_permlane32_swap(__float_as_uint(rm),__float_as_uint(rm),false,false); rm=__builtin_fmaxf(__uint_as_float(rr[0]),__uint_as_float(rr[1])); } \
      resc=false; \
      if(__builtin_expect(__any(rm>(float)THRL),0)){ const float dl=__builtin_fmaxf(rm,0.f); mhat+=dl; \
        _Pragma("unroll") for(int r=0;r<16;++r){C0[r]-=dl;C1[r]-=dl;} \
        _Pragma("unroll") for(int r=0;r<16;++r)negm[r]=-mhat; asm volatile("":"+v"(negm)); \
        const float f=__builtin_amdgcn_exp2f(-dl); l_reg*=f; if(hi==0)wsf[r32]=f; resc=true; } } \
    SBAR(); \
    GAPB(o[0]=__builtin_amdgcn_mfma_f32_32x32x16_bf16(PAF(0),VFR(0),o[0],0,0,0), C0,0); \
    GAPB(o[1]=__builtin_amdgcn_mfma_f32_32x32x16_bf16(PAF(0),VFR(4),o[1],0,0,0), C0,4); \
    KRD(GL,0); GAPB(o[0]=__builtin_amdgcn_mfma_f32_32x32x16_bf16(PAF(1),VFR(1),o[0],0,0,0), C0,8); \
    KRD(GL,1); GAPB(o[1]=__builtin_amdgcn_mfma_f32_32x32x16_bf16(PAF(1),VFR(5),o[1],0,0,0), C0,12); \
    KRD(GL,2); GAPB(o[0]=__builtin_amdgcn_mfma_f32_32x32x16_bf16(PAF(2),VFR(2),o[0],0,0,0), C1,0); \
    KRD(GL,3); GAPB(o[1]=__builtin_amdgcn_mfma_f32_32x32x16_bf16(PAF(2),VFR(6),o[1],0,0,0), C1,4); \
    GAPB(o[0]=__builtin_amdgcn_mfma_f32_32x32x16_bf16(PAF(3),VFR(3),o[0],0,0,0), C1,8); \
    GAPB(o[1]=__builtin_amdgcn_mfma_f32_32x32x16_bf16(PAF(3),VFR(7),o[1],0,0,0), C1,12); \
    }while(0)
  int t=1;
  #undef CMASK
  #define CMASK(P0,P1,t) do{}while(0)
  for(;t+5<NT;t+=2){
    STEP(pB0,pB1,pA0,pA1,t,true,true,true);     WAIT_BAR(2); RESC(); ROT();
    STEP(pA0,pA1,pB0,pB1,t+1,true,true,true);   WAIT_BAR(2); RESC(); ROT();
  }
  #undef CMASK
  #define CMASK(P0,P1,t) do{int jb_=(t)-(NT-4); if(jb_>=0)cmask(P0,P1,jb_,qrel,hi);}while(0)
  #define ENDW(tt) do{ if((tt)+3<NT){WAIT_BAR(2);} else if((tt)+2<NT){WAIT_BAR(1);} else {WAIT_BAR(0);} }while(0)
  for(;t+1<NT;t+=2){
    STEP(pB0,pB1,pA0,pA1,t,(t+3<NT),(t+1<NT),(t+1<NT));       ENDW(t);   RESC(); ROT();
    STEP(pA0,pA1,pB0,pB1,t+1,(t+4<NT),(t+2<NT),(t+2<NT));     ENDW(t+1); RESC(); ROT();
  }
  STEP(pB0,pB1,pA0,pA1,NT-1,false,false,false); RESC();
  { float sacc=pB0[0]+pB0[1]; _Pragma("unroll") for(int r=2;r<16;++r)sacc+=pB0[r]; _Pragma("unroll") for(int r=0;r<16;++r)sacc+=pB1[r]; l_reg+=sacc;
    pw0=(u32x4){PKW(pB0,0),PKW(pB0,2),PKW(pB0,4),PKW(pB0,6)};pw1=(u32x4){PKW(pB0,8),PKW(pB0,10),PKW(pB0,12),PKW(pB0,14)};pw2=(u32x4){PKW(pB1,0),PKW(pB1,2),PKW(pB1,4),PKW(pB1,6)};pw3=(u32x4){PKW(pB1,8),PKW(pB1,10),PKW(pB1,12),PKW(pB1,14)};
    SBAR(); pv(o,vb0+sl_cur,PAF(0),PAF(1),PAF(2),PAF(3)); }
  #undef PKW
  #undef PAF
  #undef VFR
  #undef PIN
  #undef MX3
  #undef GAPA
  #undef GAPB
  #undef EX
  #undef VRD
  #undef KRD
  #undef STEP
  #undef ENDW
  {auto rr=__builtin_amdgcn_permlane32_swap(__float_as_uint(l_reg),__float_as_uint(l_reg),false,false);l_reg=__uint_as_float(rr[0])+__uint_as_float(rr[1]);}
  if(hi==0)wsf[32+r32]=l_reg;asm volatile("s_waitcnt lgkmcnt(0)":::"memory");
  float rli[16];
  #pragma unroll
  for(int r=0;r<16;++r)rli[r]=__builtin_amdgcn_rcpf(wsf[32+crow(r,hi)]);
  bf16*Ow=O+(rowbase+q0+wid*QBLK)*OP+h*D;
  { bf16*stg=(bf16*)(shm+LDS_OST)+wid*2048;
    #pragma unroll
    for(int r=0;r<16;++r){const int orow=crow(r,hi);
      #pragma unroll
      for(int d0=0;d0<2;++d0)stg[orow*64+d0*32+r32]=__float2bfloat16(o[d0][r]*rli[r]);}
    asm volatile("s_waitcnt lgkmcnt(0)":::"memory");
    #pragma unroll
    for(int i=0;i<4;++i){const int row=i*8+(lane>>3),ch=lane&7; const u32x4 v=*(const u32x4*)(stg+row*64+ch*8); ATTN_STORE16(Ow+(long)row*OP+ch*8,v);} }
  asm volatile("s_waitcnt lgkmcnt(0)\n\ts_barrier":::"memory");
  #undef DMA_K
  #undef DMA_V
  #undef CMASK
  #undef START
  #undef RESC
  #undef ROT
}
constexpr int ATTN_LDS_BYTES=LDS_BYTES;
#undef SBAR
#undef WAIT_BAR
}

namespace attn3 {
using namespace attn_body;
constexpr int DV=128,KSL=8192,VSL=16384;
constexpr int L_K=0,L_V=NSLOT*KSL,L_WS=L_V+NSLOT*VSL,L_OST=L_WS+NW*64*4,L_BYTES=L_OST+NW*8192;
#define SBAR() __builtin_amdgcn_sched_barrier(0)
#define WAIT_BAR(N) asm volatile("s_waitcnt vmcnt(" #N ") lgkmcnt(0)\n\ts_barrier":::"memory")
__device__ __forceinline__ void qkt0(f32x16&p0,f32x16&p1,const char*Kslot,const bf16x8*qr,int r32,int hi){
  const char*kb=Kslot+hi*1024+r32*16;
  #pragma unroll
  for(int d0=0;d0<4;++d0){
    const bf16x8 b0=*reinterpret_cast<const bf16x8*>(kb+d0*2048);
    const bf16x8 b1=*reinterpret_cast<const bf16x8*>(kb+d0*2048+512);
    if(d0==0){p0=__builtin_amdgcn_mfma_f32_32x32x16_bf16(b0,qr[0],f32x16{},0,0,0);p1=__builtin_amdgcn_mfma_f32_32x32x16_bf16(b1,qr[0],f32x16{},0,0,0);}
    else{p0=__builtin_amdgcn_mfma_f32_32x32x16_bf16(b0,qr[d0],p0,0,0,0);p1=__builtin_amdgcn_mfma_f32_32x32x16_bf16(b1,qr[d0],p1,0,0,0);}}
}
__device__ __forceinline__ void pv4(f32x16*o,int vb,bf16x8 pa0,bf16x8 pa1,bf16x8 pa2,bf16x8 pa3){
  #pragma unroll
  for(int d0=0;d0<4;++d0){s16x4 lo[4],hi[4];
    #pragma unroll
    for(int ks=0;ks<4;++ks){
      asm volatile("ds_read_b64_tr_b16 %0,%1 offset:%c2":"=&v"(lo[ks]):"v"(vb),"i"(d0*4096+ks*1024):"memory");
      asm volatile("ds_read_b64_tr_b16 %0,%1 offset:%c2":"=&v"(hi[ks]):"v"(vb),"i"(d0*4096+ks*1024+512):"memory");}
    asm volatile("s_waitcnt lgkmcnt(0)":::"memory");SBAR();
    #define PK(k) (bf16x8){lo[k][0],lo[k][1],lo[k][2],lo[k][3],hi[k][0],hi[k][1],hi[k][2],hi[k][3]}
    o[d0]=__builtin_amdgcn_mfma_f32_32x32x16_bf16(pa0,PK(0),o[d0],0,0,0);
    o[d0]=__builtin_amdgcn_mfma_f32_32x32x16_bf16(pa1,PK(1),o[d0],0,0,0);
    o[d0]=__builtin_amdgcn_mfma_f32_32x32x16_bf16(pa2,PK(2),o[d0],0,0,0);
    o[d0]=__builtin_amdgcn_mfma_f32_32x32x16_bf16(pa3,PK(3),o[d0],0,0,0);
    #undef PK
  }
}
template<int THRL,int OPF> __device__ __forceinline__ void attn_unit128(int b,int qb,const bf16*Q,const bf16*__restrict__ K,const bf16*__restrict__ V,bf16*O,char*shm,int fin,float lam,const float*sw){
  int tid_=threadIdx.x; asm volatile("" : "+v"(tid_));
  const int tid=tid_,lane=tid&63,r32=lane&31,hi=lane>>5; const int wid=__builtin_amdgcn_readfirstlane(tid>>6);
  const long rowbase=(long)b*SEQ; const int q0=qb*QB;
  const bf16*Qw=Q+(rowbase+q0+wid*QBLK)*QP;
  const bf16*Kh=K+rowbase*KP,*Vh=V+rowbase*VP;
  const unsigned lds0=(unsigned)(uintptr_t)shm;
  float*wsf=(float*)(shm+L_WS)+wid*64;
  const bf16*ksrc=Kh+(long)lane*KP+wid*8;
  const bf16*vsrc=Vh+(long)(16*(wid&3)+(lane>>2))*VP+(wid>>2)*32+(lane&3)*8;
  const unsigned kdst=lds0+L_K+wid*1024, vdst=lds0+L_V+wid*1024;
  #define DMA_K(t,slot) glds16(ksrc+(long)(t)*KVBLK*KP,(unsigned)__builtin_amdgcn_readfirstlane(kdst+(slot)))
  #define DMA_V(t,slot) do{ glds16(vsrc+(long)(t)*KVBLK*VP,(unsigned)__builtin_amdgcn_readfirstlane(vdst+2*(slot))); glds16(vsrc+(long)(t)*KVBLK*VP+64,(unsigned)__builtin_amdgcn_readfirstlane(vdst+2*(slot)+8192)); }while(0)
  const int vb0=(int)(lds0+L_V)+((lane>>4)&1)*32+(lane&3)*8+(4*hi+((lane&15)>>2))*64;
  const char*Kbase=shm+L_K; bf16x8 kf[8];
  const lds_cptr shm3=(lds_cptr)shm; const lds_cptr kp0=shm3+L_K+hi*1024+r32*16; const lds_cptr vp0=shm3+L_V+((lane>>4)&1)*32+(lane&3)*8+(4*hi+((lane&15)>>2))*64;
  const int NT=(q0+QB)/KVBLK;
  DMA_K(0,0);DMA_V(0,0);DMA_K(1,KSL);
  bf16x8 qr[4];
  #pragma unroll
  for(int d0=0;d0<4;++d0)qr[d0]=*reinterpret_cast<const bf16x8*>(&Qw[(long)r32*QP+d0*16+hi*8]);
  float mhat=0.f,l_reg=0.f;f32x16 o[4];o[0]=f32x16{};o[1]=f32x16{};o[2]=f32x16{};o[3]=f32x16{};
  const int qrel=wid*QBLK+r32;
  #define CMASK(P0,P1,t) do{int jb_=(t)-(NT-4); if(jb_>=0)cmask(P0,P1,jb_,qrel,hi);}while(0)
  bool resc=false;
  #define START(P0,P1) do{ const float rm=rowmax(P0,P1); resc=false; \
    { const float dl=rm; mhat=fadd_s(mhat,dl); \
      _Pragma("unroll") for(int r=0;r<16;++r){P0[r]=fsub_s(P0[r],dl);P1[r]=fsub_s(P1[r],dl);} } \
    _Pragma("unroll") for(int r=0;r<16;++r)P0[r]=__builtin_amdgcn_exp2f(P0[r]); }while(0)
  #define RESC() do{ if(resc){ asm volatile("s_waitcnt lgkmcnt(0)":::"memory"); \
      _Pragma("unroll") for(int d_=0;d_<4;++d_) _Pragma("unroll") for(int r=0;r<16;++r)o[d_][r]*=wsf[crow(r,hi)]; } }while(0)
  f32x16 pA0,pA1,pB0,pB1;
  int sl_prev=0,sl_cur=0,sl_next=KSL;
  #define ROT() do{sl_prev=sl_cur;sl_cur=sl_next;sl_next=(sl_next==(NSLOT-1)*KSL)?0:sl_next+KSL;}while(0)
  DMA_K(2,2*KSL);
  WAIT_BAR(4);
  qkt0(pA0,pA1,Kbase,qr,r32,hi);asm volatile("s_nop 15\n\ts_nop 7":"+v"(pA0),"+v"(pA1));CMASK(pA0,pA1,0);
  START(pA0,pA1);
  _Pragma("unroll") for(int r=0;r<16;++r)pA1[r]=__builtin_amdgcn_exp2f(pA1[r]);
  WAIT_BAR(0);
  DMA_K(3,0);DMA_V(1,KSL);
  ROT();
  kload8(kf,kp0+sl_cur);
  WAIT_BAR(3);
  s16x4 vlo[4],vhi[4]; u32x4 pw0,pw1,pw2,pw3;
  #define PKW(P,B) cvtpk_s(P[B],P[B+1])
  #define PAF(k) __builtin_bit_cast(bf16x8,pw##k)
  #define VFR(i) (bf16x8){vlo[i][0],vlo[i][1],vlo[i][2],vlo[i][3],vhi[i][0],vhi[i][1],vhi[i][2],vhi[i][3]}
  #define PIN(x) asm volatile("":"+v"(x))
  #define MX3(a,b,c) __builtin_fmaxf(__builtin_fmaxf((a),(b)),(c))
  #define GAPA(MF,A0,A1,A2,A3,W0,W1,PW) do{ MF; sacc+=A0; sacc+=A1; sacc+=A2; sacc+=A3; PIN(sacc); W0; W1; PIN(PW); SBAR(); }while(0)
  #define EX(v) __builtin_amdgcn_exp2f((v)-mhat)
  #define VRD(j) do{ vlo[(j)&3]=vtr(vp_+(((j)&3)*4096+((j)>>2)*1024)); vhi[(j)&3]=vtr(vp_+(((j)&3)*4096+((j)>>2)*1024+512)); }while(0)
  #define GAPB(j,PA,X,B) do{ o[(j)&3]=__builtin_amdgcn_mfma_f32_32x32x16_bf16(PA,VFR((j)&3),o[(j)&3],0,0,0); if((j)+4<16){VRD((j)+4);} X[B]=EX(X[B]); X[B+1]=EX(X[B+1]); PIN(X); SBAR(); }while(0)
  #define KRD(G,j) do{ if(G){ kload2(kf,kp0+sl_next,j); SBAR(); } }while(0)
  #define STEP(C0,C1,P0,P1,t,GK,GV,GL) do{ SBAR(); \
    const lds_cptr vp_=vp0+2*sl_prev; \
    float sacc=(P0[0]+P0[1]); \
    GAPA(C0=__builtin_amdgcn_mfma_f32_32x32x16_bf16(kf[0],qr[0],f32x16{},0,0,0), P0[2],P0[3],P0[4],P0[5],     pw0[0]=PKW(P0,0), pw0[1]=PKW(P0,2), pw0); \
    GAPA(C1=__builtin_amdgcn_mfma_f32_32x32x16_bf16(kf[1],qr[0],f32x16{},0,0,0), P0[6],P0[7],P0[8],P0[9],     pw0[2]=PKW(P0,4), pw0[3]=PKW(P0,6), pw0); \
    GAPA(C0=__builtin_amdgcn_mfma_f32_32x32x16_bf16(kf[2],qr[1],C0,0,0,0),   P0[10],P0[11],P0[12],P0[13], pw1[0]=PKW(P0,8), pw1[1]=PKW(P0,10), pw1); \
    GAPA(C1=__builtin_amdgcn_mfma_f32_32x32x16_bf16(kf[3],qr[1],C1,0,0,0),   P0[14],P0[15],P1[0],P1[1],   pw1[2]=PKW(P0,12),pw1[3]=PKW(P0,14), pw1); \
    VRD(0); SBAR(); GAPA(C0=__builtin_amdgcn_mfma_f32_32x32x16_bf16(kf[4],qr[2],C0,0,0,0),   P1[2],P1[3],P1[4],P1[5],     pw2[0]=PKW(P1,0), pw2[1]=PKW(P1,2), pw2); \
    VRD(1); SBAR(); GAPA(C1=__builtin_amdgcn_mfma_f32_32x32x16_bf16(kf[5],qr[2],C1,0,0,0),   P1[6],P1[7],P1[8],P1[9],     pw2[2]=PKW(P1,4), pw2[3]=PKW(P1,6), pw2); \
    VRD(2); SBAR(); GAPA(C0=__builtin_amdgcn_mfma_f32_32x32x16_bf16(kf[6],qr[3],C0,0,0,0),   P1[10],P1[11],P1[12],P1[13], pw3[0]=PKW(P1,8), pw3[1]=PKW(P1,10), pw3); \
    VRD(3); SBAR(); GAPA(C1=__builtin_amdgcn_mfma_f32_32x32x16_bf16(kf[7],qr[3],C1,0,0,0),   P1[14],P1[15],0.f,0.f,       pw3[2]=PKW(P1,12),pw3[3]=PKW(P1,14), pw3); \
    l_reg+=sacc; \
    if(GK){DMA_K((t)+3,sl_cur);} if(GV){DMA_V((t)+1,sl_next);} \
    CMASK(C0,C1,t); \
    { float a=MX3(C0[0],C0[1],C1[0]),b=MX3(C0[2],C0[3],C1[1]); a=MX3(a,C1[2],C1[3]); \
      _Pragma("unroll") for(int r=4;r<16;r+=4){a=MX3(a,C0[r],C0[r+1]);b=MX3(b,C0[r+2],C0[r+3]);a=MX3(a,C1[r],C1[r+1]);b=MX3(b,C1[r+2],C1[r+3]);} \
      float rm=__builtin_fmaxf(a,b); { auto rr=__builtin_amdgcn_permlane32_swap(__float_as_uint(rm),__float_as_uint(rm),false,false); rm=__builtin_fmaxf(__uint_as_float(rr[0]),__uint_as_float(rr[1])); } \
      rm-=mhat; \
      resc=false; \
      if(__builtin_expect(__any(rm>(float)THRL),0)){ const float dl=__builtin_fmaxf(rm,0.f); mhat+=dl; \
        const float f=__builtin_amdgcn_exp2f(-dl); l_reg*=f; if(hi==0)wsf[r32]=f; resc=true; } } \
    SBAR(); \
    GAPB(0,PAF(0),C0,0); GAPB(1,PAF(0),C0,2); GAPB(2,PAF(0),C0,4); GAPB(3,PAF(0),C0,6); \
    KRD(GL,0); GAPB(4,PAF(1),C0,8); GAPB(5,PAF(1),C0,10); KRD(GL,1); GAPB(6,PAF(1),C0,12); GAPB(7,PAF(1),C0,14); \
    KRD(GL,2); GAPB(8,PAF(2),C1,0); GAPB(9,PAF(2),C1,2); KRD(GL,3); GAPB(10,PAF(2),C1,4); GAPB(11,PAF(2),C1,6); \
    GAPB(12,PAF(3),C1,8); GAPB(13,PAF(3),C1,10); GAPB(14,PAF(3),C1,12); GAPB(15,PAF(3),C1,14); \
    }while(0)
  int t=1;
  #undef CMASK
  #define CMASK(P0,P1,t) do{}while(0)
  for(;t+5<NT;t+=2){
    STEP(pB0,pB1,pA0,pA1,t,true,true,true);     WAIT_BAR(3); RESC(); ROT();
    STEP(pA0,pA1,pB0,pB1,t+1,true,true,true);   WAIT_BAR(3); RESC(); ROT();
  }
  #undef CMASK
  #define CMASK(P0,P1,t) do{int jb_=(t)-(NT-4); if(jb_>=0)cmask(P0,P1,jb_,qrel,hi);}while(0)
  #define ENDW(tt) do{ if((tt)+3<NT){WAIT_BAR(3);} else if((tt)+2<NT){WAIT_BAR(2);} else {WAIT_BAR(0);} }while(0)
  for(;t+1<NT;t+=2){
    STEP(pB0,pB1,pA0,pA1,t,(t+3<NT),(t+1<NT),(t+1<NT));       ENDW(t);   RESC(); ROT();
    STEP(pA0,pA1,pB0,pB1,t+1,(t+4<NT),(t+2<NT),(t+2<NT));     ENDW(t+1); RESC(); ROT();
  }
  STEP(pB0,pB1,pA0,pA1,NT-1,false,false,false); RESC();
  { float sacc=pB0[0]+pB0[1]; _Pragma("unroll") for(int r=2;r<16;++r)sacc+=pB0[r]; _Pragma("unroll") for(int r=0;r<16;++r)sacc+=pB1[r]; l_reg+=sacc;
    pw0=(u32x4){PKW(pB0,0),PKW(pB0,2),PKW(pB0,4),PKW(pB0,6)};pw1=(u32x4){PKW(pB0,8),PKW(pB0,10),PKW(pB0,12),PKW(pB0,14)};pw2=(u32x4){PKW(pB1,0),PKW(pB1,2),PKW(pB1,4),PKW(pB1,6)};pw3=(u32x4){PKW(pB1,8),PKW(pB1,10),PKW(pB1,12),PKW(pB1,14)};
    SBAR(); pv4(o,vb0+2*sl_cur,PAF(0),PAF(1),PAF(2),PAF(3)); }
  #undef PKW
  #undef PAF
  #undef VFR
  #undef PIN
  #undef MX3
  #undef GAPA
  #undef GAPB
  #undef EX
  #undef VRD
  #undef KRD
  #undef STEP
  #undef ENDW
  {auto rr=__builtin_amdgcn_permlane32_swap(__float_as_uint(l_reg),__float_as_uint(l_reg),false,false);l_reg=__uint_as_float(rr[0])+__uint_as_float(rr[1]);}
  if(hi==0)wsf[32+r32]=l_reg;asm volatile("s_waitcnt lgkmcnt(0)":::"memory");
  float rli[16];
  #pragma unroll
  for(int r=0;r<16;++r)rli[r]=__builtin_amdgcn_rcpf(wsf[32+crow(r,hi)]);
  bf16*Ow=O+(rowbase+q0+wid*QBLK)*OPF;
  { bf16*stg=(bf16*)(shm+L_OST)+wid*4096;
    if(!fin){
      #pragma unroll
      for(int r=0;r<16;++r){const int orow=crow(r,hi);
        #pragma unroll
        for(int d0=0;d0<4;++d0)stg[orow*128+d0*32+r32]=__float2bfloat16(o[d0][r]*rli[r]);}
    } else {
      float wv[4];
      #pragma unroll
      for(int d0=0;d0<4;++d0)wv[d0]=sw[d0*32+r32];
      #pragma unroll
      for(int r=0;r<16;++r){const int orow=crow(r,hi); float ss=0.f;
        #pragma unroll
        for(int d0=0;d0<4;++d0){const float y=__bfloat162float(stg[orow*128+d0*32+r32])-lam*(o[d0][r]*rli[r]); o[d0][r]=y; ss+=y*y;}
        ss+=__shfl_xor(ss,1);ss+=__shfl_xor(ss,2);ss+=__shfl_xor(ss,4);ss+=__shfl_xor(ss,8);ss+=__shfl_xor(ss,16);
        const float rn=1.0f/sqrtf(ss*(1.f/128.f)+1e-6f);
        #pragma unroll
        for(int d0=0;d0<4;++d0)stg[orow*128+d0*32+r32]=__float2bfloat16(o[d0][r]*rn*wv[d0]);}
      asm volatile("s_waitcnt lgkmcnt(0)":::"memory");
      #pragma unroll
      for(int i=0;i<8;++i){const int row=i*4+(lane>>4),ch=lane&15; const u32x4 v=*(const u32x4*)(stg+row*128+ch*8); ATTN_STORE16(Ow+(long)row*OPF+ch*8,v);}
    } }
  asm volatile("s_waitcnt lgkmcnt(0)\n\ts_barrier":::"memory");
  #undef DMA_K
  #undef DMA_V
  #undef CMASK
  #undef START
  #undef RESC
  #undef ROT
}
#undef SBAR
#undef WAIT_BAR
}

#define GAS __attribute__((address_space(1)))
#define LAS __attribute__((address_space(3)))
typedef unsigned short bf16;
typedef unsigned v4u __attribute__((ext_vector_type(4)));
typedef unsigned v2u __attribute__((ext_vector_type(2)));
typedef float f32x4 __attribute__((ext_vector_type(4)));
typedef short bf16x8 __attribute__((ext_vector_type(8)));
typedef GAS unsigned gu32;
#define RLX_AGENT __ATOMIC_RELAXED, __HIP_MEMORY_SCOPE_AGENT
#define LDS_WAIT() asm volatile("s_waitcnt lgkmcnt(0)" ::: "memory")
#define VM_WAIT() asm volatile("s_waitcnt vmcnt(0)" ::: "memory")

#ifndef P1_HOSTS_P0B
#define P1_HOSTS_P0B 1
#endif
constexpr int NWAVES = 8;
constexpr int DM = 2048, NBATCH = 8, SEQ = 2048, M = NBATCH * SEQ;
constexpr int IN_COLS = 5648;
constexpr int NIN = 5632;
constexpr int NIN_G = 5888;
constexpr int UC_Z = 0, UC_XBC = 1024, UC_Q = 2560, UC_K = 3584, UC_V = 4608;
constexpr int NE = 32, EH = 1024;
constexpr float EPS = 1e-6f;
constexpr float F8_WSCALE = 64.f;
constexpr float Y8_SCALE = 16.f;
constexpr size_t MiB = 1u << 20;

constexpr int RING_OFF = 0, RING_BYTES = 131072;
constexpr int LDSCTL_OFF = 159744, MISC_OFF = LDSCTL_OFF + 320;
constexpr int LDS_BYTES = 163840;

namespace mp {
constexpr size_t ctl = 0, small = 1 * MiB, wr = 2 * MiB, rope = 3 * MiB, dt = 5 * MiB, win = 6 * MiB, wout = 30 * MiB, wgu = 38 * MiB, wd = 166 * MiB;
constexpr size_t xn = 230 * MiB, xn2 = 230 * MiB, ycat = 294 * MiB, u16 = 358 * MiB, qn = 534 * MiB, kn = 566 * MiB, xbc = 598 * MiB, o1 = 646 * MiB, o2 = 678 * MiB, ys = 710 * MiB;
constexpr size_t y = 358 * MiB, hid = 518 * MiB;
constexpr size_t lst = 742 * MiB;
constexpr size_t xn8 = 748 * MiB;
constexpr size_t END = 780 * MiB;
}
constexpr size_t CTL_ZERO_BYTES = 1 * MiB;
constexpr int CW_TMO = 0, CW_CODE = 1, CW_BAR = 4096;
constexpr int CW_Q0 = 66560;
constexpr int CW_LOC = 8192, CW_RANK = 10240;
constexpr int CW_CNT = 65536;
constexpr int LCAP = 16384;
constexpr int SLOT_CAP = 40960;
constexpr int TAB_OFF = LDSCTL_OFF + 1024;
constexpr size_t SM_TOK_E = 0, SM_TOK_POS = 131072, SM_TOK_W = 262144, SM_TOK_SLOT = 393216, SM_RINV = 524288, SM_SLOT_W = 655360, SM_SLOT_R = 851968, SM_END = 1048576;

__device__ __forceinline__ void st16_wt(void* p, v4u v) { asm volatile("global_store_dwordx4 %0, %1, off sc1\n\ts_nop 1" :: "v"(p), "v"(v) : "memory"); }
__device__ __forceinline__ unsigned f2bf(float f) { unsigned u = __builtin_bit_cast(unsigned, f); return (u + 0x7fffu + ((u >> 16) & 1u)) >> 16; }
typedef float f32x2_pk __attribute__((ext_vector_type(2))); typedef __bf16 bf16x2_pk __attribute__((ext_vector_type(2)));
__device__ __forceinline__ unsigned pk2(float lo, float hi) { f32x2_pk v = {lo, hi}; bf16x2_pk b = __builtin_convertvector(v, bf16x2_pk); return __builtin_bit_cast(unsigned, b); }
__device__ __forceinline__ float bf2f(unsigned short b) { return __builtin_bit_cast(float, (unsigned)b << 16); }
__device__ __forceinline__ float wave_sum(float v) {
#pragma unroll
    for (int o = 1; o < 64; o <<= 1) v += __shfl_xor(v, o);
    return v;
}

#define XB_TMO      128
#define XB_XCNT(j)  (256  + 64 * (j))
#define XB_XSUB(j)  (1280 + 64 * (j))
#define XB_XGEN(j)  (2304 + 64 * (j))
#define XB_TOP      3328
#define XB_TOPGEN   3392
#define XCD_BAR_WORDS 3456
#define XB_SPIN_CAP (1u << 18)

__device__ __forceinline__ unsigned xb_ld(unsigned* p)              { return __hip_atomic_load(p, __ATOMIC_RELAXED, __HIP_MEMORY_SCOPE_AGENT); }
__device__ __forceinline__ unsigned xb_add(unsigned* p, unsigned v) { return __hip_atomic_fetch_add(p, v, __ATOMIC_RELAXED, __HIP_MEMORY_SCOPE_AGENT); }
__device__ __forceinline__ unsigned xb_xcc_id() { return (unsigned)__builtin_amdgcn_s_getreg((3 << 11) | 20) & 0xFu; }
#define XB_SPIN(cond, bar) do { unsigned _sp = 0; while (cond) { __builtin_amdgcn_s_sleep(1); \
    if ((++_sp & 255u) == 0u) { if (xb_ld(&(bar)[XB_TMO])) break; if (_sp > XB_SPIN_CAP) { atomicAdd(&(bar)[XB_TMO], 1u); break; } } } } while (0)

struct XcdBarrier {
    unsigned* bar; unsigned x;
    volatile LAS unsigned* st;
};

__device__ __forceinline__ XcdBarrier xcd_barrier_post(unsigned* bar, volatile LAS unsigned* st) {
    XcdBarrier b; b.bar = bar; b.x = xb_xcc_id(); b.st = st;
    if (threadIdx.x == 0) (void)xb_add(&bar[XB_XCNT(b.x)], 1u);
    return b;
}
__device__ __forceinline__ void xcd_barrier_complete(unsigned* bar, unsigned x, unsigned& nloc, unsigned& nx) {
    const unsigned G = gridDim.x * gridDim.y * gridDim.z;
    unsigned sum, cnt, mine, sp = 0u;
    for (;;) {
        sum = 0u; cnt = 0u; mine = 0u;
#pragma unroll
        for (unsigned j = 0; j < 16; ++j) { const unsigned c = xb_ld(&bar[XB_XCNT(j)]); sum += c; cnt += (c > 0u) ? 1u : 0u; mine = (j == x) ? c : mine; }
        if (sum == G) break;
        __builtin_amdgcn_s_sleep(1);
        if ((++sp & 255u) == 0u) { if (xb_ld(&bar[XB_TMO])) break; if (sp > XB_SPIN_CAP) { atomicAdd(&bar[XB_TMO], 1u); break; } }
    }
    nloc = mine > 0u ? mine : 1u; nx = cnt > 0u ? cnt : 1u;
}

__device__ __forceinline__ void xcd_barrier(const XcdBarrier& b) {
    asm volatile("s_waitcnt vmcnt(0)" ::: "memory");
    __syncthreads();
    if (threadIdx.x == 0) {
        unsigned* bar = b.bar;
        __builtin_amdgcn_s_waitcnt(0);
        unsigned nloc = b.st[0], nx = b.st[1];
        if (nloc == 0u) { xcd_barrier_complete(bar, b.x, nloc, nx); b.st[0] = nloc; b.st[1] = nx; }
        const unsigned old = xb_add(&bar[XB_XSUB(b.x)], 1u);
        const unsigned gen = old / nloc;
        if (old + 1u == (gen + 1u) * nloc) {
            __builtin_amdgcn_fence(__ATOMIC_RELEASE, "agent");
            asm volatile("s_waitcnt vmcnt(0)" ::: "memory");
            const unsigned og = xb_add(&bar[XB_TOP], 1u);
            const unsigned tg = og / nx;
            if (og + 1u == (tg + 1u) * nx) xb_add(&bar[XB_TOPGEN], 1u);
            else XB_SPIN(xb_ld(&bar[XB_TOPGEN]) == tg, bar);
            __builtin_amdgcn_fence(__ATOMIC_ACQUIRE, "agent");
            xb_add(&bar[XB_XGEN(b.x)], 1u);
            asm volatile("s_waitcnt vmcnt(0)" ::: "memory");
        } else {
            XB_SPIN(xb_ld(&bar[XB_XGEN(b.x)]) == gen, bar);
            __builtin_amdgcn_fence(__ATOMIC_ACQUIRE, "agent");
            asm volatile("s_waitcnt vmcnt(0)" ::: "memory");
        }
    }
    __syncthreads();
}

__device__ __forceinline__ void xcd_local_barrier(unsigned* bar, unsigned* ctr, unsigned n) {
    asm volatile("s_waitcnt vmcnt(0)" ::: "memory");
    __syncthreads();
    if (threadIdx.x == 0) {
        __builtin_amdgcn_s_waitcnt(0);
        const unsigned old = xb_add(ctr, 1u), target = (old / n + 1u) * n;
        XB_SPIN(xb_ld(ctr) < target, bar);
        __builtin_amdgcn_fence(__ATOMIC_ACQUIRE, "agent");
        asm volatile("s_waitcnt vmcnt(0)" ::: "memory");
    }
    __syncthreads();
}

struct XbTok { unsigned gen, tg; int role; };
__device__ __forceinline__ void xcd_barrier_arrive(const XcdBarrier& b, XbTok& t) {
    asm volatile("s_waitcnt vmcnt(0)" ::: "memory");
    __syncthreads();
    t.gen = 0u; t.tg = 0u; t.role = 0;
    if (threadIdx.x == 0) {
        unsigned* bar = b.bar;
        __builtin_amdgcn_s_waitcnt(0);
        unsigned nloc = b.st[0], nx = b.st[1];
        if (nloc == 0u) { xcd_barrier_complete(bar, b.x, nloc, nx); b.st[0] = nloc; b.st[1] = nx; }
        const unsigned old = xb_add(&bar[XB_XSUB(b.x)], 1u);
        const unsigned gen = old / nloc; t.gen = gen;
        if (old + 1u == (gen + 1u) * nloc) {
            __builtin_amdgcn_fence(__ATOMIC_RELEASE, "agent");
            asm volatile("s_waitcnt vmcnt(0)" ::: "memory");
            const unsigned og = xb_add(&bar[XB_TOP], 1u);
            const unsigned tg = og / nx; t.tg = tg; t.role = 1;
            if (og + 1u == (tg + 1u) * nx) xb_add(&bar[XB_TOPGEN], 1u);
        }
    }
}
__device__ __forceinline__ void xcd_barrier_wait(const XcdBarrier& b, const XbTok& t) {
    if (threadIdx.x == 0) {
        unsigned* bar = b.bar;
        if (t.role == 1) { XB_SPIN(xb_ld(&bar[XB_TOPGEN]) == t.tg, bar);
            __builtin_amdgcn_fence(__ATOMIC_ACQUIRE, "agent");
            xb_add(&bar[XB_XGEN(b.x)], 1u);
            asm volatile("s_waitcnt vmcnt(0)" ::: "memory");
        } else { XB_SPIN(xb_ld(&bar[XB_XGEN(b.x)]) == t.gen, bar);
            __builtin_amdgcn_fence(__ATOMIC_ACQUIRE, "agent");
            asm volatile("s_waitcnt vmcnt(0)" ::: "memory"); }
    }
    __syncthreads();
}

struct Frame {
    LAS unsigned char* lds;
    volatile LAS unsigned* MISC;
    gu32* ctl;
    int tid, lane, wave;
    int vcu, G;
    int cid;
    unsigned char* ws;
};

struct TItem { const float* W; bf16* base; const float* kscale; int ldw, nvalid, k0, n0, kind, pitch, f8; };
constexpr int TI_PC = 36, TI_P1 = 8 * TI_PC, TI_BYTES = 16 * TI_P1 * 4;
template <int NI> __device__ __forceinline__ void titem_issue(const TItem& d, int lane, f32x4 (&ld)[NI]) {
    const int nq = d.n0 + 4 * (lane & 7); const bool ok = nq < d.nvalid;
#pragma unroll
    for (int i = 0; i < NI; ++i) ld[i] = ok ? __builtin_nontemporal_load((const GAS f32x4*)(d.W + (size_t)(d.k0 + (lane >> 3) + 8 * i) * d.ldw + nq)) : (f32x4){0.f, 0.f, 0.f, 0.f};
}
template <int NI> __device__ __forceinline__ void titem_finish(const TItem& d, int lane, const f32x4 (&ld)[NI], LAS float* scr, bf16* WIN, bf16* WDT) {
#pragma unroll
    for (int i = 0; i < NI; ++i) { const int k = (lane >> 3) + 8 * i; *(LAS f32x4*)(scr + (k % NI) * TI_P1 + (k / NI) * TI_PC + 4 * (lane & 7)) = ld[i]; }
    LDS_WAIT(); asm volatile("" ::: "memory");
    const int c = lane & 7;
    if constexpr (NI == 16) {
#pragma unroll
        for (int j = 0; j < 4; ++j) { const int nl = (lane >> 3) + 8 * j, n = d.n0 + nl; const LAS float* s = scr + c * TI_PC + nl;
            const size_t rowi = d.kind == 3 ? (size_t)((n & ~255) + ((n >> 3) & 1) * 128 + ((n >> 6) & 3) * 32 + ((n >> 4) & 3) * 8 + (n & 7))
                                            : (size_t)((n >> 7) * 256 + (n & 127));
            v4u q; q.x = pg8::cvt4_fp8(s[0 * TI_P1] * F8_WSCALE, s[1 * TI_P1] * F8_WSCALE, s[2 * TI_P1] * F8_WSCALE, s[3 * TI_P1] * F8_WSCALE); q.y = pg8::cvt4_fp8(s[4 * TI_P1] * F8_WSCALE, s[5 * TI_P1] * F8_WSCALE, s[6 * TI_P1] * F8_WSCALE, s[7 * TI_P1] * F8_WSCALE);
            q.z = pg8::cvt4_fp8(s[8 * TI_P1] * F8_WSCALE, s[9 * TI_P1] * F8_WSCALE, s[10 * TI_P1] * F8_WSCALE, s[11 * TI_P1] * F8_WSCALE); q.w = pg8::cvt4_fp8(s[12 * TI_P1] * F8_WSCALE, s[13 * TI_P1] * F8_WSCALE, s[14 * TI_P1] * F8_WSCALE, s[15 * TI_P1] * F8_WSCALE);
            if (n < d.nvalid) __builtin_nontemporal_store(q, (GAS v4u*)((unsigned char*)d.base + rowi * d.pitch + d.k0 + 16 * c)); }
    } else {
#pragma unroll
        for (int j = 0; j < 4; ++j) { const int nl = (lane >> 3) + 8 * j, n = d.n0 + nl; const LAS float* s = scr + c * TI_PC + nl;
            v4u o; o.x = pk2(s[0 * TI_P1], s[1 * TI_P1]); o.y = pk2(s[2 * TI_P1], s[3 * TI_P1]); o.z = pk2(s[4 * TI_P1], s[5 * TI_P1]); o.w = pk2(s[6 * TI_P1], s[7 * TI_P1]);
            bf16* row;
            if (d.kind == 0) row = n < 2560 ? WIN + (size_t)n * DM : (n < 2576 ? WIN + (size_t)(NIN + n - 2560) * DM : WIN + (size_t)(n - 16) * DM);
            else row = d.base + (size_t)n * d.pitch;
            if (n < d.nvalid) *(GAS v4u*)(row + d.k0 + 8 * c) = o; }
    }
    LDS_WAIT(); asm volatile("" ::: "memory");
}

struct Args { const void* in[26]; float* out; unsigned char* ws; int ph_lo, ph_hi, li, p0_mask, rep_phase, pad; };
typedef const __attribute__((address_space(4))) Args* KA;

constexpr int P0B_NBLK = 3 * NE * 128, P0B_NSUB = 4 * P0B_NBLK;
__device__ __forceinline__ void p0b_blocks(Frame& F, KA args, int first, int nq, int gstride = 1) {
    const int lane = F.lane;
    const float* w_gate = (const float*)args->in[23]; const float* w_up = (const float*)args->in[24]; const float* w_down = (const float*)args->in[25];
    bf16* WGU = (bf16*)(F.ws + mp::wgu); bf16* WD = (bf16*)(F.ws + mp::wd);
    LAS float* scr = (LAS float*)(F.lds + F.wave * TI_BYTES);
    auto decodeB = [&](int q) -> TItem {
        const int g = first + q * gstride, cb = g >> 2, i = g & 3;
        if (cb < 8192) { const int up = cb >> 12, r = cb & 4095, e = r >> 7, kb = (r >> 3) & 15, nb = r & 7;
            return TItem{(up ? w_up : w_gate) + (size_t)e * DM * EH, (bf16*)((unsigned char*)WGU + (size_t)e * 2048 * DM + (up ? (size_t)128 * DM : 0)), nullptr, EH, EH, 128 * kb, 128 * nb + 32 * i, 2, DM, 1}; }
        const int r = cb - 8192, e = r >> 7, kb = (r >> 4) & 7, nb = r & 15;
        return TItem{w_down + (size_t)e * EH * DM, (bf16*)((unsigned char*)WD + (size_t)e * DM * EH), nullptr, DM, DM, 128 * kb, 128 * nb + 32 * i, 3, EH, 1};
    };
    if (nq <= 0) return;
    TItem d0 = decodeB(0), d1 = d0, d2 = d0; f32x4 l0[16], l1[16], l2[16];
    titem_issue<16>(d0, lane, l0);
    if (nq > 1) { d1 = decodeB(1); titem_issue<16>(d1, lane, l1); }
    for (int q = 0; q < nq; q += 3) {
        if (q + 2 < nq) { d2 = decodeB(q + 2); titem_issue<16>(d2, lane, l2); }
        titem_finish<16>(d0, lane, l0, scr, nullptr, nullptr);
        if (q + 1 >= nq) break;
        if (q + 3 < nq) { d0 = decodeB(q + 3); titem_issue<16>(d0, lane, l0); }
        titem_finish<16>(d1, lane, l1, scr, nullptr, nullptr);
        if (q + 2 >= nq) break;
        if (q + 4 < nq) { d1 = decodeB(q + 4); titem_issue<16>(d1, lane, l1); }
        titem_finish<16>(d2, lane, l2, scr, nullptr, nullptr);
    }
}
constexpr int P1_UNITS = (M / 256) * (NIN_G / 256);
#if P1_HOSTS_P0B == 2
constexpr int P1_INLOOP_BLOCKS = P1_UNITS * NWAVES;
static_assert(P0B_NBLK - P1_INLOOP_BLOCKS == 64 * NWAVES, "the 64 CUs with one GEMM unit less take one more block per wave");
#endif
#ifndef P1_NCLASS
#define P1_NCLASS 3
#endif
__device__ __forceinline__ void p1_convert_share(Frame& F, KA args, int part) {
    const int c = F.cid, xcd = c & 7, l = c >> 3, lclass = xcd % P1_NCLASS;
    const int ex = l < 24 ? 0 : 12, q = 21 + ex;
    const int base = xcd * (P0B_NSUB / 8);
    const int first = l < 24 ? base + l * (NWAVES * 21) : base + 24 * NWAVES * 21 + (l - 24) * (NWAVES * 33);
    int lo, hi;
    if (part == 0) { lo = 0; hi = lclass == 0 ? q : ex; } else if (part == lclass) { lo = ex; hi = q; } else return;
    p0b_blocks(F, args, first + F.wave * q + lo, hi - lo);
}

__device__ __forceinline__ void p0_prologue(Frame& F, KA args) {
    const int gw = F.vcu * NWAVES + F.wave, NGW = F.G * NWAVES, lane = F.lane;
    const float* w_in = (const float*)args->in[3]; const float* w_out = (const float*)args->in[17];
    bf16* WIN = (bf16*)(F.ws + mp::win); bf16* WDT = nullptr; bf16* WOUT = (bf16*)(F.ws + mp::wout);
    constexpr int NB_IN = (IN_COLS + 31) / 32;
    constexpr int I_IN = (DM / 64) * NB_IN, I_OUT = (DM / 64) * (DM / 32), NITEMS_A = I_IN + I_OUT;
    LAS float* scr = (LAS float*)(F.lds + F.wave * TI_BYTES);
    auto decodeA = [&](int it) -> TItem {
        int r = it;
        if (r < I_IN) { const int kb = r / NB_IN, nb = r % NB_IN; return TItem{w_in, WIN, nullptr, IN_COLS, IN_COLS, 64 * kb, 32 * nb, 0, DM, 0}; }
        r -= I_IN; const int kb = r / (DM / 32), nb = r % (DM / 32); return TItem{w_out, WOUT, nullptr, DM, DM, 64 * kb, 32 * nb, 1, DM, 0};
    };
    if (gw < NITEMS_A) {
        TItem dc = decodeA(gw); f32x4 la[8], lb[8];
        titem_issue<8>(dc, lane, la);
        for (int it = gw; it < NITEMS_A; it += NGW) {
            const int nx = it + NGW; TItem dn = dc;
            if (nx < NITEMS_A) { dn = decodeA(nx); titem_issue<8>(dn, lane, lb); }
            titem_finish<8>(dc, lane, la, scr, WIN, WDT);
            dc = dn;
#pragma unroll
            for (int i = 0; i < 8; ++i) la[i] = lb[i];
        }
    }
#if !P1_HOSTS_P0B
    p0b_blocks(F, args, gw * (P0B_NSUB / NGW), P0B_NSUB / NGW);
#endif
}

__device__ __forceinline__ void p0_xn1(Frame& F, KA args) {
    const int lane = F.lane;
    const float* x = (const float*)args->in[0]; const float* ln1 = (const float*)args->in[2]; bf16* XN = (bf16*)(F.ws + mp::xn);
    for (int it = 0; it < 4; ++it) { const int m0 = (F.vcu >> 5) * 2048 + it * 512 + ((F.vcu & 31) * NWAVES + F.wave) * 2;
        f32x4 v[2][8];
#pragma unroll
        for (int rr = 0; rr < 2; ++rr)
#pragma unroll
            for (int j = 0; j < 8; ++j) v[rr][j] = __builtin_nontemporal_load((const GAS f32x4*)(x + (size_t)(m0 + rr) * DM) + lane + 64 * j);
#pragma unroll
        for (int rr = 0; rr < 2; ++rr) { float s = 0.f;
#pragma unroll
            for (int j = 0; j < 8; ++j) s += (v[rr][j].x * v[rr][j].x + v[rr][j].y * v[rr][j].y) + (v[rr][j].z * v[rr][j].z + v[rr][j].w * v[rr][j].w);
            const float r = 1.0f / sqrtf(wave_sum(s) * (1.f / DM) + EPS);
            GAS v2u* o8 = (GAS v2u*)(XN + (size_t)(m0 + rr) * DM) + lane; const GAS f32x4* wr = (const GAS f32x4*)ln1 + lane;
#pragma unroll
            for (int j = 0; j < 8; ++j) { const f32x4 ww = wr[64 * j]; v2u o; o.x = pk2(v[rr][j].x * r * ww.x, v[rr][j].y * r * ww.y); o.y = pk2(v[rr][j].z * r * ww.z, v[rr][j].w * r * ww.w); o8[64 * j] = o; } }
    }
}


__device__ __forceinline__ void p0_rope(Frame& F, KA args) {
    const int gt = (F.vcu * NWAVES + F.wave) * 64 + F.lane, NGT = F.G * NWAVES * 64;
    const int* pos = (const int*)args->in[1]; float* rope = (float*)(F.ws + mp::rope);
    for (int i = gt; i < M * 8; i += NGT) { const int m = i >> 3, j = i & 7;
        const float inv_freq = powf(500000.0f, -(float)(2 * j) / 16.0f);
        const float ang = (float)pos[m] * inv_freq;
        rope[m * 16 + j] = cosf(ang); rope[m * 16 + 8 + j] = sinf(ang); }
}

__device__ __forceinline__ void p2_qknorm(Frame& F, KA args) {
    const int gw = F.vcu * NWAVES + F.wave, NGW = F.G * NWAVES, lane = F.lane;
    const bf16* U16 = (const bf16*)(F.ws + mp::u16); const float* rope = (const float*)(F.ws + mp::rope);
    bf16* QN = (bf16*)(F.ws + mp::qn); bf16* KN = (bf16*)(F.ws + mp::kn);
    const float* qw = (const float*)args->in[10]; const float* kw = (const float*)args->in[11];
    const int sub = lane & 7;
    float wq[8], wk[8];
#pragma unroll
    for (int j = 0; j < 8; ++j) { wq[j] = qw[sub * 8 + j] * attn_body::C2; wk[j] = kw[sub * 8 + j]; }
    for (int it = 0; it < 2; ++it) { const int m0 = (F.vcu >> 5) * 2048 + it * 1024 + ((F.vcu & 31) * NWAVES + F.wave) * 4;
        v4u raw[4][4]; f32x4 rp[4][4];
#pragma unroll
        for (int rr = 0; rr < 4; ++rr) {
#pragma unroll
            for (int pc = 0; pc < 4; ++pc) raw[rr][pc] = __builtin_nontemporal_load((const GAS v4u*)(U16 + (size_t)(m0 + rr) * NIN + ((pc >> 1) ? UC_K : UC_Q) + (pc & 1) * 512 + lane * 8));
#pragma unroll
            for (int q = 0; q < 4; ++q) rp[rr][q] = *(const GAS f32x4*)(rope + (size_t)(m0 + rr) * 16 + 4 * q);
        }
#pragma unroll
        for (int rr = 0; rr < 4; ++rr) {
            const int m = m0 + rr;
            const float cs[8] = {rp[rr][0].x, rp[rr][0].y, rp[rr][0].z, rp[rr][0].w, rp[rr][1].x, rp[rr][1].y, rp[rr][1].z, rp[rr][1].w};
            const float sn[8] = {rp[rr][2].x, rp[rr][2].y, rp[rr][2].z, rp[rr][2].w, rp[rr][3].x, rp[rr][3].y, rp[rr][3].z, rp[rr][3].w};
#pragma unroll
            for (int pc = 0; pc < 4; ++pc) {
                const int isk = pc >> 1, col = (pc & 1) * 512 + lane * 8;
                const v4u rw = raw[rr][pc];
                float v[8];
                v[0] = __builtin_bit_cast(float, rw.x << 16); v[1] = __builtin_bit_cast(float, rw.x & 0xffff0000u); v[2] = __builtin_bit_cast(float, rw.y << 16); v[3] = __builtin_bit_cast(float, rw.y & 0xffff0000u);
                v[4] = __builtin_bit_cast(float, rw.z << 16); v[5] = __builtin_bit_cast(float, rw.z & 0xffff0000u); v[6] = __builtin_bit_cast(float, rw.w << 16); v[7] = __builtin_bit_cast(float, rw.w & 0xffff0000u);
                float ss = 0.f;
#pragma unroll
                for (int j = 0; j < 8; ++j) ss += v[j] * v[j];
                ss += __shfl_xor(ss, 1); ss += __shfl_xor(ss, 2); ss += __shfl_xor(ss, 4);
                const float r = 1.0f / sqrtf(ss * (1.f / 64.f) + EPS);
                float y[8];
#pragma unroll
                for (int j = 0; j < 8; ++j) y[j] = v[j] * r * (isk ? wk[j] : wq[j]);
#pragma unroll
                for (int j = 0; j < 8; ++j) { const float pv = __shfl_xor(y[j], 1);
                    if (sub == 0) y[j] = y[j] * cs[j] - pv * sn[j]; else if (sub == 1) y[j] = y[j] * cs[j] + pv * sn[j]; }
                v4u o; o.x = pk2(y[0], y[1]); o.y = pk2(y[2], y[3]); o.z = pk2(y[4], y[5]); o.w = pk2(y[6], y[7]);
                *(GAS v4u*)((isk ? KN : QN) + (size_t)m * 1024 + col) = o;
            }
        }
    }
}

__device__ __forceinline__ void p3_attention(Frame& F, KA args, unsigned char* lds_generic) {
    const attn_body::bf16* QN = (const attn_body::bf16*)(F.ws + mp::qn); const attn_body::bf16* KN = (const attn_body::bf16*)(F.ws + mp::kn);
    const attn_body::bf16* U16 = (const attn_body::bf16*)(F.ws + mp::u16); attn_body::bf16* YCAT = (attn_body::bf16*)(F.ws + mp::ycat);
    const float* subw = (const float*)args->in[16];
    float lam;
    { const float* lq1 = (const float*)args->in[12]; const float* lk1 = (const float*)args->in[13]; const float* lq2 = (const float*)args->in[14]; const float* lk2 = (const float*)args->in[15];
      const float s1 = wave_sum(lq1[F.lane] * lk1[F.lane]), s2 = wave_sum(lq2[F.lane] * lk2[F.lane]); lam = expf(s1) - expf(s2) + 0.2f; }
    LAS float* swl = (LAS float*)(F.lds + TAB_OFF + 1024);
    if (F.tid < 128) swl[F.tid] = subw[F.tid] * 0.8f;
    LDS_WAIT(); __syncthreads();
    const int b = F.vcu >> 5, idx = F.vcu & 31, h = idx >> 2, s = idx & 3;
    for (int i = 0; i < 4; ++i) {
        const int j = (i + 2 * (h & 1)) & 3, qb = (j >> 1) ? 7 - s : s, comp = i & 1;
        attn3::attn_unit128<8, DM>(b, qb, QN + (h * 2 + comp) * 64, KN + (h * 2 + comp) * 64, U16 + UC_V + h * 128, YCAT + 1024 + h * 128, (char*)lds_generic + RING_OFF, comp, lam, (const float*)swl);
    }
}

__device__ __forceinline__ void p4_ycat(Frame& F, KA args, int parts) {
    const int gw = F.vcu * NWAVES + F.wave, NGW = F.G * NWAVES, lane = F.lane;
    const bf16* U16 = (const bf16*)(F.ws + mp::u16); const bf16* YS = (const bf16*)(F.ws + mp::ys);
    const bf16* O1 = (const bf16*)(F.ws + mp::o1); const bf16* O2 = (const bf16*)(F.ws + mp::o2); bf16* YCAT = (bf16*)(F.ws + mp::ycat);
    const float* nw = (const float*)args->in[9]; const float* subw = (const float*)args->in[16];
    float lam;
    { const float* lq1 = (const float*)args->in[12]; const float* lk1 = (const float*)args->in[13]; const float* lq2 = (const float*)args->in[14]; const float* lk2 = (const float*)args->in[15];
      const float s1 = wave_sum(lq1[lane] * lk1[lane]), s2 = wave_sum(lq2[lane] * lk2[lane]); lam = expf(s1) - expf(s2) + 0.2f; }
    float w_s[2][8], w_a[8];
#pragma unroll
    for (int j = 0; j < 8; ++j) { w_s[0][j] = nw[lane * 8 + j]; w_s[1][j] = nw[512 + lane * 8 + j]; w_a[j] = subw[(lane & 15) * 8 + j] * 0.8f; }
    for (int it = 0; it < 4; ++it) { const int m0 = (F.vcu >> 5) * 2048 + it * 512 + ((F.vcu & 31) * NWAVES + F.wave) * 2;
        v4u yv[2][2], zv[2][2], av[2][2], bv[2][2];
#pragma unroll
        for (int rr = 0; rr < 2; ++rr) { const size_t m = (size_t)(m0 + rr);
#pragma unroll
            for (int sl = 0; sl < 2; ++sl) {
                if (parts & 1) { yv[rr][sl] = __builtin_nontemporal_load((const GAS v4u*)(YS + m * 1024 + 512 * sl + lane * 8)); zv[rr][sl] = __builtin_nontemporal_load((const GAS v4u*)(U16 + m * NIN + UC_Z + 512 * sl + lane * 8)); }
                if (parts & 2) { av[rr][sl] = __builtin_nontemporal_load((const GAS v4u*)(O1 + m * 1024 + 512 * sl + lane * 8)); bv[rr][sl] = __builtin_nontemporal_load((const GAS v4u*)(O2 + m * 1024 + 512 * sl + lane * 8)); } } }
#pragma unroll
        for (int rr = 0; rr < 2; ++rr) { const size_t m = (size_t)(m0 + rr);
#pragma unroll
        for (int sl = 0; sl < 2; ++sl) {
        if (parts & 1) {
            const v4u y0 = yv[rr][sl], z0 = zv[rr][sl];
            const unsigned yy[4] = {y0.x, y0.y, y0.z, y0.w}, zz[4] = {z0.x, z0.y, z0.z, z0.w};
            float v[8]; float ss = 0.f;
#pragma unroll
            for (int j = 0; j < 4; ++j) { const float ya = __builtin_bit_cast(float, yy[j] << 16), yb = __builtin_bit_cast(float, yy[j] & 0xffff0000u), za = __builtin_bit_cast(float, zz[j] << 16), zb = __builtin_bit_cast(float, zz[j] & 0xffff0000u);
                v[2 * j] = ya * za / (1.f + __expf(-za)); v[2 * j + 1] = yb * zb / (1.f + __expf(-zb)); ss += v[2 * j] * v[2 * j] + v[2 * j + 1] * v[2 * j + 1]; }
            ss = wave_sum(ss);
            const float r = 1.0f / sqrtf(ss * (1.f / 512.f) + EPS);
            v4u o0; o0.x = pk2(v[0] * r * w_s[sl][0], v[1] * r * w_s[sl][1]); o0.y = pk2(v[2] * r * w_s[sl][2], v[3] * r * w_s[sl][3]); o0.z = pk2(v[4] * r * w_s[sl][4], v[5] * r * w_s[sl][5]); o0.w = pk2(v[6] * r * w_s[sl][6], v[7] * r * w_s[sl][7]);
            *(GAS v4u*)(YCAT + m * DM + 512 * sl + lane * 8) = o0;
        }
        if (parts & 2) {
            const v4u a0 = av[rr][sl], b0 = bv[rr][sl];
            const unsigned aa[4] = {a0.x, a0.y, a0.z, a0.w}, bb[4] = {b0.x, b0.y, b0.z, b0.w};
            float v[8]; float ss = 0.f;
#pragma unroll
            for (int j = 0; j < 4; ++j) { v[2 * j] = __builtin_bit_cast(float, aa[j] << 16) - lam * __builtin_bit_cast(float, bb[j] << 16); v[2 * j + 1] = __builtin_bit_cast(float, aa[j] & 0xffff0000u) - lam * __builtin_bit_cast(float, bb[j] & 0xffff0000u);
                ss += v[2 * j] * v[2 * j] + v[2 * j + 1] * v[2 * j + 1]; }
            ss += __shfl_xor(ss, 1); ss += __shfl_xor(ss, 2); ss += __shfl_xor(ss, 4); ss += __shfl_xor(ss, 8);
            const float r = 1.0f / sqrtf(ss * (1.f / 128.f) + EPS);
            v4u o0; o0.x = pk2(v[0] * r * w_a[0], v[1] * r * w_a[1]); o0.y = pk2(v[2] * r * w_a[2], v[3] * r * w_a[3]); o0.z = pk2(v[4] * r * w_a[4], v[5] * r * w_a[5]); o0.w = pk2(v[6] * r * w_a[6], v[7] * r * w_a[7]);
            *(GAS v4u*)(YCAT + m * DM + 1024 + 512 * sl + lane * 8) = o0;
        }
        }
        }
    }
}

constexpr int CONV_R = 8;
__device__ __forceinline__ void p2_conv(Frame& F, KA args) {
    const int gw = F.vcu * NWAVES + F.wave, NGW = F.G * NWAVES, lane = F.lane;
    const bf16* U16 = (const bf16*)(F.ws + mp::u16); bf16* XBC = (bf16*)(F.ws + mp::xbc);
    const float* cw = (const float*)args->in[4]; const float* cb = (const float*)args->in[5];
    for (int it = 0; it < 3; ++it) { const int task = (F.vcu & 31) * NWAVES + F.wave + 256 * it;
        const int cblk = task % 3, r0 = (F.vcu >> 5) * 2048 + (task / 3) * CONV_R, c0 = cblk * 512 + lane * 8;
        const bool seq_start = (r0 % SEQ) == 0;
        v4u raw[CONV_R + 3];
#pragma unroll
        for (int j = 0; j < CONV_R + 3; ++j) { raw[j] = (v4u){0u, 0u, 0u, 0u}; if (j >= 3 || !seq_start) raw[j] = __builtin_nontemporal_load((const GAS v4u*)(U16 + (size_t)(r0 - 3 + j) * NIN + UC_XBC + c0)); }
        float w[4][8], bias[8];
#pragma unroll
        for (int j = 0; j < 4; ++j)
#pragma unroll
            for (int i = 0; i < 8; ++i) w[j][i] = cw[j * 1536 + c0 + i];
#pragma unroll
        for (int i = 0; i < 8; ++i) bias[i] = cb[c0 + i];
#pragma unroll
        for (int t = 0; t < CONV_R; ++t) {
            float o[8];
#pragma unroll
            for (int i = 0; i < 8; ++i) o[i] = bias[i];
#pragma unroll
            for (int j = 0; j < 4; ++j) { const v4u rw = raw[t + j];
                const float e[8] = {__builtin_bit_cast(float, rw.x << 16), __builtin_bit_cast(float, rw.x & 0xffff0000u), __builtin_bit_cast(float, rw.y << 16), __builtin_bit_cast(float, rw.y & 0xffff0000u),
                                    __builtin_bit_cast(float, rw.z << 16), __builtin_bit_cast(float, rw.z & 0xffff0000u), __builtin_bit_cast(float, rw.w << 16), __builtin_bit_cast(float, rw.w & 0xffff0000u)};
#pragma unroll
                for (int i = 0; i < 8; ++i) o[i] += w[j][i] * e[i]; }
#pragma unroll
            for (int i = 0; i < 8; ++i) o[i] = o[i] / (1.f + __expf(-o[i]));
            v4u ov; ov.x = pk2(o[0], o[1]); ov.y = pk2(o[2], o[3]); ov.z = pk2(o[4], o[5]); ov.w = pk2(o[6], o[7]);
            *(GAS v4u*)(XBC + (size_t)(r0 + t) * 1536 + c0) = ov;
        }
    }
}

namespace ssd {
constexpr int BCS = 2064;
constexpr int LB = 0, LC = LB + 16 * BCS, LX = LC + 16 * BCS, LXW = LX + 8192, LST = LXW + 8192, STB = 8704, LA = LST + 2 * STB, LSL = LA + 4096, SSD_LDS_END = LSL + 10 * 4096;
static_assert(SSD_LDS_END <= LDSCTL_OFF, "SSD tiles vs LDS control words");
typedef float f32x16 __attribute__((ext_vector_type(16)));
#define SSD_PIN8(a) asm volatile("" : "+v"(a[0]), "+v"(a[1]), "+v"(a[2]), "+v"(a[3]), "+v"(a[4]), "+v"(a[5]), "+v"(a[6]), "+v"(a[7]))
#define SSD_PIN4(a) asm volatile("" : "+v"(a[0]), "+v"(a[1]), "+v"(a[2]), "+v"(a[3]))
struct Ctx { LAS unsigned char* lds; const LAS float* a2; const LAS float* dtl; const LAS float* fsl; int lane, r32, hi; };
__device__ __forceinline__ void load_cf(const Ctx& c, int lb, bf16x8 (&cf)[8]) {
#pragma unroll
    for (int ks = 0; ks < 8; ++ks) cf[ks] = *(const LAS bf16x8*)(c.lds + LC + (2 * ks + c.hi) * BCS + (32 * lb + c.r32) * 16);
    SSD_PIN8(cf);
}
template <bool DIAG> __device__ __forceinline__ void intra(const Ctx& c, int lb, int st, const bf16x8 (&cf)[8], f32x16& y) {
    bf16x8 bq[8];
#pragma unroll
    for (int ks = 0; ks < 8; ++ks) bq[ks] = *(const LAS bf16x8*)(c.lds + LB + (2 * ks + c.hi) * BCS + (32 * st + c.r32) * 16);
    f32x4 av[4], dv[4];
#pragma unroll
    for (int q = 0; q < 4; ++q) { av[q] = *(const LAS f32x4*)((DIAG ? c.a2 : c.fsl) + 32 * st + 8 * q + 4 * c.hi); if (DIAG) dv[q] = *(const LAS f32x4*)(c.dtl + 32 * st + 8 * q + 4 * c.hi); }
    const float al = c.a2[32 * lb + c.r32], aref = c.a2[32 * st + 31];
    SSD_PIN8(bq); SSD_PIN4(av); if (DIAG) SSD_PIN4(dv);
    f32x16 p;
#pragma unroll
    for (int r = 0; r < 16; ++r) p[r] = 0.f;
#pragma unroll
    for (int ks = 0; ks < 8; ++ks) p = __builtin_amdgcn_mfma_f32_32x32x16_bf16(bq[ks], cf[ks], p, 0, 0, 0);
    if (DIAG) {
        float e[16];
#pragma unroll
        for (int r = 0; r < 16; ++r) e[r] = __builtin_amdgcn_exp2f(fminf(al - av[r >> 2][r & 3], 0.f));
#pragma unroll
        for (int r = 0; r < 16; ++r) { const int sl = attn_body::crow(r, c.hi); const float v = p[r] * e[r] * dv[r >> 2][r & 3]; p[r] = sl > c.r32 ? 0.f : v; }
    } else {
        const float el = __builtin_amdgcn_exp2f(al - aref);
#pragma unroll
        for (int r = 0; r < 16; ++r) p[r] *= el * av[r >> 2][r & 3];
    }
    v4u pw0, pw1;
    pw0.x = attn_body::cvtpk_s(p[0], p[1]); pw0.y = attn_body::cvtpk_s(p[2], p[3]); pw0.z = attn_body::cvtpk_s(p[4], p[5]); pw0.w = attn_body::cvtpk_s(p[6], p[7]);
    pw1.x = attn_body::cvtpk_s(p[8], p[9]); pw1.y = attn_body::cvtpk_s(p[10], p[11]); pw1.z = attn_body::cvtpk_s(p[12], p[13]); pw1.w = attn_body::cvtpk_s(p[14], p[15]);
    const LAS unsigned char* xb = c.lds + LX + ((c.lane >> 4) & 1) * 32 + (c.lane & 3) * 8 + (4 * c.hi + ((c.lane & 15) >> 2)) * 64 + (32 * st) * 64;
    const attn_body::s16x4 lo0 = attn_body::vtr((attn_body::lds_cptr)(xb)), hh0 = attn_body::vtr((attn_body::lds_cptr)(xb + 512));
    const attn_body::s16x4 lo1 = attn_body::vtr((attn_body::lds_cptr)(xb + 1024)), hh1 = attn_body::vtr((attn_body::lds_cptr)(xb + 1024 + 512));
    y = __builtin_amdgcn_mfma_f32_32x32x16_bf16(__builtin_bit_cast(bf16x8, pw0), (bf16x8){lo0[0], lo0[1], lo0[2], lo0[3], hh0[0], hh0[1], hh0[2], hh0[3]}, y, 0, 0, 0);
    y = __builtin_amdgcn_mfma_f32_32x32x16_bf16(__builtin_bit_cast(bf16x8, pw1), (bf16x8){lo1[0], lo1[1], lo1[2], lo1[3], hh1[0], hh1[1], hh1[2], hh1[3]}, y, 0, 0, 0);
}
__device__ __forceinline__ void yoff(const Ctx& c, int lb, int sbuf, f32x16& y) {
    bf16x8 cf[8], sf[8]; f32x4 av[4];
    load_cf(c, lb, cf);
#pragma unroll
    for (int ks = 0; ks < 8; ++ks) sf[ks] = *(const LAS bf16x8*)(c.lds + LST + sbuf * STB + c.r32 * 272 + (16 * ks + 8 * c.hi) * 2);
#pragma unroll
    for (int q = 0; q < 4; ++q) av[q] = *(const LAS f32x4*)(c.a2 + 32 * lb + 8 * q + 4 * c.hi);
    SSD_PIN8(cf); SSD_PIN8(sf); SSD_PIN4(av);
#pragma unroll
    for (int r = 0; r < 16; ++r) y[r] = 0.f;
#pragma unroll
    for (int ks = 0; ks < 8; ++ks) y = __builtin_amdgcn_mfma_f32_32x32x16_bf16(cf[ks], sf[ks], y, 0, 0, 0);
#pragma unroll
    for (int r = 0; r < 16; ++r) y[r] *= __builtin_amdgcn_exp2f(av[r >> 2][r & 3]);
}
__device__ __forceinline__ void state_item(const Ctx& c, int nt, int nbuf, f32x16& st) {
    const int i16 = c.lane & 15, g1 = (c.lane >> 4) & 1;
    const float dall = __builtin_amdgcn_exp2f(c.a2[127]);
#pragma unroll
    for (int r = 0; r < 16; ++r) st[r] *= dall;
    const LAS unsigned char* ab = c.lds + LB + (4 * nt + 2 * g1 + ((i16 & 3) >> 1)) * BCS + (8 * c.hi + (i16 >> 2)) * 16 + (i16 & 1) * 8;
    const LAS unsigned char* wb = c.lds + LXW + (8 * c.hi + (i16 >> 2)) * 64 + g1 * 32 + (i16 & 3) * 8;
#pragma unroll
    for (int kb = 0; kb < 2; ++kb) {
        bf16x8 af[4], wf[4];
#pragma unroll
        for (int kk = 0; kk < 4; ++kk) { const int ks = kb * 4 + kk;
            const attn_body::s16x4 a0 = attn_body::vtr((attn_body::lds_cptr)(ab + ks * 256)), a1 = attn_body::vtr((attn_body::lds_cptr)(ab + ks * 256 + 64));
            const attn_body::s16x4 w0 = attn_body::vtr((attn_body::lds_cptr)(wb + ks * 1024)), w1 = attn_body::vtr((attn_body::lds_cptr)(wb + ks * 1024 + 256));
            af[kk] = (bf16x8){a0[0], a0[1], a0[2], a0[3], a1[0], a1[1], a1[2], a1[3]}; wf[kk] = (bf16x8){w0[0], w0[1], w0[2], w0[3], w1[0], w1[1], w1[2], w1[3]}; }
        SSD_PIN4(af); SSD_PIN4(wf);
#pragma unroll
        for (int kk = 0; kk < 4; ++kk) st = __builtin_amdgcn_mfma_f32_32x32x16_bf16(af[kk], wf[kk], st, 0, 0, 0);
    }
#pragma unroll
    for (int q = 0; q < 4; ++q) { v2u w; w.x = attn_body::cvtpk_s(st[4 * q], st[4 * q + 1]); w.y = attn_body::cvtpk_s(st[4 * q + 2], st[4 * q + 3]);
        *(LAS v2u*)(c.lds + LST + nbuf * STB + c.r32 * 272 + (32 * nt + 8 * q + 4 * c.hi) * 2) = w; }
}
__device__ __forceinline__ void put_slot(const Ctx& c, int slot, const f32x16& y) {
    LAS float* sp = (LAS float*)(c.lds + LSL + slot * 4096);
#pragma unroll
    for (int r = 0; r < 16; ++r) sp[attn_body::crow(r, c.hi) * 32 + c.r32] = y[r];
}
__device__ __forceinline__ void unit(Frame& F, KA args, int u) {
    const int tid = F.tid, lane = F.lane, wave = F.wave, r32 = lane & 31, hi = lane >> 5;
    const int b = u >> 5, h = (u >> 1) & 15, ph = u & 1, g = h >> 3;
    const bf16* XBC = (const bf16*)(F.ws + mp::xbc); const float* DTR = (const float*)(F.ws + mp::dt); bf16* YS = (bf16*)(F.ws + mp::ys);
    const float dtb = ((const float*)args->in[6])[h], Ah = -expf(((const float*)args->in[7])[h]) * 1.44269504089f, Dk = ((const float*)args->in[8])[h];
    LAS unsigned char* lds = F.lds + RING_OFF;
    const size_t mbase = (size_t)b * SEQ;
    const int brow = tid >> 4, bchk = tid & 15;
    const int xrow = tid >> 2, xpc = tid & 3;
    v4u Breg[4], Creg[4], xreg;
#define SSD_LOAD_REGS(k_) do { const size_t m0_ = mbase + (size_t)(k_) * 128; \
        _Pragma("unroll") for (int i = 0; i < 4; ++i) { Breg[i] = *(const GAS v4u*)(XBC + (m0_ + brow + 32 * i) * 1536 + 1024 + g * 128 + bchk * 8); Creg[i] = *(const GAS v4u*)(XBC + (m0_ + brow + 32 * i) * 1536 + 1280 + g * 128 + bchk * 8); } \
        xreg = *(const GAS v4u*)(XBC + (m0_ + xrow) * 1536 + h * 64 + ph * 32 + xpc * 8); } while (0)
    float dtr0 = 0.f, dtr1 = 0.f;
#define SSD_LOAD_DT(k_) do { const size_t m0_ = mbase + (size_t)(k_) * 128; dtr0 = DTR[(m0_ + 2 * lane) * 16 + h]; dtr1 = DTR[(m0_ + 2 * lane + 1) * 16 + h]; } while (0)
#define SSD_PREP_A(buf_) do { \
        const float r0 = dtr0 + dtb, r1 = dtr1 + dtb; \
        const float d0 = r0 > 20.f ? r0 : log1pf(expf(r0)), d1 = r1 > 20.f ? r1 : log1pf(expf(r1)); \
        const float v0 = d0 * Ah, v1 = d1 * Ah; float s_ = v0 + v1; \
        _Pragma("unroll") for (int o = 1; o < 64; o <<= 1) { const float t = __shfl_up(s_, o); if (lane >= o) s_ += t; } \
        LAS float* a2w = (LAS float*)(lds + LA + (buf_) * 2048); LAS float* dtw = a2w + 128; LAS float* fw = a2w + 256; \
        const float aref_ = __shfl(s_, (lane & 48) | 15); \
        a2w[2 * lane] = s_ - v1; a2w[2 * lane + 1] = s_; dtw[2 * lane] = d0; dtw[2 * lane + 1] = d1; \
        fw[2 * lane] = __builtin_amdgcn_exp2f(aref_ - (s_ - v1)) * d0; fw[2 * lane + 1] = __builtin_amdgcn_exp2f(aref_ - s_) * d1; } while (0)
    f32x16 stA, stB;
#pragma unroll
    for (int r = 0; r < 16; ++r) { stA[r] = 0.f; stB[r] = 0.f; }
    SSD_LOAD_REGS(0);
    if (wave == 1) { SSD_LOAD_DT(0); SSD_PREP_A(0); }
    LDS_WAIT(); __syncthreads();
#pragma nounroll
    for (int k = 0; k < 16; ++k) {
        const int buf = k & 1, nb = buf ^ 1; const size_t m0 = mbase + (size_t)k * 128;
        Ctx c; c.lds = lds; c.a2 = (const LAS float*)(lds + LA + buf * 2048); c.dtl = c.a2 + 128; c.fsl = c.a2 + 256; c.lane = lane; c.r32 = r32; c.hi = hi;
#pragma unroll
        for (int i = 0; i < 4; ++i) { *(LAS v4u*)(lds + LB + bchk * BCS + (brow + 32 * i) * 16) = Breg[i]; *(LAS v4u*)(lds + LC + bchk * BCS + (brow + 32 * i) * 16) = Creg[i]; }
        *(LAS v4u*)(lds + LX + xrow * 64 + xpc * 16) = xreg;
        { const float wsc = __builtin_amdgcn_exp2f(c.a2[127] - c.a2[xrow]) * c.dtl[xrow];
          const float x0 = __builtin_bit_cast(float, xreg.x << 16) * wsc, x1 = __builtin_bit_cast(float, xreg.x & 0xffff0000u) * wsc, x2 = __builtin_bit_cast(float, xreg.y << 16) * wsc, x3 = __builtin_bit_cast(float, xreg.y & 0xffff0000u) * wsc;
          const float x4 = __builtin_bit_cast(float, xreg.z << 16) * wsc, x5 = __builtin_bit_cast(float, xreg.z & 0xffff0000u) * wsc, x6 = __builtin_bit_cast(float, xreg.w << 16) * wsc, x7 = __builtin_bit_cast(float, xreg.w & 0xffff0000u) * wsc;
          v4u xw; xw.x = pk2(x0, x1); xw.y = pk2(x2, x3); xw.z = pk2(x4, x5); xw.w = pk2(x6, x7);
          *(LAS v4u*)(lds + LXW + xrow * 64 + xpc * 16) = xw; }
        LDS_WAIT(); __syncthreads();
        if (k < 15) { SSD_LOAD_REGS(k + 1); if (wave == 1) SSD_LOAD_DT(k + 1); }
        {
            f32x16 y; bf16x8 cf[8];
#pragma unroll
            for (int r = 0; r < 16; ++r) y[r] = 0.f;
            if (wave == 0)      { load_cf(c, 3, cf); intra<true>(c, 3, 3, cf, y); intra<false>(c, 3, 2, cf, y); put_slot(c, 0, y); }
            else if (wave == 1) { load_cf(c, 3, cf); intra<false>(c, 3, 1, cf, y); intra<false>(c, 3, 0, cf, y); put_slot(c, 1, y); if (k < 15) SSD_PREP_A(nb); }
            else if (wave == 2) { load_cf(c, 2, cf); intra<true>(c, 2, 2, cf, y); intra<false>(c, 2, 1, cf, y); put_slot(c, 3, y); }
            else if (wave == 3) { load_cf(c, 2, cf); intra<false>(c, 2, 0, cf, y); put_slot(c, 4, y);
#pragma unroll
                                  for (int r = 0; r < 16; ++r) y[r] = 0.f;
                                  load_cf(c, 0, cf); intra<true>(c, 0, 0, cf, y); put_slot(c, 8, y); }
            else if (wave == 4) { load_cf(c, 1, cf); intra<true>(c, 1, 1, cf, y); intra<false>(c, 1, 0, cf, y); put_slot(c, 6, y); }
            else if (wave == 5) { if (k > 0) { yoff(c, 3, buf, y); put_slot(c, 2, y); yoff(c, 2, buf, y); put_slot(c, 5, y); yoff(c, 1, buf, y); put_slot(c, 7, y); yoff(c, 0, buf, y); put_slot(c, 9, y); } }
            else if (wave == 6) { state_item(c, 0, nb, stA); state_item(c, 1, nb, stB); }
            else                { state_item(c, 2, nb, stA); state_item(c, 3, nb, stB); }
        }
        LDS_WAIT(); __syncthreads();
        { const int row = tid >> 2, pc = tid & 3, lb = wave >> 1, rl = row & 31;
          const int s0 = lb == 3 ? 0 : (lb == 2 ? 3 : (lb == 1 ? 6 : 8)), s1 = lb == 3 ? 1 : (lb == 2 ? 4 : -1), so = lb == 3 ? 2 : (lb == 2 ? 5 : (lb == 1 ? 7 : 9));
          const LAS float* p0 = (const LAS float*)(lds + LSL + s0 * 4096) + rl * 32 + pc * 8;
          f32x4 ya = *(const LAS f32x4*)p0, yb = *(const LAS f32x4*)(p0 + 4);
          if (s1 >= 0) { const LAS float* p1 = (const LAS float*)(lds + LSL + s1 * 4096) + rl * 32 + pc * 8; ya += *(const LAS f32x4*)p1; yb += *(const LAS f32x4*)(p1 + 4); }
          if (k > 0) { const LAS float* p2 = (const LAS float*)(lds + LSL + so * 4096) + rl * 32 + pc * 8; ya += *(const LAS f32x4*)p2; yb += *(const LAS f32x4*)(p2 + 4); }
          const v4u xv = *(const LAS v4u*)(lds + LX + row * 64 + pc * 16);
          v4u o; o.x = pk2(ya.x + Dk * __builtin_bit_cast(float, xv.x << 16), ya.y + Dk * __builtin_bit_cast(float, xv.x & 0xffff0000u)); o.y = pk2(ya.z + Dk * __builtin_bit_cast(float, xv.y << 16), ya.w + Dk * __builtin_bit_cast(float, xv.y & 0xffff0000u));
          o.z = pk2(yb.x + Dk * __builtin_bit_cast(float, xv.z << 16), yb.y + Dk * __builtin_bit_cast(float, xv.z & 0xffff0000u)); o.w = pk2(yb.z + Dk * __builtin_bit_cast(float, xv.w << 16), yb.w + Dk * __builtin_bit_cast(float, xv.w & 0xffff0000u));
          *(GAS v4u*)(YS + (m0 + row) * 1024 + h * 64 + ph * 32 + pc * 8) = o; }
    }
    LDS_WAIT(); __syncthreads();
#undef SSD_LOAD_REGS
#undef SSD_LOAD_DT
#undef SSD_PREP_A
}
#undef SSD_PIN8
#undef SSD_PIN4
}
__device__ __forceinline__ void p3_ssd(Frame& F, KA args) {
    for (int u = F.vcu; u < 256; u += F.G) ssd::unit(F, args, u);
}

__device__ __forceinline__ void p0_small(Frame& F, KA args) {
    const int gt = (F.vcu * NWAVES + F.wave) * 64 + F.lane, NGT = F.G * NWAVES * 64;
    const float* ln2 = (const float*)args->in[18]; const float* wrg = (const float*)args->in[19]; const float* wre = (const float*)args->in[21];
    bf16* WRH = (bf16*)(F.ws + mp::wr); bf16* WRL = WRH + 48 * DM;
    for (int i = gt; i < 48 * DM; i += NGT) { const int c = i / DM, k = i % DM;
        const float w = (c < 4 ? wrg[k * 4 + c] : (c < 36 ? wre[k * 32 + (c - 4)] : 0.f)) * ln2[k];
        const unsigned hi = f2bf(w); const float lo = w - bf2f((unsigned short)hi);
        WRH[i] = (bf16)hi; WRL[i] = (bf16)f2bf(lo); }
    { GAS v4u* z = (GAS v4u*)((bf16*)(F.ws + mp::win) + (size_t)(NIN + 16) * DM);
      for (int i = gt; i < (NIN_G - NIN - 16) * DM / 8; i += NGT) z[i] = (v4u){0u, 0u, 0u, 0u}; }
}

__device__ __forceinline__ void p5_route(Frame& F, KA args) {
    const int lane = F.lane;
    const bf16* h = (const bf16*)(F.ws + mp::xn2);
    const bf16* WRH = (const bf16*)(F.ws + mp::wr); const bf16* WRL = WRH + 48 * DM;
    const float* brg = (const float*)args->in[20]; const float* bre = (const float*)args->in[22];
    int* tok_e = (int*)(F.ws + mp::small + SM_TOK_E); int* tok_pos = (int*)(F.ws + mp::small + SM_TOK_POS); float* tok_w = (float*)(F.ws + mp::small + SM_TOK_W);
    int* lst_tok = (int*)(F.ws + mp::lst); float* lst_w = (float*)(F.ws + mp::lst) + NE * LCAP; float* lst_r = lst_w + NE * LCAP;
    unsigned* cnt = (unsigned*)(F.ctl + CW_CNT);
    LAS float* lg = (LAS float*)(F.lds + RING_OFF + F.wave * 4096);
    constexpr int KQ = 512, WQB = 2 * 48 * KQ * 2;
    LAS unsigned char* wq = F.lds + RING_OFF + 32768;
    for (int wt = F.vcu; wt < M / 64; wt += F.G) {
        const int rt = F.wave & 3, kh = F.wave >> 2, task = wt * 4 + rt;
        const bf16* hr = h + (size_t)(task * 16 + (lane & 15)) * DM + (lane >> 4) * 8;
        f32x4 acc0 = (f32x4){0.f, 0.f, 0.f, 0.f}, acc1 = acc0, acc2 = acc0; float ss = 0.f;
        for (int q = 0; q < DM / KQ; ++q) {
            __syncthreads();
#pragma unroll
            for (int i = 0; i < 12; ++i) { const int pc = F.tid + 512 * i, row = pc >> 6, c16 = pc & 63;
                const v4u v = *(const GAS v4u*)((row < 48 ? WRH + (size_t)row * DM : WRL + (size_t)(row - 48) * DM) + q * KQ + c16 * 8);
                *(LAS v4u*)(wq + row * 1040 + c16 * 16) = v; }
            LDS_WAIT(); __syncthreads();
#pragma unroll 4
            for (int k8 = 0; k8 < 8; ++k8) {
                const int kt = kh * 8 + k8;
                const v4u hv = *(const GAS v4u*)(hr + q * KQ + kt * 32);
                { const float e0 = __builtin_bit_cast(float, hv.x << 16), e1 = __builtin_bit_cast(float, hv.x & 0xffff0000u), e2 = __builtin_bit_cast(float, hv.y << 16), e3 = __builtin_bit_cast(float, hv.y & 0xffff0000u);
                  const float e4 = __builtin_bit_cast(float, hv.z << 16), e5 = __builtin_bit_cast(float, hv.z & 0xffff0000u), e6 = __builtin_bit_cast(float, hv.w << 16), e7 = __builtin_bit_cast(float, hv.w & 0xffff0000u);
                  ss += (e0 * e0 + e1 * e1) + (e2 * e2 + e3 * e3) + (e4 * e4 + e5 * e5) + (e6 * e6 + e7 * e7); }
                const bf16x8 ah = __builtin_bit_cast(bf16x8, hv);
                const LAS unsigned char* bp = wq + (lane & 15) * 1040 + kt * 64 + (lane >> 4) * 16;
                { const bf16x8 b_h = *(const LAS bf16x8*)(bp), b_l = *(const LAS bf16x8*)(bp + 48 * 1040);
                  acc0 = __builtin_amdgcn_mfma_f32_16x16x32_bf16(ah, b_h, acc0, 0, 0, 0); acc0 = __builtin_amdgcn_mfma_f32_16x16x32_bf16(ah, b_l, acc0, 0, 0, 0); }
                { const bf16x8 b_h = *(const LAS bf16x8*)(bp + 16 * 1040), b_l = *(const LAS bf16x8*)(bp + 64 * 1040);
                  acc1 = __builtin_amdgcn_mfma_f32_16x16x32_bf16(ah, b_h, acc1, 0, 0, 0); acc1 = __builtin_amdgcn_mfma_f32_16x16x32_bf16(ah, b_l, acc1, 0, 0, 0); }
                { const bf16x8 b_h = *(const LAS bf16x8*)(bp + 32 * 1040), b_l = *(const LAS bf16x8*)(bp + 80 * 1040);
                  acc2 = __builtin_amdgcn_mfma_f32_16x16x32_bf16(ah, b_h, acc2, 0, 0, 0); acc2 = __builtin_amdgcn_mfma_f32_16x16x32_bf16(ah, b_l, acc2, 0, 0, 0); }
            }
        }
        __syncthreads();
        LAS float* xp = (LAS float*)(F.lds + RING_OFF + 32768 + rt * 4096) + lane * 13;
        if (kh == 1) {
#pragma unroll
            for (int q = 0; q < 4; ++q) { xp[q] = acc0[q]; xp[4 + q] = acc1[q]; xp[8 + q] = acc2[q]; }
            xp[12] = ss; }
        LDS_WAIT(); __syncthreads();
        if (kh == 0) {
#pragma unroll
        for (int q = 0; q < 4; ++q) { acc0[q] += xp[q]; acc1[q] += xp[4 + q]; acc2[q] += xp[8 + q]; }
        ss += xp[12];
        ss += __shfl_xor(ss, 16); ss += __shfl_xor(ss, 32);
        const float r = 1.0f / sqrtf(ss * (1.f / DM) + EPS);
#pragma unroll
        for (int reg = 0; reg < 4; ++reg) { const int row = (lane >> 4) * 4 + reg; const float rr = __shfl(r, row);
            lg[row * 48 + (lane & 15)] = acc0[reg] * rr; lg[row * 48 + 16 + (lane & 15)] = acc1[reg] * rr; lg[row * 48 + 32 + (lane & 15)] = acc2[reg] * rr; }
        LDS_WAIT(); asm volatile("" ::: "memory");
        if (lane < 16) {
            const LAS float* L = lg + lane * 48; const int tok = task * 16 + lane;
            float gl[4];
#pragma unroll
            for (int j = 0; j < 4; ++j) gl[j] = L[j] + brg[j];
            int gs = 0; float gm = gl[0];
#pragma unroll
            for (int j = 1; j < 4; ++j) if (gl[j] > gm) { gm = gl[j]; gs = j; }
            float gsum = 0.f;
#pragma unroll
            for (int j = 0; j < 4; ++j) gsum += expf(gl[j] - gm);
            const float gwt = 1.f / gsum;
            float el[8];
#pragma unroll
            for (int j = 0; j < 8; ++j) el[j] = L[4 + gs * 8 + j] + bre[gs * 8 + j];
            int i1 = 0; float m1 = el[0];
#pragma unroll
            for (int j = 1; j < 8; ++j) if (el[j] > m1) { m1 = el[j]; i1 = j; }
            int i2 = 0; float m2 = -INFINITY;
#pragma unroll
            for (int j = 0; j < 8; ++j) if (j != i1 && el[j] > m2) { m2 = el[j]; i2 = j; }
            const float e2 = expf(m2 - m1); const float w1 = gwt / (1.f + e2), w2 = gwt * e2 / (1.f + e2);
            const int ea = gs * 8 + i1, eb = gs * 8 + i2;
            tok_e[tok * 2] = ea; tok_e[tok * 2 + 1] = eb; tok_w[tok * 2] = w1; tok_w[tok * 2 + 1] = w2;
            const int pa = (int)__hip_atomic_fetch_add(cnt + ea, 1u, RLX_AGENT), pb = (int)__hip_atomic_fetch_add(cnt + eb, 1u, RLX_AGENT);
            tok_pos[tok * 2] = pa; tok_pos[tok * 2 + 1] = pb;
            lst_tok[ea * LCAP + pa] = tok; lst_w[ea * LCAP + pa] = w1; lst_r[ea * LCAP + pa] = r; lst_tok[eb * LCAP + pb] = tok; lst_w[eb * LCAP + pb] = w2; lst_r[eb * LCAP + pb] = r;
        }
        }
        LDS_WAIT(); __syncthreads();
    }
}

__device__ __forceinline__ void build_tab(Frame& F, KA args) {
    LAS int* tab = (LAS int*)(F.lds + TAB_OFF);
    if (F.wave == 0) {
        const int lane = F.lane, e = lane & 31; unsigned* cnt = (unsigned*)(F.ctl + CW_CNT);
        const int c = (int)__hip_atomic_load(cnt + e, RLX_AGENT), mt = (c + 255) >> 8;
        int sc = mt;
#pragma unroll
        for (int o = 1; o < 32; o <<= 1) { const int t = __shfl_up(sc, o); if (e >= o) sc += t; }
        if (lane < 32) { tab[e] = (sc - mt) * 8; tab[40 + e] = sc - mt; tab[80 + e] = c; }
        if (lane == 31) { tab[32] = sc * 8; tab[72] = sc; }
    }
    LDS_WAIT(); __syncthreads();
}

__device__ __forceinline__ void p8_combine(Frame& F, KA args) {
    const int gw = F.vcu * NWAVES + F.wave, NGW = F.G * NWAVES, lane = F.lane;
    build_tab(F, args);
    const LAS int* tab = (const LAS int*)(F.lds + TAB_OFF);
    const int* tok_e = (const int*)(F.ws + mp::small + SM_TOK_E); const int* tok_pos = (const int*)(F.ws + mp::small + SM_TOK_POS); const unsigned char* Y8 = (const unsigned char*)(F.ws + mp::y); float* out = args->out;
    const bf16* HB = (const bf16*)(F.ws + mp::xn2);
    v4u hvA[2][2], avA[2], bvA[2], hvB[2][2], avB[2], bvB[2];
#define P8_LOAD(t_, hv_, av_, bv_) do { const int s0_ = tab[40 + tok_e[2 * (t_)]] * 256 + tok_pos[2 * (t_)], s1_ = tab[40 + tok_e[2 * (t_) + 1]] * 256 + tok_pos[2 * (t_) + 1]; \
        _Pragma("unroll") for (int j = 0; j < 2; ++j) { const int c0 = 16 * (lane + 64 * j); \
            hv_[j][0] = __builtin_nontemporal_load((const GAS v4u*)(HB + (size_t)(t_) * DM + c0)); hv_[j][1] = __builtin_nontemporal_load((const GAS v4u*)(HB + (size_t)(t_) * DM + c0 + 8)); \
            av_[j] = __builtin_nontemporal_load((const GAS v4u*)(Y8 + (size_t)s0_ * DM + c0)); bv_[j] = __builtin_nontemporal_load((const GAS v4u*)(Y8 + (size_t)s1_ * DM + c0)); } } while (0)
#define P8_STORE(t_, hv_, av_, bv_) do { \
        _Pragma("unroll") for (int j = 0; j < 2; ++j) { const int c0 = 16 * (lane + 64 * j); \
            const unsigned hw[8] = {hv_[j][0].x, hv_[j][0].y, hv_[j][0].z, hv_[j][0].w, hv_[j][1].x, hv_[j][1].y, hv_[j][1].z, hv_[j][1].w}; \
            const unsigned aw[4] = {av_[j].x, av_[j].y, av_[j].z, av_[j].w}, bw[4] = {bv_[j].x, bv_[j].y, bv_[j].z, bv_[j].w}; \
            _Pragma("unroll") for (int q = 0; q < 4; ++q) { \
                const f32x2_t a01 = __builtin_amdgcn_cvt_pk_f32_fp8((int)aw[q], false), a23 = __builtin_amdgcn_cvt_pk_f32_fp8((int)aw[q], true); \
                const f32x2_t b01 = __builtin_amdgcn_cvt_pk_f32_fp8((int)bw[q], false), b23 = __builtin_amdgcn_cvt_pk_f32_fp8((int)bw[q], true); \
                f32x4 v; \
                v.x = __builtin_bit_cast(float, hw[2 * q] << 16) + (a01.x + b01.x) * (1.f / Y8_SCALE); v.y = __builtin_bit_cast(float, hw[2 * q] & 0xffff0000u) + (a01.y + b01.y) * (1.f / Y8_SCALE); \
                v.z = __builtin_bit_cast(float, hw[2 * q + 1] << 16) + (a23.x + b23.x) * (1.f / Y8_SCALE); v.w = __builtin_bit_cast(float, hw[2 * q + 1] & 0xffff0000u) + (a23.y + b23.y) * (1.f / Y8_SCALE); \
                *(GAS f32x4*)(out + (size_t)(t_) * DM + c0 + 4 * q) = v; } } } while (0)
    typedef float f32x2_t __attribute__((ext_vector_type(2)));
    if (gw < M) P8_LOAD(gw, hvA, avA, bvA);
    for (int t = gw; t < M; t += 2 * NGW) {
        P8_LOAD(t + NGW, hvB, avB, bvB);
        P8_STORE(t, hvA, avA, bvA);
        if (t + 2 * NGW < M) P8_LOAD(t + 2 * NGW, hvA, avA, bvA);
        P8_STORE(t + NGW, hvB, avB, bvB);
    }
#undef P8_LOAD
#undef P8_STORE
}

constexpr int N_PHASES = 11;
#ifndef MK_REP_BAR
#define MK_REP_BAR 0
#endif
#ifndef MK_REP_PHASE
#define MK_REP_PHASE -1
#endif
#define PHASE_ARGS() ({ KA p_ = (KA)__builtin_amdgcn_kernarg_segment_ptr(); asm volatile("" : "+s"(p_)); p_; })
__global__ void __launch_bounds__(NWAVES * 64, 2) mega(Args args_byval) {
    KA args = PHASE_ARGS(); (void)args_byval;
    extern __shared__ __attribute__((aligned(16))) unsigned char lds[];
    Frame F;
    F.lds = (LAS unsigned char*)lds;
    F.MISC = (volatile LAS unsigned*)(F.lds + MISC_OFF);
    F.tid = threadIdx.x; F.lane = F.tid & 63; F.wave = __builtin_amdgcn_readfirstlane(F.tid >> 6);
    F.G = gridDim.x; { const int bx = blockIdx.x; F.vcu = (F.G % 8 == 0) ? (bx % 8) * (F.G / 8) + bx / 8 : bx; }
    F.cid = (int)blockIdx.x;
    F.ws = args->ws;
    F.ctl = (gu32*)(F.ws + mp::ctl);
    for (int u = F.tid; u < (LDS_BYTES - LDSCTL_OFF) / 4; u += NWAVES * 64) ((LAS unsigned*)(F.lds + LDSCTL_OFF))[u] = 0u;
    __syncthreads();
    const bool one_launch = (args->li < 0);
    XcdBarrier bar; bar.bar = (unsigned*)(F.ctl + CW_BAR); bar.x = 0; bar.st = nullptr;
    if (one_launch) bar = xcd_barrier_post((unsigned*)(F.ctl + CW_BAR), F.MISC + 8);
    if (one_launch && F.tid == 0) { const unsigned x_ = xb_xcc_id(); F.MISC[10] = x_; F.MISC[11] = xb_add((unsigned*)(F.ctl + CW_RANK + 64 * x_), 1u); }
    bool local_ok = false; unsigned* loc_ctr = nullptr;
    const int lo = args->ph_lo, hi = args->ph_hi;
#define IN(k) (lo <= (k) && (k) < hi)
#define SEAM(k) do { if (IN(k) && IN((k) + 1)) xcd_barrier(bar); } while (0)
#define SEAM_LOCAL(k) do { if (IN(k) && IN((k) + 1)) { if (local_ok) xcd_local_barrier(bar.bar, loc_ctr, 32u); else xcd_barrier(bar); } } while (0)

    if (IN(0)) for (int rep_ = 0; rep_ < (MK_REP_PHASE == 0 ? 2 : 1); ++rep_) { args = PHASE_ARGS(); p0_prologue(F, args); if (args->p0_mask & 8) p0_small(F, args); if (args->p0_mask & 16) p0_rope(F, args); }
    if (one_launch && IN(0) && IN(1)) {
        XbTok tok; xcd_barrier_arrive(bar, tok);
        if (F.tid == 0) { unsigned ok_ = (F.G == 256) ? 1u : 0u;
            for (unsigned j = 0; j < 16; ++j) { const unsigned c_ = xb_ld(&bar.bar[XB_XCNT(j)]); if (c_ != (j < 8 ? 32u : 0u)) ok_ = 0u; }
            F.MISC[12] = ok_; }
        __syncthreads();
        if (F.MISC[12]) { const int x_ = (int)F.MISC[10], r_ = (int)F.MISC[11]; local_ok = true; F.vcu = x_ * 32 + r_; F.cid = r_ * 8 + x_; loc_ctr = (unsigned*)(F.ctl + CW_LOC + 64 * x_); }
        args = PHASE_ARGS(); p0_xn1(F, args);
        xcd_barrier_wait(bar, tok);
        if (local_ok) xcd_local_barrier(bar.bar, loc_ctr, 32u); else xcd_barrier(bar);
    } else {
        if (IN(0)) { args = PHASE_ARGS(); p0_xn1(F, args); }
        SEAM(0);
    }
    if (IN(1)) for (int rep_ = 0; rep_ < (MK_REP_PHASE == 1 ? 2 : 1); ++rep_) { args = PHASE_ARGS();
        pg8::Gemm g{(const bf16*)(F.ws + mp::xn), (const bf16*)(F.ws + mp::win), M, NIN_G, DM};
        pg8::EpiInProj E{(bf16*)(F.ws + mp::u16), NIN, (float*)(F.ws + mp::dt)};
#if P1_HOSTS_P0B == 1
        const int c_ = F.cid, xcd_ = c_ & 7, team_ = c_ >> 6;
        const int ks = team_ < 3 ? ((xcd_ % P1_NCLASS) == 0 ? (xcd_ + 2 * team_) % 7 : 0) : xcd_ % 6;
        for (int part = 0; part < 2; ++part) {
            pg8::TeamOrder S{c_, part == 0 ? 0 : ks, part == 0 ? ks : 6};
            pg8::gemm_phase<pg8::EpiInProj, pg8::TeamOrder, PG8_ALIGN, PG8_SP2>(F.lds + RING_OFF, g, S, E);
            if (part == 0) { __syncthreads(); args = PHASE_ARGS(); p1_convert_share(F, args, 0); __syncthreads(); }
        }
#elif P1_HOSTS_P0B == 2
        pg8::StaticOrder S; S.init(M, NIN_G, F.G, (int)blockIdx.x);
        typedef pg8::ConvMoE<KA, 23, mp::wgu, mp::wd, mp::END, RING_OFF + RING_BYTES> CvJob;
        pg8::gemm_phase<pg8::EpiInProj, pg8::StaticOrder, PG8_ALIGN, PG8_SP2, false, CvJob>(F.lds + RING_OFF, g, S, E, CvJob{});
        if ((int)blockIdx.x >= P1_UNITS - 5 * F.G) { __syncthreads(); args = PHASE_ARGS(); p0b_blocks(F, args, 4 * (P1_INLOOP_BLOCKS + ((int)blockIdx.x - (P1_UNITS - 5 * F.G)) * NWAVES + F.wave), 4); }
#else
        pg8::StaticOrder S; S.init(M, NIN_G, F.G, (int)blockIdx.x);
        pg8::gemm_phase<pg8::EpiInProj, pg8::StaticOrder, PG8_ALIGN, PG8_SP2>(F.lds + RING_OFF, g, S, E);
#endif
    }
    SEAM_LOCAL(1);
    if (IN(2)) for (int rep_ = 0; rep_ < (MK_REP_PHASE == 2 ? 2 : 1); ++rep_) { if (MK_REP_BAR && rep_) xcd_barrier(bar); args = PHASE_ARGS(); p2_qknorm(F, args); p2_conv(F, args); }
    SEAM_LOCAL(2);
    if (IN(3)) for (int rep_ = 0; rep_ < (MK_REP_PHASE == 3 ? 2 : 1); ++rep_) { args = PHASE_ARGS(); if (args->p0_mask & 128) p3_ssd(F, args); p3_attention(F, args, lds);
#if P1_HOSTS_P0B == 1
        if (rep_ == 0) { __syncthreads(); args = PHASE_ARGS(); p1_convert_share(F, args, 1); }
#endif
    }
    SEAM_LOCAL(3);
    if (IN(4)) for (int rep_ = 0; rep_ < (MK_REP_PHASE == 4 ? 2 : 1); ++rep_) { args = PHASE_ARGS(); p4_ycat(F, args, (args->p0_mask >> 5) & 3); }
    SEAM_LOCAL(4);
    if (IN(5)) for (int rep_ = 0; rep_ < (MK_REP_PHASE == 5 ? 2 : 1); ++rep_) { args = PHASE_ARGS();
        pg8::Gemm g{(const bf16*)(F.ws + mp::ycat), (const bf16*)(F.ws + mp::wout), M, DM, DM}; pg8::StaticOrder S; S.init(M, DM, F.G, F.cid);
        pg8::EpiResid E{(const float*)args->in[0], (bf16*)(F.ws + mp::xn2), (unsigned char*)(F.ws + mp::xn8), DM, (const float*)args->in[18]};
        pg8::gemm_phase<pg8::EpiResid, pg8::StaticOrder, PG8_ALIGN, PG8_SP2>(F.lds + RING_OFF, g, S, E);
#if P1_HOSTS_P0B == 1
        if (rep_ == 0) { __syncthreads(); args = PHASE_ARGS(); p1_convert_share(F, args, 2); }
#endif
    }
    SEAM_LOCAL(5);
    if (IN(6)) for (int rep_ = 0; rep_ < (MK_REP_PHASE == 6 ? 2 : 1); ++rep_) { args = PHASE_ARGS(); p5_route(F, args);
#if P1_HOSTS_P0B == 1
        if (rep_ == 0) { __syncthreads(); args = PHASE_ARGS(); p1_convert_share(F, args, 3); }
#endif
    }
    SEAM(6);
    if (IN(8)) for (int rep_ = 0; rep_ < (MK_REP_PHASE == 8 ? 2 : 1); ++rep_) { args = PHASE_ARGS();
        build_tab(F, args);
        pg8::Gemm g{(const bf16*)(F.ws + mp::xn8), (const bf16*)(F.ws + mp::wgu), M, NE * 2048, DM / 2};    pg8::ExpertOrder S; S.init((const LAS int*)(F.lds + TAB_OFF), F.G, F.cid);
        pg8::ExpertRows RS{(const LAS int*)(F.lds + TAB_OFF), (const int*)(F.ws + mp::lst), LCAP};
        pg8::EpiGateUp E{(unsigned char*)(F.ws + mp::hid), EH, pg8::ExpertScale{(const LAS int*)(F.lds + TAB_OFF), (const float*)(F.ws + mp::lst) + 2 * NE * LCAP, LCAP}, 1.f / F8_WSCALE};
        pg8::gemm_phase_g<pg8::EpiGateUp, pg8::ExpertOrder, pg8::ExpertRows, PG8_ALIGN, PG8_SP2, true>(F.lds + RING_OFF, g, S, E, RS);
    }
    SEAM(8);
    if (IN(9)) for (int rep_ = 0; rep_ < (MK_REP_PHASE == 9 ? 2 : 1); ++rep_) { args = PHASE_ARGS();
        build_tab(F, args);
        pg8::Gemm g{(const bf16*)(F.ws + mp::hid), (const bf16*)(F.ws + mp::wd), SLOT_CAP, NE * 2048, EH / 2};    pg8::ExpertOrder S; S.init((const LAS int*)(F.lds + TAB_OFF), F.G, F.cid);
        pg8::EpiRowScale E{(unsigned char*)(F.ws + mp::y), DM, pg8::ExpertScale{(const LAS int*)(F.lds + TAB_OFF), (const float*)(F.ws + mp::lst) + NE * LCAP, LCAP}, Y8_SCALE / F8_WSCALE};
        pg8::gemm_phase<pg8::EpiRowScale, pg8::ExpertOrder, PG8_ALIGN, PG8_SP2, true>(F.lds + RING_OFF, g, S, E);
    }
    SEAM(9);
    if (IN(10)) for (int rep_ = 0; rep_ < (MK_REP_PHASE == 10 ? 2 : 1); ++rep_) { args = PHASE_ARGS(); p8_combine(F, args); }
#undef IN
#undef SEAM
#undef SEAM_LOCAL
}

__global__ void __launch_bounds__(256) k_u16_to_f32(const bf16* __restrict__ U16, const float* __restrict__ DT, float* __restrict__ U) {
    const size_t idx = (size_t)blockIdx.x * 256 + threadIdx.x;
    const int c = (int)(idx % IN_COLS); const size_t m = idx / IN_COLS;
    float v;
    if (c < 2560) v = bf2f(U16[m * NIN + c]); else if (c < 2576) v = DT[m * 16 + (c - 2560)]; else v = bf2f(U16[m * NIN + c - 16]);
    U[idx] = v;
}
__global__ void __launch_bounds__(256) k_f32_to_bf16(const float* __restrict__ src, bf16* __restrict__ dst) {
    const size_t i = (size_t)blockIdx.x * 256 + threadIdx.x;
    const float4 v = ((const float4*)src)[i]; v2u o; o.x = pk2(v.x, v.y); o.y = pk2(v.z, v.w); ((v2u*)dst)[i] = o;
}
__global__ void __launch_bounds__(256) k_ssdhalf_to_bf16(const float* __restrict__ YCATf, bf16* __restrict__ YCAT16) {
    const size_t i = (size_t)blockIdx.x * 256 + threadIdx.x;
    const size_t m = i >> 8; const int c4 = (int)(i & 255);
    const float4 v = ((const float4*)(YCATf + m * DM))[c4]; v2u o; o.x = pk2(v.x, v.y); o.y = pk2(v.z, v.w); ((v2u*)(YCAT16 + m * DM))[c4] = o;
}

#ifndef MK_ONE_LAUNCH
#define MK_ONE_LAUNCH 1
#endif
extern "C" void kernel_launch(void* const* d_in, const int* in_sizes, int n_in, void* d_out, int out_size, void* d_ws, size_t ws_size, hipStream_t stream) {
    static int ready = 0;
    if (!ready) {
        if (hipFuncSetAttribute((const void*)mega, hipFuncAttributeMaxDynamicSharedMemorySize, LDS_BYTES) != hipSuccess) { fprintf(stderr, "hipFuncSetAttribute failed\n"); }
        if (ws_size < mp::END) fprintf(stderr, "kernel_launch: ws_size %zu too small\n", ws_size);
        ready = 1;
    }
    (void)hipMemsetAsync(d_ws, 0, CTL_ZERO_BYTES, stream);
    Args a{};
    for (int i = 0; i < 26; ++i) a.in[i] = d_in[i];
    a.out = (float*)d_out; a.ws = (unsigned char*)d_ws;
    a.p0_mask = 1 | 2 | 4 | 8 | 16 | (1 << 5) | 128; a.rep_phase = MK_REP_PHASE;
#if MK_ONE_LAUNCH
    a.ph_lo = 0; a.ph_hi = N_PHASES; a.li = -1; hipLaunchKernelGGL(mega, dim3(256), dim3(NWAVES * 64), LDS_BYTES, stream, a);
#else
    for (int ph = 0; ph < N_PHASES; ++ph) { a.ph_lo = ph; a.ph_hi = ph + 1; a.li = ph; hipLaunchKernelGGL(mega, dim3(256), dim3(NWAVES * 64), LDS_BYTES, stream, a); }
#endif
}
```

```cpp
#include <hip/hip_runtime.h>
#include <hip/hip_bf16.h>
#include <math.h>
#include <stdint.h>
#include <cstdio>
#include <cmath>
namespace pg8 {
#define PG8_LAS __attribute__((address_space(3)))
typedef unsigned short bf16_t;
typedef short bf16x8 __attribute__((ext_vector_type(8)));
typedef float f32x4 __attribute__((ext_vector_type(4)));
typedef unsigned u32x4 __attribute__((ext_vector_type(4)));
typedef int v8i_t __attribute__((ext_vector_type(8)));
constexpr int BM = 256, BK = 64, HALF = 128, HTB = HALF * BK * 2  , STAGE_BYTES = 8 * HTB, NXCD = 8, WGM = 8;

__host__ __device__ __forceinline__ int lds_byte(int r, int c) { const int st = (r >> 4) * 2 + (c >> 5), rr = r & 15, cc = c & 31, ob = rr * 64 + cc * 2; return st * 1024 + (ob ^ (((ob >> 9) & 1) << 5)); }
__host__ __device__ __forceinline__ void stage_rc(int b, int& R, int& C) { const int st = b / 1024, sb = b % 1024, swz = sb ^ (((sb >> 9) & 1) << 5); R = (st >> 1) * 16 + swz / 64; C = (st & 1) * 32 + (swz % 64) / 2; }
__host__ __device__ __forceinline__ int perm32(int rho) { const int n = rho >> 4, i = rho & 15; return 8 * (i >> 2) + 4 * n + (i & 3); }

struct Unit { int pm, pn; };
struct Gemm { const bf16_t* A; const bf16_t* Bt; int M, N, K; };

struct StaticOrder {
    int nM, nN, nwg, G, c;
    __host__ __device__ void init(int M, int N, int G_, int c_) { nM = M / BM; nN = N / BM; nwg = nM * nN; G = G_; c = c_; }
    __host__ __device__ bool next(int i, Unit& u) const {
        const long L = (long)i * G + c; if (L >= nwg) return false;
        int wgid = (int)L; { const int q = nwg / NXCD, r = nwg % NXCD, xcd = wgid % NXCD, off = wgid / NXCD; wgid = (xcd < r ? xcd * (q + 1) : r * (q + 1) + (xcd - r) * q) + off; }
        const int nig = WGM * nN, gid = wgid / nig, fm = gid * WGM, gsz = (nM - fm) < WGM ? (nM - fm) : WGM;
        u.pm = fm + ((wgid % nig) % gsz); u.pn = (wgid % nig) / gsz; return true;
    }
    __device__ __forceinline__ int rows(const Unit&) const { return BM; }
    __device__ __forceinline__ void a_ready(const Unit&) const {}
    __device__ __forceinline__ void done(const Unit&) const {}
};

__device__ __forceinline__ unsigned cvt_pk_bf16(float lo, float hi) { unsigned r; asm volatile("v_cvt_pk_bf16_f32 %0, %1, %2" : "=v"(r) : "v"(lo), "v"(hi)); return r; }
typedef float f32x2 __attribute__((ext_vector_type(2)));
__device__ __forceinline__ f32x2 gelu_pk(f32x2 v) {
    const f32x2 av = __builtin_elementwise_abs(v), d = av * 0.2316418882f + 1.0f;
    f32x2 t; t.x = __builtin_amdgcn_rcpf(d.x); t.y = __builtin_amdgcn_rcpf(d.y);
    f32x2 q = t * 0.5307027145f + (-0.7265760135f); q = q * t + 0.7107068705f; q = q * t + (-0.142248368f); q = q * t + 0.127414796f; q = q * t;
    const f32x2 s = (v * v) * (-0.72134752044f);
    f32x2 e; e.x = __builtin_amdgcn_exp2f(s.x); e.y = __builtin_amdgcn_exp2f(s.y);
    const f32x2 m = v * (q * e), r = v - m;
    f32x2 o; o.x = v.x < 0.f ? m.x : r.x; o.y = v.y < 0.f ? m.y : r.y; return o;
}

template <int ACT  > struct EpiBf16 {
    static constexpr bool PERM = true, AFTER_DRAIN = false; static_assert(ACT == 0 || ACT == 1, "EpiBf16: ACT is 0 (none) or 1 (gelu_pk)");
    bf16_t* O; int ldc; const float* bias; int split_cols; size_t split_stride; float scale0;
    __device__ __forceinline__ void operator()(const f32x4 (&acc)[2][2][4][2], const Unit& u, int wr, int wc, int fr, int fq) const {
        const int row0 = u.pm * BM + wr * 64 + fr; int colt = u.pn * BM; bf16_t* base = O;
        float sc = 1.f; if (split_cols) { const int t = colt / split_cols; base += (size_t)t * split_stride; colt -= t * split_cols; if (t == 0) sc = scale0; }
        const int col0 = colt + wc * 32 + 8 * fq, bcol0 = u.pn * BM + wc * 32 + 8 * fq;
        f32x4 bv[2][2];
#pragma unroll
        for (int bj = 0; bj < 2; ++bj)
#pragma unroll
            for (int n = 0; n < 2; ++n) bv[bj][n] = bias ? *(const f32x4*)(bias + bcol0 + bj * HALF + 4 * n) : (f32x4){0.f, 0.f, 0.f, 0.f};
#pragma unroll
        for (int ai = 0; ai < 2; ++ai)
#pragma unroll
            for (int m = 0; m < 4; ++m) { bf16_t* rowp = base + (size_t)(row0 + ai * HALF + m * 16) * ldc + col0;
#pragma unroll
                for (int bj = 0; bj < 2; ++bj) { f32x4 v0 = acc[ai][bj][m][0] + bv[bj][0], v1 = acc[ai][bj][m][1] + bv[bj][1];
                    if (ACT == 1) { f32x2 a = gelu_pk((f32x2){v0[0], v0[1]}), b = gelu_pk((f32x2){v0[2], v0[3]}), c = gelu_pk((f32x2){v1[0], v1[1]}), d = gelu_pk((f32x2){v1[2], v1[3]});
                        v0 = (f32x4){a.x, a.y, b.x, b.y}; v1 = (f32x4){c.x, c.y, d.x, d.y}; }
                    v0 = v0 * sc; v1 = v1 * sc; u32x4 w; w.x = cvt_pk_bf16(v0[0], v0[1]); w.y = cvt_pk_bf16(v0[2], v0[3]); w.z = cvt_pk_bf16(v1[0], v1[1]); w.w = cvt_pk_bf16(v1[2], v1[3]);
                    *(u32x4*)(rowp + bj * HALF) = w; } }
    }
};

struct ConvNone { static constexpr bool ON = false; static constexpr int LDS_OFF = 0; };
template <class Epi, class Sched, bool ALIGN_EPI = false, bool SP2 = false, bool F8 = false, class CV = ConvNone>
__device__ __forceinline__ void gemm_phase(PG8_LAS unsigned char* lds, const Gemm g, const Sched& S, const Epi& E, const CV& cv = CV{}) {
    static_assert(!CV::ON || SP2, "the side job's vmcnt arithmetic is written for the SP2 schedule");
    const int tid = threadIdx.x, wid = __builtin_amdgcn_readfirstlane(tid >> 6), lane = tid & 63, wr = wid >> 2, wc = wid & 3, fr = lane & 15, fq = lane >> 4;
    const int K = g.K, nt = K / BK;
    unsigned voffA[2], voffB[2];
#pragma unroll
    for (int i = 0; i < 2; ++i) { int R, C; stage_rc(tid * 16 + i * 8192, R, C); const int Rb = Epi::PERM ? ((R & ~31) + perm32(R & 31)) : R;
        voffA[i] = (unsigned)(R * K + C) * 2u; voffB[i] = (unsigned)(Rb * K + C) * 2u; }
    const size_t kstep = (size_t)(BK * 2);
    const size_t hstep = (size_t)HALF * K * 2;
    const size_t tstep = 2 * hstep;
    const unsigned ldsw = (unsigned)wid * 1024u;
    const int aoff = lds_byte(wr * 64 + fr, fq * 8), boff = lds_byte(wc * 32 + fr, fq * 8);
#define PG8_CAT8(x, y) __builtin_bit_cast(v8i_t, __builtin_shufflevector((x), (y), 0, 1, 2, 3, 4, 5, 6, 7, 8, 9, 10, 11, 12, 13, 14, 15))
#define PG8_SA(b, h) (((b) * 2 + (h)) * HTB)
#define PG8_SB(b, h) ((4 + (b) * 2 + (h)) * HTB)
#define PG8_STAGE(bufoff, gbase, voff) do { _Pragma("unroll") for (int _i = 0; _i < 2; ++_i) \
        __builtin_amdgcn_global_load_lds((const unsigned*)((const char*)(gbase) + (voff)[_i]), (PG8_LAS unsigned*)(lds + (bufoff) + ldsw + _i * 8192), 16, 0, 0); } while (0)
#define PG8_LDA(dst, b, h) do { if constexpr (F8) { _Pragma("unroll") for (int m = 0; m < 4; ++m) dst##8[m] = PG8_CAT8(*(const PG8_LAS bf16x8*)(lds + PG8_SA(b, h) + aoff + m * 2048), *(const PG8_LAS bf16x8*)(lds + PG8_SA(b, h) + aoff + m * 2048 + 1024)); } else _Pragma("unroll") for (int m = 0; m < 4; ++m) _Pragma("unroll") for (int k = 0; k < 2; ++k) dst[m][k] = *(const PG8_LAS bf16x8*)(lds + PG8_SA(b, h) + aoff + m * 2048 + k * 1024); } while (0)
#define PG8_LDB(dst, b, h) do { if constexpr (F8) { _Pragma("unroll") for (int n = 0; n < 2; ++n) dst##8[n] = PG8_CAT8(*(const PG8_LAS bf16x8*)(lds + PG8_SB(b, h) + boff + n * 2048), *(const PG8_LAS bf16x8*)(lds + PG8_SB(b, h) + boff + n * 2048 + 1024)); } else _Pragma("unroll") for (int n = 0; n < 2; ++n) _Pragma("unroll") for (int k = 0; k < 2; ++k) dst[n][k] = *(const PG8_LAS bf16x8*)(lds + PG8_SB(b, h) + boff + n * 2048 + k * 1024); } while (0)
#define PG8_MMA(ai, bj, At, Bt) do { __builtin_amdgcn_s_setprio(1); \
        if constexpr (F8) { _Pragma("unroll") for (int m = 0; m < 4; ++m) _Pragma("unroll") for (int n = 0; n < 2; ++n) \
            asm volatile("v_mfma_f32_16x16x128_f8f6f4 %0, %1, %2, %0" : "+v"(acc[ai][bj][m][n]) : "v"(Bt##8[n]), "v"(At##8[m])); }     \
        else { _Pragma("unroll") for (int m = 0; m < 4; ++m) _Pragma("unroll") for (int n = 0; n < 2; ++n) _Pragma("unroll") for (int k = 0; k < 2; ++k) \
            acc[ai][bj][m][n] = __builtin_amdgcn_mfma_f32_16x16x32_bf16(Bt[n][k], At[m][k], acc[ai][bj][m][n], 0, 0, 0); } \
        __builtin_amdgcn_s_setprio(0); } while (0)
#define PG8_WAIT_V(n) asm volatile("s_waitcnt vmcnt(" #n ")" ::: "memory")
#define PG8_WAIT_L(n) asm volatile("s_waitcnt lgkmcnt(" #n ")" ::: "memory")
#define PG8_BAR __builtin_amdgcn_s_barrier()
#define PG8_SCHED __builtin_amdgcn_sched_barrier(0)
    Unit cur, nxt; int ui = 0;
    if (!S.next(0, cur)) return;
    bool skip1 = S.rows(cur) <= HALF;
    f32x4 acc[2][2][4][2];
#pragma unroll
    for (int a = 0; a < 2; ++a)
#pragma unroll
        for (int b = 0; b < 2; ++b)
#pragma unroll
            for (int m = 0; m < 4; ++m)
#pragma unroll
                for (int n = 0; n < 2; ++n) acc[a][b][m][n] = (f32x4){0.f, 0.f, 0.f, 0.f};
    bf16x8 At[4][2], B0[2][2], B1[2][2];
    v8i_t At8[4], B08[2], B18[2];
    const char* cA = (const char*)g.A + (size_t)cur.pm * tstep; const char* cB = (const char*)g.Bt + (size_t)cur.pn * tstep;
    S.a_ready(cur);
    typedef float cvf2 __attribute__((ext_vector_type(2))); typedef unsigned cvu2 __attribute__((ext_vector_type(2)));
    cvu2 cvo0 = {0u, 0u}, cvo1 = {0u, 0u};
    const char* cv_sb = nullptr; unsigned cv_sv = 0, cv_db = 0, cv_dv = 0, cv_stb = 0, cv_stv = 0; int cv_dn = 0, cv_stdn = 0;
    unsigned char* cv_ws = nullptr; unsigned cv_slot = 0;
    PG8_LAS unsigned char* const cv_lds = lds + CV::LDS_OFF + wid * 3072;
    if constexpr (CV::ON) { cv.decode(cur, wid, lane, cv_sb, cv_dn, cv_db, cv_dv, cv_sv); cv_ws = cv.wsbase(); cv_stb = CV::DUMMY_OFF; cv_stdn = 0; cv_stv = (unsigned)tid * 16u; }
#define CV_LD(slot) do { if constexpr (CV::ON) { \
        __builtin_amdgcn_global_load_lds((const unsigned*)(cv_sb + (size_t)((2 * slot) * (cv_dn ? 8192u : 4096u)) + cv_sv), (PG8_LAS unsigned*)(cv_lds + cv_slot), 16, 0, 0); \
        cv_slot = cv_slot == 2048u ? 0u : cv_slot + 1024u; } } while (0)
#define CV_CVT(slot, dw, hi) do { if constexpr (CV::ON) { \
        const cvf2 ra_ = *(const PG8_LAS cvf2*)(cv_lds + cv_slot + lane * 8), rb_ = *(const PG8_LAS cvf2*)(cv_lds + cv_slot + 512 + lane * 8); \
        cvo0[dw] = (unsigned)__builtin_amdgcn_cvt_pk_fp8_f32(ra_.x * CV::SCALE, rb_.x * CV::SCALE, (int)cvo0[dw], hi); \
        cvo1[dw] = (unsigned)__builtin_amdgcn_cvt_pk_fp8_f32(ra_.y * CV::SCALE, rb_.y * CV::SCALE, (int)cvo1[dw], hi); } } while (0)
#define CV_ST() do { if constexpr (CV::ON) { unsigned char* p_ = cv_ws + cv_stb; *(__attribute__((address_space(1))) cvu2*)(p_ + cv_stv) = cvo0; *(__attribute__((address_space(1))) cvu2*)(p_ + (cv_stdn ? 1024u : 2048u) + cv_stv) = cvo1; } } while (0)
    if constexpr (SP2) {
        PG8_STAGE(PG8_SB(0, 0), cB, voffB); PG8_STAGE(PG8_SB(0, 1), cB + hstep, voffB); PG8_STAGE(PG8_SA(0, 0), cA, voffA); PG8_STAGE(PG8_SA(0, 1), cA + hstep, voffA);
        if (wr == 1) PG8_BAR;
        PG8_WAIT_V(2); PG8_BAR;
        PG8_STAGE(PG8_SB(1, 0), cB + kstep, voffB); PG8_STAGE(PG8_SA(1, 0), cA + kstep, voffA); PG8_STAGE(PG8_SB(1, 1), cB + hstep + kstep, voffB);
        PG8_WAIT_V(6); PG8_BAR;
    } else {
        PG8_STAGE(PG8_SB(0, 0), cB, voffB); PG8_STAGE(PG8_SA(0, 0), cA, voffA); PG8_STAGE(PG8_SB(0, 1), cB + hstep, voffB); PG8_STAGE(PG8_SA(0, 1), cA + hstep, voffA);
        if (wr == 1) PG8_BAR;
        PG8_WAIT_V(4); PG8_BAR;
        PG8_STAGE(PG8_SB(1, 0), cB + kstep, voffB); PG8_STAGE(PG8_SA(1, 0), cA + kstep, voffA); PG8_STAGE(PG8_SB(1, 1), cB + hstep + kstep, voffB);
        PG8_WAIT_V(6); PG8_BAR;
    }
    for (;;) {
        const bool has_next = S.next(ui + 1, nxt);
        const char* nA = has_next ? (const char*)g.A + (size_t)nxt.pm * tstep : cA; const char* nB = has_next ? (const char*)g.Bt + (size_t)nxt.pn * tstep : cB;
#pragma clang loop unroll(disable)
        for (int t = 0; t < nt; t += 2) {
            const bool last = (t == nt - 2);
            const char* a1 = cA + (size_t)(t + 1) * kstep;
            const char* a2 = last ? nA : cA + (size_t)(t + 2) * kstep; const char* b2 = last ? nB : cB + (size_t)(t + 2) * kstep;
            const char* a3 = a2 + kstep; const char* b3 = b2 + kstep;
            if (last && has_next) S.a_ready(nxt);
            if constexpr (SP2) {
            PG8_LDB(B0, 0, 0); PG8_LDB(B1, 0, 1); PG8_SCHED; PG8_LDA(At, 0, 0); PG8_STAGE(PG8_SA(1, 1), a1 + hstep, voffA); CV_LD(0);
            if constexpr (CV::ON) PG8_WAIT_V(10); else PG8_WAIT_V(8);
            PG8_WAIT_L(0); PG8_BAR; PG8_MMA(0, 0, At, B0); PG8_MMA(0, 1, At, B1); CV_CVT(2, 1, false); PG8_BAR; PG8_SCHED;
            PG8_LDA(At, 0, 1); PG8_STAGE(PG8_SB(0, 0), b2, voffB); PG8_STAGE(PG8_SB(0, 1), b2 + hstep, voffB); PG8_STAGE(PG8_SA(0, 0), a2, voffA); CV_LD(1);
            if constexpr (CV::ON) PG8_WAIT_V(10); else PG8_WAIT_V(8);
            PG8_WAIT_L(0); PG8_BAR; if (!skip1) { PG8_MMA(1, 0, At, B0); PG8_MMA(1, 1, At, B1); } CV_CVT(3, 1, true); PG8_BAR; PG8_SCHED;
            CV_ST(); if constexpr (CV::ON) { cv_stb = cv_db + 4 * t; cv_stdn = cv_dn; cv_stv = cv_dv; }
            PG8_LDB(B0, 1, 0); PG8_LDB(B1, 1, 1); PG8_SCHED; PG8_LDA(At, 1, 0); PG8_STAGE(PG8_SA(0, 1), a2 + hstep, voffA); CV_LD(2);
            if constexpr (CV::ON) PG8_WAIT_V(12); else PG8_WAIT_V(8);
            PG8_WAIT_L(0); PG8_BAR; PG8_MMA(0, 0, At, B0); PG8_MMA(0, 1, At, B1); CV_CVT(0, 0, false); PG8_BAR; PG8_SCHED;
            PG8_LDA(At, 1, 1); PG8_STAGE(PG8_SB(1, 0), b3, voffB); PG8_STAGE(PG8_SB(1, 1), b3 + hstep, voffB); PG8_STAGE(PG8_SA(1, 0), a3, voffA); CV_LD(3);
            if constexpr (CV::ON) PG8_WAIT_V(12); else PG8_WAIT_V(8);
            PG8_WAIT_L(0); PG8_BAR; if (!skip1) { PG8_MMA(1, 0, At, B0); PG8_MMA(1, 1, At, B1); } CV_CVT(1, 0, true); PG8_BAR; PG8_SCHED;
            if constexpr (CV::ON) cv_sb += cv_dn ? 65536 : 32768;
            } else {
            PG8_LDB(B0, 0, 0); PG8_SCHED; PG8_LDA(At, 0, 0); PG8_STAGE(PG8_SA(1, 1), a1 + hstep, voffA);
            PG8_WAIT_L(8); PG8_BAR; PG8_WAIT_L(0); PG8_MMA(0, 0, At, B0); PG8_BAR; PG8_SCHED;
            PG8_LDB(B1, 0, 1); PG8_STAGE(PG8_SB(0, 0), b2, voffB);
            PG8_BAR; PG8_WAIT_L(0); PG8_MMA(0, 1, At, B1); PG8_BAR;
            PG8_LDA(At, 0, 1); PG8_STAGE(PG8_SA(0, 0), a2, voffA);
            PG8_BAR; PG8_WAIT_L(0); PG8_MMA(1, 0, At, B0); PG8_BAR; PG8_SCHED;
            PG8_STAGE(PG8_SB(0, 1), b2 + hstep, voffB);
            PG8_WAIT_V(6); PG8_BAR; PG8_MMA(1, 1, At, B1); PG8_BAR;
            PG8_LDB(B0, 1, 0); PG8_SCHED; PG8_LDA(At, 1, 0); PG8_STAGE(PG8_SA(0, 1), a2 + hstep, voffA);
            PG8_WAIT_L(8); PG8_BAR; PG8_WAIT_L(0); PG8_MMA(0, 0, At, B0); PG8_BAR; PG8_SCHED;
            PG8_LDB(B1, 1, 1); PG8_STAGE(PG8_SB(1, 0), b3, voffB);
            PG8_BAR; PG8_WAIT_L(0); PG8_MMA(0, 1, At, B1); PG8_BAR;
            PG8_LDA(At, 1, 1); PG8_STAGE(PG8_SA(1, 0), a3, voffA);
            PG8_BAR; PG8_WAIT_L(0); PG8_MMA(1, 0, At, B0); PG8_BAR; PG8_SCHED;
            PG8_STAGE(PG8_SB(1, 1), b3 + hstep, voffB);
            PG8_WAIT_V(6); PG8_BAR; PG8_MMA(1, 1, At, B1); PG8_BAR;
            }
        }
        if constexpr (F8) asm volatile("s_nop 15\n\ts_nop 7" ::: "memory");
        if constexpr (ALIGN_EPI) { if (wr == 0) PG8_BAR; }
        if constexpr (!Epi::AFTER_DRAIN) { int fr_ = fr, fq_ = fq; asm volatile("" : "+v"(fr_), "+v"(fq_));
            E(acc, cur, wr, wc, fr_, fq_); S.done(cur); }
        if (!has_next) break;
#pragma unroll
        for (int a = 0; a < 2; ++a)
#pragma unroll
            for (int b = 0; b < 2; ++b)
#pragma unroll
                for (int m = 0; m < 4; ++m)
#pragma unroll
                    for (int n = 0; n < 2; ++n) acc[a][b][m][n] = (f32x4){0.f, 0.f, 0.f, 0.f};
        cur = nxt; cA = nA; cB = nB; ++ui; skip1 = S.rows(cur) <= HALF;
        if constexpr (CV::ON) cv.decode(cur, wid, lane, cv_sb, cv_dn, cv_db, cv_dv, cv_sv);
        if constexpr (ALIGN_EPI) { if (wr == 1) PG8_BAR; }
    }
    PG8_WAIT_V(0);
    if constexpr (CV::ON) { cv_slot = cv_slot == 2048u ? 0u : cv_slot + 1024u; CV_CVT(2, 1, false); cv_slot = cv_slot == 2048u ? 0u : cv_slot + 1024u; CV_CVT(3, 1, true); CV_ST(); }
    if constexpr (!ALIGN_EPI) { if (wr == 0) PG8_BAR; }
    PG8_BAR;
    if constexpr (Epi::AFTER_DRAIN) { E.fused(acc, cur, wr, wc, fr, fq, lds, wid, lane); S.done(cur); }
#undef PG8_SA
#undef PG8_SB
#undef PG8_STAGE
#undef PG8_LDA
#undef PG8_LDB
#undef PG8_MMA
#undef PG8_CAT8
#undef PG8_WAIT_V
#undef PG8_WAIT_L
#undef PG8_BAR
#undef PG8_SCHED
#undef CV_LD
#undef CV_CVT
#undef CV_ST
}
}

namespace pg8 {
__device__ __forceinline__ void store16_wt(void* p, u32x4 v) { asm volatile("global_store_dwordx4 %0, %1, off sc1\n\ts_nop 1" :: "v"(p), "v"(v) : "memory"); }
__device__ __forceinline__ float clamp_f8(float v) { return __builtin_fminf(__builtin_fmaxf(v, -448.f), 448.f); }
__device__ __forceinline__ unsigned cvt4_fp8(float a, float b, float c, float d) { int w = 0; w = __builtin_amdgcn_cvt_pk_fp8_f32(a, b, w, false); w = __builtin_amdgcn_cvt_pk_fp8_f32(c, d, w, true); return (unsigned)w; }
__device__ __forceinline__ unsigned cvt4_fp8c(float a, float b, float c, float d) { return cvt4_fp8(clamp_f8(a), clamp_f8(b), clamp_f8(c), clamp_f8(d)); }
struct EpiInProj {
    static constexpr bool PERM = true, AFTER_DRAIN = false;
    bf16_t* O; int ldc; float* DT;
    __device__ __forceinline__ void operator()(const f32x4 (&acc)[2][2][4][2], const Unit& u, int wr, int wc, int fr, int fq) const {
        const int row0 = u.pm * BM + wr * 64 + fr;
        if (u.pn == 22) {
            if (wc == 0 && fq < 2) {
#pragma unroll
                for (int ai = 0; ai < 2; ++ai)
#pragma unroll
                    for (int m = 0; m < 4; ++m) { float* dp = DT + (size_t)(row0 + ai * HALF + m * 16) * 16 + 8 * fq; *(f32x4*)dp = acc[ai][0][m][0]; *(f32x4*)(dp + 4) = acc[ai][0][m][1]; } }
            return; }
        const int col0 = u.pn * BM + wc * 32 + 8 * fq;
#pragma unroll
        for (int ai = 0; ai < 2; ++ai)
#pragma unroll
            for (int m = 0; m < 4; ++m) { bf16_t* rowp = O + (size_t)(row0 + ai * HALF + m * 16) * ldc + col0;
#pragma unroll
                for (int bj = 0; bj < 2; ++bj) { const f32x4 v0 = acc[ai][bj][m][0], v1 = acc[ai][bj][m][1];
                    u32x4 w; w.x = cvt_pk_bf16(v0[0], v0[1]); w.y = cvt_pk_bf16(v0[2], v0[3]); w.z = cvt_pk_bf16(v1[0], v1[1]); w.w = cvt_pk_bf16(v1[2], v1[3]);
                    *(u32x4*)(rowp + bj * HALF) = w; } }
    }
};
struct EpiResid {
    static constexpr bool PERM = true, AFTER_DRAIN = false;
    const float* base; bf16_t* hb; unsigned char* h8; int ldc; const float* cs;
    __device__ __forceinline__ void operator()(const f32x4 (&acc)[2][2][4][2], const Unit& u, int wr, int wc, int fr, int fq) const {
        const int row0 = u.pm * BM + wr * 64 + fr, col0 = u.pn * BM + wc * 32 + 8 * fq;
        typedef unsigned u32x2_t __attribute__((ext_vector_type(2)));
        f32x4 csv[2][2];
#pragma unroll
        for (int bj = 0; bj < 2; ++bj) { csv[bj][0] = *(const f32x4*)(cs + col0 + bj * HALF); csv[bj][1] = *(const f32x4*)(cs + col0 + bj * HALF + 4); }
#pragma unroll
        for (int ai = 0; ai < 2; ++ai) {
            f32x4 xr[4][2][2];
#pragma unroll
            for (int m = 0; m < 4; ++m) { const size_t off = (size_t)(row0 + ai * HALF + m * 16) * ldc + col0;
#pragma unroll
                for (int bj = 0; bj < 2; ++bj) { xr[m][bj][0] = __builtin_nontemporal_load((const f32x4*)(base + off + bj * HALF)); xr[m][bj][1] = __builtin_nontemporal_load((const f32x4*)(base + off + bj * HALF + 4)); } }
#pragma unroll
            for (int m = 0; m < 4; ++m) { const size_t off = (size_t)(row0 + ai * HALF + m * 16) * ldc + col0;
#pragma unroll
                for (int bj = 0; bj < 2; ++bj) {
                    const f32x4 v0 = acc[ai][bj][m][0] + xr[m][bj][0], v1 = acc[ai][bj][m][1] + xr[m][bj][1];
                    u32x4 w; w.x = cvt_pk_bf16(v0[0], v0[1]); w.y = cvt_pk_bf16(v0[2], v0[3]); w.z = cvt_pk_bf16(v1[0], v1[1]); w.w = cvt_pk_bf16(v1[2], v1[3]);
                    *(u32x4*)(hb + off + bj * HALF) = w;
                    const f32x4 s0 = v0 * csv[bj][0], s1 = v1 * csv[bj][1];
                    u32x2_t q; q.x = cvt4_fp8c(s0[0], s0[1], s0[2], s0[3]); q.y = cvt4_fp8c(s1[0], s1[1], s1[2], s1[3]);
                    *(u32x2_t*)(h8 + off + bj * HALF) = q; } }
        }
    }
};
struct ExpertScale {
    const PG8_LAS int* tab; const float* lst; int lcap;
    __device__ __forceinline__ int rows(const Unit& u) const { const int e = u.pn >> 3; return tab[80 + e] - (u.pm - tab[40 + e]) * BM; }
    __device__ __forceinline__ float at(const Unit& u, int rowlocal) const { const int e = u.pn >> 3, p = (u.pm - tab[40 + e]) * BM + rowlocal; return p < tab[80 + e] ? lst[(size_t)e * lcap + p] : 0.f; }
};
struct EpiGateUp {
    static constexpr bool PERM = true, AFTER_DRAIN = false;
    unsigned char* O; int ldc; ExpertScale rs; float wsc;
    __device__ __forceinline__ void operator()(const f32x4 (&acc)[2][2][4][2], const Unit& u, int wr, int wc, int fr, int fq) const {
        const int rl0 = wr * 64 + fr, col0 = (u.pn & 7) * HALF + wc * 32 + 8 * fq;
        float rsc[2][4];
#pragma unroll
        for (int ai = 0; ai < 2; ++ai)
#pragma unroll
            for (int m = 0; m < 4; ++m) rsc[ai][m] = rs.at(u, rl0 + ai * HALF + m * 16) * wsc;
        const bool half_only = rs.rows(u) <= HALF;
#pragma unroll
        for (int ai = 0; ai < 2; ++ai) { if (ai == 1 && half_only) continue;
#pragma unroll
            for (int m = 0; m < 4; ++m) { const int rl = rl0 + ai * HALF + m * 16; const float r = rsc[ai][m];
                float hv[8];
#pragma unroll
                for (int n = 0; n < 2; ++n)
#pragma unroll
                    for (int j = 0; j < 4; ++j) { const float g = acc[ai][0][m][n][j] * r, up = acc[ai][1][m][n][j] * r; hv[n * 4 + j] = g * __builtin_amdgcn_rcpf(1.f + __builtin_amdgcn_exp2f(-1.44269504089f * g)) * up; }
                typedef unsigned u32x2_t __attribute__((ext_vector_type(2))); u32x2_t q; q.x = cvt4_fp8c(hv[0], hv[1], hv[2], hv[3]); q.y = cvt4_fp8c(hv[4], hv[5], hv[6], hv[7]);
                *(u32x2_t*)(O + (size_t)(u.pm * BM + rl) * ldc + col0) = q; } }
    }
};
struct EpiRowScale {
    static constexpr bool PERM = true, AFTER_DRAIN = false;
    unsigned char* O; int ldc; ExpertScale rs; float wsc;
    __device__ __forceinline__ void operator()(const f32x4 (&acc)[2][2][4][2], const Unit& u, int wr, int wc, int fr, int fq) const {
        const int rl0 = wr * 64 + fr, col0 = (u.pn & 7) * BM + wc * 64 + 16 * fq;
        float rsc[2][4];
#pragma unroll
        for (int ai = 0; ai < 2; ++ai)
#pragma unroll
            for (int m = 0; m < 4; ++m) rsc[ai][m] = rs.at(u, rl0 + ai * HALF + m * 16) * wsc;
        const bool half_only = rs.rows(u) <= HALF;
#pragma unroll
        for (int ai = 0; ai < 2; ++ai) { if (ai == 1 && half_only) continue;
#pragma unroll
            for (int m = 0; m < 4; ++m) { const int rl = rl0 + ai * HALF + m * 16; const float r = rsc[ai][m];
                const f32x4 v0 = acc[ai][0][m][0] * r, v1 = acc[ai][0][m][1] * r, v2 = acc[ai][1][m][0] * r, v3 = acc[ai][1][m][1] * r;
                u32x4 q; q.x = cvt4_fp8c(v0[0], v0[1], v0[2], v0[3]); q.y = cvt4_fp8c(v1[0], v1[1], v1[2], v1[3]); q.z = cvt4_fp8c(v2[0], v2[1], v2[2], v2[3]); q.w = cvt4_fp8c(v3[0], v3[1], v3[2], v3[3]);
                *(u32x4*)(O + (size_t)(u.pm * BM + rl) * ldc + col0) = q; } }
    }
};
struct ExpertOrder {
    const PG8_LAS int* tab; int nwg, G, c;
    __device__ __forceinline__ void init(const PG8_LAS int* t, int G_, int c_) { tab = t; nwg = t[32]; G = G_; c = c_; }
    __device__ __forceinline__ bool next(int i, Unit& u) const {
        const long L = (long)i * G + c; if (L >= nwg) return false;
        int wgid = (int)L; { const int q = nwg / NXCD, r = nwg % NXCD, xcd = wgid % NXCD, off = wgid / NXCD; wgid = (xcd < r ? xcd * (q + 1) : r * (q + 1) + (xcd - r) * q) + off; }
        const int tj = tab[threadIdx.x & 31];
        const int e = __builtin_popcountll(__ballot(wgid >= tj) & 0xffffffffull) - 1;
        const int local_i = wgid - tab[e], mt = (tab[e + 1] - tab[e]) >> 3;
        u.pm = tab[40 + e] + local_i % mt; u.pn = e * 8 + local_i / mt; return true;
    }
    __device__ __forceinline__ int rows(const Unit& u) const { const int e = u.pn >> 3; return tab[80 + e] - (u.pm - tab[40 + e]) * BM; }
    __device__ __forceinline__ void a_ready(const Unit&) const {}
    __device__ __forceinline__ void done(const Unit&) const {}
};
struct TeamOrder {
    int c, i0, i1;
    __device__ __forceinline__ bool next(int i, Unit& u) const {
        i += i0; if (i >= i1) return false;
        const int xcd = c & 7, l = c >> 3; if (i * 32 + l >= 184) return false;
        int pmo, pn;
        if (i < 5) { const int t = l >> 3, j = l & 7; pmo = 4 * (t & 1) + (j & 3); pn = 4 * i + 2 * (t >> 1) + (j >> 2); }
        else { pmo = l & 7; pn = 20 + (l >> 3); }
        u.pm = 8 * xcd + pmo; u.pn = pn; return true;
    }
    __device__ __forceinline__ int rows(const Unit&) const { return BM; }
    __device__ __forceinline__ void a_ready(const Unit&) const {}
    __device__ __forceinline__ void done(const Unit&) const {}
};
template <class KArgs, int IN_GATE, size_t WGU_OFF, size_t WD_OFF, size_t DUMMY, int LDSOFF> struct ConvMoE {
    static constexpr bool ON = true; static constexpr float SCALE = 64.f;
    static constexpr unsigned DUMMY_OFF = (unsigned)DUMMY; static constexpr int LDS_OFF = LDSOFF; static constexpr int nN = 23;
    static_assert(WD_OFF + 64u * 1024 * 1024 < (1ull << 32) && DUMMY < (1ull << 32), "32-bit workspace offsets");
    __device__ __forceinline__ unsigned char* wsbase() const { const KArgs a = (KArgs)__builtin_amdgcn_kernarg_segment_ptr(); return a->ws; }
    __device__ __forceinline__ void decode(const Unit& u, int wid, int lane, const char*& sb, int& dn, unsigned& db, unsigned& dv, unsigned& sv) const {
        const KArgs a = (KArgs)__builtin_amdgcn_kernarg_segment_ptr();
        const int cb = (u.pm * nN + u.pn) * 8 + wid, nl = 2 * lane;
        if (cb < 8192) { const int up = cb >> 12, r = cb & 4095, e = r >> 7, kb = (r >> 3) & 15, nb = r & 7;
            sb = (const char*)((const float*)a->in[IN_GATE + up] + (size_t)e * 2048 * 1024 + (size_t)(128 * kb) * 1024 + 128 * nb); dn = 0;
            db = (unsigned)(WGU_OFF + (size_t)e * 2048 * 2048 + (size_t)(nb * 256 + up * 128) * 2048 + 128 * kb); dv = (unsigned)nl * 2048u; sv = (unsigned)(lane >> 5) * 4096u + (unsigned)(lane & 31) * 16u; }
        else { const int r = cb - 8192, e = r >> 7, kb = (r >> 4) & 7, nb = r & 15;
            sb = (const char*)((const float*)a->in[IN_GATE + 2] + (size_t)e * 1024 * 2048 + (size_t)(128 * kb) * 2048 + 128 * nb); dn = 1;
            db = (unsigned)(WD_OFF + (size_t)e * 2048 * 1024 + (size_t)(256 * (nb >> 1)) * 1024 + 128 * kb);
            dv = (unsigned)(((nl >> 3) & 1) * 128 + (2 * (nb & 1) + (nl >> 6)) * 32 + ((nl >> 4) & 3) * 8 + (nl & 7)) * 1024u; sv = (unsigned)(lane >> 5) * 8192u + (unsigned)(lane & 31) * 16u; }
    }
};
}

namespace pg8 {
template <class Epi, class Sched, class RowSrc, bool ALIGN_EPI = false, bool SP2 = false, bool F8 = false>
__device__ __forceinline__ void gemm_phase_g(PG8_LAS unsigned char* lds, const Gemm g, const Sched& S, const Epi& E, const RowSrc& RS) {
    const int tid = threadIdx.x, wid = __builtin_amdgcn_readfirstlane(tid >> 6), lane = tid & 63, wr = wid >> 2, wc = wid & 3, fr = lane & 15, fq = lane >> 4;
    const int K = g.K, nt = K / BK;
    unsigned voffB[2]; unsigned vC0[2], vC1[2], vN0[2], vN1[2]; int Rr[2], Cc[2];
#pragma unroll
    for (int i = 0; i < 2; ++i) { int R, C; stage_rc(tid * 16 + i * 8192, R, C); const int Rb = Epi::PERM ? ((R & ~31) + perm32(R & 31)) : R;
        Rr[i] = R; Cc[i] = C; voffB[i] = (unsigned)(Rb * K + C) * 2u; }
    const size_t kstep = (size_t)(BK * 2);
    const size_t hstep = (size_t)HALF * K * 2;
    const size_t tstep = 2 * hstep;
    const unsigned ldsw = (unsigned)wid * 1024u;
    const int aoff = lds_byte(wr * 64 + fr, fq * 8), boff = lds_byte(wc * 32 + fr, fq * 8);
#define PG8_CAT8(x, y) __builtin_bit_cast(v8i_t, __builtin_shufflevector((x), (y), 0, 1, 2, 3, 4, 5, 6, 7, 8, 9, 10, 11, 12, 13, 14, 15))
#define PG8_SA(b, h) (((b) * 2 + (h)) * HTB)
#define PG8_SB(b, h) ((4 + (b) * 2 + (h)) * HTB)
#define PG8_STAGE(bufoff, gbase, voff) do { _Pragma("unroll") for (int _i = 0; _i < 2; ++_i) \
        __builtin_amdgcn_global_load_lds((const unsigned*)((const char*)(gbase) + (voff)[_i]), (PG8_LAS unsigned*)(lds + (bufoff) + ldsw + _i * 8192), 16, 0, 0); } while (0)
#define PG8_LDA(dst, b, h) do { if constexpr (F8) { _Pragma("unroll") for (int m = 0; m < 4; ++m) dst##8[m] = PG8_CAT8(*(const PG8_LAS bf16x8*)(lds + PG8_SA(b, h) + aoff + m * 2048), *(const PG8_LAS bf16x8*)(lds + PG8_SA(b, h) + aoff + m * 2048 + 1024)); } else _Pragma("unroll") for (int m = 0; m < 4; ++m) _Pragma("unroll") for (int k = 0; k < 2; ++k) dst[m][k] = *(const PG8_LAS bf16x8*)(lds + PG8_SA(b, h) + aoff + m * 2048 + k * 1024); } while (0)
#define PG8_LDB(dst, b, h) do { if constexpr (F8) { _Pragma("unroll") for (int n = 0; n < 2; ++n) dst##8[n] = PG8_CAT8(*(const PG8_LAS bf16x8*)(lds + PG8_SB(b, h) + boff + n * 2048), *(const PG8_LAS bf16x8*)(lds + PG8_SB(b, h) + boff + n * 2048 + 1024)); } else _Pragma("unroll") for (int n = 0; n < 2; ++n) _Pragma("unroll") for (int k = 0; k < 2; ++k) dst[n][k] = *(const PG8_LAS bf16x8*)(lds + PG8_SB(b, h) + boff + n * 2048 + k * 1024); } while (0)
#define PG8_MMA(ai, bj, At, Bt) do { __builtin_amdgcn_s_setprio(1); \
        if constexpr (F8) { _Pragma("unroll") for (int m = 0; m < 4; ++m) _Pragma("unroll") for (int n = 0; n < 2; ++n) \
            asm volatile("v_mfma_f32_16x16x128_f8f6f4 %0, %1, %2, %0" : "+v"(acc[ai][bj][m][n]) : "v"(Bt##8[n]), "v"(At##8[m])); }     \
        else { _Pragma("unroll") for (int m = 0; m < 4; ++m) _Pragma("unroll") for (int n = 0; n < 2; ++n) _Pragma("unroll") for (int k = 0; k < 2; ++k) \
            acc[ai][bj][m][n] = __builtin_amdgcn_mfma_f32_16x16x32_bf16(Bt[n][k], At[m][k], acc[ai][bj][m][n], 0, 0, 0); } \
        __builtin_amdgcn_s_setprio(0); } while (0)
#define PG8_WAIT_V(n) asm volatile("s_waitcnt vmcnt(" #n ")" ::: "memory")
#define PG8_WAIT_L(n) asm volatile("s_waitcnt lgkmcnt(" #n ")" ::: "memory")
#define PG8_BAR __builtin_amdgcn_s_barrier()
#define PG8_SCHED __builtin_amdgcn_sched_barrier(0)
    Unit cur, nxt; int ui = 0;
    if (!S.next(0, cur)) return;
    bool skip1 = S.rows(cur) <= HALF;
    f32x4 acc[2][2][4][2];
#pragma unroll
    for (int a = 0; a < 2; ++a)
#pragma unroll
        for (int b = 0; b < 2; ++b)
#pragma unroll
            for (int m = 0; m < 4; ++m)
#pragma unroll
                for (int n = 0; n < 2; ++n) acc[a][b][m][n] = (f32x4){0.f, 0.f, 0.f, 0.f};
    bf16x8 At[4][2], B0[2][2], B1[2][2];
    v8i_t At8[4], B08[2], B18[2];
    const char* cA = (const char*)g.A; const char* cB = (const char*)g.Bt + (size_t)cur.pn * tstep;
    RS.rows(cur, Rr, Cc, K, vC0, vC1);
    S.a_ready(cur);
    if constexpr (SP2) {
        PG8_STAGE(PG8_SB(0, 0), cB, voffB); PG8_STAGE(PG8_SB(0, 1), cB + hstep, voffB); PG8_STAGE(PG8_SA(0, 0), cA, vC0); PG8_STAGE(PG8_SA(0, 1), cA, vC1);
        if (wr == 1) PG8_BAR;
        PG8_WAIT_V(2); PG8_BAR;
        PG8_STAGE(PG8_SB(1, 0), cB + kstep, voffB); PG8_STAGE(PG8_SA(1, 0), cA + kstep, vC0); PG8_STAGE(PG8_SB(1, 1), cB + hstep + kstep, voffB);
        PG8_WAIT_V(6); PG8_BAR;
    } else {
        PG8_STAGE(PG8_SB(0, 0), cB, voffB); PG8_STAGE(PG8_SA(0, 0), cA, vC0); PG8_STAGE(PG8_SB(0, 1), cB + hstep, voffB); PG8_STAGE(PG8_SA(0, 1), cA, vC1);
        if (wr == 1) PG8_BAR;
        PG8_WAIT_V(4); PG8_BAR;
        PG8_STAGE(PG8_SB(1, 0), cB + kstep, voffB); PG8_STAGE(PG8_SA(1, 0), cA + kstep, vC0); PG8_STAGE(PG8_SB(1, 1), cB + hstep + kstep, voffB);
        PG8_WAIT_V(6); PG8_BAR;
    }
    for (;;) {
        const bool has_next = S.next(ui + 1, nxt);
        const char* nA = cA; const char* nB = has_next ? (const char*)g.Bt + (size_t)nxt.pn * tstep : cB;
        if (has_next) RS.rows(nxt, Rr, Cc, K, vN0, vN1); else { vN0[0] = vC0[0]; vN0[1] = vC0[1]; vN1[0] = vC1[0]; vN1[1] = vC1[1]; }
        for (int t = 0; t < nt; t += 2) {
            const bool last = (t == nt - 2);
            const char* a1 = cA + (size_t)(t + 1) * kstep;
            const char* a2 = last ? nA : cA + (size_t)(t + 2) * kstep; const char* b2 = last ? nB : cB + (size_t)(t + 2) * kstep;
            const char* a3 = a2 + kstep; const char* b3 = b2 + kstep;
            const unsigned v20[2] = {last ? vN0[0] : vC0[0], last ? vN0[1] : vC0[1]}, v21[2] = {last ? vN1[0] : vC1[0], last ? vN1[1] : vC1[1]};
            if (last && has_next) S.a_ready(nxt);
            if constexpr (SP2) {
            PG8_LDB(B0, 0, 0); PG8_LDB(B1, 0, 1); PG8_SCHED; PG8_LDA(At, 0, 0); PG8_STAGE(PG8_SA(1, 1), a1, vC1);
            PG8_WAIT_V(8); PG8_WAIT_L(0); PG8_BAR; PG8_MMA(0, 0, At, B0); PG8_MMA(0, 1, At, B1); PG8_BAR; PG8_SCHED;
            PG8_LDA(At, 0, 1); PG8_STAGE(PG8_SB(0, 0), b2, voffB); PG8_STAGE(PG8_SB(0, 1), b2 + hstep, voffB); PG8_STAGE(PG8_SA(0, 0), a2, v20);
            PG8_WAIT_V(8); PG8_WAIT_L(0); PG8_BAR; if (!skip1) { PG8_MMA(1, 0, At, B0); PG8_MMA(1, 1, At, B1); } PG8_BAR; PG8_SCHED;
            PG8_LDB(B0, 1, 0); PG8_LDB(B1, 1, 1); PG8_SCHED; PG8_LDA(At, 1, 0); PG8_STAGE(PG8_SA(0, 1), a2, v21);
            PG8_WAIT_V(8); PG8_WAIT_L(0); PG8_BAR; PG8_MMA(0, 0, At, B0); PG8_MMA(0, 1, At, B1); PG8_BAR; PG8_SCHED;
            PG8_LDA(At, 1, 1); PG8_STAGE(PG8_SB(1, 0), b3, voffB); PG8_STAGE(PG8_SB(1, 1), b3 + hstep, voffB); PG8_STAGE(PG8_SA(1, 0), a3, v20);
            PG8_WAIT_V(8); PG8_WAIT_L(0); PG8_BAR; if (!skip1) { PG8_MMA(1, 0, At, B0); PG8_MMA(1, 1, At, B1); } PG8_BAR; PG8_SCHED;
            } else {
            PG8_LDB(B0, 0, 0); PG8_SCHED; PG8_LDA(At, 0, 0); PG8_STAGE(PG8_SA(1, 1), a1, vC1);
            PG8_WAIT_L(8); PG8_BAR; PG8_WAIT_L(0); PG8_MMA(0, 0, At, B0); PG8_BAR; PG8_SCHED;
            PG8_LDB(B1, 0, 1); PG8_STAGE(PG8_SB(0, 0), b2, voffB);
            PG8_BAR; PG8_WAIT_L(0); PG8_MMA(0, 1, At, B1); PG8_BAR;
            PG8_LDA(At, 0, 1); PG8_STAGE(PG8_SA(0, 0), a2, v20);
            PG8_BAR; PG8_WAIT_L(0); PG8_MMA(1, 0, At, B0); PG8_BAR; PG8_SCHED;
            PG8_STAGE(PG8_SB(0, 1), b2 + hstep, voffB);
            PG8_WAIT_V(6); PG8_BAR; PG8_MMA(1, 1, At, B1); PG8_BAR;
            PG8_LDB(B0, 1, 0); PG8_SCHED; PG8_LDA(At, 1, 0); PG8_STAGE(PG8_SA(0, 1), a2, v21);
            PG8_WAIT_L(8); PG8_BAR; PG8_WAIT_L(0); PG8_MMA(0, 0, At, B0); PG8_BAR; PG8_SCHED;
            PG8_LDB(B1, 1, 1); PG8_STAGE(PG8_SB(1, 0), b3, voffB);
            PG8_BAR; PG8_WAIT_L(0); PG8_MMA(0, 1, At, B1); PG8_BAR;
            PG8_LDA(At, 1, 1); PG8_STAGE(PG8_SA(1, 0), a3, v20);
            PG8_BAR; PG8_WAIT_L(0); PG8_MMA(1, 0, At, B0); PG8_BAR; PG8_SCHED;
            PG8_STAGE(PG8_SB(1, 1), b3 + hstep, voffB);
            PG8_WAIT_V(6); PG8_BAR; PG8_MMA(1, 1, At, B1); PG8_BAR;
            }
        }
        if constexpr (F8) asm volatile("s_nop 15\n\ts_nop 7" ::: "memory");
        if constexpr (ALIGN_EPI) { if (wr == 0) PG8_BAR; }
        if constexpr (!Epi::AFTER_DRAIN) { E(acc, cur, wr, wc, fr, fq); S.done(cur); }
        if (!has_next) break;
#pragma unroll
        for (int a = 0; a < 2; ++a)
#pragma unroll
            for (int b = 0; b < 2; ++b)
#pragma unroll
                for (int m = 0; m < 4; ++m)
#pragma unroll
                    for (int n = 0; n < 2; ++n) acc[a][b][m][n] = (f32x4){0.f, 0.f, 0.f, 0.f};
        cur = nxt; cA = nA; cB = nB; ++ui; skip1 = S.rows(cur) <= HALF; vC0[0] = vN0[0]; vC0[1] = vN0[1]; vC1[0] = vN1[0]; vC1[1] = vN1[1];
        if constexpr (ALIGN_EPI) { if (wr == 1) PG8_BAR; }
    }
    PG8_WAIT_V(0);
    if constexpr (!ALIGN_EPI) { if (wr == 0) PG8_BAR; }
    PG8_BAR;
    if constexpr (Epi::AFTER_DRAIN) { E.fused(acc, cur, wr, wc, fr, fq, lds, wid, lane); S.done(cur); }
#undef PG8_SA
#undef PG8_SB
#undef PG8_STAGE
#undef PG8_LDA
#undef PG8_LDB
#undef PG8_MMA
#undef PG8_CAT8
#undef PG8_WAIT_V
#undef PG8_WAIT_L
#undef PG8_BAR
#undef PG8_SCHED
}

struct ExpertRows {
    const PG8_LAS int* tab; const int* lst_tok; int lcap;
    __device__ __forceinline__ void rows(const Unit& u, const int (&Rr)[2], const int (&Cc)[2], int K, unsigned (&v0)[2], unsigned (&v1)[2]) const {
        const int e = u.pn >> 3, mi = u.pm - tab[40 + e], cnt = tab[80 + e];
#pragma unroll
        for (int i = 0; i < 2; ++i) { const int p0 = mi * BM + Rr[i], p1 = p0 + HALF;
            const int t0 = p0 < cnt ? lst_tok[(size_t)e * lcap + p0] : 0, t1 = p1 < cnt ? lst_tok[(size_t)e * lcap + p1] : 0;
            v0[i] = (unsigned)(t0 * K + Cc[i]) * 2u; v1[i] = (unsigned)(t1 * K + Cc[i]) * 2u; }
    }
};
}

#ifndef PG8_SP2
#define PG8_SP2 true
#endif
#ifndef PG8_ALIGN
#define PG8_ALIGN true
#endif

namespace attn_body {
using bf16=__hip_bfloat16;
using bf16x8=__attribute__((ext_vector_type(8)))short;
using s16x4=__attribute__((ext_vector_type(4)))short;
using f32x16=__attribute__((ext_vector_type(16)))float;
using u32x4=__attribute__((ext_vector_type(4)))unsigned;
constexpr int SEQ=2048,D=64,QP=1024,KP=1024,VP=5632,OP=1024;
constexpr int NW=8,QBLK=32,QB=QBLK*NW,KVBLK=64,NQB=SEQ/QB;
constexpr int ATTN_UNIT_ROWS=QB;
__device__ __forceinline__ int crow(int r,int hi){return (r&3)+8*(r>>2)+4*hi;}
#define SBAR() __builtin_amdgcn_sched_barrier(0)
__device__ __forceinline__ void cmask(f32x16&p0,f32x16&p1,int jb,int qrel,int hi){
  const float NEG=-INFINITY; int kb=64*jb+4*hi;
  #pragma unroll
  for(int r=0;r<16;++r){int kv=kb+(r&3)+8*(r>>2); if(kv>qrel)p0[r]=NEG; if(kv+32>qrel)p1[r]=NEG;}
}

constexpr int NSLOT=3, SLOTB=8192;
constexpr int LDS_K=0, LDS_V=NSLOT*SLOTB, LDS_WS=2*NSLOT*SLOTB, LDS_OST=LDS_WS+NW*64*4, LDS_BYTES=LDS_OST+NW*4096;
constexpr float C2=0.125f*1.4426950408889634f;
__device__ __forceinline__ void glds16(const void*gsrc,unsigned lds_dst){unsigned keep;
  asm volatile("s_mov_b32 %0, m0\n\ts_mov_b32 m0, %2\n\ts_nop 0\n\tglobal_load_lds_dwordx4 %1, off\n\ts_mov_b32 m0, %0":"=&s"(keep):"v"(gsrc),"s"(lds_dst):"memory");}
__device__ __forceinline__ float max3f(float a,float b,float c){float r;asm("v_max3_f32 %0, %1, %2, %3":"=v"(r):"v"(a),"v"(b),"v"(c));return r;}
__device__ __forceinline__ float max2f(float a,float b){float r;asm("v_max_f32_e32 %0, %1, %2":"=v"(r):"v"(a),"v"(b));return r;}
__device__ __forceinline__ float fadd_s(float a,float b){float r;asm("v_add_f32_e32 %0, %1, %2":"=v"(r):"v"(a),"v"(b));return r;}
__device__ __forceinline__ float fsub_s(float a,float b){float r;asm("v_sub_f32_e32 %0, %1, %2":"=v"(r):"v"(a),"v"(b));return r;}
typedef float f32x2_t __attribute__((ext_vector_type(2))); typedef __bf16 bf16x2_t __attribute__((ext_vector_type(2)));
__device__ __forceinline__ unsigned cvtpk_s(float lo,float hi){f32x2_t v={lo,hi};bf16x2_t b=__builtin_convertvector(v,bf16x2_t);return __builtin_bit_cast(unsigned,b);}
#define WAIT_BAR(N) asm volatile("s_waitcnt vmcnt(" #N ") lgkmcnt(0)\n\ts_barrier":::"memory")

__device__ __forceinline__ void qkt(f32x16&p0,f32x16&p1,const char*Kslot,const bf16x8*qr,const f32x16&negm,int r32,int hi){
  const char*kb=Kslot+hi*1024+r32*16;
  #pragma unroll
  for(int d0=0;d0<4;++d0){
    const bf16x8 b0=*reinterpret_cast<const bf16x8*>(kb+d0*2048);
    const bf16x8 b1=*reinterpret_cast<const bf16x8*>(kb+d0*2048+512);
    if(d0==0){p0=__builtin_amdgcn_mfma_f32_32x32x16_bf16(b0,qr[0],negm,0,0,0);p1=__builtin_amdgcn_mfma_f32_32x32x16_bf16(b1,qr[0],negm,0,0,0);}
    else{p0=__builtin_amdgcn_mfma_f32_32x32x16_bf16(b0,qr[d0],p0,0,0,0);p1=__builtin_amdgcn_mfma_f32_32x32x16_bf16(b1,qr[d0],p1,0,0,0);}}
}
typedef __attribute__((address_space(3))) const char* lds_cptr;
typedef short v4i16_t __attribute__((ext_vector_type(4)));
__device__ __forceinline__ void kload8(bf16x8*kf,lds_cptr kp){
  kf[0]=*(const __attribute__((address_space(3))) bf16x8*)(kp);      kf[1]=*(const __attribute__((address_space(3))) bf16x8*)(kp+512);
  kf[2]=*(const __attribute__((address_space(3))) bf16x8*)(kp+2048); kf[3]=*(const __attribute__((address_space(3))) bf16x8*)(kp+2560);
  kf[4]=*(const __attribute__((address_space(3))) bf16x8*)(kp+4096); kf[5]=*(const __attribute__((address_space(3))) bf16x8*)(kp+4608);
  kf[6]=*(const __attribute__((address_space(3))) bf16x8*)(kp+6144); kf[7]=*(const __attribute__((address_space(3))) bf16x8*)(kp+6656);
}
__device__ __forceinline__ void kload2(bf16x8*kf,lds_cptr kp,int j){ kf[2*j]=*(const __attribute__((address_space(3))) bf16x8*)(kp+j*2048); kf[2*j+1]=*(const __attribute__((address_space(3))) bf16x8*)(kp+j*2048+512); }
__device__ __forceinline__ s16x4 vtr(lds_cptr p){ return __builtin_bit_cast(s16x4,__builtin_amdgcn_ds_read_tr16_b64_v4i16((__attribute__((address_space(3))) v4i16_t*)p)); }
__device__ __forceinline__ float rowmax(const f32x16&p0,const f32x16&p1){
  float a=max3f(p0[0],p0[1],p1[0]),b=max3f(p0[2],p0[3],p1[1]);a=max3f(a,p1[2],p1[3]);
  #pragma unroll
  for(int r=4;r<16;r+=4){a=max3f(a,p0[r],p0[r+1]);b=max3f(b,p0[r+2],p0[r+3]);a=max3f(a,p1[r],p1[r+1]);b=max3f(b,p1[r+2],p1[r+3]);}
  const float m=max2f(a,b);
  auto rr=__builtin_amdgcn_permlane32_swap(__float_as_uint(m),__float_as_uint(m),false,false);
  return max2f(__uint_as_float(rr[0]),__uint_as_float(rr[1]));
}
__device__ __forceinline__ void pv(f32x16*o,int vb,bf16x8 pa0,bf16x8 pa1,bf16x8 pa2,bf16x8 pa3){
  #pragma unroll
  for(int d0=0;d0<2;++d0){s16x4 lo[4],hi[4];
    #pragma unroll
    for(int ks=0;ks<4;++ks){
      asm volatile("ds_read_b64_tr_b16 %0,%1 offset:%c2":"=&v"(lo[ks]):"v"(vb),"i"(d0*4096+ks*1024):"memory");
      asm volatile("ds_read_b64_tr_b16 %0,%1 offset:%c2":"=&v"(hi[ks]):"v"(vb),"i"(d0*4096+ks*1024+512):"memory");}
    asm volatile("s_waitcnt lgkmcnt(0)":::"memory");SBAR();
    #define PK(k) (bf16x8){lo[k][0],lo[k][1],lo[k][2],lo[k][3],hi[k][0],hi[k][1],hi[k][2],hi[k][3]}
    o[d0]=__builtin_amdgcn_mfma_f32_32x32x16_bf16(pa0,PK(0),o[d0],0,0,0);
    o[d0]=__builtin_amdgcn_mfma_f32_32x32x16_bf16(pa1,PK(1),o[d0],0,0,0);
    o[d0]=__builtin_amdgcn_mfma_f32_32x32x16_bf16(pa2,PK(2),o[d0],0,0,0);
    o[d0]=__builtin_amdgcn_mfma_f32_32x32x16_bf16(pa3,PK(3),o[d0],0,0,0);
    #undef PK
  }
}

#ifndef ATTN_STORE16
#define ATTN_STORE16(p,v) (*(u32x4*)(p)=(v))
#endif
template<int THRL> __device__ __forceinline__ void attn_unit(int b,int h,int qb,const bf16*Q,const bf16*__restrict__ K,const bf16*__restrict__ V,bf16*O,char*shm){
  int tid_=threadIdx.x; asm volatile("" : "+v"(tid_));
  const int tid=tid_,lane=tid&63,r32=lane&31,hi=lane>>5; const int wid=__builtin_amdgcn_readfirstlane(tid>>6);
  const long rowbase=(long)b*SEQ; const int q0=qb*QB;
  const bf16*Qw=Q+(rowbase+q0+wid*QBLK)*QP+h*D;
  const bf16*Kh=K+rowbase*KP+h*D,*Vh=V+rowbase*VP+h*D;
  const unsigned lds0=(unsigned)(uintptr_t)shm;
  float*wsf=(float*)(shm+LDS_WS)+wid*64;
  const bf16*ksrc=Kh+(long)lane*KP+wid*8;
  const bf16*vsrc=Vh+(long)(16*(wid&3)+(lane>>2))*VP+(wid>>2)*32+(lane&3)*8;
  const unsigned kdst=lds0+LDS_K+wid*1024, vdst=lds0+LDS_V+wid*1024;
  #define DMA_K(t,slot) glds16(ksrc+(long)(t)*KVBLK*KP,(unsigned)__builtin_amdgcn_readfirstlane(kdst+(slot)))
  #define DMA_V(t,slot) glds16(vsrc+(long)(t)*KVBLK*VP,(unsigned)__builtin_amdgcn_readfirstlane(vdst+(slot)))
  const int vb0=(int)(lds0+LDS_V)+((lane>>4)&1)*32+(lane&3)*8+(4*hi+((lane&15)>>2))*64;
  const char*Kbase=shm+LDS_K; bf16x8 kf[8];
  const lds_cptr shm3=(lds_cptr)shm; const lds_cptr kp0=shm3+LDS_K+hi*1024+r32*16; const lds_cptr vp0=shm3+LDS_V+((lane>>4)&1)*32+(lane&3)*8+(4*hi+((lane&15)>>2))*64;
  const int NT=(q0+QB)/KVBLK;
  DMA_K(0,0);DMA_V(0,0);DMA_K(1,SLOTB);
  bf16x8 qr[4];
  #pragma unroll
  for(int d0=0;d0<4;++d0)qr[d0]=*reinterpret_cast<const bf16x8*>(&Qw[(long)r32*QP+d0*16+hi*8]);
  float mhat=0.f,l_reg=0.f;f32x16 o[2];o[0]=f32x16{};o[1]=f32x16{};f32x16 negm=f32x16{};asm volatile("":"+v"(negm));
  const int qrel=wid*QBLK+r32;
  #define CMASK(P0,P1,t) do{int jb_=(t)-(NT-4); if(jb_>=0)cmask(P0,P1,jb_,qrel,hi);}while(0)
  bool resc=false;
  #define START(P0,P1) do{ const float rm=rowmax(P0,P1); resc=false; \
    { const float dl=rm; mhat=fadd_s(mhat,dl); \
      _Pragma("unroll") for(int r=0;r<16;++r){P0[r]=fsub_s(P0[r],dl);P1[r]=fsub_s(P1[r],dl);} \
      _Pragma("unroll") for(int r=0;r<16;++r)negm[r]=-mhat; asm volatile("":"+v"(negm)); } \
    _Pragma("unroll") for(int r=0;r<16;++r)P0[r]=__builtin_amdgcn_exp2f(P0[r]); }while(0)
  #define RESC() do{ if(resc){ asm volatile("s_waitcnt lgkmcnt(0)":::"memory"); \
      _Pragma("unroll") for(int d_=0;d_<2;++d_) _Pragma("unroll") for(int r=0;r<16;++r)o[d_][r]*=wsf[crow(r,hi)]; } }while(0)
  f32x16 pA0,pA1,pB0,pB1;
  int sl_prev=0,sl_cur=0,sl_next=SLOTB;
  #define ROT() do{sl_prev=sl_cur;sl_cur=sl_next;sl_next=(sl_next==(NSLOT-1)*SLOTB)?0:sl_next+SLOTB;}while(0)
  DMA_K(2,2*SLOTB);
  WAIT_BAR(3);
  qkt(pA0,pA1,Kbase,qr,negm,r32,hi);asm volatile("s_nop 15\n\ts_nop 7":"+v"(pA0),"+v"(pA1));CMASK(pA0,pA1,0);
  START(pA0,pA1);
  _Pragma("unroll") for(int r=0;r<16;++r)pA1[r]=__builtin_amdgcn_exp2f(pA1[r]);
  WAIT_BAR(0);
  DMA_K(3,0);DMA_V(1,SLOTB);
  ROT();
  kload8(kf,kp0+sl_cur);
  WAIT_BAR(2);
  s16x4 vlo[8],vhi[8]; u32x4 pw0,pw1,pw2,pw3;
  #define PKW(P,B) cvtpk_s(P[B],P[B+1])
  #define PAF(k) __builtin_bit_cast(bf16x8,pw##k)
  #define VFR(i) (bf16x8){vlo[i][0],vlo[i][1],vlo[i][2],vlo[i][3],vhi[i][0],vhi[i][1],vhi[i][2],vhi[i][3]}
  #define PIN(x) asm volatile("":"+v"(x))
  #define MX3(a,b,c) __builtin_fmaxf(__builtin_fmaxf((a),(b)),(c))
  #define GAPA(MF,A0,A1,A2,A3,W0,W1,PW) do{ MF; sacc+=A0; sacc+=A1; sacc+=A2; sacc+=A3; PIN(sacc); W0; W1; PIN(PW); SBAR(); }while(0)
  #define EX(v) __builtin_amdgcn_exp2f(v)
  #define GAPB(MF,X,B) do{ MF; X[B]=EX(X[B]); X[B+1]=EX(X[B+1]); X[B+2]=EX(X[B+2]); X[B+3]=EX(X[B+3]); PIN(X); SBAR(); }while(0)
  #define VRD(i) do{ vlo[i]=vtr(vp_+(((i)>>2)*4096+((i)&3)*1024)); vhi[i]=vtr(vp_+(((i)>>2)*4096+((i)&3)*1024+512)); }while(0)
  #define KRD(G,j) do{ if(G){ kload2(kf,kp0+sl_next,j); SBAR(); } }while(0)
  #define STEP(C0,C1,P0,P1,t,GK,GV,GL) do{ SBAR(); \
    const lds_cptr vp_=vp0+sl_prev; \
    VRD(0); SBAR(); float sacc=(P0[0]+P0[1]); \
    GAPA(C0=__builtin_amdgcn_mfma_f32_32x32x16_bf16(kf[0],qr[0],negm,0,0,0), P0[2],P0[3],P0[4],P0[5],     pw0[0]=PKW(P0,0), pw0[1]=PKW(P0,2), pw0); \
    VRD(4); SBAR(); GAPA(C1=__builtin_amdgcn_mfma_f32_32x32x16_bf16(kf[1],qr[0],negm,0,0,0), P0[6],P0[7],P0[8],P0[9],     pw0[2]=PKW(P0,4), pw0[3]=PKW(P0,6), pw0); \
    VRD(1); SBAR(); GAPA(C0=__builtin_amdgcn_mfma_f32_32x32x16_bf16(kf[2],qr[1],C0,0,0,0),   P0[10],P0[11],P0[12],P0[13], pw1[0]=PKW(P0,8), pw1[1]=PKW(P0,10), pw1); \
    VRD(5); SBAR(); GAPA(C1=__builtin_amdgcn_mfma_f32_32x32x16_bf16(kf[3],qr[1],C1,0,0,0),   P0[14],P0[15],P1[0],P1[1],   pw1[2]=PKW(P0,12),pw1[3]=PKW(P0,14), pw1); \
    VRD(2); SBAR(); GAPA(C0=__builtin_amdgcn_mfma_f32_32x32x16_bf16(kf[4],qr[2],C0,0,0,0),   P1[2],P1[3],P1[4],P1[5],     pw2[0]=PKW(P1,0), pw2[1]=PKW(P1,2), pw2); \
    VRD(6); SBAR(); GAPA(C1=__builtin_amdgcn_mfma_f32_32x32x16_bf16(kf[5],qr[2],C1,0,0,0),   P1[6],P1[7],P1[8],P1[9],     pw2[2]=PKW(P1,4), pw2[3]=PKW(P1,6), pw2); \
    VRD(3); SBAR(); GAPA(C0=__builtin_amdgcn_mfma_f32_32x32x16_bf16(kf[6],qr[3],C0,0,0,0),   P1[10],P1[11],P1[12],P1[13], pw3[0]=PKW(P1,8), pw3[1]=PKW(P1,10), pw3); \
    VRD(7); SBAR(); GAPA(C1=__builtin_amdgcn_mfma_f32_32x32x16_bf16(kf[7],qr[3],C1,0,0,0),   P1[14],P1[15],0.f,0.f,       pw3[2]=PKW(P1,12),pw3[3]=PKW(P1,14), pw3); \
    l_reg+=sacc; \
    if(GK){DMA_K((t)+3,sl_cur);} if(GV){DMA_V((t)+1,sl_next);} \
    CMASK(C0,C1,t); \
    { float a=MX3(C0[0],C0[1],C1[0]),b=MX3(C0[2],C0[3],C1[1]); a=MX3(a,C1[2],C1[3]); \
      _Pragma("unroll") for(int r=4;r<16;r+=4){a=MX3(a,C0[r],C0[r+1]);b=MX3(b,C0[r+2],C0[r+3]);a=MX3(a,C1[r],C1[r+1]);b=MX3(b,C1[r+2],C1[r+3]);} \
      float rm=__builtin_fmaxf(a,b); { auto rr=__builtin_amdgcn_permlane32_swap(__float_as_uint(rm),__float_as_uint(rm),false,false); rm=__builtin_fmaxf(__uint_as_float(rr[0]),__uint_as_float(rr[1])); } \
      resc=false; \
      if(__builtin_expect(__any(rm>(float)THRL),0)){ const float dl=__builtin_fmaxf(rm,0.f); mhat+=dl; \
        _Pragma("unroll") for(int r=0;r<16;++r){C0[r]-=dl;C1[r]-=dl;} \
        _Pragma("unroll") for(int r=0;r<16;++r)negm[r]=-mhat; asm volatile("":"+v"(negm)); \
        const float f=__builtin_amdgcn_exp2f(-dl); l_reg*=f; if(hi==0)wsf[r32]=f; resc=true; } } \
    SBAR(); \
    GAPB(o[0]=__builtin_amdgcn_mfma_f32_32x32x16_bf16(PAF(0),VFR(0),o[0],0,0,0), C0,0); \
    GAPB(o[1]=__builtin_amdgcn_mfma_f32_32x32x16_bf16(PAF(0),VFR(4),o[1],0,0,0), C0,4); \
    KRD(GL,0); GAPB(o[0]=__builtin_amdgcn_mfma_f32_32x32x16_bf16(PAF(1),VFR(1),o[0],0,0,0), C0,8); \
    KRD(GL,1); GAPB(o[1]=__builtin_amdgcn_mfma_f32_32x32x16_bf16(PAF(1),VFR(5),o[1],0,0,0), C0,12); \
    KRD(GL,2); GAPB(o[0]=__builtin_amdgcn_mfma_f32_32x32x16_bf16(PAF(2),VFR(2),o[0],0,0,0), C1,0); \
    KRD(GL,3); GAPB(o[1]=__builtin_amdgcn_mfma_f32_32x32x16_bf16(PAF(2),VFR(6),o[1],0,0,0), C1,4); \
    GAPB(o[0]=__builtin_amdgcn_mfma_f32_32x32x16_bf16(PAF(3),VFR(3),o[0],0,0,0), C1,8); \
    GAPB(o[1]=__builtin_amdgcn_mfma_f32_32x32x16_bf16(PAF(3),VFR(7),o[1],0,0,0), C1,12); \
    }while(0)
  int t=1;
  #undef CMASK
  #define CMASK(P0,P1,t) do{}while(0)
  for(;t+5<NT;t+=2){
    STEP(pB0,pB1,pA0,pA1,t,true,true,true);     WAIT_BAR(2); RESC(); ROT();
    STEP(pA0,pA1,pB0,pB1,t+1,true,true,true);   WAIT_BAR(2); RESC(); ROT();
  }
  #undef CMASK
  #define CMASK(P0,P1,t) do{int jb_=(t)-(NT-4); if(jb_>=0)cmask(P0,P1,jb_,qrel,hi);}while(0)
  #define ENDW(tt) do{ if((tt)+3<NT){WAIT_BAR(2);} else if((tt)+2<NT){WAIT_BAR(1);} else {WAIT_BAR(0);} }while(0)
  for(;t+1<NT;t+=2){
    STEP(pB0,pB1,pA0,pA1,t,(t+3<NT),(t+1<NT),(t+1<NT));       ENDW(t);   RESC(); ROT();
    STEP(pA0,pA1,pB0,pB1,t+1,(t+4<NT),(t+2<NT),(t+2<NT));     ENDW(t+1); RESC(); ROT();
  }
  STEP(pB0,pB1,pA0,pA1,NT-1,false,false,false); RESC();
  { float sacc=pB0[0]+pB0[1]; _Pragma("unroll") for(int r=2;r<16;++r)sacc+=pB0[r]; _Pragma("unroll") for(int r=0;r<16;++r)sacc+=pB1[r]; l_reg+=sacc;
    pw0=(u32x4){PKW(pB0,0),PKW(pB0,2),PKW(pB0,4),PKW(pB0,6)};pw1=(u32x4){PKW(pB0,8),PKW(pB0,10),PKW(pB0,12),PKW(pB0,14)};pw2=(u32x4){PKW(pB1,0),PKW(pB1,2),PKW(pB1,4),PKW(pB1,6)};pw3=(u32x4){PKW(pB1,8),PKW(pB1,10),PKW(pB1,12),PKW(pB1,14)};
    SBAR(); pv(o,vb0+sl_cur,PAF(0),PAF(1),PAF(2),PAF(3)); }
  #undef PKW
  #undef PAF
  #undef VFR
  #undef PIN
  #undef MX3
  #undef GAPA
  #undef GAPB
  #undef EX
  #undef VRD
  #undef KRD
  #undef STEP
  #undef ENDW
  {auto rr=__builtin_amdgcn_permlane32_swap(__float_as_uint(l_reg),__float_as_uint(l_reg),false,false);l_reg=__uint_as_float(rr[0])+__uint_as_float(rr[1]);}
  if(hi==0)wsf[32+r32]=l_reg;asm volatile("s_waitcnt lgkmcnt(0)":::"memory");
  float rli[16];
  #pragma unroll
  for(int r=0;r<16;++r)rli[r]=__builtin_amdgcn_rcpf(wsf[32+crow(r,hi)]);
  bf16*Ow=O+(rowbase+q0+wid*QBLK)*OP+h*D;
  { bf16*stg=(bf16*)(shm+LDS_OST)+wid*2048;
    #pragma unroll
    for(int r=0;r<16;++r){const int orow=crow(r,hi);
      #pragma unroll
      for(int d0=0;d0<2;++d0)stg[orow*64+d0*32+r32]=__float2bfloat16(o[d0][r]*rli[r]);}
    asm volatile("s_waitcnt lgkmcnt(0)":::"memory");
    #pragma unroll
    for(int i=0;i<4;++i){const int row=i*8+(lane>>3),ch=lane&7; const u32x4 v=*(const u32x4*)(stg+row*64+ch*8); ATTN_STORE16(Ow+(long)row*OP+ch*8,v);} }
  asm volatile("s_waitcnt lgkmcnt(0)\n\ts_barrier":::"memory");
  #undef DMA_K
  #undef DMA_V
  #undef CMASK
  #undef START
  #undef RESC
  #undef ROT
}
constexpr int ATTN_LDS_BYTES=LDS_BYTES;
#undef SBAR
#undef WAIT_BAR
}

namespace attn3 {
using namespace attn_body;
constexpr int DV=128,KSL=8192,VSL=16384;
constexpr int L_K=0,L_V=NSLOT*KSL,L_WS=L_V+NSLOT*VSL,L_OST=L_WS+NW*64*4,L_BYTES=L_OST+NW*8192;
#define SBAR() __builtin_amdgcn_sched_barrier(0)
#define WAIT_BAR(N) asm volatile("s_waitcnt vmcnt(" #N ") lgkmcnt(0)\n\ts_barrier":::"memory")
__device__ __forceinline__ void qkt0(f32x16&p0,f32x16&p1,const char*Kslot,const bf16x8*qr,int r32,int hi){
  const char*kb=Kslot+hi*1024+r32*16;
  #pragma unroll
  for(int d0=0;d0<4;++d0){
    const bf16x8 b0=*reinterpret_cast<const bf16x8*>(kb+d0*2048);
    const bf16x8 b1=*reinterpret_cast<const bf16x8*>(kb+d0*2048+512);
    if(d0==0){p0=__builtin_amdgcn_mfma_f32_32x32x16_bf16(b0,qr[0],f32x16{},0,0,0);p1=__builtin_amdgcn_mfma_f32_32x32x16_bf16(b1,qr[0],f32x16{},0,0,0);}
    else{p0=__builtin_amdgcn_mfma_f32_32x32x16_bf16(b0,qr[d0],p0,0,0,0);p1=__builtin_amdgcn_mfma_f32_32x32x16_bf16(b1,qr[d0],p1,0,0,0);}}
}
__device__ __forceinline__ void pv4(f32x16*o,int vb,bf16x8 pa0,bf16x8 pa1,bf16x8 pa2,bf16x8 pa3){
  #pragma unroll
  for(int d0=0;d0<4;++d0){s16x4 lo[4],hi[4];
    #pragma unroll
    for(int ks=0;ks<4;++ks){
      asm volatile("ds_read_b64_tr_b16 %0,%1 offset:%c2":"=&v"(lo[ks]):"v"(vb),"i"(d0*4096+ks*1024):"memory");
      asm volatile("ds_read_b64_tr_b16 %0,%1 offset:%c2":"=&v"(hi[ks]):"v"(vb),"i"(d0*4096+ks*1024+512):"memory");}
    asm volatile("s_waitcnt lgkmcnt(0)":::"memory");SBAR();
    #define PK(k) (bf16x8){lo[k][0],lo[k][1],lo[k][2],lo[k][3],hi[k][0],hi[k][1],hi[k][2],hi[k][3]}
    o[d0]=__builtin_amdgcn_mfma_f32_32x32x16_bf16(pa0,PK(0),o[d0],0,0,0);
    o[d0]=__builtin_amdgcn_mfma_f32_32x32x16_bf16(pa1,PK(1),o[d0],0,0,0);
    o[d0]=__builtin_amdgcn_mfma_f32_32x32x16_bf16(pa2,PK(2),o[d0],0,0,0);
    o[d0]=__builtin_amdgcn_mfma_f32_32x32x16_bf16(pa3,PK(3),o[d0],0,0,0);
    #undef PK
  }
}
template<int THRL,int OPF> __device__ __forceinline__ void attn_unit128(int b,int qb,const bf16*Q,const bf16*__restrict__ K,const bf16*__restrict__ V,bf16*O,char*shm,int fin,float lam,const float*sw){
  int tid_=threadIdx.x; asm volatile("" : "+v"(tid_));
  const int tid=tid_,lane=tid&63,r32=lane&31,hi=lane>>5; const int wid=__builtin_amdgcn_readfirstlane(tid>>6);
  const long rowbase=(long)b*SEQ; const int q0=qb*QB;
  const bf16*Qw=Q+(rowbase+q0+wid*QBLK)*QP;
  const bf16*Kh=K+rowbase*KP,*Vh=V+rowbase*VP;
  const unsigned lds0=(unsigned)(uintptr_t)shm;
  float*wsf=(float*)(shm+L_WS)+wid*64;
  const bf16*ksrc=Kh+(long)lane*KP+wid*8;
  const bf16*vsrc=Vh+(long)(16*(wid&3)+(lane>>2))*VP+(wid>>2)*32+(lane&3)*8;
  const unsigned kdst=lds0+L_K+wid*1024, vdst=lds0+L_V+wid*1024;
  #define DMA_K(t,slot) glds16(ksrc+(long)(t)*KVBLK*KP,(unsigned)__builtin_amdgcn_readfirstlane(kdst+(slot)))
  #define DMA_V(t,slot) do{ glds16(vsrc+(long)(t)*KVBLK*VP,(unsigned)__builtin_amdgcn_readfirstlane(vdst+2*(slot))); glds16(vsrc+(long)(t)*KVBLK*VP+64,(unsigned)__builtin_amdgcn_readfirstlane(vdst+2*(slot)+8192)); }while(0)
  const int vb0=(int)(lds0+L_V)+((lane>>4)&1)*32+(lane&3)*8+(4*hi+((lane&15)>>2))*64;
  const char*Kbase=shm+L_K; bf16x8 kf[8];
  const lds_cptr shm3=(lds_cptr)shm; const lds_cptr kp0=shm3+L_K+hi*1024+r32*16; const lds_cptr vp0=shm3+L_V+((lane>>4)&1)*32+(lane&3)*8+(4*hi+((lane&15)>>2))*64;
  const int NT=(q0+QB)/KVBLK;
  DMA_K(0,0);DMA_V(0,0);DMA_K(1,KSL);
  bf16x8 qr[4];
  #pragma unroll
  for(int d0=0;d0<4;++d0)qr[d0]=*reinterpret_cast<const bf16x8*>(&Qw[(long)r32*QP+d0*16+hi*8]);
  float mhat=0.f,l_reg=0.f;f32x16 o[4];o[0]=f32x16{};o[1]=f32x16{};o[2]=f32x16{};o[3]=f32x16{};
  const int qrel=wid*QBLK+r32;
  #define CMASK(P0,P1,t) do{int jb_=(t)-(NT-4); if(jb_>=0)cmask(P0,P1,jb_,qrel,hi);}while(0)
  bool resc=false;
  #define START(P0,P1) do{ const float rm=rowmax(P0,P1); resc=false; \
    { const float dl=rm; mhat=fadd_s(mhat,dl); \
      _Pragma("unroll") for(int r=0;r<16;++r){P0[r]=fsub_s(P0[r],dl);P1[r]=fsub_s(P1[r],dl);} } \
    _Pragma("unroll") for(int r=0;r<16;++r)P0[r]=__builtin_amdgcn_exp2f(P0[r]); }while(0)
  #define RESC() do{ if(resc){ asm volatile("s_waitcnt lgkmcnt(0)":::"memory"); \
      _Pragma("unroll") for(int d_=0;d_<4;++d_) _Pragma("unroll") for(int r=0;r<16;++r)o[d_][r]*=wsf[crow(r,hi)]; } }while(0)
  f32x16 pA0,pA1,pB0,pB1;
  int sl_prev=0,sl_cur=0,sl_next=KSL;
  #define ROT() do{sl_prev=sl_cur;sl_cur=sl_next;sl_next=(sl_next==(NSLOT-1)*KSL)?0:sl_next+KSL;}while(0)
  DMA_K(2,2*KSL);
  WAIT_BAR(4);
  qkt0(pA0,pA1,Kbase,qr,r32,hi);asm volatile("s_nop 15\n\ts_nop 7":"+v"(pA0),"+v"(pA1));CMASK(pA0,pA1,0);
  START(pA0,pA1);
  _Pragma("unroll") for(int r=0;r<16;++r)pA1[r]=__builtin_amdgcn_exp2f(pA1[r]);
  WAIT_BAR(0);
  DMA_K(3,0);DMA_V(1,KSL);
  ROT();
  kload8(kf,kp0+sl_cur);
  WAIT_BAR(3);
  s16x4 vlo[4],vhi[4]; u32x4 pw0,pw1,pw2,pw3;
  #define PKW(P,B) cvtpk_s(P[B],P[B+1])
  #define PAF(k) __builtin_bit_cast(bf16x8,pw##k)
  #define VFR(i) (bf16x8){vlo[i][0],vlo[i][1],vlo[i][2],vlo[i][3],vhi[i][0],vhi[i][1],vhi[i][2],vhi[i][3]}
  #define PIN(x) asm volatile("":"+v"(x))
  #define MX3(a,b,c) __builtin_fmaxf(__builtin_fmaxf((a),(b)),(c))
  #define GAPA(MF,A0,A1,A2,A3,W0,W1,PW) do{ MF; sacc+=A0; sacc+=A1; sacc+=A2; sacc+=A3; PIN(sacc); W0; W1; PIN(PW); SBAR(); }while(0)
  #define EX(v) __builtin_amdgcn_exp2f((v)-mhat)
  #define VRD(j) do{ vlo[(j)&3]=vtr(vp_+(((j)&3)*4096+((j)>>2)*1024)); vhi[(j)&3]=vtr(vp_+(((j)&3)*4096+((j)>>2)*1024+512)); }while(0)
  #define GAPB(j,PA,X,B) do{ o[(j)&3]=__builtin_amdgcn_mfma_f32_32x32x16_bf16(PA,VFR((j)&3),o[(j)&3],0,0,0); if((j)+4<16){VRD((j)+4);} X[B]=EX(X[B]); X[B+1]=EX(X[B+1]); PIN(X); SBAR(); }while(0)
  #define KRD(G,j) do{ if(G){ kload2(kf,kp0+sl_next,j); SBAR(); } }while(0)
  #define STEP(C0,C1,P0,P1,t,GK,GV,GL) do{ SBAR(); \
    const lds_cptr vp_=vp0+2*sl_prev; \
    float sacc=(P0[0]+P0[1]); \
    GAPA(C0=__builtin_amdgcn_mfma_f32_32x32x16_bf16(kf[0],qr[0],f32x16{},0,0,0), P0[2],P0[3],P0[4],P0[5],     pw0[0]=PKW(P0,0), pw0[1]=PKW(P0,2), pw0); \
    GAPA(C1=__builtin_amdgcn_mfma_f32_32x32x16_bf16(kf[1],qr[0],f32x16{},0,0,0), P0[6],P0[7],P0[8],P0[9],     pw0[2]=PKW(P0,4), pw0[3]=PKW(P0,6), pw0); \
    GAPA(C0=__builtin_amdgcn_mfma_f32_32x32x16_bf16(kf[2],qr[1],C0,0,0,0),   P0[10],P0[11],P0[12],P0[13], pw1[0]=PKW(P0,8), pw1[1]=PKW(P0,10), pw1); \
    GAPA(C1=__builtin_amdgcn_mfma_f32_32x32x16_bf16(kf[3],qr[1],C1,0,0,0),   P0[14],P0[15],P1[0],P1[1],   pw1[2]=PKW(P0,12),pw1[3]=PKW(P0,14), pw1); \
    VRD(0); SBAR(); GAPA(C0=__builtin_amdgcn_mfma_f32_32x32x16_bf16(kf[4],qr[2],C0,0,0,0),   P1[2],P1[3],P1[4],P1[5],     pw2[0]=PKW(P1,0), pw2[1]=PKW(P1,2), pw2); \
    VRD(1); SBAR(); GAPA(C1=__builtin_amdgcn_mfma_f32_32x32x16_bf16(kf[5],qr[2],C1,0,0,0),   P1[6],P1[7],P1[8],P1[9],     pw2[2]=PKW(P1,4), pw2[3]=PKW(P1,6), pw2); \
    VRD(2); SBAR(); GAPA(C0=__builtin_amdgcn_mfma_f32_32x32x16_bf16(kf[6],qr[3],C0,0,0,0),   P1[10],P1[11],P1[12],P1[13], pw3[0]=PKW(P1,8), pw3[1]=PKW(P1,10), pw3); \
    VRD(3); SBAR(); GAPA(C1=__builtin_amdgcn_mfma_f32_32x32x16_bf16(kf[7],qr[3],C1,0,0,0),   P1[14],P1[15],0.f,0.f,       pw3[2]=PKW(P1,12),pw3[3]=PKW(P1,14), pw3); \
    l_reg+=sacc; \
    if(GK){DMA_K((t)+3,sl_cur);} if(GV){DMA_V((t)+1,sl_next);} \
    CMASK(C0,C1,t); \
    { float a=MX3(C0[0],C0[1],C1[0]),b=MX3(C0[2],C0[3],C1[1]); a=MX3(a,C1[2],C1[3]); \
      _Pragma("unroll") for(int r=4;r<16;r+=4){a=MX3(a,C0[r],C0[r+1]);b=MX3(b,C0[r+2],C0[r+3]);a=MX3(a,C1[r],C1[r+1]);b=MX3(b,C1[r+2],C1[r+3]);} \
      float rm=__builtin_fmaxf(a,b); { auto rr=__builtin_amdgcn_permlane32_swap(__float_as_uint(rm),__float_as_uint(rm),false,false); rm=__builtin_fmaxf(__uint_as_float(rr[0]),__uint_as_float(rr[1])); } \
      rm-=mhat; \
      resc=false; \
      if(__builtin_expect(__any(rm>(float)THRL),0)){ const float dl=__builtin_fmaxf(rm,0.f); mhat+=dl; \
        const float f=__builtin_amdgcn_exp2f(-dl); l_reg*=f; if(hi==0)wsf[r32]=f; resc=true; } } \
    SBAR(); \
    GAPB(0,PAF(0),C0,0); GAPB(1,PAF(0),C0,2); GAPB(2,PAF(0),C0,4); GAPB(3,PAF(0),C0,6); \
    KRD(GL,0); GAPB(4,PAF(1),C0,8); GAPB(5,PAF(1),C0,10); KRD(GL,1); GAPB(6,PAF(1),C0,12); GAPB(7,PAF(1),C0,14); \
    KRD(GL,2); GAPB(8,PAF(2),C1,0); GAPB(9,PAF(2),C1,2); KRD(GL,3); GAPB(10,PAF(2),C1,4); GAPB(11,PAF(2),C1,6); \
    GAPB(12,PAF(3),C1,8); GAPB(13,PAF(3),C1,10); GAPB(14,PAF(3),C1,12); GAPB(15,PAF(3),C1,14); \
    }while(0)
  int t=1;
  #undef CMASK
  #define CMASK(P0,P1,t) do{}while(0)
  for(;t+5<NT;t+=2){
    STEP(pB0,pB1,pA0,pA1,t,true,true,true);     WAIT_BAR(3); RESC(); ROT();
    STEP(pA0,pA1,pB0,pB1,t+1,true,true,true);   WAIT_BAR(3); RESC(); ROT();
  }
  #undef CMASK
  #define CMASK(P0,P1,t) do{int jb_=(t)-(NT-4); if(jb_>=0)cmask(P0,P1,jb_,qrel,hi);}while(0)
  #define ENDW(tt) do{ if((tt)+3<NT){WAIT_BAR(3);} else if((tt)+2<NT){WAIT_BAR(2);} else {WAIT_BAR(0);} }while(0)
  for(;t+1<NT;t+=2){
    STEP(pB0,pB1,pA0,pA1,t,(t+3<NT),(t+1<NT),(t+1<NT));       ENDW(t);   RESC(); ROT();
    STEP(pA0,pA1,pB0,pB1,t+1,(t+4<NT),(t+2<NT),(t+2<NT));     ENDW(t+1); RESC(); ROT();
  }
  STEP(pB0,pB1,pA0,pA1,NT-1,false,false,false); RESC();
  { float sacc=pB0[0]+pB0[1]; _Pragma("unroll") for(int r=2;r<16;++r)sacc+=pB0[r]; _Pragma("unroll") for(int r=0;r<16;++r)sacc+=pB1[r]; l_reg+=sacc;
    pw0=(u32x4){PKW(pB0,0),PKW(pB0,2),PKW(pB0,4),PKW(pB0,6)};pw1=(u32x4){PKW(pB0,8),PKW(pB0,10),PKW(pB0,12),PKW(pB0,14)};pw2=(u32x4){PKW(pB1,0),PKW(pB1,2),PKW(pB1,4),PKW(pB1,6)};pw3=(u32x4){PKW(pB1,8),PKW(pB1,10),PKW(pB1,12),PKW(pB1,14)};
    SBAR(); pv4(o,vb0+2*sl_cur,PAF(0),PAF(1),PAF(2),PAF(3)); }
  #undef PKW
  #undef PAF
  #undef VFR
  #undef PIN
  #undef MX3
  #undef GAPA
  #undef GAPB
  #undef EX
  #undef VRD
  #undef KRD
  #undef STEP
  #undef ENDW
  {auto rr=__builtin_amdgcn_permlane32_swap(__float_as_uint(l_reg),__float_as_uint(l_reg),false,false);l_reg=__uint_as_float(rr[0])+__uint_as_float(rr[1]);}
  if(hi==0)wsf[32+r32]=l_reg;asm volatile("s_waitcnt lgkmcnt(0)":::"memory");
  float rli[16];
  #pragma unroll
  for(int r=0;r<16;++r)rli[r]=__builtin_amdgcn_rcpf(wsf[32+crow(r,hi)]);
  bf16*Ow=O+(rowbase+q0+wid*QBLK)*OPF;
  { bf16*stg=(bf16*)(shm+L_OST)+wid*4096;
    if(!fin){
      #pragma unroll
      for(int r=0;r<16;++r){const int orow=crow(r,hi);
        #pragma unroll
        for(int d0=0;d0<4;++d0)stg[orow*128+d0*32+r32]=__float2bfloat16(o[d0][r]*rli[r]);}
    } else {
      float wv[4];
      #pragma unroll
      for(int d0=0;d0<4;++d0)wv[d0]=sw[d0*32+r32];
      #pragma unroll
      for(int r=0;r<16;++r){const int orow=crow(r,hi); float ss=0.f;
        #pragma unroll
        for(int d0=0;d0<4;++d0){const float y=__bfloat162float(stg[orow*128+d0*32+r32])-lam*(o[d0][r]*rli[r]); o[d0][r]=y; ss+=y*y;}
        ss+=__shfl_xor(ss,1);ss+=__shfl_xor(ss,2);ss+=__shfl_xor(ss,4);ss+=__shfl_xor(ss,8);ss+=__shfl_xor(ss,16);
        const float rn=1.0f/sqrtf(ss*(1.f/128.f)+1e-6f);
        #pragma unroll
        for(int d0=0;d0<4;++d0)stg[orow*128+d0*32+r32]=__float2bfloat16(o[d0][r]*rn*wv[d0]);}
      asm volatile("s_waitcnt lgkmcnt(0)":::"memory");
      #pragma unroll
      for(int i=0;i<8;++i){const int row=i*4+(lane>>4),ch=lane&15; const u32x4 v=*(const u32x4*)(stg+row*128+ch*8); ATTN_STORE16(Ow+(long)row*OPF+ch*8,v);}
    } }
  asm volatile("s_waitcnt lgkmcnt(0)\n\ts_barrier":::"memory");
  #undef DMA_K
  #undef DMA_V
  #undef CMASK
  #undef START
  #undef RESC
  #undef ROT
}
#undef SBAR
#undef WAIT_BAR
}

#define GAS __attribute__((address_space(1)))
#define LAS __attribute__((address_space(3)))
typedef unsigned short bf16;
typedef unsigned v4u __attribute__((ext_vector_type(4)));
typedef unsigned v2u __attribute__((ext_vector_type(2)));
typedef float f32x4 __attribute__((ext_vector_type(4)));
typedef short bf16x8 __attribute__((ext_vector_type(8)));
typedef GAS unsigned gu32;
#define RLX_AGENT __ATOMIC_RELAXED, __HIP_MEMORY_SCOPE_AGENT
#define LDS_WAIT() asm volatile("s_waitcnt lgkmcnt(0)" ::: "memory")
#define VM_WAIT() asm volatile("s_waitcnt vmcnt(0)" ::: "memory")

#ifndef P1_HOSTS_P0B
#define P1_HOSTS_P0B 1
#endif
constexpr int NWAVES = 8;
constexpr int DM = 2048, NBATCH = 8, SEQ = 2048, M = NBATCH * SEQ;
constexpr int IN_COLS = 5648;
constexpr int NIN = 5632;
constexpr int NIN_G = 5888;
constexpr int UC_Z = 0, UC_XBC = 1024, UC_Q = 2560, UC_K = 3584, UC_V = 4608;
constexpr int NE = 32, EH = 1024;
constexpr float EPS = 1e-6f;
constexpr float F8_WSCALE = 64.f;
constexpr float Y8_SCALE = 16.f;
constexpr size_t MiB = 1u << 20;

constexpr int RING_OFF = 0, RING_BYTES = 131072;
constexpr int LDSCTL_OFF = 159744, MISC_OFF = LDSCTL_OFF + 320;
constexpr int LDS_BYTES = 163840;

namespace mp {
constexpr size_t ctl = 0, small = 1 * MiB, wr = 2 * MiB, rope = 3 * MiB, dt = 5 * MiB, win = 6 * MiB, wout = 30 * MiB, wgu = 38 * MiB, wd = 166 * MiB;
constexpr size_t xn = 230 * MiB, xn2 = 230 * MiB, ycat = 294 * MiB, u16 = 358 * MiB, qn = 534 * MiB, kn = 566 * MiB, xbc = 598 * MiB, o1 = 646 * MiB, o2 = 678 * MiB, ys = 710 * MiB;
constexpr size_t y = 358 * MiB, hid = 518 * MiB;
constexpr size_t lst = 742 * MiB;
constexpr size_t xn8 = 748 * MiB;
constexpr size_t END = 780 * MiB;
}
constexpr size_t CTL_ZERO_BYTES = 1 * MiB;
constexpr int CW_TMO = 0, CW_CODE = 1, CW_BAR = 4096;
constexpr int CW_Q0 = 66560;
constexpr int CW_LOC = 8192, CW_RANK = 10240;
constexpr int CW_CNT = 65536;
constexpr int LCAP = 16384;
constexpr int SLOT_CAP = 40960;
constexpr int TAB_OFF = LDSCTL_OFF + 1024;
constexpr size_t SM_TOK_E = 0, SM_TOK_POS = 131072, SM_TOK_W = 262144, SM_TOK_SLOT = 393216, SM_RINV = 524288, SM_SLOT_W = 655360, SM_SLOT_R = 851968, SM_END = 1048576;

__device__ __forceinline__ void st16_wt(void* p, v4u v) { asm volatile("global_store_dwordx4 %0, %1, off sc1\n\ts_nop 1" :: "v"(p), "v"(v) : "memory"); }
__device__ __forceinline__ unsigned f2bf(float f) { unsigned u = __builtin_bit_cast(unsigned, f); return (u + 0x7fffu + ((u >> 16) & 1u)) >> 16; }
typedef float f32x2_pk __attribute__((ext_vector_type(2))); typedef __bf16 bf16x2_pk __attribute__((ext_vector_type(2)));
__device__ __forceinline__ unsigned pk2(float lo, float hi) { f32x2_pk v = {lo, hi}; bf16x2_pk b = __builtin_convertvector(v, bf16x2_pk); return __builtin_bit_cast(unsigned, b); }
__device__ __forceinline__ float bf2f(unsigned short b) { return __builtin_bit_cast(float, (unsigned)b << 16); }
__device__ __forceinline__ float wave_sum(float v) {
#pragma unroll
    for (int o = 1; o < 64; o <<= 1) v += __shfl_xor(v, o);
    return v;
}

#define XB_TMO      128
#define XB_XCNT(j)  (256  + 64 * (j))
#define XB_XSUB(j)  (1280 + 64 * (j))
#define XB_XGEN(j)  (2304 + 64 * (j))
#define XB_TOP      3328
#define XB_TOPGEN   3392
#define XCD_BAR_WORDS 3456
#define XB_SPIN_CAP (1u << 18)

__device__ __forceinline__ unsigned xb_ld(unsigned* p)              { return __hip_atomic_load(p, __ATOMIC_RELAXED, __HIP_MEMORY_SCOPE_AGENT); }
__device__ __forceinline__ unsigned xb_add(unsigned* p, unsigned v) { return __hip_atomic_fetch_add(p, v, __ATOMIC_RELAXED, __HIP_MEMORY_SCOPE_AGENT); }
__device__ __forceinline__ unsigned xb_xcc_id() { return (unsigned)__builtin_amdgcn_s_getreg((3 << 11) | 20) & 0xFu; }
#define XB_SPIN(cond, bar) do { unsigned _sp = 0; while (cond) { __builtin_amdgcn_s_sleep(1); \
    if ((++_sp & 255u) == 0u) { if (xb_ld(&(bar)[XB_TMO])) break; if (_sp > XB_SPIN_CAP) { atomicAdd(&(bar)[XB_TMO], 1u); break; } } } } while (0)

struct XcdBarrier {
    unsigned* bar; unsigned x;
    volatile LAS unsigned* st;
};

__device__ __forceinline__ XcdBarrier xcd_barrier_post(unsigned* bar, volatile LAS unsigned* st) {
    XcdBarrier b; b.bar = bar; b.x = xb_xcc_id(); b.st = st;
    if (threadIdx.x == 0) (void)xb_add(&bar[XB_XCNT(b.x)], 1u);
    return b;
}
__device__ __forceinline__ void xcd_barrier_complete(unsigned* bar, unsigned x, unsigned& nloc, unsigned& nx) {
    const unsigned G = gridDim.x * gridDim.y * gridDim.z;
    unsigned sum, cnt, mine, sp = 0u;
    for (;;) {
        sum = 0u; cnt = 0u; mine = 0u;
#pragma unroll
        for (unsigned j = 0; j < 16; ++j) { const unsigned c = xb_ld(&bar[XB_XCNT(j)]); sum += c; cnt += (c > 0u) ? 1u : 0u; mine = (j == x) ? c : mine; }
        if (sum == G) break;
        __builtin_amdgcn_s_sleep(1);
        if ((++sp & 255u) == 0u) { if (xb_ld(&bar[XB_TMO])) break; if (sp > XB_SPIN_CAP) { atomicAdd(&bar[XB_TMO], 1u); break; } }
    }
    nloc = mine > 0u ? mine : 1u; nx = cnt > 0u ? cnt : 1u;
}

__device__ __forceinline__ void xcd_barrier(const XcdBarrier& b) {
    asm volatile("s_waitcnt vmcnt(0)" ::: "memory");
    __syncthreads();
    if (threadIdx.x == 0) {
        unsigned* bar = b.bar;
        __builtin_amdgcn_s_waitcnt(0);
        unsigned nloc = b.st[0], nx = b.st[1];
        if (nloc == 0u) { xcd_barrier_complete(bar, b.x, nloc, nx); b.st[0] = nloc; b.st[1] = nx; }
        const unsigned old = xb_add(&bar[XB_XSUB(b.x)], 1u);
        const unsigned gen = old / nloc;
        if (old + 1u == (gen + 1u) * nloc) {
            __builtin_amdgcn_fence(__ATOMIC_RELEASE, "agent");
            asm volatile("s_waitcnt vmcnt(0)" ::: "memory");
            const unsigned og = xb_add(&bar[XB_TOP], 1u);
            const unsigned tg = og / nx;
            if (og + 1u == (tg + 1u) * nx) xb_add(&bar[XB_TOPGEN], 1u);
            else XB_SPIN(xb_ld(&bar[XB_TOPGEN]) == tg, bar);
            __builtin_amdgcn_fence(__ATOMIC_ACQUIRE, "agent");
            xb_add(&bar[XB_XGEN(b.x)], 1u);
            asm volatile("s_waitcnt vmcnt(0)" ::: "memory");
        } else {
            XB_SPIN(xb_ld(&bar[XB_XGEN(b.x)]) == gen, bar);
            __builtin_amdgcn_fence(__ATOMIC_ACQUIRE, "agent");
            asm volatile("s_waitcnt vmcnt(0)" ::: "memory");
        }
    }
    __syncthreads();
}

__device__ __forceinline__ void xcd_local_barrier(unsigned* bar, unsigned* ctr, unsigned n) {
    asm volatile("s_waitcnt vmcnt(0)" ::: "memory");
    __syncthreads();
    if (threadIdx.x == 0) {
        __builtin_amdgcn_s_waitcnt(0);
        const unsigned old = xb_add(ctr, 1u), target = (old / n + 1u) * n;
        XB_SPIN(xb_ld(ctr) < target, bar);
        __builtin_amdgcn_fence(__ATOMIC_ACQUIRE, "agent");
        asm volatile("s_waitcnt vmcnt(0)" ::: "memory");
    }
    __syncthreads();
}

struct XbTok { unsigned gen, tg; int role; };
__device__ __forceinline__ void xcd_barrier_arrive(const XcdBarrier& b, XbTok& t) {
    asm volatile("s_waitcnt vmcnt(0)" ::: "memory");
    __syncthreads();
    t.gen = 0u; t.tg = 0u; t.role = 0;
    if (threadIdx.x == 0) {
        unsigned* bar = b.bar;
        __builtin_amdgcn_s_waitcnt(0);
        unsigned nloc = b.st[0], nx = b.st[1];
        if (nloc == 0u) { xcd_barrier_complete(bar, b.x, nloc, nx); b.st[0] = nloc; b.st[1] = nx; }
        const unsigned old = xb_add(&bar[XB_XSUB(b.x)], 1u);
        const unsigned gen = old / nloc; t.gen = gen;
        if (old + 1u == (gen + 1u) * nloc) {
            __builtin_amdgcn_fence(__ATOMIC_RELEASE, "agent");
            asm volatile("s_waitcnt vmcnt(0)" ::: "memory");
            const unsigned og = xb_add(&bar[XB_TOP], 1u);
            const unsigned tg = og / nx; t.tg = tg; t.role = 1;
            if (og + 1u == (tg + 1u) * nx) xb_add(&bar[XB_TOPGEN], 1u);
        }
    }
}
__device__ __forceinline__ void xcd_barrier_wait(const XcdBarrier& b, const XbTok& t) {
    if (threadIdx.x == 0) {
        unsigned* bar = b.bar;
        if (t.role == 1) { XB_SPIN(xb_ld(&bar[XB_TOPGEN]) == t.tg, bar);
            __builtin_amdgcn_fence(__ATOMIC_ACQUIRE, "agent");
            xb_add(&bar[XB_XGEN(b.x)], 1u);
            asm volatile("s_waitcnt vmcnt(0)" ::: "memory");
        } else { XB_SPIN(xb_ld(&bar[XB_XGEN(b.x)]) == t.gen, bar);
            __builtin_amdgcn_fence(__ATOMIC_ACQUIRE, "agent");
            asm volatile("s_waitcnt vmcnt(0)" ::: "memory"); }
    }
    __syncthreads();
}

struct Frame {
    LAS unsigned char* lds;
    volatile LAS unsigned* MISC;
    gu32* ctl;
    int tid, lane, wave;
    int vcu, G;
    int cid;
    unsigned char* ws;
};

struct TItem { const float* W; bf16* base; const float* kscale; int ldw, nvalid, k0, n0, kind, pitch, f8; };
constexpr int TI_PC = 36, TI_P1 = 8 * TI_PC, TI_BYTES = 16 * TI_P1 * 4;
template <int NI> __device__ __forceinline__ void titem_issue(const TItem& d, int lane, f32x4 (&ld)[NI]) {
    const int nq = d.n0 + 4 * (lane & 7); const bool ok = nq < d.nvalid;
#pragma unroll
    for (int i = 0; i < NI; ++i) ld[i] = ok ? __builtin_nontemporal_load((const GAS f32x4*)(d.W + (size_t)(d.k0 + (lane >> 3) + 8 * i) * d.ldw + nq)) : (f32x4){0.f, 0.f, 0.f, 0.f};
}
template <int NI> __device__ __forceinline__ void titem_finish(const TItem& d, int lane, const f32x4 (&ld)[NI], LAS float* scr, bf16* WIN, bf16* WDT) {
#pragma unroll
    for (int i = 0; i < NI; ++i) { const int k = (lane >> 3) + 8 * i; *(LAS f32x4*)(scr + (k % NI) * TI_P1 + (k / NI) * TI_PC + 4 * (lane & 7)) = ld[i]; }
    LDS_WAIT(); asm volatile("" ::: "memory");
    const int c = lane & 7;
    if constexpr (NI == 16) {
#pragma unroll
        for (int j = 0; j < 4; ++j) { const int nl = (lane >> 3) + 8 * j, n = d.n0 + nl; const LAS float* s = scr + c * TI_PC + nl;
            const size_t rowi = d.kind == 3 ? (size_t)((n & ~255) + ((n >> 3) & 1) * 128 + ((n >> 6) & 3) * 32 + ((n >> 4) & 3) * 8 + (n & 7))
                                            : (size_t)((n >> 7) * 256 + (n & 127));
            v4u q; q.x = pg8::cvt4_fp8(s[0 * TI_P1] * F8_WSCALE, s[1 * TI_P1] * F8_WSCALE, s[2 * TI_P1] * F8_WSCALE, s[3 * TI_P1] * F8_WSCALE); q.y = pg8::cvt4_fp8(s[4 * TI_P1] * F8_WSCALE, s[5 * TI_P1] * F8_WSCALE, s[6 * TI_P1] * F8_WSCALE, s[7 * TI_P1] * F8_WSCALE);
            q.z = pg8::cvt4_fp8(s[8 * TI_P1] * F8_WSCALE, s[9 * TI_P1] * F8_WSCALE, s[10 * TI_P1] * F8_WSCALE, s[11 * TI_P1] * F8_WSCALE); q.w = pg8::cvt4_fp8(s[12 * TI_P1] * F8_WSCALE, s[13 * TI_P1] * F8_WSCALE, s[14 * TI_P1] * F8_WSCALE, s[15 * TI_P1] * F8_WSCALE);
            if (n < d.nvalid) __builtin_nontemporal_store(q, (GAS v4u*)((unsigned char*)d.base + rowi * d.pitch + d.k0 + 16 * c)); }
    } else {
#pragma unroll
        for (int j = 0; j < 4; ++j) { const int nl = (lane >> 3) + 8 * j, n = d.n0 + nl; const LAS float* s = scr + c * TI_PC + nl;
            v4u o; o.x = pk2(s[0 * TI_P1], s[1 * TI_P1]); o.y = pk2(s[2 * TI_P1], s[3 * TI_P1]); o.z = pk2(s[4 * TI_P1], s[5 * TI_P1]); o.w = pk2(s[6 * TI_P1], s[7 * TI_P1]);
            bf16* row;
            if (d.kind == 0) row = n < 2560 ? WIN + (size_t)n * DM : (n < 2576 ? WIN + (size_t)(NIN + n - 2560) * DM : WIN + (size_t)(n - 16) * DM);
            else row = d.base + (size_t)n * d.pitch;
            if (n < d.nvalid) *(GAS v4u*)(row + d.k0 + 8 * c) = o; }
    }
    LDS_WAIT(); asm volatile("" ::: "memory");
}

struct Args { const void* in[26]; float* out; unsigned char* ws; int ph_lo, ph_hi, li, p0_mask, rep_phase, pad; };
typedef const __attribute__((address_space(4))) Args* KA;

constexpr int P0B_NBLK = 3 * NE * 128, P0B_NSUB = 4 * P0B_NBLK;
__device__ __forceinline__ void p0b_blocks(Frame& F, KA args, int first, int nq, int gstride = 1) {
    const int lane = F.lane;
    const float* w_gate = (const float*)args->in[23]; const float* w_up = (const float*)args->in[24]; const float* w_down = (const float*)args->in[25];
    bf16* WGU = (bf16*)(F.ws + mp::wgu); bf16* WD = (bf16*)(F.ws + mp::wd);
    LAS float* scr = (LAS float*)(F.lds + F.wave * TI_BYTES);
    auto decodeB = [&](int q) -> TItem {
        const int g = first + q * gstride, cb = g >> 2, i = g & 3;
        if (cb < 8192) { const int up = cb >> 12, r = cb & 4095, e = r >> 7, kb = (r >> 3) & 15, nb = r & 7;
            return TItem{(up ? w_up : w_gate) + (size_t)e * DM * EH, (bf16*)((unsigned char*)WGU + (size_t)e * 2048 * DM + (up ? (size_t)128 * DM : 0)), nullptr, EH, EH, 128 * kb, 128 * nb + 32 * i, 2, DM, 1}; }
        const int r = cb - 8192, e = r >> 7, kb = (r >> 4) & 7, nb = r & 15;
        return TItem{w_down + (size_t)e * EH * DM, (bf16*)((unsigned char*)WD + (size_t)e * DM * EH), nullptr, DM, DM, 128 * kb, 128 * nb + 32 * i, 3, EH, 1};
    };
    if (nq <= 0) return;
    TItem d0 = decodeB(0), d1 = d0, d2 = d0; f32x4 l0[16], l1[16], l2[16];
    titem_issue<16>(d0, lane, l0);
    if (nq > 1) { d1 = decodeB(1); titem_issue<16>(d1, lane, l1); }
    for (int q = 0; q < nq; q += 3) {
        if (q + 2 < nq) { d2 = decodeB(q + 2); titem_issue<16>(d2, lane, l2); }
        titem_finish<16>(d0, lane, l0, scr, nullptr, nullptr);
        if (q + 1 >= nq) break;
        if (q + 3 < nq) { d0 = decodeB(q + 3); titem_issue<16>(d0, lane, l0); }
        titem_finish<16>(d1, lane, l1, scr, nullptr, nullptr);
        if (q + 2 >= nq) break;
        if (q + 4 < nq) { d1 = decodeB(q + 4); titem_issue<16>(d1, lane, l1); }
        titem_finish<16>(d2, lane, l2, scr, nullptr, nullptr);
    }
}
constexpr int P1_UNITS = (M / 256) * (NIN_G / 256);
#if P1_HOSTS_P0B == 2
constexpr int P1_INLOOP_BLOCKS = P1_UNITS * NWAVES;
static_assert(P0B_NBLK - P1_INLOOP_BLOCKS == 64 * NWAVES, "the 64 CUs with one GEMM unit less take one more block per wave");
#endif
#ifndef P1_NCLASS
#define P1_NCLASS 3
#endif
constexpr int P8_LATE_CUS = 96, P8_LATE_Q = 8, P8_LATE_SUB = P8_LATE_CUS * NWAVES * P8_LATE_Q;
constexpr int P1_SUB = P0B_NSUB - P8_LATE_SUB, P1_QW = (P1_SUB / 8 - 64 * 12) / 256;
static_assert(8 * (256 * P1_QW + 64 * 12) == P1_SUB, "quota");
__device__ __forceinline__ void p1_convert_share(Frame& F, KA args, int part) {
    const int c = F.cid, xcd = c & 7, l = c >> 3, lclass = xcd % P1_NCLASS;
    const int ex = l < 24 ? 0 : 12, q = P1_QW + ex;
    const int base = xcd * (P1_SUB / 8);
    const int first = l < 24 ? base + l * (NWAVES * P1_QW) : base + 24 * NWAVES * P1_QW + (l - 24) * (NWAVES * (P1_QW + 12));
    int lo, hi;
    if (part == 0) { lo = 0; hi = lclass == 0 ? q : ex; } else if (part == lclass) { lo = ex; hi = q; } else return;
    p0b_blocks(F, args, first + F.wave * q + lo, hi - lo);
}
__device__ __forceinline__ void p8_convert_late(Frame& F, KA args) {
    if (F.cid < 256 - P8_LATE_CUS) return;
    p0b_blocks(F, args, P1_SUB + ((F.cid - (256 - P8_LATE_CUS)) * NWAVES + F.wave) * P8_LATE_Q, P8_LATE_Q);
}

__device__ __forceinline__ void p0_prologue(Frame& F, KA args) {
    const int gw = F.vcu * NWAVES + F.wave, NGW = F.G * NWAVES, lane = F.lane;
    const float* w_in = (const float*)args->in[3]; const float* w_out = (const float*)args->in[17];
    bf16* WIN = (bf16*)(F.ws + mp::win); bf16* WDT = nullptr; bf16* WOUT = (bf16*)(F.ws + mp::wout);
    constexpr int NB_IN = (IN_COLS + 31) / 32;
    constexpr int I_IN = (DM / 64) * NB_IN, I_OUT = (DM / 64) * (DM / 32), NITEMS_A = I_IN + I_OUT;
    LAS float* scr = (LAS float*)(F.lds + F.wave * TI_BYTES);
    auto decodeA = [&](int it) -> TItem {
        int r = it;
        if (r < I_IN) { const int kb = r / NB_IN, nb = r % NB_IN; return TItem{w_in, WIN, nullptr, IN_COLS, IN_COLS, 64 * kb, 32 * nb, 0, DM, 0}; }
        r -= I_IN; const int kb = r / (DM / 32), nb = r % (DM / 32); return TItem{w_out, WOUT, nullptr, DM, DM, 64 * kb, 32 * nb, 1, DM, 0};
    };
    if (gw < NITEMS_A) {
        TItem dc = decodeA(gw); f32x4 la[8], lb[8];
        titem_issue<8>(dc, lane, la);
        for (int it = gw; it < NITEMS_A; it += NGW) {
            const int nx = it + NGW; TItem dn = dc;
            if (nx < NITEMS_A) { dn = decodeA(nx); titem_issue<8>(dn, lane, lb); }
            titem_finish<8>(dc, lane, la, scr, WIN, WDT);
            dc = dn;
#pragma unroll
            for (int i = 0; i < 8; ++i) la[i] = lb[i];
        }
    }
#if !P1_HOSTS_P0B
    p0b_blocks(F, args, gw * (P0B_NSUB / NGW), P0B_NSUB / NGW);
#endif
}

__device__ __forceinline__ void p0_xn1(Frame& F, KA args) {
    const int lane = F.lane;
    const float* x = (const float*)args->in[0]; const float* ln1 = (const float*)args->in[2]; bf16* XN = (bf16*)(F.ws + mp::xn);
    for (int it = 0; it < 4; ++it) { const int m0 = (F.vcu >> 5) * 2048 + it * 512 + ((F.vcu & 31) * NWAVES + F.wave) * 2;
        f32x4 v[2][8];
#pragma unroll
        for (int rr = 0; rr < 2; ++rr)
#pragma unroll
            for (int j = 0; j < 8; ++j) v[rr][j] = __builtin_nontemporal_load((const GAS f32x4*)(x + (size_t)(m0 + rr) * DM) + lane + 64 * j);
#pragma unroll
        for (int rr = 0; rr < 2; ++rr) { float s = 0.f;
#pragma unroll
            for (int j = 0; j < 8; ++j) s += (v[rr][j].x * v[rr][j].x + v[rr][j].y * v[rr][j].y) + (v[rr][j].z * v[rr][j].z + v[rr][j].w * v[rr][j].w);
            const float r = 1.0f / sqrtf(wave_sum(s) * (1.f / DM) + EPS);
            GAS v2u* o8 = (GAS v2u*)(XN + (size_t)(m0 + rr) * DM) + lane; const GAS f32x4* wr = (const GAS f32x4*)ln1 + lane;
#pragma unroll
            for (int j = 0; j < 8; ++j) { const f32x4 ww = wr[64 * j]; v2u o; o.x = pk2(v[rr][j].x * r * ww.x, v[rr][j].y * r * ww.y); o.y = pk2(v[rr][j].z * r * ww.z, v[rr][j].w * r * ww.w); o8[64 * j] = o; } }
    }
}


__device__ __forceinline__ void p0_rope(Frame& F, KA args) {
    const int gt = (F.vcu * NWAVES + F.wave) * 64 + F.lane, NGT = F.G * NWAVES * 64;
    const int* pos = (const int*)args->in[1]; float* rope = (float*)(F.ws + mp::rope);
    for (int i = gt; i < M * 8; i += NGT) { const int m = i >> 3, j = i & 7;
        const float inv_freq = powf(500000.0f, -(float)(2 * j) / 16.0f);
        const float ang = (float)pos[m] * inv_freq;
        rope[m * 16 + j] = cosf(ang); rope[m * 16 + 8 + j] = sinf(ang); }
}

__device__ __forceinline__ void p2_qknorm(Frame& F, KA args) {
    const int gw = F.vcu * NWAVES + F.wave, NGW = F.G * NWAVES, lane = F.lane;
    const bf16* U16 = (const bf16*)(F.ws + mp::u16); const float* rope = (const float*)(F.ws + mp::rope);
    bf16* QN = (bf16*)(F.ws + mp::qn); bf16* KN = (bf16*)(F.ws + mp::kn);
    const float* qw = (const float*)args->in[10]; const float* kw = (const float*)args->in[11];
    const int sub = lane & 7;
    float wq[8], wk[8];
#pragma unroll
    for (int j = 0; j < 8; ++j) { wq[j] = qw[sub * 8 + j] * attn_body::C2; wk[j] = kw[sub * 8 + j]; }
    for (int it = 0; it < 2; ++it) { const int m0 = (F.vcu >> 5) * 2048 + it * 1024 + ((F.vcu & 31) * NWAVES + F.wave) * 4;
        v4u raw[4][4]; f32x4 rp[4][4];
#pragma unroll
        for (int rr = 0; rr < 4; ++rr) {
#pragma unroll
            for (int pc = 0; pc < 4; ++pc) raw[rr][pc] = __builtin_nontemporal_load((const GAS v4u*)(U16 + (size_t)(m0 + rr) * NIN + ((pc >> 1) ? UC_K : UC_Q) + (pc & 1) * 512 + lane * 8));
#pragma unroll
            for (int q = 0; q < 4; ++q) rp[rr][q] = *(const GAS f32x4*)(rope + (size_t)(m0 + rr) * 16 + 4 * q);
        }
#pragma unroll
        for (int rr = 0; rr < 4; ++rr) {
            const int m = m0 + rr;
            const float cs[8] = {rp[rr][0].x, rp[rr][0].y, rp[rr][0].z, rp[rr][0].w, rp[rr][1].x, rp[rr][1].y, rp[rr][1].z, rp[rr][1].w};
            const float sn[8] = {rp[rr][2].x, rp[rr][2].y, rp[rr][2].z, rp[rr][2].w, rp[rr][3].x, rp[rr][3].y, rp[rr][3].z, rp[rr][3].w};
#pragma unroll
            for (int pc = 0; pc < 4; ++pc) {
                const int isk = pc >> 1, col = (pc & 1) * 512 + lane * 8;
                const v4u rw = raw[rr][pc];
                float v[8];
                v[0] = __builtin_bit_cast(float, rw.x << 16); v[1] = __builtin_bit_cast(float, rw.x & 0xffff0000u); v[2] = __builtin_bit_cast(float, rw.y << 16); v[3] = __builtin_bit_cast(float, rw.y & 0xffff0000u);
                v[4] = __builtin_bit_cast(float, rw.z << 16); v[5] = __builtin_bit_cast(float, rw.z & 0xffff0000u); v[6] = __builtin_bit_cast(float, rw.w << 16); v[7] = __builtin_bit_cast(float, rw.w & 0xffff0000u);
                float ss = 0.f;
#pragma unroll
                for (int j = 0; j < 8; ++j) ss += v[j] * v[j];
                ss += __shfl_xor(ss, 1); ss += __shfl_xor(ss, 2); ss += __shfl_xor(ss, 4);
                const float r = 1.0f / sqrtf(ss * (1.f / 64.f) + EPS);
                float y[8];
#pragma unroll
                for (int j = 0; j < 8; ++j) y[j] = v[j] * r * (isk ? wk[j] : wq[j]);
#pragma unroll
                for (int j = 0; j < 8; ++j) { const float pv = __shfl_xor(y[j], 1);
                    if (sub == 0) y[j] = y[j] * cs[j] - pv * sn[j]; else if (sub == 1) y[j] = y[j] * cs[j] + pv * sn[j]; }
                v4u o; o.x = pk2(y[0], y[1]); o.y = pk2(y[2], y[3]); o.z = pk2(y[4], y[5]); o.w = pk2(y[6], y[7]);
                *(GAS v4u*)((isk ? KN : QN) + (size_t)m * 1024 + col) = o;
            }
        }
    }
}

__device__ __forceinline__ void p3_attention(Frame& F, KA args, unsigned char* lds_generic) {
    const attn_body::bf16* QN = (const attn_body::bf16*)(F.ws + mp::qn); const attn_body::bf16* KN = (const attn_body::bf16*)(F.ws + mp::kn);
    const attn_body::bf16* U16 = (const attn_body::bf16*)(F.ws + mp::u16); attn_body::bf16* YCAT = (attn_body::bf16*)(F.ws + mp::ycat);
    const float* subw = (const float*)args->in[16];
    float lam;
    { const float* lq1 = (const float*)args->in[12]; const float* lk1 = (const float*)args->in[13]; const float* lq2 = (const float*)args->in[14]; const float* lk2 = (const float*)args->in[15];
      const float s1 = wave_sum(lq1[F.lane] * lk1[F.lane]), s2 = wave_sum(lq2[F.lane] * lk2[F.lane]); lam = expf(s1) - expf(s2) + 0.2f; }
    LAS float* swl = (LAS float*)(F.lds + TAB_OFF + 1024);
    if (F.tid < 128) swl[F.tid] = subw[F.tid] * 0.8f;
    LDS_WAIT(); __syncthreads();
    const int b = F.vcu >> 5, idx = F.vcu & 31, h = idx >> 2, s = idx & 3;
    for (int i = 0; i < 4; ++i) {
        const int j = (i + 2 * (h & 1)) & 3, qb = (j >> 1) ? 7 - s : s, comp = i & 1;
        attn3::attn_unit128<8, DM>(b, qb, QN + (h * 2 + comp) * 64, KN + (h * 2 + comp) * 64, U16 + UC_V + h * 128, YCAT + 1024 + h * 128, (char*)lds_generic + RING_OFF, comp, lam, (const float*)swl);
    }
}

__device__ __forceinline__ void p4_ycat(Frame& F, KA args, int parts) {
    const int gw = F.vcu * NWAVES + F.wave, NGW = F.G * NWAVES, lane = F.lane;
    const bf16* U16 = (const bf16*)(F.ws + mp::u16); const bf16* YS = (const bf16*)(F.ws + mp::ys);
    const bf16* O1 = (const bf16*)(F.ws + mp::o1); const bf16* O2 = (const bf16*)(F.ws + mp::o2); bf16* YCAT = (bf16*)(F.ws + mp::ycat);
    const float* nw = (const float*)args->in[9]; const float* subw = (const float*)args->in[16];
    float lam;
    { const float* lq1 = (const float*)args->in[12]; const float* lk1 = (const float*)args->in[13]; const float* lq2 = (const float*)args->in[14]; const float* lk2 = (const float*)args->in[15];
      const float s1 = wave_sum(lq1[lane] * lk1[lane]), s2 = wave_sum(lq2[lane] * lk2[lane]); lam = expf(s1) - expf(s2) + 0.2f; }
    float w_s[2][8], w_a[8];
#pragma unroll
    for (int j = 0; j < 8; ++j) { w_s[0][j] = nw[lane * 8 + j]; w_s[1][j] = nw[512 + lane * 8 + j]; w_a[j] = subw[(lane & 15) * 8 + j] * 0.8f; }
    for (int it = 0; it < 4; ++it) { const int m0 = (F.vcu >> 5) * 2048 + it * 512 + ((F.vcu & 31) * NWAVES + F.wave) * 2;
        v4u yv[2][2], zv[2][2], av[2][2], bv[2][2];
#pragma unroll
        for (int rr = 0; rr < 2; ++rr) { const size_t m = (size_t)(m0 + rr);
#pragma unroll
            for (int sl = 0; sl < 2; ++sl) {
                if (parts & 1) { yv[rr][sl] = __builtin_nontemporal_load((const GAS v4u*)(YS + m * 1024 + 512 * sl + lane * 8)); zv[rr][sl] = __builtin_nontemporal_load((const GAS v4u*)(U16 + m * NIN + UC_Z + 512 * sl + lane * 8)); }
                if (parts & 2) { av[rr][sl] = __builtin_nontemporal_load((const GAS v4u*)(O1 + m * 1024 + 512 * sl + lane * 8)); bv[rr][sl] = __builtin_nontemporal_load((const GAS v4u*)(O2 + m * 1024 + 512 * sl + lane * 8)); } } }
#pragma unroll
        for (int rr = 0; rr < 2; ++rr) { const size_t m = (size_t)(m0 + rr);
#pragma unroll
        for (int sl = 0; sl < 2; ++sl) {
        if (parts & 1) {
            const v4u y0 = yv[rr][sl], z0 = zv[rr][sl];
            const unsigned yy[4] = {y0.x, y0.y, y0.z, y0.w}, zz[4] = {z0.x, z0.y, z0.z, z0.w};
            float v[8]; float ss = 0.f;
#pragma unroll
            for (int j = 0; j < 4; ++j) { const float ya = __builtin_bit_cast(float, yy[j] << 16), yb = __builtin_bit_cast(float, yy[j] & 0xffff0000u), za = __builtin_bit_cast(float, zz[j] << 16), zb = __builtin_bit_cast(float, zz[j] & 0xffff0000u);
                v[2 * j] = ya * za / (1.f + __expf(-za)); v[2 * j + 1] = yb * zb / (1.f + __expf(-zb)); ss += v[2 * j] * v[2 * j] + v[2 * j + 1] * v[2 * j + 1]; }
            ss = wave_sum(ss);
            const float r = 1.0f / sqrtf(ss * (1.f / 512.f) + EPS);
            v4u o0; o0.x = pk2(v[0] * r * w_s[sl][0], v[1] * r * w_s[sl][1]); o0.y = pk2(v[2] * r * w_s[sl][2], v[3] * r * w_s[sl][3]); o0.z = pk2(v[4] * r * w_s[sl][4], v[5] * r * w_s[sl][5]); o0.w = pk2(v[6] * r * w_s[sl][6], v[7] * r * w_s[sl][7]);
            *(GAS v4u*)(YCAT + m * DM + 512 * sl + lane * 8) = o0;
        }
        if (parts & 2) {
            const v4u a0 = av[rr][sl], b0 = bv[rr][sl];
            const unsigned aa[4] = {a0.x, a0.y, a0.z, a0.w}, bb[4] = {b0.x, b0.y, b0.z, b0.w};
            float v[8]; float ss = 0.f;
#pragma unroll
            for (int j = 0; j < 4; ++j) { v[2 * j] = __builtin_bit_cast(float, aa[j] << 16) - lam * __builtin_bit_cast(float, bb[j] << 16); v[2 * j + 1] = __builtin_bit_cast(float, aa[j] & 0xffff0000u) - lam * __builtin_bit_cast(float, bb[j] & 0xffff0000u);
                ss += v[2 * j] * v[2 * j] + v[2 * j + 1] * v[2 * j + 1]; }
            ss += __shfl_xor(ss, 1); ss += __shfl_xor(ss, 2); ss += __shfl_xor(ss, 4); ss += __shfl_xor(ss, 8);
            const float r = 1.0f / sqrtf(ss * (1.f / 128.f) + EPS);
            v4u o0; o0.x = pk2(v[0] * r * w_a[0], v[1] * r * w_a[1]); o0.y = pk2(v[2] * r * w_a[2], v[3] * r * w_a[3]); o0.z = pk2(v[4] * r * w_a[4], v[5] * r * w_a[5]); o0.w = pk2(v[6] * r * w_a[6], v[7] * r * w_a[7]);
            *(GAS v4u*)(YCAT + m * DM + 1024 + 512 * sl + lane * 8) = o0;
        }
        }
        }
    }
}

constexpr int CONV_R = 8;
__device__ __forceinline__ void p2_conv(Frame& F, KA args) {
    const int gw = F.vcu * NWAVES + F.wave, NGW = F.G * NWAVES, lane = F.lane;
    const bf16* U16 = (const bf16*)(F.ws + mp::u16); bf16* XBC = (bf16*)(F.ws + mp::xbc);
    const float* cw = (const float*)args->in[4]; const float* cb = (const float*)args->in[5];
    for (int it = 0; it < 3; ++it) { const int task = (F.vcu & 31) * NWAVES + F.wave + 256 * it;
        const int cblk = task % 3, r0 = (F.vcu >> 5) * 2048 + (task / 3) * CONV_R, c0 = cblk * 512 + lane * 8;
        const bool seq_start = (r0 % SEQ) == 0;
        v4u raw[CONV_R + 3];
#pragma unroll
        for (int j = 0; j < CONV_R + 3; ++j) { raw[j] = (v4u){0u, 0u, 0u, 0u}; if (j >= 3 || !seq_start) raw[j] = __builtin_nontemporal_load((const GAS v4u*)(U16 + (size_t)(r0 - 3 + j) * NIN + UC_XBC + c0)); }
        float w[4][8], bias[8];
#pragma unroll
        for (int j = 0; j < 4; ++j)
#pragma unroll
            for (int i = 0; i < 8; ++i) w[j][i] = cw[j * 1536 + c0 + i];
#pragma unroll
        for (int i = 0; i < 8; ++i) bias[i] = cb[c0 + i];
#pragma unroll
        for (int t = 0; t < CONV_R; ++t) {
            float o[8];
#pragma unroll
            for (int i = 0; i < 8; ++i) o[i] = bias[i];
#pragma unroll
            for (int j = 0; j < 4; ++j) { const v4u rw = raw[t + j];
                const float e[8] = {__builtin_bit_cast(float, rw.x << 16), __builtin_bit_cast(float, rw.x & 0xffff0000u), __builtin_bit_cast(float, rw.y << 16), __builtin_bit_cast(float, rw.y & 0xffff0000u),
                                    __builtin_bit_cast(float, rw.z << 16), __builtin_bit_cast(float, rw.z & 0xffff0000u), __builtin_bit_cast(float, rw.w << 16), __builtin_bit_cast(float, rw.w & 0xffff0000u)};
#pragma unroll
                for (int i = 0; i < 8; ++i) o[i] += w[j][i] * e[i]; }
#pragma unroll
            for (int i = 0; i < 8; ++i) o[i] = o[i] / (1.f + __expf(-o[i]));
            v4u ov; ov.x = pk2(o[0], o[1]); ov.y = pk2(o[2], o[3]); ov.z = pk2(o[4], o[5]); ov.w = pk2(o[6], o[7]);
            *(GAS v4u*)(XBC + (size_t)(r0 + t) * 1536 + c0) = ov;
        }
    }
}

namespace ssd {
constexpr int BCS = 2064;
constexpr int LB = 0, LC = LB + 16 * BCS, LX = LC + 16 * BCS, LXW = LX + 8192, LST = LXW + 8192, STB = 8704, LA = LST + 2 * STB, LSL = LA + 4096, SSD_LDS_END = LSL + 10 * 4096;
static_assert(SSD_LDS_END <= LDSCTL_OFF, "SSD tiles vs LDS control words");
typedef float f32x16 __attribute__((ext_vector_type(16)));
#define SSD_PIN8(a) asm volatile("" : "+v"(a[0]), "+v"(a[1]), "+v"(a[2]), "+v"(a[3]), "+v"(a[4]), "+v"(a[5]), "+v"(a[6]), "+v"(a[7]))
#define SSD_PIN4(a) asm volatile("" : "+v"(a[0]), "+v"(a[1]), "+v"(a[2]), "+v"(a[3]))
struct Ctx { LAS unsigned char* lds; const LAS float* a2; const LAS float* dtl; const LAS float* fsl; int lane, r32, hi; };
__device__ __forceinline__ void load_cf(const Ctx& c, int lb, bf16x8 (&cf)[8]) {
#pragma unroll
    for (int ks = 0; ks < 8; ++ks) cf[ks] = *(const LAS bf16x8*)(c.lds + LC + (2 * ks + c.hi) * BCS + (32 * lb + c.r32) * 16);
    SSD_PIN8(cf);
}
template <bool DIAG> __device__ __forceinline__ void intra(const Ctx& c, int lb, int st, const bf16x8 (&cf)[8], f32x16& y) {
    bf16x8 bq[8];
#pragma unroll
    for (int ks = 0; ks < 8; ++ks) bq[ks] = *(const LAS bf16x8*)(c.lds + LB + (2 * ks + c.hi) * BCS + (32 * st + c.r32) * 16);
    f32x4 av[4], dv[4];
#pragma unroll
    for (int q = 0; q < 4; ++q) { av[q] = *(const LAS f32x4*)((DIAG ? c.a2 : c.fsl) + 32 * st + 8 * q + 4 * c.hi); if (DIAG) dv[q] = *(const LAS f32x4*)(c.dtl + 32 * st + 8 * q + 4 * c.hi); }
    const float al = c.a2[32 * lb + c.r32], aref = c.a2[32 * st + 31];
    SSD_PIN8(bq); SSD_PIN4(av); if (DIAG) SSD_PIN4(dv);
    f32x16 p;
#pragma unroll
    for (int r = 0; r < 16; ++r) p[r] = 0.f;
#pragma unroll
    for (int ks = 0; ks < 8; ++ks) p = __builtin_amdgcn_mfma_f32_32x32x16_bf16(bq[ks], cf[ks], p, 0, 0, 0);
    if (DIAG) {
        float e[16];
#pragma unroll
        for (int r = 0; r < 16; ++r) e[r] = __builtin_amdgcn_exp2f(fminf(al - av[r >> 2][r & 3], 0.f));
#pragma unroll
        for (int r = 0; r < 16; ++r) { const int sl = attn_body::crow(r, c.hi); const float v = p[r] * e[r] * dv[r >> 2][r & 3]; p[r] = sl > c.r32 ? 0.f : v; }
    } else {
        const float el = __builtin_amdgcn_exp2f(al - aref);
#pragma unroll
        for (int r = 0; r < 16; ++r) p[r] *= el * av[r >> 2][r & 3];
    }
    v4u pw0, pw1;
    pw0.x = attn_body::cvtpk_s(p[0], p[1]); pw0.y = attn_body::cvtpk_s(p[2], p[3]); pw0.z = attn_body::cvtpk_s(p[4], p[5]); pw0.w = attn_body::cvtpk_s(p[6], p[7]);
    pw1.x = attn_body::cvtpk_s(p[8], p[9]); pw1.y = attn_body::cvtpk_s(p[10], p[11]); pw1.z = attn_body::cvtpk_s(p[12], p[13]); pw1.w = attn_body::cvtpk_s(p[14], p[15]);
    const LAS unsigned char* xb = c.lds + LX + ((c.lane >> 4) & 1) * 32 + (c.lane & 3) * 8 + (4 * c.hi + ((c.lane & 15) >> 2)) * 64 + (32 * st) * 64;
    const attn_body::s16x4 lo0 = attn_body::vtr((attn_body::lds_cptr)(xb)), hh0 = attn_body::vtr((attn_body::lds_cptr)(xb + 512));
    const attn_body::s16x4 lo1 = attn_body::vtr((attn_body::lds_cptr)(xb + 1024)), hh1 = attn_body::vtr((attn_body::lds_cptr)(xb + 1024 + 512));
    y = __builtin_amdgcn_mfma_f32_32x32x16_bf16(__builtin_bit_cast(bf16x8, pw0), (bf16x8){lo0[0], lo0[1], lo0[2], lo0[3], hh0[0], hh0[1], hh0[2], hh0[3]}, y, 0, 0, 0);
    y = __builtin_amdgcn_mfma_f32_32x32x16_bf16(__builtin_bit_cast(bf16x8, pw1), (bf16x8){lo1[0], lo1[1], lo1[2], lo1[3], hh1[0], hh1[1], hh1[2], hh1[3]}, y, 0, 0, 0);
}
__device__ __forceinline__ void yoff(const Ctx& c, int lb, int sbuf, f32x16& y) {
    bf16x8 cf[8], sf[8]; f32x4 av[4];
    load_cf(c, lb, cf);
#pragma unroll
    for (int ks = 0; ks < 8; ++ks) sf[ks] = *(const LAS bf16x8*)(c.lds + LST + sbuf * STB + c.r32 * 272 + (16 * ks + 8 * c.hi) * 2);
#pragma unroll
    for (int q = 0; q < 4; ++q) av[q] = *(const LAS f32x4*)(c.a2 + 32 * lb + 8 * q + 4 * c.hi);
    SSD_PIN8(cf); SSD_PIN8(sf); SSD_PIN4(av);
#pragma unroll
    for (int r = 0; r < 16; ++r) y[r] = 0.f;
#pragma unroll
    for (int ks = 0; ks < 8; ++ks) y = __builtin_amdgcn_mfma_f32_32x32x16_bf16(cf[ks], sf[ks], y, 0, 0, 0);
#pragma unroll
    for (int r = 0; r < 16; ++r) y[r] *= __builtin_amdgcn_exp2f(av[r >> 2][r & 3]);
}
__device__ __forceinline__ void state_item(const Ctx& c, int nt, int nbuf, f32x16& st) {
    const int i16 = c.lane & 15, g1 = (c.lane >> 4) & 1;
    const float dall = __builtin_amdgcn_exp2f(c.a2[127]);
#pragma unroll
    for (int r = 0; r < 16; ++r) st[r] *= dall;
    const LAS unsigned char* ab = c.lds + LB + (4 * nt + 2 * g1 + ((i16 & 3) >> 1)) * BCS + (8 * c.hi + (i16 >> 2)) * 16 + (i16 & 1) * 8;
    const LAS unsigned char* wb = c.lds + LXW + (8 * c.hi + (i16 >> 2)) * 64 + g1 * 32 + (i16 & 3) * 8;
#pragma unroll
    for (int kb = 0; kb < 2; ++kb) {
        bf16x8 af[4], wf[4];
#pragma unroll
        for (int kk = 0; kk < 4; ++kk) { const int ks = kb * 4 + kk;
            const attn_body::s16x4 a0 = attn_body::vtr((attn_body::lds_cptr)(ab + ks * 256)), a1 = attn_body::vtr((attn_body::lds_cptr)(ab + ks * 256 + 64));
            const attn_body::s16x4 w0 = attn_body::vtr((attn_body::lds_cptr)(wb + ks * 1024)), w1 = attn_body::vtr((attn_body::lds_cptr)(wb + ks * 1024 + 256));
            af[kk] = (bf16x8){a0[0], a0[1], a0[2], a0[3], a1[0], a1[1], a1[2], a1[3]}; wf[kk] = (bf16x8){w0[0], w0[1], w0[2], w0[3], w1[0], w1[1], w1[2], w1[3]}; }
        SSD_PIN4(af); SSD_PIN4(wf);
#pragma unroll
        for (int kk = 0; kk < 4; ++kk) st = __builtin_amdgcn_mfma_f32_32x32x16_bf16(af[kk], wf[kk], st, 0, 0, 0);
    }
#pragma unroll
    for (int q = 0; q < 4; ++q) { v2u w; w.x = attn_body::cvtpk_s(st[4 * q], st[4 * q + 1]); w.y = attn_body::cvtpk_s(st[4 * q + 2], st[4 * q + 3]);
        *(LAS v2u*)(c.lds + LST + nbuf * STB + c.r32 * 272 + (32 * nt + 8 * q + 4 * c.hi) * 2) = w; }
}
__device__ __forceinline__ void put_slot(const Ctx& c, int slot, const f32x16& y) {
    LAS float* sp = (LAS float*)(c.lds + LSL + slot * 4096);
#pragma unroll
    for (int r = 0; r < 16; ++r) sp[attn_body::crow(r, c.hi) * 32 + c.r32] = y[r];
}
__device__ __forceinline__ void unit(Frame& F, KA args, int u) {
    const int tid = F.tid, lane = F.lane, wave = F.wave, r32 = lane & 31, hi = lane >> 5;
    const int b = u >> 5, h = (u >> 1) & 15, ph = u & 1, g = h >> 3;
    const bf16* XBC = (const bf16*)(F.ws + mp::xbc); const float* DTR = (const float*)(F.ws + mp::dt); bf16* YS = (bf16*)(F.ws + mp::ys);
    const float dtb = ((const float*)args->in[6])[h], Ah = -expf(((const float*)args->in[7])[h]) * 1.44269504089f, Dk = ((const float*)args->in[8])[h];
    LAS unsigned char* lds = F.lds + RING_OFF;
    const size_t mbase = (size_t)b * SEQ;
    const int brow = tid >> 4, bchk = tid & 15;
    const int xrow = tid >> 2, xpc = tid & 3;
    v4u Breg[4], Creg[4], xreg;
#define SSD_LOAD_REGS(k_) do { const size_t m0_ = mbase + (size_t)(k_) * 128; \
        _Pragma("unroll") for (int i = 0; i < 4; ++i) { Breg[i] = *(const GAS v4u*)(XBC + (m0_ + brow + 32 * i) * 1536 + 1024 + g * 128 + bchk * 8); Creg[i] = *(const GAS v4u*)(XBC + (m0_ + brow + 32 * i) * 1536 + 1280 + g * 128 + bchk * 8); } \
        xreg = *(const GAS v4u*)(XBC + (m0_ + xrow) * 1536 + h * 64 + ph * 32 + xpc * 8); } while (0)
    float dtr0 = 0.f, dtr1 = 0.f;
#define SSD_LOAD_DT(k_) do { const size_t m0_ = mbase + (size_t)(k_) * 128; dtr0 = DTR[(m0_ + 2 * lane) * 16 + h]; dtr1 = DTR[(m0_ + 2 * lane + 1) * 16 + h]; } while (0)
#define SSD_PREP_A(buf_) do { \
        const float r0 = dtr0 + dtb, r1 = dtr1 + dtb; \
        const float d0 = r0 > 20.f ? r0 : log1pf(expf(r0)), d1 = r1 > 20.f ? r1 : log1pf(expf(r1)); \
        const float v0 = d0 * Ah, v1 = d1 * Ah; float s_ = v0 + v1; \
        _Pragma("unroll") for (int o = 1; o < 64; o <<= 1) { const float t = __shfl_up(s_, o); if (lane >= o) s_ += t; } \
        LAS float* a2w = (LAS float*)(lds + LA + (buf_) * 2048); LAS float* dtw = a2w + 128; LAS float* fw = a2w + 256; \
        const float aref_ = __shfl(s_, (lane & 48) | 15); \
        a2w[2 * lane] = s_ - v1; a2w[2 * lane + 1] = s_; dtw[2 * lane] = d0; dtw[2 * lane + 1] = d1; \
        fw[2 * lane] = __builtin_amdgcn_exp2f(aref_ - (s_ - v1)) * d0; fw[2 * lane + 1] = __builtin_amdgcn_exp2f(aref_ - s_) * d1; } while (0)
    f32x16 stA, stB;
#pragma unroll
    for (int r = 0; r < 16; ++r) { stA[r] = 0.f; stB[r] = 0.f; }
    SSD_LOAD_REGS(0);
    if (wave == 1) { SSD_LOAD_DT(0); SSD_PREP_A(0); }
    LDS_WAIT(); __syncthreads();
#pragma nounroll
    for (int k = 0; k < 16; ++k) {
        const int buf = k & 1, nb = buf ^ 1; const size_t m0 = mbase + (size_t)k * 128;
        Ctx c; c.lds = lds; c.a2 = (const LAS float*)(lds + LA + buf * 2048); c.dtl = c.a2 + 128; c.fsl = c.a2 + 256; c.lane = lane; c.r32 = r32; c.hi = hi;
#pragma unroll
        for (int i = 0; i < 4; ++i) { *(LAS v4u*)(lds + LB + bchk * BCS + (brow + 32 * i) * 16) = Breg[i]; *(LAS v4u*)(lds + LC + bchk * BCS + (brow + 32 * i) * 16) = Creg[i]; }
        *(LAS v4u*)(lds + LX + xrow * 64 + xpc * 16) = xreg;
        { const float wsc = __builtin_amdgcn_exp2f(c.a2[127] - c.a2[xrow]) * c.dtl[xrow];
          const float x0 = __builtin_bit_cast(float, xreg.x << 16) * wsc, x1 = __builtin_bit_cast(float, xreg.x & 0xffff0000u) * wsc, x2 = __builtin_bit_cast(float, xreg.y << 16) * wsc, x3 = __builtin_bit_cast(float, xreg.y & 0xffff0000u) * wsc;
          const float x4 = __builtin_bit_cast(float, xreg.z << 16) * wsc, x5 = __builtin_bit_cast(float, xreg.z & 0xffff0000u) * wsc, x6 = __builtin_bit_cast(float, xreg.w << 16) * wsc, x7 = __builtin_bit_cast(float, xreg.w & 0xffff0000u) * wsc;
          v4u xw; xw.x = pk2(x0, x1); xw.y = pk2(x2, x3); xw.z = pk2(x4, x5); xw.w = pk2(x6, x7);
          *(LAS v4u*)(lds + LXW + xrow * 64 + xpc * 16) = xw; }
        LDS_WAIT(); __syncthreads();
        if (k < 15) { SSD_LOAD_REGS(k + 1); if (wave == 1) SSD_LOAD_DT(k + 1); }
        {
            f32x16 y; bf16x8 cf[8];
#pragma unroll
            for (int r = 0; r < 16; ++r) y[r] = 0.f;
            if (wave == 0)      { load_cf(c, 3, cf); intra<true>(c, 3, 3, cf, y); intra<false>(c, 3, 2, cf, y); put_slot(c, 0, y); }
            else if (wave == 1) { load_cf(c, 3, cf); intra<false>(c, 3, 1, cf, y); intra<false>(c, 3, 0, cf, y); put_slot(c, 1, y); if (k < 15) SSD_PREP_A(nb); }
            else if (wave == 2) { load_cf(c, 2, cf); intra<true>(c, 2, 2, cf, y); intra<false>(c, 2, 1, cf, y); put_slot(c, 3, y); }
            else if (wave == 3) { load_cf(c, 2, cf); intra<false>(c, 2, 0, cf, y); put_slot(c, 4, y);
#pragma unroll
                                  for (int r = 0; r < 16; ++r) y[r] = 0.f;
                                  load_cf(c, 0, cf); intra<true>(c, 0, 0, cf, y); put_slot(c, 8, y); }
            else if (wave == 4) { load_cf(c, 1, cf); intra<true>(c, 1, 1, cf, y); intra<false>(c, 1, 0, cf, y); put_slot(c, 6, y); }
            else if (wave == 5) { if (k > 0) { yoff(c, 3, buf, y); put_slot(c, 2, y); yoff(c, 2, buf, y); put_slot(c, 5, y); yoff(c, 1, buf, y); put_slot(c, 7, y); yoff(c, 0, buf, y); put_slot(c, 9, y); } }
            else if (wave == 6) { state_item(c, 0, nb, stA); state_item(c, 1, nb, stB); }
            else                { state_item(c, 2, nb, stA); state_item(c, 3, nb, stB); }
        }
        LDS_WAIT(); __syncthreads();
        { const int row = tid >> 2, pc = tid & 3, lb = wave >> 1, rl = row & 31;
          const int s0 = lb == 3 ? 0 : (lb == 2 ? 3 : (lb == 1 ? 6 : 8)), s1 = lb == 3 ? 1 : (lb == 2 ? 4 : -1), so = lb == 3 ? 2 : (lb == 2 ? 5 : (lb == 1 ? 7 : 9));
          const LAS float* p0 = (const LAS float*)(lds + LSL + s0 * 4096) + rl * 32 + pc * 8;
          f32x4 ya = *(const LAS f32x4*)p0, yb = *(const LAS f32x4*)(p0 + 4);
          if (s1 >= 0) { const LAS float* p1 = (const LAS float*)(lds + LSL + s1 * 4096) + rl * 32 + pc * 8; ya += *(const LAS f32x4*)p1; yb += *(const LAS f32x4*)(p1 + 4); }
          if (k > 0) { const LAS float* p2 = (const LAS float*)(lds + LSL + so * 4096) + rl * 32 + pc * 8; ya += *(const LAS f32x4*)p2; yb += *(const LAS f32x4*)(p2 + 4); }
          const v4u xv = *(const LAS v4u*)(lds + LX + row * 64 + pc * 16);
          v4u o; o.x = pk2(ya.x + Dk * __builtin_bit_cast(float, xv.x << 16), ya.y + Dk * __builtin_bit_cast(float, xv.x & 0xffff0000u)); o.y = pk2(ya.z + Dk * __builtin_bit_cast(float, xv.y << 16), ya.w + Dk * __builtin_bit_cast(float, xv.y & 0xffff0000u));
          o.z = pk2(yb.x + Dk * __builtin_bit_cast(float, xv.z << 16), yb.y + Dk * __builtin_bit_cast(float, xv.z & 0xffff0000u)); o.w = pk2(yb.z + Dk * __builtin_bit_cast(float, xv.w << 16), yb.w + Dk * __builtin_bit_cast(float, xv.w & 0xffff0000u));
          *(GAS v4u*)(YS + (m0 + row) * 1024 + h * 64 + ph * 32 + pc * 8) = o; }
    }
    LDS_WAIT(); __syncthreads();
#undef SSD_LOAD_REGS
#undef SSD_LOAD_DT
#undef SSD_PREP_A
}
#undef SSD_PIN8
#undef SSD_PIN4
}
__device__ __forceinline__ void p3_ssd(Frame& F, KA args) {
    for (int u = F.vcu; u < 256; u += F.G) ssd::unit(F, args, u);
}

__device__ __forceinline__ void p0_small(Frame& F, KA args) {
    const int gt = (F.vcu * NWAVES + F.wave) * 64 + F.lane, NGT = F.G * NWAVES * 64;
    const float* ln2 = (const float*)args->in[18]; const float* wrg = (const float*)args->in[19]; const float* wre = (const float*)args->in[21];
    bf16* WRH = (bf16*)(F.ws + mp::wr); bf16* WRL = WRH + 48 * DM;
    for (int i = gt; i < 48 * DM; i += NGT) { const int c = i / DM, k = i % DM;
        const float w = (c < 4 ? wrg[k * 4 + c] : (c < 36 ? wre[k * 32 + (c - 4)] : 0.f)) * ln2[k];
        const unsigned hi = f2bf(w); const float lo = w - bf2f((unsigned short)hi);
        WRH[i] = (bf16)hi; WRL[i] = (bf16)f2bf(lo); }
    { GAS v4u* z = (GAS v4u*)((bf16*)(F.ws + mp::win) + (size_t)(NIN + 16) * DM);
      for (int i = gt; i < (NIN_G - NIN - 16) * DM / 8; i += NGT) z[i] = (v4u){0u, 0u, 0u, 0u}; }
}

__device__ __forceinline__ void p5_route(Frame& F, KA args) {
    const int lane = F.lane;
    const bf16* h = (const bf16*)(F.ws + mp::xn2);
    const bf16* WRH = (const bf16*)(F.ws + mp::wr); const bf16* WRL = WRH + 48 * DM;
    const float* brg = (const float*)args->in[20]; const float* bre = (const float*)args->in[22];
    int* tok_e = (int*)(F.ws + mp::small + SM_TOK_E); int* tok_pos = (int*)(F.ws + mp::small + SM_TOK_POS); float* tok_w = (float*)(F.ws + mp::small + SM_TOK_W);
    int* lst_tok = (int*)(F.ws + mp::lst); float* lst_w = (float*)(F.ws + mp::lst) + NE * LCAP; float* lst_r = lst_w + NE * LCAP;
    unsigned* cnt = (unsigned*)(F.ctl + CW_CNT);
    LAS float* lg = (LAS float*)(F.lds + RING_OFF + F.wave * 4096);
    constexpr int KQ = 512, WQB = 2 * 48 * KQ * 2;
    LAS unsigned char* wq = F.lds + RING_OFF + 32768;
    for (int wt = F.vcu; wt < M / 64; wt += F.G) {
        const int rt = F.wave & 3, kh = F.wave >> 2, task = wt * 4 + rt;
        const bf16* hr = h + (size_t)(task * 16 + (lane & 15)) * DM + (lane >> 4) * 8;
        f32x4 acc0 = (f32x4){0.f, 0.f, 0.f, 0.f}, acc1 = acc0, acc2 = acc0; float ss = 0.f;
        for (int q = 0; q < DM / KQ; ++q) {
            __syncthreads();
#pragma unroll
            for (int i = 0; i < 12; ++i) { const int pc = F.tid + 512 * i, row = pc >> 6, c16 = pc & 63;
                const v4u v = *(const GAS v4u*)((row < 48 ? WRH + (size_t)row * DM : WRL + (size_t)(row - 48) * DM) + q * KQ + c16 * 8);
                *(LAS v4u*)(wq + row * 1040 + c16 * 16) = v; }
            LDS_WAIT(); __syncthreads();
#pragma unroll 4
            for (int k8 = 0; k8 < 8; ++k8) {
                const int kt = kh * 8 + k8;
                const v4u hv = *(const GAS v4u*)(hr + q * KQ + kt * 32);
                { const float e0 = __builtin_bit_cast(float, hv.x << 16), e1 = __builtin_bit_cast(float, hv.x & 0xffff0000u), e2 = __builtin_bit_cast(float, hv.y << 16), e3 = __builtin_bit_cast(float, hv.y & 0xffff0000u);
                  const float e4 = __builtin_bit_cast(float, hv.z << 16), e5 = __builtin_bit_cast(float, hv.z & 0xffff0000u), e6 = __builtin_bit_cast(float, hv.w << 16), e7 = __builtin_bit_cast(float, hv.w & 0xffff0000u);
                  ss += (e0 * e0 + e1 * e1) + (e2 * e2 + e3 * e3) + (e4 * e4 + e5 * e5) + (e6 * e6 + e7 * e7); }
                const bf16x8 ah = __builtin_bit_cast(bf16x8, hv);
                const LAS unsigned char* bp = wq + (lane & 15) * 1040 + kt * 64 + (lane >> 4) * 16;
                { const bf16x8 b_h = *(const LAS bf16x8*)(bp), b_l = *(const LAS bf16x8*)(bp + 48 * 1040);
                  acc0 = __builtin_amdgcn_mfma_f32_16x16x32_bf16(ah, b_h, acc0, 0, 0, 0); acc0 = __builtin_amdgcn_mfma_f32_16x16x32_bf16(ah, b_l, acc0, 0, 0, 0); }
                { const bf16x8 b_h = *(const LAS bf16x8*)(bp + 16 * 1040), b_l = *(const LAS bf16x8*)(bp + 64 * 1040);
                  acc1 = __builtin_amdgcn_mfma_f32_16x16x32_bf16(ah, b_h, acc1, 0, 0, 0); acc1 = __builtin_amdgcn_mfma_f32_16x16x32_bf16(ah, b_l, acc1, 0, 0, 0); }
                { const bf16x8 b_h = *(const LAS bf16x8*)(bp + 32 * 1040), b_l = *(const LAS bf16x8*)(bp + 80 * 1040);
                  acc2 = __builtin_amdgcn_mfma_f32_16x16x32_bf16(ah, b_h, acc2, 0, 0, 0); acc2 = __builtin_amdgcn_mfma_f32_16x16x32_bf16(ah, b_l, acc2, 0, 0, 0); }
            }
        }
        __syncthreads();
        LAS float* xp = (LAS float*)(F.lds + RING_OFF + 32768 + rt * 4096) + lane * 13;
        if (kh == 1) {
#pragma unroll
            for (int q = 0; q < 4; ++q) { xp[q] = acc0[q]; xp[4 + q] = acc1[q]; xp[8 + q] = acc2[q]; }
            xp[12] = ss; }
        LDS_WAIT(); __syncthreads();
        if (kh == 0) {
#pragma unroll
        for (int q = 0; q < 4; ++q) { acc0[q] += xp[q]; acc1[q] += xp[4 + q]; acc2[q] += xp[8 + q]; }
        ss += xp[12];
        ss += __shfl_xor(ss, 16); ss += __shfl_xor(ss, 32);
        const float r = 1.0f / sqrtf(ss * (1.f / DM) + EPS);
#pragma unroll
        for (int reg = 0; reg < 4; ++reg) { const int row = (lane >> 4) * 4 + reg; const float rr = __shfl(r, row);
            lg[row * 48 + (lane & 15)] = acc0[reg] * rr; lg[row * 48 + 16 + (lane & 15)] = acc1[reg] * rr; lg[row * 48 + 32 + (lane & 15)] = acc2[reg] * rr; }
        LDS_WAIT(); asm volatile("" ::: "memory");
        if (lane < 16) {
            const LAS float* L = lg + lane * 48; const int tok = task * 16 + lane;
            float gl[4];
#pragma unroll
            for (int j = 0; j < 4; ++j) gl[j] = L[j] + brg[j];
            int gs = 0; float gm = gl[0];
#pragma unroll
            for (int j = 1; j < 4; ++j) if (gl[j] > gm) { gm = gl[j]; gs = j; }
            float gsum = 0.f;
#pragma unroll
            for (int j = 0; j < 4; ++j) gsum += expf(gl[j] - gm);
            const float gwt = 1.f / gsum;
            float el[8];
#pragma unroll
            for (int j = 0; j < 8; ++j) el[j] = L[4 + gs * 8 + j] + bre[gs * 8 + j];
            int i1 = 0; float m1 = el[0];
#pragma unroll
            for (int j = 1; j < 8; ++j) if (el[j] > m1) { m1 = el[j]; i1 = j; }
            int i2 = 0; float m2 = -INFINITY;
#pragma unroll
            for (int j = 0; j < 8; ++j) if (j != i1 && el[j] > m2) { m2 = el[j]; i2 = j; }
            const float e2 = expf(m2 - m1); const float w1 = gwt / (1.f + e2), w2 = gwt * e2 / (1.f + e2);
            const int ea = gs * 8 + i1, eb = gs * 8 + i2;
            tok_e[tok * 2] = ea; tok_e[tok * 2 + 1] = eb; tok_w[tok * 2] = w1; tok_w[tok * 2 + 1] = w2;
            const int pa = (int)__hip_atomic_fetch_add(cnt + ea, 1u, RLX_AGENT), pb = (int)__hip_atomic_fetch_add(cnt + eb, 1u, RLX_AGENT);
            tok_pos[tok * 2] = pa; tok_pos[tok * 2 + 1] = pb;
            lst_tok[ea * LCAP + pa] = tok; lst_w[ea * LCAP + pa] = w1; lst_r[ea * LCAP + pa] = r; lst_tok[eb * LCAP + pb] = tok; lst_w[eb * LCAP + pb] = w2; lst_r[eb * LCAP + pb] = r;
        }
        }
        LDS_WAIT(); __syncthreads();
    }
}

__device__ __forceinline__ void build_tab(Frame& F, KA args) {
    LAS int* tab = (LAS int*)(F.lds + TAB_OFF);
    if (F.wave == 0) {
        const int lane = F.lane, e = lane & 31; unsigned* cnt = (unsigned*)(F.ctl + CW_CNT);
        const int c = (int)__hip_atomic_load(cnt + e, RLX_AGENT), mt = (c + 255) >> 8;
        int sc = mt;
#pragma unroll
        for (int o = 1; o < 32; o <<= 1) { const int t = __shfl_up(sc, o); if (e >= o) sc += t; }
        if (lane < 32) { tab[e] = (sc - mt) * 8; tab[40 + e] = sc - mt; tab[80 + e] = c; }
        if (lane == 31) { tab[32] = sc * 8; tab[72] = sc; }
    }
    LDS_WAIT(); __syncthreads();
}

__device__ __forceinline__ void p8_combine(Frame& F, KA args) {
    const int gw = F.vcu * NWAVES + F.wave, NGW = F.G * NWAVES, lane = F.lane;
    build_tab(F, args);
    const LAS int* tab = (const LAS int*)(F.lds + TAB_OFF);
    const int* tok_e = (const int*)(F.ws + mp::small + SM_TOK_E); const int* tok_pos = (const int*)(F.ws + mp::small + SM_TOK_POS); const unsigned char* Y8 = (const unsigned char*)(F.ws + mp::y); float* out = args->out;
    const bf16* HB = (const bf16*)(F.ws + mp::xn2);
    v4u hvA[2][2], avA[2], bvA[2], hvB[2][2], avB[2], bvB[2];
#define P8_LOAD(t_, hv_, av_, bv_) do { const int s0_ = tab[40 + tok_e[2 * (t_)]] * 256 + tok_pos[2 * (t_)], s1_ = tab[40 + tok_e[2 * (t_) + 1]] * 256 + tok_pos[2 * (t_) + 1]; \
        _Pragma("unroll") for (int j = 0; j < 2; ++j) { const int c0 = 16 * (lane + 64 * j); \
            hv_[j][0] = __builtin_nontemporal_load((const GAS v4u*)(HB + (size_t)(t_) * DM + c0)); hv_[j][1] = __builtin_nontemporal_load((const GAS v4u*)(HB + (size_t)(t_) * DM + c0 + 8)); \
            av_[j] = __builtin_nontemporal_load((const GAS v4u*)(Y8 + (size_t)s0_ * DM + c0)); bv_[j] = __builtin_nontemporal_load((const GAS v4u*)(Y8 + (size_t)s1_ * DM + c0)); } } while (0)
#define P8_STORE(t_, hv_, av_, bv_) do { \
        _Pragma("unroll") for (int j = 0; j < 2; ++j) { const int c0 = 16 * (lane + 64 * j); \
            const unsigned hw[8] = {hv_[j][0].x, hv_[j][0].y, hv_[j][0].z, hv_[j][0].w, hv_[j][1].x, hv_[j][1].y, hv_[j][1].z, hv_[j][1].w}; \
            const unsigned aw[4] = {av_[j].x, av_[j].y, av_[j].z, av_[j].w}, bw[4] = {bv_[j].x, bv_[j].y, bv_[j].z, bv_[j].w}; \
            _Pragma("unroll") for (int q = 0; q < 4; ++q) { \
                const f32x2_t a01 = __builtin_amdgcn_cvt_pk_f32_fp8((int)aw[q], false), a23 = __builtin_amdgcn_cvt_pk_f32_fp8((int)aw[q], true); \
                const f32x2_t b01 = __builtin_amdgcn_cvt_pk_f32_fp8((int)bw[q], false), b23 = __builtin_amdgcn_cvt_pk_f32_fp8((int)bw[q], true); \
                f32x4 v; \
                v.x = __builtin_bit_cast(float, hw[2 * q] << 16) + (a01.x + b01.x) * (1.f / Y8_SCALE); v.y = __builtin_bit_cast(float, hw[2 * q] & 0xffff0000u) + (a01.y + b01.y) * (1.f / Y8_SCALE); \
                v.z = __builtin_bit_cast(float, hw[2 * q + 1] << 16) + (a23.x + b23.x) * (1.f / Y8_SCALE); v.w = __builtin_bit_cast(float, hw[2 * q + 1] & 0xffff0000u) + (a23.y + b23.y) * (1.f / Y8_SCALE); \
                *(GAS f32x4*)(out + (size_t)(t_) * DM + c0 + 4 * q) = v; } } } while (0)
    typedef float f32x2_t __attribute__((ext_vector_type(2)));
    if (gw < M) P8_LOAD(gw, hvA, avA, bvA);
    for (int t = gw; t < M; t += 2 * NGW) {
        P8_LOAD(t + NGW, hvB, avB, bvB);
        P8_STORE(t, hvA, avA, bvA);
        if (t + 2 * NGW < M) P8_LOAD(t + 2 * NGW, hvA, avA, bvA);
        P8_STORE(t + NGW, hvB, avB, bvB);
    }
#undef P8_LOAD
#undef P8_STORE
}

constexpr int N_PHASES = 11;
#ifndef MK_REP_BAR
#define MK_REP_BAR 0
#endif
#ifndef MK_REP_PHASE
#define MK_REP_PHASE -1
#endif
#define PHASE_ARGS() ({ KA p_ = (KA)__builtin_amdgcn_kernarg_segment_ptr(); asm volatile("" : "+s"(p_)); p_; })
__global__ void __launch_bounds__(NWAVES * 64, 2) mega(Args args_byval) {
    KA args = PHASE_ARGS(); (void)args_byval;
    extern __shared__ __attribute__((aligned(16))) unsigned char lds[];
    Frame F;
    F.lds = (LAS unsigned char*)lds;
    F.MISC = (volatile LAS unsigned*)(F.lds + MISC_OFF);
    F.tid = threadIdx.x; F.lane = F.tid & 63; F.wave = __builtin_amdgcn_readfirstlane(F.tid >> 6);
    F.G = gridDim.x; { const int bx = blockIdx.x; F.vcu = (F.G % 8 == 0) ? (bx % 8) * (F.G / 8) + bx / 8 : bx; }
    F.cid = (int)blockIdx.x;
    F.ws = args->ws;
    F.ctl = (gu32*)(F.ws + mp::ctl);
    for (int u = F.tid; u < (LDS_BYTES - LDSCTL_OFF) / 4; u += NWAVES * 64) ((LAS unsigned*)(F.lds + LDSCTL_OFF))[u] = 0u;
    __syncthreads();
    const bool one_launch = (args->li < 0);
    XcdBarrier bar; bar.bar = (unsigned*)(F.ctl + CW_BAR); bar.x = 0; bar.st = nullptr;
    if (one_launch) bar = xcd_barrier_post((unsigned*)(F.ctl + CW_BAR), F.MISC + 8);
    if (one_launch && F.tid == 0) { const unsigned x_ = xb_xcc_id(); F.MISC[10] = x_; F.MISC[11] = xb_add((unsigned*)(F.ctl + CW_RANK + 64 * x_), 1u); }
    bool local_ok = false; unsigned* loc_ctr = nullptr;
    const int lo = args->ph_lo, hi = args->ph_hi;
#define IN(k) (lo <= (k) && (k) < hi)
#define SEAM(k) do { if (IN(k) && IN((k) + 1)) xcd_barrier(bar); } while (0)
#define SEAM_LOCAL(k) do { if (IN(k) && IN((k) + 1)) { if (local_ok) xcd_local_barrier(bar.bar, loc_ctr, 32u); else xcd_barrier(bar); } } while (0)

    if (IN(0)) for (int rep_ = 0; rep_ < (MK_REP_PHASE == 0 ? 2 : 1); ++rep_) { args = PHASE_ARGS(); p0_prologue(F, args); if (args->p0_mask & 8) p0_small(F, args); if (args->p0_mask & 16) p0_rope(F, args); }
    if (one_launch && IN(0) && IN(1)) {
        XbTok tok; xcd_barrier_arrive(bar, tok);
        if (F.tid == 0) { unsigned ok_ = (F.G == 256) ? 1u : 0u;
            for (unsigned j = 0; j < 16; ++j) { const unsigned c_ = xb_ld(&bar.bar[XB_XCNT(j)]); if (c_ != (j < 8 ? 32u : 0u)) ok_ = 0u; }
            F.MISC[12] = ok_; }
        __syncthreads();
        if (F.MISC[12]) { const int x_ = (int)F.MISC[10], r_ = (int)F.MISC[11]; local_ok = true; F.vcu = x_ * 32 + r_; F.cid = r_ * 8 + x_; loc_ctr = (unsigned*)(F.ctl + CW_LOC + 64 * x_); }
        args = PHASE_ARGS(); p0_xn1(F, args);
        xcd_barrier_wait(bar, tok);
        if (local_ok) xcd_local_barrier(bar.bar, loc_ctr, 32u); else xcd_barrier(bar);
    } else {
        if (IN(0)) { args = PHASE_ARGS(); p0_xn1(F, args); }
        SEAM(0);
    }
    if (IN(1)) for (int rep_ = 0; rep_ < (MK_REP_PHASE == 1 ? 2 : 1); ++rep_) { args = PHASE_ARGS();
        pg8::Gemm g{(const bf16*)(F.ws + mp::xn), (const bf16*)(F.ws + mp::win), M, NIN_G, DM};
        pg8::EpiInProj E{(bf16*)(F.ws + mp::u16), NIN, (float*)(F.ws + mp::dt)};
#if P1_HOSTS_P0B == 1
        const int c_ = F.cid, xcd_ = c_ & 7, team_ = c_ >> 6;
        const int ks = team_ < 3 ? ((xcd_ % P1_NCLASS) == 0 ? (xcd_ + 2 * team_) % 7 : 0) : xcd_ % 6;
        for (int part = 0; part < 2; ++part) {
            pg8::TeamOrder S{c_, part == 0 ? 0 : ks, part == 0 ? ks : 6};
            pg8::gemm_phase<pg8::EpiInProj, pg8::TeamOrder, PG8_ALIGN, PG8_SP2>(F.lds + RING_OFF, g, S, E);
            if (part == 0) { __syncthreads(); args = PHASE_ARGS(); p1_convert_share(F, args, 0); __syncthreads(); }
        }
#elif P1_HOSTS_P0B == 2
        pg8::StaticOrder S; S.init(M, NIN_G, F.G, (int)blockIdx.x);
        typedef pg8::ConvMoE<KA, 23, mp::wgu, mp::wd, mp::END, RING_OFF + RING_BYTES> CvJob;
        pg8::gemm_phase<pg8::EpiInProj, pg8::StaticOrder, PG8_ALIGN, PG8_SP2, false, CvJob>(F.lds + RING_OFF, g, S, E, CvJob{});
        if ((int)blockIdx.x >= P1_UNITS - 5 * F.G) { __syncthreads(); args = PHASE_ARGS(); p0b_blocks(F, args, 4 * (P1_INLOOP_BLOCKS + ((int)blockIdx.x - (P1_UNITS - 5 * F.G)) * NWAVES + F.wave), 4); }
#else
        pg8::StaticOrder S; S.init(M, NIN_G, F.G, (int)blockIdx.x);
        pg8::gemm_phase<pg8::EpiInProj, pg8::StaticOrder, PG8_ALIGN, PG8_SP2>(F.lds + RING_OFF, g, S, E);
#endif
    }
    SEAM_LOCAL(1);
    if (IN(2)) for (int rep_ = 0; rep_ < (MK_REP_PHASE == 2 ? 2 : 1); ++rep_) { if (MK_REP_BAR && rep_) xcd_barrier(bar); args = PHASE_ARGS(); p2_qknorm(F, args); p2_conv(F, args); }
    SEAM_LOCAL(2);
    if (IN(3)) for (int rep_ = 0; rep_ < (MK_REP_PHASE == 3 ? 2 : 1); ++rep_) { args = PHASE_ARGS(); if (args->p0_mask & 128) p3_ssd(F, args); p3_attention(F, args, lds);
#if P1_HOSTS_P0B == 1
        if (rep_ == 0) { __syncthreads(); args = PHASE_ARGS(); p1_convert_share(F, args, 1); }
#endif
    }
    SEAM_LOCAL(3);
    if (IN(4)) for (int rep_ = 0; rep_ < (MK_REP_PHASE == 4 ? 2 : 1); ++rep_) { args = PHASE_ARGS(); p4_ycat(F, args, (args->p0_mask >> 5) & 3); }
    SEAM_LOCAL(4);
    if (IN(5)) for (int rep_ = 0; rep_ < (MK_REP_PHASE == 5 ? 2 : 1); ++rep_) { args = PHASE_ARGS();
        pg8::Gemm g{(const bf16*)(F.ws + mp::ycat), (const bf16*)(F.ws + mp::wout), M, DM, DM}; pg8::StaticOrder S; S.init(M, DM, F.G, F.cid);
        pg8::EpiResid E{(const float*)args->in[0], (bf16*)(F.ws + mp::xn2), (unsigned char*)(F.ws + mp::xn8), DM, (const float*)args->in[18]};
        pg8::gemm_phase<pg8::EpiResid, pg8::StaticOrder, PG8_ALIGN, PG8_SP2>(F.lds + RING_OFF, g, S, E);
#if P1_HOSTS_P0B == 1
        if (rep_ == 0) { __syncthreads(); args = PHASE_ARGS(); p1_convert_share(F, args, 2); }
#endif
    }
    SEAM_LOCAL(5);
    if (IN(6)) for (int rep_ = 0; rep_ < (MK_REP_PHASE == 6 ? 2 : 1); ++rep_) { args = PHASE_ARGS(); p5_route(F, args);
#if P1_HOSTS_P0B == 1
        if (rep_ == 0) { __syncthreads(); args = PHASE_ARGS(); p1_convert_share(F, args, 3); }
#endif
    }
    SEAM(6);
    if (IN(8)) for (int rep_ = 0; rep_ < (MK_REP_PHASE == 8 ? 2 : 1); ++rep_) { args = PHASE_ARGS();
        build_tab(F, args);
        pg8::Gemm g{(const bf16*)(F.ws + mp::xn8), (const bf16*)(F.ws + mp::wgu), M, NE * 2048, DM / 2};    pg8::ExpertOrder S; S.init((const LAS int*)(F.lds + TAB_OFF), F.G, F.cid);
        pg8::ExpertRows RS{(const LAS int*)(F.lds + TAB_OFF), (const int*)(F.ws + mp::lst), LCAP};
        pg8::EpiGateUp E{(unsigned char*)(F.ws + mp::hid), EH, pg8::ExpertScale{(const LAS int*)(F.lds + TAB_OFF), (const float*)(F.ws + mp::lst) + 2 * NE * LCAP, LCAP}, 1.f / F8_WSCALE};
        pg8::gemm_phase_g<pg8::EpiGateUp, pg8::ExpertOrder, pg8::ExpertRows, PG8_ALIGN, PG8_SP2, true>(F.lds + RING_OFF, g, S, E, RS);
#if P1_HOSTS_P0B == 1
        if (rep_ == 0) { __syncthreads(); args = PHASE_ARGS(); p8_convert_late(F, args); }
#endif
    }
    SEAM(8);
    if (IN(9)) for (int rep_ = 0; rep_ < (MK_REP_PHASE == 9 ? 2 : 1); ++rep_) { args = PHASE_ARGS();
        build_tab(F, args);
        pg8::Gemm g{(const bf16*)(F.ws + mp::hid), (const bf16*)(F.ws + mp::wd), SLOT_CAP, NE * 2048, EH / 2};    pg8::ExpertOrder S; S.init((const LAS int*)(F.lds + TAB_OFF), F.G, F.cid);
        pg8::EpiRowScale E{(unsigned char*)(F.ws + mp::y), DM, pg8::ExpertScale{(const LAS int*)(F.lds + TAB_OFF), (const float*)(F.ws + mp::lst) + NE * LCAP, LCAP}, Y8_SCALE / F8_WSCALE};
        pg8::gemm_phase<pg8::EpiRowScale, pg8::ExpertOrder, PG8_ALIGN, PG8_SP2, true>(F.lds + RING_OFF, g, S, E);
    }
    SEAM(9);
    if (IN(10)) for (int rep_ = 0; rep_ < (MK_REP_PHASE == 10 ? 2 : 1); ++rep_) { args = PHASE_ARGS(); p8_combine(F, args); }
#undef IN
#undef SEAM
#undef SEAM_LOCAL
}

__global__ void __launch_bounds__(256) k_u16_to_f32(const bf16* __restrict__ U16, const float* __restrict__ DT, float* __restrict__ U) {
    const size_t idx = (size_t)blockIdx.x * 256 + threadIdx.x;
    const int c = (int)(idx % IN_COLS); const size_t m = idx / IN_COLS;
    float v;
    if (c < 2560) v = bf2f(U16[m * NIN + c]); else if (c < 2576) v = DT[m * 16 + (c - 2560)]; else v = bf2f(U16[m * NIN + c - 16]);
    U[idx] = v;
}
__global__ void __launch_bounds__(256) k_f32_to_bf16(const float* __restrict__ src, bf16* __restrict__ dst) {
    const size_t i = (size_t)blockIdx.x * 256 + threadIdx.x;
    const float4 v = ((const float4*)src)[i]; v2u o; o.x = pk2(v.x, v.y); o.y = pk2(v.z, v.w); ((v2u*)dst)[i] = o;
}
__global__ void __launch_bounds__(256) k_ssdhalf_to_bf16(const float* __restrict__ YCATf, bf16* __restrict__ YCAT16) {
    const size_t i = (size_t)blockIdx.x * 256 + threadIdx.x;
    const size_t m = i >> 8; const int c4 = (int)(i & 255);
    const float4 v = ((const float4*)(YCATf + m * DM))[c4]; v2u o; o.x = pk2(v.x, v.y); o.y = pk2(v.z, v.w); ((v2u*)(YCAT16 + m * DM))[c4] = o;
}

#ifndef MK_ONE_LAUNCH
#define MK_ONE_LAUNCH 1
#endif
extern "C" void kernel_launch(void* const* d_in, const int* in_sizes, int n_in, void* d_out, int out_size, void* d_ws, size_t ws_size, hipStream_t stream) {
    static int ready = 0;
    if (!ready) {
        if (hipFuncSetAttribute((const void*)mega, hipFuncAttributeMaxDynamicSharedMemorySize, LDS_BYTES) != hipSuccess) { fprintf(stderr, "hipFuncSetAttribute failed\n"); }
        if (ws_size < mp::END) fprintf(stderr, "kernel_launch: ws_size %zu too small\n", ws_size);
        ready = 1;
    }
    (void)hipMemsetAsync(d_ws, 0, CTL_ZERO_BYTES, stream);
    Args a{};
    for (int i = 0; i < 26; ++i) a.in[i] = d_in[i];
    a.out = (float*)d_out; a.ws = (unsigned char*)d_ws;
    a.p0_mask = 1 | 2 | 4 | 8 | 16 | (1 << 5) | 128; a.rep_phase = MK_REP_PHASE;
#if MK_ONE_LAUNCH
    a.ph_lo = 0; a.ph_hi = N_PHASES; a.li = -1; hipLaunchKernelGGL(mega, dim3(256), dim3(NWAVES * 64), LDS_BYTES, stream, a);
#else
    for (int ph = 0; ph < N_PHASES; ++ph) { a.ph_lo = ph; a.ph_hi = ph + 1; a.li = ph; hipLaunchKernelGGL(mega, dim3(256), dim3(NWAVES * 64), LDS_BYTES, stream, a); }
#endif
}
```
